# Optimizing an MI355X kernel written in HIP

```python
import math
import jax
import jax.numpy as jnp
from jax import lax
import numpy as np

D_MODEL = 1024
BATCH = 2
SEQ = 16384
DEPTH = 2

GRID_W = 64
CTX_LEN = 256
N_BRANCH = 4
WA = 256
CONF_K = 31
NA_HEADS = 4
NA_HEAD_DIM = 64
WB = NA_HEADS * NA_HEAD_DIM
NA_WIN_ROWS = 8
NA_WIN_COLS = 16
ATTN_SCALE = NA_HEAD_DIM ** -0.5
WC = 256
SC_K = 3
WD = 256
HY_ORDER = 2
HY_SHORT_K = 3
HY_PE_BANDS = 16
HY_PE_DIM = 1 + 2 * HY_PE_BANDS
HY_FILT_HID = 64
HY_FAST_DECAY = 0.3
HY_SLOW_DECAY = 1.5
HY_DECAY_TARGET = 1e-2
D_FF = 2816
N_MOD = 9
LN_EPS = 1e-5
ALPHA = (2 * DEPTH) ** 0.25
BETA = (8 * DEPTH) ** -0.25

OFF_A = 0
OFF_Q = OFF_A + 2 * WA
OFF_K = OFF_Q + WB
OFF_V = OFF_K + WB
OFF_SB = OFF_V + WB
OFF_SC = OFF_SB + WC
OFF_SX = OFF_SC + WC
OFF_HV = OFF_SX + WC
OFF_G = OFF_HV + (1 + HY_ORDER) * WD
P_IN = OFF_G + N_BRANCH * D_MODEL

kernel_name = 'hybrid_conv_na_hyena_diffusion_block'


def layer_norm(x, g=None, b=None):
    xf = x.astype(jnp.float32)
    mu = jnp.mean(xf, -1, keepdims=True)
    var = jnp.mean(jnp.square(xf - mu), -1, keepdims=True)
    y = (xf - mu) * lax.rsqrt(var + LN_EPS)
    if g is not None:
        y = y * g.astype(jnp.float32) + b.astype(jnp.float32)
    return y.astype(x.dtype)


def modulate(x, shift, scale):
    return layer_norm(x) * (1.0 + scale) + shift


def post_norm(x, sub, g, b):
    return layer_norm(ALPHA * x + sub, g, b)


def swiglu(h, w_in, w_out):
    a, g = jnp.split(h @ w_in, 2, axis=-1)
    return (jax.nn.silu(g) * a) @ w_out


def depthwise_conv(u, w, b=None):
    k = w.shape[0]
    y = lax.conv_general_dilated(u, w[:, None, :].astype(u.dtype), window_strides=(1,),
                                 padding=[(k // 2, k // 2)],
                                 dimension_numbers=('NWC', 'WIO', 'NWC'),
                                 feature_group_count=u.shape[-1])
    if b is not None:
        y = y + b
    return y


def heads(t):
    return t.reshape(*t.shape[:-1], NA_HEADS, NA_HEAD_DIM)


def conformer_conv(u2, dw_w, dw_b, ln_g, ln_b, w_proj):
    a, g = jnp.split(u2, 2, axis=-1)
    u = depthwise_conv(a * jax.nn.sigmoid(g), dw_w, dw_b)
    return jax.nn.silu(layer_norm(u, ln_g, ln_b)) @ w_proj


def short_gated_conv(gate_b, gate_c, u, conv_w, w_proj):
    return (gate_b * depthwise_conv(gate_c * u, conv_w)) @ w_proj


def hyena_filters(length, w1, b1, w2, b2, freq, w3):
    t = jnp.arange(length, dtype=jnp.float32)
    t_norm = t / max(length - 1, 1)
    bands = jnp.linspace(1e-4, HY_PE_BANDS - 1, HY_PE_BANDS, dtype=jnp.float32)
    ang = (2.0 * math.pi / length) * t[:, None] * bands[None, :]
    z = jnp.concatenate([t_norm[:, None], jnp.cos(ang), -jnp.sin(ang)], axis=-1)
    h = jnp.sin(freq[0] * (z @ w1 + b1))
    h = jnp.sin(freq[1] * (h @ w2 + b2))
    h = (h @ w3).astype(jnp.float32).reshape(length, HY_ORDER, 2, WD)
    deltas = jnp.linspace(math.log(HY_DECAY_TARGET) / HY_SLOW_DECAY,
                          math.log(HY_DECAY_TARGET) / HY_FAST_DECAY, WD, dtype=jnp.float32)
    decay = jnp.exp(-t_norm[:, None] * jnp.abs(deltas)[None, :])
    return h * decay[:, None, None, :]


def bidirectional_fft_conv(u, h_fwd, h_bwd, bias):
    length = u.shape[1]
    n = 2 * length
    k = jnp.concatenate([h_fwd, jnp.zeros_like(h_fwd[:1]), h_bwd[1:][::-1]], axis=0)
    k = k * lax.rsqrt(jnp.sum(jnp.square(k), axis=0, keepdims=True) + 1e-6)
    uf = u.astype(jnp.float32)
    spec = jnp.fft.rfft(uf, n=n, axis=1) * jnp.fft.rfft(k, n=n, axis=0)[None]
    y = jnp.fft.irfft(spec, n=n, axis=1)[:, :length]
    return (y + uf * bias.astype(jnp.float32)).astype(u.dtype)


def hyena_mixer(u3, sconv_w, sconv_b, filt, bias, w_proj):
    parts = jnp.split(depthwise_conv(u3, sconv_w, sconv_b), 1 + HY_ORDER, axis=-1)
    z = parts[0]
    for o in range(HY_ORDER):
        z = parts[1 + o] * bidirectional_fft_conv(z, filt[:, o, 0], filt[:, o, 1], bias[o])
    return z @ w_proj


def neighbourhood_attention(q, k, v, kc, vc, rpb):
    bsz, n_tok, n_h, dh = q.shape
    rows = n_tok // GRID_W
    wr = min(NA_WIN_ROWS, rows)
    wc = NA_WIN_COLS
    qg = (q * ATTN_SCALE).reshape(bsz, rows, GRID_W, n_h, dh).transpose(1, 0, 2, 3, 4)
    kg = k.reshape(bsz, rows, GRID_W, n_h, dh)
    vg = v.reshape(bsz, rows, GRID_W, n_h, dh)
    cols = jnp.arange(GRID_W)
    c0 = jnp.clip(cols - wc // 2, 0, GRID_W - wc)
    col_idx = c0[:, None] + jnp.arange(wc)[None, :]
    dc = col_idx - cols[:, None] + (NA_WIN_COLS - 1)

    def row_fn(args):
        r, q_row = args
        r0 = jnp.clip(r - wr // 2, 0, rows - wr)
        k_nb = lax.dynamic_slice_in_dim(kg, r0, wr, axis=1)[:, :, col_idx]
        v_nb = lax.dynamic_slice_in_dim(vg, r0, wr, axis=1)[:, :, col_idx]
        dr = r0 + jnp.arange(wr) - r + (NA_WIN_ROWS - 1)
        bias = rpb[:, dr[None, :, None], dc[:, None, :]]
        s_nb = jnp.einsum('bqhd,brqjhd->bhqrj', q_row, k_nb).astype(jnp.float32) + bias.astype(jnp.float32)
        s_ctx = jnp.einsum('bqhd,bkhd->bhqk', q_row, kc).astype(jnp.float32)
        s = jnp.concatenate([s_nb.reshape(bsz, n_h, GRID_W, wr * wc), s_ctx], axis=-1)
        p = jax.nn.softmax(s, axis=-1).astype(v.dtype)
        p_nb = p[..., :wr * wc].reshape(bsz, n_h, GRID_W, wr, wc)
        p_ctx = p[..., wr * wc:]
        return (jnp.einsum('bhqrj,brqjhd->bqhd', p_nb, v_nb)
                + jnp.einsum('bhqk,bkhd->bqhd', p_ctx, vc))

    out = lax.map(row_fn, (jnp.arange(rows), qg))
    return out.transpose(1, 0, 2, 3, 4).reshape(bsz, n_tok, n_h * dh)


def context_attention(q, k, v):
    s = jnp.einsum('bqhd,bkhd->bhqk', q * ATTN_SCALE, k).astype(jnp.float32)
    p = jax.nn.softmax(s, axis=-1).astype(v.dtype)
    o = jnp.einsum('bhqk,bkhd->bqhd', p, v)
    return o.reshape(*o.shape[:2], WB)


def token_mixer(p, attn, filt, lw):
    ya = conformer_conv(p[..., OFF_A:OFF_Q], lw['conf_dw_w'], lw['conf_dw_b'],
                        lw['conf_ln_g'], lw['conf_ln_b'], lw['conf_w_proj'])
    yb = attn @ lw['na_w_proj']
    yc = short_gated_conv(p[..., OFF_SB:OFF_SC], p[..., OFF_SC:OFF_SX], p[..., OFF_SX:OFF_HV],
                          lw['sc_conv_w'], lw['sc_w_proj'])
    yd = hyena_mixer(p[..., OFF_HV:OFF_G], lw['hy_sconv_w'], lw['hy_sconv_b'], filt,
                     lw['hy_bias'], lw['hy_w_proj'])
    g = jax.nn.sigmoid(p[..., OFF_G:P_IN]).reshape(*p.shape[:-1], N_BRANCH, D_MODEL)
    m = g[..., 0, :] * ya + g[..., 1, :] * yb + g[..., 2, :] * yc + g[..., 3, :] * yd
    return m @ lw['w_out'] + lw['b_out']


def setup_inputs(seed: int = 0) -> dict:
    key = jax.random.key(seed)
    ks = iter(jax.random.split(key, 40))

    def nrm(shape, scale):
        return jax.random.normal(next(ks), shape, jnp.float32) * scale

    L = DEPTH
    return {
        'x': nrm((BATCH, SEQ, D_MODEL), 1.0),
        'c': nrm((BATCH, D_MODEL), 1.0),
        'ctx': nrm((BATCH, CTX_LEN, D_MODEL), 1.0),
        'c_ctx': nrm((D_MODEL,), 1.0),
        'w_mod': nrm((L, D_MODEL, N_MOD * D_MODEL), 0.5 * D_MODEL ** -0.5),
        'b_mod': nrm((L, N_MOD * D_MODEL), 0.01),
        'post_ln_g': 1.0 + nrm((L, 3, D_MODEL), 0.02),
        'post_ln_b': nrm((L, 3, D_MODEL), 0.02),
        'ffn_w_in': nrm((L, 2, D_MODEL, 2 * D_FF), D_MODEL ** -0.5),
        'ffn_w_out': nrm((L, 2, D_FF, D_MODEL), BETA * D_FF ** -0.5),
        'w_in': nrm((L, D_MODEL, P_IN), D_MODEL ** -0.5),
        'b_in': nrm((L, P_IN), 0.02),
        'conf_dw_w': nrm((L, CONF_K, WA), CONF_K ** -0.5),
        'conf_dw_b': nrm((L, WA), 0.02),
        'conf_ln_g': 1.0 + nrm((L, WA), 0.02),
        'conf_ln_b': nrm((L, WA), 0.02),
        'conf_w_proj': nrm((L, WA, D_MODEL), WA ** -0.5),
        'na_rpb': nrm((L, NA_HEADS, 2 * NA_WIN_ROWS - 1, 2 * NA_WIN_COLS - 1), 0.1),
        'na_w_proj': nrm((L, WB, D_MODEL), WB ** -0.5),
        'sc_conv_w': nrm((L, SC_K, WC), SC_K ** -0.5),
        'sc_w_proj': nrm((L, WC, D_MODEL), WC ** -0.5),
        'hy_sconv_w': nrm((L, HY_SHORT_K, (1 + HY_ORDER) * WD), HY_SHORT_K ** -0.5),
        'hy_sconv_b': nrm((L, (1 + HY_ORDER) * WD), 0.02),
        'hy_w1': nrm((L, HY_PE_DIM, HY_FILT_HID), HY_PE_DIM ** -0.5),
        'hy_b1': nrm((L, HY_FILT_HID), 0.02),
        'hy_w2': nrm((L, HY_FILT_HID, HY_FILT_HID), HY_FILT_HID ** -0.5),
        'hy_b2': nrm((L, HY_FILT_HID), 0.02),
        'hy_freq': 1.0 + nrm((L, 2, HY_FILT_HID), 0.1),
        'hy_w3': nrm((L, HY_FILT_HID, HY_ORDER * 2 * WD), HY_FILT_HID ** -0.5),
        'hy_bias': nrm((L, HY_ORDER, WD), 1.0),
        'hy_w_proj': nrm((L, WD, D_MODEL), WD ** -0.5),
        'w_out': nrm((L, D_MODEL, D_MODEL), BETA * D_MODEL ** -0.5),
        'b_out': nrm((L, D_MODEL), 0.02),
    }


def reference(x, c, ctx, c_ctx, w_mod, b_mod, post_ln_g, post_ln_b, ffn_w_in, ffn_w_out,
              w_in, b_in, conf_dw_w, conf_dw_b, conf_ln_g, conf_ln_b, conf_w_proj,
              na_rpb, na_w_proj, sc_conv_w, sc_w_proj, hy_sconv_w, hy_sconv_b,
              hy_w1, hy_b1, hy_w2, hy_b2, hy_freq, hy_w3, hy_bias, hy_w_proj, w_out, b_out):
    bsz, n_lat, _ = x.shape
    ctx_len = ctx.shape[1]
    s_lat = jax.nn.silu(c)
    s_ctx = jax.nn.silu(c_ctx)
    xc = ctx
    for l in range(DEPTH):
        last = l == DEPTH - 1
        lw = {
            'conf_dw_w': conf_dw_w[l], 'conf_dw_b': conf_dw_b[l], 'conf_ln_g': conf_ln_g[l],
            'conf_ln_b': conf_ln_b[l], 'conf_w_proj': conf_w_proj[l], 'na_w_proj': na_w_proj[l],
            'sc_conv_w': sc_conv_w[l], 'sc_w_proj': sc_w_proj[l], 'hy_sconv_w': hy_sconv_w[l],
            'hy_sconv_b': hy_sconv_b[l], 'hy_bias': hy_bias[l], 'hy_w_proj': hy_w_proj[l],
            'w_out': w_out[l], 'b_out': b_out[l],
        }
        mod_all = (s_lat @ w_mod[l] + b_mod[l]).reshape(bsz, N_MOD, 1, D_MODEL)
        mod = [mod_all[:, i] for i in range(N_MOD)]
        n_cm = 5 if last else N_MOD
        mod_c = (s_ctx @ w_mod[l][:, :n_cm * D_MODEL] + b_mod[l][:n_cm * D_MODEL]).reshape(n_cm, D_MODEL)

        x = post_norm(x, 0.5 * mod[2] * swiglu(modulate(x, mod[0], mod[1]), ffn_w_in[l, 0], ffn_w_out[l, 0]),
                      post_ln_g[l, 0], post_ln_b[l, 0])
        xc = post_norm(xc, 0.5 * mod_c[2] * swiglu(modulate(xc, mod_c[0], mod_c[1]), ffn_w_in[l, 0], ffn_w_out[l, 0]),
                       post_ln_g[l, 0], post_ln_b[l, 0])

        p = modulate(x, mod[3], mod[4]) @ w_in[l] + b_in[l]
        hc = modulate(xc, mod_c[3], mod_c[4])
        if last:
            kvc = hc @ w_in[l][:, OFF_K:OFF_SB] + b_in[l][OFF_K:OFF_SB]
        else:
            pc = hc @ w_in[l] + b_in[l]
            kvc = pc[..., OFF_K:OFF_SB]
        kc = heads(kvc[..., :WB])
        vc = heads(kvc[..., WB:])
        attn = neighbourhood_attention(heads(p[..., OFF_Q:OFF_K]), heads(p[..., OFF_K:OFF_V]),
                                       heads(p[..., OFF_V:OFF_SB]), kc, vc, na_rpb[l])
        filt = hyena_filters(n_lat, hy_w1[l], hy_b1[l], hy_w2[l], hy_b2[l], hy_freq[l], hy_w3[l])
        x = post_norm(x, mod[5] * token_mixer(p, attn, filt, lw), post_ln_g[l, 1], post_ln_b[l, 1])
        if not last:
            attn_c = context_attention(heads(pc[..., OFF_Q:OFF_K]), kc, vc)
            filt_c = hyena_filters(ctx_len, hy_w1[l], hy_b1[l], hy_w2[l], hy_b2[l], hy_freq[l], hy_w3[l])
            xc = post_norm(xc, mod_c[5] * token_mixer(pc, attn_c, filt_c, lw), post_ln_g[l, 1], post_ln_b[l, 1])

        x = post_norm(x, 0.5 * mod[8] * swiglu(modulate(x, mod[6], mod[7]), ffn_w_in[l, 1], ffn_w_out[l, 1]),
                      post_ln_g[l, 2], post_ln_b[l, 2])
        if not last:
            xc = post_norm(xc, 0.5 * mod_c[8] * swiglu(modulate(xc, mod_c[6], mod_c[7]), ffn_w_in[l, 1], ffn_w_out[l, 1]),
                           post_ln_g[l, 2], post_ln_b[l, 2])
    return x
```

```cpp
#include <hip/hip_runtime.h>
#include <cstdio>
#include <cstdint>

#ifndef PHMASK
#define PHMASK 0xFFFFu
#endif
#ifndef DUPMASK
#define DUPMASK 0u
#endif
#ifndef FFTPROBE
#define FFTPROBE 0
#endif
#ifndef EPIDUP
#define EPIDUP 0
#endif
#ifndef MIXDUP
#define MIXDUP 0
#endif
#define LAS __attribute__((address_space(3)))
typedef unsigned short bf16;
typedef short bf16x8 __attribute__((ext_vector_type(8)));
typedef float f32x4 __attribute__((ext_vector_type(4)));
typedef float f32x2 __attribute__((ext_vector_type(2)));
typedef unsigned u32x4 __attribute__((ext_vector_type(4)));
typedef unsigned u32x2 __attribute__((ext_vector_type(2)));

constexpr int D = 1024, SEQ = 16384, TL = 32768, CTXL = 256, TC = 512, MT = TL + TC;
constexpr int DFF = 2816, NFF = 2 * DFF, PIN = 6912, NINP = 2816, NMOD = 9;
constexpr int WA = 256;
constexpr float LN_EPS = 1e-5f, ALPHA = 1.41421356237f, ATT_SCALE = 0.125f;
constexpr int NWAVES = 8, NTHR = 512;

constexpr size_t MiB = 1u << 20;
constexpr size_t WS_CTL = 0, CTL_BYTES = 1 * MiB;
constexpr size_t WS_MOD = 1 * MiB;
constexpr size_t WS_BIN = WS_MOD + 256 * 1024;
constexpr size_t WS_W3T = WS_BIN + 64 * 1024;
constexpr size_t WS_XC = 2 * MiB;
constexpr size_t WS_W1T = 4 * MiB;
constexpr size_t WS_W2T = WS_W1T + (size_t)4 * NFF * D * 2;
constexpr size_t WS_WIT = WS_W2T + (size_t)4 * D * DFF * 2;
constexpr size_t WS_WPT = WS_WIT + (size_t)2 * PIN * D * 2;
constexpr size_t WS_WOT = WS_WPT + (size_t)8 * D * 256 * 2;
constexpr size_t WS_H = WS_WOT + (size_t)2 * D * D * 2;
constexpr size_t WS_BRV = WS_H + (size_t)MT * D * 2;
constexpr size_t WS_FILT = WS_BRV + (size_t)MT * D * 2;
constexpr size_t WS_FILTC = WS_FILT + (size_t)4 * 256 * SEQ * 4;
constexpr size_t WS_H8L = WS_FILT + 32 * MiB;
constexpr size_t WS_LNS = WS_CTL + 64 * 1024;
constexpr size_t WS_H8C = WS_CTL + 512 * 1024;
constexpr size_t WS_U = WS_FILTC + (size_t)4 * 256 * 256 * 4;
constexpr size_t SZ256 = (size_t)MT * 256 * 2;
constexpr size_t WS_UA = WS_U, WS_Q = WS_U + SZ256, WS_K = WS_U + 2 * SZ256, WS_SB = WS_U + 3 * SZ256, WS_W = WS_U + 4 * SZ256;
constexpr size_t WS_VT = WS_U + 5 * SZ256;
constexpr size_t WS_HT = WS_U + 6 * SZ256;
constexpr size_t WS_KSCR = WS_U + 9 * SZ256;
constexpr size_t WS_MG = WS_U;
constexpr size_t WS_GS = WS_U + 4 * SZ256;
constexpr size_t WS_MI = WS_GS + (size_t)256 * 393216;
constexpr size_t WS_END = WS_U + (size_t)MT * DFF * 2;
static_assert(WS_KSCR + (size_t)256 * 131072 <= WS_END, "kscr");
static_assert(WS_MI + (size_t)4 * TC * D * 2 <= WS_END, "gs/mi");
constexpr size_t WS_ES = WS_END;
constexpr size_t WS_TOTAL = WS_ES + (size_t)256 * 131072;
static_assert(WS_TOTAL <= 512 * MiB, "ws");
static_assert(WS_BIN + 2 * PIN * 4 <= WS_W3T && WS_W3T + 2 * 1024 * 64 * 2 <= WS_XC && WS_MOD + 2 * 3 * 9216 * 4 <= WS_BIN, "small");

constexpr int RING_BYTES = 131072;
constexpr int FFT_BYTES = 133120;
constexpr int TW_OFF = FFT_BYTES;
constexpr int RPB_OFF = TW_OFF + 4096;
constexpr int RED_OFF = RPB_OFF + 7680;
constexpr int MISC_OFF = RED_OFF + 256;
constexpr int LDS_BYTES = 147456;
static_assert(MISC_OFF + 64 <= LDS_BYTES, "lds");

typedef __bf16 bf16x2_t __attribute__((ext_vector_type(2)));
__device__ __forceinline__ unsigned cvt_pk_bf16(float lo, float hi) { const f32x2 v = {lo, hi}; const bf16x2_t b = __builtin_convertvector(v, bf16x2_t); return __builtin_bit_cast(unsigned, b); }
typedef int v8i __attribute__((ext_vector_type(8)));
typedef int i32x4 __attribute__((ext_vector_type(4)));
__device__ __forceinline__ float sat8(float x) { return __builtin_amdgcn_fmed3f(x, -448.0f, 448.0f); }
__device__ __forceinline__ unsigned pk_fp8x4(float a, float b, float c, float d) { int p = 0; p = __builtin_amdgcn_cvt_pk_fp8_f32(sat8(a), sat8(b), p, false); p = __builtin_amdgcn_cvt_pk_fp8_f32(sat8(c), sat8(d), p, true); return (unsigned)p; }
constexpr float W1_SCALE = 32.0f, W2_SCALE = 64.0f;
__device__ __forceinline__ float bf2f(unsigned short b) { return __uint_as_float(((unsigned)b) << 16); }
__device__ __forceinline__ float bflo(unsigned w) { return __uint_as_float(w << 16); }
__device__ __forceinline__ float bfhi(unsigned w) { return __uint_as_float(w & 0xffff0000u); }
__device__ __forceinline__ float sigmoidf_(float x) { return __builtin_amdgcn_rcpf(1.0f + __builtin_amdgcn_exp2f(x * -1.44269504089f)); }
__device__ __forceinline__ float siluf_(float x) { return x * __builtin_amdgcn_rcpf(1.0f + __builtin_amdgcn_exp2f(x * -1.44269504089f)); }
__device__ __forceinline__ int lane_now() { int l_; asm volatile("v_mbcnt_lo_u32_b32 %0, -1, 0\n\tv_mbcnt_hi_u32_b32 %0, -1, %0" : "=v"(l_)); return l_; }
__device__ __forceinline__ float xrow_max(float v) {
    const unsigned a = __builtin_bit_cast(unsigned, v); auto r = __builtin_amdgcn_permlane16_swap(a, a, false, false);
    v = fmaxf(__builtin_bit_cast(float, (unsigned)r[0]), __builtin_bit_cast(float, (unsigned)r[1]));
    const unsigned b = __builtin_bit_cast(unsigned, v); auto q = __builtin_amdgcn_permlane32_swap(b, b, false, false);
    return fmaxf(__builtin_bit_cast(float, (unsigned)q[0]), __builtin_bit_cast(float, (unsigned)q[1]));
}
__device__ __forceinline__ float xrow_sum(float v) {
    const unsigned a = __builtin_bit_cast(unsigned, v); auto r = __builtin_amdgcn_permlane16_swap(a, a, false, false);
    v = __builtin_bit_cast(float, (unsigned)r[0]) + __builtin_bit_cast(float, (unsigned)r[1]);
    const unsigned b = __builtin_bit_cast(unsigned, v); auto q = __builtin_amdgcn_permlane32_swap(b, b, false, false);
    return __builtin_bit_cast(float, (unsigned)q[0]) + __builtin_bit_cast(float, (unsigned)q[1]);
}
__device__ __forceinline__ float shx(float v, int o, int lane) { return __builtin_bit_cast(float, __builtin_amdgcn_ds_bpermute((lane ^ o) << 2, __builtin_bit_cast(int, v))); }
#define DPP_F(v_, ctrl_) __builtin_bit_cast(float, __builtin_amdgcn_update_dpp(0, __builtin_bit_cast(int, (v_)), (ctrl_), 0xF, 0xF, true))
__device__ __forceinline__ float wave_sum(float v) {
    v += DPP_F(v, 0xB1);
    v += DPP_F(v, 0x4E);
    v += DPP_F(v, 0x141);
    v += DPP_F(v, 0x140);
    const int iv = __builtin_bit_cast(int, v);
    const float r0 = __builtin_bit_cast(float, __builtin_amdgcn_readlane(iv, 0)), r1 = __builtin_bit_cast(float, __builtin_amdgcn_readlane(iv, 16)),
                r2 = __builtin_bit_cast(float, __builtin_amdgcn_readlane(iv, 32)), r3 = __builtin_bit_cast(float, __builtin_amdgcn_readlane(iv, 48));
    return (r0 + r1) + (r2 + r3);
}
#define LDS_WAIT() asm volatile("s_waitcnt lgkmcnt(0)" ::: "memory")

#define XB_TMO      128
#define XB_XCNT(j)  (256  + 64 * (j))
#define XB_XSUB(j)  (1280 + 64 * (j))
#define XB_XGEN(j)  (2304 + 64 * (j))
#define XB_TOP      3328
#define XB_TOPGEN   3392
#define XCD_BAR_WORDS 3456
#define XB_SPIN_CAP (1u << 20)
__device__ __forceinline__ unsigned xb_ld(unsigned* p)              { return __hip_atomic_load(p, __ATOMIC_RELAXED, __HIP_MEMORY_SCOPE_AGENT); }
__device__ __forceinline__ unsigned xb_add(unsigned* p, unsigned v) { return __hip_atomic_fetch_add(p, v, __ATOMIC_RELAXED, __HIP_MEMORY_SCOPE_AGENT); }
__device__ __forceinline__ unsigned xb_xcc_id() { return (unsigned)__builtin_amdgcn_s_getreg((3 << 11) | 20) & 0xFu; }
#define XB_SPIN(cond, bar) do { unsigned _sp = 0; while (cond) { __builtin_amdgcn_s_sleep(1); \
    if ((++_sp & 255u) == 0u) { if (xb_ld(&(bar)[XB_TMO])) break; if (_sp > XB_SPIN_CAP) { atomicAdd(&(bar)[XB_TMO], 1u); break; } } } } while (0)
struct XcdBarrier { unsigned* bar; unsigned x; volatile LAS unsigned* st; };
__device__ __forceinline__ XcdBarrier xcd_barrier_post(unsigned* bar, volatile LAS unsigned* st) {
    XcdBarrier b; b.bar = bar; b.x = xb_xcc_id(); b.st = st;
    if (threadIdx.x == 0) (void)xb_add(&bar[XB_XCNT(b.x)], 1u);
    return b;
}
__device__ __forceinline__ void xcd_barrier_complete(unsigned* bar, unsigned x, unsigned& nloc, unsigned& nx) {
    const unsigned G = gridDim.x * gridDim.y * gridDim.z;
    unsigned sum, cnt, mine, sp = 0u;
    for (;;) {
        sum = 0u; cnt = 0u; mine = 0u;
#pragma unroll
        for (unsigned j = 0; j < 16; ++j) { const unsigned c = xb_ld(&bar[XB_XCNT(j)]); sum += c; cnt += (c > 0u) ? 1u : 0u; mine = (j == x) ? c : mine; }
        if (sum == G) break;
        __builtin_amdgcn_s_sleep(1);
        if ((++sp & 255u) == 0u) { if (xb_ld(&bar[XB_TMO])) break; if (sp > XB_SPIN_CAP) { atomicAdd(&bar[XB_TMO], 1u); break; } }
    }
    nloc = mine > 0u ? mine : 1u; nx = cnt > 0u ? cnt : 1u;
}
__device__ __forceinline__ void xcd_barrier(const XcdBarrier& b, int tid) {
    asm volatile("s_waitcnt vmcnt(0)" ::: "memory");
    __syncthreads();
    if (tid == 0) {
        unsigned* bar = b.bar;
        __builtin_amdgcn_s_waitcnt(0);
        unsigned nloc = b.st[0], nx = b.st[1];
        if (nloc == 0u) { xcd_barrier_complete(bar, b.x, nloc, nx); b.st[0] = nloc; b.st[1] = nx; }
        const unsigned old = xb_add(&bar[XB_XSUB(b.x)], 1u);
        const unsigned gen = old / nloc;
        if (old + 1u == (gen + 1u) * nloc) {
            __builtin_amdgcn_fence(__ATOMIC_RELEASE, "agent");
            asm volatile("s_waitcnt vmcnt(0)" ::: "memory");
            const unsigned og = xb_add(&bar[XB_TOP], 1u);
            const unsigned tg = og / nx;
            if (og + 1u == (tg + 1u) * nx) xb_add(&bar[XB_TOPGEN], 1u);
            else XB_SPIN(xb_ld(&bar[XB_TOPGEN]) == tg, bar);
            xb_add(&bar[XB_XGEN(b.x)], 1u);
            __builtin_amdgcn_fence(__ATOMIC_ACQUIRE, "agent");
            asm volatile("s_waitcnt vmcnt(0)" ::: "memory");
        } else {
            XB_SPIN(xb_ld(&bar[XB_XGEN(b.x)]) == gen, bar);
            __builtin_amdgcn_fence(__ATOMIC_ACQUIRE, "agent");
            asm volatile("s_waitcnt vmcnt(0)" ::: "memory");
        }
    }
    __syncthreads();
}

namespace pg8 {
constexpr int BM = 256, BK = 64, HALF = 128, HTB = HALF * BK * 2, NXCD = 8, WGM = 8;
__host__ __device__ __forceinline__ int lds_byte(int r, int c) { const int st = (r >> 4) * 2 + (c >> 5), rr = r & 15, cc = c & 31, ob = rr * 64 + cc * 2; return st * 1024 + (ob ^ (((ob >> 9) & 1) << 5)); }
__host__ __device__ __forceinline__ void stage_rc(int b, int& R, int& C) { const int st = b / 1024, sb = b % 1024, swz = sb ^ (((sb >> 9) & 1) << 5); R = (st >> 1) * 16 + swz / 64; C = (st & 1) * 32 + (swz % 64) / 2; }
__host__ __device__ __forceinline__ int perm32(int rho) { const int n = rho >> 4, i = rho & 15; return 8 * (i >> 2) + 4 * n + (i & 3); }

struct GUnit { const char* A; const char* B; unsigned lda, ldb; int nt; int pm, pn, kind; bool f8; };

__device__ __forceinline__ bool static_tile(int i, int G, int c, int nM, int nN, int& pm, int& pn) {
    const int nwg = nM * nN; const long L = (long)i * G + c; if (L >= nwg) return false;
    int wgid = (int)L; { const int q = nwg / NXCD, r = nwg % NXCD, xcd = wgid % NXCD, off = wgid / NXCD; wgid = (xcd < r ? xcd * (q + 1) : r * (q + 1) + (xcd - r) * q) + off; }
    const int nig = WGM * nN, gid = wgid / nig, fm = gid * WGM, gsz = (nM - fm) < WGM ? (nM - fm) : WGM;
    pm = fm + ((wgid % nig) % gsz); pn = (wgid % nig) / gsz; return true;
}

template <class Epi, class Sched, int F8M = 0  >
__device__ __forceinline__ void gemm_phase(LAS unsigned char* lds, const Sched& S, const Epi& E, int tid_in) {
    int tid_ = tid_in; asm volatile("" : "+v"(tid_));
    const int tid = tid_, wid = __builtin_amdgcn_readfirstlane(tid >> 6), lane = tid & 63, wr = wid >> 2, wc = wid & 3, fr = lane & 15, fq = lane >> 4;
    unsigned RA[2], RB[2], CC[2];
#pragma unroll
    for (int i = 0; i < 2; ++i) { int R, C; stage_rc(tid * 16 + i * 8192, R, C); RA[i] = (unsigned)R; RB[i] = (unsigned)((R & ~31) + perm32(R & 31)); CC[i] = (unsigned)C * 2u; }
    const size_t kstep = (size_t)(BK * 2);
    const unsigned ldsw = (unsigned)wid * 1024u;
#define PG8_SA(b, h) (((b) * 2 + (h)) * HTB)
#define PG8_SB(b, h) ((4 + (b) * 2 + (h)) * HTB)
#define PG8_STAGE(bufoff, gbase, RR, ld) do { _Pragma("unroll") for (int _i = 0; _i < 2; ++_i) \
        __builtin_amdgcn_global_load_lds((const unsigned*)((const char*)(gbase) + ((RR)[_i] * (ld) + CC[_i])), (LAS unsigned*)(lds + (bufoff) + ldsw + _i * 8192), 16, 0, 0); } while (0)
#define PG8_LDA(F8C, dst, b, h) do { _Pragma("unroll") for (int m = 0; m < 4; ++m) { dst[m][0] = *(const LAS i32x4*)(lds + PG8_SA(b, h) + ao0 + m * 2048); dst[m][1] = *(const LAS i32x4*)(lds + PG8_SA(b, h) + ao1 + m * 2048); } } while (0)
#define PG8_LDB(F8C, dst, b, h) do { _Pragma("unroll") for (int n = 0; n < 2; ++n) { dst[n][0] = *(const LAS i32x4*)(lds + PG8_SB(b, h) + bo0 + n * 2048); dst[n][1] = *(const LAS i32x4*)(lds + PG8_SB(b, h) + bo1 + n * 2048); } } while (0)
#define PG8_V8(x) __builtin_shufflevector((x)[0], (x)[1], 0, 1, 2, 3, 4, 5, 6, 7)
#define PG8_MMA(F8C, ai, bj, At, Bt) do { __builtin_amdgcn_s_setprio(1); if constexpr (F8C) { _Pragma("unroll") for (int m = 0; m < 4; ++m) _Pragma("unroll") for (int n = 0; n < 2; ++n) \
            { const v8i b8_ = PG8_V8(Bt[n]), a8_ = PG8_V8(At[m]); asm volatile("v_mfma_scale_f32_16x16x128_f8f6f4 %0, %1, %2, %0, %3, %3 op_sel_hi:[0,0,0]" : "+v"(acc[ai][bj][m][n]) : "v"(b8_), "v"(a8_), "v"(one_scale)); } } \
        else { _Pragma("unroll") for (int m = 0; m < 4; ++m) _Pragma("unroll") for (int n = 0; n < 2; ++n) _Pragma("unroll") for (int k = 0; k < 2; ++k) \
            acc[ai][bj][m][n] = __builtin_amdgcn_mfma_f32_16x16x32_bf16(__builtin_bit_cast(bf16x8, Bt[n][k]), __builtin_bit_cast(bf16x8, At[m][k]), acc[ai][bj][m][n], 0, 0, 0); } __builtin_amdgcn_s_setprio(0); } while (0)
#define PG8_TRIP(F8C, WN) { \
            const bool last = (t == nt - 2); \
            const char* a1 = cA + (size_t)(t + 1) * kstep; \
            const char* a2 = last ? nA : cA + (size_t)(t + 2) * kstep; const char* b2 = last ? nB : cB + (size_t)(t + 2) * kstep; \
            const char* a3 = a2 + kstep; const char* b3 = b2 + kstep; \
            const unsigned xldA = last ? nldA : ldA, xldB = last ? nldB : ldB; const size_t xhsA = last ? nhsA : hsA, xhsB = last ? nhsB : hsB; \
            PG8_LDB(F8C, B0, 0, 0); PG8_LDB(F8C, B1, 0, 1); PG8_SCHED; PG8_LDA(F8C, At, 0, 0); PG8_STAGE(PG8_SA(1, 1), a1 + hsA, RA, ldA); \
            PG8_WAIT_V(WN); PG8_WAIT_L(0); PG8_BAR; PG8_MMA(F8C, 0, 0, At, B0); PG8_MMA(F8C, 0, 1, At, B1); PG8_BAR; PG8_SCHED; \
            PG8_LDA(F8C, At, 0, 1); PG8_STAGE(PG8_SB(0, 0), b2, RB, xldB); PG8_STAGE(PG8_SB(0, 1), b2 + xhsB, RB, xldB); PG8_STAGE(PG8_SA(0, 0), a2, RA, xldA); \
            PG8_WAIT_V(WN); PG8_WAIT_L(0); PG8_BAR; PG8_MMA(F8C, 1, 0, At, B0); PG8_MMA(F8C, 1, 1, At, B1); PG8_BAR; PG8_SCHED; \
            PG8_LDB(F8C, B0, 1, 0); PG8_LDB(F8C, B1, 1, 1); PG8_SCHED; PG8_LDA(F8C, At, 1, 0); PG8_STAGE(PG8_SA(0, 1), a2 + xhsA, RA, xldA); \
            PG8_WAIT_V(8); PG8_WAIT_L(0); PG8_BAR; PG8_MMA(F8C, 0, 0, At, B0); PG8_MMA(F8C, 0, 1, At, B1); PG8_BAR; PG8_SCHED; \
            PG8_LDA(F8C, At, 1, 1); PG8_STAGE(PG8_SB(1, 0), b3, RB, xldB); PG8_STAGE(PG8_SB(1, 1), b3 + xhsB, RB, xldB); PG8_STAGE(PG8_SA(1, 0), a3, RA, xldA); \
            PG8_WAIT_V(8); PG8_WAIT_L(0); PG8_BAR; PG8_MMA(F8C, 1, 0, At, B0); PG8_MMA(F8C, 1, 1, At, B1); PG8_BAR; PG8_SCHED; \
        }
#define PG8_KLOOP(F8C) const int ln_ = lane_now();   \
        const int fr_ = ln_ & 15, fq_ = ln_ >> 4; \
        const int ao0 = lds_byte(wr * 64 + fr_, (F8C) ? 16 * fq_ : 8 * fq_), ao1 = (F8C) ? lds_byte(wr * 64 + fr_, 16 * fq_ + 8) : ao0 + 1024; \
        const int bo0 = lds_byte(wc * 32 + fr_, (F8C) ? 16 * fq_ : 8 * fq_), bo1 = (F8C) ? lds_byte(wc * 32 + fr_, 16 * fq_ + 8) : bo0 + 1024; \
        int t = 0; \
        if constexpr (Epi::NST == 8) { if (ui > 0) { PG8_TRIP(F8C, 16) t = 2; } } \
        for (; t < nt; t += 2) PG8_TRIP(F8C, 8)
#define PG8_WAIT_V(n) asm volatile("s_waitcnt vmcnt(" #n ")" ::: "memory")
#define PG8_WAIT_L(n) asm volatile("s_waitcnt lgkmcnt(" #n ")" ::: "memory")
#define PG8_BAR __builtin_amdgcn_s_barrier()
#define PG8_SCHED __builtin_amdgcn_sched_barrier(0)
    GUnit cur, nxt; int ui = 0;
    if (!S.next(0, cur)) return;
    f32x4 acc[2][2][4][2];
#pragma unroll
    for (int a = 0; a < 2; ++a)
#pragma unroll
        for (int b = 0; b < 2; ++b)
#pragma unroll
            for (int m = 0; m < 4; ++m)
#pragma unroll
                for (int n = 0; n < 2; ++n) acc[a][b][m][n] = (f32x4){0.f, 0.f, 0.f, 0.f};
    i32x4 At[4][2], B0[2][2], B1[2][2];
    int one_scale = 0x7F7F7F7F; asm volatile("" : "+v"(one_scale));
    const char* cA = cur.A; const char* cB = cur.B;
    unsigned ldA = cur.lda, ldB = cur.ldb; size_t hsA = (size_t)HALF * ldA, hsB = (size_t)HALF * ldB;
    PG8_STAGE(PG8_SB(0, 0), cB, RB, ldB); PG8_STAGE(PG8_SB(0, 1), cB + hsB, RB, ldB); PG8_STAGE(PG8_SA(0, 0), cA, RA, ldA); PG8_STAGE(PG8_SA(0, 1), cA + hsA, RA, ldA);
    if (wr == 1) PG8_BAR;
    PG8_WAIT_V(2); PG8_BAR;
    PG8_STAGE(PG8_SB(1, 0), cB + kstep, RB, ldB); PG8_STAGE(PG8_SA(1, 0), cA + kstep, RA, ldA); PG8_STAGE(PG8_SB(1, 1), cB + hsB + kstep, RB, ldB);
    PG8_WAIT_V(6); PG8_BAR;
    for (;;) {
        const bool has_next = S.next(ui + 1, nxt);
        const char* nA = has_next ? nxt.A : cA; const char* nB = has_next ? nxt.B : cB;
        const unsigned nldA = has_next ? nxt.lda : ldA, nldB = has_next ? nxt.ldb : ldB;
        const size_t nhsA = (size_t)HALF * nldA, nhsB = (size_t)HALF * nldB;
        const int nt = cur.nt;
        if constexpr (F8M == 2) { if (cur.f8) { PG8_KLOOP(true) } else { PG8_KLOOP(false) } }
        else if constexpr (F8M == 1) { PG8_KLOOP(true) }
        else { PG8_KLOOP(false) }
        if (wr == 0) PG8_BAR;
        if constexpr (F8M != 0) asm volatile("s_nop 15\n\ts_nop 15" ::: "memory");
        { const int le_ = lane_now(); E(acc, cur, (wid << 6) | le_, wr, wc, le_ & 15, le_ >> 4); }
        if (!has_next) break;
#pragma unroll
        for (int a = 0; a < 2; ++a)
#pragma unroll
            for (int b = 0; b < 2; ++b)
#pragma unroll
                for (int m = 0; m < 4; ++m)
#pragma unroll
                    for (int n = 0; n < 2; ++n) acc[a][b][m][n] = (f32x4){0.f, 0.f, 0.f, 0.f};
        cur = nxt; cA = nA; cB = nB; hsA = nhsA; hsB = nhsB; ldA = nldA; ldB = nldB; ++ui;
        if (wr == 1) PG8_BAR;
    }
    PG8_WAIT_V(0);
    PG8_BAR;
#undef PG8_SA
#undef PG8_SB
#undef PG8_STAGE
#undef PG8_LDA
#undef PG8_KLOOP
#undef PG8_TRIP
#undef PG8_V8
#undef PG8_LDB
#undef PG8_MMA
#undef PG8_WAIT_V
#undef PG8_WAIT_L
#undef PG8_BAR
#undef PG8_SCHED
}
}
using pg8::GUnit;
typedef f32x4 Acc[2][2][4][2];

struct Params {
    const float* in[33];
    float* out;
    unsigned char* ws;
    int ph_lo, ph_hi;
};
enum { I_X = 0, I_C, I_CTX, I_CCTX, I_WMOD, I_BMOD, I_PLG, I_PLB, I_FWI, I_FWO, I_WIN, I_BIN, I_CDW, I_CDB, I_CLG, I_CLB, I_CWP, I_RPB, I_NWP, I_SCW, I_SWP,
       I_HSW, I_HSB, I_HW1, I_HB1, I_HW2, I_HB2, I_HFQ, I_HW3, I_HBI, I_HWP, I_WOUT, I_BOUT };

__device__ __forceinline__ int row_grp(int pm) { return pm < 64 ? 0 : (pm < 128 ? 1 : 2); }

struct SchedPlain {
    const char* A; const char* B; unsigned lda, ldb; int nt, nM, nN, G, c;
    __device__ __forceinline__ bool next(int i, GUnit& u) const {
        int pm, pn; if (!pg8::static_tile(i, G, c, nM, nN, pm, pn)) return false;
        u.A = A + (size_t)pm * 256 * lda; u.B = B + (size_t)pn * 256 * ldb; u.lda = lda; u.ldb = ldb; u.nt = nt; u.pm = pm; u.pn = pn; u.kind = 0; u.f8 = true; return true;
    }
};
template <int NKS, int NSRC, int NTLAST = 4> struct SchedResid {
    const char* A; const char* B; unsigned ld; int nt, G, c; bool ctx; const char* Ac;
    __device__ __forceinline__ bool next(int i, GUnit& u) const {
        int pm, pn; u.lda = ld; u.ldb = ld; u.f8 = true;
        if (pg8::static_tile(i, G, c, TL / 256, 4, pm, pn)) { u.A = A + (size_t)pm * 256 * ld; u.B = B + (size_t)pn * 256 * ld; u.nt = nt; u.pm = pm; u.pn = pn; u.kind = 0; return true; }
        constexpr int NK = NKS * NSRC;
        const int j = i * G + c - (TL / 256) * 4; if (!ctx || j < 0 || j >= 8 * NK) return false;
        const int panel = j / (4 * NK), rem = j % (4 * NK), kk = rem % NK, src = kk / NKS, ks = kk % NKS; pn = rem / NK;
        u.A = Ac + ((size_t)src * TC + panel * 256) * ld + ks * 512; u.B = B + (size_t)pn * 256 * ld + ks * 512; u.nt = (ks == NKS - 1) ? NTLAST : 4; u.pm = TL / 256 + panel; u.pn = pn; u.kind = 1 + kk; return true;
    }
};
enum { KI_GLU = 0, KI_PLAIN = 1, KI_PAIR = 2, KI_TRANS = 3 };
struct SchedInproj {
    const char* H; const char* W; int nM, G, c;
    __device__ __forceinline__ bool next(int i, GUnit& u) const {
        int pm, pn; if (!pg8::static_tile(i, G, c, nM, 11, pm, pn)) return false;
        const char* a = H + (size_t)pm * 256 * 2048; const char* b = W + (size_t)pn * 256 * 2048;
        const bool tr = (pn == 4) || (pn >= 8);
        u.A = tr ? b : a; u.B = tr ? a : b; u.lda = 2048; u.ldb = 2048; u.nt = 16; u.pm = pm; u.pn = pn;
        u.f8 = false; u.kind = tr ? KI_TRANS : (pn < 2 ? KI_GLU : (pn == 6 || pn == 7 ? KI_PAIR : KI_PLAIN)); return true;
    }
};
struct SchedGateBr {
    const char* HB  ; const char* H; const char* HC  ; const char* WG  ; const char* BR; const char* WP; int G, c; bool ctx;
    __device__ __forceinline__ bool next(int i, GUnit& u) const {
        int pm, pn, j, br;
        if (pg8::static_tile(i >> 3, G, c, TL / 256, 4, pm, pn)) { j = i & 7; br = j >> 1; }
        else {
            const int ntl = ((TL / 256) * 4 - c + G - 1) / G, e = i - 8 * ntl;
            if (!ctx || c >= 32 || e < 0 || e > 1) return false;
            pm = TL / 256 + (c >> 4); pn = (c >> 2) & 3; br = c & 3; j = 8 + 2 * br + e;
        }
        if ((j & 1) == 0 && br == 3) { u.A = HB + (size_t)pm * 256 * 2048; u.B = WG + 4 * MiB + (size_t)(pn * 256) * 2048; u.lda = 2048; u.ldb = 2048; u.nt = 16; u.f8 = false; }
        else if ((j & 1) == 0) { u.A = (pm < TL / 256) ? H + (size_t)pm * 256 * 1024 : HC + (size_t)(pm - TL / 256) * 256 * 1024; u.B = WG + (size_t)(br * 1024 + pn * 256) * 1024; u.lda = 1024; u.ldb = 1024; u.nt = 8; u.f8 = true; }
        else { u.A = BR + (size_t)br * SZ256 + (size_t)pm * 256 * 512; u.B = WP + (size_t)(br * 1024 + pn * 256) * 512; u.lda = 512; u.ldb = 512; u.nt = 4; u.f8 = false; }
        u.pm = pm; u.pn = pn; u.kind = j; return true;
    }
};

struct EpiFfnUp {
    static constexpr bool DUP_OK = true; static constexpr int NST = 8;
    unsigned char* U;
    __device__ __forceinline__ void operator()(const Acc& acc, const GUnit& u, int tid, int wr, int wc, int fr, int fq) const {
        const int row0 = u.pm * 256 + wr * 64 + fr, col0 = u.pn * 128 + wc * 32 + 8 * fq;
        constexpr float IS = 1.0f / W1_SCALE;
#pragma unroll
        for (int ai = 0; ai < 2; ++ai)
#pragma unroll
            for (int m = 0; m < 4; ++m) {
                const f32x4 a0 = acc[ai][0][m][0] * IS, a1 = acc[ai][0][m][1] * IS, g0 = acc[ai][1][m][0] * IS, g1 = acc[ai][1][m][1] * IS;
                u32x2 w; w.x = pk_fp8x4(siluf_(g0[0]) * a0[0], siluf_(g0[1]) * a0[1], siluf_(g0[2]) * a0[2], siluf_(g0[3]) * a0[3]);
                w.y = pk_fp8x4(siluf_(g1[0]) * a1[0], siluf_(g1[1]) * a1[1], siluf_(g1[2]) * a1[2], siluf_(g1[3]) * a1[3]);
                *(u32x2*)(U + (size_t)(row0 + ai * 128 + m * 16) * DFF + col0) = w;
            }
    }
};
struct EpiRes {
    static constexpr bool DUP_OK = false; static constexpr int NST = 0;
    bf16* V; const void* xl; bool xbf  ; const float* modl  ; const float* bias; float coef; float* part;
    const float* xstat; const float* xg; const float* xbt;
    __device__ __forceinline__ void operator()(const Acc& acc, const GUnit& u, int tid, int wr, int wc, int fr, int fq) const {
        int row0 = u.pm * 256 + wr * 64 + fr, colt = u.pn * 256 + wc * 32 + 8 * fq; asm volatile("" : "+v"(row0), "+v"(colt));
        if (u.kind != 0) {
            float* pp = part + ((size_t)(u.kind - 1) * TC + (row0 - TL)) * D + colt;
#pragma unroll
            for (int ai = 0; ai < 2; ++ai)
#pragma unroll
                for (int m = 0; m < 4; ++m)
#pragma unroll
                    for (int bj = 0; bj < 2; ++bj) { float* q = pp + (size_t)(ai * 128 + m * 16) * D + bj * 128; *(f32x4*)q = acc[ai][bj][m][0]; *(f32x4*)(q + 4) = acc[ai][bj][m][1]; }
            return;
        }
        if (xstat) body_ln(acc, u, row0, colt); else if (xbf) body<true>(acc, u, row0, colt); else body<false>(acc, u, row0, colt);
    }
    template <bool XB> __device__ __forceinline__ void body(const Acc& acc, const GUnit& u, int row0, int colt) const {
        const float* mv = modl + (size_t)row_grp(u.pm) * 9216;
        f32x4 sc[2][2], bv[2][2];
#pragma unroll
        for (int bj = 0; bj < 2; ++bj)
#pragma unroll
            for (int n = 0; n < 2; ++n) { sc[bj][n] = *(const f32x4*)(mv + colt + bj * 128 + 4 * n) * coef;
                bv[bj][n] = bias ? *(const f32x4*)(bias + colt + bj * 128 + 4 * n) : (f32x4){0.f, 0.f, 0.f, 0.f}; }
#pragma unroll
        for (int ai = 0; ai < 2; ++ai) {
            bf16* vp = V + (size_t)(row0 + ai * 128) * D + colt;
            if constexpr (XB) {
                const bf16* xh = (const bf16*)xl + (size_t)(row0 + ai * 128) * D + colt;
                u32x4 xw[4][2];
#pragma unroll
                for (int m = 0; m < 4; ++m)
#pragma unroll
                    for (int bj = 0; bj < 2; ++bj) xw[m][bj] = *(const u32x4*)(xh + (size_t)(m * 16) * D + bj * 128);
#pragma unroll
                for (int m = 0; m < 4; ++m)
#pragma unroll
                    for (int bj = 0; bj < 2; ++bj) { const u32x4 w_ = xw[m][bj];
                        const f32x4 x0 = (f32x4){bflo(w_.x), bfhi(w_.x), bflo(w_.y), bfhi(w_.y)}, x1 = (f32x4){bflo(w_.z), bfhi(w_.z), bflo(w_.w), bfhi(w_.w)};
                        const f32x4 v0 = x0 * ALPHA + sc[bj][0] * (acc[ai][bj][m][0] + bv[bj][0]), v1 = x1 * ALPHA + sc[bj][1] * (acc[ai][bj][m][1] + bv[bj][1]);
                        u32x4 w; w.x = cvt_pk_bf16(v0[0], v0[1]); w.y = cvt_pk_bf16(v0[2], v0[3]); w.z = cvt_pk_bf16(v1[0], v1[1]); w.w = cvt_pk_bf16(v1[2], v1[3]);
                        *(u32x4*)(vp + (size_t)(m * 16) * D + bj * 128) = w; }
            } else {
                const float* xb = (const float*)xl + (size_t)(row0 + ai * 128) * D + colt;
#pragma unroll
                for (int mh = 0; mh < 2; ++mh) {
                    f32x4 xf[2][2][2];
#pragma unroll
                    for (int mm = 0; mm < 2; ++mm)
#pragma unroll
                        for (int bj = 0; bj < 2; ++bj) { const float* q = xb + (size_t)((mh * 2 + mm) * 16) * D + bj * 128; xf[mm][bj][0] = *(const f32x4*)q; xf[mm][bj][1] = *(const f32x4*)(q + 4); }
#pragma unroll
                    for (int mm = 0; mm < 2; ++mm)
#pragma unroll
                        for (int bj = 0; bj < 2; ++bj) { const int m = mh * 2 + mm;
                            const f32x4 v0 = xf[mm][bj][0] * ALPHA + sc[bj][0] * (acc[ai][bj][m][0] + bv[bj][0]), v1 = xf[mm][bj][1] * ALPHA + sc[bj][1] * (acc[ai][bj][m][1] + bv[bj][1]);
                            u32x4 w; w.x = cvt_pk_bf16(v0[0], v0[1]); w.y = cvt_pk_bf16(v0[2], v0[3]); w.z = cvt_pk_bf16(v1[0], v1[1]); w.w = cvt_pk_bf16(v1[2], v1[3]);
                            *(u32x4*)(vp + (size_t)(m * 16) * D + bj * 128) = w; }
                    asm volatile("" ::: "memory");
                }
            }
            asm volatile("" ::: "memory");
        }
    }
    __device__ __forceinline__ void body_ln(const Acc& acc, const GUnit& u, int row0, int colt) const {
        const float* mv = modl + (size_t)row_grp(u.pm) * 9216;
#pragma unroll
        for (int bj = 0; bj < 2; ++bj) {
            f32x4 sc[2], gg[2], bb[2], bv[2];
#pragma unroll
            for (int n = 0; n < 2; ++n) { sc[n] = *(const f32x4*)(mv + colt + bj * 128 + 4 * n) * coef; gg[n] = *(const f32x4*)(xg + colt + bj * 128 + 4 * n); bb[n] = *(const f32x4*)(xbt + colt + bj * 128 + 4 * n);
                bv[n] = bias ? *(const f32x4*)(bias + colt + bj * 128 + 4 * n) : (f32x4){0.f, 0.f, 0.f, 0.f}; }
#pragma unroll
            for (int ai = 0; ai < 2; ++ai) {
                bf16* vp = V + (size_t)(row0 + ai * 128) * D + colt + bj * 128; const bf16* xp = (const bf16*)xl + (size_t)(row0 + ai * 128) * D + colt + bj * 128;
                u32x4 xw[4]; f32x2 st[4];
#pragma unroll
                for (int m = 0; m < 4; ++m) { st[m] = *(const f32x2*)(xstat + (size_t)(row0 + ai * 128 + m * 16) * 2); xw[m] = *(const u32x4*)(xp + (size_t)(m * 16) * D); }
#pragma unroll
                for (int m = 0; m < 4; ++m) { const u32x4 w_ = xw[m]; const float mu = st[m].x, rs = st[m].y;
                    const f32x4 x0 = ((f32x4){bflo(w_.x), bfhi(w_.x), bflo(w_.y), bfhi(w_.y)} - mu) * (gg[0] * rs) + bb[0], x1 = ((f32x4){bflo(w_.z), bfhi(w_.z), bflo(w_.w), bfhi(w_.w)} - mu) * (gg[1] * rs) + bb[1];
                    const f32x4 v0 = x0 * ALPHA + sc[0] * (acc[ai][bj][m][0] + bv[0]), v1 = x1 * ALPHA + sc[1] * (acc[ai][bj][m][1] + bv[1]);
                    u32x4 w; w.x = cvt_pk_bf16(v0[0], v0[1]); w.y = cvt_pk_bf16(v0[2], v0[3]); w.z = cvt_pk_bf16(v1[0], v1[1]); w.w = cvt_pk_bf16(v1[2], v1[3]);
                    *(u32x4*)(vp + (size_t)(m * 16) * D) = w; }
                asm volatile("" ::: "memory");
            }
        }
    }
};
struct EpiInproj {
    static constexpr bool DUP_OK = false; static constexpr int NST = 0;
    const float* bin;
    unsigned char* ws;
    __device__ __forceinline__ void operator()(const Acc& acc, const GUnit& u, int tid, int wr, int wc, int fr, int fq) const {
        bf16* const UA = (bf16*)(ws + WS_UA); bf16* const Q = (bf16*)(ws + WS_Q); bf16* const K = (bf16*)(ws + WS_K); bf16* const SB = (bf16*)(ws + WS_SB);
        bf16* const W = (bf16*)(ws + WS_W); bf16* const VT = (bf16*)(ws + WS_VT); bf16* const HT = (bf16*)(ws + WS_HT);
        int c8 = wc * 32 + 8 * fq; asm volatile("" : "+v"(c8));
        if (u.kind == KI_TRANS) {
            bf16* dst = (u.pn == 4) ? VT : HT + (size_t)(u.pn - 8) * 256 * MT;
            const int r0 = wr * 64 + fr;
#pragma unroll
            for (int ai = 0; ai < 2; ++ai)
#pragma unroll
                for (int m = 0; m < 4; ++m) {
                    const int r = r0 + ai * 128 + m * 16; const float b = bin[u.pn * 256 + r];
#pragma unroll
                    for (int bj = 0; bj < 2; ++bj) {
                        const f32x4 v0 = acc[ai][bj][m][0] + b, v1 = acc[ai][bj][m][1] + b;
                        u32x4 w; w.x = cvt_pk_bf16(v0[0], v0[1]); w.y = cvt_pk_bf16(v0[2], v0[3]); w.z = cvt_pk_bf16(v1[0], v1[1]); w.w = cvt_pk_bf16(v1[2], v1[3]);
                        *(u32x4*)(dst + (size_t)r * MT + u.pm * 256 + bj * 128 + c8) = w;
                    }
                }
            return;
        }
        const int row0 = u.pm * 256 + wr * 64 + fr;
        f32x4 bv[2][2];
#pragma unroll
        for (int bj = 0; bj < 2; ++bj)
#pragma unroll
            for (int n = 0; n < 2; ++n) bv[bj][n] = *(const f32x4*)(bin + u.pn * 256 + bj * 128 + c8 + 4 * n);
        if (u.kind == KI_PLAIN) {
            bf16* dst = (u.pn == 2) ? Q : (u.pn == 3 ? K : SB); const float scl = (u.pn == 2) ? ATT_SCALE * 1.44269504089f : 1.0f;
#pragma unroll
            for (int ai = 0; ai < 2; ++ai)
#pragma unroll
                for (int m = 0; m < 4; ++m)
#pragma unroll
                    for (int bj = 0; bj < 2; ++bj) {
                        const f32x4 v0 = (acc[ai][bj][m][0] + bv[bj][0]) * scl, v1 = (acc[ai][bj][m][1] + bv[bj][1]) * scl;
                        u32x4 w; w.x = cvt_pk_bf16(v0[0], v0[1]); w.y = cvt_pk_bf16(v0[2], v0[3]); w.z = cvt_pk_bf16(v1[0], v1[1]); w.w = cvt_pk_bf16(v1[2], v1[3]);
                        *(u32x4*)(dst + (size_t)(row0 + ai * 128 + m * 16) * 256 + bj * 128 + c8) = w;
                    }
            return;
        }
        const bool glu = (u.kind == KI_GLU);
        bf16* dst = glu ? UA + u.pn * 128 : W + (u.pn - 6) * 128;
#pragma unroll
        for (int ai = 0; ai < 2; ++ai)
#pragma unroll
            for (int m = 0; m < 4; ++m) {
                f32x4 a0 = acc[ai][0][m][0] + bv[0][0], a1 = acc[ai][0][m][1] + bv[0][1], g0 = acc[ai][1][m][0] + bv[1][0], g1 = acc[ai][1][m][1] + bv[1][1];
                if (glu) {
#pragma unroll
                    for (int j = 0; j < 4; ++j) { g0[j] = sigmoidf_(g0[j]); g1[j] = sigmoidf_(g1[j]); }
                }
                const f32x4 v0 = a0 * g0, v1 = a1 * g1;
                u32x4 w; w.x = cvt_pk_bf16(v0[0], v0[1]); w.y = cvt_pk_bf16(v0[2], v0[3]); w.z = cvt_pk_bf16(v1[0], v1[1]); w.w = cvt_pk_bf16(v1[2], v1[3]);
                *(u32x4*)(dst + (size_t)(row0 + ai * 128 + m * 16) * 256 + c8) = w;
            }
    }
};
struct EpiGateBr {
    static constexpr bool DUP_OK = false; static constexpr int NST = 0;
    const float* bing;
    unsigned char* gs;
    bf16* MG; bf16* MI;
    __device__ __forceinline__ void operator()(const Acc& acc, const GUnit& u, int tid, int wr, int wc, int fr, int fq) const {
        const int br = (u.kind >> 1) & 3; const bool cjob = (u.kind & 8) != 0;
        unsigned so = (unsigned)tid * 16u; asm volatile("" : "+v"(so));
        const unsigned mo = so * 2u;
        if ((u.kind & 1) == 0) {
            const float* bb = bing + br * 1024 + u.pn * 256 + wc * 32 + 8 * fq;
            f32x4 bv[2][2];
#pragma unroll
            for (int bj = 0; bj < 2; ++bj)
#pragma unroll
                for (int n = 0; n < 2; ++n) bv[bj][n] = *(const f32x4*)(bb + bj * 128 + 4 * n);
            unsigned char* sp = gs;
#pragma unroll
            for (int ai = 0; ai < 2; ++ai)
#pragma unroll
                for (int m = 0; m < 4; ++m)
#pragma unroll
                    for (int bj = 0; bj < 2; ++bj) {
                        const float gs_ = u.f8 ? (1.0f / W1_SCALE) : 1.0f; f32x4 v0 = acc[ai][bj][m][0] * gs_ + bv[bj][0], v1 = acc[ai][bj][m][1] * gs_ + bv[bj][1];
#pragma unroll
                        for (int j = 0; j < 4; ++j) { v0[j] = sigmoidf_(v0[j]); v1[j] = sigmoidf_(v1[j]); }
                        u32x4 w; w.x = cvt_pk_bf16(v0[0], v0[1]); w.y = cvt_pk_bf16(v0[2], v0[3]); w.z = cvt_pk_bf16(v1[0], v1[1]); w.w = cvt_pk_bf16(v1[2], v1[3]);
                        *(u32x4*)(sp + so) = w; sp += 8192;
                    }
        } else {
            unsigned lo = (unsigned)(((wr * 64 + fr) * D + u.pn * 256 + wc * 32 + 8 * fq) * 2); asm volatile("" : "+v"(lo));
            unsigned char* op = cjob ? (unsigned char*)(MI + ((size_t)br * TC + (u.pm - TL / 256) * 256) * D) : (unsigned char*)(MG + (size_t)u.pm * 256 * D);
            const bool ldm = (br > 0 && !cjob), stm = (br < 3 && !cjob);
            if (ldm) { if (stm) branch<true, true>(acc, so, mo, lo, op); else branch<true, false>(acc, so, mo, lo, op); }
            else { if (stm) branch<false, true>(acc, so, mo, lo, op); else branch<false, false>(acc, so, mo, lo, op); }
        }
    }
    template <bool LDM, bool STM> __device__ __forceinline__ void branch(const Acc& acc, unsigned so, unsigned mo, unsigned lo, unsigned char* op) const {
        const unsigned char* sp = gs; unsigned char* mp = gs + 131072;
        u32x4 s[2][2]; f32x4 m0[2][2], m1[2][2];
#define GB_U(ptr_) ({ auto q_ = (ptr_); asm volatile("" : "+s"(q_)); q_; })
#define GB_LOAD(t_) do { _Pragma("unroll") for (int k = 0; k < 2; ++k) { s[(t_) & 1][k] = *(const u32x4*)(GB_U(sp + ((t_) * 2 + k) * 8192) + so); \
            if (LDM) { const unsigned char* mq_ = GB_U(mp + ((t_) * 2 + k) * 16384); m0[(t_) & 1][k] = *(const f32x4*)(mq_ + mo); m1[(t_) & 1][k] = *(const f32x4*)(mq_ + mo + 16); } \
            else { m0[(t_) & 1][k] = (f32x4){0.f, 0.f, 0.f, 0.f}; m1[(t_) & 1][k] = (f32x4){0.f, 0.f, 0.f, 0.f}; } } } while (0)
        GB_LOAD(0);
#pragma unroll
        for (int t = 0; t < 8; ++t) { const int ai = t >> 2, m = t & 3, p = t & 1;
            if (t < 7) GB_LOAD(t + 1);
#pragma unroll
            for (int k = 0; k < 2; ++k) { const int bj = k;
                const f32x4 y0 = acc[ai][bj][m][0], y1 = acc[ai][bj][m][1]; const u32x4 sk = s[p][k]; f32x4 a0 = m0[p][k], a1 = m1[p][k];
                a0[0] += bflo(sk.x) * y0[0]; a0[1] += bfhi(sk.x) * y0[1]; a0[2] += bflo(sk.y) * y0[2]; a0[3] += bfhi(sk.y) * y0[3];
                a1[0] += bflo(sk.z) * y1[0]; a1[1] += bfhi(sk.z) * y1[1]; a1[2] += bflo(sk.w) * y1[2]; a1[3] += bfhi(sk.w) * y1[3];
                if (STM) { unsigned char* mq = GB_U(mp + (t * 2 + k) * 16384); *(f32x4*)(mq + mo) = a0; *(f32x4*)(mq + mo + 16) = a1; }
                else { u32x4 w; w.x = cvt_pk_bf16(a0[0], a0[1]); w.y = cvt_pk_bf16(a0[2], a0[3]); w.z = cvt_pk_bf16(a1[0], a1[1]); w.w = cvt_pk_bf16(a1[2], a1[3]);
                    *(u32x4*)(op + (size_t)(ai * 128 + m * 16) * D * 2 + lo + bj * 256) = w; } }
            asm volatile("" ::: "memory");
        }
#undef GB_LOAD
#undef GB_U
    }
};

struct Frame {
    LAS unsigned char* lds;
    int tid, lane, wave, bid, G;
    unsigned char* ws;
};

__device__ __forceinline__ void transpose_item(const float* W, int K, int N, int src_col0, bf16* WT, int dst_row0, LAS float* scr, int kb, int lane) {
    const int k0 = 64 * kb;
    float tv[32];
#pragma unroll
    for (int i = 0; i < 32; ++i) { const int kk = 2 * i + (lane >> 5); tv[i] = W[(size_t)(k0 + kk) * N + src_col0 + (lane & 31)]; }
#pragma unroll
    for (int i = 0; i < 32; ++i) { const int kk = 2 * i + (lane >> 5); scr[kk * 33 + (lane & 31)] = tv[i]; }
    LDS_WAIT(); asm volatile("" ::: "memory");
    const int c = lane & 7;
#pragma unroll
    for (int j = 0; j < 4; ++j) { const int n = (lane >> 3) + 8 * j; const LAS float* s = scr + (8 * c) * 33 + n;
        u32x4 o; o.x = cvt_pk_bf16(s[0 * 33], s[1 * 33]); o.y = cvt_pk_bf16(s[2 * 33], s[3 * 33]); o.z = cvt_pk_bf16(s[4 * 33], s[5 * 33]); o.w = cvt_pk_bf16(s[6 * 33], s[7 * 33]);
        *(u32x4*)(WT + (size_t)(dst_row0 + n) * K + k0 + 8 * c) = o; }
    LDS_WAIT(); asm volatile("" ::: "memory");
}
__device__ __forceinline__ void transpose_item8(const float* W, int K, int N, int src_col0, unsigned char* WT, int dst_row0, LAS float* scr, int kb, int lane, float wscale) {
    const int k0 = 64 * kb;
    float tv[32];
#pragma unroll
    for (int i = 0; i < 32; ++i) { const int kk = 2 * i + (lane >> 5); tv[i] = W[(size_t)(k0 + kk) * N + src_col0 + (lane & 31)]; }
#pragma unroll
    for (int i = 0; i < 32; ++i) { const int kk = 2 * i + (lane >> 5); scr[kk * 33 + (lane & 31)] = tv[i]; }
    LDS_WAIT(); asm volatile("" ::: "memory");
    const int n = lane >> 1, hf = lane & 1; const LAS float* s = scr + (32 * hf) * 33 + n;
    u32x4 o0, o1;
    o0.x = pk_fp8x4(s[0 * 33] * wscale, s[1 * 33] * wscale, s[2 * 33] * wscale, s[3 * 33] * wscale); o0.y = pk_fp8x4(s[4 * 33] * wscale, s[5 * 33] * wscale, s[6 * 33] * wscale, s[7 * 33] * wscale);
    o0.z = pk_fp8x4(s[8 * 33] * wscale, s[9 * 33] * wscale, s[10 * 33] * wscale, s[11 * 33] * wscale); o0.w = pk_fp8x4(s[12 * 33] * wscale, s[13 * 33] * wscale, s[14 * 33] * wscale, s[15 * 33] * wscale);
    o1.x = pk_fp8x4(s[16 * 33] * wscale, s[17 * 33] * wscale, s[18 * 33] * wscale, s[19 * 33] * wscale); o1.y = pk_fp8x4(s[20 * 33] * wscale, s[21 * 33] * wscale, s[22 * 33] * wscale, s[23 * 33] * wscale);
    o1.z = pk_fp8x4(s[24 * 33] * wscale, s[25 * 33] * wscale, s[26 * 33] * wscale, s[27 * 33] * wscale); o1.w = pk_fp8x4(s[28 * 33] * wscale, s[29 * 33] * wscale, s[30 * 33] * wscale, s[31 * 33] * wscale);
    u32x4* dst = (u32x4*)(WT + (size_t)(dst_row0 + n) * K + k0 + 32 * hf); dst[0] = o0; dst[1] = o1;
    LDS_WAIT(); asm volatile("" ::: "memory");
}
__host__ __device__ __forceinline__ int inmap(int r) {
    if (r >= NINP) return r;
    const int t = r >> 8, cc = r & 255;
    if (t < 2) return cc < 128 ? 128 * t + cc : 256 + 128 * t + cc - 128;
    if (t < 6) return 256 * t + cc;
    if (t < 8) { const int p = t - 6; return cc < 128 ? 1536 + 128 * p + cc : 1792 + 128 * p + cc - 128; }
    return 2048 + 256 * (t - 8) + cc;
}
__device__ __forceinline__ void prologue_a(Frame& F, const Params& P) {
    LAS float* scr = (LAS float*)(F.lds + F.wave * 16384);
    const int gw = F.bid * NWAVES + F.wave, NGW = F.G * NWAVES;
    constexpr int I1 = 16 * 176, I2 = 44 * 32, I3 = 16 * 216, I4 = 4 * 32, I5 = 16 * 32;
    constexpr int I6 = 32;
    constexpr int NIT = 4 * I1 + 4 * I2 + 2 * I3 + 8 * I4 + 2 * I5 + 2 * I6;
    struct TI { const float* W; unsigned char* dst; int N, K, sc, drow, kb; bool f8; float scale; };
    auto decode = [&](int it, TI& t) {
        int r = it;
        if (r < 4 * I1) { const int mi = r / I1; r %= I1; const int kb = r / 176, nb = r % 176, d0 = nb * 32, pn = d0 >> 8, cc = d0 & 255;
            t = TI{P.in[I_FWI] + (size_t)mi * D * NFF, F.ws + WS_W1T + (size_t)mi * NFF * D, NFF, D, cc < 128 ? 128 * pn + cc : DFF + 128 * pn + cc - 128, d0, kb, true, W1_SCALE}; return; }
        r -= 4 * I1;
        if (r < 4 * I2) { const int mi = r / I2; r %= I2; const int kb = r / 32, nb = r % 32;
            t = TI{P.in[I_FWO] + (size_t)mi * DFF * D, F.ws + WS_W2T + (size_t)mi * D * DFF, D, DFF, nb * 32, nb * 32, kb, true, W2_SCALE}; return; }
        r -= 4 * I2;
        if (r < 2 * I3) { const int mi = r / I3; r %= I3; const int kb = r / 216, nb = r % 216; const float* W = P.in[I_WIN] + (size_t)mi * D * PIN;
            if (nb * 32 >= NINP + 3072) t = TI{W, F.ws + WS_WIT + ((size_t)mi * PIN + NINP) * D * 2 + 4 * MiB, PIN, D, inmap(nb * 32), nb * 32 - NINP - 3072, kb, false, 1.f};
            else if (nb * 32 >= NINP) t = TI{W, F.ws + WS_WIT + ((size_t)mi * PIN + NINP) * D * 2, PIN, D, inmap(nb * 32), nb * 32 - NINP, kb, true, W1_SCALE};
            else t = TI{W, F.ws + WS_WIT + (size_t)mi * PIN * D * 2, PIN, D, inmap(nb * 32), nb * 32, kb, false, 1.f};
            return; }
        r -= 2 * I3;
        if (r < 8 * I4) { const int mi = r / I4; r %= I4; const int l = mi >> 2, br = mi & 3, kb = r / 32, nb = r % 32;
            t = TI{P.in[br == 0 ? I_CWP : (br == 1 ? I_NWP : (br == 2 ? I_SWP : I_HWP))] + (size_t)l * 256 * D, F.ws + WS_WPT + (size_t)mi * D * 256 * 2, D, 256, nb * 32, nb * 32, kb, false, 1.f}; return; }
        r -= 8 * I4;
        if (r < 2 * I5) { const int mi = r / I5; r %= I5; const int kb = r / 32, nb = r % 32;
            t = TI{P.in[I_WOUT] + (size_t)mi * D * D, F.ws + WS_WOT + (size_t)mi * D * D * 2, D, D, nb * 32, nb * 32, kb, false, 1.f}; return; }
        r -= 2 * I5;
        { const int mi = r / I6, nb = r % I6; t = TI{P.in[I_HW3] + (size_t)mi * 64 * 1024, F.ws + WS_W3T + (size_t)mi * 1024 * 64 * 2, 1024, 64, nb * 32, nb * 32, 0, false, 1.f}; }
    };
    {
        const int lane = F.lane;
        TI cur; float tv[32];
        int it = gw;
        if (it < NIT) { decode(it, cur);
#pragma unroll
            for (int i = 0; i < 32; ++i) tv[i] = cur.W[(size_t)(64 * cur.kb + 2 * i + (lane >> 5)) * cur.N + cur.sc + (lane & 31)]; }
        for (; it < NIT; it += NGW) {
#pragma unroll
            for (int i = 0; i < 32; ++i) scr[(2 * i + (lane >> 5)) * 33 + (lane & 31)] = tv[i];
            TI nx; const bool more = it + NGW < NIT;
            if (more) { decode(it + NGW, nx);
#pragma unroll
                for (int i = 0; i < 32; ++i) tv[i] = nx.W[(size_t)(64 * nx.kb + 2 * i + (lane >> 5)) * nx.N + nx.sc + (lane & 31)]; }
            LDS_WAIT(); asm volatile("" ::: "memory");
            const int k0 = 64 * cur.kb;
            if (cur.f8) { const int n = lane >> 1, hf = lane & 1; const LAS float* s = scr + (32 * hf) * 33 + n; const float ws_ = cur.scale;
                u32x4 o0, o1;
                o0.x = pk_fp8x4(s[0 * 33] * ws_, s[1 * 33] * ws_, s[2 * 33] * ws_, s[3 * 33] * ws_); o0.y = pk_fp8x4(s[4 * 33] * ws_, s[5 * 33] * ws_, s[6 * 33] * ws_, s[7 * 33] * ws_);
                o0.z = pk_fp8x4(s[8 * 33] * ws_, s[9 * 33] * ws_, s[10 * 33] * ws_, s[11 * 33] * ws_); o0.w = pk_fp8x4(s[12 * 33] * ws_, s[13 * 33] * ws_, s[14 * 33] * ws_, s[15 * 33] * ws_);
                o1.x = pk_fp8x4(s[16 * 33] * ws_, s[17 * 33] * ws_, s[18 * 33] * ws_, s[19 * 33] * ws_); o1.y = pk_fp8x4(s[20 * 33] * ws_, s[21 * 33] * ws_, s[22 * 33] * ws_, s[23 * 33] * ws_);
                o1.z = pk_fp8x4(s[24 * 33] * ws_, s[25 * 33] * ws_, s[26 * 33] * ws_, s[27 * 33] * ws_); o1.w = pk_fp8x4(s[28 * 33] * ws_, s[29 * 33] * ws_, s[30 * 33] * ws_, s[31 * 33] * ws_);
                u32x4* dst = (u32x4*)(cur.dst + (size_t)(cur.drow + n) * cur.K + k0 + 32 * hf); dst[0] = o0; dst[1] = o1; }
            else { const int c = lane & 7;
#pragma unroll
                for (int j = 0; j < 4; ++j) { const int n = (lane >> 3) + 8 * j; const LAS float* s = scr + (8 * c) * 33 + n;
                    u32x4 o; o.x = cvt_pk_bf16(s[0 * 33], s[1 * 33]); o.y = cvt_pk_bf16(s[2 * 33], s[3 * 33]); o.z = cvt_pk_bf16(s[4 * 33], s[5 * 33]); o.w = cvt_pk_bf16(s[6 * 33], s[7 * 33]);
                    *(u32x4*)(cur.dst + ((size_t)(cur.drow + n) * cur.K + k0 + 8 * c) * 2) = o; } }
            LDS_WAIT(); asm volatile("" ::: "memory");
            cur = nx;
        }
    }
    { float* bin = (float*)(F.ws + WS_BIN); for (int i = F.bid * NTHR + F.tid; i < 2 * PIN; i += F.G * NTHR) { const int l = i / PIN, r = i % PIN; bin[i] = P.in[I_BIN][l * PIN + inmap(r)]; } }
    __syncthreads();
    LAS float* sv = (LAS float*)F.lds;
    LAS float* red = (LAS float*)(F.lds + 16384);
    for (int i = F.tid; i < 3 * D; i += NTHR) { const int g = i / D, k = i % D; const float c = g < 2 ? P.in[I_C][g * D + k] : P.in[I_CCTX][k]; sv[i] = siluf_(c); }
    __syncthreads();
    for (int un = F.bid; un < 2 * 144; un += F.G) {
        const int l = un / 144, n0 = (un % 144) * 64;
        const float* wm = P.in[I_WMOD] + (size_t)l * D * 9216 + n0 + F.lane;
        float a0 = 0.f, a1 = 0.f, a2 = 0.f;
#pragma unroll 1
        for (int k0 = 0; k0 < 128; k0 += 32) { float wv[32];
#pragma unroll
            for (int kk = 0; kk < 32; ++kk) wv[kk] = wm[(size_t)(F.wave * 128 + k0 + kk) * 9216];
#pragma unroll
            for (int kk = 0; kk < 32; ++kk) { const int k = F.wave * 128 + k0 + kk; a0 += sv[k] * wv[kk]; a1 += sv[D + k] * wv[kk]; a2 += sv[2 * D + k] * wv[kk]; } }
        red[(F.wave * 3 + 0) * 64 + F.lane] = a0; red[(F.wave * 3 + 1) * 64 + F.lane] = a1; red[(F.wave * 3 + 2) * 64 + F.lane] = a2;
        __syncthreads();
        if (F.tid < 192) { const int g = F.tid >> 6, ln = F.tid & 63; float s = P.in[I_BMOD][l * 9216 + n0 + ln];
#pragma unroll
            for (int w = 0; w < 8; ++w) s += red[(w * 3 + g) * 64 + ln];
            ((float*)(F.ws + WS_MOD))[(size_t)(l * 3 + g) * 9216 + n0 + ln] = s; }
        __syncthreads();
    }
}

__device__ __forceinline__ void ln_stats(const f32x4 (&v)[4], float& mean, float& rstd) {
    float s = 0.f;
#pragma unroll
    for (int j = 0; j < 4; ++j) s += (v[j][0] + v[j][1]) + (v[j][2] + v[j][3]);
    mean = wave_sum(s) * (1.0f / D);
    float q = 0.f;
#pragma unroll
    for (int j = 0; j < 4; ++j) { const f32x4 d = v[j] - mean; q += (d[0] * d[0] + d[1] * d[1]) + (d[2] * d[2] + d[3] * d[3]); }
    rstd = 1.0f / sqrtf(wave_sum(q) * (1.0f / D) + LN_EPS);
}
__device__ __forceinline__ void modulate_store(const f32x4 (&x)[4], const float* shift, const float* scale, bf16* hrow, int lane) {
    float mean, rstd; ln_stats(x, mean, rstd);
#pragma unroll
    for (int j = 0; j < 4; ++j) { const int c = 4 * lane + 256 * j; const f32x4 sc = *(const f32x4*)(scale + c), sh = *(const f32x4*)(shift + c);
        const f32x4 h = (x[j] - mean) * rstd * (sc + 1.0f) + sh;
        u32x2 w; w.x = cvt_pk_bf16(h[0], h[1]); w.y = cvt_pk_bf16(h[2], h[3]); *(u32x2*)(hrow + c) = w; }
}
__device__ __forceinline__ void modulate_store8(const f32x4 (&x)[4], const float* shift, const float* scale, unsigned char* hrow, int lane) {
    float mean, rstd; ln_stats(x, mean, rstd);
#pragma unroll
    for (int j = 0; j < 4; ++j) { const int c = 4 * lane + 256 * j; const f32x4 sc = *(const f32x4*)(scale + c), sh = *(const f32x4*)(shift + c);
        const f32x4 h = (x[j] - mean) * rstd * (sc + 1.0f) + sh;
        *(unsigned*)(hrow + c) = pk_fp8x4(h[0], h[1], h[2], h[3]); }
}
constexpr int LNR = 4;
__device__ __forceinline__ void ln_stats_r(const f32x4 (&v)[LNR][4], float (&mean)[LNR], float (&rstd)[LNR]) {
    float s[LNR];
#pragma unroll
    for (int r = 0; r < LNR; ++r) { s[r] = 0.f;
#pragma unroll
        for (int j = 0; j < 4; ++j) s[r] += (v[r][j][0] + v[r][j][1]) + (v[r][j][2] + v[r][j][3]); }
#pragma unroll
    for (int r = 0; r < LNR; ++r) s[r] = wave_sum(s[r]);
    float q[LNR];
#pragma unroll
    for (int r = 0; r < LNR; ++r) { mean[r] = s[r] * (1.0f / D); q[r] = 0.f;
#pragma unroll
        for (int j = 0; j < 4; ++j) { const f32x4 d = v[r][j] - mean[r]; q[r] += (d[0] * d[0] + d[1] * d[1]) + (d[2] * d[2] + d[3] * d[3]); } }
#pragma unroll
    for (int r = 0; r < LNR; ++r) q[r] = wave_sum(q[r]);
#pragma unroll
    for (int r = 0; r < LNR; ++r) rstd[r] = 1.0f / sqrtf(q[r] * (1.0f / D) + LN_EPS);
}
__device__ __forceinline__ void phase_mod0(Frame& F, const Params& P) {
    const int skip = (F.G > 8) ? 4 : 0;
    if (F.bid < skip) return;
    const int gw = (F.bid - skip) * NWAVES + F.wave, NGW = (F.G - skip) * NWAVES;
    const float* MOD = (const float*)(F.ws + WS_MOD); bf16* H = (bf16*)(F.ws + WS_H);
    for (int row0 = gw; row0 < MT; row0 += LNR * NGW) {
        f32x4 x[LNR][4]; int rows[LNR];
#pragma unroll
        for (int r = 0; r < LNR; ++r) { rows[r] = min(row0 + r * NGW, MT - 1); const int row = rows[r];
            const float* xr = row < TL ? P.in[I_X] + (size_t)row * D : P.in[I_CTX] + (size_t)(row - TL) * D;
#pragma unroll
            for (int j = 0; j < 4; ++j) x[r][j] = *(const f32x4*)(xr + 4 * F.lane + 256 * j); }
        float mean[LNR], rstd[LNR]; ln_stats_r(x, mean, rstd);
#pragma unroll
        for (int r = 0; r < LNR; ++r) if (row0 + r * NGW < MT) { const int row = rows[r], g = row < SEQ ? 0 : (row < TL ? 1 : 2);
            const float* shift = MOD + (size_t)g * 9216, *scale = shift + D;
#pragma unroll
            for (int j = 0; j < 4; ++j) { const int c = 4 * F.lane + 256 * j; const f32x4 sc = *(const f32x4*)(scale + c), sh = *(const f32x4*)(shift + c);
                const f32x4 h = (x[r][j] - mean[r]) * rstd[r] * (sc + 1.0f) + sh;
                *(unsigned*)((unsigned char*)H + (size_t)row * D + c) = pk_fp8x4(h[0], h[1], h[2], h[3]); } }
    }
}
__device__ __forceinline__ void phase_ln(Frame& F, const Params& P, const float* lg, const float* lb, const float* modl  , int ishift, bool hmod, bool h8  , bool dual  , bool final_out, int cx_nks, float cx_coef, const float* cx_modv  , const float* cx_bias, const float* cx_xsrc, bool skipx  , const bf16* vsrc  ) {
    const int gw = F.bid * NWAVES + F.wave, NGW = F.G * NWAVES;
    const bf16* V = vsrc; bf16* H = (bf16*)(F.ws + WS_H);
    f32x4 g4[4], b4[4];
#pragma unroll
    for (int j = 0; j < 4; ++j) { g4[j] = *(const f32x4*)(lg + 4 * F.lane + 256 * j); b4[j] = *(const f32x4*)(lb + 4 * F.lane + 256 * j); }
    if (cx_nks > 0) {
        const float* part = (const float*)(F.ws + WS_ES);
        for (int r = gw; r < TC; r += NGW) {
            f32x4 v[4];
#pragma unroll
            for (int j = 0; j < 4; ++j) { const int c = 4 * F.lane + 256 * j; f32x4 s = cx_bias ? *(const f32x4*)(cx_bias + c) : (f32x4){0.f, 0.f, 0.f, 0.f};
                for (int ks = 0; ks < cx_nks; ++ks) s += *(const f32x4*)(part + ((size_t)ks * TC + r) * D + c);
                v[j] = *(const f32x4*)(cx_xsrc + (size_t)r * D + c) * ALPHA + *(const f32x4*)(cx_modv + c) * cx_coef * s; }
            float mean, rstd; ln_stats(v, mean, rstd);
            float* xr = (float*)(F.ws + WS_XC) + (size_t)r * D;
#pragma unroll
            for (int j = 0; j < 4; ++j) { v[j] = (v[j] - mean) * rstd * g4[j] + b4[j]; *(f32x4*)(xr + 4 * F.lane + 256 * j) = v[j]; }
            if (hmod && dual) modulate_store8(v, modl + (size_t)2 * 9216 + ishift * D, modl + (size_t)2 * 9216 + (ishift + 1) * D, F.ws + WS_H8C + (size_t)r * D, F.lane);
            if (hmod) { if (h8) modulate_store8(v, modl + (size_t)2 * 9216 + ishift * D, modl + (size_t)2 * 9216 + (ishift + 1) * D, (unsigned char*)H + (size_t)(TL + r) * D, F.lane);
                        else modulate_store(v, modl + (size_t)2 * 9216 + ishift * D, modl + (size_t)2 * 9216 + (ishift + 1) * D, H + (size_t)(TL + r) * D, F.lane); }
        }
    }
    const int M = TL;
    u32x2 raw[LNR][4];
#pragma unroll
    for (int r = 0; r < LNR; ++r) { const int rw = min(gw + r * NGW, M - 1);
#pragma unroll
        for (int j = 0; j < 4; ++j) raw[r][j] = *(const u32x2*)(V + (size_t)rw * D + 4 * F.lane + 256 * j); }
    for (int row0 = gw; row0 < M; row0 += LNR * NGW) {
        f32x4 v[LNR][4]; int rows[LNR];
#pragma unroll
        for (int r = 0; r < LNR; ++r) { rows[r] = min(row0 + r * NGW, M - 1);
#pragma unroll
            for (int j = 0; j < 4; ++j) { const u32x2 w = raw[r][j]; v[r][j] = (f32x4){bflo(w.x), bfhi(w.x), bflo(w.y), bfhi(w.y)}; } }
        if (row0 + LNR * NGW < M) {
#pragma unroll
            for (int r = 0; r < LNR; ++r) { const int rw = min(row0 + (LNR + r) * NGW, M - 1);
#pragma unroll
                for (int j = 0; j < 4; ++j) raw[r][j] = *(const u32x2*)(V + (size_t)rw * D + 4 * F.lane + 256 * j); }
        }
        float mean[LNR], rstd[LNR]; ln_stats_r(v, mean, rstd);
#pragma unroll
        for (int r = 0; r < LNR; ++r) { const int row = rows[r]; const bool ok = row0 + r * NGW < M;
            float* xr = P.out + (size_t)row * D; bf16* xh = (bf16*)P.out + (size_t)row * D;
            if (skipx && ok && F.lane == 0) *(f32x2*)((float*)(F.ws + WS_LNS) + (size_t)row * 2) = (f32x2){mean[r], rstd[r]};
#pragma unroll
            for (int j = 0; j < 4; ++j) { v[r][j] = (v[r][j] - mean[r]) * rstd[r] * g4[j] + b4[j];
                if (ok) { if (final_out) __builtin_nontemporal_store(v[r][j], (f32x4*)(xr + 4 * F.lane + 256 * j));
                          else if (!skipx) { u32x2 w; w.x = cvt_pk_bf16(v[r][j][0], v[r][j][1]); w.y = cvt_pk_bf16(v[r][j][2], v[r][j][3]); __builtin_nontemporal_store(w, (u32x2*)(xh + 4 * F.lane + 256 * j)); } } } }
        if (hmod) {
            ln_stats_r(v, mean, rstd);
#pragma unroll
            for (int r = 0; r < LNR; ++r) if (row0 + r * NGW < M) { const int row = rows[r], g = row < SEQ ? 0 : 1;
                const float* shift = modl + (size_t)g * 9216 + ishift * D, *scale = shift + D; bf16* hrow = H + (size_t)row * D;
#pragma unroll
                for (int j = 0; j < 4; ++j) { const int c = 4 * F.lane + 256 * j; const f32x4 sc = *(const f32x4*)(scale + c), sh = *(const f32x4*)(shift + c);
                    const f32x4 h = (v[r][j] - mean[r]) * rstd[r] * (sc + 1.0f) + sh;
                    if (h8) __builtin_nontemporal_store(pk_fp8x4(h[0], h[1], h[2], h[3]), (unsigned*)((unsigned char*)H + (size_t)row * D + c));
                    else { u32x2 w; w.x = cvt_pk_bf16(h[0], h[1]); w.y = cvt_pk_bf16(h[2], h[3]); __builtin_nontemporal_store(w, (u32x2*)(hrow + c)); }
                    if (dual) __builtin_nontemporal_store(pk_fp8x4(h[0], h[1], h[2], h[3]), (unsigned*)(F.ws + WS_H8L + (size_t)row * D + c)); } }
        }
    }
}

__device__ __forceinline__ void filter_unit(Frame& F, const Params& P, int l, int L, int t0, float* filt  , bool bfout) {
    LAS float* h1 = (LAS float*)F.lds;
    LAS bf16* h2b = (LAS bf16*)(F.lds + 32768);
    LAS float* zf = (LAS float*)(F.lds + 65536);
    LAS float* w2s = (LAS float*)(F.lds + 81920);
    LAS float* w1s = (LAS float*)(F.lds + 98304);
    const float* w1 = P.in[I_HW1] + l * 33 * 64; const float* b1 = P.in[I_HB1] + l * 64; const float* w2 = P.in[I_HW2] + l * 64 * 64; const float* b2 = P.in[I_HB2] + l * 64;
    const float* fq = P.in[I_HFQ] + l * 128; const float* w3 = P.in[I_HW3] + (size_t)l * 64 * 1024;
    {
#pragma unroll
        for (int i = 0; i < 8; ++i) w2s[F.tid + 512 * i] = w2[F.tid + 512 * i];
#pragma unroll
        for (int i = 0; i < 5; ++i) if (F.tid + 512 * i < 33 * 64) w1s[F.tid + 512 * i] = w1[F.tid + 512 * i];
        const int tl = F.tid >> 3, jg = F.tid & 7; const float t = (float)(t0 + tl);
        if (jg == 0) zf[tl * 36] = t / (float)(L - 1);
#pragma unroll
        for (int ii = 0; ii < 2; ++ii) { const int i = jg + 8 * ii; const float band = 1e-4f + (float)i * ((15.0f - 1e-4f) / 15.0f); float s, c; sincospif(2.0f * t * band / (float)L, &s, &c); zf[tl * 36 + 1 + i] = c; zf[tl * 36 + 17 + i] = -s; }
        __syncthreads();
        float a[8];
#pragma unroll
        for (int jj = 0; jj < 8; ++jj) a[jj] = b1[jg * 8 + jj];
#pragma unroll 3
        for (int i = 0; i < 33; ++i) { const float zv = zf[tl * 36 + i]; const LAS f32x4* wp = (const LAS f32x4*)(w1s + i * 64 + jg * 8); const f32x4 wa = wp[0], wb = wp[1];
            a[0] += zv * wa[0]; a[1] += zv * wa[1]; a[2] += zv * wa[2]; a[3] += zv * wa[3]; a[4] += zv * wb[0]; a[5] += zv * wb[1]; a[6] += zv * wb[2]; a[7] += zv * wb[3]; }
#pragma unroll
        for (int jj = 0; jj < 8; ++jj) h1[tl * 65 + jg * 8 + jj] = sinf(fq[jg * 8 + jj] * a[jj]);
        __syncthreads();
#pragma unroll
        for (int jj = 0; jj < 8; ++jj) a[jj] = b2[jg * 8 + jj];
#pragma unroll 4
        for (int i = 0; i < 64; ++i) { const float hv = h1[tl * 65 + i]; const LAS f32x4* wp = (const LAS f32x4*)(w2s + i * 64 + jg * 8); const f32x4 wa = wp[0], wb = wp[1];
            a[0] += hv * wa[0]; a[1] += hv * wa[1]; a[2] += hv * wa[2]; a[3] += hv * wa[3]; a[4] += hv * wb[0]; a[5] += hv * wb[1]; a[6] += hv * wb[2]; a[7] += hv * wb[3]; }
#pragma unroll
        for (int jj = 0; jj < 8; ++jj) h2b[tl * 72 + jg * 8 + jj] = (bf16)(cvt_pk_bf16(sinf(fq[64 + jg * 8 + jj] * a[jj]), 0.f) & 0xffffu);
        __syncthreads();
    }
    {
        const bf16* W3T = (const bf16*)(F.ws + WS_W3T) + (size_t)l * 1024 * 64;
        const int lane = F.lane, lr = lane & 15, lg = lane >> 4;
        const float dl0 = -4.605170186f / 1.5f, dl1 = -4.605170186f / 0.3f;
        bf16x8 af[4][2];
#pragma unroll
        for (int rt = 0; rt < 4; ++rt)
#pragma unroll
            for (int ks = 0; ks < 2; ++ks) af[rt][ks] = *(const LAS bf16x8*)(h2b + (rt * 16 + lr) * 72 + ks * 32 + 8 * lg);
#pragma unroll 2
        for (int ct = 0; ct < 8; ++ct) {
            const int col = F.wave * 128 + ct * 16 + lr, c = col & 255;
            const bf16x8 b0 = *(const bf16x8*)(W3T + (size_t)col * 64 + 8 * lg), b1 = *(const bf16x8*)(W3T + (size_t)col * 64 + 32 + 8 * lg);
            const float ad = fabsf(dl0 + (dl1 - dl0) * (float)c / 255.0f);
#pragma unroll
            for (int rt = 0; rt < 4; ++rt) {
                f32x4 a = (f32x4){0.f, 0.f, 0.f, 0.f};
                a = __builtin_amdgcn_mfma_f32_16x16x32_bf16(af[rt][0], b0, a, 0, 0, 0);
                a = __builtin_amdgcn_mfma_f32_16x16x32_bf16(af[rt][1], b1, a, 0, 0, 0);
                const int tb = t0 + rt * 16 + 4 * lg;
#pragma unroll
                for (int e = 0; e < 4; ++e) { const float tn = (float)(tb + e) / (float)(L - 1); a[e] *= __expf(-tn * ad); }
                if (bfout) { u32x2 w; w.x = cvt_pk_bf16(a[0], a[1]); w.y = cvt_pk_bf16(a[2], a[3]); *(u32x2*)((bf16*)filt + (size_t)col * L + tb) = w; }
                else *(f32x4*)(filt + (size_t)col * L + tb) = a;
            }
        }
    }
    __syncthreads();
}
__device__ __forceinline__ void phase_filters(Frame& F, const Params& P, int l, bool with_ctx) {
    float* filt = (float*)(F.ws + WS_FILT); float* filtc = (float*)(F.ws + WS_FILTC);
    const int nu = SEQ / 64 + (with_ctx ? CTXL / 64 : 0);
    for (int u = F.bid; u < nu; u += F.G) {
        if (u < SEQ / 64) filter_unit(F, P, l, SEQ, u * 64, filt, true);
        else filter_unit(F, P, l, CTXL, (u - SEQ / 64) * 64, filtc, false);
    }
}

__device__ __forceinline__ void seg_of(int row, int& s0, int& s1) {
    if (row < TL) { s0 = row & ~(SEQ - 1); s1 = s0 + SEQ; } else { s0 = TL + ((row - TL) & ~(CTXL - 1)); s1 = s0 + CTXL; }
}
__device__ __forceinline__ void conformer_tiles(Frame& F, const Params& P, int l, int u0, int ntile) {
    const bf16* UA = (const bf16*)(F.ws + WS_UA); bf16* BR0 = (bf16*)(F.ws + WS_BRV);
    LAS bf16* tin = (LAS bf16*)F.lds;
    LAS float* cout = (LAS float*)(F.lds + 49152);
    const int c = F.tid & 255, half = F.tid >> 8;
    float w[31];
#pragma unroll
    for (int j = 0; j < 31; ++j) w[j] = P.in[I_CDW][(l * 31 + j) * 256 + c];
    const float b = P.in[I_CDB][l * 256 + c];
    const f32x4 g = *(const f32x4*)(P.in[I_CLG] + l * 256 + 4 * F.lane), bb = *(const f32x4*)(P.in[I_CLB] + l * 256 + 4 * F.lane);
    u32x4 v[6];
#define CONF_LOAD(u_) do { const int t0_ = (u_) * 64; int s0_, s1_; seg_of(t0_, s0_, s1_); _Pragma("unroll") for (int k = 0; k < 6; ++k) { const int idx = F.tid + NTHR * k, rr = idx >> 5, c8 = idx & 31, gr = t0_ - 15 + rr; \
        const bool ok_ = idx < 94 * 32 && gr >= s0_ && gr < s1_; const u32x4 t_ = *(const u32x4*)(UA + (size_t)min(max(gr, s0_), s1_ - 1) * 256 + c8 * 8); v[k] = ok_ ? t_ : (u32x4){0u, 0u, 0u, 0u}; } } while (0)
    if (u0 < ntile) CONF_LOAD(u0);
    for (int u = u0; u < ntile; u += F.G) {
        const int t0 = u * 64;
#pragma unroll
        for (int k = 0; k < 6; ++k) { const int idx = F.tid + NTHR * k, rr = idx >> 5, c8 = idx & 31; if (idx < 94 * 32) *(LAS u32x4*)(tin + rr * 256 + c8 * 8) = v[k]; }
        __syncthreads();
        if (u + F.G < ntile) CONF_LOAD(u + F.G);
        {
            float in[62];
#pragma unroll
            for (int i = 0; i < 62; ++i) in[i] = bf2f(tin[(half * 32 + i) * 256 + c]);
#pragma unroll
            for (int t = 0; t < 32; ++t) { float a = b;
#pragma unroll
                for (int j = 0; j < 31; ++j) a += w[j] * in[t + j];
                cout[(half * 32 + t) * 260 + c] = a; }
        }
        __syncthreads();
        {
            f32x4 v[8]; float s[8], q[8];
#pragma unroll
            for (int tt = 0; tt < 8; ++tt) { v[tt] = *(const LAS f32x4*)(cout + (F.wave * 8 + tt) * 260 + 4 * F.lane); s[tt] = (v[tt][0] + v[tt][1]) + (v[tt][2] + v[tt][3]); }
#pragma unroll
            for (int tt = 0; tt < 8; ++tt) s[tt] = wave_sum(s[tt]);
#pragma unroll
            for (int tt = 0; tt < 8; ++tt) { v[tt] = v[tt] - s[tt] * (1.0f / 256.0f); q[tt] = (v[tt][0] * v[tt][0] + v[tt][1] * v[tt][1]) + (v[tt][2] * v[tt][2] + v[tt][3] * v[tt][3]); }
#pragma unroll
            for (int tt = 0; tt < 8; ++tt) q[tt] = wave_sum(q[tt]);
#pragma unroll
            for (int tt = 0; tt < 8; ++tt) { const float rstd = 1.0f / sqrtf(q[tt] * (1.0f / 256.0f) + LN_EPS);
                f32x4 y = v[tt] * rstd * g + bb;
#pragma unroll
                for (int j = 0; j < 4; ++j) y[j] = siluf_(y[j]);
                u32x2 wv; wv.x = cvt_pk_bf16(y[0], y[1]); wv.y = cvt_pk_bf16(y[2], y[3]);
                __builtin_nontemporal_store(wv, (u32x2*)(BR0 + (size_t)(t0 + F.wave * 8 + tt) * 256 + 4 * F.lane)); }
        }
        __syncthreads();
    }
}
#undef CONF_LOAD
__device__ __forceinline__ void shortconv_unit(Frame& F, const Params& P, int l, int t0) {
    const bf16* SB = (const bf16*)(F.ws + WS_SB); const bf16* W = (const bf16*)(F.ws + WS_W); bf16* BR2 = (bf16*)(F.ws + WS_BRV) + 2 * (size_t)MT * 256;
    int s0, s1; seg_of(t0, s0, s1);
    const float* cw = P.in[I_SCW] + l * 3 * 256;
#pragma unroll
    for (int k = 0; k < 4; ++k) { const int idx = F.tid + NTHR * k, tok = idx >> 5, c8 = (idx & 31) * 8, gr = t0 + tok;
        const u32x4 z = (u32x4){0u, 0u, 0u, 0u};
        const u32x4 wm_ = *(const u32x4*)(W + (size_t)max(gr - 1, s0) * 256 + c8), w0 = *(const u32x4*)(W + (size_t)gr * 256 + c8),
                    wp_ = *(const u32x4*)(W + (size_t)min(gr + 1, s1 - 1) * 256 + c8), sb = *(const u32x4*)(SB + (size_t)gr * 256 + c8);
        const u32x4 wm = (gr - 1 >= s0) ? wm_ : z, wp = (gr + 1 < s1) ? wp_ : z;
        float o[8];
#pragma unroll
        for (int j = 0; j < 4; ++j) { const int c = c8 + 2 * j;
            o[2 * j] = bflo(sb[j]) * (cw[c] * bflo(wm[j]) + cw[256 + c] * bflo(w0[j]) + cw[512 + c] * bflo(wp[j]));
            o[2 * j + 1] = bfhi(sb[j]) * (cw[c + 1] * bfhi(wm[j]) + cw[256 + c + 1] * bfhi(w0[j]) + cw[512 + c + 1] * bfhi(wp[j])); }
        u32x4 w; w.x = cvt_pk_bf16(o[0], o[1]); w.y = cvt_pk_bf16(o[2], o[3]); w.z = cvt_pk_bf16(o[4], o[5]); w.w = cvt_pk_bf16(o[6], o[7]);
        __builtin_nontemporal_store(w, (u32x4*)(BR2 + (size_t)gr * 256 + c8)); }
}
__device__ __forceinline__ void attn_stage_ctx(Frame& F, int b, int h) {
    const unsigned char* K = F.ws + WS_K; const unsigned char* VT = F.ws + WS_VT;
#pragma unroll
    for (int i = 0; i < 4; ++i) { const int pi = F.tid + NTHR * i;
        { const int key = pi >> 3, pc = pi & 7; const u32x4 v = *(const u32x4*)(K + (size_t)(TL + b * CTXL + key) * 512 + h * 128 + pc * 16);
          *(LAS u32x4*)(F.lds + key * 128 + ((pc ^ ((key & 3) | ((key >> 1) & 4))) << 4)) = v; }
        { const int dim = pi >> 5, pc = pi & 31; const u32x4 v = *(const u32x4*)(VT + ((size_t)(h * 64 + dim) * MT + TL + b * CTXL) * 2 + pc * 16);
          *(LAS u32x4*)(F.lds + 32768 + dim * 512 + ((pc ^ (dim & 7)) << 4)) = v; } }
}
__device__ __forceinline__ void attn_wave_unit(Frame& F, int wu, bool lat, bool cl  ) {
    const bf16* Q = (const bf16*)(F.ws + WS_Q); const bf16* K = (const bf16*)(F.ws + WS_K); const bf16* VT = (const bf16*)(F.ws + WS_VT);
    bf16* BR1 = (bf16*)(F.ws + WS_BRV) + (size_t)MT * 256;
    const LAS float* rpb = (const LAS float*)(F.lds + RPB_OFF);
    const int lane = lane_now(), q = lane & 15, g = lane >> 4;
    int b, h, r = 0, qb, tq0, cb = 0, r0 = 0;
    if (lat) { qb = wu & 3; h = (wu >> 2) & 3; r = (wu >> 4) & 255; b = wu >> 12; tq0 = b * SEQ + r * 64 + 16 * qb; cb = (qb == 0) ? 0 : (qb == 1 ? 8 : (qb == 2 ? 24 : 32)); r0 = min(max(r - 4, 0), 248); }
    else { qb = wu & 15; h = (wu >> 4) & 3; b = wu >> 6; tq0 = TL + b * CTXL + 16 * qb; }
    bf16x8 qf[2];
#pragma unroll
    for (int kk = 0; kk < 2; ++kk) qf[kk] = *(const bf16x8*)(Q + (size_t)(tq0 + q) * 256 + h * 64 + 32 * kk + 8 * g);
    const int koff = (q >> 2) * 8 + (q & 3);
    const unsigned klo = (unsigned)((koff * 256 + h * 64 + 8 * g) * 2);
    const unsigned vlo = (unsigned)((((h * 64 + q) * MT) + 8 * g) * 2);
    const char* Kc = (const char*)K; const char* Vc = (const char*)VT;
    const int kl0 = koff * 128 + ((g ^ ((q & 3) | (((q >> 2) & 1) << 2))) << 4), vl0 = 32768 + q * 512 + ((g ^ (q & 7)) << 4);
    const int cq = 16 * qb + q, c0 = min(max(cq - 8, 0), 48);
    float mx = -1e30f, sum = 0.f;
    f32x4 o[4];
#pragma unroll
    for (int bl = 0; bl < 4; ++bl) o[bl] = (f32x4){0.f, 0.f, 0.f, 0.f};
    bf16x8 kf[2][2][2];
#define ATT_KBASE(i_) (((i_) < 8) ? (b * SEQ + (r0 + (i_)) * 64 + cb) : (TL + b * CTXL + 32 * ((i_) - 8)))
#define ATT_LOADK(c_) do { _Pragma("unroll") for (int s_ = 0; s_ < 2; ++s_) { const int kb_ = ATT_KBASE(2 * (c_) + s_); _Pragma("unroll") for (int tt = 0; tt < 2; ++tt) { \
        if (cl && (c_) >= 4) { const int lo_ = (2 * (c_) + s_ - 8) * 4096 + tt * 512; kf[s_][tt][0] = *(const LAS bf16x8*)(F.lds + lo_ + kl0); kf[s_][tt][1] = *(const LAS bf16x8*)(F.lds + lo_ + (kl0 ^ 64)); } \
        else { const char* kp_ = Kc + (size_t)(kb_ + 4 * tt) * 512; kf[s_][tt][0] = *(const bf16x8*)(kp_ + klo); kf[s_][tt][1] = *(const bf16x8*)(kp_ + klo + 64); } } } } while (0)
#define ATT_LOADV(dst_, c_) do { _Pragma("unroll") for (int s_ = 0; s_ < 2; ++s_) { const int kb_ = ATT_KBASE(2 * (c_) + s_); _Pragma("unroll") for (int bl = 0; bl < 4; ++bl) \
        { if (cl && (c_) >= 4) { const int m_ = 2 * (c_) + s_ - 8; dst_[s_][bl] = *(const LAS bf16x8*)(F.lds + bl * 8192 + (m_ >> 1) * 128 + ((m_ & 1) ? (vl0 ^ 64) : vl0)); } \
          else dst_[s_][bl] = *(const bf16x8*)(Vc + ((size_t)(16 * bl) * MT + kb_) * 2 + vlo); } } } while (0)
    bf16x8 vf[2][4], vn[2][4];
    u32x4 kg[2][2][4], vg[2][4];
    LAS unsigned char* wb = F.lds + 65536 + F.wave * 8192;
    const int kq = lane >> 3;
    const int wk0 = kq * 128 + (((lane & 7) ^ (kq & 3)) << 4), wv0 = 4096 + (lane >> 2) * 64 + (((lane & 3) ^ ((lane >> 3) & 3)) << 4), vl1 = 4096 + q * 64 + ((g ^ ((q >> 1) & 3)) << 4);
    const unsigned gk = (unsigned)(kq * 512 + h * 128 + (lane & 7) * 16), gv = (unsigned)(((h * 64 + (lane >> 2)) * MT) * 2 + (lane & 3) * 16);
#define ATT_GLOADK(c_) do { _Pragma("unroll") for (int s_ = 0; s_ < 2; ++s_) { const int kb_ = ATT_KBASE(2 * (c_) + s_); _Pragma("unroll") for (int n = 0; n < 4; ++n) \
        kg[(c_) & 1][s_][n] = *(const u32x4*)(Kc + (size_t)kb_ * 512 + (size_t)n * 4096 + gk); } } while (0)
#define ATT_GLOADV(c_) do { _Pragma("unroll") for (int s_ = 0; s_ < 2; ++s_) { const int kb_ = ATT_KBASE(2 * (c_) + s_); _Pragma("unroll") for (int n = 0; n < 4; ++n) \
        vg[s_][n] = *(const u32x4*)(Vc + (size_t)kb_ * 2 + (size_t)n * 16 * MT * 2 + gv); } } while (0)
#define ATT_XPOSEK(c_) do { _Pragma("unroll") for (int s_ = 0; s_ < 2; ++s_) { \
        _Pragma("unroll") for (int n = 0; n < 4; ++n) *(LAS u32x4*)(wb + n * 1024 + ((n & 1) ? (wk0 ^ 64) : wk0)) = kg[(c_) & 1][s_][n]; \
        _Pragma("unroll") for (int tt = 0; tt < 2; ++tt) { kf[s_][tt][0] = *(const LAS bf16x8*)(wb + tt * 512 + kl0); kf[s_][tt][1] = *(const LAS bf16x8*)(wb + tt * 512 + (kl0 ^ 64)); } } } while (0)
#define ATT_XPOSEV() do { _Pragma("unroll") for (int s_ = 0; s_ < 2; ++s_) { \
        _Pragma("unroll") for (int n = 0; n < 4; ++n) *(LAS u32x4*)(wb + n * 1024 + wv0) = vg[s_][n]; \
        _Pragma("unroll") for (int bl = 0; bl < 4; ++bl) vf[s_][bl] = *(const LAS bf16x8*)(wb + bl * 1024 + vl1); } } while (0)
    if (cl) { ATT_GLOADK(0); ATT_GLOADV(0); ATT_GLOADK(1); } else if (lat) { ATT_LOADK(0); ATT_LOADV(vf, 0); } else { ATT_LOADK(4); ATT_LOADV(vf, 4); }
#pragma unroll
    for (int c = 0; c < 8; ++c) {
        if (c < 4 && !lat) continue;
        if (cl) { if (c < 4) { ATT_XPOSEK(c); if (c < 2) ATT_GLOADK(c + 2); } else { ATT_LOADK(c); ATT_LOADV(vf, c); } }
        f32x4 s[2][2];
#pragma unroll
        for (int s_ = 0; s_ < 2; ++s_)
#pragma unroll
            for (int tt = 0; tt < 2; ++tt) {
                f32x4 a = (f32x4){0.f, 0.f, 0.f, 0.f};
                a = __builtin_amdgcn_mfma_f32_16x16x32_bf16(kf[s_][tt][0], qf[0], a, 0, 0, 0);
                a = __builtin_amdgcn_mfma_f32_16x16x32_bf16(kf[s_][tt][1], qf[1], a, 0, 0, 0);
                if (c < 4) {
                    const int i = 2 * c + s_;
                    const LAS float* rp = rpb + (h * 15 + (r0 + i - r + 7)) * 31;
#pragma unroll
                    for (int j = 0; j < 4; ++j) { const int kc = cb + 8 * g + 4 * tt + j; const bool ok = (kc >= c0) && (kc < c0 + 16);
                        const int dc = min(max(kc - cq + 15, 0), 30);
                        a[j] = ok ? a[j] + rp[dc] : -1e30f; }
                }
                s[s_][tt] = a;
            }
        if (!cl && c < 7) { ATT_LOADK(c + 1); ATT_LOADV(vn, c + 1); }
        if (cl && c < 4) { ATT_XPOSEV(); if (c < 3) ATT_GLOADV(c + 1); }
        float cm = -1e30f;
#pragma unroll
        for (int s_ = 0; s_ < 2; ++s_)
#pragma unroll
            for (int tt = 0; tt < 2; ++tt)
#pragma unroll
                for (int j = 0; j < 4; ++j) cm = fmaxf(cm, s[s_][tt][j]);
        cm = xrow_max(cm);
        const float mn = fmaxf(mx, cm), alpha = __builtin_amdgcn_exp2f(mx - mn);
        mx = mn; sum *= alpha;
#pragma unroll
        for (int bl = 0; bl < 4; ++bl) o[bl] *= alpha;
#pragma unroll
        for (int s_ = 0; s_ < 2; ++s_) {
            float p[8];
#pragma unroll
            for (int tt = 0; tt < 2; ++tt)
#pragma unroll
                for (int j = 0; j < 4; ++j) { const float e = __builtin_amdgcn_exp2f(s[s_][tt][j] - mn); p[4 * tt + j] = e; sum += e; }
            u32x4 pw; pw.x = cvt_pk_bf16(p[0], p[1]); pw.y = cvt_pk_bf16(p[2], p[3]); pw.z = cvt_pk_bf16(p[4], p[5]); pw.w = cvt_pk_bf16(p[6], p[7]);
            const bf16x8 pf = __builtin_bit_cast(bf16x8, pw);
#pragma unroll
            for (int bl = 0; bl < 4; ++bl) o[bl] = __builtin_amdgcn_mfma_f32_16x16x32_bf16(vf[s_][bl], pf, o[bl], 0, 0, 0);
        }
        if (!cl && c < 7) {
#pragma unroll
            for (int s_ = 0; s_ < 2; ++s_)
#pragma unroll
                for (int bl = 0; bl < 4; ++bl) vf[s_][bl] = vn[s_][bl];
        }
    }
#undef ATT_XPOSEK
#undef ATT_XPOSEV
#undef ATT_GLOADK
#undef ATT_GLOADV
#undef ATT_LOADV
#undef ATT_LOADK
#undef ATT_KBASE
    sum = xrow_sum(sum);
    const float inv = 1.0f / sum;
#pragma unroll
    for (int bl = 0; bl < 4; ++bl) { u32x2 w; w.x = cvt_pk_bf16(o[bl][0] * inv, o[bl][1] * inv); w.y = cvt_pk_bf16(o[bl][2] * inv, o[bl][3] * inv);
        __builtin_nontemporal_store(w, (u32x2*)(BR1 + (size_t)(tq0 + q) * 256 + h * 64 + 16 * bl + 4 * g)); }
}

constexpr int FL = 16384;
__device__ __forceinline__ f32x2 cmul(f32x2 a, f32x2 b) {
    f32x2 t, r;
    asm("v_pk_mul_f32 %1, %2, %3 op_sel:[1,1] op_sel_hi:[1,0]\n\tv_pk_fma_f32 %0, %2, %3, %1 op_sel:[0,0,0] op_sel_hi:[0,1,1] neg_lo:[0,0,1]" : "=v"(r), "=&v"(t) : "v"(a), "v"(b));
    return r;
}
__device__ __forceinline__ f32x2 cmulc(f32x2 a, f32x2 b) {
    f32x2 t, r;
    asm("v_pk_mul_f32 %1, %2, %3 op_sel:[1,1] op_sel_hi:[1,0]\n\tv_pk_fma_f32 %0, %2, %3, %1 op_sel:[0,0,0] op_sel_hi:[0,1,1] neg_hi:[1,0,0]" : "=v"(r), "=&v"(t) : "v"(a), "v"(b));
    return r;
}
__device__ __forceinline__ f32x2 rotm(f32x2 b, f32x2 d) { f32x2 r; asm("v_pk_add_f32 %0, %1, %2 op_sel:[0,1] op_sel_hi:[1,0] neg_hi:[0,1]" : "=v"(r) : "v"(b), "v"(d)); return r; }
__device__ __forceinline__ f32x2 rotp(f32x2 b, f32x2 d) { f32x2 r; asm("v_pk_add_f32 %0, %1, %2 op_sel:[0,1] op_sel_hi:[1,0] neg_lo:[0,1]" : "=v"(r) : "v"(b), "v"(d)); return r; }
__device__ __forceinline__ f32x2 tw_main(const LAS f32x2* T, int m) { return cmul(T[m >> 7], T[128 + (m & 127)]); }
__device__ __forceinline__ f32x2 tw_half(const LAS f32x2* T, int n) { return cmul(T[256 + (n >> 7)], T[384 + (n & 127)]); }
__device__ __forceinline__ void r4f(f32x2& x0, f32x2& x1, f32x2& x2, f32x2& x3, f32x2 w1, f32x2 w2, f32x2 w3) {
    const f32x2 a = x0 + x2, b = x0 - x2, c = x1 + x3, d = x1 - x3;
    x0 = a + c; x1 = cmul(rotm(b, d), w1); x2 = cmul(a - c, w2); x3 = cmul(rotp(b, d), w3);
}
__device__ __forceinline__ void r4f1(f32x2& x0, f32x2& x1, f32x2& x2, f32x2& x3) {
    const f32x2 a = x0 + x2, b = x0 - x2, c = x1 + x3, d = x1 - x3;
    x0 = a + c; x1 = rotm(b, d); x2 = a - c; x3 = rotp(b, d);
}
__device__ __forceinline__ void r4i(f32x2& x0, f32x2& x1, f32x2& x2, f32x2& x3, f32x2 w1, f32x2 w2, f32x2 w3) {
    const f32x2 t1 = cmulc(x1, w1), t2 = cmulc(x2, w2), t3 = cmulc(x3, w3);
    const f32x2 a = x0 + t2, b = x0 - t2, c = t1 + t3, d = t1 - t3;
    x0 = a + c; x1 = rotp(b, d); x2 = a - c; x3 = rotm(b, d);
}
__device__ __forceinline__ void r4i1(f32x2& x0, f32x2& x1, f32x2& x2, f32x2& x3) {
    const f32x2 a = x0 + x2, b = x0 - x2, c = x1 + x3, d = x1 - x3;
    x0 = a + c; x1 = rotp(b, d); x2 = a - c; x3 = rotm(b, d);
}
#define W16_1 ((f32x2){0.92387953251f, -0.38268343237f})
#define W16_2 ((f32x2){0.70710678119f, -0.70710678119f})
#define W16_3 ((f32x2){0.38268343237f, -0.92387953251f})
template <int SP, bool INV> __device__ __forceinline__ void fft_pass16(LAS f32x2* B, const LAS f32x2* T, int tid) {
    constexpr int STEP = (SP == 1024) ? 1040 : (SP == 64 ? 65 : 4);
#pragma unroll
    for (int jj = 0; jj < 2; ++jj) {
        const int q = tid + 512 * jj;
        int k, base;
        if (SP == 1024) { k = q; base = q + (q >> 6); }
        else if (SP == 64) { k = q & 63; const int i0 = (q >> 6) * 1024 + k; base = i0 + (i0 >> 6); }
        else { k = q >> 8; base = (q & 255) * 65 + k; }
        LAS f32x2* p = B + base;
        f32x2 x[16];
#pragma unroll
        for (int m = 0; m < 16; ++m) x[m] = p[m * STEP];
        const f32x2 b = tw_main(T, k * (1024 / SP));
        const f32x2 b2 = cmul(b, b), w = cmul(b2, b2), w2 = cmul(w, w), w3 = cmul(w, w2);
        f32x2 t1[4], t2[4], t3[4];
        t1[0] = b; t1[1] = cmul(b, W16_1); t1[2] = cmul(b, W16_2); t1[3] = cmul(b, W16_3);
#pragma unroll
        for (int m = 0; m < 4; ++m) { t2[m] = cmul(t1[m], t1[m]); t3[m] = cmul(t1[m], t2[m]); }
        if (!INV) {
#pragma unroll
            for (int m = 0; m < 4; ++m) r4f(x[m], x[m + 4], x[m + 8], x[m + 12], t1[m], t2[m], t3[m]);
#pragma unroll
            for (int j = 0; j < 4; ++j) r4f(x[4 * j], x[4 * j + 1], x[4 * j + 2], x[4 * j + 3], w, w2, w3);
        } else {
#pragma unroll
            for (int j = 0; j < 4; ++j) r4i(x[4 * j], x[4 * j + 1], x[4 * j + 2], x[4 * j + 3], w, w2, w3);
#pragma unroll
            for (int m = 0; m < 4; ++m) r4i(x[m], x[m + 4], x[m + 8], x[m + 12], t1[m], t2[m], t3[m]);
        }
#pragma unroll
        for (int m = 0; m < 16; ++m) p[m * STEP] = x[m];
    }
    __syncthreads();
}
template <bool INV> __device__ __forceinline__ void fft_pass4(LAS f32x2* B, int tid) {
#pragma unroll 4
    for (int jj = 0; jj < 8; ++jj) {
        const int q = tid + 512 * jj;
        LAS f32x2* p = B + (q & 255) * 65 + 4 * (q >> 8);
        f32x2 x0 = p[0], x1 = p[1], x2 = p[2], x3 = p[3];
        if (!INV) r4f1(x0, x1, x2, x3); else r4i1(x0, x1, x2, x3);
        p[0] = x0; p[1] = x1; p[2] = x2; p[3] = x3;
    }
    __syncthreads();
}
__device__ __forceinline__ void fft_fwd(LAS f32x2* B, const LAS f32x2* T, int tid) {
    fft_pass16<1024, false>(B, T, tid); fft_pass16<64, false>(B, T, tid); fft_pass16<4, false>(B, T, tid); fft_pass4<false>(B, tid);
}
__device__ __forceinline__ void fft_inv(LAS f32x2* B, const LAS f32x2* T, int tid) {
    fft_pass4<true>(B, tid); fft_pass16<4, true>(B, T, tid); fft_pass16<64, true>(B, T, tid); fft_pass16<1024, true>(B, T, tid);
}
__device__ __forceinline__ void fft_pass4_keep(LAS f32x2* B, int tid, u32x4 (&ks)[8]) {
#pragma unroll
    for (int jj = 0; jj < 8; ++jj) {
        const int q = tid + 512 * jj;
        const LAS f32x2* p = B + (q & 255) * 65 + 4 * (q >> 8);
        f32x2 x0 = p[0], x1 = p[1], x2 = p[2], x3 = p[3];
        r4f1(x0, x1, x2, x3);
        ks[jj].x = cvt_pk_bf16(x0.x, x0.y); ks[jj].y = cvt_pk_bf16(x1.x, x1.y); ks[jj].z = cvt_pk_bf16(x2.x, x2.y); ks[jj].w = cvt_pk_bf16(x3.x, x3.y);
    }
    __syncthreads();
}
__device__ __forceinline__ void fft_mid4(LAS f32x2* B, int tid, const u32x4 (&ks)[8]) {
#pragma unroll
    for (int jj = 0; jj < 8; ++jj) {
        const int q = tid + 512 * jj;
        LAS f32x2* p = B + (q & 255) * 65 + 4 * (q >> 8);
        f32x2 x0 = p[0], x1 = p[1], x2 = p[2], x3 = p[3];
        r4f1(x0, x1, x2, x3);
        x0 = cmul(x0, (f32x2){bflo(ks[jj].x), bfhi(ks[jj].x)}); x1 = cmul(x1, (f32x2){bflo(ks[jj].y), bfhi(ks[jj].y)});
        x2 = cmul(x2, (f32x2){bflo(ks[jj].z), bfhi(ks[jj].z)}); x3 = cmul(x3, (f32x2){bflo(ks[jj].w), bfhi(ks[jj].w)});
        r4i1(x0, x1, x2, x3);
        p[0] = x0; p[1] = x1; p[2] = x2; p[3] = x3;
    }
    __syncthreads();
}
__device__ __forceinline__ void fft_fwd3(LAS f32x2* B, const LAS f32x2* T, int tid) { fft_pass16<1024, false>(B, T, tid); fft_pass16<64, false>(B, T, tid); fft_pass16<4, false>(B, T, tid); }
__device__ __forceinline__ void fft_inv3(LAS f32x2* B, const LAS f32x2* T, int tid) { fft_pass16<4, true>(B, T, tid); fft_pass16<64, true>(B, T, tid); fft_pass16<1024, true>(B, T, tid); }
__device__ __forceinline__ float conv3_at(const bf16* p, int n, int L, float w0, float w1, float w2, float b) {
    const float xm = n > 0 ? bf2f(p[n - 1]) : 0.f, x0 = bf2f(p[n]), xp = n + 1 < L ? bf2f(p[n + 1]) : 0.f;
    return w0 * xm + w1 * x0 + w2 * xp + b;
}
__device__ __forceinline__ float block_sum(Frame& F, float v) {
    LAS float* red = (LAS float*)(F.lds + RED_OFF);
    v = wave_sum(v);
    __syncthreads();
    if (F.lane == 0) red[F.wave] = v;
    __syncthreads();
    float s = 0.f;
#pragma unroll
    for (int w = 0; w < 8; ++w) s += red[w];
    return s;
}
__device__ __forceinline__ f32x4 conv3x4(const bf16* p, int nb, float w0, float w1, float w2, float b) {
    const u32x2 m = *(const u32x2*)(p + nb);
    const float x0 = bflo(m.x), x1 = bfhi(m.x), x2 = bflo(m.y), x3 = bfhi(m.y);
    const float xm = nb > 0 ? bf2f(p[nb - 1]) : 0.f, xp = nb + 4 < SEQ ? bf2f(p[nb + 4]) : 0.f;
    return (f32x4){w0 * xm + w1 * x0 + w2 * x1 + b, w0 * x0 + w1 * x1 + w2 * x2 + b, w0 * x1 + w1 * x2 + w2 * x3 + b, w0 * x2 + w1 * x3 + w2 * xp + b};
}
typedef u32x4 u32x4_a4 __attribute__((aligned(4)));
__device__ __forceinline__ u32x4 ld16u(const bf16* p) { return *(const u32x4_a4*)p; }
__device__ __forceinline__ void conv3p(const u32x4 a, const u32x4 b, bool first, bool last, float w0, float w1, float w2, float bb, f32x2 (&z)[4]) {
    f32x2 X[6];
    X[0] = (f32x2){bfhi(a.x), bfhi(b.x)}; X[1] = (f32x2){bflo(a.y), bflo(b.y)}; X[2] = (f32x2){bfhi(a.y), bfhi(b.y)};
    X[3] = (f32x2){bflo(a.z), bflo(b.z)}; X[4] = (f32x2){bfhi(a.z), bfhi(b.z)}; X[5] = (f32x2){bflo(a.w), bflo(b.w)};
    if (first) X[0] = (f32x2){0.f, 0.f};
    if (last) X[5] = (f32x2){0.f, 0.f};
#pragma unroll
    for (int e = 0; e < 4; ++e) z[e] = X[e] * w0 + (X[e + 1] * w1 + (X[e + 2] * w2 + bb));
}
__device__ __forceinline__ void hyena_unit(Frame& F, const Params& P, int l, int c, bool dummy) {
    LAS f32x2* B = (LAS f32x2*)F.lds; const LAS f32x2* T = (const LAS f32x2*)(F.lds + TW_OFF);
    const bf16* HT = (const bf16*)(F.ws + WS_HT); const bf16* FILT = (const bf16*)(F.ws + WS_FILT);
    f32x4* Z = (f32x4*)(F.ws + WS_KSCR + (size_t)F.bid * 131072);
    u32x4 ksr[8];
    u32x4* ES = (u32x4*)(F.ws + WS_ES + (size_t)F.bid * 131072) + 4096;
    bf16* BR3 = (bf16*)(F.ws + WS_BRV) + 3 * (size_t)MT * 256;
    const float* sw = P.in[I_HSW] + l * 3 * 768; const float* sb = P.in[I_HSB] + l * 768;
    const int tid = F.tid;
#define HY_NB(jp_) (4 * tq + 2048 * (jp_))
#define HY_TQ int tq = tid; asm volatile("" : "+v"(tq))
#define HY_G(T_, base_, boff_) (*(T_*)((char*)(base_) + (unsigned)(boff_)))
#define HY_LDX(row_, nb_) (*(const u32x4_a4*)((const char*)((row_) - 2) + (unsigned)((nb_) * 2)))
#define HY_LDR(hb_, nb_) (*(const u32x4_a4*)((const char*)((hb_) - 2) + (unsigned)((FL - 4 - (nb_)) * 2)))
#define HY_SLOT(nb_) (B + (nb_) + ((nb_) >> 6))
#define HY_TW4(nb_, w_) do { const f32x2 tb_ = T[256 + ((nb_) >> 7)]; const LAS f32x4* tp_ = (const LAS f32x4*)(T + 384 + ((nb_) & 127)); const f32x4 ta_ = tp_[0], tc_ = tp_[1]; \
        w_[0] = cmul(tb_, (f32x2){ta_[0], ta_[1]}); w_[1] = cmul(tb_, (f32x2){ta_[2], ta_[3]}); w_[2] = cmul(tb_, (f32x2){tc_[0], tc_[1]}); w_[3] = cmul(tb_, (f32x2){tc_[2], tc_[3]}); } while (0)
#define HY_ST4(nb_, c0_, c1_, c2_, c3_) do { LAS f32x2* bp_ = HY_SLOT(nb_); bp_[0] = (c0_); bp_[1] = (c1_); bp_[2] = (c2_); bp_[3] = (c3_); } while (0)
#define HY_UNPK(w_) ((f32x2){bflo(w_), bfhi(w_)})
#define HY_FILT4(fw_, gw_, nb_, f4_, r4_) const f32x4 f4_ = (f32x4){bflo(fw_.x), bfhi(fw_.x), bflo(fw_.y), bfhi(fw_.y)};   \
        const f32x4 r4_ = (f32x4){(nb_) ? bflo(gw_.w) : 0.f, bfhi(gw_.z), bflo(gw_.z), bfhi(gw_.y)}
    {
        const bf16* p0 = HT + (size_t)c * MT; const float v0 = sw[c], v1 = sw[768 + c], v2 = sw[1536 + c], vb = sb[c];
        { HY_TQ;
#pragma unroll
        for (int h = 0; h < 2; ++h) {
            u32x4 xa[4], xb[4];
#pragma unroll
            for (int j = 0; j < 4; ++j) { const int nb = HY_NB(4 * h + j); xa[j] = HY_LDX(p0, nb); xb[j] = HY_LDX(p0 + SEQ, nb); }
#pragma unroll
            for (int j = 0; j < 4; ++j) { const int nb = HY_NB(4 * h + j); f32x2 z[4]; conv3p(xa[j], xb[j], nb == 0, nb + 4 == SEQ, v0, v1, v2, vb, z);
                HY_G(f32x4, Z, nb * 8) = (f32x4){z[0].x, z[0].y, z[1].x, z[1].y}; HY_G(f32x4, Z + 1, nb * 8) = (f32x4){z[2].x, z[2].y, z[3].x, z[3].y}; }
        } }
    }
#pragma unroll 1
    for (int o = 0; o < 2; ++o) {
        const bf16* hf = FILT + (size_t)((o * 2 + 0) * 256 + c) * SEQ; const bf16* hb = FILT + (size_t)((o * 2 + 1) * 256 + c) * SEQ;
        float ss = 0.f;
#pragma unroll 1
        for (int par = 0; par < 2; ++par) {
            if (par == 0) {
                { HY_TQ;
#pragma unroll
                for (int h = 0; h < 2; ++h) {
                    u32x2 fw[4]; u32x4 gw[4];
#pragma unroll
                    for (int j = 0; j < 4; ++j) { const int nb = HY_NB(4 * h + j); fw[j] = HY_G(const u32x2, hf, nb * 2); gw[j] = HY_LDR(hb, nb); }
#pragma unroll
                    for (int j = 0; j < 4; ++j) { const int nb = HY_NB(4 * h + j); HY_FILT4(fw[j], gw[j], nb, f4, r4);
                        const f32x4 a = f4 + r4; ss += (f4[0] * f4[0] + f4[1] * f4[1]) + (f4[2] * f4[2] + f4[3] * f4[3]) + (r4[0] * r4[0] + r4[1] * r4[1]) + (r4[2] * r4[2] + r4[3] * r4[3]);
                        HY_ST4(nb, ((f32x2){a[0], 0.f}), ((f32x2){a[1], 0.f}), ((f32x2){a[2], 0.f}), ((f32x2){a[3], 0.f})); }
                } }
                __syncthreads();
            }
            fft_fwd3(B, T, tid); fft_pass4_keep(B, tid, ksr);
            { HY_TQ;
#pragma unroll
            for (int h = 0; h < 2; ++h) {
                f32x4 za[4], zb[4];
#pragma unroll
                for (int j = 0; j < 4; ++j) { const int nb = HY_NB(4 * h + j); za[j] = HY_G(const f32x4, Z, nb * 8); zb[j] = HY_G(const f32x4, Z + 1, nb * 8); }
#pragma unroll
                for (int j = 0; j < 4; ++j) { const int nb = HY_NB(4 * h + j);
                    const f32x2 z0 = (f32x2){za[j].x, za[j].y}, z1 = (f32x2){za[j].z, za[j].w}, z2 = (f32x2){zb[j].x, zb[j].y}, z3 = (f32x2){zb[j].z, zb[j].w};
                    if (par == 0) { HY_ST4(nb, z0, z1, z2, z3); }
                    else { f32x2 tw[4]; HY_TW4(nb, tw); HY_ST4(nb, cmul(z0, tw[0]), cmul(z1, tw[1]), cmul(z2, tw[2]), cmul(z3, tw[3])); } }
            } }
            __syncthreads();
            fft_fwd3(B, T, tid); fft_mid4(B, tid, ksr);
            fft_inv3(B, T, tid);
            if (par == 0) {
                { HY_TQ;
#pragma unroll
                for (int h = 0; h < 2; ++h) {
                    u32x2 fw[4]; u32x4 gw[4];
#pragma unroll
                    for (int j = 0; j < 4; ++j) { const int nb = HY_NB(4 * h + j); fw[j] = HY_G(const u32x2, hf, nb * 2); gw[j] = HY_LDR(hb, nb); }
#pragma unroll
                    for (int j = 0; j < 4; ++j) { const int jp = 4 * h + j, nb = HY_NB(jp); const LAS f32x2* bp = HY_SLOT(nb); const f32x2 a0 = bp[0] * (1.0f / 16384.0f), a1 = bp[1] * (1.0f / 16384.0f), a2 = bp[2] * (1.0f / 16384.0f), a3 = bp[3] * (1.0f / 16384.0f);
                        u32x4 w; w.x = cvt_pk_bf16(a0.x, a0.y); w.y = cvt_pk_bf16(a1.x, a1.y); w.z = cvt_pk_bf16(a2.x, a2.y); w.w = cvt_pk_bf16(a3.x, a3.y); HY_G(u32x4, ES + jp * 512, tq * 16) = w;
                        HY_FILT4(fw[j], gw[j], nb, f4, r4);
                        const f32x4 d = f4 - r4; f32x2 tw[4]; HY_TW4(nb, tw); HY_ST4(nb, tw[0] * d[0], tw[1] * d[1], tw[2] * d[2], tw[3] * d[3]); }
                } }
                __syncthreads();
            }
        }
        const float nrm = (1.0f / sqrtf(block_sum(F, ss) + 1e-6f)) * 0.5f;
        const float hbias = P.in[I_HBI][(l * 2 + o) * 256 + c];
        const int ch = (o + 1) * 256 + c;
        const bf16* px = HT + (size_t)ch * MT; const float w0 = sw[ch], w1 = sw[768 + ch], w2 = sw[1536 + ch], bb = sb[ch];
        { HY_TQ;
#pragma unroll
        for (int h = 0; h < 4; ++h) {
            u32x4 ev[2], xa[2], xb[2]; f32x4 za[2], zb[2];
#pragma unroll
            for (int j = 0; j < 2; ++j) { const int jp = 2 * h + j, nb = HY_NB(jp); ev[j] = HY_G(const u32x4, ES + jp * 512, tq * 16); za[j] = HY_G(const f32x4, Z, nb * 8); zb[j] = HY_G(const f32x4, Z + 1, nb * 8); xa[j] = HY_LDX(px, nb); xb[j] = HY_LDX(px + SEQ, nb); }
#pragma unroll
            for (int j = 0; j < 2; ++j) { const int nb = HY_NB(2 * h + j);
                const LAS f32x2* bp = HY_SLOT(nb); f32x2 w[4]; HY_TW4(nb, w);
                const f32x2 e0 = HY_UNPK(ev[j].x) + cmulc(bp[0], w[0]) * (1.0f / 16384.0f), e1 = HY_UNPK(ev[j].y) + cmulc(bp[1], w[1]) * (1.0f / 16384.0f),
                            e2 = HY_UNPK(ev[j].z) + cmulc(bp[2], w[2]) * (1.0f / 16384.0f), e3 = HY_UNPK(ev[j].w) + cmulc(bp[3], w[3]) * (1.0f / 16384.0f);
                f32x2 x[4]; conv3p(xa[j], xb[j], nb == 0, nb + 4 == SEQ, w0, w1, w2, bb, x);
                const f32x2 y0 = (e0 * nrm + (f32x2){za[j].x, za[j].y} * hbias) * x[0], y1 = (e1 * nrm + (f32x2){za[j].z, za[j].w} * hbias) * x[1],
                            y2 = (e2 * nrm + (f32x2){zb[j].x, zb[j].y} * hbias) * x[2], y3 = (e3 * nrm + (f32x2){zb[j].z, zb[j].w} * hbias) * x[3];
                if (o == 0) { HY_G(f32x4, Z, nb * 8) = (f32x4){y0.x, y0.y, y1.x, y1.y}; HY_G(f32x4, Z + 1, nb * 8) = (f32x4){y2.x, y2.y, y3.x, y3.y}; }
                else if (!dummy) {
                    const unsigned u0 = cvt_pk_bf16(y0.x, y0.y), u1 = cvt_pk_bf16(y1.x, y1.y), u2 = cvt_pk_bf16(y2.x, y2.y), u3 = cvt_pk_bf16(y3.x, y3.y);
                    bf16* q0 = BR3 + c; bf16* q1 = q0 + (size_t)SEQ * 256; const int ob = nb * 512;
                    HY_G(bf16, q0, ob) = (bf16)(u0 & 0xffffu); HY_G(bf16, q0 + 256, ob) = (bf16)(u1 & 0xffffu); HY_G(bf16, q0 + 512, ob) = (bf16)(u2 & 0xffffu); HY_G(bf16, q0 + 768, ob) = (bf16)(u3 & 0xffffu);
                    HY_G(bf16, q1, ob) = (bf16)(u0 >> 16); HY_G(bf16, q1 + 256, ob) = (bf16)(u1 >> 16); HY_G(bf16, q1 + 512, ob) = (bf16)(u2 >> 16); HY_G(bf16, q1 + 768, ob) = (bf16)(u3 >> 16); }
            }
        } }
        __syncthreads();
    }
#undef HY_NB
#undef HY_TQ
#undef HY_G
#undef HY_LDX
#undef HY_LDR
#undef HY_FILT4
#undef HY_TW4
#undef HY_ST4
#undef HY_SLOT
#undef HY_UNPK
}
__device__ __forceinline__ void hyena_ctx_unit(Frame& F, const Params& P, int l, int c) {
    LAS float* zc = (LAS float*)F.lds;
    LAS float* kk = (LAS float*)(F.lds + 4096);
    const bf16* HT = (const bf16*)(F.ws + WS_HT); const float* FC = (const float*)(F.ws + WS_FILTC);
    bf16* BR3 = (bf16*)(F.ws + WS_BRV) + 3 * (size_t)MT * 256;
    const float* sw = P.in[I_HSW] + l * 3 * 768; const float* sb = P.in[I_HSB] + l * 768;
    const int b = F.tid >> 8, t = F.tid & 255;
    float zv = conv3_at(HT + (size_t)c * MT + TL + b * CTXL, t, CTXL, sw[c], sw[768 + c], sw[1536 + c], sb[c]);
    for (int o = 0; o < 2; ++o) {
        const float* hf = FC + (size_t)((o * 2 + 0) * 256 + c) * CTXL; const float* hb = FC + (size_t)((o * 2 + 1) * 256 + c) * CTXL;
        float ss = 0.f;
        if (F.tid < 256) { const float f = hf[F.tid]; kk[255 + F.tid] = f; ss = f * f; }
        else { const int d = F.tid - 256; if (d >= 1) { const float f = hb[d]; kk[255 - d] = f; ss = f * f; } }
        zc[F.tid] = zv;
        const float nrm = 1.0f / sqrtf(block_sum(F, ss) + 1e-6f);
        float y = 0.f;
        for (int s_ = 0; s_ < 256; ++s_) y += kk[t - s_ + 255] * zc[b * 256 + s_];
        y = y * nrm + P.in[I_HBI][(l * 2 + o) * 256 + c] * zv;
        const int ch = (o + 1) * 256 + c;
        zv = conv3_at(HT + (size_t)ch * MT + TL + b * CTXL, t, CTXL, sw[ch], sw[768 + ch], sw[1536 + ch], sb[ch]) * y;
        __syncthreads();
    }
    BR3[(size_t)(TL + b * CTXL + t) * 256 + c] = (bf16)(cvt_pk_bf16(zv, 0.f) & 0xffffu);
}
__device__ __forceinline__ void phase_mixer(Frame& F, const Params& P, int l, bool last) {
    {
        LAS float* rpb = (LAS float*)(F.lds + RPB_OFF); for (int i = F.tid; i < 1860; i += NTHR) rpb[i] = P.in[I_RPB][l * 1860 + i] * 1.44269504089f;
        LAS f32x2* T = (LAS f32x2*)(F.lds + TW_OFF);
        if (F.tid < 512) { const int tb = F.tid >> 7, a = F.tid & 127; const float x = tb == 0 ? (float)a / 128.0f : (tb == 1 ? (float)a / 16384.0f : (tb == 2 ? (float)a / 256.0f : (float)a / 32768.0f));
            float s, cs; sincospif(2.0f * x, &s, &cs); T[F.tid] = (f32x2){cs, -s}; }
        __syncthreads();
    }
#ifndef MIXMASK
#define MIXMASK 63
#endif
    if (MIXMASK & 1) for (int c = F.bid; c < 256; c += F.G) hyena_unit(F, P, l, ((c & 7) << 5) | (c >> 3), false);
    if (MIXDUP & 1) for (int c = F.bid; c < 256; c += F.G) hyena_unit(F, P, l, c, true);
    if (MIXMASK & 2) if (!last) for (int rep_ = 0; rep_ <= ((MIXDUP >> 1) & 1); ++rep_) for (int c = F.bid; c < 256; c += F.G) { hyena_ctx_unit(F, P, l, c); __syncthreads(); }
    const int ntile = (last ? TL : MT) / 64;
    if (MIXMASK & 4) for (int rep_ = 0; rep_ <= ((MIXDUP >> 2) & 1); ++rep_) conformer_tiles(F, P, l, (F.bid + F.G / 2) % F.G, ntile);
    if (MIXMASK & 8) for (int rep_ = 0; rep_ <= ((MIXDUP >> 3) & 1); ++rep_) for (int u = (F.bid + F.G / 4) % F.G; u < ntile; u += F.G) shortconv_unit(F, P, l, u * 64);
    const int gw = F.bid * NWAVES + F.wave, NGW = F.G * NWAVES;
    if (MIXMASK & 16) for (int rep_ = 0; rep_ <= ((MIXDUP >> 4) & 1); ++rep_) for (int task = F.bid; task < 256; task += F.G) {
        const int h = task & 3, b = task >> 7, rb = ((task >> 2) & 31) * 8;
        __syncthreads();
        attn_stage_ctx(F, b, h);
        __syncthreads();
#pragma unroll 1
        for (int it = 0; it < 4; ++it) { int wu = (b << 12) | ((rb + 2 * it + (F.wave >> 2)) << 4) | (h << 2) | (F.wave & 3); asm volatile("" : "+s"(wu));
            attn_wave_unit(F, wu, true, true); }
    }
    if (MIXMASK & 32) if (!last) for (int wu = gw; wu < 128; wu += NGW) attn_wave_unit(F, wu, false, false);
}

__global__ void __launch_bounds__(NTHR, 2) mk_fwd(Params P) {
    extern __shared__ __attribute__((aligned(16))) unsigned char lds_raw[];
    Frame F;
    const int wave0 = __builtin_amdgcn_readfirstlane(threadIdx.x >> 6);
    F.lds = (LAS unsigned char*)lds_raw; F.tid = threadIdx.x; F.lane = F.tid & 63; F.wave = __builtin_amdgcn_readfirstlane(F.tid >> 6); F.bid = blockIdx.x; F.G = gridDim.x; F.ws = P.ws;
    volatile LAS unsigned* MISC = (volatile LAS unsigned*)(F.lds + MISC_OFF);
    if (F.tid < 4) MISC[F.tid] = 0u;
    __syncthreads();
    XcdBarrier bar = xcd_barrier_post((unsigned*)(P.ws + WS_CTL) + 4096, MISC);
    const int lo = P.ph_lo, hi = P.ph_hi;
    int ph = 0;
#define PHASE_BEGIN if (ph >= lo && ph < hi) { { int t_; asm volatile("v_mbcnt_lo_u32_b32 %0, -1, 0\n\tv_mbcnt_hi_u32_b32 %0, -1, %0" : "=v"(t_)); t_ |= wave0 << 6; F.tid = t_; F.lane = t_ & 63; F.wave = __builtin_amdgcn_readfirstlane(t_ >> 6); size_t o_ = 0; asm volatile("" : "+s"(o_)); F.ws = P.ws + o_; }
#define PHASE_END   if (ph + 1 < hi) xcd_barrier(bar, F.tid); } ++ph;
#define MOD ((const float*)(F.ws + WS_MOD))
#define Hc ((const char*)(F.ws + WS_H))

    PHASE_BEGIN if (PHMASK & (1u << 0)) for (int rep_ = 0; rep_ <= (int)((DUPMASK >> 0) & 1u); ++rep_) { prologue_a(F, P); } PHASE_END
    PHASE_BEGIN if (PHMASK & (1u << 1)) for (int rep_ = 0; rep_ <= (int)((DUPMASK >> 1) & 1u); ++rep_) { phase_mod0(F, P); phase_filters(F, P, 0, true); } PHASE_END

    for (int l = 0; l < 2; ++l) {
        const bool last = (l == 1);
#define modl (MOD + (size_t)l * 3 * 9216)
#define xl ((l == 0) ? (const void*)P.in[I_X] : (const void*)P.out)
#define xc ((l == 0) ? P.in[I_CTX] : (const float*)(F.ws + WS_XC))
#define xcw ((const float*)(F.ws + WS_XC))
        PHASE_BEGIN if (PHMASK & (1u << 2)) for (int rep_ = 0; rep_ <= (int)((DUPMASK >> 2) & 1u); ++rep_) { { SchedPlain S{Hc, (const char*)(F.ws + WS_W1T) + (size_t)(l * 2 + 0) * NFF * D, 1024u, 1024u, 8, MT / 256, 22, F.G, F.bid};
            EpiFfnUp E{F.ws + WS_U}; pg8::gemm_phase<EpiFfnUp, SchedPlain, 1>(F.lds, S, E, F.tid); } } PHASE_END
        PHASE_BEGIN if (PHMASK & (1u << 3)) for (int rep_ = 0; rep_ <= (int)((DUPMASK >> 3) & 1u); ++rep_) { { SchedResid<5, 1, 6> S{(const char*)(F.ws + WS_U), (const char*)(F.ws + WS_W2T) + (size_t)(l * 2 + 0) * D * DFF, (unsigned)DFF, 22, F.G, F.bid, true, (const char*)(F.ws + WS_U) + (size_t)TL * DFF};
            EpiRes E{(bf16*)P.out, (l == 0) ? (const void*)P.in[I_X] : (const void*)(F.ws + WS_BRV), l != 0, modl + 2 * D, nullptr, 0.5f / W2_SCALE, (float*)(F.ws + WS_ES),
                (l != 0) ? (const float*)(F.ws + WS_LNS) : nullptr, P.in[I_PLG] + ((l + 1) % 2 * 3 + 2) * D, P.in[I_PLB] + ((l + 1) % 2 * 3 + 2) * D}; pg8::gemm_phase<EpiRes, SchedResid<5, 1, 6>, 1>(F.lds, S, E, F.tid); } } PHASE_END
        PHASE_BEGIN if (PHMASK & (1u << 4)) for (int rep_ = 0; rep_ <= (int)((DUPMASK >> 4) & 1u); ++rep_) { phase_ln(F, P, P.in[I_PLG] + (l * 3 + 0) * D, P.in[I_PLB] + (l * 3 + 0) * D, modl, 3, true, false, true, false, 5, 0.5f / W2_SCALE, modl + (size_t)2 * 9216 + 2 * D, nullptr, xc, true, (const bf16*)P.out); if (l == 1) phase_filters(F, P, 1, false); } PHASE_END
        PHASE_BEGIN if (PHMASK & (1u << 5)) for (int rep_ = 0; rep_ <= (int)((DUPMASK >> 5) & 1u); ++rep_) { { SchedInproj S{Hc, (const char*)(F.ws + WS_WIT) + (size_t)l * PIN * D * 2, MT / 256, F.G, F.bid};
            EpiInproj E{(const float*)(F.ws + WS_BIN) + l * PIN, F.ws};
            pg8::gemm_phase(F.lds, S, E, F.tid); } } PHASE_END
        PHASE_BEGIN if (PHMASK & (1u << 6)) for (int rep_ = 0; rep_ <= (int)((DUPMASK >> 6) & 1u); ++rep_) { phase_mixer(F, P, l, last); } PHASE_END
        const int Mx = last ? TL : MT;
        PHASE_BEGIN if (PHMASK & (1u << 7)) for (int rep_ = 0; rep_ <= (int)((DUPMASK >> 7) & 1u); ++rep_) { { SchedGateBr S{Hc, (const char*)(F.ws + WS_H8L), (const char*)(F.ws + WS_H8C), (const char*)(F.ws + WS_WIT) + ((size_t)l * PIN + NINP) * D * 2, (const char*)(F.ws + WS_BRV), (const char*)(F.ws + WS_WPT) + (size_t)l * 4 * D * 256 * 2, F.G, F.bid, !last};
            EpiGateBr E{(const float*)(F.ws + WS_BIN) + l * PIN + NINP, F.ws + WS_GS + (size_t)F.bid * 393216, (bf16*)(F.ws + WS_MG), (bf16*)(F.ws + WS_MI)}; pg8::gemm_phase<EpiGateBr, SchedGateBr, 2>(F.lds, S, E, F.tid); } } PHASE_END
        PHASE_BEGIN if (PHMASK & (1u << 8)) for (int rep_ = 0; rep_ <= (int)((DUPMASK >> 8) & 1u); ++rep_) { { SchedResid<4, 4> S{(const char*)(F.ws + WS_MG), (const char*)(F.ws + WS_WOT) + (size_t)l * D * D * 2, 2048u, 16, F.G, F.bid, !last, (const char*)(F.ws + WS_MI)};
            EpiRes E{(bf16*)(F.ws + WS_BRV), (const void*)P.out, true, modl + 5 * D, P.in[I_BOUT] + l * D, 1.0f, (float*)(F.ws + WS_ES), (const float*)(F.ws + WS_LNS), P.in[I_PLG] + (l * 3 + 0) * D, P.in[I_PLB] + (l * 3 + 0) * D}; pg8::gemm_phase(F.lds, S, E, F.tid); } } PHASE_END
        PHASE_BEGIN if (PHMASK & (1u << 9)) for (int rep_ = 0; rep_ <= (int)((DUPMASK >> 9) & 1u); ++rep_) { phase_ln(F, P, P.in[I_PLG] + (l * 3 + 1) * D, P.in[I_PLB] + (l * 3 + 1) * D, modl, 6, true, true, false, false, last ? 0 : 16, 1.0f, modl + (size_t)2 * 9216 + 5 * D, P.in[I_BOUT] + l * D, xcw, true, (const bf16*)(F.ws + WS_BRV)); } PHASE_END
        PHASE_BEGIN if (PHMASK & (1u << 10)) for (int rep_ = 0; rep_ <= (int)((DUPMASK >> 10) & 1u); ++rep_) { { SchedPlain S{Hc, (const char*)(F.ws + WS_W1T) + (size_t)(l * 2 + 1) * NFF * D, 1024u, 1024u, 8, Mx / 256, 22, F.G, F.bid};
            EpiFfnUp E{F.ws + WS_U}; pg8::gemm_phase<EpiFfnUp, SchedPlain, 1>(F.lds, S, E, F.tid); } } PHASE_END
        PHASE_BEGIN if (PHMASK & (1u << 11)) for (int rep_ = 0; rep_ <= (int)((DUPMASK >> 11) & 1u); ++rep_) { { SchedResid<5, 1, 6> S{(const char*)(F.ws + WS_U), (const char*)(F.ws + WS_W2T) + (size_t)(l * 2 + 1) * D * DFF, (unsigned)DFF, 22, F.G, F.bid, !last, (const char*)(F.ws + WS_U) + (size_t)TL * DFF};
            EpiRes E{(bf16*)(F.ws + WS_BRV), (const void*)(F.ws + WS_BRV), true, modl + 8 * D, nullptr, 0.5f / W2_SCALE, (float*)(F.ws + WS_ES), (const float*)(F.ws + WS_LNS), P.in[I_PLG] + (l * 3 + 1) * D, P.in[I_PLB] + (l * 3 + 1) * D}; pg8::gemm_phase<EpiRes, SchedResid<5, 1, 6>, 1>(F.lds, S, E, F.tid); } } PHASE_END
        PHASE_BEGIN if (PHMASK & (1u << 12)) for (int rep_ = 0; rep_ <= (int)((DUPMASK >> 12) & 1u); ++rep_) { phase_ln(F, P, P.in[I_PLG] + (l * 3 + 2) * D, P.in[I_PLB] + (l * 3 + 2) * D, MOD + (size_t)3 * 9216  , 0, !last, true, false, last, last ? 0 : 5, 0.5f / W2_SCALE, modl + (size_t)2 * 9216 + 8 * D, nullptr, xcw, !last, (const bf16*)(F.ws + WS_BRV)); } PHASE_END
    }
#undef MOD
#undef Hc
#undef modl
#undef xcw
#undef xc
#undef xl
#undef PHASE_BEGIN
#undef PHASE_END
}

#ifndef MK_N_LAUNCHES
#define MK_N_LAUNCHES 1
#endif
constexpr int N_PHASES = 2 + 2 * 11;
extern "C" void kernel_launch(void* const* d_in, const int* in_sizes, int n_in, void* d_out, int out_size, void* d_ws, size_t ws_size, hipStream_t stream) {
    static int grid = 0;
    if (grid == 0) {
        if (n_in != 33 || out_size != TL * D || ws_size < WS_TOTAL) { fprintf(stderr, "kernel_launch: unexpected shapes (n_in %d out %d ws %zu)\n", n_in, out_size, ws_size); grid = -1; return; }
        int dev = 0, cus = 0;
        if (hipGetDevice(&dev) != hipSuccess || hipDeviceGetAttribute(&cus, hipDeviceAttributeMultiprocessorCount, dev) != hipSuccess) { grid = -1; return; }
        if (hipFuncSetAttribute((const void*)mk_fwd, hipFuncAttributeMaxDynamicSharedMemorySize, LDS_BYTES) != hipSuccess) { fprintf(stderr, "kernel_launch: hipFuncSetAttribute failed\n"); grid = -1; return; }
        int per_cu = 0;
        if (hipOccupancyMaxActiveBlocksPerMultiprocessor(&per_cu, (const void*)mk_fwd, NTHR, LDS_BYTES) != hipSuccess || per_cu < 1) fprintf(stderr, "kernel_launch: occupancy query says %d\n", per_cu);
        (void)hipGetLastError();
        grid = cus;
    }
    if (grid < 0) return;
    (void)hipMemsetAsync((char*)d_ws + WS_CTL, 0, CTL_BYTES, stream);
    Params p{};
    for (int i = 0; i < 33; ++i) p.in[i] = (const float*)d_in[i];
    p.out = (float*)d_out; p.ws = (unsigned char*)d_ws;
#if MK_N_LAUNCHES == 1
    p.ph_lo = 0; p.ph_hi = N_PHASES;
    hipLaunchKernelGGL(mk_fwd, dim3(grid), dim3(NTHR), LDS_BYTES, stream, p);
#else
    for (int i = 0; i < N_PHASES; ++i) { p.ph_lo = i; p.ph_hi = i + 1; hipLaunchKernelGGL(mk_fwd, dim3(grid), dim3(NTHR), LDS_BYTES, stream, p); }
#endif
}
```

```cpp
#include <hip/hip_runtime.h>
#include <cstdio>
#include <cstdint>

#ifndef PHMASK
#define PHMASK 0xFFFFu
#endif
#ifndef DUPMASK
#define DUPMASK 0u
#endif
#ifndef FFTPROBE
#define FFTPROBE 0
#endif
#ifndef EPIDUP
#define EPIDUP 0
#endif
#ifndef MIXDUP
#define MIXDUP 0
#endif
#define LAS __attribute__((address_space(3)))
typedef unsigned short bf16;
typedef short bf16x8 __attribute__((ext_vector_type(8)));
typedef float f32x4 __attribute__((ext_vector_type(4)));
typedef float f32x2 __attribute__((ext_vector_type(2)));
typedef unsigned u32x4 __attribute__((ext_vector_type(4)));
typedef unsigned u32x2 __attribute__((ext_vector_type(2)));

constexpr int D = 1024, SEQ = 16384, TL = 32768, CTXL = 256, TC = 512, MT = TL + TC;
constexpr int DFF = 2816, NFF = 2 * DFF, PIN = 6912, NINP = 2816, NMOD = 9;
constexpr int WA = 256;
constexpr float LN_EPS = 1e-5f, ALPHA = 1.41421356237f, ATT_SCALE = 0.125f;
constexpr int NWAVES = 8, NTHR = 512;

constexpr size_t MiB = 1u << 20;
constexpr size_t WS_CTL = 0, CTL_BYTES = 1 * MiB;
constexpr size_t WS_MOD = 1 * MiB;
constexpr size_t WS_BIN = WS_MOD + 256 * 1024;
constexpr size_t WS_W3T = WS_BIN + 64 * 1024;
constexpr size_t WS_XC = 2 * MiB;
constexpr size_t WS_W1T = 4 * MiB;
constexpr size_t WS_W2T = WS_W1T + (size_t)4 * NFF * D * 2;
constexpr size_t WS_WIT = WS_W2T + (size_t)4 * D * DFF * 2;
constexpr size_t WS_WPT = WS_WIT + (size_t)2 * PIN * D * 2;
constexpr size_t WS_WOT = WS_WPT + (size_t)8 * D * 256 * 2;
constexpr size_t WS_H = WS_WOT + (size_t)2 * D * D * 2;
constexpr size_t WS_BRV = WS_H + (size_t)MT * D * 2;
constexpr size_t WS_FILT = WS_BRV + (size_t)MT * D * 2;
constexpr size_t WS_FILTC = WS_FILT + (size_t)4 * 256 * SEQ * 4;
constexpr size_t WS_H8L = WS_FILT + 32 * MiB;
constexpr size_t WS_LNS = WS_CTL + 64 * 1024;
constexpr size_t WS_H8C = WS_CTL + 512 * 1024;
constexpr size_t WS_U = WS_FILTC + (size_t)4 * 256 * 256 * 4;
constexpr size_t SZ256 = (size_t)MT * 256 * 2;
constexpr size_t WS_UA = WS_U, WS_Q = WS_U + SZ256, WS_K = WS_U + 2 * SZ256, WS_SB = WS_U + 3 * SZ256, WS_W = WS_U + 4 * SZ256;
constexpr size_t WS_VT = WS_U + 5 * SZ256;
constexpr size_t WS_HT = WS_U + 6 * SZ256;
constexpr size_t WS_KSCR = WS_U + 9 * SZ256;
constexpr size_t WS_MG = WS_U;
constexpr size_t WS_GS = WS_U + 4 * SZ256;
constexpr size_t WS_MI = WS_GS + (size_t)256 * 393216;
constexpr size_t WS_END = WS_U + (size_t)MT * DFF * 2;
static_assert(WS_KSCR + (size_t)256 * 131072 <= WS_END, "kscr");
static_assert(WS_MI + (size_t)4 * TC * D * 2 <= WS_END, "gs/mi");
constexpr size_t WS_ES = WS_END;
constexpr size_t WS_TOTAL = WS_ES + (size_t)256 * 131072;
static_assert(WS_TOTAL <= 512 * MiB, "ws");
static_assert(WS_BIN + 2 * PIN * 4 <= WS_W3T && WS_W3T + 2 * 1024 * 64 * 2 <= WS_XC && WS_MOD + 2 * 3 * 9216 * 4 <= WS_BIN, "small");

constexpr int RING_BYTES = 131072;
constexpr int FFT_BYTES = 133120;
constexpr int TW_OFF = FFT_BYTES;
constexpr int RPB_OFF = TW_OFF + 4096;
constexpr int RED_OFF = RPB_OFF + 7680;
constexpr int MISC_OFF = RED_OFF + 256;
constexpr int LDS_BYTES = 147456;
static_assert(MISC_OFF + 64 <= LDS_BYTES, "lds");

typedef __bf16 bf16x2_t __attribute__((ext_vector_type(2)));
__device__ __forceinline__ unsigned cvt_pk_bf16(float lo, float hi) { const f32x2 v = {lo, hi}; const bf16x2_t b = __builtin_convertvector(v, bf16x2_t); return __builtin_bit_cast(unsigned, b); }
typedef int v8i __attribute__((ext_vector_type(8)));
typedef int i32x4 __attribute__((ext_vector_type(4)));
__device__ __forceinline__ float sat8(float x) { return __builtin_amdgcn_fmed3f(x, -448.0f, 448.0f); }
__device__ __forceinline__ unsigned pk_fp8x4(float a, float b, float c, float d) { int p = 0; p = __builtin_amdgcn_cvt_pk_fp8_f32(sat8(a), sat8(b), p, false); p = __builtin_amdgcn_cvt_pk_fp8_f32(sat8(c), sat8(d), p, true); return (unsigned)p; }
constexpr float W1_SCALE = 32.0f, W2_SCALE = 64.0f;
__device__ __forceinline__ float bf2f(unsigned short b) { return __uint_as_float(((unsigned)b) << 16); }
__device__ __forceinline__ float bflo(unsigned w) { return __uint_as_float(w << 16); }
__device__ __forceinline__ float bfhi(unsigned w) { return __uint_as_float(w & 0xffff0000u); }
__device__ __forceinline__ float sigmoidf_(float x) { return __builtin_amdgcn_rcpf(1.0f + __builtin_amdgcn_exp2f(x * -1.44269504089f)); }
__device__ __forceinline__ float siluf_(float x) { return x * __builtin_amdgcn_rcpf(1.0f + __builtin_amdgcn_exp2f(x * -1.44269504089f)); }
__device__ __forceinline__ int lane_now() { int l_; asm volatile("v_mbcnt_lo_u32_b32 %0, -1, 0\n\tv_mbcnt_hi_u32_b32 %0, -1, %0" : "=v"(l_)); return l_; }
__device__ __forceinline__ float xrow_max(float v) {
    const unsigned a = __builtin_bit_cast(unsigned, v); auto r = __builtin_amdgcn_permlane16_swap(a, a, false, false);
    v = fmaxf(__builtin_bit_cast(float, (unsigned)r[0]), __builtin_bit_cast(float, (unsigned)r[1]));
    const unsigned b = __builtin_bit_cast(unsigned, v); auto q = __builtin_amdgcn_permlane32_swap(b, b, false, false);
    return fmaxf(__builtin_bit_cast(float, (unsigned)q[0]), __builtin_bit_cast(float, (unsigned)q[1]));
}
__device__ __forceinline__ float xrow_sum(float v) {
    const unsigned a = __builtin_bit_cast(unsigned, v); auto r = __builtin_amdgcn_permlane16_swap(a, a, false, false);
    v = __builtin_bit_cast(float, (unsigned)r[0]) + __builtin_bit_cast(float, (unsigned)r[1]);
    const unsigned b = __builtin_bit_cast(unsigned, v); auto q = __builtin_amdgcn_permlane32_swap(b, b, false, false);
    return __builtin_bit_cast(float, (unsigned)q[0]) + __builtin_bit_cast(float, (unsigned)q[1]);
}
__device__ __forceinline__ float shx(float v, int o, int lane) { return __builtin_bit_cast(float, __builtin_amdgcn_ds_bpermute((lane ^ o) << 2, __builtin_bit_cast(int, v))); }
#define DPP_F(v_, ctrl_) __builtin_bit_cast(float, __builtin_amdgcn_update_dpp(0, __builtin_bit_cast(int, (v_)), (ctrl_), 0xF, 0xF, true))
__device__ __forceinline__ float wave_sum(float v) {
    v += DPP_F(v, 0xB1);
    v += DPP_F(v, 0x4E);
    v += DPP_F(v, 0x141);
    v += DPP_F(v, 0x140);
    const int iv = __builtin_bit_cast(int, v);
    const float r0 = __builtin_bit_cast(float, __builtin_amdgcn_readlane(iv, 0)), r1 = __builtin_bit_cast(float, __builtin_amdgcn_readlane(iv, 16)),
                r2 = __builtin_bit_cast(float, __builtin_amdgcn_readlane(iv, 32)), r3 = __builtin_bit_cast(float, __builtin_amdgcn_readlane(iv, 48));
    return (r0 + r1) + (r2 + r3);
}
#define LDS_WAIT() asm volatile("s_waitcnt lgkmcnt(0)" ::: "memory")

#define XB_TMO      128
#define XB_XCNT(j)  (256  + 64 * (j))
#define XB_XSUB(j)  (1280 + 64 * (j))
#define XB_XGEN(j)  (2304 + 64 * (j))
#define XB_TOP      3328
#define XB_TOPGEN   3392
#define XCD_BAR_WORDS 3456
#define XB_SPIN_CAP (1u << 20)
__device__ __forceinline__ unsigned xb_ld(unsigned* p)              { return __hip_atomic_load(p, __ATOMIC_RELAXED, __HIP_MEMORY_SCOPE_AGENT); }
__device__ __forceinline__ unsigned xb_add(unsigned* p, unsigned v) { return __hip_atomic_fetch_add(p, v, __ATOMIC_RELAXED, __HIP_MEMORY_SCOPE_AGENT); }
__device__ __forceinline__ unsigned xb_xcc_id() { return (unsigned)__builtin_amdgcn_s_getreg((3 << 11) | 20) & 0xFu; }
#define XB_SPIN(cond, bar) do { unsigned _sp = 0; while (cond) { __builtin_amdgcn_s_sleep(1); \
    if ((++_sp & 255u) == 0u) { if (xb_ld(&(bar)[XB_TMO])) break; if (_sp > XB_SPIN_CAP) { atomicAdd(&(bar)[XB_TMO], 1u); break; } } } } while (0)
struct XcdBarrier { unsigned* bar; unsigned x; volatile LAS unsigned* st; };
__device__ __forceinline__ XcdBarrier xcd_barrier_post(unsigned* bar, volatile LAS unsigned* st) {
    XcdBarrier b; b.bar = bar; b.x = xb_xcc_id(); b.st = st;
    if (threadIdx.x == 0) (void)xb_add(&bar[XB_XCNT(b.x)], 1u);
    return b;
}
__device__ __forceinline__ void xcd_barrier_complete(unsigned* bar, unsigned x, unsigned& nloc, unsigned& nx) {
    const unsigned G = gridDim.x * gridDim.y * gridDim.z;
    unsigned sum, cnt, mine, sp = 0u;
    for (;;) {
        sum = 0u; cnt = 0u; mine = 0u;
#pragma unroll
        for (unsigned j = 0; j < 16; ++j) { const unsigned c = xb_ld(&bar[XB_XCNT(j)]); sum += c; cnt += (c > 0u) ? 1u : 0u; mine = (j == x) ? c : mine; }
        if (sum == G) break;
        __builtin_amdgcn_s_sleep(1);
        if ((++sp & 255u) == 0u) { if (xb_ld(&bar[XB_TMO])) break; if (sp > XB_SPIN_CAP) { atomicAdd(&bar[XB_TMO], 1u); break; } }
    }
    nloc = mine > 0u ? mine : 1u; nx = cnt > 0u ? cnt : 1u;
}
__device__ __forceinline__ void xcd_barrier(const XcdBarrier& b, int tid) {
    asm volatile("s_waitcnt vmcnt(0)" ::: "memory");
    __syncthreads();
    if (tid == 0) {
        unsigned* bar = b.bar;
        __builtin_amdgcn_s_waitcnt(0);
        unsigned nloc = b.st[0], nx = b.st[1];
        if (nloc == 0u) { xcd_barrier_complete(bar, b.x, nloc, nx); b.st[0] = nloc; b.st[1] = nx; }
        const unsigned old = xb_add(&bar[XB_XSUB(b.x)], 1u);
        const unsigned gen = old / nloc;
        if (old + 1u == (gen + 1u) * nloc) {
            __builtin_amdgcn_fence(__ATOMIC_RELEASE, "agent");
            asm volatile("s_waitcnt vmcnt(0)" ::: "memory");
            const unsigned og = xb_add(&bar[XB_TOP], 1u);
            const unsigned tg = og / nx;
            if (og + 1u == (tg + 1u) * nx) xb_add(&bar[XB_TOPGEN], 1u);
            else XB_SPIN(xb_ld(&bar[XB_TOPGEN]) == tg, bar);
            __builtin_amdgcn_fence(__ATOMIC_ACQUIRE, "agent");
            xb_add(&bar[XB_XGEN(b.x)], 1u);
            asm volatile("s_waitcnt vmcnt(0)" ::: "memory");
        } else {
            XB_SPIN(xb_ld(&bar[XB_XGEN(b.x)]) == gen, bar);
            __builtin_amdgcn_fence(__ATOMIC_ACQUIRE, "agent");
            asm volatile("s_waitcnt vmcnt(0)" ::: "memory");
        }
    }
    __syncthreads();
}

namespace pg8 {
constexpr int BM = 256, BK = 64, HALF = 128, HTB = HALF * BK * 2, NXCD = 8, WGM = 8;
__host__ __device__ __forceinline__ int lds_byte(int r, int c) { const int st = (r >> 4) * 2 + (c >> 5), rr = r & 15, cc = c & 31, ob = rr * 64 + cc * 2; return st * 1024 + (ob ^ (((ob >> 9) & 1) << 5)); }
__host__ __device__ __forceinline__ void stage_rc(int b, int& R, int& C) { const int st = b / 1024, sb = b % 1024, swz = sb ^ (((sb >> 9) & 1) << 5); R = (st >> 1) * 16 + swz / 64; C = (st & 1) * 32 + (swz % 64) / 2; }
__host__ __device__ __forceinline__ int perm32(int rho) { const int n = rho >> 4, i = rho & 15; return 8 * (i >> 2) + 4 * n + (i & 3); }

struct GUnit { const char* A; const char* B; unsigned lda, ldb; int nt; int pm, pn, kind; bool f8; };

__device__ __forceinline__ bool static_tile(int i, int G, int c, int nM, int nN, int& pm, int& pn) {
    const int nwg = nM * nN; const long L = (long)i * G + c; if (L >= nwg) return false;
    int wgid = (int)L; { const int q = nwg / NXCD, r = nwg % NXCD, xcd = wgid % NXCD, off = wgid / NXCD; wgid = (xcd < r ? xcd * (q + 1) : r * (q + 1) + (xcd - r) * q) + off; }
    const int nig = WGM * nN, gid = wgid / nig, fm = gid * WGM, gsz = (nM - fm) < WGM ? (nM - fm) : WGM;
    pm = fm + ((wgid % nig) % gsz); pn = (wgid % nig) / gsz; return true;
}

template <class Epi, class Sched, int F8M = 0  >
__device__ __forceinline__ void gemm_phase(LAS unsigned char* lds, const Sched& S, const Epi& E, int tid_in) {
    int tid_ = tid_in; asm volatile("" : "+v"(tid_));
    const int tid = tid_, wid = __builtin_amdgcn_readfirstlane(tid >> 6), lane = tid & 63, wr = wid >> 2, wc = wid & 3, fr = lane & 15, fq = lane >> 4;
    unsigned RA[2], RB[2], CC[2];
#pragma unroll
    for (int i = 0; i < 2; ++i) { int R, C; stage_rc(tid * 16 + i * 8192, R, C); RA[i] = (unsigned)R; RB[i] = (unsigned)((R & ~31) + perm32(R & 31)); CC[i] = (unsigned)C * 2u; }
    const size_t kstep = (size_t)(BK * 2);
    const unsigned ldsw = (unsigned)wid * 1024u;
#define PG8_SA(b, h) (((b) * 2 + (h)) * HTB)
#define PG8_SB(b, h) ((4 + (b) * 2 + (h)) * HTB)
#define PG8_STAGE(bufoff, gbase, RR, ld) do { _Pragma("unroll") for (int _i = 0; _i < 2; ++_i) \
        __builtin_amdgcn_global_load_lds((const unsigned*)((const char*)(gbase) + ((RR)[_i] * (ld) + CC[_i])), (LAS unsigned*)(lds + (bufoff) + ldsw + _i * 8192), 16, 0, 0); } while (0)
#define PG8_LDA(F8C, dst, b, h) do { _Pragma("unroll") for (int m = 0; m < 4; ++m) { dst[m][0] = *(const LAS i32x4*)(lds + PG8_SA(b, h) + ao0 + m * 2048); dst[m][1] = *(const LAS i32x4*)(lds + PG8_SA(b, h) + ao1 + m * 2048); } } while (0)
#define PG8_LDB(F8C, dst, b, h) do { _Pragma("unroll") for (int n = 0; n < 2; ++n) { dst[n][0] = *(const LAS i32x4*)(lds + PG8_SB(b, h) + bo0 + n * 2048); dst[n][1] = *(const LAS i32x4*)(lds + PG8_SB(b, h) + bo1 + n * 2048); } } while (0)
#define PG8_V8(x) __builtin_shufflevector((x)[0], (x)[1], 0, 1, 2, 3, 4, 5, 6, 7)
#define PG8_MMA(F8C, ai, bj, At, Bt) do { __builtin_amdgcn_s_setprio(1); if constexpr (F8C) { _Pragma("unroll") for (int m = 0; m < 4; ++m) _Pragma("unroll") for (int n = 0; n < 2; ++n) \
            { const v8i b8_ = PG8_V8(Bt[n]), a8_ = PG8_V8(At[m]); asm volatile("v_mfma_scale_f32_16x16x128_f8f6f4 %0, %1, %2, %0, %3, %3 op_sel_hi:[0,0,0]" : "+v"(acc[ai][bj][m][n]) : "v"(b8_), "v"(a8_), "v"(one_scale)); } } \
        else { _Pragma("unroll") for (int m = 0; m < 4; ++m) _Pragma("unroll") for (int n = 0; n < 2; ++n) _Pragma("unroll") for (int k = 0; k < 2; ++k) \
            acc[ai][bj][m][n] = __builtin_amdgcn_mfma_f32_16x16x32_bf16(__builtin_bit_cast(bf16x8, Bt[n][k]), __builtin_bit_cast(bf16x8, At[m][k]), acc[ai][bj][m][n], 0, 0, 0); } __builtin_amdgcn_s_setprio(0); } while (0)
#define PG8_TRIP(F8C, WN) { \
            const bool last = (t == nt - 2); \
            const char* a1 = cA + (size_t)(t + 1) * kstep; \
            const char* a2 = last ? nA : cA + (size_t)(t + 2) * kstep; const char* b2 = last ? nB : cB + (size_t)(t + 2) * kstep; \
            const char* a3 = a2 + kstep; const char* b3 = b2 + kstep; \
            const unsigned xldA = last ? nldA : ldA, xldB = last ? nldB : ldB; const size_t xhsA = last ? nhsA : hsA, xhsB = last ? nhsB : hsB; \
            PG8_LDB(F8C, B0, 0, 0); PG8_LDB(F8C, B1, 0, 1); PG8_SCHED; PG8_LDA(F8C, At, 0, 0); PG8_STAGE(PG8_SA(1, 1), a1 + hsA, RA, ldA); \
            PG8_WAIT_V(WN); PG8_WAIT_L(0); PG8_BAR; PG8_MMA(F8C, 0, 0, At, B0); PG8_MMA(F8C, 0, 1, At, B1); PG8_BAR; PG8_SCHED; \
            PG8_LDA(F8C, At, 0, 1); PG8_STAGE(PG8_SB(0, 0), b2, RB, xldB); PG8_STAGE(PG8_SB(0, 1), b2 + xhsB, RB, xldB); PG8_STAGE(PG8_SA(0, 0), a2, RA, xldA); \
            PG8_WAIT_V(WN); PG8_WAIT_L(0); PG8_BAR; PG8_MMA(F8C, 1, 0, At, B0); PG8_MMA(F8C, 1, 1, At, B1); PG8_BAR; PG8_SCHED; \
            PG8_LDB(F8C, B0, 1, 0); PG8_LDB(F8C, B1, 1, 1); PG8_SCHED; PG8_LDA(F8C, At, 1, 0); PG8_STAGE(PG8_SA(0, 1), a2 + xhsA, RA, xldA); \
            PG8_WAIT_V(8); PG8_WAIT_L(0); PG8_BAR; PG8_MMA(F8C, 0, 0, At, B0); PG8_MMA(F8C, 0, 1, At, B1); PG8_BAR; PG8_SCHED; \
            PG8_LDA(F8C, At, 1, 1); PG8_STAGE(PG8_SB(1, 0), b3, RB, xldB); PG8_STAGE(PG8_SB(1, 1), b3 + xhsB, RB, xldB); PG8_STAGE(PG8_SA(1, 0), a3, RA, xldA); \
            PG8_WAIT_V(8); PG8_WAIT_L(0); PG8_BAR; PG8_MMA(F8C, 1, 0, At, B0); PG8_MMA(F8C, 1, 1, At, B1); PG8_BAR; PG8_SCHED; \
        }
#define PG8_KLOOP(F8C) const int ln_ = lane_now();   \
        const int fr_ = ln_ & 15, fq_ = ln_ >> 4; \
        const int ao0 = lds_byte(wr * 64 + fr_, (F8C) ? 16 * fq_ : 8 * fq_), ao1 = (F8C) ? lds_byte(wr * 64 + fr_, 16 * fq_ + 8) : ao0 + 1024; \
        const int bo0 = lds_byte(wc * 32 + fr_, (F8C) ? 16 * fq_ : 8 * fq_), bo1 = (F8C) ? lds_byte(wc * 32 + fr_, 16 * fq_ + 8) : bo0 + 1024; \
        int t = 0; \
        if constexpr (Epi::NST == 8) { if (ui > 0) { PG8_TRIP(F8C, 16) t = 2; } } \
        for (; t < nt; t += 2) PG8_TRIP(F8C, 8)
#define PG8_WAIT_V(n) asm volatile("s_waitcnt vmcnt(" #n ")" ::: "memory")
#define PG8_WAIT_L(n) asm volatile("s_waitcnt lgkmcnt(" #n ")" ::: "memory")
#define PG8_BAR __builtin_amdgcn_s_barrier()
#define PG8_SCHED __builtin_amdgcn_sched_barrier(0)
    GUnit cur, nxt; int ui = 0;
    if (!S.next(0, cur)) return;
    f32x4 acc[2][2][4][2];
#pragma unroll
    for (int a = 0; a < 2; ++a)
#pragma unroll
        for (int b = 0; b < 2; ++b)
#pragma unroll
            for (int m = 0; m < 4; ++m)
#pragma unroll
                for (int n = 0; n < 2; ++n) acc[a][b][m][n] = (f32x4){0.f, 0.f, 0.f, 0.f};
    i32x4 At[4][2], B0[2][2], B1[2][2];
    int one_scale = 0x7F7F7F7F; asm volatile("" : "+v"(one_scale));
    const char* cA = cur.A; const char* cB = cur.B;
    unsigned ldA = cur.lda, ldB = cur.ldb; size_t hsA = (size_t)HALF * ldA, hsB = (size_t)HALF * ldB;
    PG8_STAGE(PG8_SB(0, 0), cB, RB, ldB); PG8_STAGE(PG8_SB(0, 1), cB + hsB, RB, ldB); PG8_STAGE(PG8_SA(0, 0), cA, RA, ldA); PG8_STAGE(PG8_SA(0, 1), cA + hsA, RA, ldA);
    if (wr == 1) PG8_BAR;
    PG8_WAIT_V(2); PG8_BAR;
    PG8_STAGE(PG8_SB(1, 0), cB + kstep, RB, ldB); PG8_STAGE(PG8_SA(1, 0), cA + kstep, RA, ldA); PG8_STAGE(PG8_SB(1, 1), cB + hsB + kstep, RB, ldB);
    PG8_WAIT_V(6); PG8_BAR;
    for (;;) {
        const bool has_next = S.next(ui + 1, nxt);
        const char* nA = has_next ? nxt.A : cA; const char* nB = has_next ? nxt.B : cB;
        const unsigned nldA = has_next ? nxt.lda : ldA, nldB = has_next ? nxt.ldb : ldB;
        const size_t nhsA = (size_t)HALF * nldA, nhsB = (size_t)HALF * nldB;
        const int nt = cur.nt;
        if constexpr (F8M == 2) { if (cur.f8) { PG8_KLOOP(true) } else { PG8_KLOOP(false) } }
        else if constexpr (F8M == 1) { PG8_KLOOP(true) }
        else { PG8_KLOOP(false) }
        if (wr == 0) PG8_BAR;
        if constexpr (F8M != 0) asm volatile("s_nop 15\n\ts_nop 15" ::: "memory");
        { const int le_ = lane_now(); E(acc, cur, (wid << 6) | le_, wr, wc, le_ & 15, le_ >> 4); }
        if (!has_next) break;
#pragma unroll
        for (int a = 0; a < 2; ++a)
#pragma unroll
            for (int b = 0; b < 2; ++b)
#pragma unroll
                for (int m = 0; m < 4; ++m)
#pragma unroll
                    for (int n = 0; n < 2; ++n) acc[a][b][m][n] = (f32x4){0.f, 0.f, 0.f, 0.f};
        cur = nxt; cA = nA; cB = nB; hsA = nhsA; hsB = nhsB; ldA = nldA; ldB = nldB; ++ui;
        if (wr == 1) PG8_BAR;
    }
    PG8_WAIT_V(0);
    PG8_BAR;
#undef PG8_SA
#undef PG8_SB
#undef PG8_STAGE
#undef PG8_LDA
#undef PG8_KLOOP
#undef PG8_TRIP
#undef PG8_V8
#undef PG8_LDB
#undef PG8_MMA
#undef PG8_WAIT_V
#undef PG8_WAIT_L
#undef PG8_BAR
#undef PG8_SCHED
}
}
using pg8::GUnit;
typedef f32x4 Acc[2][2][4][2];

struct Params {
    const float* in[33];
    float* out;
    unsigned char* ws;
    int ph_lo, ph_hi;
};
enum { I_X = 0, I_C, I_CTX, I_CCTX, I_WMOD, I_BMOD, I_PLG, I_PLB, I_FWI, I_FWO, I_WIN, I_BIN, I_CDW, I_CDB, I_CLG, I_CLB, I_CWP, I_RPB, I_NWP, I_SCW, I_SWP,
       I_HSW, I_HSB, I_HW1, I_HB1, I_HW2, I_HB2, I_HFQ, I_HW3, I_HBI, I_HWP, I_WOUT, I_BOUT };

__device__ __forceinline__ int row_grp(int pm) { return pm < 64 ? 0 : (pm < 128 ? 1 : 2); }

struct SchedPlain {
    const char* A; const char* B; unsigned lda, ldb; int nt, nM, nN, G, c;
    __device__ __forceinline__ bool next(int i, GUnit& u) const {
        int pm, pn; if (!pg8::static_tile(i, G, c, nM, nN, pm, pn)) return false;
        u.A = A + (size_t)pm * 256 * lda; u.B = B + (size_t)pn * 256 * ldb; u.lda = lda; u.ldb = ldb; u.nt = nt; u.pm = pm; u.pn = pn; u.kind = 0; u.f8 = true; return true;
    }
};
template <int NKS, int NSRC, int NTLAST = 4> struct SchedResid {
    const char* A; const char* B; unsigned ld; int nt, G, c; bool ctx; const char* Ac;
    __device__ __forceinline__ bool next(int i, GUnit& u) const {
        int pm, pn; u.lda = ld; u.ldb = ld; u.f8 = true;
        if (pg8::static_tile(i, G, c, TL / 256, 4, pm, pn)) { u.A = A + (size_t)pm * 256 * ld; u.B = B + (size_t)pn * 256 * ld; u.nt = nt; u.pm = pm; u.pn = pn; u.kind = 0; return true; }
        constexpr int NK = NKS * NSRC;
        const int j = i * G + c - (TL / 256) * 4; if (!ctx || j < 0 || j >= 8 * NK) return false;
        const int panel = j / (4 * NK), rem = j % (4 * NK), kk = rem % NK, src = kk / NKS, ks = kk % NKS; pn = rem / NK;
        u.A = Ac + ((size_t)src * TC + panel * 256) * ld + ks * 512; u.B = B + (size_t)pn * 256 * ld + ks * 512; u.nt = (ks == NKS - 1) ? NTLAST : 4; u.pm = TL / 256 + panel; u.pn = pn; u.kind = 1 + kk; return true;
    }
};
enum { KI_GLU = 0, KI_PLAIN = 1, KI_PAIR = 2, KI_TRANS = 3 };
struct SchedInproj {
    const char* H; const char* W; int nM, G, c;
    __device__ __forceinline__ bool next(int i, GUnit& u) const {
        int pm, pn; if (!pg8::static_tile(i, G, c, nM, 11, pm, pn)) return false;
        const char* a = H + (size_t)pm * 256 * 2048; const char* b = W + (size_t)pn * 256 * 2048;
        const bool tr = (pn == 4) || (pn >= 8);
        u.A = tr ? b : a; u.B = tr ? a : b; u.lda = 2048; u.ldb = 2048; u.nt = 16; u.pm = pm; u.pn = pn;
        u.f8 = false; u.kind = tr ? KI_TRANS : (pn < 2 ? KI_GLU : (pn == 6 || pn == 7 ? KI_PAIR : KI_PLAIN)); return true;
    }
};
struct SchedGateBr {
    const char* HB  ; const char* H; const char* HC  ; const char* WG  ; const char* BR; const char* WP; int G, c; bool ctx;
    __device__ __forceinline__ bool next(int i, GUnit& u) const {
        int pm, pn, j, br;
        if (pg8::static_tile(i >> 3, G, c, TL / 256, 4, pm, pn)) { j = i & 7; br = j >> 1; }
        else {
            const int ntl = ((TL / 256) * 4 - c + G - 1) / G, e = i - 8 * ntl;
            if (!ctx || c >= 32 || e < 0 || e > 1) return false;
            pm = TL / 256 + (c >> 4); pn = (c >> 2) & 3; br = c & 3; j = 8 + 2 * br + e;
        }
        if ((j & 1) == 0 && br == 3) { u.A = HB + (size_t)pm * 256 * 2048; u.B = WG + 4 * MiB + (size_t)(pn * 256) * 2048; u.lda = 2048; u.ldb = 2048; u.nt = 16; u.f8 = false; }
        else if ((j & 1) == 0) { u.A = (pm < TL / 256) ? H + (size_t)pm * 256 * 1024 : HC + (size_t)(pm - TL / 256) * 256 * 1024; u.B = WG + (size_t)(br * 1024 + pn * 256) * 1024; u.lda = 1024; u.ldb = 1024; u.nt = 8; u.f8 = true; }
        else { u.A = BR + (size_t)br * SZ256 + (size_t)pm * 256 * 512; u.B = WP + (size_t)(br * 1024 + pn * 256) * 512; u.lda = 512; u.ldb = 512; u.nt = 4; u.f8 = false; }
        u.pm = pm; u.pn = pn; u.kind = j; return true;
    }
};

struct EpiFfnUp {
    static constexpr bool DUP_OK = true; static constexpr int NST = 8;
    unsigned char* U;
    __device__ __forceinline__ void operator()(const Acc& acc, const GUnit& u, int tid, int wr, int wc, int fr, int fq) const {
        const int row0 = u.pm * 256 + wr * 64 + fr, col0 = u.pn * 128 + wc * 32 + 8 * fq;
        constexpr float IS = 1.0f / W1_SCALE;
#pragma unroll
        for (int ai = 0; ai < 2; ++ai)
#pragma unroll
            for (int m = 0; m < 4; ++m) {
                const f32x4 a0 = acc[ai][0][m][0] * IS, a1 = acc[ai][0][m][1] * IS, g0 = acc[ai][1][m][0] * IS, g1 = acc[ai][1][m][1] * IS;
                u32x2 w; w.x = pk_fp8x4(siluf_(g0[0]) * a0[0], siluf_(g0[1]) * a0[1], siluf_(g0[2]) * a0[2], siluf_(g0[3]) * a0[3]);
                w.y = pk_fp8x4(siluf_(g1[0]) * a1[0], siluf_(g1[1]) * a1[1], siluf_(g1[2]) * a1[2], siluf_(g1[3]) * a1[3]);
                *(u32x2*)(U + (size_t)(row0 + ai * 128 + m * 16) * DFF + col0) = w;
            }
    }
};
struct EpiRes {
    static constexpr bool DUP_OK = false; static constexpr int NST = 0;
    bf16* V; const void* xl; bool xbf  ; const float* modl  ; const float* bias; float coef; float* part;
    const float* xstat; const float* xg; const float* xbt;
    __device__ __forceinline__ void operator()(const Acc& acc, const GUnit& u, int tid, int wr, int wc, int fr, int fq) const {
        int row0 = u.pm * 256 + wr * 64 + fr, colt = u.pn * 256 + wc * 32 + 8 * fq; asm volatile("" : "+v"(row0), "+v"(colt));
        if (u.kind != 0) {
            float* pp = part + ((size_t)(u.kind - 1) * TC + (row0 - TL)) * D + colt;
#pragma unroll
            for (int ai = 0; ai < 2; ++ai)
#pragma unroll
                for (int m = 0; m < 4; ++m)
#pragma unroll
                    for (int bj = 0; bj < 2; ++bj) { float* q = pp + (size_t)(ai * 128 + m * 16) * D + bj * 128; *(f32x4*)q = acc[ai][bj][m][0]; *(f32x4*)(q + 4) = acc[ai][bj][m][1]; }
            return;
        }
        if (xstat) body_ln(acc, u, row0, colt); else if (xbf) body<true>(acc, u, row0, colt); else body<false>(acc, u, row0, colt);
    }
    template <bool XB> __device__ __forceinline__ void body(const Acc& acc, const GUnit& u, int row0, int colt) const {
        const float* mv = modl + (size_t)row_grp(u.pm) * 9216;
        f32x4 sc[2][2], bv[2][2];
#pragma unroll
        for (int bj = 0; bj < 2; ++bj)
#pragma unroll
            for (int n = 0; n < 2; ++n) { sc[bj][n] = *(const f32x4*)(mv + colt + bj * 128 + 4 * n) * coef;
                bv[bj][n] = bias ? *(const f32x4*)(bias + colt + bj * 128 + 4 * n) : (f32x4){0.f, 0.f, 0.f, 0.f}; }
#pragma unroll
        for (int ai = 0; ai < 2; ++ai) {
            bf16* vp = V + (size_t)(row0 + ai * 128) * D + colt;
            if constexpr (XB) {
                const bf16* xh = (const bf16*)xl + (size_t)(row0 + ai * 128) * D + colt;
                u32x4 xw[4][2];
#pragma unroll
                for (int m = 0; m < 4; ++m)
#pragma unroll
                    for (int bj = 0; bj < 2; ++bj) xw[m][bj] = *(const u32x4*)(xh + (size_t)(m * 16) * D + bj * 128);
#pragma unroll
                for (int m = 0; m < 4; ++m)
#pragma unroll
                    for (int bj = 0; bj < 2; ++bj) { const u32x4 w_ = xw[m][bj];
                        const f32x4 x0 = (f32x4){bflo(w_.x), bfhi(w_.x), bflo(w_.y), bfhi(w_.y)}, x1 = (f32x4){bflo(w_.z), bfhi(w_.z), bflo(w_.w), bfhi(w_.w)};
                        const f32x4 v0 = x0 * ALPHA + sc[bj][0] * (acc[ai][bj][m][0] + bv[bj][0]), v1 = x1 * ALPHA + sc[bj][1] * (acc[ai][bj][m][1] + bv[bj][1]);
                        u32x4 w; w.x = cvt_pk_bf16(v0[0], v0[1]); w.y = cvt_pk_bf16(v0[2], v0[3]); w.z = cvt_pk_bf16(v1[0], v1[1]); w.w = cvt_pk_bf16(v1[2], v1[3]);
                        *(u32x4*)(vp + (size_t)(m * 16) * D + bj * 128) = w; }
            } else {
                const float* xb = (const float*)xl + (size_t)(row0 + ai * 128) * D + colt;
#pragma unroll
                for (int mh = 0; mh < 2; ++mh) {
                    f32x4 xf[2][2][2];
#pragma unroll
                    for (int mm = 0; mm < 2; ++mm)
#pragma unroll
                        for (int bj = 0; bj < 2; ++bj) { const float* q = xb + (size_t)((mh * 2 + mm) * 16) * D + bj * 128; xf[mm][bj][0] = *(const f32x4*)q; xf[mm][bj][1] = *(const f32x4*)(q + 4); }
#pragma unroll
                    for (int mm = 0; mm < 2; ++mm)
#pragma unroll
                        for (int bj = 0; bj < 2; ++bj) { const int m = mh * 2 + mm;
                            const f32x4 v0 = xf[mm][bj][0] * ALPHA + sc[bj][0] * (acc[ai][bj][m][0] + bv[bj][0]), v1 = xf[mm][bj][1] * ALPHA + sc[bj][1] * (acc[ai][bj][m][1] + bv[bj][1]);
                            u32x4 w; w.x = cvt_pk_bf16(v0[0], v0[1]); w.y = cvt_pk_bf16(v0[2], v0[3]); w.z = cvt_pk_bf16(v1[0], v1[1]); w.w = cvt_pk_bf16(v1[2], v1[3]);
                            *(u32x4*)(vp + (size_t)(m * 16) * D + bj * 128) = w; }
                    asm volatile("" ::: "memory");
                }
            }
            asm volatile("" ::: "memory");
        }
    }
    __device__ __forceinline__ void body_ln(const Acc& acc, const GUnit& u, int row0, int colt) const {
        const float* mv = modl + (size_t)row_grp(u.pm) * 9216;
#pragma unroll
        for (int bj = 0; bj < 2; ++bj) {
            f32x4 sc[2], gg[2], bb[2], bv[2];
#pragma unroll
            for (int n = 0; n < 2; ++n) { sc[n] = *(const f32x4*)(mv + colt + bj * 128 + 4 * n) * coef; gg[n] = *(const f32x4*)(xg + colt + bj * 128 + 4 * n); bb[n] = *(const f32x4*)(xbt + colt + bj * 128 + 4 * n);
                bv[n] = bias ? *(const f32x4*)(bias + colt + bj * 128 + 4 * n) : (f32x4){0.f, 0.f, 0.f, 0.f}; }
#pragma unroll
            for (int ai = 0; ai < 2; ++ai) {
                bf16* vp = V + (size_t)(row0 + ai * 128) * D + colt + bj * 128; const bf16* xp = (const bf16*)xl + (size_t)(row0 + ai * 128) * D + colt + bj * 128;
                u32x4 xw[4]; f32x2 st[4];
#pragma unroll
                for (int m = 0; m < 4; ++m) { st[m] = *(const f32x2*)(xstat + (size_t)(row0 + ai * 128 + m * 16) * 2); xw[m] = *(const u32x4*)(xp + (size_t)(m * 16) * D); }
#pragma unroll
                for (int m = 0; m < 4; ++m) { const u32x4 w_ = xw[m]; const float mu = st[m].x, rs = st[m].y;
                    const f32x4 x0 = ((f32x4){bflo(w_.x), bfhi(w_.x), bflo(w_.y), bfhi(w_.y)} - mu) * (gg[0] * rs) + bb[0], x1 = ((f32x4){bflo(w_.z), bfhi(w_.z), bflo(w_.w), bfhi(w_.w)} - mu) * (gg[1] * rs) + bb[1];
                    const f32x4 v0 = x0 * ALPHA + sc[0] * (acc[ai][bj][m][0] + bv[0]), v1 = x1 * ALPHA + sc[1] * (acc[ai][bj][m][1] + bv[1]);
                    u32x4 w; w.x = cvt_pk_bf16(v0[0], v0[1]); w.y = cvt_pk_bf16(v0[2], v0[3]); w.z = cvt_pk_bf16(v1[0], v1[1]); w.w = cvt_pk_bf16(v1[2], v1[3]);
                    *(u32x4*)(vp + (size_t)(m * 16) * D) = w; }
                asm volatile("" ::: "memory");
            }
        }
    }
};
struct EpiInproj {
    static constexpr bool DUP_OK = false; static constexpr int NST = 0;
    const float* bin;
    unsigned char* ws;
    __device__ __forceinline__ void operator()(const Acc& acc, const GUnit& u, int tid, int wr, int wc, int fr, int fq) const {
        bf16* const UA = (bf16*)(ws + WS_UA); bf16* const Q = (bf16*)(ws + WS_Q); bf16* const K = (bf16*)(ws + WS_K); bf16* const SB = (bf16*)(ws + WS_SB);
        bf16* const W = (bf16*)(ws + WS_W); bf16* const VT = (bf16*)(ws + WS_VT); bf16* const HT = (bf16*)(ws + WS_HT);
        int c8 = wc * 32 + 8 * fq; asm volatile("" : "+v"(c8));
        if (u.kind == KI_TRANS) {
            bf16* dst = (u.pn == 4) ? VT : HT + (size_t)(u.pn - 8) * 256 * MT;
            const int r0 = wr * 64 + fr;
#pragma unroll
            for (int ai = 0; ai < 2; ++ai)
#pragma unroll
                for (int m = 0; m < 4; ++m) {
                    const int r = r0 + ai * 128 + m * 16; const float b = bin[u.pn * 256 + r];
#pragma unroll
                    for (int bj = 0; bj < 2; ++bj) {
                        const f32x4 v0 = acc[ai][bj][m][0] + b, v1 = acc[ai][bj][m][1] + b;
                        u32x4 w; w.x = cvt_pk_bf16(v0[0], v0[1]); w.y = cvt_pk_bf16(v0[2], v0[3]); w.z = cvt_pk_bf16(v1[0], v1[1]); w.w = cvt_pk_bf16(v1[2], v1[3]);
                        *(u32x4*)(dst + (size_t)r * MT + u.pm * 256 + bj * 128 + c8) = w;
                    }
                }
            return;
        }
        const int row0 = u.pm * 256 + wr * 64 + fr;
        f32x4 bv[2][2];
#pragma unroll
        for (int bj = 0; bj < 2; ++bj)
#pragma unroll
            for (int n = 0; n < 2; ++n) bv[bj][n] = *(const f32x4*)(bin + u.pn * 256 + bj * 128 + c8 + 4 * n);
        if (u.kind == KI_PLAIN) {
            bf16* dst = (u.pn == 2) ? Q : (u.pn == 3 ? K : SB); const float scl = (u.pn == 2) ? ATT_SCALE * 1.44269504089f : 1.0f;
#pragma unroll
            for (int ai = 0; ai < 2; ++ai)
#pragma unroll
                for (int m = 0; m < 4; ++m)
#pragma unroll
                    for (int bj = 0; bj < 2; ++bj) {
                        const f32x4 v0 = (acc[ai][bj][m][0] + bv[bj][0]) * scl, v1 = (acc[ai][bj][m][1] + bv[bj][1]) * scl;
                        u32x4 w; w.x = cvt_pk_bf16(v0[0], v0[1]); w.y = cvt_pk_bf16(v0[2], v0[3]); w.z = cvt_pk_bf16(v1[0], v1[1]); w.w = cvt_pk_bf16(v1[2], v1[3]);
                        *(u32x4*)(dst + (size_t)(row0 + ai * 128 + m * 16) * 256 + bj * 128 + c8) = w;
                    }
            return;
        }
        const bool glu = (u.kind == KI_GLU);
        bf16* dst = glu ? UA + u.pn * 128 : W + (u.pn - 6) * 128;
#pragma unroll
        for (int ai = 0; ai < 2; ++ai)
#pragma unroll
            for (int m = 0; m < 4; ++m) {
                f32x4 a0 = acc[ai][0][m][0] + bv[0][0], a1 = acc[ai][0][m][1] + bv[0][1], g0 = acc[ai][1][m][0] + bv[1][0], g1 = acc[ai][1][m][1] + bv[1][1];
                if (glu) {
#pragma unroll
                    for (int j = 0; j < 4; ++j) { g0[j] = sigmoidf_(g0[j]); g1[j] = sigmoidf_(g1[j]); }
                }
                const f32x4 v0 = a0 * g0, v1 = a1 * g1;
                u32x4 w; w.x = cvt_pk_bf16(v0[0], v0[1]); w.y = cvt_pk_bf16(v0[2], v0[3]); w.z = cvt_pk_bf16(v1[0], v1[1]); w.w = cvt_pk_bf16(v1[2], v1[3]);
                *(u32x4*)(dst + (size_t)(row0 + ai * 128 + m * 16) * 256 + c8) = w;
            }
    }
};
struct EpiGateBr {
    static constexpr bool DUP_OK = false; static constexpr int NST = 0;
    const float* bing;
    unsigned char* gs;
    bf16* MG; bf16* MI;
    __device__ __forceinline__ void operator()(const Acc& acc, const GUnit& u, int tid, int wr, int wc, int fr, int fq) const {
        const int br = (u.kind >> 1) & 3; const bool cjob = (u.kind & 8) != 0;
        unsigned so = (unsigned)tid * 16u; asm volatile("" : "+v"(so));
        const unsigned mo = so * 2u;
        if ((u.kind & 1) == 0) {
            const float* bb = bing + br * 1024 + u.pn * 256 + wc * 32 + 8 * fq;
            f32x4 bv[2][2];
#pragma unroll
            for (int bj = 0; bj < 2; ++bj)
#pragma unroll
                for (int n = 0; n < 2; ++n) bv[bj][n] = *(const f32x4*)(bb + bj * 128 + 4 * n);
            unsigned char* sp = gs;
#pragma unroll
            for (int ai = 0; ai < 2; ++ai)
#pragma unroll
                for (int m = 0; m < 4; ++m)
#pragma unroll
                    for (int bj = 0; bj < 2; ++bj) {
                        const float gs_ = u.f8 ? (1.0f / W1_SCALE) : 1.0f; f32x4 v0 = acc[ai][bj][m][0] * gs_ + bv[bj][0], v1 = acc[ai][bj][m][1] * gs_ + bv[bj][1];
#pragma unroll
                        for (int j = 0; j < 4; ++j) { v0[j] = sigmoidf_(v0[j]); v1[j] = sigmoidf_(v1[j]); }
                        u32x4 w; w.x = cvt_pk_bf16(v0[0], v0[1]); w.y = cvt_pk_bf16(v0[2], v0[3]); w.z = cvt_pk_bf16(v1[0], v1[1]); w.w = cvt_pk_bf16(v1[2], v1[3]);
                        *(u32x4*)(sp + so) = w; sp += 8192;
                    }
        } else {
            unsigned lo = (unsigned)(((wr * 64 + fr) * D + u.pn * 256 + wc * 32 + 8 * fq) * 2); asm volatile("" : "+v"(lo));
            unsigned char* op = cjob ? (unsigned char*)(MI + ((size_t)br * TC + (u.pm - TL / 256) * 256) * D) : (unsigned char*)(MG + (size_t)u.pm * 256 * D);
            const bool ldm = (br > 0 && !cjob), stm = (br < 3 && !cjob);
            if (ldm) { if (stm) branch<true, true>(acc, so, mo, lo, op); else branch<true, false>(acc, so, mo, lo, op); }
            else { if (stm) branch<false, true>(acc, so, mo, lo, op); else branch<false, false>(acc, so, mo, lo, op); }
        }
    }
    template <bool LDM, bool STM> __device__ __forceinline__ void branch(const Acc& acc, unsigned so, unsigned mo, unsigned lo, unsigned char* op) const {
        const unsigned char* sp = gs; unsigned char* mp = gs + 131072;
        u32x4 s[2][2], mw[2][2];
#define GB_U(ptr_) ({ auto q_ = (ptr_); asm volatile("" : "+s"(q_)); q_; })
#define GB_LOAD(t_) do { _Pragma("unroll") for (int k = 0; k < 2; ++k) { s[(t_) & 1][k] = *(const u32x4*)(GB_U(sp + ((t_) * 2 + k) * 8192) + so); \
            if (LDM) mw[(t_) & 1][k] = *(const u32x4*)(GB_U(mp + ((t_) * 2 + k) * 8192) + so); else mw[(t_) & 1][k] = (u32x4){0u, 0u, 0u, 0u}; } } while (0)
        GB_LOAD(0);
#pragma unroll
        for (int t = 0; t < 8; ++t) { const int ai = t >> 2, m = t & 3, p = t & 1;
            if (t < 7) GB_LOAD(t + 1);
#pragma unroll
            for (int k = 0; k < 2; ++k) { const int bj = k;
                const f32x4 y0 = acc[ai][bj][m][0], y1 = acc[ai][bj][m][1]; const u32x4 sk = s[p][k], mk = mw[p][k]; f32x4 a0 = (f32x4){bflo(mk.x), bfhi(mk.x), bflo(mk.y), bfhi(mk.y)}, a1 = (f32x4){bflo(mk.z), bfhi(mk.z), bflo(mk.w), bfhi(mk.w)};
                a0[0] += bflo(sk.x) * y0[0]; a0[1] += bfhi(sk.x) * y0[1]; a0[2] += bflo(sk.y) * y0[2]; a0[3] += bfhi(sk.y) * y0[3];
                a1[0] += bflo(sk.z) * y1[0]; a1[1] += bfhi(sk.z) * y1[1]; a1[2] += bflo(sk.w) * y1[2]; a1[3] += bfhi(sk.w) * y1[3];
                u32x4 w; w.x = cvt_pk_bf16(a0[0], a0[1]); w.y = cvt_pk_bf16(a0[2], a0[3]); w.z = cvt_pk_bf16(a1[0], a1[1]); w.w = cvt_pk_bf16(a1[2], a1[3]);
                if (STM) *(u32x4*)(GB_U(mp + (t * 2 + k) * 8192) + so) = w;
                else *(u32x4*)(op + (size_t)(ai * 128 + m * 16) * D * 2 + lo + bj * 256) = w; }
            asm volatile("" ::: "memory");
        }
#undef GB_LOAD
#undef GB_U
    }
};

struct Frame {
    LAS unsigned char* lds;
    int tid, lane, wave, bid, G;
    unsigned char* ws;
};

__device__ __forceinline__ void transpose_item(const float* W, int K, int N, int src_col0, bf16* WT, int dst_row0, LAS float* scr, int kb, int lane) {
    const int k0 = 64 * kb;
    float tv[32];
#pragma unroll
    for (int i = 0; i < 32; ++i) { const int kk = 2 * i + (lane >> 5); tv[i] = W[(size_t)(k0 + kk) * N + src_col0 + (lane & 31)]; }
#pragma unroll
    for (int i = 0; i < 32; ++i) { const int kk = 2 * i + (lane >> 5); scr[kk * 33 + (lane & 31)] = tv[i]; }
    LDS_WAIT(); asm volatile("" ::: "memory");
    const int c = lane & 7;
#pragma unroll
    for (int j = 0; j < 4; ++j) { const int n = (lane >> 3) + 8 * j; const LAS float* s = scr + (8 * c) * 33 + n;
        u32x4 o; o.x = cvt_pk_bf16(s[0 * 33], s[1 * 33]); o.y = cvt_pk_bf16(s[2 * 33], s[3 * 33]); o.z = cvt_pk_bf16(s[4 * 33], s[5 * 33]); o.w = cvt_pk_bf16(s[6 * 33], s[7 * 33]);
        *(u32x4*)(WT + (size_t)(dst_row0 + n) * K + k0 + 8 * c) = o; }
    LDS_WAIT(); asm volatile("" ::: "memory");
}
__device__ __forceinline__ void transpose_item8(const float* W, int K, int N, int src_col0, unsigned char* WT, int dst_row0, LAS float* scr, int kb, int lane, float wscale) {
    const int k0 = 64 * kb;
    float tv[32];
#pragma unroll
    for (int i = 0; i < 32; ++i) { const int kk = 2 * i + (lane >> 5); tv[i] = W[(size_t)(k0 + kk) * N + src_col0 + (lane & 31)]; }
#pragma unroll
    for (int i = 0; i < 32; ++i) { const int kk = 2 * i + (lane >> 5); scr[kk * 33 + (lane & 31)] = tv[i]; }
    LDS_WAIT(); asm volatile("" ::: "memory");
    const int n = lane >> 1, hf = lane & 1; const LAS float* s = scr + (32 * hf) * 33 + n;
    u32x4 o0, o1;
    o0.x = pk_fp8x4(s[0 * 33] * wscale, s[1 * 33] * wscale, s[2 * 33] * wscale, s[3 * 33] * wscale); o0.y = pk_fp8x4(s[4 * 33] * wscale, s[5 * 33] * wscale, s[6 * 33] * wscale, s[7 * 33] * wscale);
    o0.z = pk_fp8x4(s[8 * 33] * wscale, s[9 * 33] * wscale, s[10 * 33] * wscale, s[11 * 33] * wscale); o0.w = pk_fp8x4(s[12 * 33] * wscale, s[13 * 33] * wscale, s[14 * 33] * wscale, s[15 * 33] * wscale);
    o1.x = pk_fp8x4(s[16 * 33] * wscale, s[17 * 33] * wscale, s[18 * 33] * wscale, s[19 * 33] * wscale); o1.y = pk_fp8x4(s[20 * 33] * wscale, s[21 * 33] * wscale, s[22 * 33] * wscale, s[23 * 33] * wscale);
    o1.z = pk_fp8x4(s[24 * 33] * wscale, s[25 * 33] * wscale, s[26 * 33] * wscale, s[27 * 33] * wscale); o1.w = pk_fp8x4(s[28 * 33] * wscale, s[29 * 33] * wscale, s[30 * 33] * wscale, s[31 * 33] * wscale);
    u32x4* dst = (u32x4*)(WT + (size_t)(dst_row0 + n) * K + k0 + 32 * hf); dst[0] = o0; dst[1] = o1;
    LDS_WAIT(); asm volatile("" ::: "memory");
}
__host__ __device__ __forceinline__ int inmap(int r) {
    if (r >= NINP) return r;
    const int t = r >> 8, cc = r & 255;
    if (t < 2) return cc < 128 ? 128 * t + cc : 256 + 128 * t + cc - 128;
    if (t < 6) return 256 * t + cc;
    if (t < 8) { const int p = t - 6; return cc < 128 ? 1536 + 128 * p + cc : 1792 + 128 * p + cc - 128; }
    return 2048 + 256 * (t - 8) + cc;
}
__device__ __forceinline__ void prologue_a(Frame& F, const Params& P) {
    LAS float* scr = (LAS float*)(F.lds + F.wave * 16384);
    const int gw = F.bid * NWAVES + F.wave, NGW = F.G * NWAVES;
    constexpr int I1 = 16 * 176, I2 = 44 * 32, I3 = 16 * 216, I4 = 4 * 32, I5 = 16 * 32;
    constexpr int I6 = 32;
    constexpr int NIT = 4 * I1 + 4 * I2 + 2 * I3 + 8 * I4 + 2 * I5 + 2 * I6;
    struct TI { const float* W; unsigned char* dst; int N, K, sc, drow, kb; bool f8; float scale; };
    auto decode = [&](int it, TI& t) {
        int r = it;
        if (r < 4 * I1) { const int mi = r / I1; r %= I1; const int kb = r / 176, nb = r % 176, d0 = nb * 32, pn = d0 >> 8, cc = d0 & 255;
            t = TI{P.in[I_FWI] + (size_t)mi * D * NFF, F.ws + WS_W1T + (size_t)mi * NFF * D, NFF, D, cc < 128 ? 128 * pn + cc : DFF + 128 * pn + cc - 128, d0, kb, true, W1_SCALE}; return; }
        r -= 4 * I1;
        if (r < 4 * I2) { const int mi = r / I2; r %= I2; const int kb = r / 32, nb = r % 32;
            t = TI{P.in[I_FWO] + (size_t)mi * DFF * D, F.ws + WS_W2T + (size_t)mi * D * DFF, D, DFF, nb * 32, nb * 32, kb, true, W2_SCALE}; return; }
        r -= 4 * I2;
        if (r < 2 * I3) { const int mi = r / I3; r %= I3; const int kb = r / 216, nb = r % 216; const float* W = P.in[I_WIN] + (size_t)mi * D * PIN;
            if (nb * 32 >= NINP + 3072) t = TI{W, F.ws + WS_WIT + ((size_t)mi * PIN + NINP) * D * 2 + 4 * MiB, PIN, D, inmap(nb * 32), nb * 32 - NINP - 3072, kb, false, 1.f};
            else if (nb * 32 >= NINP) t = TI{W, F.ws + WS_WIT + ((size_t)mi * PIN + NINP) * D * 2, PIN, D, inmap(nb * 32), nb * 32 - NINP, kb, true, W1_SCALE};
            else t = TI{W, F.ws + WS_WIT + (size_t)mi * PIN * D * 2, PIN, D, inmap(nb * 32), nb * 32, kb, false, 1.f};
            return; }
        r -= 2 * I3;
        if (r < 8 * I4) { const int mi = r / I4; r %= I4; const int l = mi >> 2, br = mi & 3, kb = r / 32, nb = r % 32;
            t = TI{P.in[br == 0 ? I_CWP : (br == 1 ? I_NWP : (br == 2 ? I_SWP : I_HWP))] + (size_t)l * 256 * D, F.ws + WS_WPT + (size_t)mi * D * 256 * 2, D, 256, nb * 32, nb * 32, kb, false, 1.f}; return; }
        r -= 8 * I4;
        if (r < 2 * I5) { const int mi = r / I5; r %= I5; const int kb = r / 32, nb = r % 32;
            t = TI{P.in[I_WOUT] + (size_t)mi * D * D, F.ws + WS_WOT + (size_t)mi * D * D * 2, D, D, nb * 32, nb * 32, kb, false, 1.f}; return; }
        r -= 2 * I5;
        { const int mi = r / I6, nb = r % I6; t = TI{P.in[I_HW3] + (size_t)mi * 64 * 1024, F.ws + WS_W3T + (size_t)mi * 1024 * 64 * 2, 1024, 64, nb * 32, nb * 32, 0, false, 1.f}; }
    };
    {
        const int lane = F.lane;
        TI cur; float tv[32];
        int it = gw;
        if (it < NIT) { decode(it, cur);
#pragma unroll
            for (int i = 0; i < 32; ++i) tv[i] = cur.W[(size_t)(64 * cur.kb + 2 * i + (lane >> 5)) * cur.N + cur.sc + (lane & 31)]; }
        for (; it < NIT; it += NGW) {
#pragma unroll
            for (int i = 0; i < 32; ++i) scr[(2 * i + (lane >> 5)) * 33 + (lane & 31)] = tv[i];
            TI nx; const bool more = it + NGW < NIT;
            if (more) { decode(it + NGW, nx);
#pragma unroll
                for (int i = 0; i < 32; ++i) tv[i] = nx.W[(size_t)(64 * nx.kb + 2 * i + (lane >> 5)) * nx.N + nx.sc + (lane & 31)]; }
            LDS_WAIT(); asm volatile("" ::: "memory");
            const int k0 = 64 * cur.kb;
            if (cur.f8) { const int n = lane >> 1, hf = lane & 1; const LAS float* s = scr + (32 * hf) * 33 + n; const float ws_ = cur.scale;
                u32x4 o0, o1;
                o0.x = pk_fp8x4(s[0 * 33] * ws_, s[1 * 33] * ws_, s[2 * 33] * ws_, s[3 * 33] * ws_); o0.y = pk_fp8x4(s[4 * 33] * ws_, s[5 * 33] * ws_, s[6 * 33] * ws_, s[7 * 33] * ws_);
                o0.z = pk_fp8x4(s[8 * 33] * ws_, s[9 * 33] * ws_, s[10 * 33] * ws_, s[11 * 33] * ws_); o0.w = pk_fp8x4(s[12 * 33] * ws_, s[13 * 33] * ws_, s[14 * 33] * ws_, s[15 * 33] * ws_);
                o1.x = pk_fp8x4(s[16 * 33] * ws_, s[17 * 33] * ws_, s[18 * 33] * ws_, s[19 * 33] * ws_); o1.y = pk_fp8x4(s[20 * 33] * ws_, s[21 * 33] * ws_, s[22 * 33] * ws_, s[23 * 33] * ws_);
                o1.z = pk_fp8x4(s[24 * 33] * ws_, s[25 * 33] * ws_, s[26 * 33] * ws_, s[27 * 33] * ws_); o1.w = pk_fp8x4(s[28 * 33] * ws_, s[29 * 33] * ws_, s[30 * 33] * ws_, s[31 * 33] * ws_);
                u32x4* dst = (u32x4*)(cur.dst + (size_t)(cur.drow + n) * cur.K + k0 + 32 * hf); dst[0] = o0; dst[1] = o1; }
            else { const int c = lane & 7;
#pragma unroll
                for (int j = 0; j < 4; ++j) { const int n = (lane >> 3) + 8 * j; const LAS float* s = scr + (8 * c) * 33 + n;
                    u32x4 o; o.x = cvt_pk_bf16(s[0 * 33], s[1 * 33]); o.y = cvt_pk_bf16(s[2 * 33], s[3 * 33]); o.z = cvt_pk_bf16(s[4 * 33], s[5 * 33]); o.w = cvt_pk_bf16(s[6 * 33], s[7 * 33]);
                    *(u32x4*)(cur.dst + ((size_t)(cur.drow + n) * cur.K + k0 + 8 * c) * 2) = o; } }
            LDS_WAIT(); asm volatile("" ::: "memory");
            cur = nx;
        }
    }
    { float* bin = (float*)(F.ws + WS_BIN); for (int i = F.bid * NTHR + F.tid; i < 2 * PIN; i += F.G * NTHR) { const int l = i / PIN, r = i % PIN; bin[i] = P.in[I_BIN][l * PIN + inmap(r)]; } }
    __syncthreads();
    LAS float* sv = (LAS float*)F.lds;
    LAS float* red = (LAS float*)(F.lds + 16384);
    for (int i = F.tid; i < 3 * D; i += NTHR) { const int g = i / D, k = i % D; const float c = g < 2 ? P.in[I_C][g * D + k] : P.in[I_CCTX][k]; sv[i] = siluf_(c); }
    __syncthreads();
    for (int un = F.bid; un < 2 * 144; un += F.G) {
        const int l = un / 144, n0 = (un % 144) * 64;
        const float* wm = P.in[I_WMOD] + (size_t)l * D * 9216 + n0 + F.lane;
        float a0 = 0.f, a1 = 0.f, a2 = 0.f;
#pragma unroll 1
        for (int k0 = 0; k0 < 128; k0 += 32) { float wv[32];
#pragma unroll
            for (int kk = 0; kk < 32; ++kk) wv[kk] = wm[(size_t)(F.wave * 128 + k0 + kk) * 9216];
#pragma unroll
            for (int kk = 0; kk < 32; ++kk) { const int k = F.wave * 128 + k0 + kk; a0 += sv[k] * wv[kk]; a1 += sv[D + k] * wv[kk]; a2 += sv[2 * D + k] * wv[kk]; } }
        red[(F.wave * 3 + 0) * 64 + F.lane] = a0; red[(F.wave * 3 + 1) * 64 + F.lane] = a1; red[(F.wave * 3 + 2) * 64 + F.lane] = a2;
        __syncthreads();
        if (F.tid < 192) { const int g = F.tid >> 6, ln = F.tid & 63; float s = P.in[I_BMOD][l * 9216 + n0 + ln];
#pragma unroll
            for (int w = 0; w < 8; ++w) s += red[(w * 3 + g) * 64 + ln];
            ((float*)(F.ws + WS_MOD))[(size_t)(l * 3 + g) * 9216 + n0 + ln] = s; }
        __syncthreads();
    }
}

__device__ __forceinline__ void ln_stats(const f32x4 (&v)[4], float& mean, float& rstd) {
    float s = 0.f;
#pragma unroll
    for (int j = 0; j < 4; ++j) s += (v[j][0] + v[j][1]) + (v[j][2] + v[j][3]);
    mean = wave_sum(s) * (1.0f / D);
    float q = 0.f;
#pragma unroll
    for (int j = 0; j < 4; ++j) { const f32x4 d = v[j] - mean; q += (d[0] * d[0] + d[1] * d[1]) + (d[2] * d[2] + d[3] * d[3]); }
    rstd = 1.0f / sqrtf(wave_sum(q) * (1.0f / D) + LN_EPS);
}
__device__ __forceinline__ void modulate_store(const f32x4 (&x)[4], const float* shift, const float* scale, bf16* hrow, int lane) {
    float mean, rstd; ln_stats(x, mean, rstd);
#pragma unroll
    for (int j = 0; j < 4; ++j) { const int c = 4 * lane + 256 * j; const f32x4 sc = *(const f32x4*)(scale + c), sh = *(const f32x4*)(shift + c);
        const f32x4 h = (x[j] - mean) * rstd * (sc + 1.0f) + sh;
        u32x2 w; w.x = cvt_pk_bf16(h[0], h[1]); w.y = cvt_pk_bf16(h[2], h[3]); *(u32x2*)(hrow + c) = w; }
}
__device__ __forceinline__ void modulate_store8(const f32x4 (&x)[4], const float* shift, const float* scale, unsigned char* hrow, int lane) {
    float mean, rstd; ln_stats(x, mean, rstd);
#pragma unroll
    for (int j = 0; j < 4; ++j) { const int c = 4 * lane + 256 * j; const f32x4 sc = *(const f32x4*)(scale + c), sh = *(const f32x4*)(shift + c);
        const f32x4 h = (x[j] - mean) * rstd * (sc + 1.0f) + sh;
        *(unsigned*)(hrow + c) = pk_fp8x4(h[0], h[1], h[2], h[3]); }
}
constexpr int LNR = 4;
__device__ __forceinline__ void ln_stats_r(const f32x4 (&v)[LNR][4], float (&mean)[LNR], float (&rstd)[LNR]) {
    float s[LNR];
#pragma unroll
    for (int r = 0; r < LNR; ++r) { s[r] = 0.f;
#pragma unroll
        for (int j = 0; j < 4; ++j) s[r] += (v[r][j][0] + v[r][j][1]) + (v[r][j][2] + v[r][j][3]); }
#pragma unroll
    for (int r = 0; r < LNR; ++r) s[r] = wave_sum(s[r]);
    float q[LNR];
#pragma unroll
    for (int r = 0; r < LNR; ++r) { mean[r] = s[r] * (1.0f / D); q[r] = 0.f;
#pragma unroll
        for (int j = 0; j < 4; ++j) { const f32x4 d = v[r][j] - mean[r]; q[r] += (d[0] * d[0] + d[1] * d[1]) + (d[2] * d[2] + d[3] * d[3]); } }
#pragma unroll
    for (int r = 0; r < LNR; ++r) q[r] = wave_sum(q[r]);
#pragma unroll
    for (int r = 0; r < LNR; ++r) rstd[r] = 1.0f / sqrtf(q[r] * (1.0f / D) + LN_EPS);
}
__device__ __forceinline__ void phase_mod0(Frame& F, const Params& P) {
    const int skip = (F.G > 8) ? 4 : 0;
    if (F.bid < skip) return;
    const int gw = (F.bid - skip) * NWAVES + F.wave, NGW = (F.G - skip) * NWAVES;
    const float* MOD = (const float*)(F.ws + WS_MOD); bf16* H = (bf16*)(F.ws + WS_H);
    for (int row0 = gw; row0 < MT; row0 += LNR * NGW) {
        f32x4 x[LNR][4]; int rows[LNR];
#pragma unroll
        for (int r = 0; r < LNR; ++r) { rows[r] = min(row0 + r * NGW, MT - 1); const int row = rows[r];
            const float* xr = row < TL ? P.in[I_X] + (size_t)row * D : P.in[I_CTX] + (size_t)(row - TL) * D;
#pragma unroll
            for (int j = 0; j < 4; ++j) x[r][j] = *(const f32x4*)(xr + 4 * F.lane + 256 * j); }
        float mean[LNR], rstd[LNR]; ln_stats_r(x, mean, rstd);
#pragma unroll
        for (int r = 0; r < LNR; ++r) if (row0 + r * NGW < MT) { const int row = rows[r], g = row < SEQ ? 0 : (row < TL ? 1 : 2);
            const float* shift = MOD + (size_t)g * 9216, *scale = shift + D;
#pragma unroll
            for (int j = 0; j < 4; ++j) { const int c = 4 * F.lane + 256 * j; const f32x4 sc = *(const f32x4*)(scale + c), sh = *(const f32x4*)(shift + c);
                const f32x4 h = (x[r][j] - mean[r]) * rstd[r] * (sc + 1.0f) + sh;
                *(unsigned*)((unsigned char*)H + (size_t)row * D + c) = pk_fp8x4(h[0], h[1], h[2], h[3]); } }
    }
}
__device__ __forceinline__ void phase_ln(Frame& F, const Params& P, const float* lg, const float* lb, const float* modl  , int ishift, bool hmod, bool h8  , bool dual  , bool final_out, int cx_nks, float cx_coef, const float* cx_modv  , const float* cx_bias, const float* cx_xsrc, bool skipx  , const bf16* vsrc  ) {
    const int gw = F.bid * NWAVES + F.wave, NGW = F.G * NWAVES;
    const bf16* V = vsrc; bf16* H = (bf16*)(F.ws + WS_H);
    f32x4 g4[4], b4[4];
#pragma unroll
    for (int j = 0; j < 4; ++j) { g4[j] = *(const f32x4*)(lg + 4 * F.lane + 256 * j); b4[j] = *(const f32x4*)(lb + 4 * F.lane + 256 * j); }
    if (cx_nks > 0) {
        const float* part = (const float*)(F.ws + WS_ES);
        for (int r = gw; r < TC; r += NGW) {
            f32x4 v[4];
#pragma unroll
            for (int j = 0; j < 4; ++j) { const int c = 4 * F.lane + 256 * j; f32x4 s = cx_bias ? *(const f32x4*)(cx_bias + c) : (f32x4){0.f, 0.f, 0.f, 0.f};
                for (int ks = 0; ks < cx_nks; ++ks) s += *(const f32x4*)(part + ((size_t)ks * TC + r) * D + c);
                v[j] = *(const f32x4*)(cx_xsrc + (size_t)r * D + c) * ALPHA + *(const f32x4*)(cx_modv + c) * cx_coef * s; }
            float mean, rstd; ln_stats(v, mean, rstd);
            float* xr = (float*)(F.ws + WS_XC) + (size_t)r * D;
#pragma unroll
            for (int j = 0; j < 4; ++j) { v[j] = (v[j] - mean) * rstd * g4[j] + b4[j]; *(f32x4*)(xr + 4 * F.lane + 256 * j) = v[j]; }
            if (hmod && dual) modulate_store8(v, modl + (size_t)2 * 9216 + ishift * D, modl + (size_t)2 * 9216 + (ishift + 1) * D, F.ws + WS_H8C + (size_t)r * D, F.lane);
            if (hmod) { if (h8) modulate_store8(v, modl + (size_t)2 * 9216 + ishift * D, modl + (size_t)2 * 9216 + (ishift + 1) * D, (unsigned char*)H + (size_t)(TL + r) * D, F.lane);
                        else modulate_store(v, modl + (size_t)2 * 9216 + ishift * D, modl + (size_t)2 * 9216 + (ishift + 1) * D, H + (size_t)(TL + r) * D, F.lane); }
        }
    }
    const int M = TL;
    u32x2 raw[LNR][4];
#pragma unroll
    for (int r = 0; r < LNR; ++r) { const int rw = min(gw + r * NGW, M - 1);
#pragma unroll
        for (int j = 0; j < 4; ++j) raw[r][j] = *(const u32x2*)(V + (size_t)rw * D + 4 * F.lane + 256 * j); }
    for (int row0 = gw; row0 < M; row0 += LNR * NGW) {
        f32x4 v[LNR][4]; int rows[LNR];
#pragma unroll
        for (int r = 0; r < LNR; ++r) { rows[r] = min(row0 + r * NGW, M - 1);
#pragma unroll
            for (int j = 0; j < 4; ++j) { const u32x2 w = raw[r][j]; v[r][j] = (f32x4){bflo(w.x), bfhi(w.x), bflo(w.y), bfhi(w.y)}; } }
        if (row0 + LNR * NGW < M) {
#pragma unroll
            for (int r = 0; r < LNR; ++r) { const int rw = min(row0 + (LNR + r) * NGW, M - 1);
#pragma unroll
                for (int j = 0; j < 4; ++j) raw[r][j] = *(const u32x2*)(V + (size_t)rw * D + 4 * F.lane + 256 * j); }
        }
        float mean[LNR], rstd[LNR]; ln_stats_r(v, mean, rstd);
#pragma unroll
        for (int r = 0; r < LNR; ++r) { const int row = rows[r]; const bool ok = row0 + r * NGW < M;
            float* xr = P.out + (size_t)row * D; bf16* xh = (bf16*)P.out + (size_t)row * D;
            if (skipx && ok && F.lane == 0) *(f32x2*)((float*)(F.ws + WS_LNS) + (size_t)row * 2) = (f32x2){mean[r], rstd[r]};
#pragma unroll
            for (int j = 0; j < 4; ++j) { v[r][j] = (v[r][j] - mean[r]) * rstd[r] * g4[j] + b4[j];
                if (ok) { if (final_out) __builtin_nontemporal_store(v[r][j], (f32x4*)(xr + 4 * F.lane + 256 * j));
                          else if (!skipx) { u32x2 w; w.x = cvt_pk_bf16(v[r][j][0], v[r][j][1]); w.y = cvt_pk_bf16(v[r][j][2], v[r][j][3]); __builtin_nontemporal_store(w, (u32x2*)(xh + 4 * F.lane + 256 * j)); } } } }
        if (hmod) {
            ln_stats_r(v, mean, rstd);
#pragma unroll
            for (int r = 0; r < LNR; ++r) if (row0 + r * NGW < M) { const int row = rows[r], g = row < SEQ ? 0 : 1;
                const float* shift = modl + (size_t)g * 9216 + ishift * D, *scale = shift + D; bf16* hrow = H + (size_t)row * D;
#pragma unroll
                for (int j = 0; j < 4; ++j) { const int c = 4 * F.lane + 256 * j; const f32x4 sc = *(const f32x4*)(scale + c), sh = *(const f32x4*)(shift + c);
                    const f32x4 h = (v[r][j] - mean[r]) * rstd[r] * (sc + 1.0f) + sh;
                    if (h8) __builtin_nontemporal_store(pk_fp8x4(h[0], h[1], h[2], h[3]), (unsigned*)((unsigned char*)H + (size_t)row * D + c));
                    else { u32x2 w; w.x = cvt_pk_bf16(h[0], h[1]); w.y = cvt_pk_bf16(h[2], h[3]); __builtin_nontemporal_store(w, (u32x2*)(hrow + c)); }
                    if (dual) __builtin_nontemporal_store(pk_fp8x4(h[0], h[1], h[2], h[3]), (unsigned*)(F.ws + WS_H8L + (size_t)row * D + c)); } }
        }
    }
}

__device__ __forceinline__ void filter_unit(Frame& F, const Params& P, int l, int L, int t0, float* filt  , bool bfout) {
    LAS float* h1 = (LAS float*)F.lds;
    LAS bf16* h2b = (LAS bf16*)(F.lds + 32768);
    LAS float* zf = (LAS float*)(F.lds + 65536);
    LAS float* w2s = (LAS float*)(F.lds + 81920);
    LAS float* w1s = (LAS float*)(F.lds + 98304);
    const float* w1 = P.in[I_HW1] + l * 33 * 64; const float* b1 = P.in[I_HB1] + l * 64; const float* w2 = P.in[I_HW2] + l * 64 * 64; const float* b2 = P.in[I_HB2] + l * 64;
    const float* fq = P.in[I_HFQ] + l * 128; const float* w3 = P.in[I_HW3] + (size_t)l * 64 * 1024;
    {
#pragma unroll
        for (int i = 0; i < 8; ++i) w2s[F.tid + 512 * i] = w2[F.tid + 512 * i];
#pragma unroll
        for (int i = 0; i < 5; ++i) if (F.tid + 512 * i < 33 * 64) w1s[F.tid + 512 * i] = w1[F.tid + 512 * i];
        const int tl = F.tid >> 3, jg = F.tid & 7; const float t = (float)(t0 + tl);
        if (jg == 0) zf[tl * 36] = t / (float)(L - 1);
#pragma unroll
        for (int ii = 0; ii < 2; ++ii) { const int i = jg + 8 * ii; const float band = 1e-4f + (float)i * ((15.0f - 1e-4f) / 15.0f); float s, c; sincospif(2.0f * t * band / (float)L, &s, &c); zf[tl * 36 + 1 + i] = c; zf[tl * 36 + 17 + i] = -s; }
        __syncthreads();
        float a[8];
#pragma unroll
        for (int jj = 0; jj < 8; ++jj) a[jj] = b1[jg * 8 + jj];
#pragma unroll 3
        for (int i = 0; i < 33; ++i) { const float zv = zf[tl * 36 + i]; const LAS f32x4* wp = (const LAS f32x4*)(w1s + i * 64 + jg * 8); const f32x4 wa = wp[0], wb = wp[1];
            a[0] += zv * wa[0]; a[1] += zv * wa[1]; a[2] += zv * wa[2]; a[3] += zv * wa[3]; a[4] += zv * wb[0]; a[5] += zv * wb[1]; a[6] += zv * wb[2]; a[7] += zv * wb[3]; }
#pragma unroll
        for (int jj = 0; jj < 8; ++jj) h1[tl * 65 + jg * 8 + jj] = sinf(fq[jg * 8 + jj] * a[jj]);
        __syncthreads();
#pragma unroll
        for (int jj = 0; jj < 8; ++jj) a[jj] = b2[jg * 8 + jj];
#pragma unroll 4
        for (int i = 0; i < 64; ++i) { const float hv = h1[tl * 65 + i]; const LAS f32x4* wp = (const LAS f32x4*)(w2s + i * 64 + jg * 8); const f32x4 wa = wp[0], wb = wp[1];
            a[0] += hv * wa[0]; a[1] += hv * wa[1]; a[2] += hv * wa[2]; a[3] += hv * wa[3]; a[4] += hv * wb[0]; a[5] += hv * wb[1]; a[6] += hv * wb[2]; a[7] += hv * wb[3]; }
#pragma unroll
        for (int jj = 0; jj < 8; ++jj) h2b[tl * 72 + jg * 8 + jj] = (bf16)(cvt_pk_bf16(sinf(fq[64 + jg * 8 + jj] * a[jj]), 0.f) & 0xffffu);
        __syncthreads();
    }
    {
        const bf16* W3T = (const bf16*)(F.ws + WS_W3T) + (size_t)l * 1024 * 64;
        const int lane = F.lane, lr = lane & 15, lg = lane >> 4;
        const float dl0 = -4.605170186f / 1.5f, dl1 = -4.605170186f / 0.3f;
        bf16x8 af[4][2];
#pragma unroll
        for (int rt = 0; rt < 4; ++rt)
#pragma unroll
            for (int ks = 0; ks < 2; ++ks) af[rt][ks] = *(const LAS bf16x8*)(h2b + (rt * 16 + lr) * 72 + ks * 32 + 8 * lg);
#pragma unroll 2
        for (int ct = 0; ct < 8; ++ct) {
            const int col = F.wave * 128 + ct * 16 + lr, c = col & 255;
            const bf16x8 b0 = *(const bf16x8*)(W3T + (size_t)col * 64 + 8 * lg), b1 = *(const bf16x8*)(W3T + (size_t)col * 64 + 32 + 8 * lg);
            const float ad = fabsf(dl0 + (dl1 - dl0) * (float)c / 255.0f);
#pragma unroll
            for (int rt = 0; rt < 4; ++rt) {
                f32x4 a = (f32x4){0.f, 0.f, 0.f, 0.f};
                a = __builtin_amdgcn_mfma_f32_16x16x32_bf16(af[rt][0], b0, a, 0, 0, 0);
                a = __builtin_amdgcn_mfma_f32_16x16x32_bf16(af[rt][1], b1, a, 0, 0, 0);
                const int tb = t0 + rt * 16 + 4 * lg;
#pragma unroll
                for (int e = 0; e < 4; ++e) { const float tn = (float)(tb + e) / (float)(L - 1); a[e] *= __expf(-tn * ad); }
                if (bfout) { u32x2 w; w.x = cvt_pk_bf16(a[0], a[1]); w.y = cvt_pk_bf16(a[2], a[3]); *(u32x2*)((bf16*)filt + (size_t)col * L + tb) = w; }
                else *(f32x4*)(filt + (size_t)col * L + tb) = a;
            }
        }
    }
    __syncthreads();
}
__device__ __forceinline__ void phase_filters(Frame& F, const Params& P, int l, bool with_ctx) {
    float* filt = (float*)(F.ws + WS_FILT); float* filtc = (float*)(F.ws + WS_FILTC);
    const int nu = SEQ / 64 + (with_ctx ? CTXL / 64 : 0);
    for (int u = F.bid; u < nu; u += F.G) {
        if (u < SEQ / 64) filter_unit(F, P, l, SEQ, u * 64, filt, true);
        else filter_unit(F, P, l, CTXL, (u - SEQ / 64) * 64, filtc, false);
    }
}

__device__ __forceinline__ void seg_of(int row, int& s0, int& s1) {
    if (row < TL) { s0 = row & ~(SEQ - 1); s1 = s0 + SEQ; } else { s0 = TL + ((row - TL) & ~(CTXL - 1)); s1 = s0 + CTXL; }
}
__device__ __forceinline__ void conformer_tiles(Frame& F, const Params& P, int l, int u0, int ntile) {
    const bf16* UA = (const bf16*)(F.ws + WS_UA); bf16* BR0 = (bf16*)(F.ws + WS_BRV);
    LAS bf16* tin = (LAS bf16*)F.lds;
    LAS float* cout = (LAS float*)(F.lds + 49152);
    const int c = F.tid & 255, half = F.tid >> 8;
    float w[31];
#pragma unroll
    for (int j = 0; j < 31; ++j) w[j] = P.in[I_CDW][(l * 31 + j) * 256 + c];
    const float b = P.in[I_CDB][l * 256 + c];
    const f32x4 g = *(const f32x4*)(P.in[I_CLG] + l * 256 + 4 * F.lane), bb = *(const f32x4*)(P.in[I_CLB] + l * 256 + 4 * F.lane);
    u32x4 v[6];
#define CONF_LOAD(u_) do { const int t0_ = (u_) * 64; int s0_, s1_; seg_of(t0_, s0_, s1_); _Pragma("unroll") for (int k = 0; k < 6; ++k) { const int idx = F.tid + NTHR * k, rr = idx >> 5, c8 = idx & 31, gr = t0_ - 15 + rr; \
        const bool ok_ = idx < 94 * 32 && gr >= s0_ && gr < s1_; const u32x4 t_ = *(const u32x4*)(UA + (size_t)min(max(gr, s0_), s1_ - 1) * 256 + c8 * 8); v[k] = ok_ ? t_ : (u32x4){0u, 0u, 0u, 0u}; } } while (0)
    if (u0 < ntile) CONF_LOAD(u0);
    for (int u = u0; u < ntile; u += F.G) {
        const int t0 = u * 64;
#pragma unroll
        for (int k = 0; k < 6; ++k) { const int idx = F.tid + NTHR * k, rr = idx >> 5, c8 = idx & 31; if (idx < 94 * 32) *(LAS u32x4*)(tin + rr * 256 + c8 * 8) = v[k]; }
        __syncthreads();
        if (u + F.G < ntile) CONF_LOAD(u + F.G);
        {
            float in[62];
#pragma unroll
            for (int i = 0; i < 62; ++i) in[i] = bf2f(tin[(half * 32 + i) * 256 + c]);
#pragma unroll
            for (int t = 0; t < 32; ++t) { float a = b;
#pragma unroll
                for (int j = 0; j < 31; ++j) a += w[j] * in[t + j];
                cout[(half * 32 + t) * 260 + c] = a; }
        }
        __syncthreads();
        {
            f32x4 v[8]; float s[8], q[8];
#pragma unroll
            for (int tt = 0; tt < 8; ++tt) { v[tt] = *(const LAS f32x4*)(cout + (F.wave * 8 + tt) * 260 + 4 * F.lane); s[tt] = (v[tt][0] + v[tt][1]) + (v[tt][2] + v[tt][3]); }
#pragma unroll
            for (int tt = 0; tt < 8; ++tt) s[tt] = wave_sum(s[tt]);
#pragma unroll
            for (int tt = 0; tt < 8; ++tt) { v[tt] = v[tt] - s[tt] * (1.0f / 256.0f); q[tt] = (v[tt][0] * v[tt][0] + v[tt][1] * v[tt][1]) + (v[tt][2] * v[tt][2] + v[tt][3] * v[tt][3]); }
#pragma unroll
            for (int tt = 0; tt < 8; ++tt) q[tt] = wave_sum(q[tt]);
#pragma unroll
            for (int tt = 0; tt < 8; ++tt) { const float rstd = 1.0f / sqrtf(q[tt] * (1.0f / 256.0f) + LN_EPS);
                f32x4 y = v[tt] * rstd * g + bb;
#pragma unroll
                for (int j = 0; j < 4; ++j) y[j] = siluf_(y[j]);
                u32x2 wv; wv.x = cvt_pk_bf16(y[0], y[1]); wv.y = cvt_pk_bf16(y[2], y[3]);
                __builtin_nontemporal_store(wv, (u32x2*)(BR0 + (size_t)(t0 + F.wave * 8 + tt) * 256 + 4 * F.lane)); }
        }
        __syncthreads();
    }
}
#undef CONF_LOAD
__device__ __forceinline__ void shortconv_unit(Frame& F, const Params& P, int l, int t0) {
    const bf16* SB = (const bf16*)(F.ws + WS_SB); const bf16* W = (const bf16*)(F.ws + WS_W); bf16* BR2 = (bf16*)(F.ws + WS_BRV) + 2 * (size_t)MT * 256;
    int s0, s1; seg_of(t0, s0, s1);
    const float* cw = P.in[I_SCW] + l * 3 * 256;
#pragma unroll
    for (int k = 0; k < 4; ++k) { const int idx = F.tid + NTHR * k, tok = idx >> 5, c8 = (idx & 31) * 8, gr = t0 + tok;
        const u32x4 z = (u32x4){0u, 0u, 0u, 0u};
        const u32x4 wm_ = *(const u32x4*)(W + (size_t)max(gr - 1, s0) * 256 + c8), w0 = *(const u32x4*)(W + (size_t)gr * 256 + c8),
                    wp_ = *(const u32x4*)(W + (size_t)min(gr + 1, s1 - 1) * 256 + c8), sb = *(const u32x4*)(SB + (size_t)gr * 256 + c8);
        const u32x4 wm = (gr - 1 >= s0) ? wm_ : z, wp = (gr + 1 < s1) ? wp_ : z;
        float o[8];
#pragma unroll
        for (int j = 0; j < 4; ++j) { const int c = c8 + 2 * j;
            o[2 * j] = bflo(sb[j]) * (cw[c] * bflo(wm[j]) + cw[256 + c] * bflo(w0[j]) + cw[512 + c] * bflo(wp[j]));
            o[2 * j + 1] = bfhi(sb[j]) * (cw[c + 1] * bfhi(wm[j]) + cw[256 + c + 1] * bfhi(w0[j]) + cw[512 + c + 1] * bfhi(wp[j])); }
        u32x4 w; w.x = cvt_pk_bf16(o[0], o[1]); w.y = cvt_pk_bf16(o[2], o[3]); w.z = cvt_pk_bf16(o[4], o[5]); w.w = cvt_pk_bf16(o[6], o[7]);
        __builtin_nontemporal_store(w, (u32x4*)(BR2 + (size_t)gr * 256 + c8)); }
}
__device__ __forceinline__ void attn_stage_ctx(Frame& F, int b, int h) {
    const unsigned char* K = F.ws + WS_K; const unsigned char* VT = F.ws + WS_VT;
#pragma unroll
    for (int i = 0; i < 4; ++i) { const int pi = F.tid + NTHR * i;
        { const int key = pi >> 3, pc = pi & 7; const u32x4 v = *(const u32x4*)(K + (size_t)(TL + b * CTXL + key) * 512 + h * 128 + pc * 16);
          *(LAS u32x4*)(F.lds + key * 128 + ((pc ^ ((key & 3) | ((key >> 1) & 4))) << 4)) = v; }
        { const int dim = pi >> 5, pc = pi & 31; const u32x4 v = *(const u32x4*)(VT + ((size_t)(h * 64 + dim) * MT + TL + b * CTXL) * 2 + pc * 16);
          *(LAS u32x4*)(F.lds + 32768 + dim * 512 + ((pc ^ (dim & 7)) << 4)) = v; } }
}
__device__ __forceinline__ void attn_wave_unit(Frame& F, int wu, bool lat, bool cl  ) {
    const bf16* Q = (const bf16*)(F.ws + WS_Q); const bf16* K = (const bf16*)(F.ws + WS_K); const bf16* VT = (const bf16*)(F.ws + WS_VT);
    bf16* BR1 = (bf16*)(F.ws + WS_BRV) + (size_t)MT * 256;
    const LAS float* rpb = (const LAS float*)(F.lds + RPB_OFF);
    const int lane = lane_now(), q = lane & 15, g = lane >> 4;
    int b, h, r = 0, qb, tq0, cb = 0, r0 = 0;
    if (lat) { qb = wu & 3; h = (wu >> 2) & 3; r = (wu >> 4) & 255; b = wu >> 12; tq0 = b * SEQ + r * 64 + 16 * qb; cb = (qb == 0) ? 0 : (qb == 1 ? 8 : (qb == 2 ? 24 : 32)); r0 = min(max(r - 4, 0), 248); }
    else { qb = wu & 15; h = (wu >> 4) & 3; b = wu >> 6; tq0 = TL + b * CTXL + 16 * qb; }
    bf16x8 qf[2];
#pragma unroll
    for (int kk = 0; kk < 2; ++kk) qf[kk] = *(const bf16x8*)(Q + (size_t)(tq0 + q) * 256 + h * 64 + 32 * kk + 8 * g);
    const int koff = (q >> 2) * 8 + (q & 3);
    const unsigned klo = (unsigned)((koff * 256 + h * 64 + 8 * g) * 2);
    const unsigned vlo = (unsigned)((((h * 64 + q) * MT) + 8 * g) * 2);
    const char* Kc = (const char*)K; const char* Vc = (const char*)VT;
    const int kl0 = koff * 128 + ((g ^ ((q & 3) | (((q >> 2) & 1) << 2))) << 4), vl0 = 32768 + q * 512 + ((g ^ (q & 7)) << 4);
    const int cq = 16 * qb + q, c0 = min(max(cq - 8, 0), 48);
    float mx = -1e30f, sum = 0.f;
    f32x4 o[4];
#pragma unroll
    for (int bl = 0; bl < 4; ++bl) o[bl] = (f32x4){0.f, 0.f, 0.f, 0.f};
    bf16x8 kf[2][2][2];
#define ATT_KBASE(i_) (((i_) < 8) ? (b * SEQ + (r0 + (i_)) * 64 + cb) : (TL + b * CTXL + 32 * ((i_) - 8)))
#define ATT_LOADK(c_) do { _Pragma("unroll") for (int s_ = 0; s_ < 2; ++s_) { const int kb_ = ATT_KBASE(2 * (c_) + s_); _Pragma("unroll") for (int tt = 0; tt < 2; ++tt) { \
        if (cl && (c_) >= 4) { const int lo_ = (2 * (c_) + s_ - 8) * 4096 + tt * 512; kf[s_][tt][0] = *(const LAS bf16x8*)(F.lds + lo_ + kl0); kf[s_][tt][1] = *(const LAS bf16x8*)(F.lds + lo_ + (kl0 ^ 64)); } \
        else { const char* kp_ = Kc + (size_t)(kb_ + 4 * tt) * 512; kf[s_][tt][0] = *(const bf16x8*)(kp_ + klo); kf[s_][tt][1] = *(const bf16x8*)(kp_ + klo + 64); } } } } while (0)
#define ATT_LOADV(dst_, c_) do { _Pragma("unroll") for (int s_ = 0; s_ < 2; ++s_) { const int kb_ = ATT_KBASE(2 * (c_) + s_); _Pragma("unroll") for (int bl = 0; bl < 4; ++bl) \
        { if (cl && (c_) >= 4) { const int m_ = 2 * (c_) + s_ - 8; dst_[s_][bl] = *(const LAS bf16x8*)(F.lds + bl * 8192 + (m_ >> 1) * 128 + ((m_ & 1) ? (vl0 ^ 64) : vl0)); } \
          else dst_[s_][bl] = *(const bf16x8*)(Vc + ((size_t)(16 * bl) * MT + kb_) * 2 + vlo); } } } while (0)
    bf16x8 vf[2][4], vn[2][4];
    u32x4 kg[2][2][4], vg[2][4];
    LAS unsigned char* wb = F.lds + 65536 + F.wave * 8192;
    const int kq = lane >> 3;
    const int wk0 = kq * 128 + (((lane & 7) ^ (kq & 3)) << 4), wv0 = 4096 + (lane >> 2) * 64 + (((lane & 3) ^ ((lane >> 3) & 3)) << 4), vl1 = 4096 + q * 64 + ((g ^ ((q >> 1) & 3)) << 4);
    const unsigned gk = (unsigned)(kq * 512 + h * 128 + (lane & 7) * 16), gv = (unsigned)(((h * 64 + (lane >> 2)) * MT) * 2 + (lane & 3) * 16);
#define ATT_GLOADK(c_) do { _Pragma("unroll") for (int s_ = 0; s_ < 2; ++s_) { const int kb_ = ATT_KBASE(2 * (c_) + s_); _Pragma("unroll") for (int n = 0; n < 4; ++n) \
        kg[(c_) & 1][s_][n] = *(const u32x4*)(Kc + (size_t)kb_ * 512 + (size_t)n * 4096 + gk); } } while (0)
#define ATT_GLOADV(c_) do { _Pragma("unroll") for (int s_ = 0; s_ < 2; ++s_) { const int kb_ = ATT_KBASE(2 * (c_) + s_); _Pragma("unroll") for (int n = 0; n < 4; ++n) \
        vg[s_][n] = *(const u32x4*)(Vc + (size_t)kb_ * 2 + (size_t)n * 16 * MT * 2 + gv); } } while (0)
#define ATT_XPOSEK(c_) do { _Pragma("unroll") for (int s_ = 0; s_ < 2; ++s_) { \
        _Pragma("unroll") for (int n = 0; n < 4; ++n) *(LAS u32x4*)(wb + n * 1024 + ((n & 1) ? (wk0 ^ 64) : wk0)) = kg[(c_) & 1][s_][n]; \
        _Pragma("unroll") for (int tt = 0; tt < 2; ++tt) { kf[s_][tt][0] = *(const LAS bf16x8*)(wb + tt * 512 + kl0); kf[s_][tt][1] = *(const LAS bf16x8*)(wb + tt * 512 + (kl0 ^ 64)); } } } while (0)
#define ATT_XPOSEV() do { _Pragma("unroll") for (int s_ = 0; s_ < 2; ++s_) { \
        _Pragma("unroll") for (int n = 0; n < 4; ++n) *(LAS u32x4*)(wb + n * 1024 + wv0) = vg[s_][n]; \
        _Pragma("unroll") for (int bl = 0; bl < 4; ++bl) vf[s_][bl] = *(const LAS bf16x8*)(wb + bl * 1024 + vl1); } } while (0)
    if (cl) { ATT_GLOADK(0); ATT_GLOADV(0); ATT_GLOADK(1); } else if (lat) { ATT_LOADK(0); ATT_LOADV(vf, 0); } else { ATT_LOADK(4); ATT_LOADV(vf, 4); }
#pragma unroll
    for (int c = 0; c < 8; ++c) {
        if (c < 4 && !lat) continue;
        if (cl) { if (c < 4) { ATT_XPOSEK(c); if (c < 2) ATT_GLOADK(c + 2); } else { ATT_LOADK(c); ATT_LOADV(vf, c); } }
        f32x4 s[2][2];
#pragma unroll
        for (int s_ = 0; s_ < 2; ++s_)
#pragma unroll
            for (int tt = 0; tt < 2; ++tt) {
                f32x4 a = (f32x4){0.f, 0.f, 0.f, 0.f};
                a = __builtin_amdgcn_mfma_f32_16x16x32_bf16(kf[s_][tt][0], qf[0], a, 0, 0, 0);
                a = __builtin_amdgcn_mfma_f32_16x16x32_bf16(kf[s_][tt][1], qf[1], a, 0, 0, 0);
                if (c < 4) {
                    const int i = 2 * c + s_;
                    const LAS float* rp = rpb + (h * 15 + (r0 + i - r + 7)) * 31;
#pragma unroll
                    for (int j = 0; j < 4; ++j) { const int kc = cb + 8 * g + 4 * tt + j; const bool ok = (kc >= c0) && (kc < c0 + 16);
                        const int dc = min(max(kc - cq + 15, 0), 30);
                        a[j] = ok ? a[j] + rp[dc] : -1e30f; }
                }
                s[s_][tt] = a;
            }
        if (!cl && c < 7) { ATT_LOADK(c + 1); ATT_LOADV(vn, c + 1); }
        if (cl && c < 4) { ATT_XPOSEV(); if (c < 3) ATT_GLOADV(c + 1); }
        float cm = -1e30f;
#pragma unroll
        for (int s_ = 0; s_ < 2; ++s_)
#pragma unroll
            for (int tt = 0; tt < 2; ++tt)
#pragma unroll
                for (int j = 0; j < 4; ++j) cm = fmaxf(cm, s[s_][tt][j]);
        cm = xrow_max(cm);
        const float mn = fmaxf(mx, cm), alpha = __builtin_amdgcn_exp2f(mx - mn);
        mx = mn; sum *= alpha;
#pragma unroll
        for (int bl = 0; bl < 4; ++bl) o[bl] *= alpha;
#pragma unroll
        for (int s_ = 0; s_ < 2; ++s_) {
            float p[8];
#pragma unroll
            for (int tt = 0; tt < 2; ++tt)
#pragma unroll
                for (int j = 0; j < 4; ++j) { const float e = __builtin_amdgcn_exp2f(s[s_][tt][j] - mn); p[4 * tt + j] = e; sum += e; }
            u32x4 pw; pw.x = cvt_pk_bf16(p[0], p[1]); pw.y = cvt_pk_bf16(p[2], p[3]); pw.z = cvt_pk_bf16(p[4], p[5]); pw.w = cvt_pk_bf16(p[6], p[7]);
            const bf16x8 pf = __builtin_bit_cast(bf16x8, pw);
#pragma unroll
            for (int bl = 0; bl < 4; ++bl) o[bl] = __builtin_amdgcn_mfma_f32_16x16x32_bf16(vf[s_][bl], pf, o[bl], 0, 0, 0);
        }
        if (!cl && c < 7) {
#pragma unroll
            for (int s_ = 0; s_ < 2; ++s_)
#pragma unroll
                for (int bl = 0; bl < 4; ++bl) vf[s_][bl] = vn[s_][bl];
        }
    }
#undef ATT_XPOSEK
#undef ATT_XPOSEV
#undef ATT_GLOADK
#undef ATT_GLOADV
#undef ATT_LOADV
#undef ATT_LOADK
#undef ATT_KBASE
    sum = xrow_sum(sum);
    const float inv = 1.0f / sum;
#pragma unroll
    for (int bl = 0; bl < 4; ++bl) { u32x2 w; w.x = cvt_pk_bf16(o[bl][0] * inv, o[bl][1] * inv); w.y = cvt_pk_bf16(o[bl][2] * inv, o[bl][3] * inv);
        __builtin_nontemporal_store(w, (u32x2*)(BR1 + (size_t)(tq0 + q) * 256 + h * 64 + 16 * bl + 4 * g)); }
}

constexpr int FL = 16384;
__device__ __forceinline__ f32x2 cmul(f32x2 a, f32x2 b) {
    f32x2 t, r;
    asm("v_pk_mul_f32 %1, %2, %3 op_sel:[1,1] op_sel_hi:[1,0]\n\tv_pk_fma_f32 %0, %2, %3, %1 op_sel:[0,0,0] op_sel_hi:[0,1,1] neg_lo:[0,0,1]" : "=v"(r), "=&v"(t) : "v"(a), "v"(b));
    return r;
}
__device__ __forceinline__ f32x2 cmulc(f32x2 a, f32x2 b) {
    f32x2 t, r;
    asm("v_pk_mul_f32 %1, %2, %3 op_sel:[1,1] op_sel_hi:[1,0]\n\tv_pk_fma_f32 %0, %2, %3, %1 op_sel:[0,0,0] op_sel_hi:[0,1,1] neg_hi:[1,0,0]" : "=v"(r), "=&v"(t) : "v"(a), "v"(b));
    return r;
}
__device__ __forceinline__ f32x2 rotm(f32x2 b, f32x2 d) { f32x2 r; asm("v_pk_add_f32 %0, %1, %2 op_sel:[0,1] op_sel_hi:[1,0] neg_hi:[0,1]" : "=v"(r) : "v"(b), "v"(d)); return r; }
__device__ __forceinline__ f32x2 rotp(f32x2 b, f32x2 d) { f32x2 r; asm("v_pk_add_f32 %0, %1, %2 op_sel:[0,1] op_sel_hi:[1,0] neg_lo:[0,1]" : "=v"(r) : "v"(b), "v"(d)); return r; }
__device__ __forceinline__ f32x2 tw_main(const LAS f32x2* T, int m) { return cmul(T[m >> 7], T[128 + (m & 127)]); }
__device__ __forceinline__ f32x2 tw_half(const LAS f32x2* T, int n) { return cmul(T[256 + (n >> 7)], T[384 + (n & 127)]); }
__device__ __forceinline__ void r4f(f32x2& x0, f32x2& x1, f32x2& x2, f32x2& x3, f32x2 w1, f32x2 w2, f32x2 w3) {
    const f32x2 a = x0 + x2, b = x0 - x2, c = x1 + x3, d = x1 - x3;
    x0 = a + c; x1 = cmul(rotm(b, d), w1); x2 = cmul(a - c, w2); x3 = cmul(rotp(b, d), w3);
}
__device__ __forceinline__ void r4f1(f32x2& x0, f32x2& x1, f32x2& x2, f32x2& x3) {
    const f32x2 a = x0 + x2, b = x0 - x2, c = x1 + x3, d = x1 - x3;
    x0 = a + c; x1 = rotm(b, d); x2 = a - c; x3 = rotp(b, d);
}
__device__ __forceinline__ void r4i(f32x2& x0, f32x2& x1, f32x2& x2, f32x2& x3, f32x2 w1, f32x2 w2, f32x2 w3) {
    const f32x2 t1 = cmulc(x1, w1), t2 = cmulc(x2, w2), t3 = cmulc(x3, w3);
    const f32x2 a = x0 + t2, b = x0 - t2, c = t1 + t3, d = t1 - t3;
    x0 = a + c; x1 = rotp(b, d); x2 = a - c; x3 = rotm(b, d);
}
__device__ __forceinline__ void r4i1(f32x2& x0, f32x2& x1, f32x2& x2, f32x2& x3) {
    const f32x2 a = x0 + x2, b = x0 - x2, c = x1 + x3, d = x1 - x3;
    x0 = a + c; x1 = rotp(b, d); x2 = a - c; x3 = rotm(b, d);
}
#define W16_1 ((f32x2){0.92387953251f, -0.38268343237f})
#define W16_2 ((f32x2){0.70710678119f, -0.70710678119f})
#define W16_3 ((f32x2){0.38268343237f, -0.92387953251f})
template <int SP, bool INV> __device__ __forceinline__ void fft_pass16(LAS f32x2* B, const LAS f32x2* T, int tid) {
    constexpr int STEP = (SP == 1024) ? 1040 : (SP == 64 ? 65 : 4);
#pragma unroll
    for (int jj = 0; jj < 2; ++jj) {
        const int q = tid + 512 * jj;
        int k, base;
        if (SP == 1024) { k = q; base = q + (q >> 6); }
        else if (SP == 64) { k = q & 63; const int i0 = (q >> 6) * 1024 + k; base = i0 + (i0 >> 6); }
        else { k = q >> 8; base = (q & 255) * 65 + k; }
        LAS f32x2* p = B + base;
        f32x2 x[16];
#pragma unroll
        for (int m = 0; m < 16; ++m) x[m] = p[m * STEP];
        const f32x2 b = tw_main(T, k * (1024 / SP));
        const f32x2 b2 = cmul(b, b), w = cmul(b2, b2), w2 = cmul(w, w), w3 = cmul(w, w2);
        f32x2 t1[4], t2[4], t3[4];
        t1[0] = b; t1[1] = cmul(b, W16_1); t1[2] = cmul(b, W16_2); t1[3] = cmul(b, W16_3);
#pragma unroll
        for (int m = 0; m < 4; ++m) { t2[m] = cmul(t1[m], t1[m]); t3[m] = cmul(t1[m], t2[m]); }
        if (!INV) {
#pragma unroll
            for (int m = 0; m < 4; ++m) r4f(x[m], x[m + 4], x[m + 8], x[m + 12], t1[m], t2[m], t3[m]);
#pragma unroll
            for (int j = 0; j < 4; ++j) r4f(x[4 * j], x[4 * j + 1], x[4 * j + 2], x[4 * j + 3], w, w2, w3);
        } else {
#pragma unroll
            for (int j = 0; j < 4; ++j) r4i(x[4 * j], x[4 * j + 1], x[4 * j + 2], x[4 * j + 3], w, w2, w3);
#pragma unroll
            for (int m = 0; m < 4; ++m) r4i(x[m], x[m + 4], x[m + 8], x[m + 12], t1[m], t2[m], t3[m]);
        }
#pragma unroll
        for (int m = 0; m < 16; ++m) p[m * STEP] = x[m];
    }
    __syncthreads();
}
template <bool INV> __device__ __forceinline__ void fft_pass4(LAS f32x2* B, int tid) {
#pragma unroll 4
    for (int jj = 0; jj < 8; ++jj) {
        const int q = tid + 512 * jj;
        LAS f32x2* p = B + (q & 255) * 65 + 4 * (q >> 8);
        f32x2 x0 = p[0], x1 = p[1], x2 = p[2], x3 = p[3];
        if (!INV) r4f1(x0, x1, x2, x3); else r4i1(x0, x1, x2, x3);
        p[0] = x0; p[1] = x1; p[2] = x2; p[3] = x3;
    }
    __syncthreads();
}
__device__ __forceinline__ void fft_fwd(LAS f32x2* B, const LAS f32x2* T, int tid) {
    fft_pass16<1024, false>(B, T, tid); fft_pass16<64, false>(B, T, tid); fft_pass16<4, false>(B, T, tid); fft_pass4<false>(B, tid);
}
__device__ __forceinline__ void fft_inv(LAS f32x2* B, const LAS f32x2* T, int tid) {
    fft_pass4<true>(B, tid); fft_pass16<4, true>(B, T, tid); fft_pass16<64, true>(B, T, tid); fft_pass16<1024, true>(B, T, tid);
}
__device__ __forceinline__ void fft_pass4_keep(LAS f32x2* B, int tid, u32x4 (&ks)[8]) {
#pragma unroll
    for (int jj = 0; jj < 8; ++jj) {
        const int q = tid + 512 * jj;
        const LAS f32x2* p = B + (q & 255) * 65 + 4 * (q >> 8);
        f32x2 x0 = p[0], x1 = p[1], x2 = p[2], x3 = p[3];
        r4f1(x0, x1, x2, x3);
        ks[jj].x = cvt_pk_bf16(x0.x, x0.y); ks[jj].y = cvt_pk_bf16(x1.x, x1.y); ks[jj].z = cvt_pk_bf16(x2.x, x2.y); ks[jj].w = cvt_pk_bf16(x3.x, x3.y);
    }
    __syncthreads();
}
__device__ __forceinline__ void fft_mid4(LAS f32x2* B, int tid, const u32x4 (&ks)[8]) {
#pragma unroll
    for (int jj = 0; jj < 8; ++jj) {
        const int q = tid + 512 * jj;
        LAS f32x2* p = B + (q & 255) * 65 + 4 * (q >> 8);
        f32x2 x0 = p[0], x1 = p[1], x2 = p[2], x3 = p[3];
        r4f1(x0, x1, x2, x3);
        x0 = cmul(x0, (f32x2){bflo(ks[jj].x), bfhi(ks[jj].x)}); x1 = cmul(x1, (f32x2){bflo(ks[jj].y), bfhi(ks[jj].y)});
        x2 = cmul(x2, (f32x2){bflo(ks[jj].z), bfhi(ks[jj].z)}); x3 = cmul(x3, (f32x2){bflo(ks[jj].w), bfhi(ks[jj].w)});
        r4i1(x0, x1, x2, x3);
        p[0] = x0; p[1] = x1; p[2] = x2; p[3] = x3;
    }
    __syncthreads();
}
__device__ __forceinline__ void fft_fwd3(LAS f32x2* B, const LAS f32x2* T, int tid) { fft_pass16<1024, false>(B, T, tid); fft_pass16<64, false>(B, T, tid); fft_pass16<4, false>(B, T, tid); }
__device__ __forceinline__ void fft_inv3(LAS f32x2* B, const LAS f32x2* T, int tid) { fft_pass16<4, true>(B, T, tid); fft_pass16<64, true>(B, T, tid); fft_pass16<1024, true>(B, T, tid); }
__device__ __forceinline__ float conv3_at(const bf16* p, int n, int L, float w0, float w1, float w2, float b) {
    const float xm = n > 0 ? bf2f(p[n - 1]) : 0.f, x0 = bf2f(p[n]), xp = n + 1 < L ? bf2f(p[n + 1]) : 0.f;
    return w0 * xm + w1 * x0 + w2 * xp + b;
}
__device__ __forceinline__ float block_sum(Frame& F, float v) {
    LAS float* red = (LAS float*)(F.lds + RED_OFF);
    v = wave_sum(v);
    __syncthreads();
    if (F.lane == 0) red[F.wave] = v;
    __syncthreads();
    float s = 0.f;
#pragma unroll
    for (int w = 0; w < 8; ++w) s += red[w];
    return s;
}
__device__ __forceinline__ f32x4 conv3x4(const bf16* p, int nb, float w0, float w1, float w2, float b) {
    const u32x2 m = *(const u32x2*)(p + nb);
    const float x0 = bflo(m.x), x1 = bfhi(m.x), x2 = bflo(m.y), x3 = bfhi(m.y);
    const float xm = nb > 0 ? bf2f(p[nb - 1]) : 0.f, xp = nb + 4 < SEQ ? bf2f(p[nb + 4]) : 0.f;
    return (f32x4){w0 * xm + w1 * x0 + w2 * x1 + b, w0 * x0 + w1 * x1 + w2 * x2 + b, w0 * x1 + w1 * x2 + w2 * x3 + b, w0 * x2 + w1 * x3 + w2 * xp + b};
}
typedef u32x4 u32x4_a4 __attribute__((aligned(4)));
__device__ __forceinline__ u32x4 ld16u(const bf16* p) { return *(const u32x4_a4*)p; }
__device__ __forceinline__ void conv3p(const u32x4 a, const u32x4 b, bool first, bool last, float w0, float w1, float w2, float bb, f32x2 (&z)[4]) {
    f32x2 X[6];
    X[0] = (f32x2){bfhi(a.x), bfhi(b.x)}; X[1] = (f32x2){bflo(a.y), bflo(b.y)}; X[2] = (f32x2){bfhi(a.y), bfhi(b.y)};
    X[3] = (f32x2){bflo(a.z), bflo(b.z)}; X[4] = (f32x2){bfhi(a.z), bfhi(b.z)}; X[5] = (f32x2){bflo(a.w), bflo(b.w)};
    if (first) X[0] = (f32x2){0.f, 0.f};
    if (last) X[5] = (f32x2){0.f, 0.f};
#pragma unroll
    for (int e = 0; e < 4; ++e) z[e] = X[e] * w0 + (X[e + 1] * w1 + (X[e + 2] * w2 + bb));
}
__device__ __forceinline__ void hyena_unit(Frame& F, const Params& P, int l, int c, bool dummy) {
    LAS f32x2* B = (LAS f32x2*)F.lds; const LAS f32x2* T = (const LAS f32x2*)(F.lds + TW_OFF);
    const bf16* HT = (const bf16*)(F.ws + WS_HT); const bf16* FILT = (const bf16*)(F.ws + WS_FILT);
    f32x4* Z = (f32x4*)(F.ws + WS_KSCR + (size_t)F.bid * 131072);
    u32x4 ksr[8];
    u32x4* ES = (u32x4*)(F.ws + WS_ES + (size_t)F.bid * 131072) + 4096;
    bf16* BR3 = (bf16*)(F.ws + WS_BRV) + 3 * (size_t)MT * 256;
    const float* sw = P.in[I_HSW] + l * 3 * 768; const float* sb = P.in[I_HSB] + l * 768;
    const int tid = F.tid;
#define HY_NB(jp_) (4 * tq + 2048 * (jp_))
#define HY_TQ int tq = tid; asm volatile("" : "+v"(tq))
#define HY_G(T_, base_, boff_) (*(T_*)((char*)(base_) + (unsigned)(boff_)))
#define HY_LDX(row_, nb_) (*(const u32x4_a4*)((const char*)((row_) - 2) + (unsigned)((nb_) * 2)))
#define HY_LDR(hb_, nb_) (*(const u32x4_a4*)((const char*)((hb_) - 2) + (unsigned)((FL - 4 - (nb_)) * 2)))
#define HY_SLOT(nb_) (B + (nb_) + ((nb_) >> 6))
#define HY_TW4(nb_, w_) do { const f32x2 tb_ = T[256 + ((nb_) >> 7)]; const LAS f32x4* tp_ = (const LAS f32x4*)(T + 384 + ((nb_) & 127)); const f32x4 ta_ = tp_[0], tc_ = tp_[1]; \
        w_[0] = cmul(tb_, (f32x2){ta_[0], ta_[1]}); w_[1] = cmul(tb_, (f32x2){ta_[2], ta_[3]}); w_[2] = cmul(tb_, (f32x2){tc_[0], tc_[1]}); w_[3] = cmul(tb_, (f32x2){tc_[2], tc_[3]}); } while (0)
#define HY_ST4(nb_, c0_, c1_, c2_, c3_) do { LAS f32x2* bp_ = HY_SLOT(nb_); bp_[0] = (c0_); bp_[1] = (c1_); bp_[2] = (c2_); bp_[3] = (c3_); } while (0)
#define HY_UNPK(w_) ((f32x2){bflo(w_), bfhi(w_)})
#define HY_FILT4(fw_, gw_, nb_, f4_, r4_) const f32x4 f4_ = (f32x4){bflo(fw_.x), bfhi(fw_.x), bflo(fw_.y), bfhi(fw_.y)};   \
        const f32x4 r4_ = (f32x4){(nb_) ? bflo(gw_.w) : 0.f, bfhi(gw_.z), bflo(gw_.z), bfhi(gw_.y)}
    {
        const bf16* p0 = HT + (size_t)c * MT; const float v0 = sw[c], v1 = sw[768 + c], v2 = sw[1536 + c], vb = sb[c];
        { HY_TQ;
#pragma unroll
        for (int h = 0; h < 2; ++h) {
            u32x4 xa[4], xb[4];
#pragma unroll
            for (int j = 0; j < 4; ++j) { const int nb = HY_NB(4 * h + j); xa[j] = HY_LDX(p0, nb); xb[j] = HY_LDX(p0 + SEQ, nb); }
#pragma unroll
            for (int j = 0; j < 4; ++j) { const int nb = HY_NB(4 * h + j); f32x2 z[4]; conv3p(xa[j], xb[j], nb == 0, nb + 4 == SEQ, v0, v1, v2, vb, z);
                HY_G(f32x4, Z, nb * 8) = (f32x4){z[0].x, z[0].y, z[1].x, z[1].y}; HY_G(f32x4, Z + 1, nb * 8) = (f32x4){z[2].x, z[2].y, z[3].x, z[3].y}; }
        } }
    }
#pragma unroll 1
    for (int o = 0; o < 2; ++o) {
        const bf16* hf = FILT + (size_t)((o * 2 + 0) * 256 + c) * SEQ; const bf16* hb = FILT + (size_t)((o * 2 + 1) * 256 + c) * SEQ;
        float ss = 0.f;
#pragma unroll 1
        for (int par = 0; par < 2; ++par) {
            if (par == 0) {
                { HY_TQ;
#pragma unroll
                for (int h = 0; h < 2; ++h) {
                    u32x2 fw[4]; u32x4 gw[4];
#pragma unroll
                    for (int j = 0; j < 4; ++j) { const int nb = HY_NB(4 * h + j); fw[j] = HY_G(const u32x2, hf, nb * 2); gw[j] = HY_LDR(hb, nb); }
#pragma unroll
                    for (int j = 0; j < 4; ++j) { const int nb = HY_NB(4 * h + j); HY_FILT4(fw[j], gw[j], nb, f4, r4);
                        const f32x4 a = f4 + r4; ss += (f4[0] * f4[0] + f4[1] * f4[1]) + (f4[2] * f4[2] + f4[3] * f4[3]) + (r4[0] * r4[0] + r4[1] * r4[1]) + (r4[2] * r4[2] + r4[3] * r4[3]);
                        HY_ST4(nb, ((f32x2){a[0], 0.f}), ((f32x2){a[1], 0.f}), ((f32x2){a[2], 0.f}), ((f32x2){a[3], 0.f})); }
                } }
                __syncthreads();
            }
            fft_fwd3(B, T, tid); fft_pass4_keep(B, tid, ksr);
            { HY_TQ;
#pragma unroll
            for (int h = 0; h < 2; ++h) {
                f32x4 za[4], zb[4];
#pragma unroll
                for (int j = 0; j < 4; ++j) { const int nb = HY_NB(4 * h + j); za[j] = HY_G(const f32x4, Z, nb * 8); zb[j] = HY_G(const f32x4, Z + 1, nb * 8); }
#pragma unroll
                for (int j = 0; j < 4; ++j) { const int nb = HY_NB(4 * h + j);
                    const f32x2 z0 = (f32x2){za[j].x, za[j].y}, z1 = (f32x2){za[j].z, za[j].w}, z2 = (f32x2){zb[j].x, zb[j].y}, z3 = (f32x2){zb[j].z, zb[j].w};
                    if (par == 0) { HY_ST4(nb, z0, z1, z2, z3); }
                    else { f32x2 tw[4]; HY_TW4(nb, tw); HY_ST4(nb, cmul(z0, tw[0]), cmul(z1, tw[1]), cmul(z2, tw[2]), cmul(z3, tw[3])); } }
            } }
            __syncthreads();
            fft_fwd3(B, T, tid); fft_mid4(B, tid, ksr);
            fft_inv3(B, T, tid);
            if (par == 0) {
                { HY_TQ;
#pragma unroll
                for (int h = 0; h < 2; ++h) {
                    u32x2 fw[4]; u32x4 gw[4];
#pragma unroll
                    for (int j = 0; j < 4; ++j) { const int nb = HY_NB(4 * h + j); fw[j] = HY_G(const u32x2, hf, nb * 2); gw[j] = HY_LDR(hb, nb); }
#pragma unroll
                    for (int j = 0; j < 4; ++j) { const int jp = 4 * h + j, nb = HY_NB(jp); const LAS f32x2* bp = HY_SLOT(nb); const f32x2 a0 = bp[0] * (1.0f / 16384.0f), a1 = bp[1] * (1.0f / 16384.0f), a2 = bp[2] * (1.0f / 16384.0f), a3 = bp[3] * (1.0f / 16384.0f);
                        u32x4 w; w.x = cvt_pk_bf16(a0.x, a0.y); w.y = cvt_pk_bf16(a1.x, a1.y); w.z = cvt_pk_bf16(a2.x, a2.y); w.w = cvt_pk_bf16(a3.x, a3.y); HY_G(u32x4, ES + jp * 512, tq * 16) = w;
                        HY_FILT4(fw[j], gw[j], nb, f4, r4);
                        const f32x4 d = f4 - r4; f32x2 tw[4]; HY_TW4(nb, tw); HY_ST4(nb, tw[0] * d[0], tw[1] * d[1], tw[2] * d[2], tw[3] * d[3]); }
                } }
                __syncthreads();
            }
        }
        const float nrm = (1.0f / sqrtf(block_sum(F, ss) + 1e-6f)) * 0.5f;
        const float hbias = P.in[I_HBI][(l * 2 + o) * 256 + c];
        const int ch = (o + 1) * 256 + c;
        const bf16* px = HT + (size_t)ch * MT; const float w0 = sw[ch], w1 = sw[768 + ch], w2 = sw[1536 + ch], bb = sb[ch];
        { HY_TQ;
#pragma unroll
        for (int h = 0; h < 4; ++h) {
            u32x4 ev[2], xa[2], xb[2]; f32x4 za[2], zb[2];
#pragma unroll
            for (int j = 0; j < 2; ++j) { const int jp = 2 * h + j, nb = HY_NB(jp); ev[j] = HY_G(const u32x4, ES + jp * 512, tq * 16); za[j] = HY_G(const f32x4, Z, nb * 8); zb[j] = HY_G(const f32x4, Z + 1, nb * 8); xa[j] = HY_LDX(px, nb); xb[j] = HY_LDX(px + SEQ, nb); }
#pragma unroll
            for (int j = 0; j < 2; ++j) { const int nb = HY_NB(2 * h + j);
                const LAS f32x2* bp = HY_SLOT(nb); f32x2 w[4]; HY_TW4(nb, w);
                const f32x2 e0 = HY_UNPK(ev[j].x) + cmulc(bp[0], w[0]) * (1.0f / 16384.0f), e1 = HY_UNPK(ev[j].y) + cmulc(bp[1], w[1]) * (1.0f / 16384.0f),
                            e2 = HY_UNPK(ev[j].z) + cmulc(bp[2], w[2]) * (1.0f / 16384.0f), e3 = HY_UNPK(ev[j].w) + cmulc(bp[3], w[3]) * (1.0f / 16384.0f);
                f32x2 x[4]; conv3p(xa[j], xb[j], nb == 0, nb + 4 == SEQ, w0, w1, w2, bb, x);
                const f32x2 y0 = (e0 * nrm + (f32x2){za[j].x, za[j].y} * hbias) * x[0], y1 = (e1 * nrm + (f32x2){za[j].z, za[j].w} * hbias) * x[1],
                            y2 = (e2 * nrm + (f32x2){zb[j].x, zb[j].y} * hbias) * x[2], y3 = (e3 * nrm + (f32x2){zb[j].z, zb[j].w} * hbias) * x[3];
                if (o == 0) { HY_G(f32x4, Z, nb * 8) = (f32x4){y0.x, y0.y, y1.x, y1.y}; HY_G(f32x4, Z + 1, nb * 8) = (f32x4){y2.x, y2.y, y3.x, y3.y}; }
                else if (!dummy) {
                    const unsigned u0 = cvt_pk_bf16(y0.x, y0.y), u1 = cvt_pk_bf16(y1.x, y1.y), u2 = cvt_pk_bf16(y2.x, y2.y), u3 = cvt_pk_bf16(y3.x, y3.y);
                    bf16* q0 = BR3 + c; bf16* q1 = q0 + (size_t)SEQ * 256; const int ob = nb * 512;
                    HY_G(bf16, q0, ob) = (bf16)(u0 & 0xffffu); HY_G(bf16, q0 + 256, ob) = (bf16)(u1 & 0xffffu); HY_G(bf16, q0 + 512, ob) = (bf16)(u2 & 0xffffu); HY_G(bf16, q0 + 768, ob) = (bf16)(u3 & 0xffffu);
                    HY_G(bf16, q1, ob) = (bf16)(u0 >> 16); HY_G(bf16, q1 + 256, ob) = (bf16)(u1 >> 16); HY_G(bf16, q1 + 512, ob) = (bf16)(u2 >> 16); HY_G(bf16, q1 + 768, ob) = (bf16)(u3 >> 16); }
            }
        } }
        __syncthreads();
    }
#undef HY_NB
#undef HY_TQ
#undef HY_G
#undef HY_LDX
#undef HY_LDR
#undef HY_FILT4
#undef HY_TW4
#undef HY_ST4
#undef HY_SLOT
#undef HY_UNPK
}
__device__ __forceinline__ void hyena_ctx_unit(Frame& F, const Params& P, int l, int c) {
    LAS float* zc = (LAS float*)F.lds;
    LAS float* kk = (LAS float*)(F.lds + 4096);
    const bf16* HT = (const bf16*)(F.ws + WS_HT); const float* FC = (const float*)(F.ws + WS_FILTC);
    bf16* BR3 = (bf16*)(F.ws + WS_BRV) + 3 * (size_t)MT * 256;
    const float* sw = P.in[I_HSW] + l * 3 * 768; const float* sb = P.in[I_HSB] + l * 768;
    const int b = F.tid >> 8, t = F.tid & 255;
    float zv = conv3_at(HT + (size_t)c * MT + TL + b * CTXL, t, CTXL, sw[c], sw[768 + c], sw[1536 + c], sb[c]);
    for (int o = 0; o < 2; ++o) {
        const float* hf = FC + (size_t)((o * 2 + 0) * 256 + c) * CTXL; const float* hb = FC + (size_t)((o * 2 + 1) * 256 + c) * CTXL;
        float ss = 0.f;
        if (F.tid < 256) { const float f = hf[F.tid]; kk[255 + F.tid] = f; ss = f * f; }
        else { const int d = F.tid - 256; if (d >= 1) { const float f = hb[d]; kk[255 - d] = f; ss = f * f; } }
        zc[F.tid] = zv;
        const float nrm = 1.0f / sqrtf(block_sum(F, ss) + 1e-6f);
        float y = 0.f;
        for (int s_ = 0; s_ < 256; ++s_) y += kk[t - s_ + 255] * zc[b * 256 + s_];
        y = y * nrm + P.in[I_HBI][(l * 2 + o) * 256 + c] * zv;
        const int ch = (o + 1) * 256 + c;
        zv = conv3_at(HT + (size_t)ch * MT + TL + b * CTXL, t, CTXL, sw[ch], sw[768 + ch], sw[1536 + ch], sb[ch]) * y;
        __syncthreads();
    }
    BR3[(size_t)(TL + b * CTXL + t) * 256 + c] = (bf16)(cvt_pk_bf16(zv, 0.f) & 0xffffu);
}
__device__ __forceinline__ void phase_mixer(Frame& F, const Params& P, int l, bool last) {
    {
        LAS float* rpb = (LAS float*)(F.lds + RPB_OFF); for (int i = F.tid; i < 1860; i += NTHR) rpb[i] = P.in[I_RPB][l * 1860 + i] * 1.44269504089f;
        LAS f32x2* T = (LAS f32x2*)(F.lds + TW_OFF);
        if (F.tid < 512) { const int tb = F.tid >> 7, a = F.tid & 127; const float x = tb == 0 ? (float)a / 128.0f : (tb == 1 ? (float)a / 16384.0f : (tb == 2 ? (float)a / 256.0f : (float)a / 32768.0f));
            float s, cs; sincospif(2.0f * x, &s, &cs); T[F.tid] = (f32x2){cs, -s}; }
        __syncthreads();
    }
#ifndef MIXMASK
#define MIXMASK 63
#endif
    if (MIXMASK & 1) for (int c = F.bid; c < 256; c += F.G) hyena_unit(F, P, l, ((c & 7) << 5) | (c >> 3), false);
    if (MIXDUP & 1) for (int c = F.bid; c < 256; c += F.G) hyena_unit(F, P, l, c, true);
    if (MIXMASK & 2) if (!last) for (int rep_ = 0; rep_ <= ((MIXDUP >> 1) & 1); ++rep_) for (int c = F.bid; c < 256; c += F.G) { hyena_ctx_unit(F, P, l, c); __syncthreads(); }
    const int ntile = (last ? TL : MT) / 64;
    if (MIXMASK & 4) for (int rep_ = 0; rep_ <= ((MIXDUP >> 2) & 1); ++rep_) conformer_tiles(F, P, l, (F.bid + F.G / 2) % F.G, ntile);
    if (MIXMASK & 8) for (int rep_ = 0; rep_ <= ((MIXDUP >> 3) & 1); ++rep_) for (int u = (F.bid + F.G / 4) % F.G; u < ntile; u += F.G) shortconv_unit(F, P, l, u * 64);
    const int gw = F.bid * NWAVES + F.wave, NGW = F.G * NWAVES;
    if (MIXMASK & 16) for (int rep_ = 0; rep_ <= ((MIXDUP >> 4) & 1); ++rep_) for (int task = F.bid; task < 256; task += F.G) {
        const int h = task & 3, b = task >> 7, rb = ((task >> 2) & 31) * 8;
        __syncthreads();
        attn_stage_ctx(F, b, h);
        __syncthreads();
#pragma unroll 1
        for (int it = 0; it < 4; ++it) { int wu = (b << 12) | ((rb + 2 * it + (F.wave >> 2)) << 4) | (h << 2) | (F.wave & 3); asm volatile("" : "+s"(wu));
            attn_wave_unit(F, wu, true, true); }
    }
    if (MIXMASK & 32) if (!last) for (int wu = gw; wu < 128; wu += NGW) attn_wave_unit(F, wu, false, false);
}

__global__ void __launch_bounds__(NTHR, 2) mk_fwd(Params P) {
    extern __shared__ __attribute__((aligned(16))) unsigned char lds_raw[];
    Frame F;
    const int wave0 = __builtin_amdgcn_readfirstlane(threadIdx.x >> 6);
    F.lds = (LAS unsigned char*)lds_raw; F.tid = threadIdx.x; F.lane = F.tid & 63; F.wave = __builtin_amdgcn_readfirstlane(F.tid >> 6); F.bid = blockIdx.x; F.G = gridDim.x; F.ws = P.ws;
    volatile LAS unsigned* MISC = (volatile LAS unsigned*)(F.lds + MISC_OFF);
    if (F.tid < 4) MISC[F.tid] = 0u;
    __syncthreads();
    XcdBarrier bar = xcd_barrier_post((unsigned*)(P.ws + WS_CTL) + 4096, MISC);
    const int lo = P.ph_lo, hi = P.ph_hi;
    int ph = 0;
#define PHASE_BEGIN if (ph >= lo && ph < hi) { { int t_; asm volatile("v_mbcnt_lo_u32_b32 %0, -1, 0\n\tv_mbcnt_hi_u32_b32 %0, -1, %0" : "=v"(t_)); t_ |= wave0 << 6; F.tid = t_; F.lane = t_ & 63; F.wave = __builtin_amdgcn_readfirstlane(t_ >> 6); size_t o_ = 0; asm volatile("" : "+s"(o_)); F.ws = P.ws + o_; }
#define PHASE_END   if (ph + 1 < hi) xcd_barrier(bar, F.tid); } ++ph;
#define MOD ((const float*)(F.ws + WS_MOD))
#define Hc ((const char*)(F.ws + WS_H))

    PHASE_BEGIN if (PHMASK & (1u << 0)) for (int rep_ = 0; rep_ <= (int)((DUPMASK >> 0) & 1u); ++rep_) { prologue_a(F, P); } PHASE_END
    PHASE_BEGIN if (PHMASK & (1u << 1)) for (int rep_ = 0; rep_ <= (int)((DUPMASK >> 1) & 1u); ++rep_) { phase_mod0(F, P); phase_filters(F, P, 0, true); } PHASE_END

    for (int l = 0; l < 2; ++l) {
        const bool last = (l == 1);
#define modl (MOD + (size_t)l * 3 * 9216)
#define xl ((l == 0) ? (const void*)P.in[I_X] : (const void*)P.out)
#define xc ((l == 0) ? P.in[I_CTX] : (const float*)(F.ws + WS_XC))
#define xcw ((const float*)(F.ws + WS_XC))
        PHASE_BEGIN if (PHMASK & (1u << 2)) for (int rep_ = 0; rep_ <= (int)((DUPMASK >> 2) & 1u); ++rep_) { { SchedPlain S{Hc, (const char*)(F.ws + WS_W1T) + (size_t)(l * 2 + 0) * NFF * D, 1024u, 1024u, 8, MT / 256, 22, F.G, F.bid};
            EpiFfnUp E{F.ws + WS_U}; pg8::gemm_phase<EpiFfnUp, SchedPlain, 1>(F.lds, S, E, F.tid); } } PHASE_END
        PHASE_BEGIN if (PHMASK & (1u << 3)) for (int rep_ = 0; rep_ <= (int)((DUPMASK >> 3) & 1u); ++rep_) { { SchedResid<5, 1, 6> S{(const char*)(F.ws + WS_U), (const char*)(F.ws + WS_W2T) + (size_t)(l * 2 + 0) * D * DFF, (unsigned)DFF, 22, F.G, F.bid, true, (const char*)(F.ws + WS_U) + (size_t)TL * DFF};
            EpiRes E{(bf16*)P.out, (l == 0) ? (const void*)P.in[I_X] : (const void*)(F.ws + WS_BRV), l != 0, modl + 2 * D, nullptr, 0.5f / W2_SCALE, (float*)(F.ws + WS_ES),
                (l != 0) ? (const float*)(F.ws + WS_LNS) : nullptr, P.in[I_PLG] + ((l + 1) % 2 * 3 + 2) * D, P.in[I_PLB] + ((l + 1) % 2 * 3 + 2) * D}; pg8::gemm_phase<EpiRes, SchedResid<5, 1, 6>, 1>(F.lds, S, E, F.tid); } } PHASE_END
        PHASE_BEGIN if (PHMASK & (1u << 4)) for (int rep_ = 0; rep_ <= (int)((DUPMASK >> 4) & 1u); ++rep_) { phase_ln(F, P, P.in[I_PLG] + (l * 3 + 0) * D, P.in[I_PLB] + (l * 3 + 0) * D, modl, 3, true, false, true, false, 5, 0.5f / W2_SCALE, modl + (size_t)2 * 9216 + 2 * D, nullptr, xc, true, (const bf16*)P.out); if (l == 1) phase_filters(F, P, 1, false); } PHASE_END
        PHASE_BEGIN if (PHMASK & (1u << 5)) for (int rep_ = 0; rep_ <= (int)((DUPMASK >> 5) & 1u); ++rep_) { { SchedInproj S{Hc, (const char*)(F.ws + WS_WIT) + (size_t)l * PIN * D * 2, MT / 256, F.G, F.bid};
            EpiInproj E{(const float*)(F.ws + WS_BIN) + l * PIN, F.ws};
            pg8::gemm_phase(F.lds, S, E, F.tid); } } PHASE_END
        PHASE_BEGIN if (PHMASK & (1u << 6)) for (int rep_ = 0; rep_ <= (int)((DUPMASK >> 6) & 1u); ++rep_) { phase_mixer(F, P, l, last); } PHASE_END
        const int Mx = last ? TL : MT;
        PHASE_BEGIN if (PHMASK & (1u << 7)) for (int rep_ = 0; rep_ <= (int)((DUPMASK >> 7) & 1u); ++rep_) { { SchedGateBr S{Hc, (const char*)(F.ws + WS_H8L), (const char*)(F.ws + WS_H8C), (const char*)(F.ws + WS_WIT) + ((size_t)l * PIN + NINP) * D * 2, (const char*)(F.ws + WS_BRV), (const char*)(F.ws + WS_WPT) + (size_t)l * 4 * D * 256 * 2, F.G, F.bid, !last};
            EpiGateBr E{(const float*)(F.ws + WS_BIN) + l * PIN + NINP, F.ws + WS_GS + (size_t)F.bid * 393216, (bf16*)(F.ws + WS_MG), (bf16*)(F.ws + WS_MI)}; pg8::gemm_phase<EpiGateBr, SchedGateBr, 2>(F.lds, S, E, F.tid); } } PHASE_END
        PHASE_BEGIN if (PHMASK & (1u << 8)) for (int rep_ = 0; rep_ <= (int)((DUPMASK >> 8) & 1u); ++rep_) { { SchedResid<4, 4> S{(const char*)(F.ws + WS_MG), (const char*)(F.ws + WS_WOT) + (size_t)l * D * D * 2, 2048u, 16, F.G, F.bid, !last, (const char*)(F.ws + WS_MI)};
            EpiRes E{(bf16*)(F.ws + WS_BRV), (const void*)P.out, true, modl + 5 * D, P.in[I_BOUT] + l * D, 1.0f, (float*)(F.ws + WS_ES), (const float*)(F.ws + WS_LNS), P.in[I_PLG] + (l * 3 + 0) * D, P.in[I_PLB] + (l * 3 + 0) * D}; pg8::gemm_phase(F.lds, S, E, F.tid); } } PHASE_END
        PHASE_BEGIN if (PHMASK & (1u << 9)) for (int rep_ = 0; rep_ <= (int)((DUPMASK >> 9) & 1u); ++rep_) { phase_ln(F, P, P.in[I_PLG] + (l * 3 + 1) * D, P.in[I_PLB] + (l * 3 + 1) * D, modl, 6, true, true, false, false, last ? 0 : 16, 1.0f, modl + (size_t)2 * 9216 + 5 * D, P.in[I_BOUT] + l * D, xcw, true, (const bf16*)(F.ws + WS_BRV)); } PHASE_END
        PHASE_BEGIN if (PHMASK & (1u << 10)) for (int rep_ = 0; rep_ <= (int)((DUPMASK >> 10) & 1u); ++rep_) { { SchedPlain S{Hc, (const char*)(F.ws + WS_W1T) + (size_t)(l * 2 + 1) * NFF * D, 1024u, 1024u, 8, Mx / 256, 22, F.G, F.bid};
            EpiFfnUp E{F.ws + WS_U}; pg8::gemm_phase<EpiFfnUp, SchedPlain, 1>(F.lds, S, E, F.tid); } } PHASE_END
        PHASE_BEGIN if (PHMASK & (1u << 11)) for (int rep_ = 0; rep_ <= (int)((DUPMASK >> 11) & 1u); ++rep_) { { SchedResid<5, 1, 6> S{(const char*)(F.ws + WS_U), (const char*)(F.ws + WS_W2T) + (size_t)(l * 2 + 1) * D * DFF, (unsigned)DFF, 22, F.G, F.bid, !last, (const char*)(F.ws + WS_U) + (size_t)TL * DFF};
            EpiRes E{(bf16*)(F.ws + WS_BRV), (const void*)(F.ws + WS_BRV), true, modl + 8 * D, nullptr, 0.5f / W2_SCALE, (float*)(F.ws + WS_ES), (const float*)(F.ws + WS_LNS), P.in[I_PLG] + (l * 3 + 1) * D, P.in[I_PLB] + (l * 3 + 1) * D}; pg8::gemm_phase<EpiRes, SchedResid<5, 1, 6>, 1>(F.lds, S, E, F.tid); } } PHASE_END
        PHASE_BEGIN if (PHMASK & (1u << 12)) for (int rep_ = 0; rep_ <= (int)((DUPMASK >> 12) & 1u); ++rep_) { phase_ln(F, P, P.in[I_PLG] + (l * 3 + 2) * D, P.in[I_PLB] + (l * 3 + 2) * D, MOD + (size_t)3 * 9216  , 0, !last, true, false, last, last ? 0 : 5, 0.5f / W2_SCALE, modl + (size_t)2 * 9216 + 8 * D, nullptr, xcw, !last, (const bf16*)(F.ws + WS_BRV)); } PHASE_END
    }
#undef MOD
#undef Hc
#undef modl
#undef xcw
#undef xc
#undef xl
#undef PHASE_BEGIN
#undef PHASE_END
}

#ifndef MK_N_LAUNCHES
#define MK_N_LAUNCHES 1
#endif
constexpr int N_PHASES = 2 + 2 * 11;
extern "C" void kernel_launch(void* const* d_in, const int* in_sizes, int n_in, void* d_out, int out_size, void* d_ws, size_t ws_size, hipStream_t stream) {
    static int grid = 0;
    if (grid == 0) {
        if (n_in != 33 || out_size != TL * D || ws_size < WS_TOTAL) { fprintf(stderr, "kernel_launch: unexpected shapes (n_in %d out %d ws %zu)\n", n_in, out_size, ws_size); grid = -1; return; }
        int dev = 0, cus = 0;
        if (hipGetDevice(&dev) != hipSuccess || hipDeviceGetAttribute(&cus, hipDeviceAttributeMultiprocessorCount, dev) != hipSuccess) { grid = -1; return; }
        if (hipFuncSetAttribute((const void*)mk_fwd, hipFuncAttributeMaxDynamicSharedMemorySize, LDS_BYTES) != hipSuccess) { fprintf(stderr, "kernel_launch: hipFuncSetAttribute failed\n"); grid = -1; return; }
        int per_cu = 0;
        if (hipOccupancyMaxActiveBlocksPerMultiprocessor(&per_cu, (const void*)mk_fwd, NTHR, LDS_BYTES) != hipSuccess || per_cu < 1) fprintf(stderr, "kernel_launch: occupancy query says %d\n", per_cu);
        (void)hipGetLastError();
        grid = cus;
    }
    if (grid < 0) return;
    (void)hipMemsetAsync((char*)d_ws + WS_CTL, 0, CTL_BYTES, stream);
    Params p{};
    for (int i = 0; i < 33; ++i) p.in[i] = (const float*)d_in[i];
    p.out = (float*)d_out; p.ws = (unsigned char*)d_ws;
#if MK_N_LAUNCHES == 1
    p.ph_lo = 0; p.ph_hi = N_PHASES;
    hipLaunchKernelGGL(mk_fwd, dim3(grid), dim3(NTHR), LDS_BYTES, stream, p);
#else
    for (int i = 0; i < N_PHASES; ++i) { p.ph_lo = i; p.ph_hi = i + 1; hipLaunchKernelGGL(mk_fwd, dim3(grid), dim3(NTHR), LDS_BYTES, stream, p); }
#endif
}
```

```cpp
#include <hip/hip_runtime.h>
#include <cstdio>
#include <cstdint>

#ifndef PHMASK
#define PHMASK 0xFFFFu
#endif
#ifndef DUPMASK
#define DUPMASK 0u
#endif
#ifndef FFTPROBE
#define FFTPROBE 0
#endif
#ifndef EPIDUP
#define EPIDUP 0
#endif
#ifndef MIXDUP
#define MIXDUP 0
#endif
#define LAS __attribute__((address_space(3)))
typedef unsigned short bf16;
typedef short bf16x8 __attribute__((ext_vector_type(8)));
typedef float f32x4 __attribute__((ext_vector_type(4)));
typedef float f32x2 __attribute__((ext_vector_type(2)));
typedef unsigned u32x4 __attribute__((ext_vector_type(4)));
typedef unsigned u32x2 __attribute__((ext_vector_type(2)));

constexpr int D = 1024, SEQ = 16384, TL = 32768, CTXL = 256, TC = 512, MT = TL + TC;
constexpr int DFF = 2816, NFF = 2 * DFF, PIN = 6912, NINP = 2816, NMOD = 9;
constexpr int WA = 256;
constexpr float LN_EPS = 1e-5f, ALPHA = 1.41421356237f, ATT_SCALE = 0.125f;
constexpr int NWAVES = 8, NTHR = 512;

constexpr size_t MiB = 1u << 20;
constexpr size_t WS_CTL = 0, CTL_BYTES = 1 * MiB;
constexpr size_t WS_MOD = 1 * MiB;
constexpr size_t WS_BIN = WS_MOD + 256 * 1024;
constexpr size_t WS_W3T = WS_BIN + 64 * 1024;
constexpr size_t WS_XC = 2 * MiB;
constexpr size_t WS_W1T = 4 * MiB;
constexpr size_t WS_W2T = WS_W1T + (size_t)4 * NFF * D * 2;
constexpr size_t WS_WIT = WS_W2T + (size_t)4 * D * DFF * 2;
constexpr size_t WS_WPT = WS_WIT + (size_t)2 * PIN * D * 2;
constexpr size_t WS_WOT = WS_WPT + (size_t)8 * D * 256 * 2;
constexpr size_t WS_H = WS_WOT + (size_t)2 * D * D * 2;
constexpr size_t WS_BRV = WS_H + (size_t)MT * D * 2;
constexpr size_t WS_FILT = WS_BRV + (size_t)MT * D * 2;
constexpr size_t WS_FILTC = WS_FILT + (size_t)4 * 256 * SEQ * 4;
constexpr size_t WS_H8L = WS_FILT + 32 * MiB;
constexpr size_t WS_LNS = WS_CTL + 64 * 1024;
constexpr size_t WS_H8C = WS_CTL + 512 * 1024;
constexpr size_t WS_U = WS_FILTC + (size_t)4 * 256 * 256 * 4;
constexpr size_t SZ256 = (size_t)MT * 256 * 2;
constexpr size_t WS_UA = WS_U, WS_Q = WS_U + SZ256, WS_K = WS_U + 2 * SZ256, WS_SB = WS_U + 3 * SZ256, WS_W = WS_U + 4 * SZ256;
constexpr size_t WS_VT = WS_U + 5 * SZ256;
constexpr size_t WS_HT = WS_U + 6 * SZ256;
constexpr size_t WS_KSCR = WS_U + 9 * SZ256;
constexpr size_t WS_MG = WS_U;
constexpr size_t WS_GS = WS_U + 4 * SZ256;
constexpr size_t WS_MI = WS_GS + (size_t)256 * 393216;
constexpr size_t WS_END = WS_U + (size_t)MT * DFF * 2;
static_assert(WS_KSCR + (size_t)256 * 131072 <= WS_END, "kscr");
static_assert(WS_MI + (size_t)4 * TC * D * 2 <= WS_END, "gs/mi");
constexpr size_t WS_ES = WS_END;
constexpr size_t WS_TOTAL = WS_ES + (size_t)256 * 131072;
static_assert(WS_TOTAL <= 512 * MiB, "ws");
static_assert(WS_BIN + 2 * PIN * 4 <= WS_W3T && WS_W3T + 2 * 1024 * 64 * 2 <= WS_XC && WS_MOD + 2 * 3 * 9216 * 4 <= WS_BIN, "small");

constexpr int RING_BYTES = 131072;
constexpr int FFT_BYTES = 133120;
constexpr int TW_OFF = FFT_BYTES;
constexpr int RPB_OFF = TW_OFF + 4096;
constexpr int RED_OFF = RPB_OFF + 7680;
constexpr int MISC_OFF = RED_OFF + 256;
constexpr int LDS_BYTES = 147456;
static_assert(MISC_OFF + 64 <= LDS_BYTES, "lds");

typedef __bf16 bf16x2_t __attribute__((ext_vector_type(2)));
__device__ __forceinline__ unsigned cvt_pk_bf16(float lo, float hi) { const f32x2 v = {lo, hi}; const bf16x2_t b = __builtin_convertvector(v, bf16x2_t); return __builtin_bit_cast(unsigned, b); }
typedef int v8i __attribute__((ext_vector_type(8)));
typedef int i32x4 __attribute__((ext_vector_type(4)));
__device__ __forceinline__ float sat8(float x) { return __builtin_amdgcn_fmed3f(x, -448.0f, 448.0f); }
__device__ __forceinline__ unsigned pk_fp8x4(float a, float b, float c, float d) { int p = 0; p = __builtin_amdgcn_cvt_pk_fp8_f32(sat8(a), sat8(b), p, false); p = __builtin_amdgcn_cvt_pk_fp8_f32(sat8(c), sat8(d), p, true); return (unsigned)p; }
constexpr float W1_SCALE = 32.0f, W2_SCALE = 64.0f;
__device__ __forceinline__ float bf2f(unsigned short b) { return __uint_as_float(((unsigned)b) << 16); }
__device__ __forceinline__ float bflo(unsigned w) { return __uint_as_float(w << 16); }
__device__ __forceinline__ float bfhi(unsigned w) { return __uint_as_float(w & 0xffff0000u); }
__device__ __forceinline__ float sigmoidf_(float x) { return __builtin_amdgcn_rcpf(1.0f + __builtin_amdgcn_exp2f(x * -1.44269504089f)); }
__device__ __forceinline__ float siluf_(float x) { return x * __builtin_amdgcn_rcpf(1.0f + __builtin_amdgcn_exp2f(x * -1.44269504089f)); }
__device__ __forceinline__ int lane_now() { int l_; asm volatile("v_mbcnt_lo_u32_b32 %0, -1, 0\n\tv_mbcnt_hi_u32_b32 %0, -1, %0" : "=v"(l_)); return l_; }
__device__ __forceinline__ float xrow_max(float v) {
    const unsigned a = __builtin_bit_cast(unsigned, v); auto r = __builtin_amdgcn_permlane16_swap(a, a, false, false);
    v = fmaxf(__builtin_bit_cast(float, (unsigned)r[0]), __builtin_bit_cast(float, (unsigned)r[1]));
    const unsigned b = __builtin_bit_cast(unsigned, v); auto q = __builtin_amdgcn_permlane32_swap(b, b, false, false);
    return fmaxf(__builtin_bit_cast(float, (unsigned)q[0]), __builtin_bit_cast(float, (unsigned)q[1]));
}
__device__ __forceinline__ float xrow_sum(float v) {
    const unsigned a = __builtin_bit_cast(unsigned, v); auto r = __builtin_amdgcn_permlane16_swap(a, a, false, false);
    v = __builtin_bit_cast(float, (unsigned)r[0]) + __builtin_bit_cast(float, (unsigned)r[1]);
    const unsigned b = __builtin_bit_cast(unsigned, v); auto q = __builtin_amdgcn_permlane32_swap(b, b, false, false);
    return __builtin_bit_cast(float, (unsigned)q[0]) + __builtin_bit_cast(float, (unsigned)q[1]);
}
__device__ __forceinline__ float shx(float v, int o, int lane) { return __builtin_bit_cast(float, __builtin_amdgcn_ds_bpermute((lane ^ o) << 2, __builtin_bit_cast(int, v))); }
#define DPP_F(v_, ctrl_) __builtin_bit_cast(float, __builtin_amdgcn_update_dpp(0, __builtin_bit_cast(int, (v_)), (ctrl_), 0xF, 0xF, true))
__device__ __forceinline__ float wave_sum(float v) {
    v += DPP_F(v, 0xB1);
    v += DPP_F(v, 0x4E);
    v += DPP_F(v, 0x141);
    v += DPP_F(v, 0x140);
    const int iv = __builtin_bit_cast(int, v);
    const float r0 = __builtin_bit_cast(float, __builtin_amdgcn_readlane(iv, 0)), r1 = __builtin_bit_cast(float, __builtin_amdgcn_readlane(iv, 16)),
                r2 = __builtin_bit_cast(float, __builtin_amdgcn_readlane(iv, 32)), r3 = __builtin_bit_cast(float, __builtin_amdgcn_readlane(iv, 48));
    return (r0 + r1) + (r2 + r3);
}
#define LDS_WAIT() asm volatile("s_waitcnt lgkmcnt(0)" ::: "memory")

#define XB_TMO      128
#define XB_XCNT(j)  (256  + 64 * (j))
#define XB_XSUB(j)  (1280 + 64 * (j))
#define XB_XGEN(j)  (2304 + 64 * (j))
#define XB_TOP      3328
#define XB_TOPGEN   3392
#define XCD_BAR_WORDS 3456
#define XB_SPIN_CAP (1u << 20)
__device__ __forceinline__ unsigned xb_ld(unsigned* p)              { return __hip_atomic_load(p, __ATOMIC_RELAXED, __HIP_MEMORY_SCOPE_AGENT); }
__device__ __forceinline__ unsigned xb_add(unsigned* p, unsigned v) { return __hip_atomic_fetch_add(p, v, __ATOMIC_RELAXED, __HIP_MEMORY_SCOPE_AGENT); }
__device__ __forceinline__ unsigned xb_xcc_id() { return (unsigned)__builtin_amdgcn_s_getreg((3 << 11) | 20) & 0xFu; }
#define XB_SPIN(cond, bar) do { unsigned _sp = 0; while (cond) { __builtin_amdgcn_s_sleep(1); \
    if ((++_sp & 255u) == 0u) { if (xb_ld(&(bar)[XB_TMO])) break; if (_sp > XB_SPIN_CAP) { atomicAdd(&(bar)[XB_TMO], 1u); break; } } } } while (0)
struct XcdBarrier { unsigned* bar; unsigned x; volatile LAS unsigned* st; };
__device__ __forceinline__ XcdBarrier xcd_barrier_post(unsigned* bar, volatile LAS unsigned* st) {
    XcdBarrier b; b.bar = bar; b.x = xb_xcc_id(); b.st = st;
    if (threadIdx.x == 0) (void)xb_add(&bar[XB_XCNT(b.x)], 1u);
    return b;
}
__device__ __forceinline__ void xcd_barrier_complete(unsigned* bar, unsigned x, unsigned& nloc, unsigned& nx) {
    const unsigned G = gridDim.x * gridDim.y * gridDim.z;
    unsigned sum, cnt, mine, sp = 0u;
    for (;;) {
        sum = 0u; cnt = 0u; mine = 0u;
#pragma unroll
        for (unsigned j = 0; j < 16; ++j) { const unsigned c = xb_ld(&bar[XB_XCNT(j)]); sum += c; cnt += (c > 0u) ? 1u : 0u; mine = (j == x) ? c : mine; }
        if (sum == G) break;
        __builtin_amdgcn_s_sleep(1);
        if ((++sp & 255u) == 0u) { if (xb_ld(&bar[XB_TMO])) break; if (sp > XB_SPIN_CAP) { atomicAdd(&bar[XB_TMO], 1u); break; } }
    }
    nloc = mine > 0u ? mine : 1u; nx = cnt > 0u ? cnt : 1u;
}
__device__ __forceinline__ void xcd_barrier(const XcdBarrier& b, int tid) {
    asm volatile("s_waitcnt vmcnt(0)" ::: "memory");
    __syncthreads();
    if (tid == 0) {
        unsigned* bar = b.bar;
        __builtin_amdgcn_s_waitcnt(0);
        unsigned nloc = b.st[0], nx = b.st[1];
        if (nloc == 0u) { xcd_barrier_complete(bar, b.x, nloc, nx); b.st[0] = nloc; b.st[1] = nx; }
        const unsigned old = xb_add(&bar[XB_XSUB(b.x)], 1u);
        const unsigned gen = old / nloc;
        if (old + 1u == (gen + 1u) * nloc) {
            __builtin_amdgcn_fence(__ATOMIC_RELEASE, "agent");
            asm volatile("s_waitcnt vmcnt(0)" ::: "memory");
            const unsigned og = xb_add(&bar[XB_TOP], 1u);
            const unsigned tg = og / nx;
            if (og + 1u == (tg + 1u) * nx) xb_add(&bar[XB_TOPGEN], 1u);
            else XB_SPIN(xb_ld(&bar[XB_TOPGEN]) == tg, bar);
            __builtin_amdgcn_fence(__ATOMIC_ACQUIRE, "agent");
            xb_add(&bar[XB_XGEN(b.x)], 1u);
            asm volatile("s_waitcnt vmcnt(0)" ::: "memory");
        } else {
            XB_SPIN(xb_ld(&bar[XB_XGEN(b.x)]) == gen, bar);
            __builtin_amdgcn_fence(__ATOMIC_ACQUIRE, "agent");
            asm volatile("s_waitcnt vmcnt(0)" ::: "memory");
        }
    }
    __syncthreads();
}

namespace pg8 {
constexpr int BM = 256, BK = 64, HALF = 128, HTB = HALF * BK * 2, NXCD = 8, WGM = 8;
__host__ __device__ __forceinline__ int lds_byte(int r, int c) { const int st = (r >> 4) * 2 + (c >> 5), rr = r & 15, cc = c & 31, ob = rr * 64 + cc * 2; return st * 1024 + (ob ^ (((ob >> 9) & 1) << 5)); }
__host__ __device__ __forceinline__ void stage_rc(int b, int& R, int& C) { const int st = b / 1024, sb = b % 1024, swz = sb ^ (((sb >> 9) & 1) << 5); R = (st >> 1) * 16 + swz / 64; C = (st & 1) * 32 + (swz % 64) / 2; }
__host__ __device__ __forceinline__ int perm32(int rho) { const int n = rho >> 4, i = rho & 15; return 8 * (i >> 2) + 4 * n + (i & 3); }

struct GUnit { const char* A; const char* B; unsigned lda, ldb; int nt; int pm, pn, kind; bool f8; };

__device__ __forceinline__ bool static_tile(int i, int G, int c, int nM, int nN, int& pm, int& pn) {
    const int nwg = nM * nN; const long L = (long)i * G + c; if (L >= nwg) return false;
    int wgid = (int)L; { const int q = nwg / NXCD, r = nwg % NXCD, xcd = wgid % NXCD, off = wgid / NXCD; wgid = (xcd < r ? xcd * (q + 1) : r * (q + 1) + (xcd - r) * q) + off; }
    const int nig = WGM * nN, gid = wgid / nig, fm = gid * WGM, gsz = (nM - fm) < WGM ? (nM - fm) : WGM;
    pm = fm + ((wgid % nig) % gsz); pn = (wgid % nig) / gsz; return true;
}

template <class Epi, class Sched, int F8M = 0  >
__device__ __forceinline__ void gemm_phase(LAS unsigned char* lds, const Sched& S, const Epi& E, int tid_in) {
    int tid_ = tid_in; asm volatile("" : "+v"(tid_));
    const int tid = tid_, wid = __builtin_amdgcn_readfirstlane(tid >> 6), lane = tid & 63, wr = wid >> 2, wc = wid & 3, fr = lane & 15, fq = lane >> 4;
    unsigned RA[2], RB[2], CC[2];
#pragma unroll
    for (int i = 0; i < 2; ++i) { int R, C; stage_rc(tid * 16 + i * 8192, R, C); RA[i] = (unsigned)R; RB[i] = (unsigned)((R & ~31) + perm32(R & 31)); CC[i] = (unsigned)C * 2u; }
    const size_t kstep = (size_t)(BK * 2);
    const unsigned ldsw = (unsigned)wid * 1024u;
#define PG8_SA(b, h) (((b) * 2 + (h)) * HTB)
#define PG8_SB(b, h) ((4 + (b) * 2 + (h)) * HTB)
#define PG8_STAGE(bufoff, gbase, RR, ld) do { _Pragma("unroll") for (int _i = 0; _i < 2; ++_i) \
        __builtin_amdgcn_global_load_lds((const unsigned*)((const char*)(gbase) + ((RR)[_i] * (ld) + CC[_i])), (LAS unsigned*)(lds + (bufoff) + ldsw + _i * 8192), 16, 0, 0); } while (0)
#define PG8_LDA(F8C, dst, b, h) do { _Pragma("unroll") for (int m = 0; m < 4; ++m) { dst[m][0] = *(const LAS i32x4*)(lds + PG8_SA(b, h) + ao0 + m * 2048); dst[m][1] = *(const LAS i32x4*)(lds + PG8_SA(b, h) + ao1 + m * 2048); } } while (0)
#define PG8_LDB(F8C, dst, b, h) do { _Pragma("unroll") for (int n = 0; n < 2; ++n) { dst[n][0] = *(const LAS i32x4*)(lds + PG8_SB(b, h) + bo0 + n * 2048); dst[n][1] = *(const LAS i32x4*)(lds + PG8_SB(b, h) + bo1 + n * 2048); } } while (0)
#define PG8_V8(x) __builtin_shufflevector((x)[0], (x)[1], 0, 1, 2, 3, 4, 5, 6, 7)
#define PG8_MMA(F8C, ai, bj, At, Bt) do { __builtin_amdgcn_s_setprio(1); if constexpr (F8C) { _Pragma("unroll") for (int m = 0; m < 4; ++m) _Pragma("unroll") for (int n = 0; n < 2; ++n) \
            { const v8i b8_ = PG8_V8(Bt[n]), a8_ = PG8_V8(At[m]); asm volatile("v_mfma_scale_f32_16x16x128_f8f6f4 %0, %1, %2, %0, %3, %3 op_sel_hi:[0,0,0]" : "+v"(acc[ai][bj][m][n]) : "v"(b8_), "v"(a8_), "v"(one_scale)); } } \
        else { _Pragma("unroll") for (int m = 0; m < 4; ++m) _Pragma("unroll") for (int n = 0; n < 2; ++n) _Pragma("unroll") for (int k = 0; k < 2; ++k) \
            acc[ai][bj][m][n] = __builtin_amdgcn_mfma_f32_16x16x32_bf16(__builtin_bit_cast(bf16x8, Bt[n][k]), __builtin_bit_cast(bf16x8, At[m][k]), acc[ai][bj][m][n], 0, 0, 0); } __builtin_amdgcn_s_setprio(0); } while (0)
#define PG8_TRIP(F8C, WN) { \
            const bool last = (t == nt - 2); \
            const char* a1 = cA + (size_t)(t + 1) * kstep; \
            const char* a2 = last ? nA : cA + (size_t)(t + 2) * kstep; const char* b2 = last ? nB : cB + (size_t)(t + 2) * kstep; \
            const char* a3 = a2 + kstep; const char* b3 = b2 + kstep; \
            const unsigned xldA = last ? nldA : ldA, xldB = last ? nldB : ldB; const size_t xhsA = last ? nhsA : hsA, xhsB = last ? nhsB : hsB; \
            PG8_LDB(F8C, B0, 0, 0); PG8_LDB(F8C, B1, 0, 1); PG8_SCHED; PG8_LDA(F8C, At, 0, 0); PG8_STAGE(PG8_SA(1, 1), a1 + hsA, RA, ldA); \
            PG8_WAIT_V(WN); PG8_WAIT_L(0); PG8_BAR; PG8_MMA(F8C, 0, 0, At, B0); PG8_MMA(F8C, 0, 1, At, B1); PG8_BAR; PG8_SCHED; \
            PG8_LDA(F8C, At, 0, 1); PG8_STAGE(PG8_SB(0, 0), b2, RB, xldB); PG8_STAGE(PG8_SB(0, 1), b2 + xhsB, RB, xldB); PG8_STAGE(PG8_SA(0, 0), a2, RA, xldA); \
            PG8_WAIT_V(WN); PG8_WAIT_L(0); PG8_BAR; PG8_MMA(F8C, 1, 0, At, B0); PG8_MMA(F8C, 1, 1, At, B1); PG8_BAR; PG8_SCHED; \
            PG8_LDB(F8C, B0, 1, 0); PG8_LDB(F8C, B1, 1, 1); PG8_SCHED; PG8_LDA(F8C, At, 1, 0); PG8_STAGE(PG8_SA(0, 1), a2 + xhsA, RA, xldA); \
            PG8_WAIT_V(8); PG8_WAIT_L(0); PG8_BAR; PG8_MMA(F8C, 0, 0, At, B0); PG8_MMA(F8C, 0, 1, At, B1); PG8_BAR; PG8_SCHED; \
            PG8_LDA(F8C, At, 1, 1); PG8_STAGE(PG8_SB(1, 0), b3, RB, xldB); PG8_STAGE(PG8_SB(1, 1), b3 + xhsB, RB, xldB); PG8_STAGE(PG8_SA(1, 0), a3, RA, xldA); \
            PG8_WAIT_V(8); PG8_WAIT_L(0); PG8_BAR; PG8_MMA(F8C, 1, 0, At, B0); PG8_MMA(F8C, 1, 1, At, B1); PG8_BAR; PG8_SCHED; \
        }
#define PG8_KLOOP(F8C) const int ln_ = lane_now();   \
        const int fr_ = ln_ & 15, fq_ = ln_ >> 4; \
        const int ao0 = lds_byte(wr * 64 + fr_, (F8C) ? 16 * fq_ : 8 * fq_), ao1 = (F8C) ? lds_byte(wr * 64 + fr_, 16 * fq_ + 8) : ao0 + 1024; \
        const int bo0 = lds_byte(wc * 32 + fr_, (F8C) ? 16 * fq_ : 8 * fq_), bo1 = (F8C) ? lds_byte(wc * 32 + fr_, 16 * fq_ + 8) : bo0 + 1024; \
        int t = 0; \
        if constexpr (Epi::NST == 8) { if (ui > 0) { PG8_TRIP(F8C, 16) t = 2; } } \
        for (; t < nt; t += 2) PG8_TRIP(F8C, 8)
#define PG8_WAIT_V(n) asm volatile("s_waitcnt vmcnt(" #n ")" ::: "memory")
#define PG8_WAIT_L(n) asm volatile("s_waitcnt lgkmcnt(" #n ")" ::: "memory")
#define PG8_BAR __builtin_amdgcn_s_barrier()
#define PG8_SCHED __builtin_amdgcn_sched_barrier(0)
    GUnit cur, nxt; int ui = 0;
    if (!S.next(0, cur)) return;
    f32x4 acc[2][2][4][2];
#pragma unroll
    for (int a = 0; a < 2; ++a)
#pragma unroll
        for (int b = 0; b < 2; ++b)
#pragma unroll
            for (int m = 0; m < 4; ++m)
#pragma unroll
                for (int n = 0; n < 2; ++n) acc[a][b][m][n] = (f32x4){0.f, 0.f, 0.f, 0.f};
    i32x4 At[4][2], B0[2][2], B1[2][2];
    int one_scale = 0x7F7F7F7F; asm volatile("" : "+v"(one_scale));
    const char* cA = cur.A; const char* cB = cur.B;
    unsigned ldA = cur.lda, ldB = cur.ldb; size_t hsA = (size_t)HALF * ldA, hsB = (size_t)HALF * ldB;
    PG8_STAGE(PG8_SB(0, 0), cB, RB, ldB); PG8_STAGE(PG8_SB(0, 1), cB + hsB, RB, ldB); PG8_STAGE(PG8_SA(0, 0), cA, RA, ldA); PG8_STAGE(PG8_SA(0, 1), cA + hsA, RA, ldA);
    if (wr == 1) PG8_BAR;
    PG8_WAIT_V(2); PG8_BAR;
    PG8_STAGE(PG8_SB(1, 0), cB + kstep, RB, ldB); PG8_STAGE(PG8_SA(1, 0), cA + kstep, RA, ldA); PG8_STAGE(PG8_SB(1, 1), cB + hsB + kstep, RB, ldB);
    PG8_WAIT_V(6); PG8_BAR;
    for (;;) {
        const bool has_next = S.next(ui + 1, nxt);
        const char* nA = has_next ? nxt.A : cA; const char* nB = has_next ? nxt.B : cB;
        const unsigned nldA = has_next ? nxt.lda : ldA, nldB = has_next ? nxt.ldb : ldB;
        const size_t nhsA = (size_t)HALF * nldA, nhsB = (size_t)HALF * nldB;
        const int nt = cur.nt;
        if constexpr (F8M == 2) { if (cur.f8) { PG8_KLOOP(true) } else { PG8_KLOOP(false) } }
        else if constexpr (F8M == 1) { PG8_KLOOP(true) }
        else { PG8_KLOOP(false) }
        if (wr == 0) PG8_BAR;
        if constexpr (F8M != 0) asm volatile("s_nop 15\n\ts_nop 15" ::: "memory");
        { const int le_ = lane_now(); E(acc, cur, (wid << 6) | le_, wr, wc, le_ & 15, le_ >> 4); }
        if (!has_next) break;
#pragma unroll
        for (int a = 0; a < 2; ++a)
#pragma unroll
            for (int b = 0; b < 2; ++b)
#pragma unroll
                for (int m = 0; m < 4; ++m)
#pragma unroll
                    for (int n = 0; n < 2; ++n) acc[a][b][m][n] = (f32x4){0.f, 0.f, 0.f, 0.f};
        cur = nxt; cA = nA; cB = nB; hsA = nhsA; hsB = nhsB; ldA = nldA; ldB = nldB; ++ui;
        if (wr == 1) PG8_BAR;
    }
    PG8_WAIT_V(0);
    PG8_BAR;
#undef PG8_SA
#undef PG8_SB
#undef PG8_STAGE
#undef PG8_LDA
#undef PG8_KLOOP
#undef PG8_TRIP
#undef PG8_V8
#undef PG8_LDB
#undef PG8_MMA
#undef PG8_WAIT_V
#undef PG8_WAIT_L
#undef PG8_BAR
#undef PG8_SCHED
}
}
using pg8::GUnit;
typedef f32x4 Acc[2][2][4][2];

struct Params {
    const float* in[33];
    float* out;
    unsigned char* ws;
    int ph_lo, ph_hi;
};
enum { I_X = 0, I_C, I_CTX, I_CCTX, I_WMOD, I_BMOD, I_PLG, I_PLB, I_FWI, I_FWO, I_WIN, I_BIN, I_CDW, I_CDB, I_CLG, I_CLB, I_CWP, I_RPB, I_NWP, I_SCW, I_SWP,
       I_HSW, I_HSB, I_HW1, I_HB1, I_HW2, I_HB2, I_HFQ, I_HW3, I_HBI, I_HWP, I_WOUT, I_BOUT };

__device__ __forceinline__ int row_grp(int pm) { return pm < 64 ? 0 : (pm < 128 ? 1 : 2); }

struct SchedPlain {
    const char* A; const char* B; unsigned lda, ldb; int nt, nM, nN, G, c;
    __device__ __forceinline__ bool next(int i, GUnit& u) const {
        int pm, pn; if (!pg8::static_tile(i, G, c, nM, nN, pm, pn)) return false;
        u.A = A + (size_t)pm * 256 * lda; u.B = B + (size_t)pn * 256 * ldb; u.lda = lda; u.ldb = ldb; u.nt = nt; u.pm = pm; u.pn = pn; u.kind = 0; u.f8 = true; return true;
    }
};
template <int NKS, int NSRC, int NTLAST = 4> struct SchedResid {
    const char* A; const char* B; unsigned ld; int nt, G, c; bool ctx; const char* Ac;
    __device__ __forceinline__ bool next(int i, GUnit& u) const {
        int pm, pn; u.lda = ld; u.ldb = ld; u.f8 = true;
        if (pg8::static_tile(i, G, c, TL / 256, 4, pm, pn)) { u.A = A + (size_t)pm * 256 * ld; u.B = B + (size_t)pn * 256 * ld; u.nt = nt; u.pm = pm; u.pn = pn; u.kind = 0; return true; }
        constexpr int NK = NKS * NSRC;
        const int j = i * G + c - (TL / 256) * 4; if (!ctx || j < 0 || j >= 8 * NK) return false;
        const int panel = j / (4 * NK), rem = j % (4 * NK), kk = rem % NK, src = kk / NKS, ks = kk % NKS; pn = rem / NK;
        u.A = Ac + ((size_t)src * TC + panel * 256) * ld + ks * 512; u.B = B + (size_t)pn * 256 * ld + ks * 512; u.nt = (ks == NKS - 1) ? NTLAST : 4; u.pm = TL / 256 + panel; u.pn = pn; u.kind = 1 + kk; return true;
    }
};
enum { KI_GLU = 0, KI_PLAIN = 1, KI_PAIR = 2, KI_TRANS = 3 };
struct SchedInproj {
    const char* H; const char* W; int nM, G, c;
    __device__ __forceinline__ bool next(int i, GUnit& u) const {
        int pm, pn; if (!pg8::static_tile(i, G, c, nM, 11, pm, pn)) return false;
        const char* a = H + (size_t)pm * 256 * 2048; const char* b = W + (size_t)pn * 256 * 2048;
        const bool tr = (pn == 4) || (pn >= 8);
        u.A = tr ? b : a; u.B = tr ? a : b; u.lda = 2048; u.ldb = 2048; u.nt = 16; u.pm = pm; u.pn = pn;
        u.f8 = false; u.kind = tr ? KI_TRANS : (pn < 2 ? KI_GLU : (pn == 6 || pn == 7 ? KI_PAIR : KI_PLAIN)); return true;
    }
};
struct SchedGateBr {
    const char* HB  ; const char* H; const char* HC  ; const char* WG  ; const char* BR; const char* WP; int G, c; bool ctx;
    __device__ __forceinline__ bool next(int i, GUnit& u) const {
        int pm, pn, j, br;
        if (pg8::static_tile(i >> 3, G, c, TL / 256, 4, pm, pn)) { j = i & 7; br = j >> 1; }
        else {
            const int ntl = ((TL / 256) * 4 - c + G - 1) / G, e = i - 8 * ntl;
            if (!ctx || c >= 32 || e < 0 || e > 1) return false;
            pm = TL / 256 + (c >> 4); pn = (c >> 2) & 3; br = c & 3; j = 8 + 2 * br + e;
        }
        if ((j & 1) == 0 && br == 3) { u.A = HB + (size_t)pm * 256 * 2048; u.B = WG + 4 * MiB + (size_t)(pn * 256) * 2048; u.lda = 2048; u.ldb = 2048; u.nt = 16; u.f8 = false; }
        else if ((j & 1) == 0) { u.A = (pm < TL / 256) ? H + (size_t)pm * 256 * 1024 : HC + (size_t)(pm - TL / 256) * 256 * 1024; u.B = WG + (size_t)(br * 1024 + pn * 256) * 1024; u.lda = 1024; u.ldb = 1024; u.nt = 8; u.f8 = true; }
        else { u.A = BR + (size_t)br * SZ256 + (size_t)pm * 256 * 512; u.B = WP + (size_t)(br * 1024 + pn * 256) * 512; u.lda = 512; u.ldb = 512; u.nt = 4; u.f8 = false; }
        u.pm = pm; u.pn = pn; u.kind = j; return true;
    }
};

struct EpiFfnUp {
    static constexpr bool DUP_OK = true; static constexpr int NST = 8;
    unsigned char* U;
    __device__ __forceinline__ void operator()(const Acc& acc, const GUnit& u, int tid, int wr, int wc, int fr, int fq) const {
        const int row0 = u.pm * 256 + wr * 64 + fr, col0 = u.pn * 128 + wc * 32 + 8 * fq;
        constexpr float IS = 1.0f / W1_SCALE;
#pragma unroll
        for (int ai = 0; ai < 2; ++ai)
#pragma unroll
            for (int m = 0; m < 4; ++m) {
                const f32x4 a0 = acc[ai][0][m][0] * IS, a1 = acc[ai][0][m][1] * IS, g0 = acc[ai][1][m][0] * IS, g1 = acc[ai][1][m][1] * IS;
                u32x2 w; w.x = pk_fp8x4(siluf_(g0[0]) * a0[0], siluf_(g0[1]) * a0[1], siluf_(g0[2]) * a0[2], siluf_(g0[3]) * a0[3]);
                w.y = pk_fp8x4(siluf_(g1[0]) * a1[0], siluf_(g1[1]) * a1[1], siluf_(g1[2]) * a1[2], siluf_(g1[3]) * a1[3]);
                *(u32x2*)(U + (size_t)(row0 + ai * 128 + m * 16) * DFF + col0) = w;
            }
    }
};
struct EpiRes {
    static constexpr bool DUP_OK = false; static constexpr int NST = 0;
    bf16* V; const void* xl; bool xbf  ; const float* modl  ; const float* bias; float coef; float* part;
    const float* xstat; const float* xg; const float* xbt;
    __device__ __forceinline__ void operator()(const Acc& acc, const GUnit& u, int tid, int wr, int wc, int fr, int fq) const {
        int row0 = u.pm * 256 + wr * 64 + fr, colt = u.pn * 256 + wc * 32 + 8 * fq; asm volatile("" : "+v"(row0), "+v"(colt));
        if (u.kind != 0) {
            float* pp = part + ((size_t)(u.kind - 1) * TC + (row0 - TL)) * D + colt;
#pragma unroll
            for (int ai = 0; ai < 2; ++ai)
#pragma unroll
                for (int m = 0; m < 4; ++m)
#pragma unroll
                    for (int bj = 0; bj < 2; ++bj) { float* q = pp + (size_t)(ai * 128 + m * 16) * D + bj * 128; *(f32x4*)q = acc[ai][bj][m][0]; *(f32x4*)(q + 4) = acc[ai][bj][m][1]; }
            return;
        }
        if (xstat) body_ln(acc, u, row0, colt); else if (xbf) body<true>(acc, u, row0, colt); else body<false>(acc, u, row0, colt);
    }
    template <bool XB> __device__ __forceinline__ void body(const Acc& acc, const GUnit& u, int row0, int colt) const {
        const float* mv = modl + (size_t)row_grp(u.pm) * 9216;
        f32x4 sc[2][2], bv[2][2];
#pragma unroll
        for (int bj = 0; bj < 2; ++bj)
#pragma unroll
            for (int n = 0; n < 2; ++n) { sc[bj][n] = *(const f32x4*)(mv + colt + bj * 128 + 4 * n) * coef;
                bv[bj][n] = bias ? *(const f32x4*)(bias + colt + bj * 128 + 4 * n) : (f32x4){0.f, 0.f, 0.f, 0.f}; }
#pragma unroll
        for (int ai = 0; ai < 2; ++ai) {
            bf16* vp = V + (size_t)(row0 + ai * 128) * D + colt;
            if constexpr (XB) {
                const bf16* xh = (const bf16*)xl + (size_t)(row0 + ai * 128) * D + colt;
                u32x4 xw[4][2];
#pragma unroll
                for (int m = 0; m < 4; ++m)
#pragma unroll
                    for (int bj = 0; bj < 2; ++bj) xw[m][bj] = *(const u32x4*)(xh + (size_t)(m * 16) * D + bj * 128);
#pragma unroll
                for (int m = 0; m < 4; ++m)
#pragma unroll
                    for (int bj = 0; bj < 2; ++bj) { const u32x4 w_ = xw[m][bj];
                        const f32x4 x0 = (f32x4){bflo(w_.x), bfhi(w_.x), bflo(w_.y), bfhi(w_.y)}, x1 = (f32x4){bflo(w_.z), bfhi(w_.z), bflo(w_.w), bfhi(w_.w)};
                        const f32x4 v0 = x0 * ALPHA + sc[bj][0] * (acc[ai][bj][m][0] + bv[bj][0]), v1 = x1 * ALPHA + sc[bj][1] * (acc[ai][bj][m][1] + bv[bj][1]);
                        u32x4 w; w.x = cvt_pk_bf16(v0[0], v0[1]); w.y = cvt_pk_bf16(v0[2], v0[3]); w.z = cvt_pk_bf16(v1[0], v1[1]); w.w = cvt_pk_bf16(v1[2], v1[3]);
                        *(u32x4*)(vp + (size_t)(m * 16) * D + bj * 128) = w; }
            } else {
                const float* xb = (const float*)xl + (size_t)(row0 + ai * 128) * D + colt;
#pragma unroll
                for (int mh = 0; mh < 2; ++mh) {
                    f32x4 xf[2][2][2];
#pragma unroll
                    for (int mm = 0; mm < 2; ++mm)
#pragma unroll
                        for (int bj = 0; bj < 2; ++bj) { const float* q = xb + (size_t)((mh * 2 + mm) * 16) * D + bj * 128; xf[mm][bj][0] = *(const f32x4*)q; xf[mm][bj][1] = *(const f32x4*)(q + 4); }
#pragma unroll
                    for (int mm = 0; mm < 2; ++mm)
#pragma unroll
                        for (int bj = 0; bj < 2; ++bj) { const int m = mh * 2 + mm;
                            const f32x4 v0 = xf[mm][bj][0] * ALPHA + sc[bj][0] * (acc[ai][bj][m][0] + bv[bj][0]), v1 = xf[mm][bj][1] * ALPHA + sc[bj][1] * (acc[ai][bj][m][1] + bv[bj][1]);
                            u32x4 w; w.x = cvt_pk_bf16(v0[0], v0[1]); w.y = cvt_pk_bf16(v0[2], v0[3]); w.z = cvt_pk_bf16(v1[0], v1[1]); w.w = cvt_pk_bf16(v1[2], v1[3]);
                            *(u32x4*)(vp + (size_t)(m * 16) * D + bj * 128) = w; }
                    asm volatile("" ::: "memory");
                }
            }
            asm volatile("" ::: "memory");
        }
    }
    __device__ __forceinline__ void body_ln(const Acc& acc, const GUnit& u, int row0, int colt) const {
        const float* mv = modl + (size_t)row_grp(u.pm) * 9216;
#pragma unroll
        for (int bj = 0; bj < 2; ++bj) {
            f32x4 sc[2], gg[2], bb[2], bv[2];
#pragma unroll
            for (int n = 0; n < 2; ++n) { sc[n] = *(const f32x4*)(mv + colt + bj * 128 + 4 * n) * coef; gg[n] = *(const f32x4*)(xg + colt + bj * 128 + 4 * n); bb[n] = *(const f32x4*)(xbt + colt + bj * 128 + 4 * n);
                bv[n] = bias ? *(const f32x4*)(bias + colt + bj * 128 + 4 * n) : (f32x4){0.f, 0.f, 0.f, 0.f}; }
#pragma unroll
            for (int ai = 0; ai < 2; ++ai) {
                bf16* vp = V + (size_t)(row0 + ai * 128) * D + colt + bj * 128; const bf16* xp = (const bf16*)xl + (size_t)(row0 + ai * 128) * D + colt + bj * 128;
                u32x4 xw[4]; f32x2 st[4];
#pragma unroll
                for (int m = 0; m < 4; ++m) { st[m] = *(const f32x2*)(xstat + (size_t)(row0 + ai * 128 + m * 16) * 2); xw[m] = *(const u32x4*)(xp + (size_t)(m * 16) * D); }
#pragma unroll
                for (int m = 0; m < 4; ++m) { const u32x4 w_ = xw[m]; const float mu = st[m].x, rs = st[m].y;
                    const f32x4 x0 = ((f32x4){bflo(w_.x), bfhi(w_.x), bflo(w_.y), bfhi(w_.y)} - mu) * (gg[0] * rs) + bb[0], x1 = ((f32x4){bflo(w_.z), bfhi(w_.z), bflo(w_.w), bfhi(w_.w)} - mu) * (gg[1] * rs) + bb[1];
                    const f32x4 v0 = x0 * ALPHA + sc[0] * (acc[ai][bj][m][0] + bv[0]), v1 = x1 * ALPHA + sc[1] * (acc[ai][bj][m][1] + bv[1]);
                    u32x4 w; w.x = cvt_pk_bf16(v0[0], v0[1]); w.y = cvt_pk_bf16(v0[2], v0[3]); w.z = cvt_pk_bf16(v1[0], v1[1]); w.w = cvt_pk_bf16(v1[2], v1[3]);
                    *(u32x4*)(vp + (size_t)(m * 16) * D) = w; }
                asm volatile("" ::: "memory");
            }
        }
    }
};
struct EpiInproj {
    static constexpr bool DUP_OK = false; static constexpr int NST = 0;
    const float* bin;
    unsigned char* ws;
    __device__ __forceinline__ void operator()(const Acc& acc, const GUnit& u, int tid, int wr, int wc, int fr, int fq) const {
        bf16* const UA = (bf16*)(ws + WS_UA); bf16* const Q = (bf16*)(ws + WS_Q); bf16* const K = (bf16*)(ws + WS_K); bf16* const SB = (bf16*)(ws + WS_SB);
        bf16* const W = (bf16*)(ws + WS_W); bf16* const VT = (bf16*)(ws + WS_VT); bf16* const HT = (bf16*)(ws + WS_HT);
        int c8 = wc * 32 + 8 * fq; asm volatile("" : "+v"(c8));
        if (u.kind == KI_TRANS) {
            bf16* dst = (u.pn == 4) ? VT : HT + (size_t)(u.pn - 8) * 256 * MT;
            const int r0 = wr * 64 + fr;
#pragma unroll
            for (int ai = 0; ai < 2; ++ai)
#pragma unroll
                for (int m = 0; m < 4; ++m) {
                    const int r = r0 + ai * 128 + m * 16; const float b = bin[u.pn * 256 + r];
#pragma unroll
                    for (int bj = 0; bj < 2; ++bj) {
                        const f32x4 v0 = acc[ai][bj][m][0] + b, v1 = acc[ai][bj][m][1] + b;
                        u32x4 w; w.x = cvt_pk_bf16(v0[0], v0[1]); w.y = cvt_pk_bf16(v0[2], v0[3]); w.z = cvt_pk_bf16(v1[0], v1[1]); w.w = cvt_pk_bf16(v1[2], v1[3]);
                        *(u32x4*)(dst + (size_t)r * MT + u.pm * 256 + bj * 128 + c8) = w;
                    }
                }
            return;
        }
        const int row0 = u.pm * 256 + wr * 64 + fr;
        f32x4 bv[2][2];
#pragma unroll
        for (int bj = 0; bj < 2; ++bj)
#pragma unroll
            for (int n = 0; n < 2; ++n) bv[bj][n] = *(const f32x4*)(bin + u.pn * 256 + bj * 128 + c8 + 4 * n);
        if (u.kind == KI_PLAIN) {
            bf16* dst = (u.pn == 2) ? Q : (u.pn == 3 ? K : SB); const float scl = (u.pn == 2) ? ATT_SCALE * 1.44269504089f : 1.0f;
#pragma unroll
            for (int ai = 0; ai < 2; ++ai)
#pragma unroll
                for (int m = 0; m < 4; ++m)
#pragma unroll
                    for (int bj = 0; bj < 2; ++bj) {
                        const f32x4 v0 = (acc[ai][bj][m][0] + bv[bj][0]) * scl, v1 = (acc[ai][bj][m][1] + bv[bj][1]) * scl;
                        u32x4 w; w.x = cvt_pk_bf16(v0[0], v0[1]); w.y = cvt_pk_bf16(v0[2], v0[3]); w.z = cvt_pk_bf16(v1[0], v1[1]); w.w = cvt_pk_bf16(v1[2], v1[3]);
                        *(u32x4*)(dst + (size_t)(row0 + ai * 128 + m * 16) * 256 + bj * 128 + c8) = w;
                    }
            return;
        }
        const bool glu = (u.kind == KI_GLU);
        bf16* dst = glu ? UA + u.pn * 128 : W + (u.pn - 6) * 128;
#pragma unroll
        for (int ai = 0; ai < 2; ++ai)
#pragma unroll
            for (int m = 0; m < 4; ++m) {
                f32x4 a0 = acc[ai][0][m][0] + bv[0][0], a1 = acc[ai][0][m][1] + bv[0][1], g0 = acc[ai][1][m][0] + bv[1][0], g1 = acc[ai][1][m][1] + bv[1][1];
                if (glu) {
#pragma unroll
                    for (int j = 0; j < 4; ++j) { g0[j] = sigmoidf_(g0[j]); g1[j] = sigmoidf_(g1[j]); }
                }
                const f32x4 v0 = a0 * g0, v1 = a1 * g1;
                u32x4 w; w.x = cvt_pk_bf16(v0[0], v0[1]); w.y = cvt_pk_bf16(v0[2], v0[3]); w.z = cvt_pk_bf16(v1[0], v1[1]); w.w = cvt_pk_bf16(v1[2], v1[3]);
                *(u32x4*)(dst + (size_t)(row0 + ai * 128 + m * 16) * 256 + c8) = w;
            }
    }
};
__device__ __forceinline__ unsigned pk_u8x4(f32x4 v) { const unsigned a = (unsigned)(v[0] * 255.0f + 0.5f), b = (unsigned)(v[1] * 255.0f + 0.5f), c = (unsigned)(v[2] * 255.0f + 0.5f), d = (unsigned)(v[3] * 255.0f + 0.5f); return a | (b << 8) | (c << 16) | (d << 24); }
struct EpiGateBr {
    static constexpr bool DUP_OK = false; static constexpr int NST = 0;
    const float* bing;
    unsigned char* gs;
    bf16* MG; bf16* MI;
    __device__ __forceinline__ void operator()(const Acc& acc, const GUnit& u, int tid, int wr, int wc, int fr, int fq) const {
        const int br = (u.kind >> 1) & 3; const bool cjob = (u.kind & 8) != 0;
        unsigned so = (unsigned)tid * 16u; asm volatile("" : "+v"(so));
        const unsigned mo = so * 2u;
        if ((u.kind & 1) == 0) {
            const float* bb = bing + br * 1024 + u.pn * 256 + wc * 32 + 8 * fq;
            f32x4 bv[2][2];
#pragma unroll
            for (int bj = 0; bj < 2; ++bj)
#pragma unroll
                for (int n = 0; n < 2; ++n) bv[bj][n] = *(const f32x4*)(bb + bj * 128 + 4 * n);
            unsigned char* sp = gs;
#pragma unroll
            for (int ai = 0; ai < 2; ++ai)
#pragma unroll
                for (int m = 0; m < 4; ++m)
#pragma unroll
                    for (int bj = 0; bj < 2; ++bj) {
                        const float gs_ = u.f8 ? (1.0f / W1_SCALE) : 1.0f; f32x4 v0 = acc[ai][bj][m][0] * gs_ + bv[bj][0], v1 = acc[ai][bj][m][1] * gs_ + bv[bj][1];
#pragma unroll
                        for (int j = 0; j < 4; ++j) { v0[j] = sigmoidf_(v0[j]); v1[j] = sigmoidf_(v1[j]); }
                        u32x2 w; w.x = pk_u8x4(v0); w.y = pk_u8x4(v1);
                        *(u32x2*)(sp + (so >> 1)) = w; sp += 4096;
                    }
        } else {
            unsigned lo = (unsigned)(((wr * 64 + fr) * D + u.pn * 256 + wc * 32 + 8 * fq) * 2); asm volatile("" : "+v"(lo));
            unsigned char* op = cjob ? (unsigned char*)(MI + ((size_t)br * TC + (u.pm - TL / 256) * 256) * D) : (unsigned char*)(MG + (size_t)u.pm * 256 * D);
            const bool ldm = (br > 0 && !cjob), stm = (br < 3 && !cjob);
            if (ldm) { if (stm) branch<true, true>(acc, so, mo, lo, op); else branch<true, false>(acc, so, mo, lo, op); }
            else { if (stm) branch<false, true>(acc, so, mo, lo, op); else branch<false, false>(acc, so, mo, lo, op); }
        }
    }
    template <bool LDM, bool STM> __device__ __forceinline__ void branch(const Acc& acc, unsigned so, unsigned mo, unsigned lo, unsigned char* op) const {
        const unsigned char* sp = gs; unsigned char* mp = gs + 131072;
        u32x2 s[2][2]; u32x4 mw[2][2];
#define GB_U(ptr_) ({ auto q_ = (ptr_); asm volatile("" : "+s"(q_)); q_; })
#define GB_LOAD(t_) do { _Pragma("unroll") for (int k = 0; k < 2; ++k) { s[(t_) & 1][k] = *(const u32x2*)(GB_U(sp + ((t_) * 2 + k) * 4096) + (so >> 1)); \
            if (LDM) mw[(t_) & 1][k] = *(const u32x4*)(GB_U(mp + ((t_) * 2 + k) * 8192) + so); else mw[(t_) & 1][k] = (u32x4){0u, 0u, 0u, 0u}; } } while (0)
        GB_LOAD(0);
#pragma unroll
        for (int t = 0; t < 8; ++t) { const int ai = t >> 2, m = t & 3, p = t & 1;
            if (t < 7) GB_LOAD(t + 1);
#pragma unroll
            for (int k = 0; k < 2; ++k) { const int bj = k;
                const f32x4 y0 = acc[ai][bj][m][0], y1 = acc[ai][bj][m][1]; const u32x2 sk = s[p][k]; const u32x4 mk = mw[p][k]; f32x4 a0 = (f32x4){bflo(mk.x), bfhi(mk.x), bflo(mk.y), bfhi(mk.y)}, a1 = (f32x4){bflo(mk.z), bfhi(mk.z), bflo(mk.w), bfhi(mk.w)};
                a0[0] += (float)((sk.x >> 0) & 0xffu) * y0[0]; a0[1] += (float)((sk.x >> 8) & 0xffu) * y0[1]; a0[2] += (float)((sk.x >> 16) & 0xffu) * y0[2]; a0[3] += (float)((sk.x >> 24) & 0xffu) * y0[3];
                a1[0] += (float)((sk.y >> 0) & 0xffu) * y1[0]; a1[1] += (float)((sk.y >> 8) & 0xffu) * y1[1]; a1[2] += (float)((sk.y >> 16) & 0xffu) * y1[2]; a1[3] += (float)((sk.y >> 24) & 0xffu) * y1[3];
                if (!STM) { a0 = a0 * (1.0f / 255.0f); a1 = a1 * (1.0f / 255.0f); }
                u32x4 w; w.x = cvt_pk_bf16(a0[0], a0[1]); w.y = cvt_pk_bf16(a0[2], a0[3]); w.z = cvt_pk_bf16(a1[0], a1[1]); w.w = cvt_pk_bf16(a1[2], a1[3]);
                if (STM) *(u32x4*)(GB_U(mp + (t * 2 + k) * 8192) + so) = w;
                else *(u32x4*)(op + (size_t)(ai * 128 + m * 16) * D * 2 + lo + bj * 256) = w; }
            asm volatile("" ::: "memory");
        }
#undef GB_LOAD
#undef GB_U
    }
};

struct Frame {
    LAS unsigned char* lds;
    int tid, lane, wave, bid, G;
    unsigned char* ws;
};

__device__ __forceinline__ void transpose_item(const float* W, int K, int N, int src_col0, bf16* WT, int dst_row0, LAS float* scr, int kb, int lane) {
    const int k0 = 64 * kb;
    float tv[32];
#pragma unroll
    for (int i = 0; i < 32; ++i) { const int kk = 2 * i + (lane >> 5); tv[i] = W[(size_t)(k0 + kk) * N + src_col0 + (lane & 31)]; }
#pragma unroll
    for (int i = 0; i < 32; ++i) { const int kk = 2 * i + (lane >> 5); scr[kk * 33 + (lane & 31)] = tv[i]; }
    LDS_WAIT(); asm volatile("" ::: "memory");
    const int c = lane & 7;
#pragma unroll
    for (int j = 0; j < 4; ++j) { const int n = (lane >> 3) + 8 * j; const LAS float* s = scr + (8 * c) * 33 + n;
        u32x4 o; o.x = cvt_pk_bf16(s[0 * 33], s[1 * 33]); o.y = cvt_pk_bf16(s[2 * 33], s[3 * 33]); o.z = cvt_pk_bf16(s[4 * 33], s[5 * 33]); o.w = cvt_pk_bf16(s[6 * 33], s[7 * 33]);
        *(u32x4*)(WT + (size_t)(dst_row0 + n) * K + k0 + 8 * c) = o; }
    LDS_WAIT(); asm volatile("" ::: "memory");
}
__device__ __forceinline__ void transpose_item8(const float* W, int K, int N, int src_col0, unsigned char* WT, int dst_row0, LAS float* scr, int kb, int lane, float wscale) {
    const int k0 = 64 * kb;
    float tv[32];
#pragma unroll
    for (int i = 0; i < 32; ++i) { const int kk = 2 * i + (lane >> 5); tv[i] = W[(size_t)(k0 + kk) * N + src_col0 + (lane & 31)]; }
#pragma unroll
    for (int i = 0; i < 32; ++i) { const int kk = 2 * i + (lane >> 5); scr[kk * 33 + (lane & 31)] = tv[i]; }
    LDS_WAIT(); asm volatile("" ::: "memory");
    const int n = lane >> 1, hf = lane & 1; const LAS float* s = scr + (32 * hf) * 33 + n;
    u32x4 o0, o1;
    o0.x = pk_fp8x4(s[0 * 33] * wscale, s[1 * 33] * wscale, s[2 * 33] * wscale, s[3 * 33] * wscale); o0.y = pk_fp8x4(s[4 * 33] * wscale, s[5 * 33] * wscale, s[6 * 33] * wscale, s[7 * 33] * wscale);
    o0.z = pk_fp8x4(s[8 * 33] * wscale, s[9 * 33] * wscale, s[10 * 33] * wscale, s[11 * 33] * wscale); o0.w = pk_fp8x4(s[12 * 33] * wscale, s[13 * 33] * wscale, s[14 * 33] * wscale, s[15 * 33] * wscale);
    o1.x = pk_fp8x4(s[16 * 33] * wscale, s[17 * 33] * wscale, s[18 * 33] * wscale, s[19 * 33] * wscale); o1.y = pk_fp8x4(s[20 * 33] * wscale, s[21 * 33] * wscale, s[22 * 33] * wscale, s[23 * 33] * wscale);
    o1.z = pk_fp8x4(s[24 * 33] * wscale, s[25 * 33] * wscale, s[26 * 33] * wscale, s[27 * 33] * wscale); o1.w = pk_fp8x4(s[28 * 33] * wscale, s[29 * 33] * wscale, s[30 * 33] * wscale, s[31 * 33] * wscale);
    u32x4* dst = (u32x4*)(WT + (size_t)(dst_row0 + n) * K + k0 + 32 * hf); dst[0] = o0; dst[1] = o1;
    LDS_WAIT(); asm volatile("" ::: "memory");
}
__host__ __device__ __forceinline__ int inmap(int r) {
    if (r >= NINP) return r;
    const int t = r >> 8, cc = r & 255;
    if (t < 2) return cc < 128 ? 128 * t + cc : 256 + 128 * t + cc - 128;
    if (t < 6) return 256 * t + cc;
    if (t < 8) { const int p = t - 6; return cc < 128 ? 1536 + 128 * p + cc : 1792 + 128 * p + cc - 128; }
    return 2048 + 256 * (t - 8) + cc;
}
__device__ __forceinline__ void prologue_a(Frame& F, const Params& P) {
    LAS float* scr = (LAS float*)(F.lds + F.wave * 16384);
    const int gw = F.bid * NWAVES + F.wave, NGW = F.G * NWAVES;
    constexpr int I1 = 16 * 176, I2 = 44 * 32, I3 = 16 * 216, I4 = 4 * 32, I5 = 16 * 32;
    constexpr int I6 = 32;
    constexpr int NIT = 4 * I1 + 4 * I2 + 2 * I3 + 8 * I4 + 2 * I5 + 2 * I6;
    struct TI { const float* W; unsigned char* dst; int N, K, sc, drow, kb; bool f8; float scale; };
    auto decode = [&](int it, TI& t) {
        int r = it;
        if (r < 4 * I1) { const int mi = r / I1; r %= I1; const int kb = r / 176, nb = r % 176, d0 = nb * 32, pn = d0 >> 8, cc = d0 & 255;
            t = TI{P.in[I_FWI] + (size_t)mi * D * NFF, F.ws + WS_W1T + (size_t)mi * NFF * D, NFF, D, cc < 128 ? 128 * pn + cc : DFF + 128 * pn + cc - 128, d0, kb, true, W1_SCALE}; return; }
        r -= 4 * I1;
        if (r < 4 * I2) { const int mi = r / I2; r %= I2; const int kb = r / 32, nb = r % 32;
            t = TI{P.in[I_FWO] + (size_t)mi * DFF * D, F.ws + WS_W2T + (size_t)mi * D * DFF, D, DFF, nb * 32, nb * 32, kb, true, W2_SCALE}; return; }
        r -= 4 * I2;
        if (r < 2 * I3) { const int mi = r / I3; r %= I3; const int kb = r / 216, nb = r % 216; const float* W = P.in[I_WIN] + (size_t)mi * D * PIN;
            if (nb * 32 >= NINP + 3072) t = TI{W, F.ws + WS_WIT + ((size_t)mi * PIN + NINP) * D * 2 + 4 * MiB, PIN, D, inmap(nb * 32), nb * 32 - NINP - 3072, kb, false, 1.f};
            else if (nb * 32 >= NINP) t = TI{W, F.ws + WS_WIT + ((size_t)mi * PIN + NINP) * D * 2, PIN, D, inmap(nb * 32), nb * 32 - NINP, kb, true, W1_SCALE};
            else t = TI{W, F.ws + WS_WIT + (size_t)mi * PIN * D * 2, PIN, D, inmap(nb * 32), nb * 32, kb, false, 1.f};
            return; }
        r -= 2 * I3;
        if (r < 8 * I4) { const int mi = r / I4; r %= I4; const int l = mi >> 2, br = mi & 3, kb = r / 32, nb = r % 32;
            t = TI{P.in[br == 0 ? I_CWP : (br == 1 ? I_NWP : (br == 2 ? I_SWP : I_HWP))] + (size_t)l * 256 * D, F.ws + WS_WPT + (size_t)mi * D * 256 * 2, D, 256, nb * 32, nb * 32, kb, false, 1.f}; return; }
        r -= 8 * I4;
        if (r < 2 * I5) { const int mi = r / I5; r %= I5; const int kb = r / 32, nb = r % 32;
            t = TI{P.in[I_WOUT] + (size_t)mi * D * D, F.ws + WS_WOT + (size_t)mi * D * D * 2, D, D, nb * 32, nb * 32, kb, false, 1.f}; return; }
        r -= 2 * I5;
        { const int mi = r / I6, nb = r % I6; t = TI{P.in[I_HW3] + (size_t)mi * 64 * 1024, F.ws + WS_W3T + (size_t)mi * 1024 * 64 * 2, 1024, 64, nb * 32, nb * 32, 0, false, 1.f}; }
    };
    {
        const int lane = F.lane;
        TI cur; float tv[32];
        int it = gw;
        if (it < NIT) { decode(it, cur);
#pragma unroll
            for (int i = 0; i < 32; ++i) tv[i] = cur.W[(size_t)(64 * cur.kb + 2 * i + (lane >> 5)) * cur.N + cur.sc + (lane & 31)]; }
        for (; it < NIT; it += NGW) {
#pragma unroll
            for (int i = 0; i < 32; ++i) scr[(2 * i + (lane >> 5)) * 33 + (lane & 31)] = tv[i];
            TI nx; const bool more = it + NGW < NIT;
            if (more) { decode(it + NGW, nx);
#pragma unroll
                for (int i = 0; i < 32; ++i) tv[i] = nx.W[(size_t)(64 * nx.kb + 2 * i + (lane >> 5)) * nx.N + nx.sc + (lane & 31)]; }
            LDS_WAIT(); asm volatile("" ::: "memory");
            const int k0 = 64 * cur.kb;
            if (cur.f8) { const int n = lane >> 1, hf = lane & 1; const LAS float* s = scr + (32 * hf) * 33 + n; const float ws_ = cur.scale;
                u32x4 o0, o1;
                o0.x = pk_fp8x4(s[0 * 33] * ws_, s[1 * 33] * ws_, s[2 * 33] * ws_, s[3 * 33] * ws_); o0.y = pk_fp8x4(s[4 * 33] * ws_, s[5 * 33] * ws_, s[6 * 33] * ws_, s[7 * 33] * ws_);
                o0.z = pk_fp8x4(s[8 * 33] * ws_, s[9 * 33] * ws_, s[10 * 33] * ws_, s[11 * 33] * ws_); o0.w = pk_fp8x4(s[12 * 33] * ws_, s[13 * 33] * ws_, s[14 * 33] * ws_, s[15 * 33] * ws_);
                o1.x = pk_fp8x4(s[16 * 33] * ws_, s[17 * 33] * ws_, s[18 * 33] * ws_, s[19 * 33] * ws_); o1.y = pk_fp8x4(s[20 * 33] * ws_, s[21 * 33] * ws_, s[22 * 33] * ws_, s[23 * 33] * ws_);
                o1.z = pk_fp8x4(s[24 * 33] * ws_, s[25 * 33] * ws_, s[26 * 33] * ws_, s[27 * 33] * ws_); o1.w = pk_fp8x4(s[28 * 33] * ws_, s[29 * 33] * ws_, s[30 * 33] * ws_, s[31 * 33] * ws_);
                u32x4* dst = (u32x4*)(cur.dst + (size_t)(cur.drow + n) * cur.K + k0 + 32 * hf); dst[0] = o0; dst[1] = o1; }
            else { const int c = lane & 7;
#pragma unroll
                for (int j = 0; j < 4; ++j) { const int n = (lane >> 3) + 8 * j; const LAS float* s = scr + (8 * c) * 33 + n;
                    u32x4 o; o.x = cvt_pk_bf16(s[0 * 33], s[1 * 33]); o.y = cvt_pk_bf16(s[2 * 33], s[3 * 33]); o.z = cvt_pk_bf16(s[4 * 33], s[5 * 33]); o.w = cvt_pk_bf16(s[6 * 33], s[7 * 33]);
                    *(u32x4*)(cur.dst + ((size_t)(cur.drow + n) * cur.K + k0 + 8 * c) * 2) = o; } }
            LDS_WAIT(); asm volatile("" ::: "memory");
            cur = nx;
        }
    }
    { float* bin = (float*)(F.ws + WS_BIN); for (int i = F.bid * NTHR + F.tid; i < 2 * PIN; i += F.G * NTHR) { const int l = i / PIN, r = i % PIN; bin[i] = P.in[I_BIN][l * PIN + inmap(r)]; } }
    __syncthreads();
    LAS float* sv = (LAS float*)F.lds;
    LAS float* red = (LAS float*)(F.lds + 16384);
    for (int i = F.tid; i < 3 * D; i += NTHR) { const int g = i / D, k = i % D; const float c = g < 2 ? P.in[I_C][g * D + k] : P.in[I_CCTX][k]; sv[i] = siluf_(c); }
    __syncthreads();
    for (int un = F.bid; un < 2 * 144; un += F.G) {
        const int l = un / 144, n0 = (un % 144) * 64;
        const float* wm = P.in[I_WMOD] + (size_t)l * D * 9216 + n0 + F.lane;
        float a0 = 0.f, a1 = 0.f, a2 = 0.f;
#pragma unroll 1
        for (int k0 = 0; k0 < 128; k0 += 32) { float wv[32];
#pragma unroll
            for (int kk = 0; kk < 32; ++kk) wv[kk] = wm[(size_t)(F.wave * 128 + k0 + kk) * 9216];
#pragma unroll
            for (int kk = 0; kk < 32; ++kk) { const int k = F.wave * 128 + k0 + kk; a0 += sv[k] * wv[kk]; a1 += sv[D + k] * wv[kk]; a2 += sv[2 * D + k] * wv[kk]; } }
        red[(F.wave * 3 + 0) * 64 + F.lane] = a0; red[(F.wave * 3 + 1) * 64 + F.lane] = a1; red[(F.wave * 3 + 2) * 64 + F.lane] = a2;
        __syncthreads();
        if (F.tid < 192) { const int g = F.tid >> 6, ln = F.tid & 63; float s = P.in[I_BMOD][l * 9216 + n0 + ln];
#pragma unroll
            for (int w = 0; w < 8; ++w) s += red[(w * 3 + g) * 64 + ln];
            ((float*)(F.ws + WS_MOD))[(size_t)(l * 3 + g) * 9216 + n0 + ln] = s; }
        __syncthreads();
    }
}

__device__ __forceinline__ void ln_stats(const f32x4 (&v)[4], float& mean, float& rstd) {
    float s = 0.f;
#pragma unroll
    for (int j = 0; j < 4; ++j) s += (v[j][0] + v[j][1]) + (v[j][2] + v[j][3]);
    mean = wave_sum(s) * (1.0f / D);
    float q = 0.f;
#pragma unroll
    for (int j = 0; j < 4; ++j) { const f32x4 d = v[j] - mean; q += (d[0] * d[0] + d[1] * d[1]) + (d[2] * d[2] + d[3] * d[3]); }
    rstd = 1.0f / sqrtf(wave_sum(q) * (1.0f / D) + LN_EPS);
}
__device__ __forceinline__ void modulate_store(const f32x4 (&x)[4], const float* shift, const float* scale, bf16* hrow, int lane) {
    float mean, rstd; ln_stats(x, mean, rstd);
#pragma unroll
    for (int j = 0; j < 4; ++j) { const int c = 4 * lane + 256 * j; const f32x4 sc = *(const f32x4*)(scale + c), sh = *(const f32x4*)(shift + c);
        const f32x4 h = (x[j] - mean) * rstd * (sc + 1.0f) + sh;
        u32x2 w; w.x = cvt_pk_bf16(h[0], h[1]); w.y = cvt_pk_bf16(h[2], h[3]); *(u32x2*)(hrow + c) = w; }
}
__device__ __forceinline__ void modulate_store8(const f32x4 (&x)[4], const float* shift, const float* scale, unsigned char* hrow, int lane) {
    float mean, rstd; ln_stats(x, mean, rstd);
#pragma unroll
    for (int j = 0; j < 4; ++j) { const int c = 4 * lane + 256 * j; const f32x4 sc = *(const f32x4*)(scale + c), sh = *(const f32x4*)(shift + c);
        const f32x4 h = (x[j] - mean) * rstd * (sc + 1.0f) + sh;
        *(unsigned*)(hrow + c) = pk_fp8x4(h[0], h[1], h[2], h[3]); }
}
constexpr int LNR = 4;
__device__ __forceinline__ void ln_stats_r(const f32x4 (&v)[LNR][4], float (&mean)[LNR], float (&rstd)[LNR]) {
    float s[LNR];
#pragma unroll
    for (int r = 0; r < LNR; ++r) { s[r] = 0.f;
#pragma unroll
        for (int j = 0; j < 4; ++j) s[r] += (v[r][j][0] + v[r][j][1]) + (v[r][j][2] + v[r][j][3]); }
#pragma unroll
    for (int r = 0; r < LNR; ++r) s[r] = wave_sum(s[r]);
    float q[LNR];
#pragma unroll
    for (int r = 0; r < LNR; ++r) { mean[r] = s[r] * (1.0f / D); q[r] = 0.f;
#pragma unroll
        for (int j = 0; j < 4; ++j) { const f32x4 d = v[r][j] - mean[r]; q[r] += (d[0] * d[0] + d[1] * d[1]) + (d[2] * d[2] + d[3] * d[3]); } }
#pragma unroll
    for (int r = 0; r < LNR; ++r) q[r] = wave_sum(q[r]);
#pragma unroll
    for (int r = 0; r < LNR; ++r) rstd[r] = 1.0f / sqrtf(q[r] * (1.0f / D) + LN_EPS);
}
__device__ __forceinline__ void phase_mod0(Frame& F, const Params& P) {
    const int skip = (F.G > 8) ? 4 : 0;
    if (F.bid < skip) return;
    const int gw = (F.bid - skip) * NWAVES + F.wave, NGW = (F.G - skip) * NWAVES;
    const float* MOD = (const float*)(F.ws + WS_MOD); bf16* H = (bf16*)(F.ws + WS_H);
    for (int row0 = gw; row0 < MT; row0 += LNR * NGW) {
        f32x4 x[LNR][4]; int rows[LNR];
#pragma unroll
        for (int r = 0; r < LNR; ++r) { rows[r] = min(row0 + r * NGW, MT - 1); const int row = rows[r];
            const float* xr = row < TL ? P.in[I_X] + (size_t)row * D : P.in[I_CTX] + (size_t)(row - TL) * D;
#pragma unroll
            for (int j = 0; j < 4; ++j) x[r][j] = *(const f32x4*)(xr + 4 * F.lane + 256 * j); }
        float mean[LNR], rstd[LNR]; ln_stats_r(x, mean, rstd);
#pragma unroll
        for (int r = 0; r < LNR; ++r) if (row0 + r * NGW < MT) { const int row = rows[r], g = row < SEQ ? 0 : (row < TL ? 1 : 2);
            const float* shift = MOD + (size_t)g * 9216, *scale = shift + D;
#pragma unroll
            for (int j = 0; j < 4; ++j) { const int c = 4 * F.lane + 256 * j; const f32x4 sc = *(const f32x4*)(scale + c), sh = *(const f32x4*)(shift + c);
                const f32x4 h = (x[r][j] - mean[r]) * rstd[r] * (sc + 1.0f) + sh;
                *(unsigned*)((unsigned char*)H + (size_t)row * D + c) = pk_fp8x4(h[0], h[1], h[2], h[3]); } }
    }
}
__device__ __forceinline__ void phase_ln(Frame& F, const Params& P, const float* lg, const float* lb, const float* modl  , int ishift, bool hmod, bool h8  , bool dual  , bool final_out, int cx_nks, float cx_coef, const float* cx_modv  , const float* cx_bias, const float* cx_xsrc, bool skipx  , const bf16* vsrc  ) {
    const int gw = F.bid * NWAVES + F.wave, NGW = F.G * NWAVES;
    const bf16* V = vsrc; bf16* H = (bf16*)(F.ws + WS_H);
    f32x4 g4[4], b4[4];
#pragma unroll
    for (int j = 0; j < 4; ++j) { g4[j] = *(const f32x4*)(lg + 4 * F.lane + 256 * j); b4[j] = *(const f32x4*)(lb + 4 * F.lane + 256 * j); }
    if (cx_nks > 0) {
        const float* part = (const float*)(F.ws + WS_ES);
        for (int r = gw; r < TC; r += NGW) {
            f32x4 v[4];
#pragma unroll
            for (int j = 0; j < 4; ++j) { const int c = 4 * F.lane + 256 * j; f32x4 s = cx_bias ? *(const f32x4*)(cx_bias + c) : (f32x4){0.f, 0.f, 0.f, 0.f};
                for (int ks = 0; ks < cx_nks; ++ks) s += *(const f32x4*)(part + ((size_t)ks * TC + r) * D + c);
                v[j] = *(const f32x4*)(cx_xsrc + (size_t)r * D + c) * ALPHA + *(const f32x4*)(cx_modv + c) * cx_coef * s; }
            float mean, rstd; ln_stats(v, mean, rstd);
            float* xr = (float*)(F.ws + WS_XC) + (size_t)r * D;
#pragma unroll
            for (int j = 0; j < 4; ++j) { v[j] = (v[j] - mean) * rstd * g4[j] + b4[j]; *(f32x4*)(xr + 4 * F.lane + 256 * j) = v[j]; }
            if (hmod && dual) modulate_store8(v, modl + (size_t)2 * 9216 + ishift * D, modl + (size_t)2 * 9216 + (ishift + 1) * D, F.ws + WS_H8C + (size_t)r * D, F.lane);
            if (hmod) { if (h8) modulate_store8(v, modl + (size_t)2 * 9216 + ishift * D, modl + (size_t)2 * 9216 + (ishift + 1) * D, (unsigned char*)H + (size_t)(TL + r) * D, F.lane);
                        else modulate_store(v, modl + (size_t)2 * 9216 + ishift * D, modl + (size_t)2 * 9216 + (ishift + 1) * D, H + (size_t)(TL + r) * D, F.lane); }
        }
    }
    const int M = TL;
    u32x2 raw[LNR][4];
#pragma unroll
    for (int r = 0; r < LNR; ++r) { const int rw = min(gw + r * NGW, M - 1);
#pragma unroll
        for (int j = 0; j < 4; ++j) raw[r][j] = *(const u32x2*)(V + (size_t)rw * D + 4 * F.lane + 256 * j); }
    for (int row0 = gw; row0 < M; row0 += LNR * NGW) {
        f32x4 v[LNR][4]; int rows[LNR];
#pragma unroll
        for (int r = 0; r < LNR; ++r) { rows[r] = min(row0 + r * NGW, M - 1);
#pragma unroll
            for (int j = 0; j < 4; ++j) { const u32x2 w = raw[r][j]; v[r][j] = (f32x4){bflo(w.x), bfhi(w.x), bflo(w.y), bfhi(w.y)}; } }
        if (row0 + LNR * NGW < M) {
#pragma unroll
            for (int r = 0; r < LNR; ++r) { const int rw = min(row0 + (LNR + r) * NGW, M - 1);
#pragma unroll
                for (int j = 0; j < 4; ++j) raw[r][j] = *(const u32x2*)(V + (size_t)rw * D + 4 * F.lane + 256 * j); }
        }
        float mean[LNR], rstd[LNR]; ln_stats_r(v, mean, rstd);
#pragma unroll
        for (int r = 0; r < LNR; ++r) { const int row = rows[r]; const bool ok = row0 + r * NGW < M;
            float* xr = P.out + (size_t)row * D; bf16* xh = (bf16*)P.out + (size_t)row * D;
            if (skipx && ok && F.lane == 0) *(f32x2*)((float*)(F.ws + WS_LNS) + (size_t)row * 2) = (f32x2){mean[r], rstd[r]};
#pragma unroll
            for (int j = 0; j < 4; ++j) { v[r][j] = (v[r][j] - mean[r]) * rstd[r] * g4[j] + b4[j];
                if (ok) { if (final_out) __builtin_nontemporal_store(v[r][j], (f32x4*)(xr + 4 * F.lane + 256 * j));
                          else if (!skipx) { u32x2 w; w.x = cvt_pk_bf16(v[r][j][0], v[r][j][1]); w.y = cvt_pk_bf16(v[r][j][2], v[r][j][3]); __builtin_nontemporal_store(w, (u32x2*)(xh + 4 * F.lane + 256 * j)); } } } }
        if (hmod) {
            ln_stats_r(v, mean, rstd);
#pragma unroll
            for (int r = 0; r < LNR; ++r) if (row0 + r * NGW < M) { const int row = rows[r], g = row < SEQ ? 0 : 1;
                const float* shift = modl + (size_t)g * 9216 + ishift * D, *scale = shift + D; bf16* hrow = H + (size_t)row * D;
#pragma unroll
                for (int j = 0; j < 4; ++j) { const int c = 4 * F.lane + 256 * j; const f32x4 sc = *(const f32x4*)(scale + c), sh = *(const f32x4*)(shift + c);
                    const f32x4 h = (v[r][j] - mean[r]) * rstd[r] * (sc + 1.0f) + sh;
                    if (h8) __builtin_nontemporal_store(pk_fp8x4(h[0], h[1], h[2], h[3]), (unsigned*)((unsigned char*)H + (size_t)row * D + c));
                    else { u32x2 w; w.x = cvt_pk_bf16(h[0], h[1]); w.y = cvt_pk_bf16(h[2], h[3]); __builtin_nontemporal_store(w, (u32x2*)(hrow + c)); }
                    if (dual) __builtin_nontemporal_store(pk_fp8x4(h[0], h[1], h[2], h[3]), (unsigned*)(F.ws + WS_H8L + (size_t)row * D + c)); } }
        }
    }
}

__device__ __forceinline__ void filter_unit(Frame& F, const Params& P, int l, int L, int t0, float* filt  , bool bfout) {
    LAS float* h1 = (LAS float*)F.lds;
    LAS bf16* h2b = (LAS bf16*)(F.lds + 32768);
    LAS float* zf = (LAS float*)(F.lds + 65536);
    LAS float* w2s = (LAS float*)(F.lds + 81920);
    LAS float* w1s = (LAS float*)(F.lds + 98304);
    const float* w1 = P.in[I_HW1] + l * 33 * 64; const float* b1 = P.in[I_HB1] + l * 64; const float* w2 = P.in[I_HW2] + l * 64 * 64; const float* b2 = P.in[I_HB2] + l * 64;
    const float* fq = P.in[I_HFQ] + l * 128; const float* w3 = P.in[I_HW3] + (size_t)l * 64 * 1024;
    {
#pragma unroll
        for (int i = 0; i < 8; ++i) w2s[F.tid + 512 * i] = w2[F.tid + 512 * i];
#pragma unroll
        for (int i = 0; i < 5; ++i) if (F.tid + 512 * i < 33 * 64) w1s[F.tid + 512 * i] = w1[F.tid + 512 * i];
        const int tl = F.tid >> 3, jg = F.tid & 7; const float t = (float)(t0 + tl);
        if (jg == 0) zf[tl * 36] = t / (float)(L - 1);
#pragma unroll
        for (int ii = 0; ii < 2; ++ii) { const int i = jg + 8 * ii; const float band = 1e-4f + (float)i * ((15.0f - 1e-4f) / 15.0f); float s, c; sincospif(2.0f * t * band / (float)L, &s, &c); zf[tl * 36 + 1 + i] = c; zf[tl * 36 + 17 + i] = -s; }
        __syncthreads();
        float a[8];
#pragma unroll
        for (int jj = 0; jj < 8; ++jj) a[jj] = b1[jg * 8 + jj];
#pragma unroll 3
        for (int i = 0; i < 33; ++i) { const float zv = zf[tl * 36 + i]; const LAS f32x4* wp = (const LAS f32x4*)(w1s + i * 64 + jg * 8); const f32x4 wa = wp[0], wb = wp[1];
            a[0] += zv * wa[0]; a[1] += zv * wa[1]; a[2] += zv * wa[2]; a[3] += zv * wa[3]; a[4] += zv * wb[0]; a[5] += zv * wb[1]; a[6] += zv * wb[2]; a[7] += zv * wb[3]; }
#pragma unroll
        for (int jj = 0; jj < 8; ++jj) h1[tl * 65 + jg * 8 + jj] = sinf(fq[jg * 8 + jj] * a[jj]);
        __syncthreads();
#pragma unroll
        for (int jj = 0; jj < 8; ++jj) a[jj] = b2[jg * 8 + jj];
#pragma unroll 4
        for (int i = 0; i < 64; ++i) { const float hv = h1[tl * 65 + i]; const LAS f32x4* wp = (const LAS f32x4*)(w2s + i * 64 + jg * 8); const f32x4 wa = wp[0], wb = wp[1];
            a[0] += hv * wa[0]; a[1] += hv * wa[1]; a[2] += hv * wa[2]; a[3] += hv * wa[3]; a[4] += hv * wb[0]; a[5] += hv * wb[1]; a[6] += hv * wb[2]; a[7] += hv * wb[3]; }
#pragma unroll
        for (int jj = 0; jj < 8; ++jj) h2b[tl * 72 + jg * 8 + jj] = (bf16)(cvt_pk_bf16(sinf(fq[64 + jg * 8 + jj] * a[jj]), 0.f) & 0xffffu);
        __syncthreads();
    }
    {
        const bf16* W3T = (const bf16*)(F.ws + WS_W3T) + (size_t)l * 1024 * 64;
        const int lane = F.lane, lr = lane & 15, lg = lane >> 4;
        const float dl0 = -4.605170186f / 1.5f, dl1 = -4.605170186f / 0.3f;
        bf16x8 af[4][2];
#pragma unroll
        for (int rt = 0; rt < 4; ++rt)
#pragma unroll
            for (int ks = 0; ks < 2; ++ks) af[rt][ks] = *(const LAS bf16x8*)(h2b + (rt * 16 + lr) * 72 + ks * 32 + 8 * lg);
#pragma unroll 2
        for (int ct = 0; ct < 8; ++ct) {
            const int col = F.wave * 128 + ct * 16 + lr, c = col & 255;
            const bf16x8 b0 = *(const bf16x8*)(W3T + (size_t)col * 64 + 8 * lg), b1 = *(const bf16x8*)(W3T + (size_t)col * 64 + 32 + 8 * lg);
            const float ad = fabsf(dl0 + (dl1 - dl0) * (float)c / 255.0f);
#pragma unroll
            for (int rt = 0; rt < 4; ++rt) {
                f32x4 a = (f32x4){0.f, 0.f, 0.f, 0.f};
                a = __builtin_amdgcn_mfma_f32_16x16x32_bf16(af[rt][0], b0, a, 0, 0, 0);
                a = __builtin_amdgcn_mfma_f32_16x16x32_bf16(af[rt][1], b1, a, 0, 0, 0);
                const int tb = t0 + rt * 16 + 4 * lg;
#pragma unroll
                for (int e = 0; e < 4; ++e) { const float tn = (float)(tb + e) / (float)(L - 1); a[e] *= __expf(-tn * ad); }
                if (bfout) { u32x2 w; w.x = cvt_pk_bf16(a[0], a[1]); w.y = cvt_pk_bf16(a[2], a[3]); *(u32x2*)((bf16*)filt + (size_t)col * L + tb) = w; }
                else *(f32x4*)(filt + (size_t)col * L + tb) = a;
            }
        }
    }
    __syncthreads();
}
__device__ __forceinline__ void phase_filters(Frame& F, const Params& P, int l, bool with_ctx) {
    float* filt = (float*)(F.ws + WS_FILT); float* filtc = (float*)(F.ws + WS_FILTC);
    const int nu = SEQ / 64 + (with_ctx ? CTXL / 64 : 0);
    for (int u = F.bid; u < nu; u += F.G) {
        if (u < SEQ / 64) filter_unit(F, P, l, SEQ, u * 64, filt, true);
        else filter_unit(F, P, l, CTXL, (u - SEQ / 64) * 64, filtc, false);
    }
}

__device__ __forceinline__ void seg_of(int row, int& s0, int& s1) {
    if (row < TL) { s0 = row & ~(SEQ - 1); s1 = s0 + SEQ; } else { s0 = TL + ((row - TL) & ~(CTXL - 1)); s1 = s0 + CTXL; }
}
__device__ __forceinline__ void conformer_tiles(Frame& F, const Params& P, int l, int u0, int ntile) {
    const bf16* UA = (const bf16*)(F.ws + WS_UA); bf16* BR0 = (bf16*)(F.ws + WS_BRV);
    LAS bf16* tin = (LAS bf16*)F.lds;
    LAS float* cout = (LAS float*)(F.lds + 49152);
    const int c = F.tid & 255, half = F.tid >> 8;
    float w[31];
#pragma unroll
    for (int j = 0; j < 31; ++j) w[j] = P.in[I_CDW][(l * 31 + j) * 256 + c];
    const float b = P.in[I_CDB][l * 256 + c];
    const f32x4 g = *(const f32x4*)(P.in[I_CLG] + l * 256 + 4 * F.lane), bb = *(const f32x4*)(P.in[I_CLB] + l * 256 + 4 * F.lane);
    u32x4 v[6];
#define CONF_LOAD(u_) do { const int t0_ = (u_) * 64; int s0_, s1_; seg_of(t0_, s0_, s1_); _Pragma("unroll") for (int k = 0; k < 6; ++k) { const int idx = F.tid + NTHR * k, rr = idx >> 5, c8 = idx & 31, gr = t0_ - 15 + rr; \
        const bool ok_ = idx < 94 * 32 && gr >= s0_ && gr < s1_; const u32x4 t_ = *(const u32x4*)(UA + (size_t)min(max(gr, s0_), s1_ - 1) * 256 + c8 * 8); v[k] = ok_ ? t_ : (u32x4){0u, 0u, 0u, 0u}; } } while (0)
    if (u0 < ntile) CONF_LOAD(u0);
    for (int u = u0; u < ntile; u += F.G) {
        const int t0 = u * 64;
#pragma unroll
        for (int k = 0; k < 6; ++k) { const int idx = F.tid + NTHR * k, rr = idx >> 5, c8 = idx & 31; if (idx < 94 * 32) *(LAS u32x4*)(tin + rr * 256 + c8 * 8) = v[k]; }
        __syncthreads();
        if (u + F.G < ntile) CONF_LOAD(u + F.G);
        {
            float in[62];
#pragma unroll
            for (int i = 0; i < 62; ++i) in[i] = bf2f(tin[(half * 32 + i) * 256 + c]);
#pragma unroll
            for (int t = 0; t < 32; ++t) { float a = b;
#pragma unroll
                for (int j = 0; j < 31; ++j) a += w[j] * in[t + j];
                cout[(half * 32 + t) * 260 + c] = a; }
        }
        __syncthreads();
        {
            f32x4 v[8]; float s[8], q[8];
#pragma unroll
            for (int tt = 0; tt < 8; ++tt) { v[tt] = *(const LAS f32x4*)(cout + (F.wave * 8 + tt) * 260 + 4 * F.lane); s[tt] = (v[tt][0] + v[tt][1]) + (v[tt][2] + v[tt][3]); }
#pragma unroll
            for (int tt = 0; tt < 8; ++tt) s[tt] = wave_sum(s[tt]);
#pragma unroll
            for (int tt = 0; tt < 8; ++tt) { v[tt] = v[tt] - s[tt] * (1.0f / 256.0f); q[tt] = (v[tt][0] * v[tt][0] + v[tt][1] * v[tt][1]) + (v[tt][2] * v[tt][2] + v[tt][3] * v[tt][3]); }
#pragma unroll
            for (int tt = 0; tt < 8; ++tt) q[tt] = wave_sum(q[tt]);
#pragma unroll
            for (int tt = 0; tt < 8; ++tt) { const float rstd = 1.0f / sqrtf(q[tt] * (1.0f / 256.0f) + LN_EPS);
                f32x4 y = v[tt] * rstd * g + bb;
#pragma unroll
                for (int j = 0; j < 4; ++j) y[j] = siluf_(y[j]);
                u32x2 wv; wv.x = cvt_pk_bf16(y[0], y[1]); wv.y = cvt_pk_bf16(y[2], y[3]);
                __builtin_nontemporal_store(wv, (u32x2*)(BR0 + (size_t)(t0 + F.wave * 8 + tt) * 256 + 4 * F.lane)); }
        }
        __syncthreads();
    }
}
#undef CONF_LOAD
__device__ __forceinline__ void shortconv_unit(Frame& F, const Params& P, int l, int t0) {
    const bf16* SB = (const bf16*)(F.ws + WS_SB); const bf16* W = (const bf16*)(F.ws + WS_W); bf16* BR2 = (bf16*)(F.ws + WS_BRV) + 2 * (size_t)MT * 256;
    int s0, s1; seg_of(t0, s0, s1);
    const float* cw = P.in[I_SCW] + l * 3 * 256;
#pragma unroll
    for (int k = 0; k < 4; ++k) { const int idx = F.tid + NTHR * k, tok = idx >> 5, c8 = (idx & 31) * 8, gr = t0 + tok;
        const u32x4 z = (u32x4){0u, 0u, 0u, 0u};
        const u32x4 wm_ = *(const u32x4*)(W + (size_t)max(gr - 1, s0) * 256 + c8), w0 = *(const u32x4*)(W + (size_t)gr * 256 + c8),
                    wp_ = *(const u32x4*)(W + (size_t)min(gr + 1, s1 - 1) * 256 + c8), sb = *(const u32x4*)(SB + (size_t)gr * 256 + c8);
        const u32x4 wm = (gr - 1 >= s0) ? wm_ : z, wp = (gr + 1 < s1) ? wp_ : z;
        float o[8];
#pragma unroll
        for (int j = 0; j < 4; ++j) { const int c = c8 + 2 * j;
            o[2 * j] = bflo(sb[j]) * (cw[c] * bflo(wm[j]) + cw[256 + c] * bflo(w0[j]) + cw[512 + c] * bflo(wp[j]));
            o[2 * j + 1] = bfhi(sb[j]) * (cw[c + 1] * bfhi(wm[j]) + cw[256 + c + 1] * bfhi(w0[j]) + cw[512 + c + 1] * bfhi(wp[j])); }
        u32x4 w; w.x = cvt_pk_bf16(o[0], o[1]); w.y = cvt_pk_bf16(o[2], o[3]); w.z = cvt_pk_bf16(o[4], o[5]); w.w = cvt_pk_bf16(o[6], o[7]);
        __builtin_nontemporal_store(w, (u32x4*)(BR2 + (size_t)gr * 256 + c8)); }
}
__device__ __forceinline__ void attn_stage_ctx(Frame& F, int b, int h) {
    const unsigned char* K = F.ws + WS_K; const unsigned char* VT = F.ws + WS_VT;
#pragma unroll
    for (int i = 0; i < 4; ++i) { const int pi = F.tid + NTHR * i;
        { const int key = pi >> 3, pc = pi & 7; const u32x4 v = *(const u32x4*)(K + (size_t)(TL + b * CTXL + key) * 512 + h * 128 + pc * 16);
          *(LAS u32x4*)(F.lds + key * 128 + ((pc ^ ((key & 3) | ((key >> 1) & 4))) << 4)) = v; }
        { const int dim = pi >> 5, pc = pi & 31; const u32x4 v = *(const u32x4*)(VT + ((size_t)(h * 64 + dim) * MT + TL + b * CTXL) * 2 + pc * 16);
          *(LAS u32x4*)(F.lds + 32768 + dim * 512 + ((pc ^ (dim & 7)) << 4)) = v; } }
}
__device__ __forceinline__ void attn_wave_unit(Frame& F, int wu, bool lat, bool cl  ) {
    const bf16* Q = (const bf16*)(F.ws + WS_Q); const bf16* K = (const bf16*)(F.ws + WS_K); const bf16* VT = (const bf16*)(F.ws + WS_VT);
    bf16* BR1 = (bf16*)(F.ws + WS_BRV) + (size_t)MT * 256;
    const LAS float* rpb = (const LAS float*)(F.lds + RPB_OFF);
    const int lane = lane_now(), q = lane & 15, g = lane >> 4;
    int b, h, r = 0, qb, tq0, cb = 0, r0 = 0;
    if (lat) { qb = wu & 3; h = (wu >> 2) & 3; r = (wu >> 4) & 255; b = wu >> 12; tq0 = b * SEQ + r * 64 + 16 * qb; cb = (qb == 0) ? 0 : (qb == 1 ? 8 : (qb == 2 ? 24 : 32)); r0 = min(max(r - 4, 0), 248); }
    else { qb = wu & 15; h = (wu >> 4) & 3; b = wu >> 6; tq0 = TL + b * CTXL + 16 * qb; }
    bf16x8 qf[2];
#pragma unroll
    for (int kk = 0; kk < 2; ++kk) qf[kk] = *(const bf16x8*)(Q + (size_t)(tq0 + q) * 256 + h * 64 + 32 * kk + 8 * g);
    const int koff = (q >> 2) * 8 + (q & 3);
    const unsigned klo = (unsigned)((koff * 256 + h * 64 + 8 * g) * 2);
    const unsigned vlo = (unsigned)((((h * 64 + q) * MT) + 8 * g) * 2);
    const char* Kc = (const char*)K; const char* Vc = (const char*)VT;
    const int kl0 = koff * 128 + ((g ^ ((q & 3) | (((q >> 2) & 1) << 2))) << 4), vl0 = 32768 + q * 512 + ((g ^ (q & 7)) << 4);
    const int cq = 16 * qb + q, c0 = min(max(cq - 8, 0), 48);
    float mx = -1e30f, sum = 0.f;
    f32x4 o[4];
#pragma unroll
    for (int bl = 0; bl < 4; ++bl) o[bl] = (f32x4){0.f, 0.f, 0.f, 0.f};
    bf16x8 kf[2][2][2];
#define ATT_KBASE(i_) (((i_) < 8) ? (b * SEQ + (r0 + (i_)) * 64 + cb) : (TL + b * CTXL + 32 * ((i_) - 8)))
#define ATT_LOADK(c_) do { _Pragma("unroll") for (int s_ = 0; s_ < 2; ++s_) { const int kb_ = ATT_KBASE(2 * (c_) + s_); _Pragma("unroll") for (int tt = 0; tt < 2; ++tt) { \
        if (cl && (c_) >= 4) { const int lo_ = (2 * (c_) + s_ - 8) * 4096 + tt * 512; kf[s_][tt][0] = *(const LAS bf16x8*)(F.lds + lo_ + kl0); kf[s_][tt][1] = *(const LAS bf16x8*)(F.lds + lo_ + (kl0 ^ 64)); } \
        else { const char* kp_ = Kc + (size_t)(kb_ + 4 * tt) * 512; kf[s_][tt][0] = *(const bf16x8*)(kp_ + klo); kf[s_][tt][1] = *(const bf16x8*)(kp_ + klo + 64); } } } } while (0)
#define ATT_LOADV(dst_, c_) do { _Pragma("unroll") for (int s_ = 0; s_ < 2; ++s_) { const int kb_ = ATT_KBASE(2 * (c_) + s_); _Pragma("unroll") for (int bl = 0; bl < 4; ++bl) \
        { if (cl && (c_) >= 4) { const int m_ = 2 * (c_) + s_ - 8; dst_[s_][bl] = *(const LAS bf16x8*)(F.lds + bl * 8192 + (m_ >> 1) * 128 + ((m_ & 1) ? (vl0 ^ 64) : vl0)); } \
          else dst_[s_][bl] = *(const bf16x8*)(Vc + ((size_t)(16 * bl) * MT + kb_) * 2 + vlo); } } } while (0)
    bf16x8 vf[2][4], vn[2][4];
    u32x4 kg[2][2][4], vg[2][4];
    LAS unsigned char* wb = F.lds + 65536 + F.wave * 8192;
    const int kq = lane >> 3;
    const int wk0 = kq * 128 + (((lane & 7) ^ (kq & 3)) << 4), wv0 = 4096 + (lane >> 2) * 64 + (((lane & 3) ^ ((lane >> 3) & 3)) << 4), vl1 = 4096 + q * 64 + ((g ^ ((q >> 1) & 3)) << 4);
    const unsigned gk = (unsigned)(kq * 512 + h * 128 + (lane & 7) * 16), gv = (unsigned)(((h * 64 + (lane >> 2)) * MT) * 2 + (lane & 3) * 16);
#define ATT_GLOADK(c_) do { _Pragma("unroll") for (int s_ = 0; s_ < 2; ++s_) { const int kb_ = ATT_KBASE(2 * (c_) + s_); _Pragma("unroll") for (int n = 0; n < 4; ++n) \
        kg[(c_) & 1][s_][n] = *(const u32x4*)(Kc + (size_t)kb_ * 512 + (size_t)n * 4096 + gk); } } while (0)
#define ATT_GLOADV(c_) do { _Pragma("unroll") for (int s_ = 0; s_ < 2; ++s_) { const int kb_ = ATT_KBASE(2 * (c_) + s_); _Pragma("unroll") for (int n = 0; n < 4; ++n) \
        vg[s_][n] = *(const u32x4*)(Vc + (size_t)kb_ * 2 + (size_t)n * 16 * MT * 2 + gv); } } while (0)
#define ATT_XPOSEK(c_) do { _Pragma("unroll") for (int s_ = 0; s_ < 2; ++s_) { \
        _Pragma("unroll") for (int n = 0; n < 4; ++n) *(LAS u32x4*)(wb + n * 1024 + ((n & 1) ? (wk0 ^ 64) : wk0)) = kg[(c_) & 1][s_][n]; \
        _Pragma("unroll") for (int tt = 0; tt < 2; ++tt) { kf[s_][tt][0] = *(const LAS bf16x8*)(wb + tt * 512 + kl0); kf[s_][tt][1] = *(const LAS bf16x8*)(wb + tt * 512 + (kl0 ^ 64)); } } } while (0)
#define ATT_XPOSEV() do { _Pragma("unroll") for (int s_ = 0; s_ < 2; ++s_) { \
        _Pragma("unroll") for (int n = 0; n < 4; ++n) *(LAS u32x4*)(wb + n * 1024 + wv0) = vg[s_][n]; \
        _Pragma("unroll") for (int bl = 0; bl < 4; ++bl) vf[s_][bl] = *(const LAS bf16x8*)(wb + bl * 1024 + vl1); } } while (0)
    if (cl) { ATT_GLOADK(0); ATT_GLOADV(0); ATT_GLOADK(1); } else if (lat) { ATT_LOADK(0); ATT_LOADV(vf, 0); } else { ATT_LOADK(4); ATT_LOADV(vf, 4); }
#pragma unroll
    for (int c = 0; c < 8; ++c) {
        if (c < 4 && !lat) continue;
        if (cl) { if (c < 4) { ATT_XPOSEK(c); if (c < 2) ATT_GLOADK(c + 2); } else { ATT_LOADK(c); ATT_LOADV(vf, c); } }
        f32x4 s[2][2];
#pragma unroll
        for (int s_ = 0; s_ < 2; ++s_)
#pragma unroll
            for (int tt = 0; tt < 2; ++tt) {
                f32x4 a = (f32x4){0.f, 0.f, 0.f, 0.f};
                a = __builtin_amdgcn_mfma_f32_16x16x32_bf16(kf[s_][tt][0], qf[0], a, 0, 0, 0);
                a = __builtin_amdgcn_mfma_f32_16x16x32_bf16(kf[s_][tt][1], qf[1], a, 0, 0, 0);
                if (c < 4) {
                    const int i = 2 * c + s_;
                    const LAS float* rp = rpb + (h * 15 + (r0 + i - r + 7)) * 31;
#pragma unroll
                    for (int j = 0; j < 4; ++j) { const int kc = cb + 8 * g + 4 * tt + j; const bool ok = (kc >= c0) && (kc < c0 + 16);
                        const int dc = min(max(kc - cq + 15, 0), 30);
                        a[j] = ok ? a[j] + rp[dc] : -1e30f; }
                }
                s[s_][tt] = a;
            }
        if (!cl && c < 7) { ATT_LOADK(c + 1); ATT_LOADV(vn, c + 1); }
        if (cl && c < 4) { ATT_XPOSEV(); if (c < 3) ATT_GLOADV(c + 1); }
        float cm = -1e30f;
#pragma unroll
        for (int s_ = 0; s_ < 2; ++s_)
#pragma unroll
            for (int tt = 0; tt < 2; ++tt)
#pragma unroll
                for (int j = 0; j < 4; ++j) cm = fmaxf(cm, s[s_][tt][j]);
        cm = xrow_max(cm);
        const float mn = fmaxf(mx, cm), alpha = __builtin_amdgcn_exp2f(mx - mn);
        mx = mn; sum *= alpha;
#pragma unroll
        for (int bl = 0; bl < 4; ++bl) o[bl] *= alpha;
#pragma unroll
        for (int s_ = 0; s_ < 2; ++s_) {
            float p[8];
#pragma unroll
            for (int tt = 0; tt < 2; ++tt)
#pragma unroll
                for (int j = 0; j < 4; ++j) { const float e = __builtin_amdgcn_exp2f(s[s_][tt][j] - mn); p[4 * tt + j] = e; sum += e; }
            u32x4 pw; pw.x = cvt_pk_bf16(p[0], p[1]); pw.y = cvt_pk_bf16(p[2], p[3]); pw.z = cvt_pk_bf16(p[4], p[5]); pw.w = cvt_pk_bf16(p[6], p[7]);
            const bf16x8 pf = __builtin_bit_cast(bf16x8, pw);
#pragma unroll
            for (int bl = 0; bl < 4; ++bl) o[bl] = __builtin_amdgcn_mfma_f32_16x16x32_bf16(vf[s_][bl], pf, o[bl], 0, 0, 0);
        }
        if (!cl && c < 7) {
#pragma unroll
            for (int s_ = 0; s_ < 2; ++s_)
#pragma unroll
                for (int bl = 0; bl < 4; ++bl) vf[s_][bl] = vn[s_][bl];
        }
    }
#undef ATT_XPOSEK
#undef ATT_XPOSEV
#undef ATT_GLOADK
#undef ATT_GLOADV
#undef ATT_LOADV
#undef ATT_LOADK
#undef ATT_KBASE
    sum = xrow_sum(sum);
    const float inv = 1.0f / sum;
#pragma unroll
    for (int bl = 0; bl < 4; ++bl) { u32x2 w; w.x = cvt_pk_bf16(o[bl][0] * inv, o[bl][1] * inv); w.y = cvt_pk_bf16(o[bl][2] * inv, o[bl][3] * inv);
        __builtin_nontemporal_store(w, (u32x2*)(BR1 + (size_t)(tq0 + q) * 256 + h * 64 + 16 * bl + 4 * g)); }
}

constexpr int FL = 16384;
__device__ __forceinline__ f32x2 cmul(f32x2 a, f32x2 b) {
    f32x2 t, r;
    asm("v_pk_mul_f32 %1, %2, %3 op_sel:[1,1] op_sel_hi:[1,0]\n\tv_pk_fma_f32 %0, %2, %3, %1 op_sel:[0,0,0] op_sel_hi:[0,1,1] neg_lo:[0,0,1]" : "=v"(r), "=&v"(t) : "v"(a), "v"(b));
    return r;
}
__device__ __forceinline__ f32x2 cmulc(f32x2 a, f32x2 b) {
    f32x2 t, r;
    asm("v_pk_mul_f32 %1, %2, %3 op_sel:[1,1] op_sel_hi:[1,0]\n\tv_pk_fma_f32 %0, %2, %3, %1 op_sel:[0,0,0] op_sel_hi:[0,1,1] neg_hi:[1,0,0]" : "=v"(r), "=&v"(t) : "v"(a), "v"(b));
    return r;
}
__device__ __forceinline__ f32x2 rotm(f32x2 b, f32x2 d) { f32x2 r; asm("v_pk_add_f32 %0, %1, %2 op_sel:[0,1] op_sel_hi:[1,0] neg_hi:[0,1]" : "=v"(r) : "v"(b), "v"(d)); return r; }
__device__ __forceinline__ f32x2 rotp(f32x2 b, f32x2 d) { f32x2 r; asm("v_pk_add_f32 %0, %1, %2 op_sel:[0,1] op_sel_hi:[1,0] neg_lo:[0,1]" : "=v"(r) : "v"(b), "v"(d)); return r; }
__device__ __forceinline__ f32x2 tw_main(const LAS f32x2* T, int m) { return cmul(T[m >> 7], T[128 + (m & 127)]); }
__device__ __forceinline__ f32x2 tw_half(const LAS f32x2* T, int n) { return cmul(T[256 + (n >> 7)], T[384 + (n & 127)]); }
__device__ __forceinline__ void r4f(f32x2& x0, f32x2& x1, f32x2& x2, f32x2& x3, f32x2 w1, f32x2 w2, f32x2 w3) {
    const f32x2 a = x0 + x2, b = x0 - x2, c = x1 + x3, d = x1 - x3;
    x0 = a + c; x1 = cmul(rotm(b, d), w1); x2 = cmul(a - c, w2); x3 = cmul(rotp(b, d), w3);
}
__device__ __forceinline__ void r4f1(f32x2& x0, f32x2& x1, f32x2& x2, f32x2& x3) {
    const f32x2 a = x0 + x2, b = x0 - x2, c = x1 + x3, d = x1 - x3;
    x0 = a + c; x1 = rotm(b, d); x2 = a - c; x3 = rotp(b, d);
}
__device__ __forceinline__ void r4i(f32x2& x0, f32x2& x1, f32x2& x2, f32x2& x3, f32x2 w1, f32x2 w2, f32x2 w3) {
    const f32x2 t1 = cmulc(x1, w1), t2 = cmulc(x2, w2), t3 = cmulc(x3, w3);
    const f32x2 a = x0 + t2, b = x0 - t2, c = t1 + t3, d = t1 - t3;
    x0 = a + c; x1 = rotp(b, d); x2 = a - c; x3 = rotm(b, d);
}
__device__ __forceinline__ void r4i1(f32x2& x0, f32x2& x1, f32x2& x2, f32x2& x3) {
    const f32x2 a = x0 + x2, b = x0 - x2, c = x1 + x3, d = x1 - x3;
    x0 = a + c; x1 = rotp(b, d); x2 = a - c; x3 = rotm(b, d);
}
#define W16_1 ((f32x2){0.92387953251f, -0.38268343237f})
#define W16_2 ((f32x2){0.70710678119f, -0.70710678119f})
#define W16_3 ((f32x2){0.38268343237f, -0.92387953251f})
template <int SP, bool INV> __device__ __forceinline__ void fft_pass16(LAS f32x2* B, const LAS f32x2* T, int tid) {
    constexpr int STEP = (SP == 1024) ? 1040 : (SP == 64 ? 65 : 4);
#pragma unroll
    for (int jj = 0; jj < 2; ++jj) {
        const int q = tid + 512 * jj;
        int k, base;
        if (SP == 1024) { k = q; base = q + (q >> 6); }
        else if (SP == 64) { k = q & 63; const int i0 = (q >> 6) * 1024 + k; base = i0 + (i0 >> 6); }
        else { k = q >> 8; base = (q & 255) * 65 + k; }
        LAS f32x2* p = B + base;
        f32x2 x[16];
#pragma unroll
        for (int m = 0; m < 16; ++m) x[m] = p[m * STEP];
        const f32x2 b = tw_main(T, k * (1024 / SP));
        const f32x2 b2 = cmul(b, b), w = cmul(b2, b2), w2 = cmul(w, w), w3 = cmul(w, w2);
        f32x2 t1[4], t2[4], t3[4];
        t1[0] = b; t1[1] = cmul(b, W16_1); t1[2] = cmul(b, W16_2); t1[3] = cmul(b, W16_3);
#pragma unroll
        for (int m = 0; m < 4; ++m) { t2[m] = cmul(t1[m], t1[m]); t3[m] = cmul(t1[m], t2[m]); }
        if (!INV) {
#pragma unroll
            for (int m = 0; m < 4; ++m) r4f(x[m], x[m + 4], x[m + 8], x[m + 12], t1[m], t2[m], t3[m]);
#pragma unroll
            for (int j = 0; j < 4; ++j) r4f(x[4 * j], x[4 * j + 1], x[4 * j + 2], x[4 * j + 3], w, w2, w3);
        } else {
#pragma unroll
            for (int j = 0; j < 4; ++j) r4i(x[4 * j], x[4 * j + 1], x[4 * j + 2], x[4 * j + 3], w, w2, w3);
#pragma unroll
            for (int m = 0; m < 4; ++m) r4i(x[m], x[m + 4], x[m + 8], x[m + 12], t1[m], t2[m], t3[m]);
        }
#pragma unroll
        for (int m = 0; m < 16; ++m) p[m * STEP] = x[m];
    }
    __syncthreads();
}
template <bool INV> __device__ __forceinline__ void fft_pass4(LAS f32x2* B, int tid) {
#pragma unroll 4
    for (int jj = 0; jj < 8; ++jj) {
        const int q = tid + 512 * jj;
        LAS f32x2* p = B + (q & 255) * 65 + 4 * (q >> 8);
        f32x2 x0 = p[0], x1 = p[1], x2 = p[2], x3 = p[3];
        if (!INV) r4f1(x0, x1, x2, x3); else r4i1(x0, x1, x2, x3);
        p[0] = x0; p[1] = x1; p[2] = x2; p[3] = x3;
    }
    __syncthreads();
}
__device__ __forceinline__ void fft_fwd(LAS f32x2* B, const LAS f32x2* T, int tid) {
    fft_pass16<1024, false>(B, T, tid); fft_pass16<64, false>(B, T, tid); fft_pass16<4, false>(B, T, tid); fft_pass4<false>(B, tid);
}
__device__ __forceinline__ void fft_inv(LAS f32x2* B, const LAS f32x2* T, int tid) {
    fft_pass4<true>(B, tid); fft_pass16<4, true>(B, T, tid); fft_pass16<64, true>(B, T, tid); fft_pass16<1024, true>(B, T, tid);
}
__device__ __forceinline__ void fft_pass4_keep(LAS f32x2* B, int tid, u32x4 (&ks)[8]) {
#pragma unroll
    for (int jj = 0; jj < 8; ++jj) {
        const int q = tid + 512 * jj;
        const LAS f32x2* p = B + (q & 255) * 65 + 4 * (q >> 8);
        f32x2 x0 = p[0], x1 = p[1], x2 = p[2], x3 = p[3];
        r4f1(x0, x1, x2, x3);
        ks[jj].x = cvt_pk_bf16(x0.x, x0.y); ks[jj].y = cvt_pk_bf16(x1.x, x1.y); ks[jj].z = cvt_pk_bf16(x2.x, x2.y); ks[jj].w = cvt_pk_bf16(x3.x, x3.y);
    }
    __syncthreads();
}
__device__ __forceinline__ void fft_mid4(LAS f32x2* B, int tid, const u32x4 (&ks)[8]) {
#pragma unroll
    for (int jj = 0; jj < 8; ++jj) {
        const int q = tid + 512 * jj;
        LAS f32x2* p = B + (q & 255) * 65 + 4 * (q >> 8);
        f32x2 x0 = p[0], x1 = p[1], x2 = p[2], x3 = p[3];
        r4f1(x0, x1, x2, x3);
        x0 = cmul(x0, (f32x2){bflo(ks[jj].x), bfhi(ks[jj].x)}); x1 = cmul(x1, (f32x2){bflo(ks[jj].y), bfhi(ks[jj].y)});
        x2 = cmul(x2, (f32x2){bflo(ks[jj].z), bfhi(ks[jj].z)}); x3 = cmul(x3, (f32x2){bflo(ks[jj].w), bfhi(ks[jj].w)});
        r4i1(x0, x1, x2, x3);
        p[0] = x0; p[1] = x1; p[2] = x2; p[3] = x3;
    }
    __syncthreads();
}
__device__ __forceinline__ void fft_fwd3(LAS f32x2* B, const LAS f32x2* T, int tid) { fft_pass16<1024, false>(B, T, tid); fft_pass16<64, false>(B, T, tid); fft_pass16<4, false>(B, T, tid); }
__device__ __forceinline__ void fft_inv3(LAS f32x2* B, const LAS f32x2* T, int tid) { fft_pass16<4, true>(B, T, tid); fft_pass16<64, true>(B, T, tid); fft_pass16<1024, true>(B, T, tid); }
__device__ __forceinline__ float conv3_at(const bf16* p, int n, int L, float w0, float w1, float w2, float b) {
    const float xm = n > 0 ? bf2f(p[n - 1]) : 0.f, x0 = bf2f(p[n]), xp = n + 1 < L ? bf2f(p[n + 1]) : 0.f;
    return w0 * xm + w1 * x0 + w2 * xp + b;
}
__device__ __forceinline__ float block_sum(Frame& F, float v) {
    LAS float* red = (LAS float*)(F.lds + RED_OFF);
    v = wave_sum(v);
    __syncthreads();
    if (F.lane == 0) red[F.wave] = v;
    __syncthreads();
    float s = 0.f;
#pragma unroll
    for (int w = 0; w < 8; ++w) s += red[w];
    return s;
}
__device__ __forceinline__ f32x4 conv3x4(const bf16* p, int nb, float w0, float w1, float w2, float b) {
    const u32x2 m = *(const u32x2*)(p + nb);
    const float x0 = bflo(m.x), x1 = bfhi(m.x), x2 = bflo(m.y), x3 = bfhi(m.y);
    const float xm = nb > 0 ? bf2f(p[nb - 1]) : 0.f, xp = nb + 4 < SEQ ? bf2f(p[nb + 4]) : 0.f;
    return (f32x4){w0 * xm + w1 * x0 + w2 * x1 + b, w0 * x0 + w1 * x1 + w2 * x2 + b, w0 * x1 + w1 * x2 + w2 * x3 + b, w0 * x2 + w1 * x3 + w2 * xp + b};
}
typedef u32x4 u32x4_a4 __attribute__((aligned(4)));
__device__ __forceinline__ u32x4 ld16u(const bf16* p) { return *(const u32x4_a4*)p; }
__device__ __forceinline__ void conv3p(const u32x4 a, const u32x4 b, bool first, bool last, float w0, float w1, float w2, float bb, f32x2 (&z)[4]) {
    f32x2 X[6];
    X[0] = (f32x2){bfhi(a.x), bfhi(b.x)}; X[1] = (f32x2){bflo(a.y), bflo(b.y)}; X[2] = (f32x2){bfhi(a.y), bfhi(b.y)};
    X[3] = (f32x2){bflo(a.z), bflo(b.z)}; X[4] = (f32x2){bfhi(a.z), bfhi(b.z)}; X[5] = (f32x2){bflo(a.w), bflo(b.w)};
    if (first) X[0] = (f32x2){0.f, 0.f};
    if (last) X[5] = (f32x2){0.f, 0.f};
#pragma unroll
    for (int e = 0; e < 4; ++e) z[e] = X[e] * w0 + (X[e + 1] * w1 + (X[e + 2] * w2 + bb));
}
__device__ __forceinline__ void hyena_unit(Frame& F, const Params& P, int l, int c, bool dummy) {
    LAS f32x2* B = (LAS f32x2*)F.lds; const LAS f32x2* T = (const LAS f32x2*)(F.lds + TW_OFF);
    const bf16* HT = (const bf16*)(F.ws + WS_HT); const bf16* FILT = (const bf16*)(F.ws + WS_FILT);
    f32x4* Z = (f32x4*)(F.ws + WS_KSCR + (size_t)F.bid * 131072);
    u32x4 ksr[8];
    u32x4* ES = (u32x4*)(F.ws + WS_ES + (size_t)F.bid * 131072) + 4096;
    bf16* BR3 = (bf16*)(F.ws + WS_BRV) + 3 * (size_t)MT * 256;
    const float* sw = P.in[I_HSW] + l * 3 * 768; const float* sb = P.in[I_HSB] + l * 768;
    const int tid = F.tid;
#define HY_NB(jp_) (4 * tq + 2048 * (jp_))
#define HY_TQ int tq = tid; asm volatile("" : "+v"(tq))
#define HY_G(T_, base_, boff_) (*(T_*)((char*)(base_) + (unsigned)(boff_)))
#define HY_LDX(row_, nb_) (*(const u32x4_a4*)((const char*)((row_) - 2) + (unsigned)((nb_) * 2)))
#define HY_LDR(hb_, nb_) (*(const u32x4_a4*)((const char*)((hb_) - 2) + (unsigned)((FL - 4 - (nb_)) * 2)))
#define HY_SLOT(nb_) (B + (nb_) + ((nb_) >> 6))
#define HY_TW4(nb_, w_) do { const f32x2 tb_ = T[256 + ((nb_) >> 7)]; const LAS f32x4* tp_ = (const LAS f32x4*)(T + 384 + ((nb_) & 127)); const f32x4 ta_ = tp_[0], tc_ = tp_[1]; \
        w_[0] = cmul(tb_, (f32x2){ta_[0], ta_[1]}); w_[1] = cmul(tb_, (f32x2){ta_[2], ta_[3]}); w_[2] = cmul(tb_, (f32x2){tc_[0], tc_[1]}); w_[3] = cmul(tb_, (f32x2){tc_[2], tc_[3]}); } while (0)
#define HY_ST4(nb_, c0_, c1_, c2_, c3_) do { LAS f32x2* bp_ = HY_SLOT(nb_); bp_[0] = (c0_); bp_[1] = (c1_); bp_[2] = (c2_); bp_[3] = (c3_); } while (0)
#define HY_UNPK(w_) ((f32x2){bflo(w_), bfhi(w_)})
#define HY_FILT4(fw_, gw_, nb_, f4_, r4_) const f32x4 f4_ = (f32x4){bflo(fw_.x), bfhi(fw_.x), bflo(fw_.y), bfhi(fw_.y)};   \
        const f32x4 r4_ = (f32x4){(nb_) ? bflo(gw_.w) : 0.f, bfhi(gw_.z), bflo(gw_.z), bfhi(gw_.y)}
    {
        const bf16* p0 = HT + (size_t)c * MT; const float v0 = sw[c], v1 = sw[768 + c], v2 = sw[1536 + c], vb = sb[c];
        { HY_TQ;
#pragma unroll
        for (int h = 0; h < 2; ++h) {
            u32x4 xa[4], xb[4];
#pragma unroll
            for (int j = 0; j < 4; ++j) { const int nb = HY_NB(4 * h + j); xa[j] = HY_LDX(p0, nb); xb[j] = HY_LDX(p0 + SEQ, nb); }
#pragma unroll
            for (int j = 0; j < 4; ++j) { const int nb = HY_NB(4 * h + j); f32x2 z[4]; conv3p(xa[j], xb[j], nb == 0, nb + 4 == SEQ, v0, v1, v2, vb, z);
                HY_G(f32x4, Z, nb * 8) = (f32x4){z[0].x, z[0].y, z[1].x, z[1].y}; HY_G(f32x4, Z + 1, nb * 8) = (f32x4){z[2].x, z[2].y, z[3].x, z[3].y}; }
        } }
    }
#pragma unroll 1
    for (int o = 0; o < 2; ++o) {
        const bf16* hf = FILT + (size_t)((o * 2 + 0) * 256 + c) * SEQ; const bf16* hb = FILT + (size_t)((o * 2 + 1) * 256 + c) * SEQ;
        float ss = 0.f;
#pragma unroll 1
        for (int par = 0; par < 2; ++par) {
            if (par == 0) {
                { HY_TQ;
#pragma unroll
                for (int h = 0; h < 2; ++h) {
                    u32x2 fw[4]; u32x4 gw[4];
#pragma unroll
                    for (int j = 0; j < 4; ++j) { const int nb = HY_NB(4 * h + j); fw[j] = HY_G(const u32x2, hf, nb * 2); gw[j] = HY_LDR(hb, nb); }
#pragma unroll
                    for (int j = 0; j < 4; ++j) { const int nb = HY_NB(4 * h + j); HY_FILT4(fw[j], gw[j], nb, f4, r4);
                        const f32x4 a = f4 + r4; ss += (f4[0] * f4[0] + f4[1] * f4[1]) + (f4[2] * f4[2] + f4[3] * f4[3]) + (r4[0] * r4[0] + r4[1] * r4[1]) + (r4[2] * r4[2] + r4[3] * r4[3]);
                        HY_ST4(nb, ((f32x2){a[0], 0.f}), ((f32x2){a[1], 0.f}), ((f32x2){a[2], 0.f}), ((f32x2){a[3], 0.f})); }
                } }
                __syncthreads();
            }
            fft_fwd3(B, T, tid); fft_pass4_keep(B, tid, ksr);
            { HY_TQ;
#pragma unroll
            for (int h = 0; h < 2; ++h) {
                f32x4 za[4], zb[4];
#pragma unroll
                for (int j = 0; j < 4; ++j) { const int nb = HY_NB(4 * h + j); za[j] = HY_G(const f32x4, Z, nb * 8); zb[j] = HY_G(const f32x4, Z + 1, nb * 8); }
#pragma unroll
                for (int j = 0; j < 4; ++j) { const int nb = HY_NB(4 * h + j);
                    const f32x2 z0 = (f32x2){za[j].x, za[j].y}, z1 = (f32x2){za[j].z, za[j].w}, z2 = (f32x2){zb[j].x, zb[j].y}, z3 = (f32x2){zb[j].z, zb[j].w};
                    if (par == 0) { HY_ST4(nb, z0, z1, z2, z3); }
                    else { f32x2 tw[4]; HY_TW4(nb, tw); HY_ST4(nb, cmul(z0, tw[0]), cmul(z1, tw[1]), cmul(z2, tw[2]), cmul(z3, tw[3])); } }
            } }
            __syncthreads();
            fft_fwd3(B, T, tid); fft_mid4(B, tid, ksr);
            fft_inv3(B, T, tid);
            if (par == 0) {
                { HY_TQ;
#pragma unroll
                for (int h = 0; h < 2; ++h) {
                    u32x2 fw[4]; u32x4 gw[4];
#pragma unroll
                    for (int j = 0; j < 4; ++j) { const int nb = HY_NB(4 * h + j); fw[j] = HY_G(const u32x2, hf, nb * 2); gw[j] = HY_LDR(hb, nb); }
#pragma unroll
                    for (int j = 0; j < 4; ++j) { const int jp = 4 * h + j, nb = HY_NB(jp); const LAS f32x2* bp = HY_SLOT(nb); const f32x2 a0 = bp[0] * (1.0f / 16384.0f), a1 = bp[1] * (1.0f / 16384.0f), a2 = bp[2] * (1.0f / 16384.0f), a3 = bp[3] * (1.0f / 16384.0f);
                        u32x4 w; w.x = cvt_pk_bf16(a0.x, a0.y); w.y = cvt_pk_bf16(a1.x, a1.y); w.z = cvt_pk_bf16(a2.x, a2.y); w.w = cvt_pk_bf16(a3.x, a3.y); HY_G(u32x4, ES + jp * 512, tq * 16) = w;
                        HY_FILT4(fw[j], gw[j], nb, f4, r4);
                        const f32x4 d = f4 - r4; f32x2 tw[4]; HY_TW4(nb, tw); HY_ST4(nb, tw[0] * d[0], tw[1] * d[1], tw[2] * d[2], tw[3] * d[3]); }
                } }
                __syncthreads();
            }
        }
        const float nrm = (1.0f / sqrtf(block_sum(F, ss) + 1e-6f)) * 0.5f;
        const float hbias = P.in[I_HBI][(l * 2 + o) * 256 + c];
        const int ch = (o + 1) * 256 + c;
        const bf16* px = HT + (size_t)ch * MT; const float w0 = sw[ch], w1 = sw[768 + ch], w2 = sw[1536 + ch], bb = sb[ch];
        { HY_TQ;
#pragma unroll
        for (int h = 0; h < 4; ++h) {
            u32x4 ev[2], xa[2], xb[2]; f32x4 za[2], zb[2];
#pragma unroll
            for (int j = 0; j < 2; ++j) { const int jp = 2 * h + j, nb = HY_NB(jp); ev[j] = HY_G(const u32x4, ES + jp * 512, tq * 16); za[j] = HY_G(const f32x4, Z, nb * 8); zb[j] = HY_G(const f32x4, Z + 1, nb * 8); xa[j] = HY_LDX(px, nb); xb[j] = HY_LDX(px + SEQ, nb); }
#pragma unroll
            for (int j = 0; j < 2; ++j) { const int nb = HY_NB(2 * h + j);
                const LAS f32x2* bp = HY_SLOT(nb); f32x2 w[4]; HY_TW4(nb, w);
                const f32x2 e0 = HY_UNPK(ev[j].x) + cmulc(bp[0], w[0]) * (1.0f / 16384.0f), e1 = HY_UNPK(ev[j].y) + cmulc(bp[1], w[1]) * (1.0f / 16384.0f),
                            e2 = HY_UNPK(ev[j].z) + cmulc(bp[2], w[2]) * (1.0f / 16384.0f), e3 = HY_UNPK(ev[j].w) + cmulc(bp[3], w[3]) * (1.0f / 16384.0f);
                f32x2 x[4]; conv3p(xa[j], xb[j], nb == 0, nb + 4 == SEQ, w0, w1, w2, bb, x);
                const f32x2 y0 = (e0 * nrm + (f32x2){za[j].x, za[j].y} * hbias) * x[0], y1 = (e1 * nrm + (f32x2){za[j].z, za[j].w} * hbias) * x[1],
                            y2 = (e2 * nrm + (f32x2){zb[j].x, zb[j].y} * hbias) * x[2], y3 = (e3 * nrm + (f32x2){zb[j].z, zb[j].w} * hbias) * x[3];
                if (o == 0) { HY_G(f32x4, Z, nb * 8) = (f32x4){y0.x, y0.y, y1.x, y1.y}; HY_G(f32x4, Z + 1, nb * 8) = (f32x4){y2.x, y2.y, y3.x, y3.y}; }
                else if (!dummy) {
                    const unsigned u0 = cvt_pk_bf16(y0.x, y0.y), u1 = cvt_pk_bf16(y1.x, y1.y), u2 = cvt_pk_bf16(y2.x, y2.y), u3 = cvt_pk_bf16(y3.x, y3.y);
                    bf16* q0 = BR3 + c; bf16* q1 = q0 + (size_t)SEQ * 256; const int ob = nb * 512;
                    HY_G(bf16, q0, ob) = (bf16)(u0 & 0xffffu); HY_G(bf16, q0 + 256, ob) = (bf16)(u1 & 0xffffu); HY_G(bf16, q0 + 512, ob) = (bf16)(u2 & 0xffffu); HY_G(bf16, q0 + 768, ob) = (bf16)(u3 & 0xffffu);
                    HY_G(bf16, q1, ob) = (bf16)(u0 >> 16); HY_G(bf16, q1 + 256, ob) = (bf16)(u1 >> 16); HY_G(bf16, q1 + 512, ob) = (bf16)(u2 >> 16); HY_G(bf16, q1 + 768, ob) = (bf16)(u3 >> 16); }
            }
        } }
        __syncthreads();
    }
#undef HY_NB
#undef HY_TQ
#undef HY_G
#undef HY_LDX
#undef HY_LDR
#undef HY_FILT4
#undef HY_TW4
#undef HY_ST4
#undef HY_SLOT
#undef HY_UNPK
}
__device__ __forceinline__ void hyena_ctx_unit(Frame& F, const Params& P, int l, int c) {
    LAS float* zc = (LAS float*)F.lds;
    LAS float* kk = (LAS float*)(F.lds + 4096);
    const bf16* HT = (const bf16*)(F.ws + WS_HT); const float* FC = (const float*)(F.ws + WS_FILTC);
    bf16* BR3 = (bf16*)(F.ws + WS_BRV) + 3 * (size_t)MT * 256;
    const float* sw = P.in[I_HSW] + l * 3 * 768; const float* sb = P.in[I_HSB] + l * 768;
    const int b = F.tid >> 8, t = F.tid & 255;
    float zv = conv3_at(HT + (size_t)c * MT + TL + b * CTXL, t, CTXL, sw[c], sw[768 + c], sw[1536 + c], sb[c]);
    for (int o = 0; o < 2; ++o) {
        const float* hf = FC + (size_t)((o * 2 + 0) * 256 + c) * CTXL; const float* hb = FC + (size_t)((o * 2 + 1) * 256 + c) * CTXL;
        float ss = 0.f;
        if (F.tid < 256) { const float f = hf[F.tid]; kk[255 + F.tid] = f; ss = f * f; }
        else { const int d = F.tid - 256; if (d >= 1) { const float f = hb[d]; kk[255 - d] = f; ss = f * f; } }
        zc[F.tid] = zv;
        const float nrm = 1.0f / sqrtf(block_sum(F, ss) + 1e-6f);
        float y = 0.f;
        for (int s_ = 0; s_ < 256; ++s_) y += kk[t - s_ + 255] * zc[b * 256 + s_];
        y = y * nrm + P.in[I_HBI][(l * 2 + o) * 256 + c] * zv;
        const int ch = (o + 1) * 256 + c;
        zv = conv3_at(HT + (size_t)ch * MT + TL + b * CTXL, t, CTXL, sw[ch], sw[768 + ch], sw[1536 + ch], sb[ch]) * y;
        __syncthreads();
    }
    BR3[(size_t)(TL + b * CTXL + t) * 256 + c] = (bf16)(cvt_pk_bf16(zv, 0.f) & 0xffffu);
}
__device__ __forceinline__ void phase_mixer(Frame& F, const Params& P, int l, bool last) {
    {
        LAS float* rpb = (LAS float*)(F.lds + RPB_OFF); for (int i = F.tid; i < 1860; i += NTHR) rpb[i] = P.in[I_RPB][l * 1860 + i] * 1.44269504089f;
        LAS f32x2* T = (LAS f32x2*)(F.lds + TW_OFF);
        if (F.tid < 512) { const int tb = F.tid >> 7, a = F.tid & 127; const float x = tb == 0 ? (float)a / 128.0f : (tb == 1 ? (float)a / 16384.0f : (tb == 2 ? (float)a / 256.0f : (float)a / 32768.0f));
            float s, cs; sincospif(2.0f * x, &s, &cs); T[F.tid] = (f32x2){cs, -s}; }
        __syncthreads();
    }
#ifndef MIXMASK
#define MIXMASK 63
#endif
    if (MIXMASK & 1) for (int c = F.bid; c < 256; c += F.G) hyena_unit(F, P, l, ((c & 7) << 5) | (c >> 3), false);
    if (MIXDUP & 1) for (int c = F.bid; c < 256; c += F.G) hyena_unit(F, P, l, c, true);
    if (MIXMASK & 2) if (!last) for (int rep_ = 0; rep_ <= ((MIXDUP >> 1) & 1); ++rep_) for (int c = F.bid; c < 256; c += F.G) { hyena_ctx_unit(F, P, l, c); __syncthreads(); }
    const int ntile = (last ? TL : MT) / 64;
    if (MIXMASK & 4) for (int rep_ = 0; rep_ <= ((MIXDUP >> 2) & 1); ++rep_) conformer_tiles(F, P, l, (F.bid + F.G / 2) % F.G, ntile);
    if (MIXMASK & 8) for (int rep_ = 0; rep_ <= ((MIXDUP >> 3) & 1); ++rep_) for (int u = (F.bid + F.G / 4) % F.G; u < ntile; u += F.G) shortconv_unit(F, P, l, u * 64);
    const int gw = F.bid * NWAVES + F.wave, NGW = F.G * NWAVES;
    if (MIXMASK & 16) for (int rep_ = 0; rep_ <= ((MIXDUP >> 4) & 1); ++rep_) for (int task = F.bid; task < 256; task += F.G) {
        const int h = task & 3, b = task >> 7, rb = ((task >> 2) & 31) * 8;
        __syncthreads();
        attn_stage_ctx(F, b, h);
        __syncthreads();
#pragma unroll 1
        for (int it = 0; it < 4; ++it) { int wu = (b << 12) | ((rb + 2 * it + (F.wave >> 2)) << 4) | (h << 2) | (F.wave & 3); asm volatile("" : "+s"(wu));
            attn_wave_unit(F, wu, true, true); }
    }
    if (MIXMASK & 32) if (!last) for (int wu = gw; wu < 128; wu += NGW) attn_wave_unit(F, wu, false, false);
}

__global__ void __launch_bounds__(NTHR, 2) mk_fwd(Params P) {
    extern __shared__ __attribute__((aligned(16))) unsigned char lds_raw[];
    Frame F;
    const int wave0 = __builtin_amdgcn_readfirstlane(threadIdx.x >> 6);
    F.lds = (LAS unsigned char*)lds_raw; F.tid = threadIdx.x; F.lane = F.tid & 63; F.wave = __builtin_amdgcn_readfirstlane(F.tid >> 6); F.bid = blockIdx.x; F.G = gridDim.x; F.ws = P.ws;
    volatile LAS unsigned* MISC = (volatile LAS unsigned*)(F.lds + MISC_OFF);
    if (F.tid < 4) MISC[F.tid] = 0u;
    __syncthreads();
    XcdBarrier bar = xcd_barrier_post((unsigned*)(P.ws + WS_CTL) + 4096, MISC);
    const int lo = P.ph_lo, hi = P.ph_hi;
    int ph = 0;
#define PHASE_BEGIN if (ph >= lo && ph < hi) { { int t_; asm volatile("v_mbcnt_lo_u32_b32 %0, -1, 0\n\tv_mbcnt_hi_u32_b32 %0, -1, %0" : "=v"(t_)); t_ |= wave0 << 6; F.tid = t_; F.lane = t_ & 63; F.wave = __builtin_amdgcn_readfirstlane(t_ >> 6); size_t o_ = 0; asm volatile("" : "+s"(o_)); F.ws = P.ws + o_; }
#define PHASE_END   if (ph + 1 < hi) xcd_barrier(bar, F.tid); } ++ph;
#define MOD ((const float*)(F.ws + WS_MOD))
#define Hc ((const char*)(F.ws + WS_H))

    PHASE_BEGIN if (PHMASK & (1u << 0)) for (int rep_ = 0; rep_ <= (int)((DUPMASK >> 0) & 1u); ++rep_) { prologue_a(F, P); } PHASE_END
    PHASE_BEGIN if (PHMASK & (1u << 1)) for (int rep_ = 0; rep_ <= (int)((DUPMASK >> 1) & 1u); ++rep_) { phase_mod0(F, P); phase_filters(F, P, 0, true); } PHASE_END

    for (int l = 0; l < 2; ++l) {
        const bool last = (l == 1);
#define modl (MOD + (size_t)l * 3 * 9216)
#define xl ((l == 0) ? (const void*)P.in[I_X] : (const void*)P.out)
#define xc ((l == 0) ? P.in[I_CTX] : (const float*)(F.ws + WS_XC))
#define xcw ((const float*)(F.ws + WS_XC))
        PHASE_BEGIN if (PHMASK & (1u << 2)) for (int rep_ = 0; rep_ <= (int)((DUPMASK >> 2) & 1u); ++rep_) { { SchedPlain S{Hc, (const char*)(F.ws + WS_W1T) + (size_t)(l * 2 + 0) * NFF * D, 1024u, 1024u, 8, MT / 256, 22, F.G, F.bid};
            EpiFfnUp E{F.ws + WS_U}; pg8::gemm_phase<EpiFfnUp, SchedPlain, 1>(F.lds, S, E, F.tid); } } PHASE_END
        PHASE_BEGIN if (PHMASK & (1u << 3)) for (int rep_ = 0; rep_ <= (int)((DUPMASK >> 3) & 1u); ++rep_) { { SchedResid<5, 1, 6> S{(const char*)(F.ws + WS_U), (const char*)(F.ws + WS_W2T) + (size_t)(l * 2 + 0) * D * DFF, (unsigned)DFF, 22, F.G, F.bid, true, (const char*)(F.ws + WS_U) + (size_t)TL * DFF};
            EpiRes E{(bf16*)P.out, (l == 0) ? (const void*)P.in[I_X] : (const void*)(F.ws + WS_BRV), l != 0, modl + 2 * D, nullptr, 0.5f / W2_SCALE, (float*)(F.ws + WS_ES),
                (l != 0) ? (const float*)(F.ws + WS_LNS) : nullptr, P.in[I_PLG] + ((l + 1) % 2 * 3 + 2) * D, P.in[I_PLB] + ((l + 1) % 2 * 3 + 2) * D}; pg8::gemm_phase<EpiRes, SchedResid<5, 1, 6>, 1>(F.lds, S, E, F.tid); } } PHASE_END
        PHASE_BEGIN if (PHMASK & (1u << 4)) for (int rep_ = 0; rep_ <= (int)((DUPMASK >> 4) & 1u); ++rep_) { phase_ln(F, P, P.in[I_PLG] + (l * 3 + 0) * D, P.in[I_PLB] + (l * 3 + 0) * D, modl, 3, true, false, true, false, 5, 0.5f / W2_SCALE, modl + (size_t)2 * 9216 + 2 * D, nullptr, xc, true, (const bf16*)P.out); if (l == 1) phase_filters(F, P, 1, false); } PHASE_END
        PHASE_BEGIN if (PHMASK & (1u << 5)) for (int rep_ = 0; rep_ <= (int)((DUPMASK >> 5) & 1u); ++rep_) { { SchedInproj S{Hc, (const char*)(F.ws + WS_WIT) + (size_t)l * PIN * D * 2, MT / 256, F.G, F.bid};
            EpiInproj E{(const float*)(F.ws + WS_BIN) + l * PIN, F.ws};
            pg8::gemm_phase(F.lds, S, E, F.tid); } } PHASE_END
        PHASE_BEGIN if (PHMASK & (1u << 6)) for (int rep_ = 0; rep_ <= (int)((DUPMASK >> 6) & 1u); ++rep_) { phase_mixer(F, P, l, last); } PHASE_END
        const int Mx = last ? TL : MT;
        PHASE_BEGIN if (PHMASK & (1u << 7)) for (int rep_ = 0; rep_ <= (int)((DUPMASK >> 7) & 1u); ++rep_) { { SchedGateBr S{Hc, (const char*)(F.ws + WS_H8L), (const char*)(F.ws + WS_H8C), (const char*)(F.ws + WS_WIT) + ((size_t)l * PIN + NINP) * D * 2, (const char*)(F.ws + WS_BRV), (const char*)(F.ws + WS_WPT) + (size_t)l * 4 * D * 256 * 2, F.G, F.bid, !last};
            EpiGateBr E{(const float*)(F.ws + WS_BIN) + l * PIN + NINP, F.ws + WS_GS + (size_t)F.bid * 393216, (bf16*)(F.ws + WS_MG), (bf16*)(F.ws + WS_MI)}; pg8::gemm_phase<EpiGateBr, SchedGateBr, 2>(F.lds, S, E, F.tid); } } PHASE_END
        PHASE_BEGIN if (PHMASK & (1u << 8)) for (int rep_ = 0; rep_ <= (int)((DUPMASK >> 8) & 1u); ++rep_) { { SchedResid<4, 4> S{(const char*)(F.ws + WS_MG), (const char*)(F.ws + WS_WOT) + (size_t)l * D * D * 2, 2048u, 16, F.G, F.bid, !last, (const char*)(F.ws + WS_MI)};
            EpiRes E{(bf16*)(F.ws + WS_BRV), (const void*)P.out, true, modl + 5 * D, P.in[I_BOUT] + l * D, 1.0f, (float*)(F.ws + WS_ES), (const float*)(F.ws + WS_LNS), P.in[I_PLG] + (l * 3 + 0) * D, P.in[I_PLB] + (l * 3 + 0) * D}; pg8::gemm_phase(F.lds, S, E, F.tid); } } PHASE_END
        PHASE_BEGIN if (PHMASK & (1u << 9)) for (int rep_ = 0; rep_ <= (int)((DUPMASK >> 9) & 1u); ++rep_) { phase_ln(F, P, P.in[I_PLG] + (l * 3 + 1) * D, P.in[I_PLB] + (l * 3 + 1) * D, modl, 6, true, true, false, false, last ? 0 : 16, 1.0f, modl + (size_t)2 * 9216 + 5 * D, P.in[I_BOUT] + l * D, xcw, true, (const bf16*)(F.ws + WS_BRV)); } PHASE_END
        PHASE_BEGIN if (PHMASK & (1u << 10)) for (int rep_ = 0; rep_ <= (int)((DUPMASK >> 10) & 1u); ++rep_) { { SchedPlain S{Hc, (const char*)(F.ws + WS_W1T) + (size_t)(l * 2 + 1) * NFF * D, 1024u, 1024u, 8, Mx / 256, 22, F.G, F.bid};
            EpiFfnUp E{F.ws + WS_U}; pg8::gemm_phase<EpiFfnUp, SchedPlain, 1>(F.lds, S, E, F.tid); } } PHASE_END
        PHASE_BEGIN if (PHMASK & (1u << 11)) for (int rep_ = 0; rep_ <= (int)((DUPMASK >> 11) & 1u); ++rep_) { { SchedResid<5, 1, 6> S{(const char*)(F.ws + WS_U), (const char*)(F.ws + WS_W2T) + (size_t)(l * 2 + 1) * D * DFF, (unsigned)DFF, 22, F.G, F.bid, !last, (const char*)(F.ws + WS_U) + (size_t)TL * DFF};
            EpiRes E{(bf16*)(F.ws + WS_BRV), (const void*)(F.ws + WS_BRV), true, modl + 8 * D, nullptr, 0.5f / W2_SCALE, (float*)(F.ws + WS_ES), (const float*)(F.ws + WS_LNS), P.in[I_PLG] + (l * 3 + 1) * D, P.in[I_PLB] + (l * 3 + 1) * D}; pg8::gemm_phase<EpiRes, SchedResid<5, 1, 6>, 1>(F.lds, S, E, F.tid); } } PHASE_END
        PHASE_BEGIN if (PHMASK & (1u << 12)) for (int rep_ = 0; rep_ <= (int)((DUPMASK >> 12) & 1u); ++rep_) { phase_ln(F, P, P.in[I_PLG] + (l * 3 + 2) * D, P.in[I_PLB] + (l * 3 + 2) * D, MOD + (size_t)3 * 9216  , 0, !last, true, false, last, last ? 0 : 5, 0.5f / W2_SCALE, modl + (size_t)2 * 9216 + 8 * D, nullptr, xcw, !last, (const bf16*)(F.ws + WS_BRV)); } PHASE_END
    }
#undef MOD
#undef Hc
#undef modl
#undef xcw
#undef xc
#undef xl
#undef PHASE_BEGIN
#undef PHASE_END
}

#ifndef MK_N_LAUNCHES
#define MK_N_LAUNCHES 1
#endif
constexpr int N_PHASES = 2 + 2 * 11;
extern "C" void kernel_launch(void* const* d_in, const int* in_sizes, int n_in, void* d_out, int out_size, void* d_ws, size_t ws_size, hipStream_t stream) {
    static int grid = 0;
    if (grid == 0) {
        if (n_in != 33 || out_size != TL * D || ws_size < WS_TOTAL) { fprintf(stderr, "kernel_launch: unexpected shapes (n_in %d out %d ws %zu)\n", n_in, out_size, ws_size); grid = -1; return; }
        int dev = 0, cus = 0;
        if (hipGetDevice(&dev) != hipSuccess || hipDeviceGetAttribute(&cus, hipDeviceAttributeMultiprocessorCount, dev) != hipSuccess) { grid = -1; return; }
        if (hipFuncSetAttribute((const void*)mk_fwd, hipFuncAttributeMaxDynamicSharedMemorySize, LDS_BYTES) != hipSuccess) { fprintf(stderr, "kernel_launch: hipFuncSetAttribute failed\n"); grid = -1; return; }
        int per_cu = 0;
        if (hipOccupancyMaxActiveBlocksPerMultiprocessor(&per_cu, (const void*)mk_fwd, NTHR, LDS_BYTES) != hipSuccess || per_cu < 1) fprintf(stderr, "kernel_launch: occupancy query says %d\n", per_cu);
        (void)hipGetLastError();
        grid = cus;
    }
    if (grid < 0) return;
    (void)hipMemsetAsync((char*)d_ws + WS_CTL, 0, CTL_BYTES, stream);
    Params p{};
    for (int i = 0; i < 33; ++i) p.in[i] = (const float*)d_in[i];
    p.out = (float*)d_out; p.ws = (unsigned char*)d_ws;
#if MK_N_LAUNCHES == 1
    p.ph_lo = 0; p.ph_hi = N_PHASES;
    hipLaunchKernelGGL(mk_fwd, dim3(grid), dim3(NTHR), LDS_BYTES, stream, p);
#else
    for (int i = 0; i < N_PHASES; ++i) { p.ph_lo = i; p.ph_hi = i + 1; hipLaunchKernelGGL(mk_fwd, dim3(grid), dim3(NTHR), LDS_BYTES, stream, p); }
#endif
}
```

```cpp
#include <hip/hip_runtime.h>
#include <cstdio>
#include <cstdint>

#ifndef PHMASK
#define PHMASK 0xFFFFu
#endif
#ifndef DUPMASK
#define DUPMASK 0u
#endif
#ifndef FFTPROBE
#define FFTPROBE 0
#endif
#ifndef EPIDUP
#define EPIDUP 0
#endif
#ifndef MIXDUP
#define MIXDUP 0
#endif
#define LAS __attribute__((address_space(3)))
typedef unsigned short bf16;
typedef short bf16x8 __attribute__((ext_vector_type(8)));
typedef float f32x4 __attribute__((ext_vector_type(4)));
typedef float f32x2 __attribute__((ext_vector_type(2)));
typedef unsigned u32x4 __attribute__((ext_vector_type(4)));
typedef unsigned u32x2 __attribute__((ext_vector_type(2)));

constexpr int D = 1024, SEQ = 16384, TL = 32768, CTXL = 256, TC = 512, MT = TL + TC;
constexpr int DFF = 2816, NFF = 2 * DFF, PIN = 6912, NINP = 2816, NMOD = 9;
constexpr int WA = 256;
constexpr float LN_EPS = 1e-5f, ALPHA = 1.41421356237f, ATT_SCALE = 0.125f;
constexpr int NWAVES = 8, NTHR = 512;

constexpr size_t MiB = 1u << 20;
constexpr size_t WS_CTL = 0, CTL_BYTES = 1 * MiB;
constexpr size_t WS_MOD = 1 * MiB;
constexpr size_t WS_BIN = WS_MOD + 256 * 1024;
constexpr size_t WS_W3T = WS_BIN + 64 * 1024;
constexpr size_t WS_XC = 2 * MiB;
constexpr size_t WS_W1T = 4 * MiB;
constexpr size_t WS_W2T = WS_W1T + (size_t)4 * NFF * D * 2;
constexpr size_t WS_WIT = WS_W2T + (size_t)4 * D * DFF * 2;
constexpr size_t WS_WPT = WS_WIT + (size_t)2 * PIN * D * 2;
constexpr size_t WS_WOT = WS_WPT + (size_t)8 * D * 256 * 2;
constexpr size_t WS_H = WS_WOT + (size_t)2 * D * D * 2;
constexpr size_t WS_BRV = WS_H + (size_t)MT * D * 2;
constexpr size_t WS_FILT = WS_BRV + (size_t)MT * D * 2;
constexpr size_t WS_FILTC = WS_FILT + (size_t)4 * 256 * SEQ * 4;
constexpr size_t WS_H8L = WS_FILT + 32 * MiB;
constexpr size_t WS_LNS = WS_CTL + 64 * 1024;
constexpr size_t WS_H8C = WS_CTL + 512 * 1024;
constexpr size_t WS_U = WS_FILTC + (size_t)4 * 256 * 256 * 4;
constexpr size_t SZ256 = (size_t)MT * 256 * 2;
constexpr size_t WS_UA = WS_U, WS_Q = WS_U + SZ256, WS_K = WS_U + 2 * SZ256, WS_SB = WS_U + 3 * SZ256, WS_W = WS_U + 4 * SZ256;
constexpr size_t WS_VT = WS_U + 5 * SZ256;
constexpr size_t WS_HT = WS_U + 6 * SZ256;
constexpr size_t WS_KSCR = WS_U + 9 * SZ256;
constexpr size_t WS_MG = WS_U;
constexpr size_t WS_GS = WS_U + 4 * SZ256;
constexpr size_t WS_MI = WS_GS + (size_t)256 * 393216;
constexpr size_t WS_END = WS_U + (size_t)MT * DFF * 2;
static_assert(WS_KSCR + (size_t)256 * 131072 <= WS_END, "kscr");
static_assert(WS_MI + (size_t)4 * TC * D * 2 <= WS_END, "gs/mi");
constexpr size_t WS_ES = WS_END;
constexpr size_t WS_TOTAL = WS_ES + (size_t)256 * 131072;
static_assert(WS_TOTAL <= 512 * MiB, "ws");
static_assert(WS_BIN + 2 * PIN * 4 <= WS_W3T && WS_W3T + 2 * 1024 * 64 * 2 <= WS_XC && WS_MOD + 2 * 3 * 9216 * 4 <= WS_BIN, "small");

constexpr int RING_BYTES = 131072;
constexpr int FFT_BYTES = 133120;
constexpr int TW_OFF = FFT_BYTES;
constexpr int RPB_OFF = TW_OFF + 4096;
constexpr int RED_OFF = RPB_OFF + 7680;
constexpr int MISC_OFF = RED_OFF + 256;
constexpr int LDS_BYTES = 147456;
static_assert(MISC_OFF + 64 <= LDS_BYTES, "lds");

typedef __bf16 bf16x2_t __attribute__((ext_vector_type(2)));
__device__ __forceinline__ unsigned cvt_pk_bf16(float lo, float hi) { const f32x2 v = {lo, hi}; const bf16x2_t b = __builtin_convertvector(v, bf16x2_t); return __builtin_bit_cast(unsigned, b); }
typedef int v8i __attribute__((ext_vector_type(8)));
typedef int i32x4 __attribute__((ext_vector_type(4)));
__device__ __forceinline__ float sat8(float x) { return __builtin_amdgcn_fmed3f(x, -448.0f, 448.0f); }
__device__ __forceinline__ unsigned pk_fp8x4(float a, float b, float c, float d) { int p = 0; p = __builtin_amdgcn_cvt_pk_fp8_f32(sat8(a), sat8(b), p, false); p = __builtin_amdgcn_cvt_pk_fp8_f32(sat8(c), sat8(d), p, true); return (unsigned)p; }
constexpr float W1_SCALE = 32.0f, W2_SCALE = 64.0f;
__device__ __forceinline__ float bf2f(unsigned short b) { return __uint_as_float(((unsigned)b) << 16); }
__device__ __forceinline__ float bflo(unsigned w) { return __uint_as_float(w << 16); }
__device__ __forceinline__ float bfhi(unsigned w) { return __uint_as_float(w & 0xffff0000u); }
__device__ __forceinline__ float sigmoidf_(float x) { return __builtin_amdgcn_rcpf(1.0f + __builtin_amdgcn_exp2f(x * -1.44269504089f)); }
__device__ __forceinline__ float siluf_(float x) { return x * __builtin_amdgcn_rcpf(1.0f + __builtin_amdgcn_exp2f(x * -1.44269504089f)); }
__device__ __forceinline__ int lane_now() { int l_; asm volatile("v_mbcnt_lo_u32_b32 %0, -1, 0\n\tv_mbcnt_hi_u32_b32 %0, -1, %0" : "=v"(l_)); return l_; }
__device__ __forceinline__ float xrow_max(float v) {
    const unsigned a = __builtin_bit_cast(unsigned, v); auto r = __builtin_amdgcn_permlane16_swap(a, a, false, false);
    v = fmaxf(__builtin_bit_cast(float, (unsigned)r[0]), __builtin_bit_cast(float, (unsigned)r[1]));
    const unsigned b = __builtin_bit_cast(unsigned, v); auto q = __builtin_amdgcn_permlane32_swap(b, b, false, false);
    return fmaxf(__builtin_bit_cast(float, (unsigned)q[0]), __builtin_bit_cast(float, (unsigned)q[1]));
}
__device__ __forceinline__ float xrow_sum(float v) {
    const unsigned a = __builtin_bit_cast(unsigned, v); auto r = __builtin_amdgcn_permlane16_swap(a, a, false, false);
    v = __builtin_bit_cast(float, (unsigned)r[0]) + __builtin_bit_cast(float, (unsigned)r[1]);
    const unsigned b = __builtin_bit_cast(unsigned, v); auto q = __builtin_amdgcn_permlane32_swap(b, b, false, false);
    return __builtin_bit_cast(float, (unsigned)q[0]) + __builtin_bit_cast(float, (unsigned)q[1]);
}
__device__ __forceinline__ float shx(float v, int o, int lane) { return __builtin_bit_cast(float, __builtin_amdgcn_ds_bpermute((lane ^ o) << 2, __builtin_bit_cast(int, v))); }
#define DPP_F(v_, ctrl_) __builtin_bit_cast(float, __builtin_amdgcn_update_dpp(0, __builtin_bit_cast(int, (v_)), (ctrl_), 0xF, 0xF, true))
__device__ __forceinline__ float wave_sum(float v) {
    v += DPP_F(v, 0xB1);
    v += DPP_F(v, 0x4E);
    v += DPP_F(v, 0x141);
    v += DPP_F(v, 0x140);
    const int iv = __builtin_bit_cast(int, v);
    const float r0 = __builtin_bit_cast(float, __builtin_amdgcn_readlane(iv, 0)), r1 = __builtin_bit_cast(float, __builtin_amdgcn_readlane(iv, 16)),
                r2 = __builtin_bit_cast(float, __builtin_amdgcn_readlane(iv, 32)), r3 = __builtin_bit_cast(float, __builtin_amdgcn_readlane(iv, 48));
    return (r0 + r1) + (r2 + r3);
}
#define LDS_WAIT() asm volatile("s_waitcnt lgkmcnt(0)" ::: "memory")

#define XB_TMO      128
#define XB_XCNT(j)  (256  + 64 * (j))
#define XB_XSUB(j)  (1280 + 64 * (j))
#define XB_XGEN(j)  (2304 + 64 * (j))
#define XB_TOP      3328
#define XB_TOPGEN   3392
#define XCD_BAR_WORDS 3456
#define XB_SPIN_CAP (1u << 20)
__device__ __forceinline__ unsigned xb_ld(unsigned* p)              { return __hip_atomic_load(p, __ATOMIC_RELAXED, __HIP_MEMORY_SCOPE_AGENT); }
__device__ __forceinline__ unsigned xb_add(unsigned* p, unsigned v) { return __hip_atomic_fetch_add(p, v, __ATOMIC_RELAXED, __HIP_MEMORY_SCOPE_AGENT); }
__device__ __forceinline__ unsigned xb_xcc_id() { return (unsigned)__builtin_amdgcn_s_getreg((3 << 11) | 20) & 0xFu; }
#define XB_SPIN(cond, bar) do { unsigned _sp = 0; while (cond) { __builtin_amdgcn_s_sleep(1); \
    if ((++_sp & 255u) == 0u) { if (xb_ld(&(bar)[XB_TMO])) break; if (_sp > XB_SPIN_CAP) { atomicAdd(&(bar)[XB_TMO], 1u); break; } } } } while (0)
struct XcdBarrier { unsigned* bar; unsigned x; volatile LAS unsigned* st; };
__device__ __forceinline__ XcdBarrier xcd_barrier_post(unsigned* bar, volatile LAS unsigned* st) {
    XcdBarrier b; b.bar = bar; b.x = xb_xcc_id(); b.st = st;
    if (threadIdx.x == 0) (void)xb_add(&bar[XB_XCNT(b.x)], 1u);
    return b;
}
__device__ __forceinline__ void xcd_barrier_complete(unsigned* bar, unsigned x, unsigned& nloc, unsigned& nx) {
    const unsigned G = gridDim.x * gridDim.y * gridDim.z;
    unsigned sum, cnt, mine, sp = 0u;
    for (;;) {
        sum = 0u; cnt = 0u; mine = 0u;
#pragma unroll
        for (unsigned j = 0; j < 16; ++j) { const unsigned c = xb_ld(&bar[XB_XCNT(j)]); sum += c; cnt += (c > 0u) ? 1u : 0u; mine = (j == x) ? c : mine; }
        if (sum == G) break;
        __builtin_amdgcn_s_sleep(1);
        if ((++sp & 255u) == 0u) { if (xb_ld(&bar[XB_TMO])) break; if (sp > XB_SPIN_CAP) { atomicAdd(&bar[XB_TMO], 1u); break; } }
    }
    nloc = mine > 0u ? mine : 1u; nx = cnt > 0u ? cnt : 1u;
}
__device__ __forceinline__ void xcd_barrier(const XcdBarrier& b, int tid) {
    asm volatile("s_waitcnt vmcnt(0)" ::: "memory");
    __syncthreads();
    if (tid == 0) {
        unsigned* bar = b.bar;
        __builtin_amdgcn_s_waitcnt(0);
        unsigned nloc = b.st[0], nx = b.st[1];
        if (nloc == 0u) { xcd_barrier_complete(bar, b.x, nloc, nx); b.st[0] = nloc; b.st[1] = nx; }
        const unsigned old = xb_add(&bar[XB_XSUB(b.x)], 1u);
        const unsigned gen = old / nloc;
        if (old + 1u == (gen + 1u) * nloc) {
            __builtin_amdgcn_fence(__ATOMIC_RELEASE, "agent");
            asm volatile("s_waitcnt vmcnt(0)" ::: "memory");
            const unsigned og = xb_add(&bar[XB_TOP], 1u);
            const unsigned tg = og / nx;
            if (og + 1u == (tg + 1u) * nx) xb_add(&bar[XB_TOPGEN], 1u);
            else XB_SPIN(xb_ld(&bar[XB_TOPGEN]) == tg, bar);
            __builtin_amdgcn_fence(__ATOMIC_ACQUIRE, "agent");
            xb_add(&bar[XB_XGEN(b.x)], 1u);
            asm volatile("s_waitcnt vmcnt(0)" ::: "memory");
        } else {
            XB_SPIN(xb_ld(&bar[XB_XGEN(b.x)]) == gen, bar);
            __builtin_amdgcn_fence(__ATOMIC_ACQUIRE, "agent");
            asm volatile("s_waitcnt vmcnt(0)" ::: "memory");
        }
    }
    __syncthreads();
}

namespace pg8 {
constexpr int BM = 256, BK = 64, HALF = 128, HTB = HALF * BK * 2, NXCD = 8, WGM = 8;
__host__ __device__ __forceinline__ int lds_byte(int r, int c) { const int st = (r >> 4) * 2 + (c >> 5), rr = r & 15, cc = c & 31, ob = rr * 64 + cc * 2; return st * 1024 + (ob ^ (((ob >> 9) & 1) << 5)); }
__host__ __device__ __forceinline__ void stage_rc(int b, int& R, int& C) { const int st = b / 1024, sb = b % 1024, swz = sb ^ (((sb >> 9) & 1) << 5); R = (st >> 1) * 16 + swz / 64; C = (st & 1) * 32 + (swz % 64) / 2; }
__host__ __device__ __forceinline__ int perm32(int rho) { const int n = rho >> 4, i = rho & 15; return 8 * (i >> 2) + 4 * n + (i & 3); }

struct GUnit { const char* A; const char* B; unsigned lda, ldb; int nt; int pm, pn, kind; bool f8; };

__device__ __forceinline__ bool static_tile(int i, int G, int c, int nM, int nN, int& pm, int& pn) {
    const int nwg = nM * nN; const long L = (long)i * G + c; if (L >= nwg) return false;
    int wgid = (int)L; { const int q = nwg / NXCD, r = nwg % NXCD, xcd = wgid % NXCD, off = wgid / NXCD; wgid = (xcd < r ? xcd * (q + 1) : r * (q + 1) + (xcd - r) * q) + off; }
    const int nig = WGM * nN, gid = wgid / nig, fm = gid * WGM, gsz = (nM - fm) < WGM ? (nM - fm) : WGM;
    pm = fm + ((wgid % nig) % gsz); pn = (wgid % nig) / gsz; return true;
}

template <class Epi, class Sched, int F8M = 0  >
__device__ __forceinline__ void gemm_phase(LAS unsigned char* lds, const Sched& S, const Epi& E, int tid_in) {
    int tid_ = tid_in; asm volatile("" : "+v"(tid_));
    const int tid = tid_, wid = __builtin_amdgcn_readfirstlane(tid >> 6), lane = tid & 63, wr = wid >> 2, wc = wid & 3, fr = lane & 15, fq = lane >> 4;
    unsigned RA[2], RB[2], CC[2];
#pragma unroll
    for (int i = 0; i < 2; ++i) { int R, C; stage_rc(tid * 16 + i * 8192, R, C); RA[i] = (unsigned)R; RB[i] = (unsigned)((R & ~31) + perm32(R & 31)); CC[i] = (unsigned)C * 2u; }
    const size_t kstep = (size_t)(BK * 2);
    const unsigned ldsw = (unsigned)wid * 1024u;
#define PG8_SA(b, h) (((b) * 2 + (h)) * HTB)
#define PG8_SB(b, h) ((4 + (b) * 2 + (h)) * HTB)
#define PG8_STAGE(bufoff, gbase, RR, ld) do { _Pragma("unroll") for (int _i = 0; _i < 2; ++_i) \
        __builtin_amdgcn_global_load_lds((const unsigned*)((const char*)(gbase) + ((RR)[_i] * (ld) + CC[_i])), (LAS unsigned*)(lds + (bufoff) + ldsw + _i * 8192), 16, 0, 0); } while (0)
#define PG8_LDA(F8C, dst, b, h) do { _Pragma("unroll") for (int m = 0; m < 4; ++m) { dst[m][0] = *(const LAS i32x4*)(lds + PG8_SA(b, h) + ao0 + m * 2048); dst[m][1] = *(const LAS i32x4*)(lds + PG8_SA(b, h) + ao1 + m * 2048); } } while (0)
#define PG8_LDB(F8C, dst, b, h) do { _Pragma("unroll") for (int n = 0; n < 2; ++n) { dst[n][0] = *(const LAS i32x4*)(lds + PG8_SB(b, h) + bo0 + n * 2048); dst[n][1] = *(const LAS i32x4*)(lds + PG8_SB(b, h) + bo1 + n * 2048); } } while (0)
#define PG8_V8(x) __builtin_shufflevector((x)[0], (x)[1], 0, 1, 2, 3, 4, 5, 6, 7)
#define PG8_MMA(F8C, ai, bj, At, Bt) do { __builtin_amdgcn_s_setprio(1); if constexpr (F8C) { _Pragma("unroll") for (int m = 0; m < 4; ++m) _Pragma("unroll") for (int n = 0; n < 2; ++n) \
            { const v8i b8_ = PG8_V8(Bt[n]), a8_ = PG8_V8(At[m]); asm volatile("v_mfma_scale_f32_16x16x128_f8f6f4 %0, %1, %2, %0, %3, %3 op_sel_hi:[0,0,0]" : "+v"(acc[ai][bj][m][n]) : "v"(b8_), "v"(a8_), "v"(one_scale)); } } \
        else { _Pragma("unroll") for (int m = 0; m < 4; ++m) _Pragma("unroll") for (int n = 0; n < 2; ++n) _Pragma("unroll") for (int k = 0; k < 2; ++k) \
            acc[ai][bj][m][n] = __builtin_amdgcn_mfma_f32_16x16x32_bf16(__builtin_bit_cast(bf16x8, Bt[n][k]), __builtin_bit_cast(bf16x8, At[m][k]), acc[ai][bj][m][n], 0, 0, 0); } __builtin_amdgcn_s_setprio(0); } while (0)
#define PG8_TRIP(F8C, WN) { \
            const bool last = (t == nt - 2); \
            const char* a1 = cA + (size_t)(t + 1) * kstep; \
            const char* a2 = last ? nA : cA + (size_t)(t + 2) * kstep; const char* b2 = last ? nB : cB + (size_t)(t + 2) * kstep; \
            const char* a3 = a2 + kstep; const char* b3 = b2 + kstep; \
            const unsigned xldA = last ? nldA : ldA, xldB = last ? nldB : ldB; const size_t xhsA = last ? nhsA : hsA, xhsB = last ? nhsB : hsB; \
            PG8_LDB(F8C, B0, 0, 0); PG8_LDB(F8C, B1, 0, 1); PG8_SCHED; PG8_LDA(F8C, At, 0, 0); PG8_STAGE(PG8_SA(1, 1), a1 + hsA, RA, ldA); \
            PG8_WAIT_V(WN); PG8_WAIT_L(0); PG8_BAR; PG8_MMA(F8C, 0, 0, At, B0); PG8_MMA(F8C, 0, 1, At, B1); PG8_BAR; PG8_SCHED; \
            PG8_LDA(F8C, At, 0, 1); PG8_STAGE(PG8_SB(0, 0), b2, RB, xldB); PG8_STAGE(PG8_SB(0, 1), b2 + xhsB, RB, xldB); PG8_STAGE(PG8_SA(0, 0), a2, RA, xldA); \
            PG8_WAIT_V(WN); PG8_WAIT_L(0); PG8_BAR; PG8_MMA(F8C, 1, 0, At, B0); PG8_MMA(F8C, 1, 1, At, B1); PG8_BAR; PG8_SCHED; \
            PG8_LDB(F8C, B0, 1, 0); PG8_LDB(F8C, B1, 1, 1); PG8_SCHED; PG8_LDA(F8C, At, 1, 0); PG8_STAGE(PG8_SA(0, 1), a2 + xhsA, RA, xldA); \
            PG8_WAIT_V(8); PG8_WAIT_L(0); PG8_BAR; PG8_MMA(F8C, 0, 0, At, B0); PG8_MMA(F8C, 0, 1, At, B1); PG8_BAR; PG8_SCHED; \
            PG8_LDA(F8C, At, 1, 1); PG8_STAGE(PG8_SB(1, 0), b3, RB, xldB); PG8_STAGE(PG8_SB(1, 1), b3 + xhsB, RB, xldB); PG8_STAGE(PG8_SA(1, 0), a3, RA, xldA); \
            PG8_WAIT_V(8); PG8_WAIT_L(0); PG8_BAR; PG8_MMA(F8C, 1, 0, At, B0); PG8_MMA(F8C, 1, 1, At, B1); PG8_BAR; PG8_SCHED; \
        }
#define PG8_KLOOP(F8C) const int ln_ = lane_now();   \
        const int fr_ = ln_ & 15, fq_ = ln_ >> 4; \
        const int ao0 = lds_byte(wr * 64 + fr_, (F8C) ? 16 * fq_ : 8 * fq_), ao1 = (F8C) ? lds_byte(wr * 64 + fr_, 16 * fq_ + 8) : ao0 + 1024; \
        const int bo0 = lds_byte(wc * 32 + fr_, (F8C) ? 16 * fq_ : 8 * fq_), bo1 = (F8C) ? lds_byte(wc * 32 + fr_, 16 * fq_ + 8) : bo0 + 1024; \
        int t = 0; \
        if constexpr (Epi::NST == 8) { if (ui > 0) { PG8_TRIP(F8C, 16) t = 2; } } \
        for (; t < nt; t += 2) PG8_TRIP(F8C, 8)
#define PG8_WAIT_V(n) asm volatile("s_waitcnt vmcnt(" #n ")" ::: "memory")
#define PG8_WAIT_L(n) asm volatile("s_waitcnt lgkmcnt(" #n ")" ::: "memory")
#define PG8_BAR __builtin_amdgcn_s_barrier()
#define PG8_SCHED __builtin_amdgcn_sched_barrier(0)
    GUnit cur, nxt; int ui = 0;
    if (!S.next(0, cur)) return;
    f32x4 acc[2][2][4][2];
#pragma unroll
    for (int a = 0; a < 2; ++a)
#pragma unroll
        for (int b = 0; b < 2; ++b)
#pragma unroll
            for (int m = 0; m < 4; ++m)
#pragma unroll
                for (int n = 0; n < 2; ++n) acc[a][b][m][n] = (f32x4){0.f, 0.f, 0.f, 0.f};
    i32x4 At[4][2], B0[2][2], B1[2][2];
    int one_scale = 0x7F7F7F7F; asm volatile("" : "+v"(one_scale));
    const char* cA = cur.A; const char* cB = cur.B;
    unsigned ldA = cur.lda, ldB = cur.ldb; size_t hsA = (size_t)HALF * ldA, hsB = (size_t)HALF * ldB;
    PG8_STAGE(PG8_SB(0, 0), cB, RB, ldB); PG8_STAGE(PG8_SB(0, 1), cB + hsB, RB, ldB); PG8_STAGE(PG8_SA(0, 0), cA, RA, ldA); PG8_STAGE(PG8_SA(0, 1), cA + hsA, RA, ldA);
    if (wr == 1) PG8_BAR;
    PG8_WAIT_V(2); PG8_BAR;
    PG8_STAGE(PG8_SB(1, 0), cB + kstep, RB, ldB); PG8_STAGE(PG8_SA(1, 0), cA + kstep, RA, ldA); PG8_STAGE(PG8_SB(1, 1), cB + hsB + kstep, RB, ldB);
    PG8_WAIT_V(6); PG8_BAR;
    for (;;) {
        const bool has_next = S.next(ui + 1, nxt);
        const char* nA = has_next ? nxt.A : cA; const char* nB = has_next ? nxt.B : cB;
        const unsigned nldA = has_next ? nxt.lda : ldA, nldB = has_next ? nxt.ldb : ldB;
        const size_t nhsA = (size_t)HALF * nldA, nhsB = (size_t)HALF * nldB;
        const int nt = cur.nt;
        if constexpr (F8M == 2) { if (cur.f8) { PG8_KLOOP(true) } else { PG8_KLOOP(false) } }
        else if constexpr (F8M == 1) { PG8_KLOOP(true) }
        else { PG8_KLOOP(false) }
        if (wr == 0) PG8_BAR;
        if constexpr (F8M != 0) asm volatile("s_nop 15\n\ts_nop 15" ::: "memory");
        { const int le_ = lane_now(); E(acc, cur, (wid << 6) | le_, wr, wc, le_ & 15, le_ >> 4); }
        if (!has_next) break;
#pragma unroll
        for (int a = 0; a < 2; ++a)
#pragma unroll
            for (int b = 0; b < 2; ++b)
#pragma unroll
                for (int m = 0; m < 4; ++m)
#pragma unroll
                    for (int n = 0; n < 2; ++n) acc[a][b][m][n] = (f32x4){0.f, 0.f, 0.f, 0.f};
        cur = nxt; cA = nA; cB = nB; hsA = nhsA; hsB = nhsB; ldA = nldA; ldB = nldB; ++ui;
        if (wr == 1) PG8_BAR;
    }
    PG8_WAIT_V(0);
    PG8_BAR;
#undef PG8_SA
#undef PG8_SB
#undef PG8_STAGE
#undef PG8_LDA
#undef PG8_KLOOP
#undef PG8_TRIP
#undef PG8_V8
#undef PG8_LDB
#undef PG8_MMA
#undef PG8_WAIT_V
#undef PG8_WAIT_L
#undef PG8_BAR
#undef PG8_SCHED
}
}
using pg8::GUnit;
typedef f32x4 Acc[2][2][4][2];

struct Params {
    const float* in[33];
    float* out;
    unsigned char* ws;
    int ph_lo, ph_hi;
};
enum { I_X = 0, I_C, I_CTX, I_CCTX, I_WMOD, I_BMOD, I_PLG, I_PLB, I_FWI, I_FWO, I_WIN, I_BIN, I_CDW, I_CDB, I_CLG, I_CLB, I_CWP, I_RPB, I_NWP, I_SCW, I_SWP,
       I_HSW, I_HSB, I_HW1, I_HB1, I_HW2, I_HB2, I_HFQ, I_HW3, I_HBI, I_HWP, I_WOUT, I_BOUT };

__device__ __forceinline__ int row_grp(int pm) { return pm < 64 ? 0 : (pm < 128 ? 1 : 2); }

struct SchedPlain {
    const char* A; const char* B; unsigned lda, ldb; int nt, nM, nN, G, c;
    __device__ __forceinline__ bool next(int i, GUnit& u) const {
        int pm, pn; if (!pg8::static_tile(i, G, c, nM, nN, pm, pn)) return false;
        u.A = A + (size_t)pm * 256 * lda; u.B = B + (size_t)pn * 256 * ldb; u.lda = lda; u.ldb = ldb; u.nt = nt; u.pm = pm; u.pn = pn; u.kind = 0; u.f8 = true; return true;
    }
};
template <int NKS, int NSRC, int NTLAST = 4> struct SchedResid {
    const char* A; const char* B; unsigned ld; int nt, G, c; bool ctx; const char* Ac;
    __device__ __forceinline__ bool next(int i, GUnit& u) const {
        int pm, pn; u.lda = ld; u.ldb = ld; u.f8 = true;
        if (pg8::static_tile(i, G, c, TL / 256, 4, pm, pn)) { u.A = A + (size_t)pm * 256 * ld; u.B = B + (size_t)pn * 256 * ld; u.nt = nt; u.pm = pm; u.pn = pn; u.kind = 0; return true; }
        constexpr int NK = NKS * NSRC;
        const int j = i * G + c - (TL / 256) * 4; if (!ctx || j < 0 || j >= 8 * NK) return false;
        const int panel = j / (4 * NK), rem = j % (4 * NK), kk = rem % NK, src = kk / NKS, ks = kk % NKS; pn = rem / NK;
        u.A = Ac + ((size_t)src * TC + panel * 256) * ld + ks * 512; u.B = B + (size_t)pn * 256 * ld + ks * 512; u.nt = (ks == NKS - 1) ? NTLAST : 4; u.pm = TL / 256 + panel; u.pn = pn; u.kind = 1 + kk; return true;
    }
};
enum { KI_GLU = 0, KI_PLAIN = 1, KI_PAIR = 2, KI_TRANS = 3 };
struct SchedInproj {
    const char* H; const char* W; int nM, G, c;
    __device__ __forceinline__ bool next(int i, GUnit& u) const {
        int pm, pn; if (!pg8::static_tile(i, G, c, nM, 11, pm, pn)) return false;
        const char* a = H + (size_t)pm * 256 * 2048; const char* b = W + (size_t)pn * 256 * 2048;
        const bool tr = (pn == 4) || (pn >= 8);
        u.A = tr ? b : a; u.B = tr ? a : b; u.lda = 2048; u.ldb = 2048; u.nt = 16; u.pm = pm; u.pn = pn;
        u.f8 = false; u.kind = tr ? KI_TRANS : (pn < 2 ? KI_GLU : (pn == 6 || pn == 7 ? KI_PAIR : KI_PLAIN)); return true;
    }
};
struct SchedGateBr {
    const char* HB  ; const char* H; const char* HC  ; const char* WG  ; const char* BR; const char* WP; int G, c; bool ctx;
    __device__ __forceinline__ bool next(int i, GUnit& u) const {
        int pm, pn, j, br;
        if (pg8::static_tile(i >> 3, G, c, TL / 256, 4, pm, pn)) { j = i & 7; br = j >> 1; }
        else {
            const int ntl = ((TL / 256) * 4 - c + G - 1) / G, e = i - 8 * ntl;
            if (!ctx || c >= 32 || e < 0 || e > 1) return false;
            pm = TL / 256 + (c >> 4); pn = (c >> 2) & 3; br = c & 3; j = 8 + 2 * br + e;
        }
        if ((j & 1) == 0) { u.A = (pm < TL / 256) ? H + (size_t)pm * 256 * 1024 : HC + (size_t)(pm - TL / 256) * 256 * 1024; u.B = WG + (size_t)(br * 1024 + pn * 256) * 1024; u.lda = 1024; u.ldb = 1024; u.nt = 8; u.f8 = true; }
        else { u.A = BR + (size_t)br * SZ256 + (size_t)pm * 256 * 512; u.B = WP + (size_t)(br * 1024 + pn * 256) * 512; u.lda = 512; u.ldb = 512; u.nt = 4; u.f8 = false; }
        u.pm = pm; u.pn = pn; u.kind = j; return true;
    }
};

struct EpiFfnUp {
    static constexpr bool DUP_OK = true; static constexpr int NST = 8;
    unsigned char* U;
    __device__ __forceinline__ void operator()(const Acc& acc, const GUnit& u, int tid, int wr, int wc, int fr, int fq) const {
        const int row0 = u.pm * 256 + wr * 64 + fr, col0 = u.pn * 128 + wc * 32 + 8 * fq;
        constexpr float IS = 1.0f / W1_SCALE;
#pragma unroll
        for (int ai = 0; ai < 2; ++ai)
#pragma unroll
            for (int m = 0; m < 4; ++m) {
                const f32x4 a0 = acc[ai][0][m][0] * IS, a1 = acc[ai][0][m][1] * IS, g0 = acc[ai][1][m][0] * IS, g1 = acc[ai][1][m][1] * IS;
                u32x2 w; w.x = pk_fp8x4(siluf_(g0[0]) * a0[0], siluf_(g0[1]) * a0[1], siluf_(g0[2]) * a0[2], siluf_(g0[3]) * a0[3]);
                w.y = pk_fp8x4(siluf_(g1[0]) * a1[0], siluf_(g1[1]) * a1[1], siluf_(g1[2]) * a1[2], siluf_(g1[3]) * a1[3]);
                *(u32x2*)(U + (size_t)(row0 + ai * 128 + m * 16) * DFF + col0) = w;
            }
    }
};
struct EpiRes {
    static constexpr bool DUP_OK = false; static constexpr int NST = 0;
    bf16* V; const void* xl; bool xbf  ; const float* modl  ; const float* bias; float coef; float* part;
    const float* xstat; const float* xg; const float* xbt;
    __device__ __forceinline__ void operator()(const Acc& acc, const GUnit& u, int tid, int wr, int wc, int fr, int fq) const {
        int row0 = u.pm * 256 + wr * 64 + fr, colt = u.pn * 256 + wc * 32 + 8 * fq; asm volatile("" : "+v"(row0), "+v"(colt));
        if (u.kind != 0) {
            float* pp = part + ((size_t)(u.kind - 1) * TC + (row0 - TL)) * D + colt;
#pragma unroll
            for (int ai = 0; ai < 2; ++ai)
#pragma unroll
                for (int m = 0; m < 4; ++m)
#pragma unroll
                    for (int bj = 0; bj < 2; ++bj) { float* q = pp + (size_t)(ai * 128 + m * 16) * D + bj * 128; *(f32x4*)q = acc[ai][bj][m][0]; *(f32x4*)(q + 4) = acc[ai][bj][m][1]; }
            return;
        }
        if (xstat) body_ln(acc, u, row0, colt); else if (xbf) body<true>(acc, u, row0, colt); else body<false>(acc, u, row0, colt);
    }
    template <bool XB> __device__ __forceinline__ void body(const Acc& acc, const GUnit& u, int row0, int colt) const {
        const float* mv = modl + (size_t)row_grp(u.pm) * 9216;
        f32x4 sc[2][2], bv[2][2];
#pragma unroll
        for (int bj = 0; bj < 2; ++bj)
#pragma unroll
            for (int n = 0; n < 2; ++n) { sc[bj][n] = *(const f32x4*)(mv + colt + bj * 128 + 4 * n) * coef;
                bv[bj][n] = bias ? *(const f32x4*)(bias + colt + bj * 128 + 4 * n) : (f32x4){0.f, 0.f, 0.f, 0.f}; }
#pragma unroll
        for (int ai = 0; ai < 2; ++ai) {
            bf16* vp = V + (size_t)(row0 + ai * 128) * D + colt;
            if constexpr (XB) {
                const bf16* xh = (const bf16*)xl + (size_t)(row0 + ai * 128) * D + colt;
                u32x4 xw[4][2];
#pragma unroll
                for (int m = 0; m < 4; ++m)
#pragma unroll
                    for (int bj = 0; bj < 2; ++bj) xw[m][bj] = *(const u32x4*)(xh + (size_t)(m * 16) * D + bj * 128);
#pragma unroll
                for (int m = 0; m < 4; ++m)
#pragma unroll
                    for (int bj = 0; bj < 2; ++bj) { const u32x4 w_ = xw[m][bj];
                        const f32x4 x0 = (f32x4){bflo(w_.x), bfhi(w_.x), bflo(w_.y), bfhi(w_.y)}, x1 = (f32x4){bflo(w_.z), bfhi(w_.z), bflo(w_.w), bfhi(w_.w)};
                        const f32x4 v0 = x0 * ALPHA + sc[bj][0] * (acc[ai][bj][m][0] + bv[bj][0]), v1 = x1 * ALPHA + sc[bj][1] * (acc[ai][bj][m][1] + bv[bj][1]);
                        u32x4 w; w.x = cvt_pk_bf16(v0[0], v0[1]); w.y = cvt_pk_bf16(v0[2], v0[3]); w.z = cvt_pk_bf16(v1[0], v1[1]); w.w = cvt_pk_bf16(v1[2], v1[3]);
                        *(u32x4*)(vp + (size_t)(m * 16) * D + bj * 128) = w; }
            } else {
                const float* xb = (const float*)xl + (size_t)(row0 + ai * 128) * D + colt;
#pragma unroll
                for (int mh = 0; mh < 2; ++mh) {
                    f32x4 xf[2][2][2];
#pragma unroll
                    for (int mm = 0; mm < 2; ++mm)
#pragma unroll
                        for (int bj = 0; bj < 2; ++bj) { const float* q = xb + (size_t)((mh * 2 + mm) * 16) * D + bj * 128; xf[mm][bj][0] = *(const f32x4*)q; xf[mm][bj][1] = *(const f32x4*)(q + 4); }
#pragma unroll
                    for (int mm = 0; mm < 2; ++mm)
#pragma unroll
                        for (int bj = 0; bj < 2; ++bj) { const int m = mh * 2 + mm;
                            const f32x4 v0 = xf[mm][bj][0] * ALPHA + sc[bj][0] * (acc[ai][bj][m][0] + bv[bj][0]), v1 = xf[mm][bj][1] * ALPHA + sc[bj][1] * (acc[ai][bj][m][1] + bv[bj][1]);
                            u32x4 w; w.x = cvt_pk_bf16(v0[0], v0[1]); w.y = cvt_pk_bf16(v0[2], v0[3]); w.z = cvt_pk_bf16(v1[0], v1[1]); w.w = cvt_pk_bf16(v1[2], v1[3]);
                            *(u32x4*)(vp + (size_t)(m * 16) * D + bj * 128) = w; }
                    asm volatile("" ::: "memory");
                }
            }
            asm volatile("" ::: "memory");
        }
    }
    __device__ __forceinline__ void body_ln(const Acc& acc, const GUnit& u, int row0, int colt) const {
        const float* mv = modl + (size_t)row_grp(u.pm) * 9216;
#pragma unroll
        for (int bj = 0; bj < 2; ++bj) {
            f32x4 sc[2], gg[2], bb[2], bv[2];
#pragma unroll
            for (int n = 0; n < 2; ++n) { sc[n] = *(const f32x4*)(mv + colt + bj * 128 + 4 * n) * coef; gg[n] = *(const f32x4*)(xg + colt + bj * 128 + 4 * n); bb[n] = *(const f32x4*)(xbt + colt + bj * 128 + 4 * n);
                bv[n] = bias ? *(const f32x4*)(bias + colt + bj * 128 + 4 * n) : (f32x4){0.f, 0.f, 0.f, 0.f}; }
#pragma unroll
            for (int ai = 0; ai < 2; ++ai) {
                bf16* vp = V + (size_t)(row0 + ai * 128) * D + colt + bj * 128; const bf16* xp = (const bf16*)xl + (size_t)(row0 + ai * 128) * D + colt + bj * 128;
                u32x4 xw[4]; f32x2 st[4];
#pragma unroll
                for (int m = 0; m < 4; ++m) { st[m] = *(const f32x2*)(xstat + (size_t)(row0 + ai * 128 + m * 16) * 2); xw[m] = *(const u32x4*)(xp + (size_t)(m * 16) * D); }
#pragma unroll
                for (int m = 0; m < 4; ++m) { const u32x4 w_ = xw[m]; const float mu = st[m].x, rs = st[m].y;
                    const f32x4 x0 = ((f32x4){bflo(w_.x), bfhi(w_.x), bflo(w_.y), bfhi(w_.y)} - mu) * (gg[0] * rs) + bb[0], x1 = ((f32x4){bflo(w_.z), bfhi(w_.z), bflo(w_.w), bfhi(w_.w)} - mu) * (gg[1] * rs) + bb[1];
                    const f32x4 v0 = x0 * ALPHA + sc[0] * (acc[ai][bj][m][0] + bv[0]), v1 = x1 * ALPHA + sc[1] * (acc[ai][bj][m][1] + bv[1]);
                    u32x4 w; w.x = cvt_pk_bf16(v0[0], v0[1]); w.y = cvt_pk_bf16(v0[2], v0[3]); w.z = cvt_pk_bf16(v1[0], v1[1]); w.w = cvt_pk_bf16(v1[2], v1[3]);
                    *(u32x4*)(vp + (size_t)(m * 16) * D) = w; }
                asm volatile("" ::: "memory");
            }
        }
    }
};
struct EpiInproj {
    static constexpr bool DUP_OK = false; static constexpr int NST = 0;
    const float* bin;
    unsigned char* ws;
    __device__ __forceinline__ void operator()(const Acc& acc, const GUnit& u, int tid, int wr, int wc, int fr, int fq) const {
        bf16* const UA = (bf16*)(ws + WS_UA); bf16* const Q = (bf16*)(ws + WS_Q); bf16* const K = (bf16*)(ws + WS_K); bf16* const SB = (bf16*)(ws + WS_SB);
        bf16* const W = (bf16*)(ws + WS_W); bf16* const VT = (bf16*)(ws + WS_VT); bf16* const HT = (bf16*)(ws + WS_HT);
        int c8 = wc * 32 + 8 * fq; asm volatile("" : "+v"(c8));
        if (u.kind == KI_TRANS) {
            bf16* dst = (u.pn == 4) ? VT : HT + (size_t)(u.pn - 8) * 256 * MT;
            const int r0 = wr * 64 + fr;
#pragma unroll
            for (int ai = 0; ai < 2; ++ai)
#pragma unroll
                for (int m = 0; m < 4; ++m) {
                    const int r = r0 + ai * 128 + m * 16; const float b = bin[u.pn * 256 + r];
#pragma unroll
                    for (int bj = 0; bj < 2; ++bj) {
                        const f32x4 v0 = acc[ai][bj][m][0] + b, v1 = acc[ai][bj][m][1] + b;
                        u32x4 w; w.x = cvt_pk_bf16(v0[0], v0[1]); w.y = cvt_pk_bf16(v0[2], v0[3]); w.z = cvt_pk_bf16(v1[0], v1[1]); w.w = cvt_pk_bf16(v1[2], v1[3]);
                        *(u32x4*)(dst + (size_t)r * MT + u.pm * 256 + bj * 128 + c8) = w;
                    }
                }
            return;
        }
        const int row0 = u.pm * 256 + wr * 64 + fr;
        f32x4 bv[2][2];
#pragma unroll
        for (int bj = 0; bj < 2; ++bj)
#pragma unroll
            for (int n = 0; n < 2; ++n) bv[bj][n] = *(const f32x4*)(bin + u.pn * 256 + bj * 128 + c8 + 4 * n);
        if (u.kind == KI_PLAIN) {
            bf16* dst = (u.pn == 2) ? Q : (u.pn == 3 ? K : SB); const float scl = (u.pn == 2) ? ATT_SCALE * 1.44269504089f : 1.0f;
#pragma unroll
            for (int ai = 0; ai < 2; ++ai)
#pragma unroll
                for (int m = 0; m < 4; ++m)
#pragma unroll
                    for (int bj = 0; bj < 2; ++bj) {
                        const f32x4 v0 = (acc[ai][bj][m][0] + bv[bj][0]) * scl, v1 = (acc[ai][bj][m][1] + bv[bj][1]) * scl;
                        u32x4 w; w.x = cvt_pk_bf16(v0[0], v0[1]); w.y = cvt_pk_bf16(v0[2], v0[3]); w.z = cvt_pk_bf16(v1[0], v1[1]); w.w = cvt_pk_bf16(v1[2], v1[3]);
                        *(u32x4*)(dst + (size_t)(row0 + ai * 128 + m * 16) * 256 + bj * 128 + c8) = w;
                    }
            return;
        }
        const bool glu = (u.kind == KI_GLU);
        bf16* dst = glu ? UA + u.pn * 128 : W + (u.pn - 6) * 128;
#pragma unroll
        for (int ai = 0; ai < 2; ++ai)
#pragma unroll
            for (int m = 0; m < 4; ++m) {
                f32x4 a0 = acc[ai][0][m][0] + bv[0][0], a1 = acc[ai][0][m][1] + bv[0][1], g0 = acc[ai][1][m][0] + bv[1][0], g1 = acc[ai][1][m][1] + bv[1][1];
                if (glu) {
#pragma unroll
                    for (int j = 0; j < 4; ++j) { g0[j] = sigmoidf_(g0[j]); g1[j] = sigmoidf_(g1[j]); }
                }
                const f32x4 v0 = a0 * g0, v1 = a1 * g1;
                u32x4 w; w.x = cvt_pk_bf16(v0[0], v0[1]); w.y = cvt_pk_bf16(v0[2], v0[3]); w.z = cvt_pk_bf16(v1[0], v1[1]); w.w = cvt_pk_bf16(v1[2], v1[3]);
                *(u32x4*)(dst + (size_t)(row0 + ai * 128 + m * 16) * 256 + c8) = w;
            }
    }
};
__device__ __forceinline__ unsigned pk_u8x4(f32x4 v) { const unsigned a = (unsigned)(v[0] * 255.0f + 0.5f), b = (unsigned)(v[1] * 255.0f + 0.5f), c = (unsigned)(v[2] * 255.0f + 0.5f), d = (unsigned)(v[3] * 255.0f + 0.5f); return a | (b << 8) | (c << 16) | (d << 24); }
struct EpiGateBr {
    static constexpr bool DUP_OK = false; static constexpr int NST = 0;
    const float* bing;
    unsigned char* gs;
    bf16* MG; bf16* MI;
    __device__ __forceinline__ void operator()(const Acc& acc, const GUnit& u, int tid, int wr, int wc, int fr, int fq) const {
        const int br = (u.kind >> 1) & 3; const bool cjob = (u.kind & 8) != 0;
        unsigned so = (unsigned)tid * 16u; asm volatile("" : "+v"(so));
        const unsigned mo = so * 2u;
        if ((u.kind & 1) == 0) {
            const float* bb = bing + br * 1024 + u.pn * 256 + wc * 32 + 8 * fq;
            f32x4 bv[2][2];
#pragma unroll
            for (int bj = 0; bj < 2; ++bj)
#pragma unroll
                for (int n = 0; n < 2; ++n) bv[bj][n] = *(const f32x4*)(bb + bj * 128 + 4 * n);
            unsigned char* sp = gs;
#pragma unroll
            for (int ai = 0; ai < 2; ++ai)
#pragma unroll
                for (int m = 0; m < 4; ++m)
#pragma unroll
                    for (int bj = 0; bj < 2; ++bj) {
                        const float gs_ = u.f8 ? (1.0f / W1_SCALE) : 1.0f; f32x4 v0 = acc[ai][bj][m][0] * gs_ + bv[bj][0], v1 = acc[ai][bj][m][1] * gs_ + bv[bj][1];
#pragma unroll
                        for (int j = 0; j < 4; ++j) { v0[j] = sigmoidf_(v0[j]); v1[j] = sigmoidf_(v1[j]); }
                        u32x2 w; w.x = pk_u8x4(v0); w.y = pk_u8x4(v1);
                        *(u32x2*)(sp + (so >> 1)) = w; sp += 4096;
                    }
        } else {
            unsigned lo = (unsigned)(((wr * 64 + fr) * D + u.pn * 256 + wc * 32 + 8 * fq) * 2); asm volatile("" : "+v"(lo));
            unsigned char* op = cjob ? (unsigned char*)(MI + ((size_t)br * TC + (u.pm - TL / 256) * 256) * D) : (unsigned char*)(MG + (size_t)u.pm * 256 * D);
            const bool ldm = (br > 0 && !cjob), stm = (br < 3 && !cjob);
            if (ldm) { if (stm) branch<true, true>(acc, so, mo, lo, op); else branch<true, false>(acc, so, mo, lo, op); }
            else { if (stm) branch<false, true>(acc, so, mo, lo, op); else branch<false, false>(acc, so, mo, lo, op); }
        }
    }
    template <bool LDM, bool STM> __device__ __forceinline__ void branch(const Acc& acc, unsigned so, unsigned mo, unsigned lo, unsigned char* op) const {
        const unsigned char* sp = gs; unsigned char* mp = gs + 131072;
        u32x2 s[2][2]; u32x4 mw[2][2];
#define GB_U(ptr_) ({ auto q_ = (ptr_); asm volatile("" : "+s"(q_)); q_; })
#define GB_LOAD(t_) do { _Pragma("unroll") for (int k = 0; k < 2; ++k) { s[(t_) & 1][k] = *(const u32x2*)(GB_U(sp + ((t_) * 2 + k) * 4096) + (so >> 1)); \
            if (LDM) mw[(t_) & 1][k] = *(const u32x4*)(GB_U(mp + ((t_) * 2 + k) * 8192) + so); else mw[(t_) & 1][k] = (u32x4){0u, 0u, 0u, 0u}; } } while (0)
        GB_LOAD(0);
#pragma unroll
        for (int t = 0; t < 8; ++t) { const int ai = t >> 2, m = t & 3, p = t & 1;
            if (t < 7) GB_LOAD(t + 1);
#pragma unroll
            for (int k = 0; k < 2; ++k) { const int bj = k;
                const f32x4 y0 = acc[ai][bj][m][0], y1 = acc[ai][bj][m][1]; const u32x2 sk = s[p][k]; const u32x4 mk = mw[p][k]; f32x4 a0 = (f32x4){bflo(mk.x), bfhi(mk.x), bflo(mk.y), bfhi(mk.y)}, a1 = (f32x4){bflo(mk.z), bfhi(mk.z), bflo(mk.w), bfhi(mk.w)};
                a0[0] += (float)((sk.x >> 0) & 0xffu) * y0[0]; a0[1] += (float)((sk.x >> 8) & 0xffu) * y0[1]; a0[2] += (float)((sk.x >> 16) & 0xffu) * y0[2]; a0[3] += (float)((sk.x >> 24) & 0xffu) * y0[3];
                a1[0] += (float)((sk.y >> 0) & 0xffu) * y1[0]; a1[1] += (float)((sk.y >> 8) & 0xffu) * y1[1]; a1[2] += (float)((sk.y >> 16) & 0xffu) * y1[2]; a1[3] += (float)((sk.y >> 24) & 0xffu) * y1[3];
                if (!STM) { a0 = a0 * (1.0f / 255.0f); a1 = a1 * (1.0f / 255.0f); }
                u32x4 w; w.x = cvt_pk_bf16(a0[0], a0[1]); w.y = cvt_pk_bf16(a0[2], a0[3]); w.z = cvt_pk_bf16(a1[0], a1[1]); w.w = cvt_pk_bf16(a1[2], a1[3]);
                if (STM) *(u32x4*)(GB_U(mp + (t * 2 + k) * 8192) + so) = w;
                else *(u32x4*)(op + (size_t)(ai * 128 + m * 16) * D * 2 + lo + bj * 256) = w; }
            asm volatile("" ::: "memory");
        }
#undef GB_LOAD
#undef GB_U
    }
};

struct Frame {
    LAS unsigned char* lds;
    int tid, lane, wave, bid, G;
    unsigned char* ws;
};

__device__ __forceinline__ void transpose_item(const float* W, int K, int N, int src_col0, bf16* WT, int dst_row0, LAS float* scr, int kb, int lane) {
    const int k0 = 64 * kb;
    float tv[32];
#pragma unroll
    for (int i = 0; i < 32; ++i) { const int kk = 2 * i + (lane >> 5); tv[i] = W[(size_t)(k0 + kk) * N + src_col0 + (lane & 31)]; }
#pragma unroll
    for (int i = 0; i < 32; ++i) { const int kk = 2 * i + (lane >> 5); scr[kk * 33 + (lane & 31)] = tv[i]; }
    LDS_WAIT(); asm volatile("" ::: "memory");
    const int c = lane & 7;
#pragma unroll
    for (int j = 0; j < 4; ++j) { const int n = (lane >> 3) + 8 * j; const LAS float* s = scr + (8 * c) * 33 + n;
        u32x4 o; o.x = cvt_pk_bf16(s[0 * 33], s[1 * 33]); o.y = cvt_pk_bf16(s[2 * 33], s[3 * 33]); o.z = cvt_pk_bf16(s[4 * 33], s[5 * 33]); o.w = cvt_pk_bf16(s[6 * 33], s[7 * 33]);
        *(u32x4*)(WT + (size_t)(dst_row0 + n) * K + k0 + 8 * c) = o; }
    LDS_WAIT(); asm volatile("" ::: "memory");
}
__device__ __forceinline__ void transpose_item8(const float* W, int K, int N, int src_col0, unsigned char* WT, int dst_row0, LAS float* scr, int kb, int lane, float wscale) {
    const int k0 = 64 * kb;
    float tv[32];
#pragma unroll
    for (int i = 0; i < 32; ++i) { const int kk = 2 * i + (lane >> 5); tv[i] = W[(size_t)(k0 + kk) * N + src_col0 + (lane & 31)]; }
#pragma unroll
    for (int i = 0; i < 32; ++i) { const int kk = 2 * i + (lane >> 5); scr[kk * 33 + (lane & 31)] = tv[i]; }
    LDS_WAIT(); asm volatile("" ::: "memory");
    const int n = lane >> 1, hf = lane & 1; const LAS float* s = scr + (32 * hf) * 33 + n;
    u32x4 o0, o1;
    o0.x = pk_fp8x4(s[0 * 33] * wscale, s[1 * 33] * wscale, s[2 * 33] * wscale, s[3 * 33] * wscale); o0.y = pk_fp8x4(s[4 * 33] * wscale, s[5 * 33] * wscale, s[6 * 33] * wscale, s[7 * 33] * wscale);
    o0.z = pk_fp8x4(s[8 * 33] * wscale, s[9 * 33] * wscale, s[10 * 33] * wscale, s[11 * 33] * wscale); o0.w = pk_fp8x4(s[12 * 33] * wscale, s[13 * 33] * wscale, s[14 * 33] * wscale, s[15 * 33] * wscale);
    o1.x = pk_fp8x4(s[16 * 33] * wscale, s[17 * 33] * wscale, s[18 * 33] * wscale, s[19 * 33] * wscale); o1.y = pk_fp8x4(s[20 * 33] * wscale, s[21 * 33] * wscale, s[22 * 33] * wscale, s[23 * 33] * wscale);
    o1.z = pk_fp8x4(s[24 * 33] * wscale, s[25 * 33] * wscale, s[26 * 33] * wscale, s[27 * 33] * wscale); o1.w = pk_fp8x4(s[28 * 33] * wscale, s[29 * 33] * wscale, s[30 * 33] * wscale, s[31 * 33] * wscale);
    u32x4* dst = (u32x4*)(WT + (size_t)(dst_row0 + n) * K + k0 + 32 * hf); dst[0] = o0; dst[1] = o1;
    LDS_WAIT(); asm volatile("" ::: "memory");
}
__host__ __device__ __forceinline__ int inmap(int r) {
    if (r >= NINP) return r;
    const int t = r >> 8, cc = r & 255;
    if (t < 2) return cc < 128 ? 128 * t + cc : 256 + 128 * t + cc - 128;
    if (t < 6) return 256 * t + cc;
    if (t < 8) { const int p = t - 6; return cc < 128 ? 1536 + 128 * p + cc : 1792 + 128 * p + cc - 128; }
    return 2048 + 256 * (t - 8) + cc;
}
__device__ __forceinline__ void prologue_a(Frame& F, const Params& P) {
    LAS float* scr = (LAS float*)(F.lds + F.wave * 16384);
    const int gw = F.bid * NWAVES + F.wave, NGW = F.G * NWAVES;
    constexpr int I1 = 16 * 176, I2 = 44 * 32, I3 = 16 * 216, I4 = 4 * 32, I5 = 16 * 32;
    constexpr int I6 = 32;
    constexpr int NIT = 4 * I1 + 4 * I2 + 2 * I3 + 8 * I4 + 2 * I5 + 2 * I6;
    struct TI { const float* W; unsigned char* dst; int N, K, sc, drow, kb; bool f8; float scale; };
    auto decode = [&](int it, TI& t) {
        int r = it;
        if (r < 4 * I1) { const int mi = r / I1; r %= I1; const int kb = r / 176, nb = r % 176, d0 = nb * 32, pn = d0 >> 8, cc = d0 & 255;
            t = TI{P.in[I_FWI] + (size_t)mi * D * NFF, F.ws + WS_W1T + (size_t)mi * NFF * D, NFF, D, cc < 128 ? 128 * pn + cc : DFF + 128 * pn + cc - 128, d0, kb, true, W1_SCALE}; return; }
        r -= 4 * I1;
        if (r < 4 * I2) { const int mi = r / I2; r %= I2; const int kb = r / 32, nb = r % 32;
            t = TI{P.in[I_FWO] + (size_t)mi * DFF * D, F.ws + WS_W2T + (size_t)mi * D * DFF, D, DFF, nb * 32, nb * 32, kb, true, W2_SCALE}; return; }
        r -= 4 * I2;
        if (r < 2 * I3) { const int mi = r / I3; r %= I3; const int kb = r / 216, nb = r % 216; const float* W = P.in[I_WIN] + (size_t)mi * D * PIN;
            if (nb * 32 >= NINP) t = TI{W, F.ws + WS_WIT + ((size_t)mi * PIN + NINP) * D * 2, PIN, D, inmap(nb * 32), nb * 32 - NINP, kb, true, W1_SCALE};
            else t = TI{W, F.ws + WS_WIT + (size_t)mi * PIN * D * 2, PIN, D, inmap(nb * 32), nb * 32, kb, false, 1.f};
            return; }
        r -= 2 * I3;
        if (r < 8 * I4) { const int mi = r / I4; r %= I4; const int l = mi >> 2, br = mi & 3, kb = r / 32, nb = r % 32;
            t = TI{P.in[br == 0 ? I_CWP : (br == 1 ? I_NWP : (br == 2 ? I_SWP : I_HWP))] + (size_t)l * 256 * D, F.ws + WS_WPT + (size_t)mi * D * 256 * 2, D, 256, nb * 32, nb * 32, kb, false, 1.f}; return; }
        r -= 8 * I4;
        if (r < 2 * I5) { const int mi = r / I5; r %= I5; const int kb = r / 32, nb = r % 32;
            t = TI{P.in[I_WOUT] + (size_t)mi * D * D, F.ws + WS_WOT + (size_t)mi * D * D * 2, D, D, nb * 32, nb * 32, kb, false, 1.f}; return; }
        r -= 2 * I5;
        { const int mi = r / I6, nb = r % I6; t = TI{P.in[I_HW3] + (size_t)mi * 64 * 1024, F.ws + WS_W3T + (size_t)mi * 1024 * 64 * 2, 1024, 64, nb * 32, nb * 32, 0, false, 1.f}; }
    };
    {
        const int lane = F.lane;
        TI cur; float tv[32];
        int it = gw;
        if (it < NIT) { decode(it, cur);
#pragma unroll
            for (int i = 0; i < 32; ++i) tv[i] = cur.W[(size_t)(64 * cur.kb + 2 * i + (lane >> 5)) * cur.N + cur.sc + (lane & 31)]; }
        for (; it < NIT; it += NGW) {
#pragma unroll
            for (int i = 0; i < 32; ++i) scr[(2 * i + (lane >> 5)) * 33 + (lane & 31)] = tv[i];
            TI nx; const bool more = it + NGW < NIT;
            if (more) { decode(it + NGW, nx);
#pragma unroll
                for (int i = 0; i < 32; ++i) tv[i] = nx.W[(size_t)(64 * nx.kb + 2 * i + (lane >> 5)) * nx.N + nx.sc + (lane & 31)]; }
            LDS_WAIT(); asm volatile("" ::: "memory");
            const int k0 = 64 * cur.kb;
            if (cur.f8) { const int n = lane >> 1, hf = lane & 1; const LAS float* s = scr + (32 * hf) * 33 + n; const float ws_ = cur.scale;
                u32x4 o0, o1;
                o0.x = pk_fp8x4(s[0 * 33] * ws_, s[1 * 33] * ws_, s[2 * 33] * ws_, s[3 * 33] * ws_); o0.y = pk_fp8x4(s[4 * 33] * ws_, s[5 * 33] * ws_, s[6 * 33] * ws_, s[7 * 33] * ws_);
                o0.z = pk_fp8x4(s[8 * 33] * ws_, s[9 * 33] * ws_, s[10 * 33] * ws_, s[11 * 33] * ws_); o0.w = pk_fp8x4(s[12 * 33] * ws_, s[13 * 33] * ws_, s[14 * 33] * ws_, s[15 * 33] * ws_);
                o1.x = pk_fp8x4(s[16 * 33] * ws_, s[17 * 33] * ws_, s[18 * 33] * ws_, s[19 * 33] * ws_); o1.y = pk_fp8x4(s[20 * 33] * ws_, s[21 * 33] * ws_, s[22 * 33] * ws_, s[23 * 33] * ws_);
                o1.z = pk_fp8x4(s[24 * 33] * ws_, s[25 * 33] * ws_, s[26 * 33] * ws_, s[27 * 33] * ws_); o1.w = pk_fp8x4(s[28 * 33] * ws_, s[29 * 33] * ws_, s[30 * 33] * ws_, s[31 * 33] * ws_);
                u32x4* dst = (u32x4*)(cur.dst + (size_t)(cur.drow + n) * cur.K + k0 + 32 * hf); dst[0] = o0; dst[1] = o1; }
            else { const int c = lane & 7;
#pragma unroll
                for (int j = 0; j < 4; ++j) { const int n = (lane >> 3) + 8 * j; const LAS float* s = scr + (8 * c) * 33 + n;
                    u32x4 o; o.x = cvt_pk_bf16(s[0 * 33], s[1 * 33]); o.y = cvt_pk_bf16(s[2 * 33], s[3 * 33]); o.z = cvt_pk_bf16(s[4 * 33], s[5 * 33]); o.w = cvt_pk_bf16(s[6 * 33], s[7 * 33]);
                    *(u32x4*)(cur.dst + ((size_t)(cur.drow + n) * cur.K + k0 + 8 * c) * 2) = o; } }
            LDS_WAIT(); asm volatile("" ::: "memory");
            cur = nx;
        }
    }
    { float* bin = (float*)(F.ws + WS_BIN); for (int i = F.bid * NTHR + F.tid; i < 2 * PIN; i += F.G * NTHR) { const int l = i / PIN, r = i % PIN; bin[i] = P.in[I_BIN][l * PIN + inmap(r)]; } }
    __syncthreads();
    LAS float* sv = (LAS float*)F.lds;
    LAS float* red = (LAS float*)(F.lds + 16384);
    for (int i = F.tid; i < 3 * D; i += NTHR) { const int g = i / D, k = i % D; const float c = g < 2 ? P.in[I_C][g * D + k] : P.in[I_CCTX][k]; sv[i] = siluf_(c); }
    __syncthreads();
    for (int un = F.bid; un < 2 * 144; un += F.G) {
        const int l = un / 144, n0 = (un % 144) * 64;
        const float* wm = P.in[I_WMOD] + (size_t)l * D * 9216 + n0 + F.lane;
        float a0 = 0.f, a1 = 0.f, a2 = 0.f;
#pragma unroll 1
        for (int k0 = 0; k0 < 128; k0 += 32) { float wv[32];
#pragma unroll
            for (int kk = 0; kk < 32; ++kk) wv[kk] = wm[(size_t)(F.wave * 128 + k0 + kk) * 9216];
#pragma unroll
            for (int kk = 0; kk < 32; ++kk) { const int k = F.wave * 128 + k0 + kk; a0 += sv[k] * wv[kk]; a1 += sv[D + k] * wv[kk]; a2 += sv[2 * D + k] * wv[kk]; } }
        red[(F.wave * 3 + 0) * 64 + F.lane] = a0; red[(F.wave * 3 + 1) * 64 + F.lane] = a1; red[(F.wave * 3 + 2) * 64 + F.lane] = a2;
        __syncthreads();
        if (F.tid < 192) { const int g = F.tid >> 6, ln = F.tid & 63; float s = P.in[I_BMOD][l * 9216 + n0 + ln];
#pragma unroll
            for (int w = 0; w < 8; ++w) s += red[(w * 3 + g) * 64 + ln];
            ((float*)(F.ws + WS_MOD))[(size_t)(l * 3 + g) * 9216 + n0 + ln] = s; }
        __syncthreads();
    }
}

__device__ __forceinline__ void ln_stats(const f32x4 (&v)[4], float& mean, float& rstd) {
    float s = 0.f;
#pragma unroll
    for (int j = 0; j < 4; ++j) s += (v[j][0] + v[j][1]) + (v[j][2] + v[j][3]);
    mean = wave_sum(s) * (1.0f / D);
    float q = 0.f;
#pragma unroll
    for (int j = 0; j < 4; ++j) { const f32x4 d = v[j] - mean; q += (d[0] * d[0] + d[1] * d[1]) + (d[2] * d[2] + d[3] * d[3]); }
    rstd = 1.0f / sqrtf(wave_sum(q) * (1.0f / D) + LN_EPS);
}
__device__ __forceinline__ void modulate_store(const f32x4 (&x)[4], const float* shift, const float* scale, bf16* hrow, int lane) {
    float mean, rstd; ln_stats(x, mean, rstd);
#pragma unroll
    for (int j = 0; j < 4; ++j) { const int c = 4 * lane + 256 * j; const f32x4 sc = *(const f32x4*)(scale + c), sh = *(const f32x4*)(shift + c);
        const f32x4 h = (x[j] - mean) * rstd * (sc + 1.0f) + sh;
        u32x2 w; w.x = cvt_pk_bf16(h[0], h[1]); w.y = cvt_pk_bf16(h[2], h[3]); *(u32x2*)(hrow + c) = w; }
}
__device__ __forceinline__ void modulate_store8(const f32x4 (&x)[4], const float* shift, const float* scale, unsigned char* hrow, int lane) {
    float mean, rstd; ln_stats(x, mean, rstd);
#pragma unroll
    for (int j = 0; j < 4; ++j) { const int c = 4 * lane + 256 * j; const f32x4 sc = *(const f32x4*)(scale + c), sh = *(const f32x4*)(shift + c);
        const f32x4 h = (x[j] - mean) * rstd * (sc + 1.0f) + sh;
        *(unsigned*)(hrow + c) = pk_fp8x4(h[0], h[1], h[2], h[3]); }
}
constexpr int LNR = 4;
__device__ __forceinline__ void ln_stats_r(const f32x4 (&v)[LNR][4], float (&mean)[LNR], float (&rstd)[LNR]) {
    float s[LNR];
#pragma unroll
    for (int r = 0; r < LNR; ++r) { s[r] = 0.f;
#pragma unroll
        for (int j = 0; j < 4; ++j) s[r] += (v[r][j][0] + v[r][j][1]) + (v[r][j][2] + v[r][j][3]); }
#pragma unroll
    for (int r = 0; r < LNR; ++r) s[r] = wave_sum(s[r]);
    float q[LNR];
#pragma unroll
    for (int r = 0; r < LNR; ++r) { mean[r] = s[r] * (1.0f / D); q[r] = 0.f;
#pragma unroll
        for (int j = 0; j < 4; ++j) { const f32x4 d = v[r][j] - mean[r]; q[r] += (d[0] * d[0] + d[1] * d[1]) + (d[2] * d[2] + d[3] * d[3]); } }
#pragma unroll
    for (int r = 0; r < LNR; ++r) q[r] = wave_sum(q[r]);
#pragma unroll
    for (int r = 0; r < LNR; ++r) rstd[r] = 1.0f / sqrtf(q[r] * (1.0f / D) + LN_EPS);
}
__device__ __forceinline__ void phase_mod0(Frame& F, const Params& P) {
    const int skip = (F.G > 8) ? 4 : 0;
    if (F.bid < skip) return;
    const int gw = (F.bid - skip) * NWAVES + F.wave, NGW = (F.G - skip) * NWAVES;
    const float* MOD = (const float*)(F.ws + WS_MOD); bf16* H = (bf16*)(F.ws + WS_H);
    for (int row0 = gw; row0 < MT; row0 += LNR * NGW) {
        f32x4 x[LNR][4]; int rows[LNR];
#pragma unroll
        for (int r = 0; r < LNR; ++r) { rows[r] = min(row0 + r * NGW, MT - 1); const int row = rows[r];
            const float* xr = row < TL ? P.in[I_X] + (size_t)row * D : P.in[I_CTX] + (size_t)(row - TL) * D;
#pragma unroll
            for (int j = 0; j < 4; ++j) x[r][j] = *(const f32x4*)(xr + 4 * F.lane + 256 * j); }
        float mean[LNR], rstd[LNR]; ln_stats_r(x, mean, rstd);
#pragma unroll
        for (int r = 0; r < LNR; ++r) if (row0 + r * NGW < MT) { const int row = rows[r], g = row < SEQ ? 0 : (row < TL ? 1 : 2);
            const float* shift = MOD + (size_t)g * 9216, *scale = shift + D;
#pragma unroll
            for (int j = 0; j < 4; ++j) { const int c = 4 * F.lane + 256 * j; const f32x4 sc = *(const f32x4*)(scale + c), sh = *(const f32x4*)(shift + c);
                const f32x4 h = (x[r][j] - mean[r]) * rstd[r] * (sc + 1.0f) + sh;
                *(unsigned*)((unsigned char*)H + (size_t)row * D + c) = pk_fp8x4(h[0], h[1], h[2], h[3]); } }
    }
}
__device__ __forceinline__ void phase_ln(Frame& F, const Params& P, const float* lg, const float* lb, const float* modl  , int ishift, bool hmod, bool h8  , bool dual  , bool final_out, int cx_nks, float cx_coef, const float* cx_modv  , const float* cx_bias, const float* cx_xsrc, bool skipx  , const bf16* vsrc  ) {
    const int gw = F.bid * NWAVES + F.wave, NGW = F.G * NWAVES;
    const bf16* V = vsrc; bf16* H = (bf16*)(F.ws + WS_H);
    f32x4 g4[4], b4[4];
#pragma unroll
    for (int j = 0; j < 4; ++j) { g4[j] = *(const f32x4*)(lg + 4 * F.lane + 256 * j); b4[j] = *(const f32x4*)(lb + 4 * F.lane + 256 * j); }
    if (cx_nks > 0) {
        const float* part = (const float*)(F.ws + WS_ES);
        for (int r = gw; r < TC; r += NGW) {
            f32x4 v[4];
#pragma unroll
            for (int j = 0; j < 4; ++j) { const int c = 4 * F.lane + 256 * j; f32x4 s = cx_bias ? *(const f32x4*)(cx_bias + c) : (f32x4){0.f, 0.f, 0.f, 0.f};
                for (int ks = 0; ks < cx_nks; ++ks) s += *(const f32x4*)(part + ((size_t)ks * TC + r) * D + c);
                v[j] = *(const f32x4*)(cx_xsrc + (size_t)r * D + c) * ALPHA + *(const f32x4*)(cx_modv + c) * cx_coef * s; }
            float mean, rstd; ln_stats(v, mean, rstd);
            float* xr = (float*)(F.ws + WS_XC) + (size_t)r * D;
#pragma unroll
            for (int j = 0; j < 4; ++j) { v[j] = (v[j] - mean) * rstd * g4[j] + b4[j]; *(f32x4*)(xr + 4 * F.lane + 256 * j) = v[j]; }
            if (hmod && dual) modulate_store8(v, modl + (size_t)2 * 9216 + ishift * D, modl + (size_t)2 * 9216 + (ishift + 1) * D, F.ws + WS_H8C + (size_t)r * D, F.lane);
            if (hmod) { if (h8) modulate_store8(v, modl + (size_t)2 * 9216 + ishift * D, modl + (size_t)2 * 9216 + (ishift + 1) * D, (unsigned char*)H + (size_t)(TL + r) * D, F.lane);
                        else modulate_store(v, modl + (size_t)2 * 9216 + ishift * D, modl + (size_t)2 * 9216 + (ishift + 1) * D, H + (size_t)(TL + r) * D, F.lane); }
        }
    }
    const int M = TL;
    u32x2 raw[LNR][4];
#pragma unroll
    for (int r = 0; r < LNR; ++r) { const int rw = min(gw + r * NGW, M - 1);
#pragma unroll
        for (int j = 0; j < 4; ++j) raw[r][j] = *(const u32x2*)(V + (size_t)rw * D + 4 * F.lane + 256 * j); }
    for (int row0 = gw; row0 < M; row0 += LNR * NGW) {
        f32x4 v[LNR][4]; int rows[LNR];
#pragma unroll
        for (int r = 0; r < LNR; ++r) { rows[r] = min(row0 + r * NGW, M - 1);
#pragma unroll
            for (int j = 0; j < 4; ++j) { const u32x2 w = raw[r][j]; v[r][j] = (f32x4){bflo(w.x), bfhi(w.x), bflo(w.y), bfhi(w.y)}; } }
        if (row0 + LNR * NGW < M) {
#pragma unroll
            for (int r = 0; r < LNR; ++r) { const int rw = min(row0 + (LNR + r) * NGW, M - 1);
#pragma unroll
                for (int j = 0; j < 4; ++j) raw[r][j] = *(const u32x2*)(V + (size_t)rw * D + 4 * F.lane + 256 * j); }
        }
        float mean[LNR], rstd[LNR]; ln_stats_r(v, mean, rstd);
#pragma unroll
        for (int r = 0; r < LNR; ++r) { const int row = rows[r]; const bool ok = row0 + r * NGW < M;
            float* xr = P.out + (size_t)row * D; bf16* xh = (bf16*)P.out + (size_t)row * D;
            if (skipx && ok && F.lane == 0) *(f32x2*)((float*)(F.ws + WS_LNS) + (size_t)row * 2) = (f32x2){mean[r], rstd[r]};
#pragma unroll
            for (int j = 0; j < 4; ++j) { v[r][j] = (v[r][j] - mean[r]) * rstd[r] * g4[j] + b4[j];
                if (ok) { if (final_out) __builtin_nontemporal_store(v[r][j], (f32x4*)(xr + 4 * F.lane + 256 * j));
                          else if (!skipx) { u32x2 w; w.x = cvt_pk_bf16(v[r][j][0], v[r][j][1]); w.y = cvt_pk_bf16(v[r][j][2], v[r][j][3]); __builtin_nontemporal_store(w, (u32x2*)(xh + 4 * F.lane + 256 * j)); } } } }
        if (hmod) {
            ln_stats_r(v, mean, rstd);
#pragma unroll
            for (int r = 0; r < LNR; ++r) if (row0 + r * NGW < M) { const int row = rows[r], g = row < SEQ ? 0 : 1;
                const float* shift = modl + (size_t)g * 9216 + ishift * D, *scale = shift + D; bf16* hrow = H + (size_t)row * D;
#pragma unroll
                for (int j = 0; j < 4; ++j) { const int c = 4 * F.lane + 256 * j; const f32x4 sc = *(const f32x4*)(scale + c), sh = *(const f32x4*)(shift + c);
                    const f32x4 h = (v[r][j] - mean[r]) * rstd[r] * (sc + 1.0f) + sh;
                    if (h8) __builtin_nontemporal_store(pk_fp8x4(h[0], h[1], h[2], h[3]), (unsigned*)((unsigned char*)H + (size_t)row * D + c));
                    else { u32x2 w; w.x = cvt_pk_bf16(h[0], h[1]); w.y = cvt_pk_bf16(h[2], h[3]); __builtin_nontemporal_store(w, (u32x2*)(hrow + c)); }
                    if (dual) __builtin_nontemporal_store(pk_fp8x4(h[0], h[1], h[2], h[3]), (unsigned*)(F.ws + WS_H8L + (size_t)row * D + c)); } }
        }
    }
}

__device__ __forceinline__ void filter_unit(Frame& F, const Params& P, int l, int L, int t0, float* filt  , bool bfout) {
    LAS float* h1 = (LAS float*)F.lds;
    LAS bf16* h2b = (LAS bf16*)(F.lds + 32768);
    LAS float* zf = (LAS float*)(F.lds + 65536);
    LAS float* w2s = (LAS float*)(F.lds + 81920);
    LAS float* w1s = (LAS float*)(F.lds + 98304);
    const float* w1 = P.in[I_HW1] + l * 33 * 64; const float* b1 = P.in[I_HB1] + l * 64; const float* w2 = P.in[I_HW2] + l * 64 * 64; const float* b2 = P.in[I_HB2] + l * 64;
    const float* fq = P.in[I_HFQ] + l * 128; const float* w3 = P.in[I_HW3] + (size_t)l * 64 * 1024;
    {
#pragma unroll
        for (int i = 0; i < 8; ++i) w2s[F.tid + 512 * i] = w2[F.tid + 512 * i];
#pragma unroll
        for (int i = 0; i < 5; ++i) if (F.tid + 512 * i < 33 * 64) w1s[F.tid + 512 * i] = w1[F.tid + 512 * i];
        const int tl = F.tid >> 3, jg = F.tid & 7; const float t = (float)(t0 + tl);
        if (jg == 0) zf[tl * 36] = t / (float)(L - 1);
#pragma unroll
        for (int ii = 0; ii < 2; ++ii) { const int i = jg + 8 * ii; const float band = 1e-4f + (float)i * ((15.0f - 1e-4f) / 15.0f); float s, c; sincospif(2.0f * t * band / (float)L, &s, &c); zf[tl * 36 + 1 + i] = c; zf[tl * 36 + 17 + i] = -s; }
        __syncthreads();
        float a[8];
#pragma unroll
        for (int jj = 0; jj < 8; ++jj) a[jj] = b1[jg * 8 + jj];
#pragma unroll 3
        for (int i = 0; i < 33; ++i) { const float zv = zf[tl * 36 + i]; const LAS f32x4* wp = (const LAS f32x4*)(w1s + i * 64 + jg * 8); const f32x4 wa = wp[0], wb = wp[1];
            a[0] += zv * wa[0]; a[1] += zv * wa[1]; a[2] += zv * wa[2]; a[3] += zv * wa[3]; a[4] += zv * wb[0]; a[5] += zv * wb[1]; a[6] += zv * wb[2]; a[7] += zv * wb[3]; }
#pragma unroll
        for (int jj = 0; jj < 8; ++jj) h1[tl * 65 + jg * 8 + jj] = sinf(fq[jg * 8 + jj] * a[jj]);
        __syncthreads();
#pragma unroll
        for (int jj = 0; jj < 8; ++jj) a[jj] = b2[jg * 8 + jj];
#pragma unroll 4
        for (int i = 0; i < 64; ++i) { const float hv = h1[tl * 65 + i]; const LAS f32x4* wp = (const LAS f32x4*)(w2s + i * 64 + jg * 8); const f32x4 wa = wp[0], wb = wp[1];
            a[0] += hv * wa[0]; a[1] += hv * wa[1]; a[2] += hv * wa[2]; a[3] += hv * wa[3]; a[4] += hv * wb[0]; a[5] += hv * wb[1]; a[6] += hv * wb[2]; a[7] += hv * wb[3]; }
#pragma unroll
        for (int jj = 0; jj < 8; ++jj) h2b[tl * 72 + jg * 8 + jj] = (bf16)(cvt_pk_bf16(sinf(fq[64 + jg * 8 + jj] * a[jj]), 0.f) & 0xffffu);
        __syncthreads();
    }
    {
        const bf16* W3T = (const bf16*)(F.ws + WS_W3T) + (size_t)l * 1024 * 64;
        const int lane = F.lane, lr = lane & 15, lg = lane >> 4;
        const float dl0 = -4.605170186f / 1.5f, dl1 = -4.605170186f / 0.3f;
        bf16x8 af[4][2];
#pragma unroll
        for (int rt = 0; rt < 4; ++rt)
#pragma unroll
            for (int ks = 0; ks < 2; ++ks) af[rt][ks] = *(const LAS bf16x8*)(h2b + (rt * 16 + lr) * 72 + ks * 32 + 8 * lg);
#pragma unroll 2
        for (int ct = 0; ct < 8; ++ct) {
            const int col = F.wave * 128 + ct * 16 + lr, c = col & 255;
            const bf16x8 b0 = *(const bf16x8*)(W3T + (size_t)col * 64 + 8 * lg), b1 = *(const bf16x8*)(W3T + (size_t)col * 64 + 32 + 8 * lg);
            const float ad = fabsf(dl0 + (dl1 - dl0) * (float)c / 255.0f);
#pragma unroll
            for (int rt = 0; rt < 4; ++rt) {
                f32x4 a = (f32x4){0.f, 0.f, 0.f, 0.f};
                a = __builtin_amdgcn_mfma_f32_16x16x32_bf16(af[rt][0], b0, a, 0, 0, 0);
                a = __builtin_amdgcn_mfma_f32_16x16x32_bf16(af[rt][1], b1, a, 0, 0, 0);
                const int tb = t0 + rt * 16 + 4 * lg;
#pragma unroll
                for (int e = 0; e < 4; ++e) { const float tn = (float)(tb + e) / (float)(L - 1); a[e] *= __expf(-tn * ad); }
                if (bfout) { u32x2 w; w.x = cvt_pk_bf16(a[0], a[1]); w.y = cvt_pk_bf16(a[2], a[3]); *(u32x2*)((bf16*)filt + (size_t)col * L + tb) = w; }
                else *(f32x4*)(filt + (size_t)col * L + tb) = a;
            }
        }
    }
    __syncthreads();
}
__device__ __forceinline__ void phase_filters(Frame& F, const Params& P, int l, bool with_ctx) {
    float* filt = (float*)(F.ws + WS_FILT); float* filtc = (float*)(F.ws + WS_FILTC);
    const int nu = SEQ / 64 + (with_ctx ? CTXL / 64 : 0);
    for (int u = F.bid; u < nu; u += F.G) {
        if (u < SEQ / 64) filter_unit(F, P, l, SEQ, u * 64, filt, true);
        else filter_unit(F, P, l, CTXL, (u - SEQ / 64) * 64, filtc, false);
    }
}

__device__ __forceinline__ void seg_of(int row, int& s0, int& s1) {
    if (row < TL) { s0 = row & ~(SEQ - 1); s1 = s0 + SEQ; } else { s0 = TL + ((row - TL) & ~(CTXL - 1)); s1 = s0 + CTXL; }
}
__device__ __forceinline__ void conformer_tiles(Frame& F, const Params& P, int l, int u0, int ntile) {
    const bf16* UA = (const bf16*)(F.ws + WS_UA); bf16* BR0 = (bf16*)(F.ws + WS_BRV);
    LAS bf16* tin = (LAS bf16*)F.lds;
    LAS float* cout = (LAS float*)(F.lds + 49152);
    const int c = F.tid & 255, half = F.tid >> 8;
    float w[31];
#pragma unroll
    for (int j = 0; j < 31; ++j) w[j] = P.in[I_CDW][(l * 31 + j) * 256 + c];
    const float b = P.in[I_CDB][l * 256 + c];
    const f32x4 g = *(const f32x4*)(P.in[I_CLG] + l * 256 + 4 * F.lane), bb = *(const f32x4*)(P.in[I_CLB] + l * 256 + 4 * F.lane);
    u32x4 v[6];
#define CONF_LOAD(u_) do { const int t0_ = (u_) * 64; int s0_, s1_; seg_of(t0_, s0_, s1_); _Pragma("unroll") for (int k = 0; k < 6; ++k) { const int idx = F.tid + NTHR * k, rr = idx >> 5, c8 = idx & 31, gr = t0_ - 15 + rr; \
        const bool ok_ = idx < 94 * 32 && gr >= s0_ && gr < s1_; const u32x4 t_ = *(const u32x4*)(UA + (size_t)min(max(gr, s0_), s1_ - 1) * 256 + c8 * 8); v[k] = ok_ ? t_ : (u32x4){0u, 0u, 0u, 0u}; } } while (0)
    if (u0 < ntile) CONF_LOAD(u0);
    for (int u = u0; u < ntile; u += F.G) {
        const int t0 = u * 64;
#pragma unroll
        for (int k = 0; k < 6; ++k) { const int idx = F.tid + NTHR * k, rr = idx >> 5, c8 = idx & 31; if (idx < 94 * 32) *(LAS u32x4*)(tin + rr * 256 + c8 * 8) = v[k]; }
        __syncthreads();
        if (u + F.G < ntile) CONF_LOAD(u + F.G);
        {
            float in[62];
#pragma unroll
            for (int i = 0; i < 62; ++i) in[i] = bf2f(tin[(half * 32 + i) * 256 + c]);
#pragma unroll
            for (int t = 0; t < 32; ++t) { float a = b;
#pragma unroll
                for (int j = 0; j < 31; ++j) a += w[j] * in[t + j];
                cout[(half * 32 + t) * 260 + c] = a; }
        }
        __syncthreads();
        {
            f32x4 v[8]; float s[8], q[8];
#pragma unroll
            for (int tt = 0; tt < 8; ++tt) { v[tt] = *(const LAS f32x4*)(cout + (F.wave * 8 + tt) * 260 + 4 * F.lane); s[tt] = (v[tt][0] + v[tt][1]) + (v[tt][2] + v[tt][3]); }
#pragma unroll
            for (int tt = 0; tt < 8; ++tt) s[tt] = wave_sum(s[tt]);
#pragma unroll
            for (int tt = 0; tt < 8; ++tt) { v[tt] = v[tt] - s[tt] * (1.0f / 256.0f); q[tt] = (v[tt][0] * v[tt][0] + v[tt][1] * v[tt][1]) + (v[tt][2] * v[tt][2] + v[tt][3] * v[tt][3]); }
#pragma unroll
            for (int tt = 0; tt < 8; ++tt) q[tt] = wave_sum(q[tt]);
#pragma unroll
            for (int tt = 0; tt < 8; ++tt) { const float rstd = 1.0f / sqrtf(q[tt] * (1.0f / 256.0f) + LN_EPS);
                f32x4 y = v[tt] * rstd * g + bb;
#pragma unroll
                for (int j = 0; j < 4; ++j) y[j] = siluf_(y[j]);
                u32x2 wv; wv.x = cvt_pk_bf16(y[0], y[1]); wv.y = cvt_pk_bf16(y[2], y[3]);
                __builtin_nontemporal_store(wv, (u32x2*)(BR0 + (size_t)(t0 + F.wave * 8 + tt) * 256 + 4 * F.lane)); }
        }
        __syncthreads();
    }
}
#undef CONF_LOAD
__device__ __forceinline__ void shortconv_unit(Frame& F, const Params& P, int l, int t0) {
    const bf16* SB = (const bf16*)(F.ws + WS_SB); const bf16* W = (const bf16*)(F.ws + WS_W); bf16* BR2 = (bf16*)(F.ws + WS_BRV) + 2 * (size_t)MT * 256;
    int s0, s1; seg_of(t0, s0, s1);
    const float* cw = P.in[I_SCW] + l * 3 * 256;
#pragma unroll
    for (int k = 0; k < 4; ++k) { const int idx = F.tid + NTHR * k, tok = idx >> 5, c8 = (idx & 31) * 8, gr = t0 + tok;
        const u32x4 z = (u32x4){0u, 0u, 0u, 0u};
        const u32x4 wm_ = *(const u32x4*)(W + (size_t)max(gr - 1, s0) * 256 + c8), w0 = *(const u32x4*)(W + (size_t)gr * 256 + c8),
                    wp_ = *(const u32x4*)(W + (size_t)min(gr + 1, s1 - 1) * 256 + c8), sb = *(const u32x4*)(SB + (size_t)gr * 256 + c8);
        const u32x4 wm = (gr - 1 >= s0) ? wm_ : z, wp = (gr + 1 < s1) ? wp_ : z;
        float o[8];
#pragma unroll
        for (int j = 0; j < 4; ++j) { const int c = c8 + 2 * j;
            o[2 * j] = bflo(sb[j]) * (cw[c] * bflo(wm[j]) + cw[256 + c] * bflo(w0[j]) + cw[512 + c] * bflo(wp[j]));
            o[2 * j + 1] = bfhi(sb[j]) * (cw[c + 1] * bfhi(wm[j]) + cw[256 + c + 1] * bfhi(w0[j]) + cw[512 + c + 1] * bfhi(wp[j])); }
        u32x4 w; w.x = cvt_pk_bf16(o[0], o[1]); w.y = cvt_pk_bf16(o[2], o[3]); w.z = cvt_pk_bf16(o[4], o[5]); w.w = cvt_pk_bf16(o[6], o[7]);
        __builtin_nontemporal_store(w, (u32x4*)(BR2 + (size_t)gr * 256 + c8)); }
}
__device__ __forceinline__ void attn_stage_ctx(Frame& F, int b, int h) {
    const unsigned char* K = F.ws + WS_K; const unsigned char* VT = F.ws + WS_VT;
#pragma unroll
    for (int i = 0; i < 4; ++i) { const int pi = F.tid + NTHR * i;
        { const int key = pi >> 3, pc = pi & 7; const u32x4 v = *(const u32x4*)(K + (size_t)(TL + b * CTXL + key) * 512 + h * 128 + pc * 16);
          *(LAS u32x4*)(F.lds + key * 128 + ((pc ^ ((key & 3) | ((key >> 1) & 4))) << 4)) = v; }
        { const int dim = pi >> 5, pc = pi & 31; const u32x4 v = *(const u32x4*)(VT + ((size_t)(h * 64 + dim) * MT + TL + b * CTXL) * 2 + pc * 16);
          *(LAS u32x4*)(F.lds + 32768 + dim * 512 + ((pc ^ (dim & 7)) << 4)) = v; } }
}
__device__ __forceinline__ void attn_wave_unit(Frame& F, int wu, bool lat, bool cl  ) {
    const bf16* Q = (const bf16*)(F.ws + WS_Q); const bf16* K = (const bf16*)(F.ws + WS_K); const bf16* VT = (const bf16*)(F.ws + WS_VT);
    bf16* BR1 = (bf16*)(F.ws + WS_BRV) + (size_t)MT * 256;
    const LAS float* rpb = (const LAS float*)(F.lds + RPB_OFF);
    const int lane = lane_now(), q = lane & 15, g = lane >> 4;
    int b, h, r = 0, qb, tq0, cb = 0, r0 = 0;
    if (lat) { qb = wu & 3; h = (wu >> 2) & 3; r = (wu >> 4) & 255; b = wu >> 12; tq0 = b * SEQ + r * 64 + 16 * qb; cb = (qb == 0) ? 0 : (qb == 1 ? 8 : (qb == 2 ? 24 : 32)); r0 = min(max(r - 4, 0), 248); }
    else { qb = wu & 15; h = (wu >> 4) & 3; b = wu >> 6; tq0 = TL + b * CTXL + 16 * qb; }
    bf16x8 qf[2];
#pragma unroll
    for (int kk = 0; kk < 2; ++kk) qf[kk] = *(const bf16x8*)(Q + (size_t)(tq0 + q) * 256 + h * 64 + 32 * kk + 8 * g);
    const int koff = (q >> 2) * 8 + (q & 3);
    const unsigned klo = (unsigned)((koff * 256 + h * 64 + 8 * g) * 2);
    const unsigned vlo = (unsigned)((((h * 64 + q) * MT) + 8 * g) * 2);
    const char* Kc = (const char*)K; const char* Vc = (const char*)VT;
    const int kl0 = koff * 128 + ((g ^ ((q & 3) | (((q >> 2) & 1) << 2))) << 4), vl0 = 32768 + q * 512 + ((g ^ (q & 7)) << 4);
    const int cq = 16 * qb + q, c0 = min(max(cq - 8, 0), 48);
    float mx = -1e30f, sum = 0.f;
    f32x4 o[4];
#pragma unroll
    for (int bl = 0; bl < 4; ++bl) o[bl] = (f32x4){0.f, 0.f, 0.f, 0.f};
    bf16x8 kf[2][2][2];
#define ATT_KBASE(i_) (((i_) < 8) ? (b * SEQ + (r0 + (i_)) * 64 + cb) : (TL + b * CTXL + 32 * ((i_) - 8)))
#define ATT_LOADK(c_) do { _Pragma("unroll") for (int s_ = 0; s_ < 2; ++s_) { const int kb_ = ATT_KBASE(2 * (c_) + s_); _Pragma("unroll") for (int tt = 0; tt < 2; ++tt) { \
        if (cl && (c_) >= 4) { const int lo_ = (2 * (c_) + s_ - 8) * 4096 + tt * 512; kf[s_][tt][0] = *(const LAS bf16x8*)(F.lds + lo_ + kl0); kf[s_][tt][1] = *(const LAS bf16x8*)(F.lds + lo_ + (kl0 ^ 64)); } \
        else { const char* kp_ = Kc + (size_t)(kb_ + 4 * tt) * 512; kf[s_][tt][0] = *(const bf16x8*)(kp_ + klo); kf[s_][tt][1] = *(const bf16x8*)(kp_ + klo + 64); } } } } while (0)
#define ATT_LOADV(dst_, c_) do { _Pragma("unroll") for (int s_ = 0; s_ < 2; ++s_) { const int kb_ = ATT_KBASE(2 * (c_) + s_); _Pragma("unroll") for (int bl = 0; bl < 4; ++bl) \
        { if (cl && (c_) >= 4) { const int m_ = 2 * (c_) + s_ - 8; dst_[s_][bl] = *(const LAS bf16x8*)(F.lds + bl * 8192 + (m_ >> 1) * 128 + ((m_ & 1) ? (vl0 ^ 64) : vl0)); } \
          else dst_[s_][bl] = *(const bf16x8*)(Vc + ((size_t)(16 * bl) * MT + kb_) * 2 + vlo); } } } while (0)
    bf16x8 vf[2][4], vn[2][4];
    u32x4 kg[2][2][4], vg[2][4];
    LAS unsigned char* wb = F.lds + 65536 + F.wave * 8192;
    const int kq = lane >> 3;
    const int wk0 = kq * 128 + (((lane & 7) ^ (kq & 3)) << 4), wv0 = 4096 + (lane >> 2) * 64 + (((lane & 3) ^ ((lane >> 3) & 3)) << 4), vl1 = 4096 + q * 64 + ((g ^ ((q >> 1) & 3)) << 4);
    const unsigned gk = (unsigned)(kq * 512 + h * 128 + (lane & 7) * 16), gv = (unsigned)(((h * 64 + (lane >> 2)) * MT) * 2 + (lane & 3) * 16);
#define ATT_GLOADK(c_) do { _Pragma("unroll") for (int s_ = 0; s_ < 2; ++s_) { const int kb_ = ATT_KBASE(2 * (c_) + s_); _Pragma("unroll") for (int n = 0; n < 4; ++n) \
        kg[(c_) & 1][s_][n] = *(const u32x4*)(Kc + (size_t)kb_ * 512 + (size_t)n * 4096 + gk); } } while (0)
#define ATT_GLOADV(c_) do { _Pragma("unroll") for (int s_ = 0; s_ < 2; ++s_) { const int kb_ = ATT_KBASE(2 * (c_) + s_); _Pragma("unroll") for (int n = 0; n < 4; ++n) \
        vg[s_][n] = *(const u32x4*)(Vc + (size_t)kb_ * 2 + (size_t)n * 16 * MT * 2 + gv); } } while (0)
#define ATT_XPOSEK(c_) do { _Pragma("unroll") for (int s_ = 0; s_ < 2; ++s_) { \
        _Pragma("unroll") for (int n = 0; n < 4; ++n) *(LAS u32x4*)(wb + n * 1024 + ((n & 1) ? (wk0 ^ 64) : wk0)) = kg[(c_) & 1][s_][n]; \
        _Pragma("unroll") for (int tt = 0; tt < 2; ++tt) { kf[s_][tt][0] = *(const LAS bf16x8*)(wb + tt * 512 + kl0); kf[s_][tt][1] = *(const LAS bf16x8*)(wb + tt * 512 + (kl0 ^ 64)); } } } while (0)
#define ATT_XPOSEV() do { _Pragma("unroll") for (int s_ = 0; s_ < 2; ++s_) { \
        _Pragma("unroll") for (int n = 0; n < 4; ++n) *(LAS u32x4*)(wb + n * 1024 + wv0) = vg[s_][n]; \
        _Pragma("unroll") for (int bl = 0; bl < 4; ++bl) vf[s_][bl] = *(const LAS bf16x8*)(wb + bl * 1024 + vl1); } } while (0)
    if (cl) { ATT_GLOADK(0); ATT_GLOADV(0); ATT_GLOADK(1); } else if (lat) { ATT_LOADK(0); ATT_LOADV(vf, 0); } else { ATT_LOADK(4); ATT_LOADV(vf, 4); }
#pragma unroll
    for (int c = 0; c < 8; ++c) {
        if (c < 4 && !lat) continue;
        if (cl) { if (c < 4) { ATT_XPOSEK(c); if (c < 2) ATT_GLOADK(c + 2); } else { ATT_LOADK(c); ATT_LOADV(vf, c); } }
        f32x4 s[2][2];
#pragma unroll
        for (int s_ = 0; s_ < 2; ++s_)
#pragma unroll
            for (int tt = 0; tt < 2; ++tt) {
                f32x4 a = (f32x4){0.f, 0.f, 0.f, 0.f};
                a = __builtin_amdgcn_mfma_f32_16x16x32_bf16(kf[s_][tt][0], qf[0], a, 0, 0, 0);
                a = __builtin_amdgcn_mfma_f32_16x16x32_bf16(kf[s_][tt][1], qf[1], a, 0, 0, 0);
                if (c < 4) {
                    const int i = 2 * c + s_;
                    const LAS float* rp = rpb + (h * 15 + (r0 + i - r + 7)) * 31;
#pragma unroll
                    for (int j = 0; j < 4; ++j) { const int kc = cb + 8 * g + 4 * tt + j; const bool ok = (kc >= c0) && (kc < c0 + 16);
                        const int dc = min(max(kc - cq + 15, 0), 30);
                        a[j] = ok ? a[j] + rp[dc] : -1e30f; }
                }
                s[s_][tt] = a;
            }
        if (!cl && c < 7) { ATT_LOADK(c + 1); ATT_LOADV(vn, c + 1); }
        if (cl && c < 4) { ATT_XPOSEV(); if (c < 3) ATT_GLOADV(c + 1); }
        float cm = -1e30f;
#pragma unroll
        for (int s_ = 0; s_ < 2; ++s_)
#pragma unroll
            for (int tt = 0; tt < 2; ++tt)
#pragma unroll
                for (int j = 0; j < 4; ++j) cm = fmaxf(cm, s[s_][tt][j]);
        cm = xrow_max(cm);
        const float mn = fmaxf(mx, cm), alpha = __builtin_amdgcn_exp2f(mx - mn);
        mx = mn; sum *= alpha;
#pragma unroll
        for (int bl = 0; bl < 4; ++bl) o[bl] *= alpha;
#pragma unroll
        for (int s_ = 0; s_ < 2; ++s_) {
            float p[8];
#pragma unroll
            for (int tt = 0; tt < 2; ++tt)
#pragma unroll
                for (int j = 0; j < 4; ++j) { const float e = __builtin_amdgcn_exp2f(s[s_][tt][j] - mn); p[4 * tt + j] = e; sum += e; }
            u32x4 pw; pw.x = cvt_pk_bf16(p[0], p[1]); pw.y = cvt_pk_bf16(p[2], p[3]); pw.z = cvt_pk_bf16(p[4], p[5]); pw.w = cvt_pk_bf16(p[6], p[7]);
            const bf16x8 pf = __builtin_bit_cast(bf16x8, pw);
#pragma unroll
            for (int bl = 0; bl < 4; ++bl) o[bl] = __builtin_amdgcn_mfma_f32_16x16x32_bf16(vf[s_][bl], pf, o[bl], 0, 0, 0);
        }
        if (!cl && c < 7) {
#pragma unroll
            for (int s_ = 0; s_ < 2; ++s_)
#pragma unroll
                for (int bl = 0; bl < 4; ++bl) vf[s_][bl] = vn[s_][bl];
        }
    }
#undef ATT_XPOSEK
#undef ATT_XPOSEV
#undef ATT_GLOADK
#undef ATT_GLOADV
#undef ATT_LOADV
#undef ATT_LOADK
#undef ATT_KBASE
    sum = xrow_sum(sum);
    const float inv = 1.0f / sum;
#pragma unroll
    for (int bl = 0; bl < 4; ++bl) { u32x2 w; w.x = cvt_pk_bf16(o[bl][0] * inv, o[bl][1] * inv); w.y = cvt_pk_bf16(o[bl][2] * inv, o[bl][3] * inv);
        __builtin_nontemporal_store(w, (u32x2*)(BR1 + (size_t)(tq0 + q) * 256 + h * 64 + 16 * bl + 4 * g)); }
}

constexpr int FL = 16384;
__device__ __forceinline__ f32x2 cmul(f32x2 a, f32x2 b) {
    f32x2 t, r;
    asm("v_pk_mul_f32 %1, %2, %3 op_sel:[1,1] op_sel_hi:[1,0]\n\tv_pk_fma_f32 %0, %2, %3, %1 op_sel:[0,0,0] op_sel_hi:[0,1,1] neg_lo:[0,0,1]" : "=v"(r), "=&v"(t) : "v"(a), "v"(b));
    return r;
}
__device__ __forceinline__ f32x2 cmulc(f32x2 a, f32x2 b) {
    f32x2 t, r;
    asm("v_pk_mul_f32 %1, %2, %3 op_sel:[1,1] op_sel_hi:[1,0]\n\tv_pk_fma_f32 %0, %2, %3, %1 op_sel:[0,0,0] op_sel_hi:[0,1,1] neg_hi:[1,0,0]" : "=v"(r), "=&v"(t) : "v"(a), "v"(b));
    return r;
}
__device__ __forceinline__ f32x2 rotm(f32x2 b, f32x2 d) { f32x2 r; asm("v_pk_add_f32 %0, %1, %2 op_sel:[0,1] op_sel_hi:[1,0] neg_hi:[0,1]" : "=v"(r) : "v"(b), "v"(d)); return r; }
__device__ __forceinline__ f32x2 rotp(f32x2 b, f32x2 d) { f32x2 r; asm("v_pk_add_f32 %0, %1, %2 op_sel:[0,1] op_sel_hi:[1,0] neg_lo:[0,1]" : "=v"(r) : "v"(b), "v"(d)); return r; }
__device__ __forceinline__ f32x2 tw_main(const LAS f32x2* T, int m) { return cmul(T[m >> 7], T[128 + (m & 127)]); }
__device__ __forceinline__ f32x2 tw_half(const LAS f32x2* T, int n) { return cmul(T[256 + (n >> 7)], T[384 + (n & 127)]); }
__device__ __forceinline__ void r4f(f32x2& x0, f32x2& x1, f32x2& x2, f32x2& x3, f32x2 w1, f32x2 w2, f32x2 w3) {
    const f32x2 a = x0 + x2, b = x0 - x2, c = x1 + x3, d = x1 - x3;
    x0 = a + c; x1 = cmul(rotm(b, d), w1); x2 = cmul(a - c, w2); x3 = cmul(rotp(b, d), w3);
}
__device__ __forceinline__ void r4f1(f32x2& x0, f32x2& x1, f32x2& x2, f32x2& x3) {
    const f32x2 a = x0 + x2, b = x0 - x2, c = x1 + x3, d = x1 - x3;
    x0 = a + c; x1 = rotm(b, d); x2 = a - c; x3 = rotp(b, d);
}
__device__ __forceinline__ void r4i(f32x2& x0, f32x2& x1, f32x2& x2, f32x2& x3, f32x2 w1, f32x2 w2, f32x2 w3) {
    const f32x2 t1 = cmulc(x1, w1), t2 = cmulc(x2, w2), t3 = cmulc(x3, w3);
    const f32x2 a = x0 + t2, b = x0 - t2, c = t1 + t3, d = t1 - t3;
    x0 = a + c; x1 = rotp(b, d); x2 = a - c; x3 = rotm(b, d);
}
__device__ __forceinline__ void r4i1(f32x2& x0, f32x2& x1, f32x2& x2, f32x2& x3) {
    const f32x2 a = x0 + x2, b = x0 - x2, c = x1 + x3, d = x1 - x3;
    x0 = a + c; x1 = rotp(b, d); x2 = a - c; x3 = rotm(b, d);
}
#define W16_1 ((f32x2){0.92387953251f, -0.38268343237f})
#define W16_2 ((f32x2){0.70710678119f, -0.70710678119f})
#define W16_3 ((f32x2){0.38268343237f, -0.92387953251f})
template <int SP, bool INV> __device__ __forceinline__ void fft_pass16(LAS f32x2* B, const LAS f32x2* T, int tid) {
    constexpr int STEP = (SP == 1024) ? 1040 : (SP == 64 ? 65 : 4);
#pragma unroll
    for (int jj = 0; jj < 2; ++jj) {
        const int q = tid + 512 * jj;
        int k, base;
        if (SP == 1024) { k = q; base = q + (q >> 6); }
        else if (SP == 64) { k = q & 63; const int i0 = (q >> 6) * 1024 + k; base = i0 + (i0 >> 6); }
        else { k = q >> 8; base = (q & 255) * 65 + k; }
        LAS f32x2* p = B + base;
        f32x2 x[16];
#pragma unroll
        for (int m = 0; m < 16; ++m) x[m] = p[m * STEP];
        const f32x2 b = tw_main(T, k * (1024 / SP));
        const f32x2 b2 = cmul(b, b), w = cmul(b2, b2), w2 = cmul(w, w), w3 = cmul(w, w2);
        f32x2 t1[4], t2[4], t3[4];
        t1[0] = b; t1[1] = cmul(b, W16_1); t1[2] = cmul(b, W16_2); t1[3] = cmul(b, W16_3);
#pragma unroll
        for (int m = 0; m < 4; ++m) { t2[m] = cmul(t1[m], t1[m]); t3[m] = cmul(t1[m], t2[m]); }
        if (!INV) {
#pragma unroll
            for (int m = 0; m < 4; ++m) r4f(x[m], x[m + 4], x[m + 8], x[m + 12], t1[m], t2[m], t3[m]);
#pragma unroll
            for (int j = 0; j < 4; ++j) r4f(x[4 * j], x[4 * j + 1], x[4 * j + 2], x[4 * j + 3], w, w2, w3);
        } else {
#pragma unroll
            for (int j = 0; j < 4; ++j) r4i(x[4 * j], x[4 * j + 1], x[4 * j + 2], x[4 * j + 3], w, w2, w3);
#pragma unroll
            for (int m = 0; m < 4; ++m) r4i(x[m], x[m + 4], x[m + 8], x[m + 12], t1[m], t2[m], t3[m]);
        }
#pragma unroll
        for (int m = 0; m < 16; ++m) p[m * STEP] = x[m];
    }
    __syncthreads();
}
template <bool INV> __device__ __forceinline__ void fft_pass4(LAS f32x2* B, int tid) {
#pragma unroll 4
    for (int jj = 0; jj < 8; ++jj) {
        const int q = tid + 512 * jj;
        LAS f32x2* p = B + (q & 255) * 65 + 4 * (q >> 8);
        f32x2 x0 = p[0], x1 = p[1], x2 = p[2], x3 = p[3];
        if (!INV) r4f1(x0, x1, x2, x3); else r4i1(x0, x1, x2, x3);
        p[0] = x0; p[1] = x1; p[2] = x2; p[3] = x3;
    }
    __syncthreads();
}
__device__ __forceinline__ void fft_fwd(LAS f32x2* B, const LAS f32x2* T, int tid) {
    fft_pass16<1024, false>(B, T, tid); fft_pass16<64, false>(B, T, tid); fft_pass16<4, false>(B, T, tid); fft_pass4<false>(B, tid);
}
__device__ __forceinline__ void fft_inv(LAS f32x2* B, const LAS f32x2* T, int tid) {
    fft_pass4<true>(B, tid); fft_pass16<4, true>(B, T, tid); fft_pass16<64, true>(B, T, tid); fft_pass16<1024, true>(B, T, tid);
}
__device__ __forceinline__ void fft_pass4_keep(LAS f32x2* B, int tid, u32x4 (&ks)[8]) {
#pragma unroll
    for (int jj = 0; jj < 8; ++jj) {
        const int q = tid + 512 * jj;
        const LAS f32x2* p = B + (q & 255) * 65 + 4 * (q >> 8);
        f32x2 x0 = p[0], x1 = p[1], x2 = p[2], x3 = p[3];
        r4f1(x0, x1, x2, x3);
        ks[jj].x = cvt_pk_bf16(x0.x, x0.y); ks[jj].y = cvt_pk_bf16(x1.x, x1.y); ks[jj].z = cvt_pk_bf16(x2.x, x2.y); ks[jj].w = cvt_pk_bf16(x3.x, x3.y);
    }
    __syncthreads();
}
__device__ __forceinline__ void fft_mid4(LAS f32x2* B, int tid, const u32x4 (&ks)[8]) {
#pragma unroll
    for (int jj = 0; jj < 8; ++jj) {
        const int q = tid + 512 * jj;
        LAS f32x2* p = B + (q & 255) * 65 + 4 * (q >> 8);
        f32x2 x0 = p[0], x1 = p[1], x2 = p[2], x3 = p[3];
        r4f1(x0, x1, x2, x3);
        x0 = cmul(x0, (f32x2){bflo(ks[jj].x), bfhi(ks[jj].x)}); x1 = cmul(x1, (f32x2){bflo(ks[jj].y), bfhi(ks[jj].y)});
        x2 = cmul(x2, (f32x2){bflo(ks[jj].z), bfhi(ks[jj].z)}); x3 = cmul(x3, (f32x2){bflo(ks[jj].w), bfhi(ks[jj].w)});
        r4i1(x0, x1, x2, x3);
        p[0] = x0; p[1] = x1; p[2] = x2; p[3] = x3;
    }
    __syncthreads();
}
__device__ __forceinline__ void fft_fwd3(LAS f32x2* B, const LAS f32x2* T, int tid) { fft_pass16<1024, false>(B, T, tid); fft_pass16<64, false>(B, T, tid); fft_pass16<4, false>(B, T, tid); }
__device__ __forceinline__ void fft_inv3(LAS f32x2* B, const LAS f32x2* T, int tid) { fft_pass16<4, true>(B, T, tid); fft_pass16<64, true>(B, T, tid); fft_pass16<1024, true>(B, T, tid); }
__device__ __forceinline__ float conv3_at(const bf16* p, int n, int L, float w0, float w1, float w2, float b) {
    const float xm = n > 0 ? bf2f(p[n - 1]) : 0.f, x0 = bf2f(p[n]), xp = n + 1 < L ? bf2f(p[n + 1]) : 0.f;
    return w0 * xm + w1 * x0 + w2 * xp + b;
}
__device__ __forceinline__ float block_sum(Frame& F, float v) {
    LAS float* red = (LAS float*)(F.lds + RED_OFF);
    v = wave_sum(v);
    __syncthreads();
    if (F.lane == 0) red[F.wave] = v;
    __syncthreads();
    float s = 0.f;
#pragma unroll
    for (int w = 0; w < 8; ++w) s += red[w];
    return s;
}
__device__ __forceinline__ f32x4 conv3x4(const bf16* p, int nb, float w0, float w1, float w2, float b) {
    const u32x2 m = *(const u32x2*)(p + nb);
    const float x0 = bflo(m.x), x1 = bfhi(m.x), x2 = bflo(m.y), x3 = bfhi(m.y);
    const float xm = nb > 0 ? bf2f(p[nb - 1]) : 0.f, xp = nb + 4 < SEQ ? bf2f(p[nb + 4]) : 0.f;
    return (f32x4){w0 * xm + w1 * x0 + w2 * x1 + b, w0 * x0 + w1 * x1 + w2 * x2 + b, w0 * x1 + w1 * x2 + w2 * x3 + b, w0 * x2 + w1 * x3 + w2 * xp + b};
}
typedef u32x4 u32x4_a4 __attribute__((aligned(4)));
__device__ __forceinline__ u32x4 ld16u(const bf16* p) { return *(const u32x4_a4*)p; }
__device__ __forceinline__ void conv3p(const u32x4 a, const u32x4 b, bool first, bool last, float w0, float w1, float w2, float bb, f32x2 (&z)[4]) {
    f32x2 X[6];
    X[0] = (f32x2){bfhi(a.x), bfhi(b.x)}; X[1] = (f32x2){bflo(a.y), bflo(b.y)}; X[2] = (f32x2){bfhi(a.y), bfhi(b.y)};
    X[3] = (f32x2){bflo(a.z), bflo(b.z)}; X[4] = (f32x2){bfhi(a.z), bfhi(b.z)}; X[5] = (f32x2){bflo(a.w), bflo(b.w)};
    if (first) X[0] = (f32x2){0.f, 0.f};
    if (last) X[5] = (f32x2){0.f, 0.f};
#pragma unroll
    for (int e = 0; e < 4; ++e) z[e] = X[e] * w0 + (X[e + 1] * w1 + (X[e + 2] * w2 + bb));
}
__device__ __forceinline__ void hyena_unit(Frame& F, const Params& P, int l, int c, bool dummy) {
    LAS f32x2* B = (LAS f32x2*)F.lds; const LAS f32x2* T = (const LAS f32x2*)(F.lds + TW_OFF);
    const bf16* HT = (const bf16*)(F.ws + WS_HT); const bf16* FILT = (const bf16*)(F.ws + WS_FILT);
    f32x4* Z = (f32x4*)(F.ws + WS_KSCR + (size_t)F.bid * 131072);
    u32x4 ksr[8];
    u32x4* ES = (u32x4*)(F.ws + WS_ES + (size_t)F.bid * 131072) + 4096;
    bf16* BR3 = (bf16*)(F.ws + WS_BRV) + 3 * (size_t)MT * 256;
    const float* sw = P.in[I_HSW] + l * 3 * 768; const float* sb = P.in[I_HSB] + l * 768;
    const int tid = F.tid;
#define HY_NB(jp_) (4 * tq + 2048 * (jp_))
#define HY_TQ int tq = tid; asm volatile("" : "+v"(tq))
#define HY_G(T_, base_, boff_) (*(T_*)((char*)(base_) + (unsigned)(boff_)))
#define HY_LDX(row_, nb_) (*(const u32x4_a4*)((const char*)((row_) - 2) + (unsigned)((nb_) * 2)))
#define HY_LDR(hb_, nb_) (*(const u32x4_a4*)((const char*)((hb_) - 2) + (unsigned)((FL - 4 - (nb_)) * 2)))
#define HY_SLOT(nb_) (B + (nb_) + ((nb_) >> 6))
#define HY_TW4(nb_, w_) do { const f32x2 tb_ = T[256 + ((nb_) >> 7)]; const LAS f32x4* tp_ = (const LAS f32x4*)(T + 384 + ((nb_) & 127)); const f32x4 ta_ = tp_[0], tc_ = tp_[1]; \
        w_[0] = cmul(tb_, (f32x2){ta_[0], ta_[1]}); w_[1] = cmul(tb_, (f32x2){ta_[2], ta_[3]}); w_[2] = cmul(tb_, (f32x2){tc_[0], tc_[1]}); w_[3] = cmul(tb_, (f32x2){tc_[2], tc_[3]}); } while (0)
#define HY_ST4(nb_, c0_, c1_, c2_, c3_) do { LAS f32x2* bp_ = HY_SLOT(nb_); bp_[0] = (c0_); bp_[1] = (c1_); bp_[2] = (c2_); bp_[3] = (c3_); } while (0)
#define HY_UNPK(w_) ((f32x2){bflo(w_), bfhi(w_)})
#define HY_FILT4(fw_, gw_, nb_, f4_, r4_) const f32x4 f4_ = (f32x4){bflo(fw_.x), bfhi(fw_.x), bflo(fw_.y), bfhi(fw_.y)};   \
        const f32x4 r4_ = (f32x4){(nb_) ? bflo(gw_.w) : 0.f, bfhi(gw_.z), bflo(gw_.z), bfhi(gw_.y)}
    {
        const bf16* p0 = HT + (size_t)c * MT; const float v0 = sw[c], v1 = sw[768 + c], v2 = sw[1536 + c], vb = sb[c];
        { HY_TQ;
#pragma unroll
        for (int h = 0; h < 2; ++h) {
            u32x4 xa[4], xb[4];
#pragma unroll
            for (int j = 0; j < 4; ++j) { const int nb = HY_NB(4 * h + j); xa[j] = HY_LDX(p0, nb); xb[j] = HY_LDX(p0 + SEQ, nb); }
#pragma unroll
            for (int j = 0; j < 4; ++j) { const int nb = HY_NB(4 * h + j); f32x2 z[4]; conv3p(xa[j], xb[j], nb == 0, nb + 4 == SEQ, v0, v1, v2, vb, z);
                HY_G(f32x4, Z, nb * 8) = (f32x4){z[0].x, z[0].y, z[1].x, z[1].y}; HY_G(f32x4, Z + 1, nb * 8) = (f32x4){z[2].x, z[2].y, z[3].x, z[3].y}; }
        } }
    }
#pragma unroll 1
    for (int o = 0; o < 2; ++o) {
        const bf16* hf = FILT + (size_t)((o * 2 + 0) * 256 + c) * SEQ; const bf16* hb = FILT + (size_t)((o * 2 + 1) * 256 + c) * SEQ;
        float ss = 0.f;
#pragma unroll 1
        for (int par = 0; par < 2; ++par) {
            if (par == 0) {
                { HY_TQ;
#pragma unroll
                for (int h = 0; h < 2; ++h) {
                    u32x2 fw[4]; u32x4 gw[4];
#pragma unroll
                    for (int j = 0; j < 4; ++j) { const int nb = HY_NB(4 * h + j); fw[j] = HY_G(const u32x2, hf, nb * 2); gw[j] = HY_LDR(hb, nb); }
#pragma unroll
                    for (int j = 0; j < 4; ++j) { const int nb = HY_NB(4 * h + j); HY_FILT4(fw[j], gw[j], nb, f4, r4);
                        const f32x4 a = f4 + r4; ss += (f4[0] * f4[0] + f4[1] * f4[1]) + (f4[2] * f4[2] + f4[3] * f4[3]) + (r4[0] * r4[0] + r4[1] * r4[1]) + (r4[2] * r4[2] + r4[3] * r4[3]);
                        HY_ST4(nb, ((f32x2){a[0], 0.f}), ((f32x2){a[1], 0.f}), ((f32x2){a[2], 0.f}), ((f32x2){a[3], 0.f})); }
                } }
                __syncthreads();
            }
            fft_fwd3(B, T, tid); fft_pass4_keep(B, tid, ksr);
            { HY_TQ;
#pragma unroll
            for (int h = 0; h < 2; ++h) {
                f32x4 za[4], zb[4];
#pragma unroll
                for (int j = 0; j < 4; ++j) { const int nb = HY_NB(4 * h + j); za[j] = HY_G(const f32x4, Z, nb * 8); zb[j] = HY_G(const f32x4, Z + 1, nb * 8); }
#pragma unroll
                for (int j = 0; j < 4; ++j) { const int nb = HY_NB(4 * h + j);
                    const f32x2 z0 = (f32x2){za[j].x, za[j].y}, z1 = (f32x2){za[j].z, za[j].w}, z2 = (f32x2){zb[j].x, zb[j].y}, z3 = (f32x2){zb[j].z, zb[j].w};
                    if (par == 0) { HY_ST4(nb, z0, z1, z2, z3); }
                    else { f32x2 tw[4]; HY_TW4(nb, tw); HY_ST4(nb, cmul(z0, tw[0]), cmul(z1, tw[1]), cmul(z2, tw[2]), cmul(z3, tw[3])); } }
            } }
            __syncthreads();
            fft_fwd3(B, T, tid); fft_mid4(B, tid, ksr);
            fft_inv3(B, T, tid);
            if (par == 0) {
                { HY_TQ;
#pragma unroll
                for (int h = 0; h < 2; ++h) {
                    u32x2 fw[4]; u32x4 gw[4];
#pragma unroll
                    for (int j = 0; j < 4; ++j) { const int nb = HY_NB(4 * h + j); fw[j] = HY_G(const u32x2, hf, nb * 2); gw[j] = HY_LDR(hb, nb); }
#pragma unroll
                    for (int j = 0; j < 4; ++j) { const int jp = 4 * h + j, nb = HY_NB(jp); const LAS f32x2* bp = HY_SLOT(nb); const f32x2 a0 = bp[0] * (1.0f / 16384.0f), a1 = bp[1] * (1.0f / 16384.0f), a2 = bp[2] * (1.0f / 16384.0f), a3 = bp[3] * (1.0f / 16384.0f);
                        u32x4 w; w.x = cvt_pk_bf16(a0.x, a0.y); w.y = cvt_pk_bf16(a1.x, a1.y); w.z = cvt_pk_bf16(a2.x, a2.y); w.w = cvt_pk_bf16(a3.x, a3.y); HY_G(u32x4, ES + jp * 512, tq * 16) = w;
                        HY_FILT4(fw[j], gw[j], nb, f4, r4);
                        const f32x4 d = f4 - r4; f32x2 tw[4]; HY_TW4(nb, tw); HY_ST4(nb, tw[0] * d[0], tw[1] * d[1], tw[2] * d[2], tw[3] * d[3]); }
                } }
                __syncthreads();
            }
        }
        const float nrm = (1.0f / sqrtf(block_sum(F, ss) + 1e-6f)) * 0.5f;
        const float hbias = P.in[I_HBI][(l * 2 + o) * 256 + c];
        const int ch = (o + 1) * 256 + c;
        const bf16* px = HT + (size_t)ch * MT; const float w0 = sw[ch], w1 = sw[768 + ch], w2 = sw[1536 + ch], bb = sb[ch];
        { HY_TQ;
#pragma unroll
        for (int h = 0; h < 4; ++h) {
            u32x4 ev[2], xa[2], xb[2]; f32x4 za[2], zb[2];
#pragma unroll
            for (int j = 0; j < 2; ++j) { const int jp = 2 * h + j, nb = HY_NB(jp); ev[j] = HY_G(const u32x4, ES + jp * 512, tq * 16); za[j] = HY_G(const f32x4, Z, nb * 8); zb[j] = HY_G(const f32x4, Z + 1, nb * 8); xa[j] = HY_LDX(px, nb); xb[j] = HY_LDX(px + SEQ, nb); }
#pragma unroll
            for (int j = 0; j < 2; ++j) { const int nb = HY_NB(2 * h + j);
                const LAS f32x2* bp = HY_SLOT(nb); f32x2 w[4]; HY_TW4(nb, w);
                const f32x2 e0 = HY_UNPK(ev[j].x) + cmulc(bp[0], w[0]) * (1.0f / 16384.0f), e1 = HY_UNPK(ev[j].y) + cmulc(bp[1], w[1]) * (1.0f / 16384.0f),
                            e2 = HY_UNPK(ev[j].z) + cmulc(bp[2], w[2]) * (1.0f / 16384.0f), e3 = HY_UNPK(ev[j].w) + cmulc(bp[3], w[3]) * (1.0f / 16384.0f);
                f32x2 x[4]; conv3p(xa[j], xb[j], nb == 0, nb + 4 == SEQ, w0, w1, w2, bb, x);
                const f32x2 y0 = (e0 * nrm + (f32x2){za[j].x, za[j].y} * hbias) * x[0], y1 = (e1 * nrm + (f32x2){za[j].z, za[j].w} * hbias) * x[1],
                            y2 = (e2 * nrm + (f32x2){zb[j].x, zb[j].y} * hbias) * x[2], y3 = (e3 * nrm + (f32x2){zb[j].z, zb[j].w} * hbias) * x[3];
                if (o == 0) { HY_G(f32x4, Z, nb * 8) = (f32x4){y0.x, y0.y, y1.x, y1.y}; HY_G(f32x4, Z + 1, nb * 8) = (f32x4){y2.x, y2.y, y3.x, y3.y}; }
                else if (!dummy) {
                    const unsigned u0 = cvt_pk_bf16(y0.x, y0.y), u1 = cvt_pk_bf16(y1.x, y1.y), u2 = cvt_pk_bf16(y2.x, y2.y), u3 = cvt_pk_bf16(y3.x, y3.y);
                    bf16* q0 = BR3 + c; bf16* q1 = q0 + (size_t)SEQ * 256; const int ob = nb * 512;
                    HY_G(bf16, q0, ob) = (bf16)(u0 & 0xffffu); HY_G(bf16, q0 + 256, ob) = (bf16)(u1 & 0xffffu); HY_G(bf16, q0 + 512, ob) = (bf16)(u2 & 0xffffu); HY_G(bf16, q0 + 768, ob) = (bf16)(u3 & 0xffffu);
                    HY_G(bf16, q1, ob) = (bf16)(u0 >> 16); HY_G(bf16, q1 + 256, ob) = (bf16)(u1 >> 16); HY_G(bf16, q1 + 512, ob) = (bf16)(u2 >> 16); HY_G(bf16, q1 + 768, ob) = (bf16)(u3 >> 16); }
            }
        } }
        __syncthreads();
    }
#undef HY_NB
#undef HY_TQ
#undef HY_G
#undef HY_LDX
#undef HY_LDR
#undef HY_FILT4
#undef HY_TW4
#undef HY_ST4
#undef HY_SLOT
#undef HY_UNPK
}
__device__ __forceinline__ void hyena_ctx_unit(Frame& F, const Params& P, int l, int c) {
    LAS float* zc = (LAS float*)F.lds;
    LAS float* kk = (LAS float*)(F.lds + 4096);
    const bf16* HT = (const bf16*)(F.ws + WS_HT); const float* FC = (const float*)(F.ws + WS_FILTC);
    bf16* BR3 = (bf16*)(F.ws + WS_BRV) + 3 * (size_t)MT * 256;
    const float* sw = P.in[I_HSW] + l * 3 * 768; const float* sb = P.in[I_HSB] + l * 768;
    const int b = F.tid >> 8, t = F.tid & 255;
    float zv = conv3_at(HT + (size_t)c * MT + TL + b * CTXL, t, CTXL, sw[c], sw[768 + c], sw[1536 + c], sb[c]);
    for (int o = 0; o < 2; ++o) {
        const float* hf = FC + (size_t)((o * 2 + 0) * 256 + c) * CTXL; const float* hb = FC + (size_t)((o * 2 + 1) * 256 + c) * CTXL;
        float ss = 0.f;
        if (F.tid < 256) { const float f = hf[F.tid]; kk[255 + F.tid] = f; ss = f * f; }
        else { const int d = F.tid - 256; if (d >= 1) { const float f = hb[d]; kk[255 - d] = f; ss = f * f; } }
        zc[F.tid] = zv;
        const float nrm = 1.0f / sqrtf(block_sum(F, ss) + 1e-6f);
        float y = 0.f;
        for (int s_ = 0; s_ < 256; ++s_) y += kk[t - s_ + 255] * zc[b * 256 + s_];
        y = y * nrm + P.in[I_HBI][(l * 2 + o) * 256 + c] * zv;
        const int ch = (o + 1) * 256 + c;
        zv = conv3_at(HT + (size_t)ch * MT + TL + b * CTXL, t, CTXL, sw[ch], sw[768 + ch], sw[1536 + ch], sb[ch]) * y;
        __syncthreads();
    }
    BR3[(size_t)(TL + b * CTXL + t) * 256 + c] = (bf16)(cvt_pk_bf16(zv, 0.f) & 0xffffu);
}
__device__ __forceinline__ void phase_mixer(Frame& F, const Params& P, int l, bool last) {
    {
        LAS float* rpb = (LAS float*)(F.lds + RPB_OFF); for (int i = F.tid; i < 1860; i += NTHR) rpb[i] = P.in[I_RPB][l * 1860 + i] * 1.44269504089f;
        LAS f32x2* T = (LAS f32x2*)(F.lds + TW_OFF);
        if (F.tid < 512) { const int tb = F.tid >> 7, a = F.tid & 127; const float x = tb == 0 ? (float)a / 128.0f : (tb == 1 ? (float)a / 16384.0f : (tb == 2 ? (float)a / 256.0f : (float)a / 32768.0f));
            float s, cs; sincospif(2.0f * x, &s, &cs); T[F.tid] = (f32x2){cs, -s}; }
        __syncthreads();
    }
#ifndef MIXMASK
#define MIXMASK 63
#endif
    if (MIXMASK & 1) for (int c = F.bid; c < 256; c += F.G) hyena_unit(F, P, l, ((c & 7) << 5) | (c >> 3), false);
    if (MIXDUP & 1) for (int c = F.bid; c < 256; c += F.G) hyena_unit(F, P, l, c, true);
    if (MIXMASK & 2) if (!last) for (int rep_ = 0; rep_ <= ((MIXDUP >> 1) & 1); ++rep_) for (int c = F.bid; c < 256; c += F.G) { hyena_ctx_unit(F, P, l, c); __syncthreads(); }
    const int ntile = (last ? TL : MT) / 64;
    if (MIXMASK & 4) for (int rep_ = 0; rep_ <= ((MIXDUP >> 2) & 1); ++rep_) conformer_tiles(F, P, l, (F.bid + F.G / 2) % F.G, ntile);
    if (MIXMASK & 8) for (int rep_ = 0; rep_ <= ((MIXDUP >> 3) & 1); ++rep_) for (int u = (F.bid + F.G / 4) % F.G; u < ntile; u += F.G) shortconv_unit(F, P, l, u * 64);
    const int gw = F.bid * NWAVES + F.wave, NGW = F.G * NWAVES;
    if (MIXMASK & 16) for (int rep_ = 0; rep_ <= ((MIXDUP >> 4) & 1); ++rep_) for (int task = F.bid; task < 256; task += F.G) {
        const int h = task & 3, b = task >> 7, rb = ((task >> 2) & 31) * 8;
        __syncthreads();
        attn_stage_ctx(F, b, h);
        __syncthreads();
#pragma unroll 1
        for (int it = 0; it < 4; ++it) { int wu = (b << 12) | ((rb + 2 * it + (F.wave >> 2)) << 4) | (h << 2) | (F.wave & 3); asm volatile("" : "+s"(wu));
            attn_wave_unit(F, wu, true, true); }
    }
    if (MIXMASK & 32) if (!last) for (int wu = gw; wu < 128; wu += NGW) attn_wave_unit(F, wu, false, false);
}

__global__ void __launch_bounds__(NTHR, 2) mk_fwd(Params P) {
    extern __shared__ __attribute__((aligned(16))) unsigned char lds_raw[];
    Frame F;
    const int wave0 = __builtin_amdgcn_readfirstlane(threadIdx.x >> 6);
    F.lds = (LAS unsigned char*)lds_raw; F.tid = threadIdx.x; F.lane = F.tid & 63; F.wave = __builtin_amdgcn_readfirstlane(F.tid >> 6); F.bid = blockIdx.x; F.G = gridDim.x; F.ws = P.ws;
    volatile LAS unsigned* MISC = (volatile LAS unsigned*)(F.lds + MISC_OFF);
    if (F.tid < 4) MISC[F.tid] = 0u;
    __syncthreads();
    XcdBarrier bar = xcd_barrier_post((unsigned*)(P.ws + WS_CTL) + 4096, MISC);
    const int lo = P.ph_lo, hi = P.ph_hi;
    int ph = 0;
#define PHASE_BEGIN if (ph >= lo && ph < hi) { { int t_; asm volatile("v_mbcnt_lo_u32_b32 %0, -1, 0\n\tv_mbcnt_hi_u32_b32 %0, -1, %0" : "=v"(t_)); t_ |= wave0 << 6; F.tid = t_; F.lane = t_ & 63; F.wave = __builtin_amdgcn_readfirstlane(t_ >> 6); size_t o_ = 0; asm volatile("" : "+s"(o_)); F.ws = P.ws + o_; }
#define PHASE_END   if (ph + 1 < hi) xcd_barrier(bar, F.tid); } ++ph;
#define MOD ((const float*)(F.ws + WS_MOD))
#define Hc ((const char*)(F.ws + WS_H))

    PHASE_BEGIN if (PHMASK & (1u << 0)) for (int rep_ = 0; rep_ <= (int)((DUPMASK >> 0) & 1u); ++rep_) { prologue_a(F, P); } PHASE_END
    PHASE_BEGIN if (PHMASK & (1u << 1)) for (int rep_ = 0; rep_ <= (int)((DUPMASK >> 1) & 1u); ++rep_) { phase_mod0(F, P); phase_filters(F, P, 0, true); } PHASE_END

    for (int l = 0; l < 2; ++l) {
        const bool last = (l == 1);
#define modl (MOD + (size_t)l * 3 * 9216)
#define xl ((l == 0) ? (const void*)P.in[I_X] : (const void*)P.out)
#define xc ((l == 0) ? P.in[I_CTX] : (const float*)(F.ws + WS_XC))
#define xcw ((const float*)(F.ws + WS_XC))
        PHASE_BEGIN if (PHMASK & (1u << 2)) for (int rep_ = 0; rep_ <= (int)((DUPMASK >> 2) & 1u); ++rep_) { { SchedPlain S{Hc, (const char*)(F.ws + WS_W1T) + (size_t)(l * 2 + 0) * NFF * D, 1024u, 1024u, 8, MT / 256, 22, F.G, F.bid};
            EpiFfnUp E{F.ws + WS_U}; pg8::gemm_phase<EpiFfnUp, SchedPlain, 1>(F.lds, S, E, F.tid); } } PHASE_END
        PHASE_BEGIN if (PHMASK & (1u << 3)) for (int rep_ = 0; rep_ <= (int)((DUPMASK >> 3) & 1u); ++rep_) { { SchedResid<5, 1, 6> S{(const char*)(F.ws + WS_U), (const char*)(F.ws + WS_W2T) + (size_t)(l * 2 + 0) * D * DFF, (unsigned)DFF, 22, F.G, F.bid, true, (const char*)(F.ws + WS_U) + (size_t)TL * DFF};
            EpiRes E{(bf16*)P.out, (l == 0) ? (const void*)P.in[I_X] : (const void*)(F.ws + WS_BRV), l != 0, modl + 2 * D, nullptr, 0.5f / W2_SCALE, (float*)(F.ws + WS_ES),
                (l != 0) ? (const float*)(F.ws + WS_LNS) : nullptr, P.in[I_PLG] + ((l + 1) % 2 * 3 + 2) * D, P.in[I_PLB] + ((l + 1) % 2 * 3 + 2) * D}; pg8::gemm_phase<EpiRes, SchedResid<5, 1, 6>, 1>(F.lds, S, E, F.tid); } } PHASE_END
        PHASE_BEGIN if (PHMASK & (1u << 4)) for (int rep_ = 0; rep_ <= (int)((DUPMASK >> 4) & 1u); ++rep_) { phase_ln(F, P, P.in[I_PLG] + (l * 3 + 0) * D, P.in[I_PLB] + (l * 3 + 0) * D, modl, 3, true, false, true, false, 5, 0.5f / W2_SCALE, modl + (size_t)2 * 9216 + 2 * D, nullptr, xc, true, (const bf16*)P.out); if (l == 1) phase_filters(F, P, 1, false); } PHASE_END
        PHASE_BEGIN if (PHMASK & (1u << 5)) for (int rep_ = 0; rep_ <= (int)((DUPMASK >> 5) & 1u); ++rep_) { { SchedInproj S{Hc, (const char*)(F.ws + WS_WIT) + (size_t)l * PIN * D * 2, MT / 256, F.G, F.bid};
            EpiInproj E{(const float*)(F.ws + WS_BIN) + l * PIN, F.ws};
            pg8::gemm_phase(F.lds, S, E, F.tid); } } PHASE_END
        PHASE_BEGIN if (PHMASK & (1u << 6)) for (int rep_ = 0; rep_ <= (int)((DUPMASK >> 6) & 1u); ++rep_) { phase_mixer(F, P, l, last); } PHASE_END
        const int Mx = last ? TL : MT;
        PHASE_BEGIN if (PHMASK & (1u << 7)) for (int rep_ = 0; rep_ <= (int)((DUPMASK >> 7) & 1u); ++rep_) { { SchedGateBr S{Hc, (const char*)(F.ws + WS_H8L), (const char*)(F.ws + WS_H8C), (const char*)(F.ws + WS_WIT) + ((size_t)l * PIN + NINP) * D * 2, (const char*)(F.ws + WS_BRV), (const char*)(F.ws + WS_WPT) + (size_t)l * 4 * D * 256 * 2, F.G, F.bid, !last};
            EpiGateBr E{(const float*)(F.ws + WS_BIN) + l * PIN + NINP, F.ws + WS_GS + (size_t)F.bid * 393216, (bf16*)(F.ws + WS_MG), (bf16*)(F.ws + WS_MI)}; pg8::gemm_phase<EpiGateBr, SchedGateBr, 2>(F.lds, S, E, F.tid); } } PHASE_END
        PHASE_BEGIN if (PHMASK & (1u << 8)) for (int rep_ = 0; rep_ <= (int)((DUPMASK >> 8) & 1u); ++rep_) { { SchedResid<4, 4> S{(const char*)(F.ws + WS_MG), (const char*)(F.ws + WS_WOT) + (size_t)l * D * D * 2, 2048u, 16, F.G, F.bid, !last, (const char*)(F.ws + WS_MI)};
            EpiRes E{(bf16*)(F.ws + WS_BRV), (const void*)P.out, true, modl + 5 * D, P.in[I_BOUT] + l * D, 1.0f, (float*)(F.ws + WS_ES), (const float*)(F.ws + WS_LNS), P.in[I_PLG] + (l * 3 + 0) * D, P.in[I_PLB] + (l * 3 + 0) * D}; pg8::gemm_phase(F.lds, S, E, F.tid); } } PHASE_END
        PHASE_BEGIN if (PHMASK & (1u << 9)) for (int rep_ = 0; rep_ <= (int)((DUPMASK >> 9) & 1u); ++rep_) { phase_ln(F, P, P.in[I_PLG] + (l * 3 + 1) * D, P.in[I_PLB] + (l * 3 + 1) * D, modl, 6, true, true, false, false, last ? 0 : 16, 1.0f, modl + (size_t)2 * 9216 + 5 * D, P.in[I_BOUT] + l * D, xcw, true, (const bf16*)(F.ws + WS_BRV)); } PHASE_END
        PHASE_BEGIN if (PHMASK & (1u << 10)) for (int rep_ = 0; rep_ <= (int)((DUPMASK >> 10) & 1u); ++rep_) { { SchedPlain S{Hc, (const char*)(F.ws + WS_W1T) + (size_t)(l * 2 + 1) * NFF * D, 1024u, 1024u, 8, Mx / 256, 22, F.G, F.bid};
            EpiFfnUp E{F.ws + WS_U}; pg8::gemm_phase<EpiFfnUp, SchedPlain, 1>(F.lds, S, E, F.tid); } } PHASE_END
        PHASE_BEGIN if (PHMASK & (1u << 11)) for (int rep_ = 0; rep_ <= (int)((DUPMASK >> 11) & 1u); ++rep_) { { SchedResid<5, 1, 6> S{(const char*)(F.ws + WS_U), (const char*)(F.ws + WS_W2T) + (size_t)(l * 2 + 1) * D * DFF, (unsigned)DFF, 22, F.G, F.bid, !last, (const char*)(F.ws + WS_U) + (size_t)TL * DFF};
            EpiRes E{(bf16*)(F.ws + WS_BRV), (const void*)(F.ws + WS_BRV), true, modl + 8 * D, nullptr, 0.5f / W2_SCALE, (float*)(F.ws + WS_ES), (const float*)(F.ws + WS_LNS), P.in[I_PLG] + (l * 3 + 1) * D, P.in[I_PLB] + (l * 3 + 1) * D}; pg8::gemm_phase<EpiRes, SchedResid<5, 1, 6>, 1>(F.lds, S, E, F.tid); } } PHASE_END
        PHASE_BEGIN if (PHMASK & (1u << 12)) for (int rep_ = 0; rep_ <= (int)((DUPMASK >> 12) & 1u); ++rep_) { phase_ln(F, P, P.in[I_PLG] + (l * 3 + 2) * D, P.in[I_PLB] + (l * 3 + 2) * D, MOD + (size_t)3 * 9216  , 0, !last, true, false, last, last ? 0 : 5, 0.5f / W2_SCALE, modl + (size_t)2 * 9216 + 8 * D, nullptr, xcw, !last, (const bf16*)(F.ws + WS_BRV)); } PHASE_END
    }
#undef MOD
#undef Hc
#undef modl
#undef xcw
#undef xc
#undef xl
#undef PHASE_BEGIN
#undef PHASE_END
}

#ifndef MK_N_LAUNCHES
#define MK_N_LAUNCHES 1
#endif
constexpr int N_PHASES = 2 + 2 * 11;
extern "C" void kernel_launch(void* const* d_in, const int* in_sizes, int n_in, void* d_out, int out_size, void* d_ws, size_t ws_size, hipStream_t stream) {
    static int grid = 0;
    if (grid == 0) {
        if (n_in != 33 || out_size != TL * D || ws_size < WS_TOTAL) { fprintf(stderr, "kernel_launch: unexpected shapes (n_in %d out %d ws %zu)\n", n_in, out_size, ws_size); grid = -1; return; }
        int dev = 0, cus = 0;
        if (hipGetDevice(&dev) != hipSuccess || hipDeviceGetAttribute(&cus, hipDeviceAttributeMultiprocessorCount, dev) != hipSuccess) { grid = -1; return; }
        if (hipFuncSetAttribute((const void*)mk_fwd, hipFuncAttributeMaxDynamicSharedMemorySize, LDS_BYTES) != hipSuccess) { fprintf(stderr, "kernel_launch: hipFuncSetAttribute failed\n"); grid = -1; return; }
        int per_cu = 0;
        if (hipOccupancyMaxActiveBlocksPerMultiprocessor(&per_cu, (const void*)mk_fwd, NTHR, LDS_BYTES) != hipSuccess || per_cu < 1) fprintf(stderr, "kernel_launch: occupancy query says %d\n", per_cu);
        (void)hipGetLastError();
        grid = cus;
    }
    if (grid < 0) return;
    (void)hipMemsetAsync((char*)d_ws + WS_CTL, 0, CTL_BYTES, stream);
    Params p{};
    for (int i = 0; i < 33; ++i) p.in[i] = (const float*)d_in[i];
    p.out = (float*)d_out; p.ws = (unsigned char*)d_ws;
#if MK_N_LAUNCHES == 1
    p.ph_lo = 0; p.ph_hi = N_PHASES;
    hipLaunchKernelGGL(mk_fwd, dim3(grid), dim3(NTHR), LDS_BYTES, stream, p);
#else
    for (int i = 0; i < N_PHASES; ++i) { p.ph_lo = i; p.ph_hi = i + 1; hipLaunchKernelGGL(mk_fwd, dim3(grid), dim3(NTHR), LDS_BYTES, stream, p); }
#endif
}
```

```cpp
#include <hip/hip_runtime.h>
#include <cstdio>
#include <cstdint>

#ifndef PHMASK
#define PHMASK 0xFFFFu
#endif
#ifndef DUPMASK
#define DUPMASK 0u
#endif
#ifndef FFTPROBE
#define FFTPROBE 0
#endif
#ifndef EPIDUP
#define EPIDUP 0
#endif
#ifndef MIXDUP
#define MIXDUP 0
#endif
#define LAS __attribute__((address_space(3)))
typedef unsigned short bf16;
typedef short bf16x8 __attribute__((ext_vector_type(8)));
typedef float f32x4 __attribute__((ext_vector_type(4)));
typedef float f32x2 __attribute__((ext_vector_type(2)));
typedef unsigned u32x4 __attribute__((ext_vector_type(4)));
typedef unsigned u32x2 __attribute__((ext_vector_type(2)));

constexpr int D = 1024, SEQ = 16384, TL = 32768, CTXL = 256, TC = 512, MT = TL + TC;
constexpr int DFF = 2816, NFF = 2 * DFF, PIN = 6912, NINP = 2816, NMOD = 9;
constexpr int WA = 256;
constexpr float LN_EPS = 1e-5f, ALPHA = 1.41421356237f, ATT_SCALE = 0.125f;
constexpr int NWAVES = 8, NTHR = 512;

constexpr size_t MiB = 1u << 20;
constexpr size_t WS_CTL = 0, CTL_BYTES = 1 * MiB;
constexpr size_t WS_MOD = 1 * MiB;
constexpr size_t WS_BIN = WS_MOD + 256 * 1024;
constexpr size_t WS_W3T = WS_BIN + 64 * 1024;
constexpr size_t WS_XC = 2 * MiB;
constexpr size_t WS_W1T = 4 * MiB;
constexpr size_t WS_W2T = WS_W1T + (size_t)4 * NFF * D * 2;
constexpr size_t WS_WIT = WS_W2T + (size_t)4 * D * DFF * 2;
constexpr size_t WS_WPT = WS_WIT + (size_t)2 * PIN * D * 2;
constexpr size_t WS_WOT = WS_WPT + (size_t)8 * D * 256 * 2;
constexpr size_t WS_H = WS_WOT + (size_t)2 * D * D * 2;
constexpr size_t WS_BRV = WS_H + (size_t)MT * D * 2;
constexpr size_t WS_FILT = WS_BRV + (size_t)MT * D * 2;
constexpr size_t WS_FILTC = WS_FILT + (size_t)4 * 256 * SEQ * 4;
constexpr size_t WS_H8L = WS_FILT + 32 * MiB;
constexpr size_t WS_LNS = WS_CTL + 64 * 1024;
constexpr size_t WS_H8C = WS_CTL + 512 * 1024;
constexpr size_t WS_U = WS_FILTC + (size_t)4 * 256 * 256 * 4;
constexpr size_t SZ256 = (size_t)MT * 256 * 2;
constexpr size_t WS_UA = WS_U, WS_Q = WS_U + SZ256, WS_K = WS_U + 2 * SZ256, WS_SB = WS_U + 3 * SZ256, WS_W = WS_U + 4 * SZ256;
constexpr size_t WS_VT = WS_U + 5 * SZ256;
constexpr size_t WS_HT = WS_U + 6 * SZ256;
constexpr size_t WS_KSCR = WS_U + 9 * SZ256;
constexpr size_t WS_MG = WS_U;
constexpr size_t WS_GS = WS_U + 4 * SZ256;
constexpr size_t WS_MI = WS_GS + (size_t)256 * 393216;
constexpr size_t WS_END = WS_U + (size_t)MT * DFF * 2;
static_assert(WS_KSCR + (size_t)256 * 131072 <= WS_END, "kscr");
static_assert(WS_MI + (size_t)4 * TC * D * 2 <= WS_END, "gs/mi");
constexpr size_t WS_ES = WS_END;
constexpr size_t WS_TOTAL = WS_ES + (size_t)256 * 131072;
static_assert(WS_TOTAL <= 512 * MiB, "ws");
static_assert(WS_BIN + 2 * PIN * 4 <= WS_W3T && WS_W3T + 2 * 1024 * 64 * 2 <= WS_XC && WS_MOD + 2 * 3 * 9216 * 4 <= WS_BIN, "small");

constexpr int RING_BYTES = 131072;
constexpr int FFT_BYTES = 133120;
constexpr int TW_OFF = FFT_BYTES;
constexpr int RPB_OFF = TW_OFF + 4096;
constexpr int RED_OFF = RPB_OFF + 7680;
constexpr int MISC_OFF = RED_OFF + 256;
constexpr int LDS_BYTES = 147456;
static_assert(MISC_OFF + 64 <= LDS_BYTES, "lds");

typedef __bf16 bf16x2_t __attribute__((ext_vector_type(2)));
__device__ __forceinline__ unsigned cvt_pk_bf16(float lo, float hi) { const f32x2 v = {lo, hi}; const bf16x2_t b = __builtin_convertvector(v, bf16x2_t); return __builtin_bit_cast(unsigned, b); }
typedef int v8i __attribute__((ext_vector_type(8)));
typedef int i32x4 __attribute__((ext_vector_type(4)));
__device__ __forceinline__ float sat8(float x) { return __builtin_amdgcn_fmed3f(x, -448.0f, 448.0f); }
__device__ __forceinline__ unsigned pk_fp8x4(float a, float b, float c, float d) { int p = 0; p = __builtin_amdgcn_cvt_pk_fp8_f32(sat8(a), sat8(b), p, false); p = __builtin_amdgcn_cvt_pk_fp8_f32(sat8(c), sat8(d), p, true); return (unsigned)p; }
constexpr float W1_SCALE = 32.0f, W2_SCALE = 64.0f;
__device__ __forceinline__ float bf2f(unsigned short b) { return __uint_as_float(((unsigned)b) << 16); }
__device__ __forceinline__ float bflo(unsigned w) { return __uint_as_float(w << 16); }
__device__ __forceinline__ float bfhi(unsigned w) { return __uint_as_float(w & 0xffff0000u); }
__device__ __forceinline__ float sigmoidf_(float x) { return __builtin_amdgcn_rcpf(1.0f + __builtin_amdgcn_exp2f(x * -1.44269504089f)); }
__device__ __forceinline__ float siluf_(float x) { return x * __builtin_amdgcn_rcpf(1.0f + __builtin_amdgcn_exp2f(x * -1.44269504089f)); }
__device__ __forceinline__ int lane_now() { int l_; asm volatile("v_mbcnt_lo_u32_b32 %0, -1, 0\n\tv_mbcnt_hi_u32_b32 %0, -1, %0" : "=v"(l_)); return l_; }
__device__ __forceinline__ float xrow_max(float v) {
    const unsigned a = __builtin_bit_cast(unsigned, v); auto r = __builtin_amdgcn_permlane16_swap(a, a, false, false);
    v = fmaxf(__builtin_bit_cast(float, (unsigned)r[0]), __builtin_bit_cast(float, (unsigned)r[1]));
    const unsigned b = __builtin_bit_cast(unsigned, v); auto q = __builtin_amdgcn_permlane32_swap(b, b, false, false);
    return fmaxf(__builtin_bit_cast(float, (unsigned)q[0]), __builtin_bit_cast(float, (unsigned)q[1]));
}
__device__ __forceinline__ float xrow_sum(float v) {
    const unsigned a = __builtin_bit_cast(unsigned, v); auto r = __builtin_amdgcn_permlane16_swap(a, a, false, false);
    v = __builtin_bit_cast(float, (unsigned)r[0]) + __builtin_bit_cast(float, (unsigned)r[1]);
    const unsigned b = __builtin_bit_cast(unsigned, v); auto q = __builtin_amdgcn_permlane32_swap(b, b, false, false);
    return __builtin_bit_cast(float, (unsigned)q[0]) + __builtin_bit_cast(float, (unsigned)q[1]);
}
__device__ __forceinline__ float shx(float v, int o, int lane) { return __builtin_bit_cast(float, __builtin_amdgcn_ds_bpermute((lane ^ o) << 2, __builtin_bit_cast(int, v))); }
#define DPP_F(v_, ctrl_) __builtin_bit_cast(float, __builtin_amdgcn_update_dpp(0, __builtin_bit_cast(int, (v_)), (ctrl_), 0xF, 0xF, true))
__device__ __forceinline__ float wave_sum(float v) {
    v += DPP_F(v, 0xB1);
    v += DPP_F(v, 0x4E);
    v += DPP_F(v, 0x141);
    v += DPP_F(v, 0x140);
    const int iv = __builtin_bit_cast(int, v);
    const float r0 = __builtin_bit_cast(float, __builtin_amdgcn_readlane(iv, 0)), r1 = __builtin_bit_cast(float, __builtin_amdgcn_readlane(iv, 16)),
                r2 = __builtin_bit_cast(float, __builtin_amdgcn_readlane(iv, 32)), r3 = __builtin_bit_cast(float, __builtin_amdgcn_readlane(iv, 48));
    return (r0 + r1) + (r2 + r3);
}
#define LDS_WAIT() asm volatile("s_waitcnt lgkmcnt(0)" ::: "memory")

#define XB_TMO      128
#define XB_XCNT(j)  (256  + 64 * (j))
#define XB_XSUB(j)  (1280 + 64 * (j))
#define XB_XGEN(j)  (2304 + 64 * (j))
#define XB_TOP      3328
#define XB_TOPGEN   3392
#define XCD_BAR_WORDS 3456
#define XB_SPIN_CAP (1u << 20)
__device__ __forceinline__ unsigned xb_ld(unsigned* p)              { return __hip_atomic_load(p, __ATOMIC_RELAXED, __HIP_MEMORY_SCOPE_AGENT); }
__device__ __forceinline__ unsigned xb_add(unsigned* p, unsigned v) { return __hip_atomic_fetch_add(p, v, __ATOMIC_RELAXED, __HIP_MEMORY_SCOPE_AGENT); }
__device__ __forceinline__ unsigned xb_xcc_id() { return (unsigned)__builtin_amdgcn_s_getreg((3 << 11) | 20) & 0xFu; }
#define XB_SPIN(cond, bar) do { unsigned _sp = 0; while (cond) { __builtin_amdgcn_s_sleep(1); \
    if ((++_sp & 255u) == 0u) { if (xb_ld(&(bar)[XB_TMO])) break; if (_sp > XB_SPIN_CAP) { atomicAdd(&(bar)[XB_TMO], 1u); break; } } } } while (0)
struct XcdBarrier { unsigned* bar; unsigned x; volatile LAS unsigned* st; };
__device__ __forceinline__ XcdBarrier xcd_barrier_post(unsigned* bar, volatile LAS unsigned* st) {
    XcdBarrier b; b.bar = bar; b.x = xb_xcc_id(); b.st = st;
    if (threadIdx.x == 0) (void)xb_add(&bar[XB_XCNT(b.x)], 1u);
    return b;
}
__device__ __forceinline__ void xcd_barrier_complete(unsigned* bar, unsigned x, unsigned& nloc, unsigned& nx) {
    const unsigned G = gridDim.x * gridDim.y * gridDim.z;
    unsigned sum, cnt, mine, sp = 0u;
    for (;;) {
        sum = 0u; cnt = 0u; mine = 0u;
#pragma unroll
        for (unsigned j = 0; j < 16; ++j) { const unsigned c = xb_ld(&bar[XB_XCNT(j)]); sum += c; cnt += (c > 0u) ? 1u : 0u; mine = (j == x) ? c : mine; }
        if (sum == G) break;
        __builtin_amdgcn_s_sleep(1);
        if ((++sp & 255u) == 0u) { if (xb_ld(&bar[XB_TMO])) break; if (sp > XB_SPIN_CAP) { atomicAdd(&bar[XB_TMO], 1u); break; } }
    }
    nloc = mine > 0u ? mine : 1u; nx = cnt > 0u ? cnt : 1u;
}
__device__ __forceinline__ void xcd_barrier(const XcdBarrier& b, int tid) {
    asm volatile("s_waitcnt vmcnt(0)" ::: "memory");
    __syncthreads();
    if (tid == 0) {
        unsigned* bar = b.bar;
        __builtin_amdgcn_s_waitcnt(0);
        unsigned nloc = b.st[0], nx = b.st[1];
        if (nloc == 0u) { xcd_barrier_complete(bar, b.x, nloc, nx); b.st[0] = nloc; b.st[1] = nx; }
        const unsigned old = xb_add(&bar[XB_XSUB(b.x)], 1u);
        const unsigned gen = old / nloc;
        if (old + 1u == (gen + 1u) * nloc) {
            __builtin_amdgcn_fence(__ATOMIC_RELEASE, "agent");
            asm volatile("s_waitcnt vmcnt(0)" ::: "memory");
            const unsigned og = xb_add(&bar[XB_TOP], 1u);
            const unsigned tg = og / nx;
            if (og + 1u == (tg + 1u) * nx) xb_add(&bar[XB_TOPGEN], 1u);
            else XB_SPIN(xb_ld(&bar[XB_TOPGEN]) == tg, bar);
            __builtin_amdgcn_fence(__ATOMIC_ACQUIRE, "agent");
            xb_add(&bar[XB_XGEN(b.x)], 1u);
            asm volatile("s_waitcnt vmcnt(0)" ::: "memory");
        } else {
            XB_SPIN(xb_ld(&bar[XB_XGEN(b.x)]) == gen, bar);
            __builtin_amdgcn_fence(__ATOMIC_ACQUIRE, "agent");
            asm volatile("s_waitcnt vmcnt(0)" ::: "memory");
        }
    }
    __syncthreads();
}

namespace pg8 {
constexpr int BM = 256, BK = 64, HALF = 128, HTB = HALF * BK * 2, NXCD = 8, WGM = 8;
__host__ __device__ __forceinline__ int lds_byte(int r, int c) { const int st = (r >> 4) * 2 + (c >> 5), rr = r & 15, cc = c & 31, ob = rr * 64 + cc * 2; return st * 1024 + (ob ^ (((ob >> 9) & 1) << 5)); }
__host__ __device__ __forceinline__ void stage_rc(int b, int& R, int& C) { const int st = b / 1024, sb = b % 1024, swz = sb ^ (((sb >> 9) & 1) << 5); R = (st >> 1) * 16 + swz / 64; C = (st & 1) * 32 + (swz % 64) / 2; }
__host__ __device__ __forceinline__ int perm32(int rho) { const int n = rho >> 4, i = rho & 15; return 8 * (i >> 2) + 4 * n + (i & 3); }

struct GUnit { const char* A; const char* B; unsigned lda, ldb; int nt; int pm, pn, kind; bool f8; };

__device__ __forceinline__ bool static_tile(int i, int G, int c, int nM, int nN, int& pm, int& pn) {
    const int nwg = nM * nN; const long L = (long)i * G + c; if (L >= nwg) return false;
    int wgid = (int)L; { const int q = nwg / NXCD, r = nwg % NXCD, xcd = wgid % NXCD, off = wgid / NXCD; wgid = (xcd < r ? xcd * (q + 1) : r * (q + 1) + (xcd - r) * q) + off; }
    const int nig = WGM * nN, gid = wgid / nig, fm = gid * WGM, gsz = (nM - fm) < WGM ? (nM - fm) : WGM;
    pm = fm + ((wgid % nig) % gsz); pn = (wgid % nig) / gsz; return true;
}

template <class Epi, class Sched, int F8M = 0  >
__device__ __forceinline__ void gemm_phase(LAS unsigned char* lds, const Sched& S, const Epi& E, int tid_in) {
    int tid_ = tid_in; asm volatile("" : "+v"(tid_));
    const int tid = tid_, wid = __builtin_amdgcn_readfirstlane(tid >> 6), lane = tid & 63, wr = wid >> 2, wc = wid & 3, fr = lane & 15, fq = lane >> 4;
    unsigned RA[2], RB[2], CC[2];
#pragma unroll
    for (int i = 0; i < 2; ++i) { int R, C; stage_rc(tid * 16 + i * 8192, R, C); RA[i] = (unsigned)R; RB[i] = (unsigned)((R & ~31) + perm32(R & 31)); CC[i] = (unsigned)C * 2u; }
    const size_t kstep = (size_t)(BK * 2);
    const unsigned ldsw = (unsigned)wid * 1024u;
#define PG8_SA(b, h) (((b) * 2 + (h)) * HTB)
#define PG8_SB(b, h) ((4 + (b) * 2 + (h)) * HTB)
#define PG8_STAGE(bufoff, gbase, RR, ld) do { _Pragma("unroll") for (int _i = 0; _i < 2; ++_i) \
        __builtin_amdgcn_global_load_lds((const unsigned*)((const char*)(gbase) + ((RR)[_i] * (ld) + CC[_i])), (LAS unsigned*)(lds + (bufoff) + ldsw + _i * 8192), 16, 0, 0); } while (0)
#define PG8_LDA(F8C, dst, b, h) do { _Pragma("unroll") for (int m = 0; m < 4; ++m) { dst[m][0] = *(const LAS i32x4*)(lds + PG8_SA(b, h) + ao0 + m * 2048); dst[m][1] = *(const LAS i32x4*)(lds + PG8_SA(b, h) + ao1 + m * 2048); } } while (0)
#define PG8_LDB(F8C, dst, b, h) do { _Pragma("unroll") for (int n = 0; n < 2; ++n) { dst[n][0] = *(const LAS i32x4*)(lds + PG8_SB(b, h) + bo0 + n * 2048); dst[n][1] = *(const LAS i32x4*)(lds + PG8_SB(b, h) + bo1 + n * 2048); } } while (0)
#define PG8_V8(x) __builtin_shufflevector((x)[0], (x)[1], 0, 1, 2, 3, 4, 5, 6, 7)
#define PG8_MMA(F8C, ai, bj, At, Bt) do { __builtin_amdgcn_s_setprio(1); if constexpr (F8C) { _Pragma("unroll") for (int m = 0; m < 4; ++m) _Pragma("unroll") for (int n = 0; n < 2; ++n) \
            { const v8i b8_ = PG8_V8(Bt[n]), a8_ = PG8_V8(At[m]); asm volatile("v_mfma_scale_f32_16x16x128_f8f6f4 %0, %1, %2, %0, %3, %3 op_sel_hi:[0,0,0]" : "+v"(acc[ai][bj][m][n]) : "v"(b8_), "v"(a8_), "v"(one_scale)); } } \
        else { _Pragma("unroll") for (int m = 0; m < 4; ++m) _Pragma("unroll") for (int n = 0; n < 2; ++n) _Pragma("unroll") for (int k = 0; k < 2; ++k) \
            acc[ai][bj][m][n] = __builtin_amdgcn_mfma_f32_16x16x32_bf16(__builtin_bit_cast(bf16x8, Bt[n][k]), __builtin_bit_cast(bf16x8, At[m][k]), acc[ai][bj][m][n], 0, 0, 0); } __builtin_amdgcn_s_setprio(0); } while (0)
#define PG8_TRIP(F8C, WN) { \
            const bool last = (t == nt - 2); \
            const char* a1 = cA + (size_t)(t + 1) * kstep; \
            const char* a2 = last ? nA : cA + (size_t)(t + 2) * kstep; const char* b2 = last ? nB : cB + (size_t)(t + 2) * kstep; \
            const char* a3 = a2 + kstep; const char* b3 = b2 + kstep; \
            const unsigned xldA = last ? nldA : ldA, xldB = last ? nldB : ldB; const size_t xhsA = last ? nhsA : hsA, xhsB = last ? nhsB : hsB; \
            PG8_LDB(F8C, B0, 0, 0); PG8_LDB(F8C, B1, 0, 1); PG8_SCHED; PG8_LDA(F8C, At, 0, 0); PG8_STAGE(PG8_SA(1, 1), a1 + hsA, RA, ldA); \
            PG8_WAIT_V(WN); PG8_WAIT_L(0); PG8_BAR; PG8_MMA(F8C, 0, 0, At, B0); PG8_MMA(F8C, 0, 1, At, B1); PG8_BAR; PG8_SCHED; \
            PG8_LDA(F8C, At, 0, 1); PG8_STAGE(PG8_SB(0, 0), b2, RB, xldB); PG8_STAGE(PG8_SB(0, 1), b2 + xhsB, RB, xldB); PG8_STAGE(PG8_SA(0, 0), a2, RA, xldA); \
            PG8_WAIT_V(WN); PG8_WAIT_L(0); PG8_BAR; PG8_MMA(F8C, 1, 0, At, B0); PG8_MMA(F8C, 1, 1, At, B1); PG8_BAR; PG8_SCHED; \
            PG8_LDB(F8C, B0, 1, 0); PG8_LDB(F8C, B1, 1, 1); PG8_SCHED; PG8_LDA(F8C, At, 1, 0); PG8_STAGE(PG8_SA(0, 1), a2 + xhsA, RA, xldA); \
            PG8_WAIT_V(8); PG8_WAIT_L(0); PG8_BAR; PG8_MMA(F8C, 0, 0, At, B0); PG8_MMA(F8C, 0, 1, At, B1); PG8_BAR; PG8_SCHED; \
            PG8_LDA(F8C, At, 1, 1); PG8_STAGE(PG8_SB(1, 0), b3, RB, xldB); PG8_STAGE(PG8_SB(1, 1), b3 + xhsB, RB, xldB); PG8_STAGE(PG8_SA(1, 0), a3, RA, xldA); \
            PG8_WAIT_V(8); PG8_WAIT_L(0); PG8_BAR; PG8_MMA(F8C, 1, 0, At, B0); PG8_MMA(F8C, 1, 1, At, B1); PG8_BAR; PG8_SCHED; \
        }
#define PG8_KLOOP(F8C) const int ln_ = lane_now();   \
        const int fr_ = ln_ & 15, fq_ = ln_ >> 4; \
        const int ao0 = lds_byte(wr * 64 + fr_, (F8C) ? 16 * fq_ : 8 * fq_), ao1 = (F8C) ? lds_byte(wr * 64 + fr_, 16 * fq_ + 8) : ao0 + 1024; \
        const int bo0 = lds_byte(wc * 32 + fr_, (F8C) ? 16 * fq_ : 8 * fq_), bo1 = (F8C) ? lds_byte(wc * 32 + fr_, 16 * fq_ + 8) : bo0 + 1024; \
        int t = 0; \
        if constexpr (Epi::NST == 8) { if (ui > 0) { PG8_TRIP(F8C, 16) t = 2; } } \
        for (; t < nt; t += 2) PG8_TRIP(F8C, 8)
#define PG8_WAIT_V(n) asm volatile("s_waitcnt vmcnt(" #n ")" ::: "memory")
#define PG8_WAIT_L(n) asm volatile("s_waitcnt lgkmcnt(" #n ")" ::: "memory")
#define PG8_BAR __builtin_amdgcn_s_barrier()
#define PG8_SCHED __builtin_amdgcn_sched_barrier(0)
    GUnit cur, nxt; int ui = 0;
    if (!S.next(0, cur)) return;
    f32x4 acc[2][2][4][2];
#pragma unroll
    for (int a = 0; a < 2; ++a)
#pragma unroll
        for (int b = 0; b < 2; ++b)
#pragma unroll
            for (int m = 0; m < 4; ++m)
#pragma unroll
                for (int n = 0; n < 2; ++n) acc[a][b][m][n] = (f32x4){0.f, 0.f, 0.f, 0.f};
    i32x4 At[4][2], B0[2][2], B1[2][2];
    int one_scale = 0x7F7F7F7F; asm volatile("" : "+v"(one_scale));
    const char* cA = cur.A; const char* cB = cur.B;
    unsigned ldA = cur.lda, ldB = cur.ldb; size_t hsA = (size_t)HALF * ldA, hsB = (size_t)HALF * ldB;
    PG8_STAGE(PG8_SB(0, 0), cB, RB, ldB); PG8_STAGE(PG8_SB(0, 1), cB + hsB, RB, ldB); PG8_STAGE(PG8_SA(0, 0), cA, RA, ldA); PG8_STAGE(PG8_SA(0, 1), cA + hsA, RA, ldA);
    if (wr == 1) PG8_BAR;
    PG8_WAIT_V(2); PG8_BAR;
    PG8_STAGE(PG8_SB(1, 0), cB + kstep, RB, ldB); PG8_STAGE(PG8_SA(1, 0), cA + kstep, RA, ldA); PG8_STAGE(PG8_SB(1, 1), cB + hsB + kstep, RB, ldB);
    PG8_WAIT_V(6); PG8_BAR;
    for (;;) {
        const bool has_next = S.next(ui + 1, nxt);
        const char* nA = has_next ? nxt.A : cA; const char* nB = has_next ? nxt.B : cB;
        const unsigned nldA = has_next ? nxt.lda : ldA, nldB = has_next ? nxt.ldb : ldB;
        const size_t nhsA = (size_t)HALF * nldA, nhsB = (size_t)HALF * nldB;
        const int nt = cur.nt;
        if constexpr (F8M == 2) { if (cur.f8) { PG8_KLOOP(true) } else { PG8_KLOOP(false) } }
        else if constexpr (F8M == 1) { PG8_KLOOP(true) }
        else { PG8_KLOOP(false) }
        if (wr == 0) PG8_BAR;
        if constexpr (F8M != 0) asm volatile("s_nop 15\n\ts_nop 15" ::: "memory");
        { const int le_ = lane_now(); E(acc, cur, (wid << 6) | le_, wr, wc, le_ & 15, le_ >> 4); }
        if (!has_next) break;
#pragma unroll
        for (int a = 0; a < 2; ++a)
#pragma unroll
            for (int b = 0; b < 2; ++b)
#pragma unroll
                for (int m = 0; m < 4; ++m)
#pragma unroll
                    for (int n = 0; n < 2; ++n) acc[a][b][m][n] = (f32x4){0.f, 0.f, 0.f, 0.f};
        cur = nxt; cA = nA; cB = nB; hsA = nhsA; hsB = nhsB; ldA = nldA; ldB = nldB; ++ui;
        if (wr == 1) PG8_BAR;
    }
    PG8_WAIT_V(0);
    PG8_BAR;
#undef PG8_SA
#undef PG8_SB
#undef PG8_STAGE
#undef PG8_LDA
#undef PG8_KLOOP
#undef PG8_TRIP
#undef PG8_V8
#undef PG8_LDB
#undef PG8_MMA
#undef PG8_WAIT_V
#undef PG8_WAIT_L
#undef PG8_BAR
#undef PG8_SCHED
}
}
using pg8::GUnit;
typedef f32x4 Acc[2][2][4][2];

struct Params {
    const float* in[33];
    float* out;
    unsigned char* ws;
    int ph_lo, ph_hi;
};
enum { I_X = 0, I_C, I_CTX, I_CCTX, I_WMOD, I_BMOD, I_PLG, I_PLB, I_FWI, I_FWO, I_WIN, I_BIN, I_CDW, I_CDB, I_CLG, I_CLB, I_CWP, I_RPB, I_NWP, I_SCW, I_SWP,
       I_HSW, I_HSB, I_HW1, I_HB1, I_HW2, I_HB2, I_HFQ, I_HW3, I_HBI, I_HWP, I_WOUT, I_BOUT };

__device__ __forceinline__ int row_grp(int pm) { return pm < 64 ? 0 : (pm < 128 ? 1 : 2); }

struct SchedPlain {
    const char* A; const char* B; unsigned lda, ldb; int nt, nM, nN, G, c;
    __device__ __forceinline__ bool next(int i, GUnit& u) const {
        int pm, pn; if (!pg8::static_tile(i, G, c, nM, nN, pm, pn)) return false;
        u.A = A + (size_t)pm * 256 * lda; u.B = B + (size_t)pn * 256 * ldb; u.lda = lda; u.ldb = ldb; u.nt = nt; u.pm = pm; u.pn = pn; u.kind = 0; u.f8 = true; return true;
    }
};
template <int NKS, int NSRC, int NTLAST = 4> struct SchedResid {
    const char* A; const char* B; unsigned ld; int nt, G, c; bool ctx; const char* Ac;
    __device__ __forceinline__ bool next(int i, GUnit& u) const {
        int pm, pn; u.lda = ld; u.ldb = ld; u.f8 = true;
        if (pg8::static_tile(i, G, c, TL / 256, 4, pm, pn)) { u.A = A + (size_t)pm * 256 * ld; u.B = B + (size_t)pn * 256 * ld; u.nt = nt; u.pm = pm; u.pn = pn; u.kind = 0; return true; }
        constexpr int NK = NKS * NSRC;
        const int j = i * G + c - (TL / 256) * 4; if (!ctx || j < 0 || j >= 8 * NK) return false;
        const int panel = j / (4 * NK), rem = j % (4 * NK), kk = rem % NK, src = kk / NKS, ks = kk % NKS; pn = rem / NK;
        u.A = Ac + ((size_t)src * TC + panel * 256) * ld + ks * 512; u.B = B + (size_t)pn * 256 * ld + ks * 512; u.nt = (ks == NKS - 1) ? NTLAST : 4; u.pm = TL / 256 + panel; u.pn = pn; u.kind = 1 + kk; return true;
    }
};
enum { KI_GLU = 0, KI_PLAIN = 1, KI_PAIR = 2, KI_TRANS = 3 };
struct SchedInproj {
    const char* H; const char* W; int nM, G, c;
    __device__ __forceinline__ bool next(int i, GUnit& u) const {
        int pm, pn; if (!pg8::static_tile(i, G, c, nM, 11, pm, pn)) return false;
        const char* a = H + (size_t)pm * 256 * 2048; const char* b = W + (size_t)pn * 256 * 2048;
        const bool tr = (pn == 4) || (pn >= 8);
        u.A = tr ? b : a; u.B = tr ? a : b; u.lda = 2048; u.ldb = 2048; u.nt = 16; u.pm = pm; u.pn = pn;
        u.f8 = false; u.kind = tr ? KI_TRANS : (pn < 2 ? KI_GLU : (pn == 6 || pn == 7 ? KI_PAIR : KI_PLAIN)); return true;
    }
};
struct SchedGateBr {
    const char* HB  ; const char* H; const char* HC  ; const char* WG  ; const char* BR; const char* WP; int G, c; bool ctx;
    __device__ __forceinline__ bool next(int i, GUnit& u) const {
        int pm, pn, j, br;
        if (pg8::static_tile(i >> 3, G, c, TL / 256, 4, pm, pn)) { j = i & 7; br = j >> 1; }
        else {
            const int ntl = ((TL / 256) * 4 - c + G - 1) / G, e = i - 8 * ntl;
            if (!ctx || c >= 32 || e < 0 || e > 1) return false;
            pm = TL / 256 + (c >> 4); pn = (c >> 2) & 3; br = c & 3; j = 8 + 2 * br + e;
        }
        if ((j & 1) == 0) { u.A = (pm < TL / 256) ? H + (size_t)pm * 256 * 1024 : HC + (size_t)(pm - TL / 256) * 256 * 1024; u.B = WG + (size_t)(br * 1024 + pn * 256) * 1024; u.lda = 1024; u.ldb = 1024; u.nt = 8; u.f8 = true; }
        else { u.A = BR + (size_t)br * SZ256 + (size_t)pm * 256 * 512; u.B = WP + (size_t)(br * 1024 + pn * 256) * 512; u.lda = 512; u.ldb = 512; u.nt = 4; u.f8 = false; }
        u.pm = pm; u.pn = pn; u.kind = j; return true;
    }
};

struct EpiFfnUp {
    static constexpr bool DUP_OK = true; static constexpr int NST = 8;
    unsigned char* U;
    __device__ __forceinline__ void operator()(const Acc& acc, const GUnit& u, int tid, int wr, int wc, int fr, int fq) const {
        const int row0 = u.pm * 256 + wr * 64 + fr, col0 = u.pn * 128 + wc * 32 + 8 * fq;
        constexpr float IS = 1.0f / W1_SCALE;
#pragma unroll
        for (int ai = 0; ai < 2; ++ai)
#pragma unroll
            for (int m = 0; m < 4; ++m) {
                const f32x4 a0 = acc[ai][0][m][0] * IS, a1 = acc[ai][0][m][1] * IS, g0 = acc[ai][1][m][0] * IS, g1 = acc[ai][1][m][1] * IS;
                u32x2 w; w.x = pk_fp8x4(siluf_(g0[0]) * a0[0], siluf_(g0[1]) * a0[1], siluf_(g0[2]) * a0[2], siluf_(g0[3]) * a0[3]);
                w.y = pk_fp8x4(siluf_(g1[0]) * a1[0], siluf_(g1[1]) * a1[1], siluf_(g1[2]) * a1[2], siluf_(g1[3]) * a1[3]);
                *(u32x2*)(U + (size_t)(row0 + ai * 128 + m * 16) * DFF + col0) = w;
            }
    }
};
struct EpiRes {
    static constexpr bool DUP_OK = false; static constexpr int NST = 0;
    bf16* V; const void* xl; bool xbf  ; const float* modl  ; const float* bias; float coef; float* part;
    const float* xstat; const float* xg; const float* xbt;
    __device__ __forceinline__ void operator()(const Acc& acc, const GUnit& u, int tid, int wr, int wc, int fr, int fq) const {
        int row0 = u.pm * 256 + wr * 64 + fr, colt = u.pn * 256 + wc * 32 + 8 * fq; asm volatile("" : "+v"(row0), "+v"(colt));
        if (u.kind != 0) {
            float* pp = part + ((size_t)(u.kind - 1) * TC + (row0 - TL)) * D + colt;
#pragma unroll
            for (int ai = 0; ai < 2; ++ai)
#pragma unroll
                for (int m = 0; m < 4; ++m)
#pragma unroll
                    for (int bj = 0; bj < 2; ++bj) { float* q = pp + (size_t)(ai * 128 + m * 16) * D + bj * 128; *(f32x4*)q = acc[ai][bj][m][0]; *(f32x4*)(q + 4) = acc[ai][bj][m][1]; }
            return;
        }
        if (xstat) body_ln(acc, u, row0, colt); else if (xbf) body<true>(acc, u, row0, colt); else body<false>(acc, u, row0, colt);
    }
    template <bool XB> __device__ __forceinline__ void body(const Acc& acc, const GUnit& u, int row0, int colt) const {
        const float* mv = modl + (size_t)row_grp(u.pm) * 9216;
        f32x4 sc[2][2], bv[2][2];
#pragma unroll
        for (int bj = 0; bj < 2; ++bj)
#pragma unroll
            for (int n = 0; n < 2; ++n) { sc[bj][n] = *(const f32x4*)(mv + colt + bj * 128 + 4 * n) * coef;
                bv[bj][n] = bias ? *(const f32x4*)(bias + colt + bj * 128 + 4 * n) : (f32x4){0.f, 0.f, 0.f, 0.f}; }
#pragma unroll
        for (int ai = 0; ai < 2; ++ai) {
            bf16* vp = V + (size_t)(row0 + ai * 128) * D + colt;
            if constexpr (XB) {
                const bf16* xh = (const bf16*)xl + (size_t)(row0 + ai * 128) * D + colt;
                u32x4 xw[4][2];
#pragma unroll
                for (int m = 0; m < 4; ++m)
#pragma unroll
                    for (int bj = 0; bj < 2; ++bj) xw[m][bj] = *(const u32x4*)(xh + (size_t)(m * 16) * D + bj * 128);
#pragma unroll
                for (int m = 0; m < 4; ++m)
#pragma unroll
                    for (int bj = 0; bj < 2; ++bj) { const u32x4 w_ = xw[m][bj];
                        const f32x4 x0 = (f32x4){bflo(w_.x), bfhi(w_.x), bflo(w_.y), bfhi(w_.y)}, x1 = (f32x4){bflo(w_.z), bfhi(w_.z), bflo(w_.w), bfhi(w_.w)};
                        const f32x4 v0 = x0 * ALPHA + sc[bj][0] * (acc[ai][bj][m][0] + bv[bj][0]), v1 = x1 * ALPHA + sc[bj][1] * (acc[ai][bj][m][1] + bv[bj][1]);
                        u32x4 w; w.x = cvt_pk_bf16(v0[0], v0[1]); w.y = cvt_pk_bf16(v0[2], v0[3]); w.z = cvt_pk_bf16(v1[0], v1[1]); w.w = cvt_pk_bf16(v1[2], v1[3]);
                        *(u32x4*)(vp + (size_t)(m * 16) * D + bj * 128) = w; }
            } else {
                const float* xb = (const float*)xl + (size_t)(row0 + ai * 128) * D + colt;
#pragma unroll
                for (int mh = 0; mh < 2; ++mh) {
                    f32x4 xf[2][2][2];
#pragma unroll
                    for (int mm = 0; mm < 2; ++mm)
#pragma unroll
                        for (int bj = 0; bj < 2; ++bj) { const float* q = xb + (size_t)((mh * 2 + mm) * 16) * D + bj * 128; xf[mm][bj][0] = *(const f32x4*)q; xf[mm][bj][1] = *(const f32x4*)(q + 4); }
#pragma unroll
                    for (int mm = 0; mm < 2; ++mm)
#pragma unroll
                        for (int bj = 0; bj < 2; ++bj) { const int m = mh * 2 + mm;
                            const f32x4 v0 = xf[mm][bj][0] * ALPHA + sc[bj][0] * (acc[ai][bj][m][0] + bv[bj][0]), v1 = xf[mm][bj][1] * ALPHA + sc[bj][1] * (acc[ai][bj][m][1] + bv[bj][1]);
                            u32x4 w; w.x = cvt_pk_bf16(v0[0], v0[1]); w.y = cvt_pk_bf16(v0[2], v0[3]); w.z = cvt_pk_bf16(v1[0], v1[1]); w.w = cvt_pk_bf16(v1[2], v1[3]);
                            *(u32x4*)(vp + (size_t)(m * 16) * D + bj * 128) = w; }
                    asm volatile("" ::: "memory");
                }
            }
            asm volatile("" ::: "memory");
        }
    }
    __device__ __forceinline__ void body_ln(const Acc& acc, const GUnit& u, int row0, int colt) const {
        const float* mv = modl + (size_t)row_grp(u.pm) * 9216;
#pragma unroll
        for (int bj = 0; bj < 2; ++bj) {
            f32x4 sc[2], gg[2], bb[2], bv[2];
#pragma unroll
            for (int n = 0; n < 2; ++n) { sc[n] = *(const f32x4*)(mv + colt + bj * 128 + 4 * n) * coef; gg[n] = *(const f32x4*)(xg + colt + bj * 128 + 4 * n); bb[n] = *(const f32x4*)(xbt + colt + bj * 128 + 4 * n);
                bv[n] = bias ? *(const f32x4*)(bias + colt + bj * 128 + 4 * n) : (f32x4){0.f, 0.f, 0.f, 0.f}; }
#pragma unroll
            for (int ai = 0; ai < 2; ++ai) {
                bf16* vp = V + (size_t)(row0 + ai * 128) * D + colt + bj * 128; const bf16* xp = (const bf16*)xl + (size_t)(row0 + ai * 128) * D + colt + bj * 128;
                u32x4 xw[4]; f32x2 st[4];
#pragma unroll
                for (int m = 0; m < 4; ++m) { st[m] = *(const f32x2*)(xstat + (size_t)(row0 + ai * 128 + m * 16) * 2); xw[m] = *(const u32x4*)(xp + (size_t)(m * 16) * D); }
#pragma unroll
                for (int m = 0; m < 4; ++m) { const u32x4 w_ = xw[m]; const float mu = st[m].x, rs = st[m].y;
                    const f32x4 x0 = ((f32x4){bflo(w_.x), bfhi(w_.x), bflo(w_.y), bfhi(w_.y)} - mu) * (gg[0] * rs) + bb[0], x1 = ((f32x4){bflo(w_.z), bfhi(w_.z), bflo(w_.w), bfhi(w_.w)} - mu) * (gg[1] * rs) + bb[1];
                    const f32x4 v0 = x0 * ALPHA + sc[0] * (acc[ai][bj][m][0] + bv[0]), v1 = x1 * ALPHA + sc[1] * (acc[ai][bj][m][1] + bv[1]);
                    u32x4 w; w.x = cvt_pk_bf16(v0[0], v0[1]); w.y = cvt_pk_bf16(v0[2], v0[3]); w.z = cvt_pk_bf16(v1[0], v1[1]); w.w = cvt_pk_bf16(v1[2], v1[3]);
                    *(u32x4*)(vp + (size_t)(m * 16) * D) = w; }
                asm volatile("" ::: "memory");
            }
        }
    }
};
struct EpiInproj {
    static constexpr bool DUP_OK = false; static constexpr int NST = 0;
    const float* bin;
    unsigned char* ws;
    __device__ __forceinline__ void operator()(const Acc& acc, const GUnit& u, int tid, int wr, int wc, int fr, int fq) const {
        bf16* const UA = (bf16*)(ws + WS_UA); bf16* const Q = (bf16*)(ws + WS_Q); bf16* const K = (bf16*)(ws + WS_K); bf16* const SB = (bf16*)(ws + WS_SB);
        bf16* const W = (bf16*)(ws + WS_W); bf16* const VT = (bf16*)(ws + WS_VT); bf16* const HT = (bf16*)(ws + WS_HT);
        int c8 = wc * 32 + 8 * fq; asm volatile("" : "+v"(c8));
        if (u.kind == KI_TRANS) {
            bf16* dst = (u.pn == 4) ? VT : HT + (size_t)(u.pn - 8) * 256 * MT;
            const int r0 = wr * 64 + fr;
#pragma unroll
            for (int ai = 0; ai < 2; ++ai)
#pragma unroll
                for (int m = 0; m < 4; ++m) {
                    const int r = r0 + ai * 128 + m * 16; const float b = bin[u.pn * 256 + r];
#pragma unroll
                    for (int bj = 0; bj < 2; ++bj) {
                        const f32x4 v0 = acc[ai][bj][m][0] + b, v1 = acc[ai][bj][m][1] + b;
                        u32x4 w; w.x = cvt_pk_bf16(v0[0], v0[1]); w.y = cvt_pk_bf16(v0[2], v0[3]); w.z = cvt_pk_bf16(v1[0], v1[1]); w.w = cvt_pk_bf16(v1[2], v1[3]);
                        *(u32x4*)(dst + (size_t)r * MT + u.pm * 256 + bj * 128 + c8) = w;
                    }
                }
            return;
        }
        const int row0 = u.pm * 256 + wr * 64 + fr;
        f32x4 bv[2][2];
#pragma unroll
        for (int bj = 0; bj < 2; ++bj)
#pragma unroll
            for (int n = 0; n < 2; ++n) bv[bj][n] = *(const f32x4*)(bin + u.pn * 256 + bj * 128 + c8 + 4 * n);
        if (u.kind == KI_PLAIN) {
            bf16* dst = (u.pn == 2) ? Q : (u.pn == 3 ? K : SB); const float scl = (u.pn == 2) ? ATT_SCALE * 1.44269504089f : 1.0f;
#pragma unroll
            for (int ai = 0; ai < 2; ++ai)
#pragma unroll
                for (int m = 0; m < 4; ++m)
#pragma unroll
                    for (int bj = 0; bj < 2; ++bj) {
                        const f32x4 v0 = (acc[ai][bj][m][0] + bv[bj][0]) * scl, v1 = (acc[ai][bj][m][1] + bv[bj][1]) * scl;
                        u32x4 w; w.x = cvt_pk_bf16(v0[0], v0[1]); w.y = cvt_pk_bf16(v0[2], v0[3]); w.z = cvt_pk_bf16(v1[0], v1[1]); w.w = cvt_pk_bf16(v1[2], v1[3]);
                        *(u32x4*)(dst + (size_t)(row0 + ai * 128 + m * 16) * 256 + bj * 128 + c8) = w;
                    }
            return;
        }
        const bool glu = (u.kind == KI_GLU);
        bf16* dst = glu ? UA + u.pn * 128 : W + (u.pn - 6) * 128;
#pragma unroll
        for (int ai = 0; ai < 2; ++ai)
#pragma unroll
            for (int m = 0; m < 4; ++m) {
                f32x4 a0 = acc[ai][0][m][0] + bv[0][0], a1 = acc[ai][0][m][1] + bv[0][1], g0 = acc[ai][1][m][0] + bv[1][0], g1 = acc[ai][1][m][1] + bv[1][1];
                if (glu) {
#pragma unroll
                    for (int j = 0; j < 4; ++j) { g0[j] = sigmoidf_(g0[j]); g1[j] = sigmoidf_(g1[j]); }
                }
                const f32x4 v0 = a0 * g0, v1 = a1 * g1;
                u32x4 w; w.x = cvt_pk_bf16(v0[0], v0[1]); w.y = cvt_pk_bf16(v0[2], v0[3]); w.z = cvt_pk_bf16(v1[0], v1[1]); w.w = cvt_pk_bf16(v1[2], v1[3]);
                *(u32x4*)(dst + (size_t)(row0 + ai * 128 + m * 16) * 256 + c8) = w;
            }
    }
};
__device__ __forceinline__ unsigned pk_u8x4(f32x4 v) { const unsigned a = (unsigned)(v[0] * 255.0f + 0.5f), b = (unsigned)(v[1] * 255.0f + 0.5f), c = (unsigned)(v[2] * 255.0f + 0.5f), d = (unsigned)(v[3] * 255.0f + 0.5f); return a | (b << 8) | (c << 16) | (d << 24); }
struct EpiGateBr {
    static constexpr bool DUP_OK = false; static constexpr int NST = 0;
    const float* bing;
    unsigned char* gs;
    bf16* MG; bf16* MI;
    __device__ __forceinline__ void operator()(const Acc& acc, const GUnit& u, int tid, int wr, int wc, int fr, int fq) const {
        const int br = (u.kind >> 1) & 3; const bool cjob = (u.kind & 8) != 0;
        unsigned so = (unsigned)tid * 16u; asm volatile("" : "+v"(so));
        const unsigned mo = so * 2u;
        if ((u.kind & 1) == 0) {
            const float* bb = bing + br * 1024 + u.pn * 256 + wc * 32 + 8 * fq;
            f32x4 bv[2][2];
#pragma unroll
            for (int bj = 0; bj < 2; ++bj)
#pragma unroll
                for (int n = 0; n < 2; ++n) bv[bj][n] = *(const f32x4*)(bb + bj * 128 + 4 * n);
            unsigned char* sp = gs;
#pragma unroll
            for (int ai = 0; ai < 2; ++ai)
#pragma unroll
                for (int m = 0; m < 4; ++m)
#pragma unroll
                    for (int bj = 0; bj < 2; ++bj) {
                        const float gs_ = u.f8 ? (1.0f / W1_SCALE) : 1.0f; f32x4 v0 = acc[ai][bj][m][0] * gs_ + bv[bj][0], v1 = acc[ai][bj][m][1] * gs_ + bv[bj][1];
#pragma unroll
                        for (int j = 0; j < 4; ++j) { v0[j] = sigmoidf_(v0[j]); v1[j] = sigmoidf_(v1[j]); }
                        u32x2 w; w.x = pk_u8x4(v0); w.y = pk_u8x4(v1);
                        *(u32x2*)(sp + (so >> 1)) = w; sp += 4096;
                    }
        } else {
            unsigned lo = (unsigned)(((wr * 64 + fr) * D + u.pn * 256 + wc * 32 + 8 * fq) * 2); asm volatile("" : "+v"(lo));
            unsigned char* op = cjob ? (unsigned char*)(MI + ((size_t)br * TC + (u.pm - TL / 256) * 256) * D) : (unsigned char*)(MG + (size_t)u.pm * 256 * D);
            const bool ldm = (br > 0 && !cjob), stm = (br < 3 && !cjob);
            if (ldm) { if (stm) branch<true, true>(acc, so, mo, lo, op); else branch<true, false>(acc, so, mo, lo, op); }
            else { if (stm) branch<false, true>(acc, so, mo, lo, op); else branch<false, false>(acc, so, mo, lo, op); }
        }
    }
    template <bool LDM, bool STM> __device__ __forceinline__ void branch(const Acc& acc, unsigned so, unsigned mo, unsigned lo, unsigned char* op) const {
        const unsigned char* sp = gs; unsigned char* mp = gs + 131072;
        u32x2 s[3][2]; u32x4 mw[3][2];
#define GB_U(ptr_) ({ auto q_ = (ptr_); asm volatile("" : "+s"(q_)); q_; })
#define GB_LOAD(t_) do { _Pragma("unroll") for (int k = 0; k < 2; ++k) { s[(t_) % 3][k] = *(const u32x2*)(GB_U(sp + ((t_) * 2 + k) * 4096) + (so >> 1)); \
            if (LDM) mw[(t_) % 3][k] = *(const u32x4*)(GB_U(mp + ((t_) * 2 + k) * 8192) + so); else mw[(t_) % 3][k] = (u32x4){0u, 0u, 0u, 0u}; } } while (0)
        GB_LOAD(0); GB_LOAD(1);
#pragma unroll
        for (int t = 0; t < 8; ++t) { const int ai = t >> 2, m = t & 3, p = t % 3;
            if (t < 6) GB_LOAD(t + 2);
#pragma unroll
            for (int k = 0; k < 2; ++k) { const int bj = k;
                const f32x4 y0 = acc[ai][bj][m][0], y1 = acc[ai][bj][m][1]; const u32x2 sk = s[p][k]; const u32x4 mk = mw[p][k]; f32x4 a0 = (f32x4){bflo(mk.x), bfhi(mk.x), bflo(mk.y), bfhi(mk.y)}, a1 = (f32x4){bflo(mk.z), bfhi(mk.z), bflo(mk.w), bfhi(mk.w)};
                a0[0] += (float)((sk.x >> 0) & 0xffu) * y0[0]; a0[1] += (float)((sk.x >> 8) & 0xffu) * y0[1]; a0[2] += (float)((sk.x >> 16) & 0xffu) * y0[2]; a0[3] += (float)((sk.x >> 24) & 0xffu) * y0[3];
                a1[0] += (float)((sk.y >> 0) & 0xffu) * y1[0]; a1[1] += (float)((sk.y >> 8) & 0xffu) * y1[1]; a1[2] += (float)((sk.y >> 16) & 0xffu) * y1[2]; a1[3] += (float)((sk.y >> 24) & 0xffu) * y1[3];
                if (!STM) { a0 = a0 * (1.0f / 255.0f); a1 = a1 * (1.0f / 255.0f); }
                u32x4 w; w.x = cvt_pk_bf16(a0[0], a0[1]); w.y = cvt_pk_bf16(a0[2], a0[3]); w.z = cvt_pk_bf16(a1[0], a1[1]); w.w = cvt_pk_bf16(a1[2], a1[3]);
                if (STM) *(u32x4*)(GB_U(mp + (t * 2 + k) * 8192) + so) = w;
                else *(u32x4*)(op + (size_t)(ai * 128 + m * 16) * D * 2 + lo + bj * 256) = w; }
            asm volatile("" ::: "memory");
        }
#undef GB_LOAD
#undef GB_U
    }
};

struct Frame {
    LAS unsigned char* lds;
    int tid, lane, wave, bid, G;
    unsigned char* ws;
};

__device__ __forceinline__ void transpose_item(const float* W, int K, int N, int src_col0, bf16* WT, int dst_row0, LAS float* scr, int kb, int lane) {
    const int k0 = 64 * kb;
    float tv[32];
#pragma unroll
    for (int i = 0; i < 32; ++i) { const int kk = 2 * i + (lane >> 5); tv[i] = W[(size_t)(k0 + kk) * N + src_col0 + (lane & 31)]; }
#pragma unroll
    for (int i = 0; i < 32; ++i) { const int kk = 2 * i + (lane >> 5); scr[kk * 33 + (lane & 31)] = tv[i]; }
    LDS_WAIT(); asm volatile("" ::: "memory");
    const int c = lane & 7;
#pragma unroll
    for (int j = 0; j < 4; ++j) { const int n = (lane >> 3) + 8 * j; const LAS float* s = scr + (8 * c) * 33 + n;
        u32x4 o; o.x = cvt_pk_bf16(s[0 * 33], s[1 * 33]); o.y = cvt_pk_bf16(s[2 * 33], s[3 * 33]); o.z = cvt_pk_bf16(s[4 * 33], s[5 * 33]); o.w = cvt_pk_bf16(s[6 * 33], s[7 * 33]);
        *(u32x4*)(WT + (size_t)(dst_row0 + n) * K + k0 + 8 * c) = o; }
    LDS_WAIT(); asm volatile("" ::: "memory");
}
__device__ __forceinline__ void transpose_item8(const float* W, int K, int N, int src_col0, unsigned char* WT, int dst_row0, LAS float* scr, int kb, int lane, float wscale) {
    const int k0 = 64 * kb;
    float tv[32];
#pragma unroll
    for (int i = 0; i < 32; ++i) { const int kk = 2 * i + (lane >> 5); tv[i] = W[(size_t)(k0 + kk) * N + src_col0 + (lane & 31)]; }
#pragma unroll
    for (int i = 0; i < 32; ++i) { const int kk = 2 * i + (lane >> 5); scr[kk * 33 + (lane & 31)] = tv[i]; }
    LDS_WAIT(); asm volatile("" ::: "memory");
    const int n = lane >> 1, hf = lane & 1; const LAS float* s = scr + (32 * hf) * 33 + n;
    u32x4 o0, o1;
    o0.x = pk_fp8x4(s[0 * 33] * wscale, s[1 * 33] * wscale, s[2 * 33] * wscale, s[3 * 33] * wscale); o0.y = pk_fp8x4(s[4 * 33] * wscale, s[5 * 33] * wscale, s[6 * 33] * wscale, s[7 * 33] * wscale);
    o0.z = pk_fp8x4(s[8 * 33] * wscale, s[9 * 33] * wscale, s[10 * 33] * wscale, s[11 * 33] * wscale); o0.w = pk_fp8x4(s[12 * 33] * wscale, s[13 * 33] * wscale, s[14 * 33] * wscale, s[15 * 33] * wscale);
    o1.x = pk_fp8x4(s[16 * 33] * wscale, s[17 * 33] * wscale, s[18 * 33] * wscale, s[19 * 33] * wscale); o1.y = pk_fp8x4(s[20 * 33] * wscale, s[21 * 33] * wscale, s[22 * 33] * wscale, s[23 * 33] * wscale);
    o1.z = pk_fp8x4(s[24 * 33] * wscale, s[25 * 33] * wscale, s[26 * 33] * wscale, s[27 * 33] * wscale); o1.w = pk_fp8x4(s[28 * 33] * wscale, s[29 * 33] * wscale, s[30 * 33] * wscale, s[31 * 33] * wscale);
    u32x4* dst = (u32x4*)(WT + (size_t)(dst_row0 + n) * K + k0 + 32 * hf); dst[0] = o0; dst[1] = o1;
    LDS_WAIT(); asm volatile("" ::: "memory");
}
__host__ __device__ __forceinline__ int inmap(int r) {
    if (r >= NINP) return r;
    const int t = r >> 8, cc = r & 255;
    if (t < 2) return cc < 128 ? 128 * t + cc : 256 + 128 * t + cc - 128;
    if (t < 6) return 256 * t + cc;
    if (t < 8) { const int p = t - 6; return cc < 128 ? 1536 + 128 * p + cc : 1792 + 128 * p + cc - 128; }
    return 2048 + 256 * (t - 8) + cc;
}
__device__ __forceinline__ void prologue_a(Frame& F, const Params& P) {
    LAS float* scr = (LAS float*)(F.lds + F.wave * 16384);
    const int gw = F.bid * NWAVES + F.wave, NGW = F.G * NWAVES;
    constexpr int I1 = 16 * 176, I2 = 44 * 32, I3 = 16 * 216, I4 = 4 * 32, I5 = 16 * 32;
    constexpr int I6 = 32;
    constexpr int NIT = 4 * I1 + 4 * I2 + 2 * I3 + 8 * I4 + 2 * I5 + 2 * I6;
    struct TI { const float* W; unsigned char* dst; int N, K, sc, drow, kb; bool f8; float scale; };
    auto decode = [&](int it, TI& t) {
        int r = it;
        if (r < 4 * I1) { const int mi = r / I1; r %= I1; const int kb = r / 176, nb = r % 176, d0 = nb * 32, pn = d0 >> 8, cc = d0 & 255;
            t = TI{P.in[I_FWI] + (size_t)mi * D * NFF, F.ws + WS_W1T + (size_t)mi * NFF * D, NFF, D, cc < 128 ? 128 * pn + cc : DFF + 128 * pn + cc - 128, d0, kb, true, W1_SCALE}; return; }
        r -= 4 * I1;
        if (r < 4 * I2) { const int mi = r / I2; r %= I2; const int kb = r / 32, nb = r % 32;
            t = TI{P.in[I_FWO] + (size_t)mi * DFF * D, F.ws + WS_W2T + (size_t)mi * D * DFF, D, DFF, nb * 32, nb * 32, kb, true, W2_SCALE}; return; }
        r -= 4 * I2;
        if (r < 2 * I3) { const int mi = r / I3; r %= I3; const int kb = r / 216, nb = r % 216; const float* W = P.in[I_WIN] + (size_t)mi * D * PIN;
            if (nb * 32 >= NINP) t = TI{W, F.ws + WS_WIT + ((size_t)mi * PIN + NINP) * D * 2, PIN, D, inmap(nb * 32), nb * 32 - NINP, kb, true, W1_SCALE};
            else t = TI{W, F.ws + WS_WIT + (size_t)mi * PIN * D * 2, PIN, D, inmap(nb * 32), nb * 32, kb, false, 1.f};
            return; }
        r -= 2 * I3;
        if (r < 8 * I4) { const int mi = r / I4; r %= I4; const int l = mi >> 2, br = mi & 3, kb = r / 32, nb = r % 32;
            t = TI{P.in[br == 0 ? I_CWP : (br == 1 ? I_NWP : (br == 2 ? I_SWP : I_HWP))] + (size_t)l * 256 * D, F.ws + WS_WPT + (size_t)mi * D * 256 * 2, D, 256, nb * 32, nb * 32, kb, false, 1.f}; return; }
        r -= 8 * I4;
        if (r < 2 * I5) { const int mi = r / I5; r %= I5; const int kb = r / 32, nb = r % 32;
            t = TI{P.in[I_WOUT] + (size_t)mi * D * D, F.ws + WS_WOT + (size_t)mi * D * D * 2, D, D, nb * 32, nb * 32, kb, false, 1.f}; return; }
        r -= 2 * I5;
        { const int mi = r / I6, nb = r % I6; t = TI{P.in[I_HW3] + (size_t)mi * 64 * 1024, F.ws + WS_W3T + (size_t)mi * 1024 * 64 * 2, 1024, 64, nb * 32, nb * 32, 0, false, 1.f}; }
    };
    {
        const int lane = F.lane;
        TI cur; float tv[32];
        int it = gw;
        if (it < NIT) { decode(it, cur);
#pragma unroll
            for (int i = 0; i < 32; ++i) tv[i] = cur.W[(size_t)(64 * cur.kb + 2 * i + (lane >> 5)) * cur.N + cur.sc + (lane & 31)]; }
        for (; it < NIT; it += NGW) {
#pragma unroll
            for (int i = 0; i < 32; ++i) scr[(2 * i + (lane >> 5)) * 33 + (lane & 31)] = tv[i];
            TI nx; const bool more = it + NGW < NIT;
            if (more) { decode(it + NGW, nx);
#pragma unroll
                for (int i = 0; i < 32; ++i) tv[i] = nx.W[(size_t)(64 * nx.kb + 2 * i + (lane >> 5)) * nx.N + nx.sc + (lane & 31)]; }
            LDS_WAIT(); asm volatile("" ::: "memory");
            const int k0 = 64 * cur.kb;
            if (cur.f8) { const int n = lane >> 1, hf = lane & 1; const LAS float* s = scr + (32 * hf) * 33 + n; const float ws_ = cur.scale;
                u32x4 o0, o1;
                o0.x = pk_fp8x4(s[0 * 33] * ws_, s[1 * 33] * ws_, s[2 * 33] * ws_, s[3 * 33] * ws_); o0.y = pk_fp8x4(s[4 * 33] * ws_, s[5 * 33] * ws_, s[6 * 33] * ws_, s[7 * 33] * ws_);
                o0.z = pk_fp8x4(s[8 * 33] * ws_, s[9 * 33] * ws_, s[10 * 33] * ws_, s[11 * 33] * ws_); o0.w = pk_fp8x4(s[12 * 33] * ws_, s[13 * 33] * ws_, s[14 * 33] * ws_, s[15 * 33] * ws_);
                o1.x = pk_fp8x4(s[16 * 33] * ws_, s[17 * 33] * ws_, s[18 * 33] * ws_, s[19 * 33] * ws_); o1.y = pk_fp8x4(s[20 * 33] * ws_, s[21 * 33] * ws_, s[22 * 33] * ws_, s[23 * 33] * ws_);
                o1.z = pk_fp8x4(s[24 * 33] * ws_, s[25 * 33] * ws_, s[26 * 33] * ws_, s[27 * 33] * ws_); o1.w = pk_fp8x4(s[28 * 33] * ws_, s[29 * 33] * ws_, s[30 * 33] * ws_, s[31 * 33] * ws_);
                u32x4* dst = (u32x4*)(cur.dst + (size_t)(cur.drow + n) * cur.K + k0 + 32 * hf); dst[0] = o0; dst[1] = o1; }
            else { const int c = lane & 7;
#pragma unroll
                for (int j = 0; j < 4; ++j) { const int n = (lane >> 3) + 8 * j; const LAS float* s = scr + (8 * c) * 33 + n;
                    u32x4 o; o.x = cvt_pk_bf16(s[0 * 33], s[1 * 33]); o.y = cvt_pk_bf16(s[2 * 33], s[3 * 33]); o.z = cvt_pk_bf16(s[4 * 33], s[5 * 33]); o.w = cvt_pk_bf16(s[6 * 33], s[7 * 33]);
                    *(u32x4*)(cur.dst + ((size_t)(cur.drow + n) * cur.K + k0 + 8 * c) * 2) = o; } }
            LDS_WAIT(); asm volatile("" ::: "memory");
            cur = nx;
        }
    }
    { float* bin = (float*)(F.ws + WS_BIN); for (int i = F.bid * NTHR + F.tid; i < 2 * PIN; i += F.G * NTHR) { const int l = i / PIN, r = i % PIN; bin[i] = P.in[I_BIN][l * PIN + inmap(r)]; } }
    __syncthreads();
    LAS float* sv = (LAS float*)F.lds;
    LAS float* red = (LAS float*)(F.lds + 16384);
    for (int i = F.tid; i < 3 * D; i += NTHR) { const int g = i / D, k = i % D; const float c = g < 2 ? P.in[I_C][g * D + k] : P.in[I_CCTX][k]; sv[i] = siluf_(c); }
    __syncthreads();
    for (int un = F.bid; un < 2 * 144; un += F.G) {
        const int l = un / 144, n0 = (un % 144) * 64;
        const float* wm = P.in[I_WMOD] + (size_t)l * D * 9216 + n0 + F.lane;
        float a0 = 0.f, a1 = 0.f, a2 = 0.f;
#pragma unroll 1
        for (int k0 = 0; k0 < 128; k0 += 32) { float wv[32];
#pragma unroll
            for (int kk = 0; kk < 32; ++kk) wv[kk] = wm[(size_t)(F.wave * 128 + k0 + kk) * 9216];
#pragma unroll
            for (int kk = 0; kk < 32; ++kk) { const int k = F.wave * 128 + k0 + kk; a0 += sv[k] * wv[kk]; a1 += sv[D + k] * wv[kk]; a2 += sv[2 * D + k] * wv[kk]; } }
        red[(F.wave * 3 + 0) * 64 + F.lane] = a0; red[(F.wave * 3 + 1) * 64 + F.lane] = a1; red[(F.wave * 3 + 2) * 64 + F.lane] = a2;
        __syncthreads();
        if (F.tid < 192) { const int g = F.tid >> 6, ln = F.tid & 63; float s = P.in[I_BMOD][l * 9216 + n0 + ln];
#pragma unroll
            for (int w = 0; w < 8; ++w) s += red[(w * 3 + g) * 64 + ln];
            ((float*)(F.ws + WS_MOD))[(size_t)(l * 3 + g) * 9216 + n0 + ln] = s; }
        __syncthreads();
    }
}

__device__ __forceinline__ void ln_stats(const f32x4 (&v)[4], float& mean, float& rstd) {
    float s = 0.f;
#pragma unroll
    for (int j = 0; j < 4; ++j) s += (v[j][0] + v[j][1]) + (v[j][2] + v[j][3]);
    mean = wave_sum(s) * (1.0f / D);
    float q = 0.f;
#pragma unroll
    for (int j = 0; j < 4; ++j) { const f32x4 d = v[j] - mean; q += (d[0] * d[0] + d[1] * d[1]) + (d[2] * d[2] + d[3] * d[3]); }
    rstd = 1.0f / sqrtf(wave_sum(q) * (1.0f / D) + LN_EPS);
}
__device__ __forceinline__ void modulate_store(const f32x4 (&x)[4], const float* shift, const float* scale, bf16* hrow, int lane) {
    float mean, rstd; ln_stats(x, mean, rstd);
#pragma unroll
    for (int j = 0; j < 4; ++j) { const int c = 4 * lane + 256 * j; const f32x4 sc = *(const f32x4*)(scale + c), sh = *(const f32x4*)(shift + c);
        const f32x4 h = (x[j] - mean) * rstd * (sc + 1.0f) + sh;
        u32x2 w; w.x = cvt_pk_bf16(h[0], h[1]); w.y = cvt_pk_bf16(h[2], h[3]); *(u32x2*)(hrow + c) = w; }
}
__device__ __forceinline__ void modulate_store8(const f32x4 (&x)[4], const float* shift, const float* scale, unsigned char* hrow, int lane) {
    float mean, rstd; ln_stats(x, mean, rstd);
#pragma unroll
    for (int j = 0; j < 4; ++j) { const int c = 4 * lane + 256 * j; const f32x4 sc = *(const f32x4*)(scale + c), sh = *(const f32x4*)(shift + c);
        const f32x4 h = (x[j] - mean) * rstd * (sc + 1.0f) + sh;
        *(unsigned*)(hrow + c) = pk_fp8x4(h[0], h[1], h[2], h[3]); }
}
constexpr int LNR = 4;
__device__ __forceinline__ void ln_stats_r(const f32x4 (&v)[LNR][4], float (&mean)[LNR], float (&rstd)[LNR]) {
    float s[LNR];
#pragma unroll
    for (int r = 0; r < LNR; ++r) { s[r] = 0.f;
#pragma unroll
        for (int j = 0; j < 4; ++j) s[r] += (v[r][j][0] + v[r][j][1]) + (v[r][j][2] + v[r][j][3]); }
#pragma unroll
    for (int r = 0; r < LNR; ++r) s[r] = wave_sum(s[r]);
    float q[LNR];
#pragma unroll
    for (int r = 0; r < LNR; ++r) { mean[r] = s[r] * (1.0f / D); q[r] = 0.f;
#pragma unroll
        for (int j = 0; j < 4; ++j) { const f32x4 d = v[r][j] - mean[r]; q[r] += (d[0] * d[0] + d[1] * d[1]) + (d[2] * d[2] + d[3] * d[3]); } }
#pragma unroll
    for (int r = 0; r < LNR; ++r) q[r] = wave_sum(q[r]);
#pragma unroll
    for (int r = 0; r < LNR; ++r) rstd[r] = 1.0f / sqrtf(q[r] * (1.0f / D) + LN_EPS);
}
__device__ __forceinline__ void phase_mod0(Frame& F, const Params& P) {
    const int skip = (F.G > 8) ? 4 : 0;
    if (F.bid < skip) return;
    const int gw = (F.bid - skip) * NWAVES + F.wave, NGW = (F.G - skip) * NWAVES;
    const float* MOD = (const float*)(F.ws + WS_MOD); bf16* H = (bf16*)(F.ws + WS_H);
    for (int row0 = gw; row0 < MT; row0 += LNR * NGW) {
        f32x4 x[LNR][4]; int rows[LNR];
#pragma unroll
        for (int r = 0; r < LNR; ++r) { rows[r] = min(row0 + r * NGW, MT - 1); const int row = rows[r];
            const float* xr = row < TL ? P.in[I_X] + (size_t)row * D : P.in[I_CTX] + (size_t)(row - TL) * D;
#pragma unroll
            for (int j = 0; j < 4; ++j) x[r][j] = *(const f32x4*)(xr + 4 * F.lane + 256 * j); }
        float mean[LNR], rstd[LNR]; ln_stats_r(x, mean, rstd);
#pragma unroll
        for (int r = 0; r < LNR; ++r) if (row0 + r * NGW < MT) { const int row = rows[r], g = row < SEQ ? 0 : (row < TL ? 1 : 2);
            const float* shift = MOD + (size_t)g * 9216, *scale = shift + D;
#pragma unroll
            for (int j = 0; j < 4; ++j) { const int c = 4 * F.lane + 256 * j; const f32x4 sc = *(const f32x4*)(scale + c), sh = *(const f32x4*)(shift + c);
                const f32x4 h = (x[r][j] - mean[r]) * rstd[r] * (sc + 1.0f) + sh;
                *(unsigned*)((unsigned char*)H + (size_t)row * D + c) = pk_fp8x4(h[0], h[1], h[2], h[3]); } }
    }
}
__device__ __forceinline__ void phase_ln(Frame& F, const Params& P, const float* lg, const float* lb, const float* modl  , int ishift, bool hmod, bool h8  , bool dual  , bool final_out, int cx_nks, float cx_coef, const float* cx_modv  , const float* cx_bias, const float* cx_xsrc, bool skipx  , const bf16* vsrc  ) {
    const int gw = F.bid * NWAVES + F.wave, NGW = F.G * NWAVES;
    const bf16* V = vsrc; bf16* H = (bf16*)(F.ws + WS_H);
    f32x4 g4[4], b4[4];
#pragma unroll
    for (int j = 0; j < 4; ++j) { g4[j] = *(const f32x4*)(lg + 4 * F.lane + 256 * j); b4[j] = *(const f32x4*)(lb + 4 * F.lane + 256 * j); }
    if (cx_nks > 0) {
        const float* part = (const float*)(F.ws + WS_ES);
        for (int r = gw; r < TC; r += NGW) {
            f32x4 v[4];
#pragma unroll
            for (int j = 0; j < 4; ++j) { const int c = 4 * F.lane + 256 * j; f32x4 s = cx_bias ? *(const f32x4*)(cx_bias + c) : (f32x4){0.f, 0.f, 0.f, 0.f};
                for (int ks = 0; ks < cx_nks; ++ks) s += *(const f32x4*)(part + ((size_t)ks * TC + r) * D + c);
                v[j] = *(const f32x4*)(cx_xsrc + (size_t)r * D + c) * ALPHA + *(const f32x4*)(cx_modv + c) * cx_coef * s; }
            float mean, rstd; ln_stats(v, mean, rstd);
            float* xr = (float*)(F.ws + WS_XC) + (size_t)r * D;
#pragma unroll
            for (int j = 0; j < 4; ++j) { v[j] = (v[j] - mean) * rstd * g4[j] + b4[j]; *(f32x4*)(xr + 4 * F.lane + 256 * j) = v[j]; }
            if (hmod && dual) modulate_store8(v, modl + (size_t)2 * 9216 + ishift * D, modl + (size_t)2 * 9216 + (ishift + 1) * D, F.ws + WS_H8C + (size_t)r * D, F.lane);
            if (hmod) { if (h8) modulate_store8(v, modl + (size_t)2 * 9216 + ishift * D, modl + (size_t)2 * 9216 + (ishift + 1) * D, (unsigned char*)H + (size_t)(TL + r) * D, F.lane);
                        else modulate_store(v, modl + (size_t)2 * 9216 + ishift * D, modl + (size_t)2 * 9216 + (ishift + 1) * D, H + (size_t)(TL + r) * D, F.lane); }
        }
    }
    const int M = TL;
    u32x2 raw[LNR][4];
#pragma unroll
    for (int r = 0; r < LNR; ++r) { const int rw = min(gw + r * NGW, M - 1);
#pragma unroll
        for (int j = 0; j < 4; ++j) raw[r][j] = *(const u32x2*)(V + (size_t)rw * D + 4 * F.lane + 256 * j); }
    for (int row0 = gw; row0 < M; row0 += LNR * NGW) {
        f32x4 v[LNR][4]; int rows[LNR];
#pragma unroll
        for (int r = 0; r < LNR; ++r) { rows[r] = min(row0 + r * NGW, M - 1);
#pragma unroll
            for (int j = 0; j < 4; ++j) { const u32x2 w = raw[r][j]; v[r][j] = (f32x4){bflo(w.x), bfhi(w.x), bflo(w.y), bfhi(w.y)}; } }
        if (row0 + LNR * NGW < M) {
#pragma unroll
            for (int r = 0; r < LNR; ++r) { const int rw = min(row0 + (LNR + r) * NGW, M - 1);
#pragma unroll
                for (int j = 0; j < 4; ++j) raw[r][j] = *(const u32x2*)(V + (size_t)rw * D + 4 * F.lane + 256 * j); }
        }
        float mean[LNR], rstd[LNR]; ln_stats_r(v, mean, rstd);
#pragma unroll
        for (int r = 0; r < LNR; ++r) { const int row = rows[r]; const bool ok = row0 + r * NGW < M;
            float* xr = P.out + (size_t)row * D; bf16* xh = (bf16*)P.out + (size_t)row * D;
            if (skipx && ok && F.lane == 0) *(f32x2*)((float*)(F.ws + WS_LNS) + (size_t)row * 2) = (f32x2){mean[r], rstd[r]};
#pragma unroll
            for (int j = 0; j < 4; ++j) { v[r][j] = (v[r][j] - mean[r]) * rstd[r] * g4[j] + b4[j];
                if (ok) { if (final_out) __builtin_nontemporal_store(v[r][j], (f32x4*)(xr + 4 * F.lane + 256 * j));
                          else if (!skipx) { u32x2 w; w.x = cvt_pk_bf16(v[r][j][0], v[r][j][1]); w.y = cvt_pk_bf16(v[r][j][2], v[r][j][3]); __builtin_nontemporal_store(w, (u32x2*)(xh + 4 * F.lane + 256 * j)); } } } }
        if (hmod) {
            ln_stats_r(v, mean, rstd);
#pragma unroll
            for (int r = 0; r < LNR; ++r) if (row0 + r * NGW < M) { const int row = rows[r], g = row < SEQ ? 0 : 1;
                const float* shift = modl + (size_t)g * 9216 + ishift * D, *scale = shift + D; bf16* hrow = H + (size_t)row * D;
#pragma unroll
                for (int j = 0; j < 4; ++j) { const int c = 4 * F.lane + 256 * j; const f32x4 sc = *(const f32x4*)(scale + c), sh = *(const f32x4*)(shift + c);
                    const f32x4 h = (v[r][j] - mean[r]) * rstd[r] * (sc + 1.0f) + sh;
                    if (h8) __builtin_nontemporal_store(pk_fp8x4(h[0], h[1], h[2], h[3]), (unsigned*)((unsigned char*)H + (size_t)row * D + c));
                    else { u32x2 w; w.x = cvt_pk_bf16(h[0], h[1]); w.y = cvt_pk_bf16(h[2], h[3]); __builtin_nontemporal_store(w, (u32x2*)(hrow + c)); }
                    if (dual) __builtin_nontemporal_store(pk_fp8x4(h[0], h[1], h[2], h[3]), (unsigned*)(F.ws + WS_H8L + (size_t)row * D + c)); } }
        }
    }
}

__device__ __forceinline__ void filter_unit(Frame& F, const Params& P, int l, int L, int t0, float* filt  , bool bfout) {
    LAS float* h1 = (LAS float*)F.lds;
    LAS bf16* h2b = (LAS bf16*)(F.lds + 32768);
    LAS float* zf = (LAS float*)(F.lds + 65536);
    LAS float* w2s = (LAS float*)(F.lds + 81920);
    LAS float* w1s = (LAS float*)(F.lds + 98304);
    const float* w1 = P.in[I_HW1] + l * 33 * 64; const float* b1 = P.in[I_HB1] + l * 64; const float* w2 = P.in[I_HW2] + l * 64 * 64; const float* b2 = P.in[I_HB2] + l * 64;
    const float* fq = P.in[I_HFQ] + l * 128; const float* w3 = P.in[I_HW3] + (size_t)l * 64 * 1024;
    {
#pragma unroll
        for (int i = 0; i < 8; ++i) w2s[F.tid + 512 * i] = w2[F.tid + 512 * i];
#pragma unroll
        for (int i = 0; i < 5; ++i) if (F.tid + 512 * i < 33 * 64) w1s[F.tid + 512 * i] = w1[F.tid + 512 * i];
        const int tl = F.tid >> 3, jg = F.tid & 7; const float t = (float)(t0 + tl);
        if (jg == 0) zf[tl * 36] = t / (float)(L - 1);
#pragma unroll
        for (int ii = 0; ii < 2; ++ii) { const int i = jg + 8 * ii; const float band = 1e-4f + (float)i * ((15.0f - 1e-4f) / 15.0f); float s, c; sincospif(2.0f * t * band / (float)L, &s, &c); zf[tl * 36 + 1 + i] = c; zf[tl * 36 + 17 + i] = -s; }
        __syncthreads();
        float a[8];
#pragma unroll
        for (int jj = 0; jj < 8; ++jj) a[jj] = b1[jg * 8 + jj];
#pragma unroll 3
        for (int i = 0; i < 33; ++i) { const float zv = zf[tl * 36 + i]; const LAS f32x4* wp = (const LAS f32x4*)(w1s + i * 64 + jg * 8); const f32x4 wa = wp[0], wb = wp[1];
            a[0] += zv * wa[0]; a[1] += zv * wa[1]; a[2] += zv * wa[2]; a[3] += zv * wa[3]; a[4] += zv * wb[0]; a[5] += zv * wb[1]; a[6] += zv * wb[2]; a[7] += zv * wb[3]; }
#pragma unroll
        for (int jj = 0; jj < 8; ++jj) h1[tl * 65 + jg * 8 + jj] = sinf(fq[jg * 8 + jj] * a[jj]);
        __syncthreads();
#pragma unroll
        for (int jj = 0; jj < 8; ++jj) a[jj] = b2[jg * 8 + jj];
#pragma unroll 4
        for (int i = 0; i < 64; ++i) { const float hv = h1[tl * 65 + i]; const LAS f32x4* wp = (const LAS f32x4*)(w2s + i * 64 + jg * 8); const f32x4 wa = wp[0], wb = wp[1];
            a[0] += hv * wa[0]; a[1] += hv * wa[1]; a[2] += hv * wa[2]; a[3] += hv * wa[3]; a[4] += hv * wb[0]; a[5] += hv * wb[1]; a[6] += hv * wb[2]; a[7] += hv * wb[3]; }
#pragma unroll
        for (int jj = 0; jj < 8; ++jj) h2b[tl * 72 + jg * 8 + jj] = (bf16)(cvt_pk_bf16(sinf(fq[64 + jg * 8 + jj] * a[jj]), 0.f) & 0xffffu);
        __syncthreads();
    }
    {
        const bf16* W3T = (const bf16*)(F.ws + WS_W3T) + (size_t)l * 1024 * 64;
        const int lane = F.lane, lr = lane & 15, lg = lane >> 4;
        const float dl0 = -4.605170186f / 1.5f, dl1 = -4.605170186f / 0.3f;
        bf16x8 af[4][2];
#pragma unroll
        for (int rt = 0; rt < 4; ++rt)
#pragma unroll
            for (int ks = 0; ks < 2; ++ks) af[rt][ks] = *(const LAS bf16x8*)(h2b + (rt * 16 + lr) * 72 + ks * 32 + 8 * lg);
#pragma unroll 2
        for (int ct = 0; ct < 8; ++ct) {
            const int col = F.wave * 128 + ct * 16 + lr, c = col & 255;
            const bf16x8 b0 = *(const bf16x8*)(W3T + (size_t)col * 64 + 8 * lg), b1 = *(const bf16x8*)(W3T + (size_t)col * 64 + 32 + 8 * lg);
            const float ad = fabsf(dl0 + (dl1 - dl0) * (float)c / 255.0f);
#pragma unroll
            for (int rt = 0; rt < 4; ++rt) {
                f32x4 a = (f32x4){0.f, 0.f, 0.f, 0.f};
                a = __builtin_amdgcn_mfma_f32_16x16x32_bf16(af[rt][0], b0, a, 0, 0, 0);
                a = __builtin_amdgcn_mfma_f32_16x16x32_bf16(af[rt][1], b1, a, 0, 0, 0);
                const int tb = t0 + rt * 16 + 4 * lg;
#pragma unroll
                for (int e = 0; e < 4; ++e) { const float tn = (float)(tb + e) / (float)(L - 1); a[e] *= __expf(-tn * ad); }
                if (bfout) { u32x2 w; w.x = cvt_pk_bf16(a[0], a[1]); w.y = cvt_pk_bf16(a[2], a[3]); *(u32x2*)((bf16*)filt + (size_t)col * L + tb) = w; }
                else *(f32x4*)(filt + (size_t)col * L + tb) = a;
            }
        }
    }
    __syncthreads();
}
__device__ __forceinline__ void phase_filters(Frame& F, const Params& P, int l, bool with_ctx) {
    float* filt = (float*)(F.ws + WS_FILT); float* filtc = (float*)(F.ws + WS_FILTC);
    const int nu = SEQ / 64 + (with_ctx ? CTXL / 64 : 0);
    for (int u = F.bid; u < nu; u += F.G) {
        if (u < SEQ / 64) filter_unit(F, P, l, SEQ, u * 64, filt, true);
        else filter_unit(F, P, l, CTXL, (u - SEQ / 64) * 64, filtc, false);
    }
}

__device__ __forceinline__ void seg_of(int row, int& s0, int& s1) {
    if (row < TL) { s0 = row & ~(SEQ - 1); s1 = s0 + SEQ; } else { s0 = TL + ((row - TL) & ~(CTXL - 1)); s1 = s0 + CTXL; }
}
__device__ __forceinline__ void conformer_tiles(Frame& F, const Params& P, int l, int u0, int ntile) {
    const bf16* UA = (const bf16*)(F.ws + WS_UA); bf16* BR0 = (bf16*)(F.ws + WS_BRV);
    LAS bf16* tin = (LAS bf16*)F.lds;
    LAS float* cout = (LAS float*)(F.lds + 49152);
    const int c = F.tid & 255, half = F.tid >> 8;
    float w[31];
#pragma unroll
    for (int j = 0; j < 31; ++j) w[j] = P.in[I_CDW][(l * 31 + j) * 256 + c];
    const float b = P.in[I_CDB][l * 256 + c];
    const f32x4 g = *(const f32x4*)(P.in[I_CLG] + l * 256 + 4 * F.lane), bb = *(const f32x4*)(P.in[I_CLB] + l * 256 + 4 * F.lane);
    u32x4 v[6];
#define CONF_LOAD(u_) do { const int t0_ = (u_) * 64; int s0_, s1_; seg_of(t0_, s0_, s1_); _Pragma("unroll") for (int k = 0; k < 6; ++k) { const int idx = F.tid + NTHR * k, rr = idx >> 5, c8 = idx & 31, gr = t0_ - 15 + rr; \
        const bool ok_ = idx < 94 * 32 && gr >= s0_ && gr < s1_; const u32x4 t_ = *(const u32x4*)(UA + (size_t)min(max(gr, s0_), s1_ - 1) * 256 + c8 * 8); v[k] = ok_ ? t_ : (u32x4){0u, 0u, 0u, 0u}; } } while (0)
    if (u0 < ntile) CONF_LOAD(u0);
    for (int u = u0; u < ntile; u += F.G) {
        const int t0 = u * 64;
#pragma unroll
        for (int k = 0; k < 6; ++k) { const int idx = F.tid + NTHR * k, rr = idx >> 5, c8 = idx & 31; if (idx < 94 * 32) *(LAS u32x4*)(tin + rr * 256 + c8 * 8) = v[k]; }
        __syncthreads();
        if (u + F.G < ntile) CONF_LOAD(u + F.G);
        {
            float in[62];
#pragma unroll
            for (int i = 0; i < 62; ++i) in[i] = bf2f(tin[(half * 32 + i) * 256 + c]);
#pragma unroll
            for (int t = 0; t < 32; ++t) { float a = b;
#pragma unroll
                for (int j = 0; j < 31; ++j) a += w[j] * in[t + j];
                cout[(half * 32 + t) * 260 + c] = a; }
        }
        __syncthreads();
        {
            f32x4 v[8]; float s[8], q[8];
#pragma unroll
            for (int tt = 0; tt < 8; ++tt) { v[tt] = *(const LAS f32x4*)(cout + (F.wave * 8 + tt) * 260 + 4 * F.lane); s[tt] = (v[tt][0] + v[tt][1]) + (v[tt][2] + v[tt][3]); }
#pragma unroll
            for (int tt = 0; tt < 8; ++tt) s[tt] = wave_sum(s[tt]);
#pragma unroll
            for (int tt = 0; tt < 8; ++tt) { v[tt] = v[tt] - s[tt] * (1.0f / 256.0f); q[tt] = (v[tt][0] * v[tt][0] + v[tt][1] * v[tt][1]) + (v[tt][2] * v[tt][2] + v[tt][3] * v[tt][3]); }
#pragma unroll
            for (int tt = 0; tt < 8; ++tt) q[tt] = wave_sum(q[tt]);
#pragma unroll
            for (int tt = 0; tt < 8; ++tt) { const float rstd = 1.0f / sqrtf(q[tt] * (1.0f / 256.0f) + LN_EPS);
                f32x4 y = v[tt] * rstd * g + bb;
#pragma unroll
                for (int j = 0; j < 4; ++j) y[j] = siluf_(y[j]);
                u32x2 wv; wv.x = cvt_pk_bf16(y[0], y[1]); wv.y = cvt_pk_bf16(y[2], y[3]);
                __builtin_nontemporal_store(wv, (u32x2*)(BR0 + (size_t)(t0 + F.wave * 8 + tt) * 256 + 4 * F.lane)); }
        }
        __syncthreads();
    }
}
#undef CONF_LOAD
__device__ __forceinline__ void shortconv_unit(Frame& F, const Params& P, int l, int t0) {
    const bf16* SB = (const bf16*)(F.ws + WS_SB); const bf16* W = (const bf16*)(F.ws + WS_W); bf16* BR2 = (bf16*)(F.ws + WS_BRV) + 2 * (size_t)MT * 256;
    int s0, s1; seg_of(t0, s0, s1);
    const float* cw = P.in[I_SCW] + l * 3 * 256;
#pragma unroll
    for (int k = 0; k < 4; ++k) { const int idx = F.tid + NTHR * k, tok = idx >> 5, c8 = (idx & 31) * 8, gr = t0 + tok;
        const u32x4 z = (u32x4){0u, 0u, 0u, 0u};
        const u32x4 wm_ = *(const u32x4*)(W + (size_t)max(gr - 1, s0) * 256 + c8), w0 = *(const u32x4*)(W + (size_t)gr * 256 + c8),
                    wp_ = *(const u32x4*)(W + (size_t)min(gr + 1, s1 - 1) * 256 + c8), sb = *(const u32x4*)(SB + (size_t)gr * 256 + c8);
        const u32x4 wm = (gr - 1 >= s0) ? wm_ : z, wp = (gr + 1 < s1) ? wp_ : z;
        float o[8];
#pragma unroll
        for (int j = 0; j < 4; ++j) { const int c = c8 + 2 * j;
            o[2 * j] = bflo(sb[j]) * (cw[c] * bflo(wm[j]) + cw[256 + c] * bflo(w0[j]) + cw[512 + c] * bflo(wp[j]));
            o[2 * j + 1] = bfhi(sb[j]) * (cw[c + 1] * bfhi(wm[j]) + cw[256 + c + 1] * bfhi(w0[j]) + cw[512 + c + 1] * bfhi(wp[j])); }
        u32x4 w; w.x = cvt_pk_bf16(o[0], o[1]); w.y = cvt_pk_bf16(o[2], o[3]); w.z = cvt_pk_bf16(o[4], o[5]); w.w = cvt_pk_bf16(o[6], o[7]);
        __builtin_nontemporal_store(w, (u32x4*)(BR2 + (size_t)gr * 256 + c8)); }
}
__device__ __forceinline__ void attn_stage_ctx(Frame& F, int b, int h) {
    const unsigned char* K = F.ws + WS_K; const unsigned char* VT = F.ws + WS_VT;
#pragma unroll
    for (int i = 0; i < 4; ++i) { const int pi = F.tid + NTHR * i;
        { const int key = pi >> 3, pc = pi & 7; const u32x4 v = *(const u32x4*)(K + (size_t)(TL + b * CTXL + key) * 512 + h * 128 + pc * 16);
          *(LAS u32x4*)(F.lds + key * 128 + ((pc ^ ((key & 3) | ((key >> 1) & 4))) << 4)) = v; }
        { const int dim = pi >> 5, pc = pi & 31; const u32x4 v = *(const u32x4*)(VT + ((size_t)(h * 64 + dim) * MT + TL + b * CTXL) * 2 + pc * 16);
          *(LAS u32x4*)(F.lds + 32768 + dim * 512 + ((pc ^ (dim & 7)) << 4)) = v; } }
}
__device__ __forceinline__ void attn_wave_unit(Frame& F, int wu, bool lat, bool cl  ) {
    const bf16* Q = (const bf16*)(F.ws + WS_Q); const bf16* K = (const bf16*)(F.ws + WS_K); const bf16* VT = (const bf16*)(F.ws + WS_VT);
    bf16* BR1 = (bf16*)(F.ws + WS_BRV) + (size_t)MT * 256;
    const LAS float* rpb = (const LAS float*)(F.lds + RPB_OFF);
    const int lane = lane_now(), q = lane & 15, g = lane >> 4;
    int b, h, r = 0, qb, tq0, cb = 0, r0 = 0;
    if (lat) { qb = wu & 3; h = (wu >> 2) & 3; r = (wu >> 4) & 255; b = wu >> 12; tq0 = b * SEQ + r * 64 + 16 * qb; cb = (qb == 0) ? 0 : (qb == 1 ? 8 : (qb == 2 ? 24 : 32)); r0 = min(max(r - 4, 0), 248); }
    else { qb = wu & 15; h = (wu >> 4) & 3; b = wu >> 6; tq0 = TL + b * CTXL + 16 * qb; }
    bf16x8 qf[2];
#pragma unroll
    for (int kk = 0; kk < 2; ++kk) qf[kk] = *(const bf16x8*)(Q + (size_t)(tq0 + q) * 256 + h * 64 + 32 * kk + 8 * g);
    const int koff = (q >> 2) * 8 + (q & 3);
    const unsigned klo = (unsigned)((koff * 256 + h * 64 + 8 * g) * 2);
    const unsigned vlo = (unsigned)((((h * 64 + q) * MT) + 8 * g) * 2);
    const char* Kc = (const char*)K; const char* Vc = (const char*)VT;
    const int kl0 = koff * 128 + ((g ^ ((q & 3) | (((q >> 2) & 1) << 2))) << 4), vl0 = 32768 + q * 512 + ((g ^ (q & 7)) << 4);
    const int cq = 16 * qb + q, c0 = min(max(cq - 8, 0), 48);
    float mx = -1e30f, sum = 0.f;
    f32x4 o[4];
#pragma unroll
    for (int bl = 0; bl < 4; ++bl) o[bl] = (f32x4){0.f, 0.f, 0.f, 0.f};
    bf16x8 kf[2][2][2];
#define ATT_KBASE(i_) (((i_) < 8) ? (b * SEQ + (r0 + (i_)) * 64 + cb) : (TL + b * CTXL + 32 * ((i_) - 8)))
#define ATT_LOADK(c_) do { _Pragma("unroll") for (int s_ = 0; s_ < 2; ++s_) { const int kb_ = ATT_KBASE(2 * (c_) + s_); _Pragma("unroll") for (int tt = 0; tt < 2; ++tt) { \
        if (cl && (c_) >= 4) { const int lo_ = (2 * (c_) + s_ - 8) * 4096 + tt * 512; kf[s_][tt][0] = *(const LAS bf16x8*)(F.lds + lo_ + kl0); kf[s_][tt][1] = *(const LAS bf16x8*)(F.lds + lo_ + (kl0 ^ 64)); } \
        else { const char* kp_ = Kc + (size_t)(kb_ + 4 * tt) * 512; kf[s_][tt][0] = *(const bf16x8*)(kp_ + klo); kf[s_][tt][1] = *(const bf16x8*)(kp_ + klo + 64); } } } } while (0)
#define ATT_LOADV(dst_, c_) do { _Pragma("unroll") for (int s_ = 0; s_ < 2; ++s_) { const int kb_ = ATT_KBASE(2 * (c_) + s_); _Pragma("unroll") for (int bl = 0; bl < 4; ++bl) \
        { if (cl && (c_) >= 4) { const int m_ = 2 * (c_) + s_ - 8; dst_[s_][bl] = *(const LAS bf16x8*)(F.lds + bl * 8192 + (m_ >> 1) * 128 + ((m_ & 1) ? (vl0 ^ 64) : vl0)); } \
          else dst_[s_][bl] = *(const bf16x8*)(Vc + ((size_t)(16 * bl) * MT + kb_) * 2 + vlo); } } } while (0)
    bf16x8 vf[2][4], vn[2][4];
    u32x4 kg[2][2][4], vg[2][4];
    LAS unsigned char* wb = F.lds + 65536 + F.wave * 8192;
    const int kq = lane >> 3;
    const int wk0 = kq * 128 + (((lane & 7) ^ (kq & 3)) << 4), wv0 = 4096 + (lane >> 2) * 64 + (((lane & 3) ^ ((lane >> 3) & 3)) << 4), vl1 = 4096 + q * 64 + ((g ^ ((q >> 1) & 3)) << 4);
    const unsigned gk = (unsigned)(kq * 512 + h * 128 + (lane & 7) * 16), gv = (unsigned)(((h * 64 + (lane >> 2)) * MT) * 2 + (lane & 3) * 16);
#define ATT_GLOADK(c_) do { _Pragma("unroll") for (int s_ = 0; s_ < 2; ++s_) { const int kb_ = ATT_KBASE(2 * (c_) + s_); _Pragma("unroll") for (int n = 0; n < 4; ++n) \
        kg[(c_) & 1][s_][n] = *(const u32x4*)(Kc + (size_t)kb_ * 512 + (size_t)n * 4096 + gk); } } while (0)
#define ATT_GLOADV(c_) do { _Pragma("unroll") for (int s_ = 0; s_ < 2; ++s_) { const int kb_ = ATT_KBASE(2 * (c_) + s_); _Pragma("unroll") for (int n = 0; n < 4; ++n) \
        vg[s_][n] = *(const u32x4*)(Vc + (size_t)kb_ * 2 + (size_t)n * 16 * MT * 2 + gv); } } while (0)
#define ATT_XPOSEK(c_) do { _Pragma("unroll") for (int s_ = 0; s_ < 2; ++s_) { \
        _Pragma("unroll") for (int n = 0; n < 4; ++n) *(LAS u32x4*)(wb + n * 1024 + ((n & 1) ? (wk0 ^ 64) : wk0)) = kg[(c_) & 1][s_][n]; \
        _Pragma("unroll") for (int tt = 0; tt < 2; ++tt) { kf[s_][tt][0] = *(const LAS bf16x8*)(wb + tt * 512 + kl0); kf[s_][tt][1] = *(const LAS bf16x8*)(wb + tt * 512 + (kl0 ^ 64)); } } } while (0)
#define ATT_XPOSEV() do { _Pragma("unroll") for (int s_ = 0; s_ < 2; ++s_) { \
        _Pragma("unroll") for (int n = 0; n < 4; ++n) *(LAS u32x4*)(wb + n * 1024 + wv0) = vg[s_][n]; \
        _Pragma("unroll") for (int bl = 0; bl < 4; ++bl) vf[s_][bl] = *(const LAS bf16x8*)(wb + bl * 1024 + vl1); } } while (0)
    if (cl) { ATT_GLOADK(0); ATT_GLOADV(0); ATT_GLOADK(1); } else if (lat) { ATT_LOADK(0); ATT_LOADV(vf, 0); } else { ATT_LOADK(4); ATT_LOADV(vf, 4); }
#pragma unroll
    for (int c = 0; c < 8; ++c) {
        if (c < 4 && !lat) continue;
        if (cl) { if (c < 4) { ATT_XPOSEK(c); if (c < 2) ATT_GLOADK(c + 2); } else { ATT_LOADK(c); ATT_LOADV(vf, c); } }
        f32x4 s[2][2];
#pragma unroll
        for (int s_ = 0; s_ < 2; ++s_)
#pragma unroll
            for (int tt = 0; tt < 2; ++tt) {
                f32x4 a = (f32x4){0.f, 0.f, 0.f, 0.f};
                a = __builtin_amdgcn_mfma_f32_16x16x32_bf16(kf[s_][tt][0], qf[0], a, 0, 0, 0);
                a = __builtin_amdgcn_mfma_f32_16x16x32_bf16(kf[s_][tt][1], qf[1], a, 0, 0, 0);
                if (c < 4) {
                    const int i = 2 * c + s_;
                    const LAS float* rp = rpb + (h * 15 + (r0 + i - r + 7)) * 31;
#pragma unroll
                    for (int j = 0; j < 4; ++j) { const int kc = cb + 8 * g + 4 * tt + j; const bool ok = (kc >= c0) && (kc < c0 + 16);
                        const int dc = min(max(kc - cq + 15, 0), 30);
                        a[j] = ok ? a[j] + rp[dc] : -1e30f; }
                }
                s[s_][tt] = a;
            }
        if (!cl && c < 7) { ATT_LOADK(c + 1); ATT_LOADV(vn, c + 1); }
        if (cl && c < 4) { ATT_XPOSEV(); if (c < 3) ATT_GLOADV(c + 1); }
        float cm = -1e30f;
#pragma unroll
        for (int s_ = 0; s_ < 2; ++s_)
#pragma unroll
            for (int tt = 0; tt < 2; ++tt)
#pragma unroll
                for (int j = 0; j < 4; ++j) cm = fmaxf(cm, s[s_][tt][j]);
        cm = xrow_max(cm);
        const float mn = fmaxf(mx, cm), alpha = __builtin_amdgcn_exp2f(mx - mn);
        mx = mn; sum *= alpha;
#pragma unroll
        for (int bl = 0; bl < 4; ++bl) o[bl] *= alpha;
#pragma unroll
        for (int s_ = 0; s_ < 2; ++s_) {
            float p[8];
#pragma unroll
            for (int tt = 0; tt < 2; ++tt)
#pragma unroll
                for (int j = 0; j < 4; ++j) { const float e = __builtin_amdgcn_exp2f(s[s_][tt][j] - mn); p[4 * tt + j] = e; sum += e; }
            u32x4 pw; pw.x = cvt_pk_bf16(p[0], p[1]); pw.y = cvt_pk_bf16(p[2], p[3]); pw.z = cvt_pk_bf16(p[4], p[5]); pw.w = cvt_pk_bf16(p[6], p[7]);
            const bf16x8 pf = __builtin_bit_cast(bf16x8, pw);
#pragma unroll
            for (int bl = 0; bl < 4; ++bl) o[bl] = __builtin_amdgcn_mfma_f32_16x16x32_bf16(vf[s_][bl], pf, o[bl], 0, 0, 0);
        }
        if (!cl && c < 7) {
#pragma unroll
            for (int s_ = 0; s_ < 2; ++s_)
#pragma unroll
                for (int bl = 0; bl < 4; ++bl) vf[s_][bl] = vn[s_][bl];
        }
    }
#undef ATT_XPOSEK
#undef ATT_XPOSEV
#undef ATT_GLOADK
#undef ATT_GLOADV
#undef ATT_LOADV
#undef ATT_LOADK
#undef ATT_KBASE
    sum = xrow_sum(sum);
    const float inv = 1.0f / sum;
#pragma unroll
    for (int bl = 0; bl < 4; ++bl) { u32x2 w; w.x = cvt_pk_bf16(o[bl][0] * inv, o[bl][1] * inv); w.y = cvt_pk_bf16(o[bl][2] * inv, o[bl][3] * inv);
        __builtin_nontemporal_store(w, (u32x2*)(BR1 + (size_t)(tq0 + q) * 256 + h * 64 + 16 * bl + 4 * g)); }
}

constexpr int FL = 16384;
__device__ __forceinline__ f32x2 cmul(f32x2 a, f32x2 b) {
    f32x2 t, r;
    asm("v_pk_mul_f32 %1, %2, %3 op_sel:[1,1] op_sel_hi:[1,0]\n\tv_pk_fma_f32 %0, %2, %3, %1 op_sel:[0,0,0] op_sel_hi:[0,1,1] neg_lo:[0,0,1]" : "=v"(r), "=&v"(t) : "v"(a), "v"(b));
    return r;
}
__device__ __forceinline__ f32x2 cmulc(f32x2 a, f32x2 b) {
    f32x2 t, r;
    asm("v_pk_mul_f32 %1, %2, %3 op_sel:[1,1] op_sel_hi:[1,0]\n\tv_pk_fma_f32 %0, %2, %3, %1 op_sel:[0,0,0] op_sel_hi:[0,1,1] neg_hi:[1,0,0]" : "=v"(r), "=&v"(t) : "v"(a), "v"(b));
    return r;
}
__device__ __forceinline__ f32x2 rotm(f32x2 b, f32x2 d) { f32x2 r; asm("v_pk_add_f32 %0, %1, %2 op_sel:[0,1] op_sel_hi:[1,0] neg_hi:[0,1]" : "=v"(r) : "v"(b), "v"(d)); return r; }
__device__ __forceinline__ f32x2 rotp(f32x2 b, f32x2 d) { f32x2 r; asm("v_pk_add_f32 %0, %1, %2 op_sel:[0,1] op_sel_hi:[1,0] neg_lo:[0,1]" : "=v"(r) : "v"(b), "v"(d)); return r; }
__device__ __forceinline__ f32x2 tw_main(const LAS f32x2* T, int m) { return cmul(T[m >> 7], T[128 + (m & 127)]); }
__device__ __forceinline__ f32x2 tw_half(const LAS f32x2* T, int n) { return cmul(T[256 + (n >> 7)], T[384 + (n & 127)]); }
__device__ __forceinline__ void r4f(f32x2& x0, f32x2& x1, f32x2& x2, f32x2& x3, f32x2 w1, f32x2 w2, f32x2 w3) {
    const f32x2 a = x0 + x2, b = x0 - x2, c = x1 + x3, d = x1 - x3;
    x0 = a + c; x1 = cmul(rotm(b, d), w1); x2 = cmul(a - c, w2); x3 = cmul(rotp(b, d), w3);
}
__device__ __forceinline__ void r4f1(f32x2& x0, f32x2& x1, f32x2& x2, f32x2& x3) {
    const f32x2 a = x0 + x2, b = x0 - x2, c = x1 + x3, d = x1 - x3;
    x0 = a + c; x1 = rotm(b, d); x2 = a - c; x3 = rotp(b, d);
}
__device__ __forceinline__ void r4i(f32x2& x0, f32x2& x1, f32x2& x2, f32x2& x3, f32x2 w1, f32x2 w2, f32x2 w3) {
    const f32x2 t1 = cmulc(x1, w1), t2 = cmulc(x2, w2), t3 = cmulc(x3, w3);
    const f32x2 a = x0 + t2, b = x0 - t2, c = t1 + t3, d = t1 - t3;
    x0 = a + c; x1 = rotp(b, d); x2 = a - c; x3 = rotm(b, d);
}
__device__ __forceinline__ void r4i1(f32x2& x0, f32x2& x1, f32x2& x2, f32x2& x3) {
    const f32x2 a = x0 + x2, b = x0 - x2, c = x1 + x3, d = x1 - x3;
    x0 = a + c; x1 = rotp(b, d); x2 = a - c; x3 = rotm(b, d);
}
#define W16_1 ((f32x2){0.92387953251f, -0.38268343237f})
#define W16_2 ((f32x2){0.70710678119f, -0.70710678119f})
#define W16_3 ((f32x2){0.38268343237f, -0.92387953251f})
template <int SP, bool INV> __device__ __forceinline__ void fft_pass16(LAS f32x2* B, const LAS f32x2* T, int tid) {
    constexpr int STEP = (SP == 1024) ? 1040 : (SP == 64 ? 65 : 4);
#pragma unroll
    for (int jj = 0; jj < 2; ++jj) {
        const int q = tid + 512 * jj;
        int k, base;
        if (SP == 1024) { k = q; base = q + (q >> 6); }
        else if (SP == 64) { k = q & 63; const int i0 = (q >> 6) * 1024 + k; base = i0 + (i0 >> 6); }
        else { k = q >> 8; base = (q & 255) * 65 + k; }
        LAS f32x2* p = B + base;
        f32x2 x[16];
#pragma unroll
        for (int m = 0; m < 16; ++m) x[m] = p[m * STEP];
        const f32x2 b = tw_main(T, k * (1024 / SP));
        const f32x2 b2 = cmul(b, b), w = cmul(b2, b2), w2 = cmul(w, w), w3 = cmul(w, w2);
        f32x2 t1[4], t2[4], t3[4];
        t1[0] = b; t1[1] = cmul(b, W16_1); t1[2] = cmul(b, W16_2); t1[3] = cmul(b, W16_3);
#pragma unroll
        for (int m = 0; m < 4; ++m) { t2[m] = cmul(t1[m], t1[m]); t3[m] = cmul(t1[m], t2[m]); }
        if (!INV) {
#pragma unroll
            for (int m = 0; m < 4; ++m) r4f(x[m], x[m + 4], x[m + 8], x[m + 12], t1[m], t2[m], t3[m]);
#pragma unroll
            for (int j = 0; j < 4; ++j) r4f(x[4 * j], x[4 * j + 1], x[4 * j + 2], x[4 * j + 3], w, w2, w3);
        } else {
#pragma unroll
            for (int j = 0; j < 4; ++j) r4i(x[4 * j], x[4 * j + 1], x[4 * j + 2], x[4 * j + 3], w, w2, w3);
#pragma unroll
            for (int m = 0; m < 4; ++m) r4i(x[m], x[m + 4], x[m + 8], x[m + 12], t1[m], t2[m], t3[m]);
        }
#pragma unroll
        for (int m = 0; m < 16; ++m) p[m * STEP] = x[m];
    }
    __syncthreads();
}
template <bool INV> __device__ __forceinline__ void fft_pass4(LAS f32x2* B, int tid) {
#pragma unroll 4
    for (int jj = 0; jj < 8; ++jj) {
        const int q = tid + 512 * jj;
        LAS f32x2* p = B + (q & 255) * 65 + 4 * (q >> 8);
        f32x2 x0 = p[0], x1 = p[1], x2 = p[2], x3 = p[3];
        if (!INV) r4f1(x0, x1, x2, x3); else r4i1(x0, x1, x2, x3);
        p[0] = x0; p[1] = x1; p[2] = x2; p[3] = x3;
    }
    __syncthreads();
}
__device__ __forceinline__ void fft_fwd(LAS f32x2* B, const LAS f32x2* T, int tid) {
    fft_pass16<1024, false>(B, T, tid); fft_pass16<64, false>(B, T, tid); fft_pass16<4, false>(B, T, tid); fft_pass4<false>(B, tid);
}
__device__ __forceinline__ void fft_inv(LAS f32x2* B, const LAS f32x2* T, int tid) {
    fft_pass4<true>(B, tid); fft_pass16<4, true>(B, T, tid); fft_pass16<64, true>(B, T, tid); fft_pass16<1024, true>(B, T, tid);
}
__device__ __forceinline__ void fft_pass4_keep(LAS f32x2* B, int tid, u32x4 (&ks)[8]) {
#pragma unroll
    for (int jj = 0; jj < 8; ++jj) {
        const int q = tid + 512 * jj;
        const LAS f32x2* p = B + (q & 255) * 65 + 4 * (q >> 8);
        f32x2 x0 = p[0], x1 = p[1], x2 = p[2], x3 = p[3];
        r4f1(x0, x1, x2, x3);
        ks[jj].x = cvt_pk_bf16(x0.x, x0.y); ks[jj].y = cvt_pk_bf16(x1.x, x1.y); ks[jj].z = cvt_pk_bf16(x2.x, x2.y); ks[jj].w = cvt_pk_bf16(x3.x, x3.y);
    }
    __syncthreads();
}
__device__ __forceinline__ void fft_mid4(LAS f32x2* B, int tid, const u32x4 (&ks)[8]) {
#pragma unroll
    for (int jj = 0; jj < 8; ++jj) {
        const int q = tid + 512 * jj;
        LAS f32x2* p = B + (q & 255) * 65 + 4 * (q >> 8);
        f32x2 x0 = p[0], x1 = p[1], x2 = p[2], x3 = p[3];
        r4f1(x0, x1, x2, x3);
        x0 = cmul(x0, (f32x2){bflo(ks[jj].x), bfhi(ks[jj].x)}); x1 = cmul(x1, (f32x2){bflo(ks[jj].y), bfhi(ks[jj].y)});
        x2 = cmul(x2, (f32x2){bflo(ks[jj].z), bfhi(ks[jj].z)}); x3 = cmul(x3, (f32x2){bflo(ks[jj].w), bfhi(ks[jj].w)});
        r4i1(x0, x1, x2, x3);
        p[0] = x0; p[1] = x1; p[2] = x2; p[3] = x3;
    }
    __syncthreads();
}
__device__ __forceinline__ void fft_fwd3(LAS f32x2* B, const LAS f32x2* T, int tid) { fft_pass16<1024, false>(B, T, tid); fft_pass16<64, false>(B, T, tid); fft_pass16<4, false>(B, T, tid); }
__device__ __forceinline__ void fft_inv3(LAS f32x2* B, const LAS f32x2* T, int tid) { fft_pass16<4, true>(B, T, tid); fft_pass16<64, true>(B, T, tid); fft_pass16<1024, true>(B, T, tid); }
__device__ __forceinline__ float conv3_at(const bf16* p, int n, int L, float w0, float w1, float w2, float b) {
    const float xm = n > 0 ? bf2f(p[n - 1]) : 0.f, x0 = bf2f(p[n]), xp = n + 1 < L ? bf2f(p[n + 1]) : 0.f;
    return w0 * xm + w1 * x0 + w2 * xp + b;
}
__device__ __forceinline__ float block_sum(Frame& F, float v) {
    LAS float* red = (LAS float*)(F.lds + RED_OFF);
    v = wave_sum(v);
    __syncthreads();
    if (F.lane == 0) red[F.wave] = v;
    __syncthreads();
    float s = 0.f;
#pragma unroll
    for (int w = 0; w < 8; ++w) s += red[w];
    return s;
}
__device__ __forceinline__ f32x4 conv3x4(const bf16* p, int nb, float w0, float w1, float w2, float b) {
    const u32x2 m = *(const u32x2*)(p + nb);
    const float x0 = bflo(m.x), x1 = bfhi(m.x), x2 = bflo(m.y), x3 = bfhi(m.y);
    const float xm = nb > 0 ? bf2f(p[nb - 1]) : 0.f, xp = nb + 4 < SEQ ? bf2f(p[nb + 4]) : 0.f;
    return (f32x4){w0 * xm + w1 * x0 + w2 * x1 + b, w0 * x0 + w1 * x1 + w2 * x2 + b, w0 * x1 + w1 * x2 + w2 * x3 + b, w0 * x2 + w1 * x3 + w2 * xp + b};
}
typedef u32x4 u32x4_a4 __attribute__((aligned(4)));
__device__ __forceinline__ u32x4 ld16u(const bf16* p) { return *(const u32x4_a4*)p; }
__device__ __forceinline__ void conv3p(const u32x4 a, const u32x4 b, bool first, bool last, float w0, float w1, float w2, float bb, f32x2 (&z)[4]) {
    f32x2 X[6];
    X[0] = (f32x2){bfhi(a.x), bfhi(b.x)}; X[1] = (f32x2){bflo(a.y), bflo(b.y)}; X[2] = (f32x2){bfhi(a.y), bfhi(b.y)};
    X[3] = (f32x2){bflo(a.z), bflo(b.z)}; X[4] = (f32x2){bfhi(a.z), bfhi(b.z)}; X[5] = (f32x2){bflo(a.w), bflo(b.w)};
    if (first) X[0] = (f32x2){0.f, 0.f};
    if (last) X[5] = (f32x2){0.f, 0.f};
#pragma unroll
    for (int e = 0; e < 4; ++e) z[e] = X[e] * w0 + (X[e + 1] * w1 + (X[e + 2] * w2 + bb));
}
__device__ __forceinline__ void hyena_unit(Frame& F, const Params& P, int l, int c, bool dummy) {
    LAS f32x2* B = (LAS f32x2*)F.lds; const LAS f32x2* T = (const LAS f32x2*)(F.lds + TW_OFF);
    const bf16* HT = (const bf16*)(F.ws + WS_HT); const bf16* FILT = (const bf16*)(F.ws + WS_FILT);
    f32x4* Z = (f32x4*)(F.ws + WS_KSCR + (size_t)F.bid * 131072);
    u32x4 ksr[8];
    u32x4* ES = (u32x4*)(F.ws + WS_ES + (size_t)F.bid * 131072) + 4096;
    bf16* BR3 = (bf16*)(F.ws + WS_BRV) + 3 * (size_t)MT * 256;
    const float* sw = P.in[I_HSW] + l * 3 * 768; const float* sb = P.in[I_HSB] + l * 768;
    const int tid = F.tid;
#define HY_NB(jp_) (4 * tq + 2048 * (jp_))
#define HY_TQ int tq = tid; asm volatile("" : "+v"(tq))
#define HY_G(T_, base_, boff_) (*(T_*)((char*)(base_) + (unsigned)(boff_)))
#define HY_LDX(row_, nb_) (*(const u32x4_a4*)((const char*)((row_) - 2) + (unsigned)((nb_) * 2)))
#define HY_LDR(hb_, nb_) (*(const u32x4_a4*)((const char*)((hb_) - 2) + (unsigned)((FL - 4 - (nb_)) * 2)))
#define HY_SLOT(nb_) (B + (nb_) + ((nb_) >> 6))
#define HY_TW4(nb_, w_) do { const f32x2 tb_ = T[256 + ((nb_) >> 7)]; const LAS f32x4* tp_ = (const LAS f32x4*)(T + 384 + ((nb_) & 127)); const f32x4 ta_ = tp_[0], tc_ = tp_[1]; \
        w_[0] = cmul(tb_, (f32x2){ta_[0], ta_[1]}); w_[1] = cmul(tb_, (f32x2){ta_[2], ta_[3]}); w_[2] = cmul(tb_, (f32x2){tc_[0], tc_[1]}); w_[3] = cmul(tb_, (f32x2){tc_[2], tc_[3]}); } while (0)
#define HY_ST4(nb_, c0_, c1_, c2_, c3_) do { LAS f32x2* bp_ = HY_SLOT(nb_); bp_[0] = (c0_); bp_[1] = (c1_); bp_[2] = (c2_); bp_[3] = (c3_); } while (0)
#define HY_UNPK(w_) ((f32x2){bflo(w_), bfhi(w_)})
#define HY_FILT4(fw_, gw_, nb_, f4_, r4_) const f32x4 f4_ = (f32x4){bflo(fw_.x), bfhi(fw_.x), bflo(fw_.y), bfhi(fw_.y)};   \
        const f32x4 r4_ = (f32x4){(nb_) ? bflo(gw_.w) : 0.f, bfhi(gw_.z), bflo(gw_.z), bfhi(gw_.y)}
    {
        const bf16* p0 = HT + (size_t)c * MT; const float v0 = sw[c], v1 = sw[768 + c], v2 = sw[1536 + c], vb = sb[c];
        { HY_TQ;
#pragma unroll
        for (int h = 0; h < 2; ++h) {
            u32x4 xa[4], xb[4];
#pragma unroll
            for (int j = 0; j < 4; ++j) { const int nb = HY_NB(4 * h + j); xa[j] = HY_LDX(p0, nb); xb[j] = HY_LDX(p0 + SEQ, nb); }
#pragma unroll
            for (int j = 0; j < 4; ++j) { const int nb = HY_NB(4 * h + j); f32x2 z[4]; conv3p(xa[j], xb[j], nb == 0, nb + 4 == SEQ, v0, v1, v2, vb, z);
                HY_G(f32x4, Z, nb * 8) = (f32x4){z[0].x, z[0].y, z[1].x, z[1].y}; HY_G(f32x4, Z + 1, nb * 8) = (f32x4){z[2].x, z[2].y, z[3].x, z[3].y}; }
        } }
    }
#pragma unroll 1
    for (int o = 0; o < 2; ++o) {
        const bf16* hf = FILT + (size_t)((o * 2 + 0) * 256 + c) * SEQ; const bf16* hb = FILT + (size_t)((o * 2 + 1) * 256 + c) * SEQ;
        float ss = 0.f;
#pragma unroll 1
        for (int par = 0; par < 2; ++par) {
            if (par == 0) {
                { HY_TQ;
#pragma unroll
                for (int h = 0; h < 2; ++h) {
                    u32x2 fw[4]; u32x4 gw[4];
#pragma unroll
                    for (int j = 0; j < 4; ++j) { const int nb = HY_NB(4 * h + j); fw[j] = HY_G(const u32x2, hf, nb * 2); gw[j] = HY_LDR(hb, nb); }
#pragma unroll
                    for (int j = 0; j < 4; ++j) { const int nb = HY_NB(4 * h + j); HY_FILT4(fw[j], gw[j], nb, f4, r4);
                        const f32x4 a = f4 + r4; ss += (f4[0] * f4[0] + f4[1] * f4[1]) + (f4[2] * f4[2] + f4[3] * f4[3]) + (r4[0] * r4[0] + r4[1] * r4[1]) + (r4[2] * r4[2] + r4[3] * r4[3]);
                        HY_ST4(nb, ((f32x2){a[0], 0.f}), ((f32x2){a[1], 0.f}), ((f32x2){a[2], 0.f}), ((f32x2){a[3], 0.f})); }
                } }
                __syncthreads();
            }
            fft_fwd3(B, T, tid); fft_pass4_keep(B, tid, ksr);
            { HY_TQ;
#pragma unroll
            for (int h = 0; h < 2; ++h) {
                f32x4 za[4], zb[4];
#pragma unroll
                for (int j = 0; j < 4; ++j) { const int nb = HY_NB(4 * h + j); za[j] = HY_G(const f32x4, Z, nb * 8); zb[j] = HY_G(const f32x4, Z + 1, nb * 8); }
#pragma unroll
                for (int j = 0; j < 4; ++j) { const int nb = HY_NB(4 * h + j);
                    const f32x2 z0 = (f32x2){za[j].x, za[j].y}, z1 = (f32x2){za[j].z, za[j].w}, z2 = (f32x2){zb[j].x, zb[j].y}, z3 = (f32x2){zb[j].z, zb[j].w};
                    if (par == 0) { HY_ST4(nb, z0, z1, z2, z3); }
                    else { f32x2 tw[4]; HY_TW4(nb, tw); HY_ST4(nb, cmul(z0, tw[0]), cmul(z1, tw[1]), cmul(z2, tw[2]), cmul(z3, tw[3])); } }
            } }
            __syncthreads();
            fft_fwd3(B, T, tid); fft_mid4(B, tid, ksr);
            fft_inv3(B, T, tid);
            if (par == 0) {
                { HY_TQ;
#pragma unroll
                for (int h = 0; h < 2; ++h) {
                    u32x2 fw[4]; u32x4 gw[4];
#pragma unroll
                    for (int j = 0; j < 4; ++j) { const int nb = HY_NB(4 * h + j); fw[j] = HY_G(const u32x2, hf, nb * 2); gw[j] = HY_LDR(hb, nb); }
#pragma unroll
                    for (int j = 0; j < 4; ++j) { const int jp = 4 * h + j, nb = HY_NB(jp); const LAS f32x2* bp = HY_SLOT(nb); const f32x2 a0 = bp[0] * (1.0f / 16384.0f), a1 = bp[1] * (1.0f / 16384.0f), a2 = bp[2] * (1.0f / 16384.0f), a3 = bp[3] * (1.0f / 16384.0f);
                        u32x4 w; w.x = cvt_pk_bf16(a0.x, a0.y); w.y = cvt_pk_bf16(a1.x, a1.y); w.z = cvt_pk_bf16(a2.x, a2.y); w.w = cvt_pk_bf16(a3.x, a3.y); HY_G(u32x4, ES + jp * 512, tq * 16) = w;
                        HY_FILT4(fw[j], gw[j], nb, f4, r4);
                        const f32x4 d = f4 - r4; f32x2 tw[4]; HY_TW4(nb, tw); HY_ST4(nb, tw[0] * d[0], tw[1] * d[1], tw[2] * d[2], tw[3] * d[3]); }
                } }
                __syncthreads();
            }
        }
        const float nrm = (1.0f / sqrtf(block_sum(F, ss) + 1e-6f)) * 0.5f;
        const float hbias = P.in[I_HBI][(l * 2 + o) * 256 + c];
        const int ch = (o + 1) * 256 + c;
        const bf16* px = HT + (size_t)ch * MT; const float w0 = sw[ch], w1 = sw[768 + ch], w2 = sw[1536 + ch], bb = sb[ch];
        { HY_TQ;
#pragma unroll
        for (int h = 0; h < 4; ++h) {
            u32x4 ev[2], xa[2], xb[2]; f32x4 za[2], zb[2];
#pragma unroll
            for (int j = 0; j < 2; ++j) { const int jp = 2 * h + j, nb = HY_NB(jp); ev[j] = HY_G(const u32x4, ES + jp * 512, tq * 16); za[j] = HY_G(const f32x4, Z, nb * 8); zb[j] = HY_G(const f32x4, Z + 1, nb * 8); xa[j] = HY_LDX(px, nb); xb[j] = HY_LDX(px + SEQ, nb); }
#pragma unroll
            for (int j = 0; j < 2; ++j) { const int nb = HY_NB(2 * h + j);
                const LAS f32x2* bp = HY_SLOT(nb); f32x2 w[4]; HY_TW4(nb, w);
                const f32x2 e0 = HY_UNPK(ev[j].x) + cmulc(bp[0], w[0]) * (1.0f / 16384.0f), e1 = HY_UNPK(ev[j].y) + cmulc(bp[1], w[1]) * (1.0f / 16384.0f),
                            e2 = HY_UNPK(ev[j].z) + cmulc(bp[2], w[2]) * (1.0f / 16384.0f), e3 = HY_UNPK(ev[j].w) + cmulc(bp[3], w[3]) * (1.0f / 16384.0f);
                f32x2 x[4]; conv3p(xa[j], xb[j], nb == 0, nb + 4 == SEQ, w0, w1, w2, bb, x);
                const f32x2 y0 = (e0 * nrm + (f32x2){za[j].x, za[j].y} * hbias) * x[0], y1 = (e1 * nrm + (f32x2){za[j].z, za[j].w} * hbias) * x[1],
                            y2 = (e2 * nrm + (f32x2){zb[j].x, zb[j].y} * hbias) * x[2], y3 = (e3 * nrm + (f32x2){zb[j].z, zb[j].w} * hbias) * x[3];
                if (o == 0) { HY_G(f32x4, Z, nb * 8) = (f32x4){y0.x, y0.y, y1.x, y1.y}; HY_G(f32x4, Z + 1, nb * 8) = (f32x4){y2.x, y2.y, y3.x, y3.y}; }
                else if (!dummy) {
                    const unsigned u0 = cvt_pk_bf16(y0.x, y0.y), u1 = cvt_pk_bf16(y1.x, y1.y), u2 = cvt_pk_bf16(y2.x, y2.y), u3 = cvt_pk_bf16(y3.x, y3.y);
                    bf16* q0 = BR3 + c; bf16* q1 = q0 + (size_t)SEQ * 256; const int ob = nb * 512;
                    HY_G(bf16, q0, ob) = (bf16)(u0 & 0xffffu); HY_G(bf16, q0 + 256, ob) = (bf16)(u1 & 0xffffu); HY_G(bf16, q0 + 512, ob) = (bf16)(u2 & 0xffffu); HY_G(bf16, q0 + 768, ob) = (bf16)(u3 & 0xffffu);
                    HY_G(bf16, q1, ob) = (bf16)(u0 >> 16); HY_G(bf16, q1 + 256, ob) = (bf16)(u1 >> 16); HY_G(bf16, q1 + 512, ob) = (bf16)(u2 >> 16); HY_G(bf16, q1 + 768, ob) = (bf16)(u3 >> 16); }
            }
        } }
        __syncthreads();
    }
#undef HY_NB
#undef HY_TQ
#undef HY_G
#undef HY_LDX
#undef HY_LDR
#undef HY_FILT4
#undef HY_TW4
#undef HY_ST4
#undef HY_SLOT
#undef HY_UNPK
}
__device__ __forceinline__ void hyena_ctx_unit(Frame& F, const Params& P, int l, int c) {
    LAS float* zc = (LAS float*)F.lds;
    LAS float* kk = (LAS float*)(F.lds + 4096);
    const bf16* HT = (const bf16*)(F.ws + WS_HT); const float* FC = (const float*)(F.ws + WS_FILTC);
    bf16* BR3 = (bf16*)(F.ws + WS_BRV) + 3 * (size_t)MT * 256;
    const float* sw = P.in[I_HSW] + l * 3 * 768; const float* sb = P.in[I_HSB] + l * 768;
    const int b = F.tid >> 8, t = F.tid & 255;
    float zv = conv3_at(HT + (size_t)c * MT + TL + b * CTXL, t, CTXL, sw[c], sw[768 + c], sw[1536 + c], sb[c]);
    for (int o = 0; o < 2; ++o) {
        const float* hf = FC + (size_t)((o * 2 + 0) * 256 + c) * CTXL; const float* hb = FC + (size_t)((o * 2 + 1) * 256 + c) * CTXL;
        float ss = 0.f;
        if (F.tid < 256) { const float f = hf[F.tid]; kk[255 + F.tid] = f; ss = f * f; }
        else { const int d = F.tid - 256; if (d >= 1) { const float f = hb[d]; kk[255 - d] = f; ss = f * f; } }
        zc[F.tid] = zv;
        const float nrm = 1.0f / sqrtf(block_sum(F, ss) + 1e-6f);
        float y = 0.f;
        for (int s_ = 0; s_ < 256; ++s_) y += kk[t - s_ + 255] * zc[b * 256 + s_];
        y = y * nrm + P.in[I_HBI][(l * 2 + o) * 256 + c] * zv;
        const int ch = (o + 1) * 256 + c;
        zv = conv3_at(HT + (size_t)ch * MT + TL + b * CTXL, t, CTXL, sw[ch], sw[768 + ch], sw[1536 + ch], sb[ch]) * y;
        __syncthreads();
    }
    BR3[(size_t)(TL + b * CTXL + t) * 256 + c] = (bf16)(cvt_pk_bf16(zv, 0.f) & 0xffffu);
}
__device__ __forceinline__ void phase_mixer(Frame& F, const Params& P, int l, bool last) {
    {
        LAS float* rpb = (LAS float*)(F.lds + RPB_OFF); for (int i = F.tid; i < 1860; i += NTHR) rpb[i] = P.in[I_RPB][l * 1860 + i] * 1.44269504089f;
        LAS f32x2* T = (LAS f32x2*)(F.lds + TW_OFF);
        if (F.tid < 512) { const int tb = F.tid >> 7, a = F.tid & 127; const float x = tb == 0 ? (float)a / 128.0f : (tb == 1 ? (float)a / 16384.0f : (tb == 2 ? (float)a / 256.0f : (float)a / 32768.0f));
            float s, cs; sincospif(2.0f * x, &s, &cs); T[F.tid] = (f32x2){cs, -s}; }
        __syncthreads();
    }
#ifndef MIXMASK
#define MIXMASK 63
#endif
    if (MIXMASK & 1) for (int c = F.bid; c < 256; c += F.G) hyena_unit(F, P, l, ((c & 7) << 5) | (c >> 3), false);
    if (MIXDUP & 1) for (int c = F.bid; c < 256; c += F.G) hyena_unit(F, P, l, c, true);
    if (MIXMASK & 2) if (!last) for (int rep_ = 0; rep_ <= ((MIXDUP >> 1) & 1); ++rep_) for (int c = F.bid; c < 256; c += F.G) { hyena_ctx_unit(F, P, l, c); __syncthreads(); }
    const int ntile = (last ? TL : MT) / 64;
    if (MIXMASK & 4) for (int rep_ = 0; rep_ <= ((MIXDUP >> 2) & 1); ++rep_) conformer_tiles(F, P, l, (F.bid + F.G / 2) % F.G, ntile);
    if (MIXMASK & 8) for (int rep_ = 0; rep_ <= ((MIXDUP >> 3) & 1); ++rep_) for (int u = (F.bid + F.G / 4) % F.G; u < ntile; u += F.G) shortconv_unit(F, P, l, u * 64);
    const int gw = F.bid * NWAVES + F.wave, NGW = F.G * NWAVES;
    if (MIXMASK & 16) for (int rep_ = 0; rep_ <= ((MIXDUP >> 4) & 1); ++rep_) for (int task = F.bid; task < 256; task += F.G) {
        const int h = task & 3, b = task >> 7, rb = ((task >> 2) & 31) * 8;
        __syncthreads();
        attn_stage_ctx(F, b, h);
        __syncthreads();
#pragma unroll 1
        for (int it = 0; it < 4; ++it) { int wu = (b << 12) | ((rb + 2 * it + (F.wave >> 2)) << 4) | (h << 2) | (F.wave & 3); asm volatile("" : "+s"(wu));
            attn_wave_unit(F, wu, true, true); }
    }
    if (MIXMASK & 32) if (!last) for (int wu = gw; wu < 128; wu += NGW) attn_wave_unit(F, wu, false, false);
}

__global__ void __launch_bounds__(NTHR, 2) mk_fwd(Params P) {
    extern __shared__ __attribute__((aligned(16))) unsigned char lds_raw[];
    Frame F;
    const int wave0 = __builtin_amdgcn_readfirstlane(threadIdx.x >> 6);
    F.lds = (LAS unsigned char*)lds_raw; F.tid = threadIdx.x; F.lane = F.tid & 63; F.wave = __builtin_amdgcn_readfirstlane(F.tid >> 6); F.bid = blockIdx.x; F.G = gridDim.x; F.ws = P.ws;
    volatile LAS unsigned* MISC = (volatile LAS unsigned*)(F.lds + MISC_OFF);
    if (F.tid < 4) MISC[F.tid] = 0u;
    __syncthreads();
    XcdBarrier bar = xcd_barrier_post((unsigned*)(P.ws + WS_CTL) + 4096, MISC);
    const int lo = P.ph_lo, hi = P.ph_hi;
    int ph = 0;
#define PHASE_BEGIN if (ph >= lo && ph < hi) { { int t_; asm volatile("v_mbcnt_lo_u32_b32 %0, -1, 0\n\tv_mbcnt_hi_u32_b32 %0, -1, %0" : "=v"(t_)); t_ |= wave0 << 6; F.tid = t_; F.lane = t_ & 63; F.wave = __builtin_amdgcn_readfirstlane(t_ >> 6); size_t o_ = 0; asm volatile("" : "+s"(o_)); F.ws = P.ws + o_; }
#define PHASE_END   if (ph + 1 < hi) xcd_barrier(bar, F.tid); } ++ph;
#define MOD ((const float*)(F.ws + WS_MOD))
#define Hc ((const char*)(F.ws + WS_H))

    PHASE_BEGIN if (PHMASK & (1u << 0)) for (int rep_ = 0; rep_ <= (int)((DUPMASK >> 0) & 1u); ++rep_) { prologue_a(F, P); } PHASE_END
    PHASE_BEGIN if (PHMASK & (1u << 1)) for (int rep_ = 0; rep_ <= (int)((DUPMASK >> 1) & 1u); ++rep_) { phase_mod0(F, P); phase_filters(F, P, 0, true); } PHASE_END

    for (int l = 0; l < 2; ++l) {
        const bool last = (l == 1);
#define modl (MOD + (size_t)l * 3 * 9216)
#define xl ((l == 0) ? (const void*)P.in[I_X] : (const void*)P.out)
#define xc ((l == 0) ? P.in[I_CTX] : (const float*)(F.ws + WS_XC))
#define xcw ((const float*)(F.ws + WS_XC))
        PHASE_BEGIN if (PHMASK & (1u << 2)) for (int rep_ = 0; rep_ <= (int)((DUPMASK >> 2) & 1u); ++rep_) { { SchedPlain S{Hc, (const char*)(F.ws + WS_W1T) + (size_t)(l * 2 + 0) * NFF * D, 1024u, 1024u, 8, MT / 256, 22, F.G, F.bid};
            EpiFfnUp E{F.ws + WS_U}; pg8::gemm_phase<EpiFfnUp, SchedPlain, 1>(F.lds, S, E, F.tid); } } PHASE_END
        PHASE_BEGIN if (PHMASK & (1u << 3)) for (int rep_ = 0; rep_ <= (int)((DUPMASK >> 3) & 1u); ++rep_) { { SchedResid<5, 1, 6> S{(const char*)(F.ws + WS_U), (const char*)(F.ws + WS_W2T) + (size_t)(l * 2 + 0) * D * DFF, (unsigned)DFF, 22, F.G, F.bid, true, (const char*)(F.ws + WS_U) + (size_t)TL * DFF};
            EpiRes E{(bf16*)P.out, (l == 0) ? (const void*)P.in[I_X] : (const void*)(F.ws + WS_BRV), l != 0, modl + 2 * D, nullptr, 0.5f / W2_SCALE, (float*)(F.ws + WS_ES),
                (l != 0) ? (const float*)(F.ws + WS_LNS) : nullptr, P.in[I_PLG] + ((l + 1) % 2 * 3 + 2) * D, P.in[I_PLB] + ((l + 1) % 2 * 3 + 2) * D}; pg8::gemm_phase<EpiRes, SchedResid<5, 1, 6>, 1>(F.lds, S, E, F.tid); } } PHASE_END
        PHASE_BEGIN if (PHMASK & (1u << 4)) for (int rep_ = 0; rep_ <= (int)((DUPMASK >> 4) & 1u); ++rep_) { phase_ln(F, P, P.in[I_PLG] + (l * 3 + 0) * D, P.in[I_PLB] + (l * 3 + 0) * D, modl, 3, true, false, true, false, 5, 0.5f / W2_SCALE, modl + (size_t)2 * 9216 + 2 * D, nullptr, xc, true, (const bf16*)P.out); if (l == 1) phase_filters(F, P, 1, false); } PHASE_END
        PHASE_BEGIN if (PHMASK & (1u << 5)) for (int rep_ = 0; rep_ <= (int)((DUPMASK >> 5) & 1u); ++rep_) { { SchedInproj S{Hc, (const char*)(F.ws + WS_WIT) + (size_t)l * PIN * D * 2, MT / 256, F.G, F.bid};
            EpiInproj E{(const float*)(F.ws + WS_BIN) + l * PIN, F.ws};
            pg8::gemm_phase(F.lds, S, E, F.tid); } } PHASE_END
        PHASE_BEGIN if (PHMASK & (1u << 6)) for (int rep_ = 0; rep_ <= (int)((DUPMASK >> 6) & 1u); ++rep_) { phase_mixer(F, P, l, last); } PHASE_END
        const int Mx = last ? TL : MT;
        PHASE_BEGIN if (PHMASK & (1u << 7)) for (int rep_ = 0; rep_ <= (int)((DUPMASK >> 7) & 1u); ++rep_) { { SchedGateBr S{Hc, (const char*)(F.ws + WS_H8L), (const char*)(F.ws + WS_H8C), (const char*)(F.ws + WS_WIT) + ((size_t)l * PIN + NINP) * D * 2, (const char*)(F.ws + WS_BRV), (const char*)(F.ws + WS_WPT) + (size_t)l * 4 * D * 256 * 2, F.G, F.bid, !last};
            EpiGateBr E{(const float*)(F.ws + WS_BIN) + l * PIN + NINP, F.ws + WS_GS + (size_t)F.bid * 393216, (bf16*)(F.ws + WS_MG), (bf16*)(F.ws + WS_MI)}; pg8::gemm_phase<EpiGateBr, SchedGateBr, 2>(F.lds, S, E, F.tid); } } PHASE_END
        PHASE_BEGIN if (PHMASK & (1u << 8)) for (int rep_ = 0; rep_ <= (int)((DUPMASK >> 8) & 1u); ++rep_) { { SchedResid<4, 4> S{(const char*)(F.ws + WS_MG), (const char*)(F.ws + WS_WOT) + (size_t)l * D * D * 2, 2048u, 16, F.G, F.bid, !last, (const char*)(F.ws + WS_MI)};
            EpiRes E{(bf16*)(F.ws + WS_BRV), (const void*)P.out, true, modl + 5 * D, P.in[I_BOUT] + l * D, 1.0f, (float*)(F.ws + WS_ES), (const float*)(F.ws + WS_LNS), P.in[I_PLG] + (l * 3 + 0) * D, P.in[I_PLB] + (l * 3 + 0) * D}; pg8::gemm_phase(F.lds, S, E, F.tid); } } PHASE_END
        PHASE_BEGIN if (PHMASK & (1u << 9)) for (int rep_ = 0; rep_ <= (int)((DUPMASK >> 9) & 1u); ++rep_) { phase_ln(F, P, P.in[I_PLG] + (l * 3 + 1) * D, P.in[I_PLB] + (l * 3 + 1) * D, modl, 6, true, true, false, false, last ? 0 : 16, 1.0f, modl + (size_t)2 * 9216 + 5 * D, P.in[I_BOUT] + l * D, xcw, true, (const bf16*)(F.ws + WS_BRV)); } PHASE_END
        PHASE_BEGIN if (PHMASK & (1u << 10)) for (int rep_ = 0; rep_ <= (int)((DUPMASK >> 10) & 1u); ++rep_) { { SchedPlain S{Hc, (const char*)(F.ws + WS_W1T) + (size_t)(l * 2 + 1) * NFF * D, 1024u, 1024u, 8, Mx / 256, 22, F.G, F.bid};
            EpiFfnUp E{F.ws + WS_U}; pg8::gemm_phase<EpiFfnUp, SchedPlain, 1>(F.lds, S, E, F.tid); } } PHASE_END
        PHASE_BEGIN if (PHMASK & (1u << 11)) for (int rep_ = 0; rep_ <= (int)((DUPMASK >> 11) & 1u); ++rep_) { { SchedResid<5, 1, 6> S{(const char*)(F.ws + WS_U), (const char*)(F.ws + WS_W2T) + (size_t)(l * 2 + 1) * D * DFF, (unsigned)DFF, 22, F.G, F.bid, !last, (const char*)(F.ws + WS_U) + (size_t)TL * DFF};
            EpiRes E{(bf16*)(F.ws + WS_BRV), (const void*)(F.ws + WS_BRV), true, modl + 8 * D, nullptr, 0.5f / W2_SCALE, (float*)(F.ws + WS_ES), (const float*)(F.ws + WS_LNS), P.in[I_PLG] + (l * 3 + 1) * D, P.in[I_PLB] + (l * 3 + 1) * D}; pg8::gemm_phase<EpiRes, SchedResid<5, 1, 6>, 1>(F.lds, S, E, F.tid); } } PHASE_END
        PHASE_BEGIN if (PHMASK & (1u << 12)) for (int rep_ = 0; rep_ <= (int)((DUPMASK >> 12) & 1u); ++rep_) { phase_ln(F, P, P.in[I_PLG] + (l * 3 + 2) * D, P.in[I_PLB] + (l * 3 + 2) * D, MOD + (size_t)3 * 9216  , 0, !last, true, false, last, last ? 0 : 5, 0.5f / W2_SCALE, modl + (size_t)2 * 9216 + 8 * D, nullptr, xcw, !last, (const bf16*)(F.ws + WS_BRV)); } PHASE_END
    }
#undef MOD
#undef Hc
#undef modl
#undef xcw
#undef xc
#undef xl
#undef PHASE_BEGIN
#undef PHASE_END
}

#ifndef MK_N_LAUNCHES
#define MK_N_LAUNCHES 1
#endif
constexpr int N_PHASES = 2 + 2 * 11;
extern "C" void kernel_launch(void* const* d_in, const int* in_sizes, int n_in, void* d_out, int out_size, void* d_ws, size_t ws_size, hipStream_t stream) {
    static int grid = 0;
    if (grid == 0) {
        if (n_in != 33 || out_size != TL * D || ws_size < WS_TOTAL) { fprintf(stderr, "kernel_launch: unexpected shapes (n_in %d out %d ws %zu)\n", n_in, out_size, ws_size); grid = -1; return; }
        int dev = 0, cus = 0;
        if (hipGetDevice(&dev) != hipSuccess || hipDeviceGetAttribute(&cus, hipDeviceAttributeMultiprocessorCount, dev) != hipSuccess) { grid = -1; return; }
        if (hipFuncSetAttribute((const void*)mk_fwd, hipFuncAttributeMaxDynamicSharedMemorySize, LDS_BYTES) != hipSuccess) { fprintf(stderr, "kernel_launch: hipFuncSetAttribute failed\n"); grid = -1; return; }
        int per_cu = 0;
        if (hipOccupancyMaxActiveBlocksPerMultiprocessor(&per_cu, (const void*)mk_fwd, NTHR, LDS_BYTES) != hipSuccess || per_cu < 1) fprintf(stderr, "kernel_launch: occupancy query says %d\n", per_cu);
        (void)hipGetLastError();
        grid = cus;
    }
    if (grid < 0) return;
    (void)hipMemsetAsync((char*)d_ws + WS_CTL, 0, CTL_BYTES, stream);
    Params p{};
    for (int i = 0; i < 33; ++i) p.in[i] = (const float*)d_in[i];
    p.out = (float*)d_out; p.ws = (unsigned char*)d_ws;
#if MK_N_LAUNCHES == 1
    p.ph_lo = 0; p.ph_hi = N_PHASES;
    hipLaunchKernelGGL(mk_fwd, dim3(grid), dim3(NTHR), LDS_BYTES, stream, p);
#else
    for (int i = 0; i < N_PHASES; ++i) { p.ph_lo = i; p.ph_hi = i + 1; hipLaunchKernelGGL(mk_fwd, dim3(grid), dim3(NTHR), LDS_BYTES, stream, p); }
#endif
}
```

```cpp
#include <hip/hip_runtime.h>
#include <cstdio>
#include <cstdint>

#ifndef PHMASK
#define PHMASK 0xFFFFu
#endif
#ifndef DUPMASK
#define DUPMASK 0u
#endif
#ifndef FFTPROBE
#define FFTPROBE 0
#endif
#ifndef EPIDUP
#define EPIDUP 0
#endif
#ifndef MIXDUP
#define MIXDUP 0
#endif
#define LAS __attribute__((address_space(3)))
typedef unsigned short bf16;
typedef short bf16x8 __attribute__((ext_vector_type(8)));
typedef float f32x4 __attribute__((ext_vector_type(4)));
typedef float f32x2 __attribute__((ext_vector_type(2)));
typedef unsigned u32x4 __attribute__((ext_vector_type(4)));
typedef unsigned u32x2 __attribute__((ext_vector_type(2)));

constexpr int D = 1024, SEQ = 16384, TL = 32768, CTXL = 256, TC = 512, MT = TL + TC;
constexpr int DFF = 2816, NFF = 2 * DFF, PIN = 6912, NINP = 2816, NMOD = 9;
constexpr int WA = 256;
constexpr float LN_EPS = 1e-5f, ALPHA = 1.41421356237f, ATT_SCALE = 0.125f;
constexpr int NWAVES = 8, NTHR = 512;

constexpr size_t MiB = 1u << 20;
constexpr size_t WS_CTL = 0, CTL_BYTES = 1 * MiB;
constexpr size_t WS_MOD = 1 * MiB;
constexpr size_t WS_BIN = WS_MOD + 256 * 1024;
constexpr size_t WS_W3T = WS_BIN + 64 * 1024;
constexpr size_t WS_XC = 2 * MiB;
constexpr size_t WS_W1T = 4 * MiB;
constexpr size_t WS_W2T = WS_W1T + (size_t)4 * NFF * D * 2;
constexpr size_t WS_WIT = WS_W2T + (size_t)4 * D * DFF * 2;
constexpr size_t WS_WPT = WS_WIT + (size_t)2 * PIN * D * 2;
constexpr size_t WS_WOT = WS_WPT + (size_t)8 * D * 256 * 2;
constexpr size_t WS_H = WS_WOT + (size_t)2 * D * D * 2;
constexpr size_t WS_BRV = WS_H + (size_t)MT * D * 2;
constexpr size_t WS_FILT = WS_BRV + (size_t)MT * D * 2;
constexpr size_t WS_FILTC = WS_FILT + (size_t)4 * 256 * SEQ * 4;
constexpr size_t WS_H8L = WS_FILT + 32 * MiB;
constexpr size_t WS_LNS = WS_CTL + 64 * 1024;
constexpr size_t WS_H8C = WS_CTL + 512 * 1024;
constexpr size_t WS_U = WS_FILTC + (size_t)4 * 256 * 256 * 4;
constexpr size_t SZ256 = (size_t)MT * 256 * 2;
constexpr size_t WS_UA = WS_U, WS_Q = WS_U + SZ256, WS_K = WS_U + 2 * SZ256, WS_SB = WS_U + 3 * SZ256, WS_W = WS_U + 4 * SZ256;
constexpr size_t WS_VT = WS_U + 5 * SZ256;
constexpr size_t WS_HT = WS_U + 6 * SZ256;
constexpr size_t WS_KSCR = WS_U + 9 * SZ256;
constexpr size_t WS_MG = WS_U;
constexpr size_t WS_GS = WS_U + 4 * SZ256;
constexpr size_t WS_MI = WS_GS + (size_t)256 * 393216;
constexpr size_t WS_END = WS_U + (size_t)MT * DFF * 2;
static_assert(WS_KSCR + (size_t)256 * 131072 <= WS_END, "kscr");
static_assert(WS_MI + (size_t)4 * TC * D * 2 <= WS_END, "gs/mi");
constexpr size_t WS_ES = WS_END;
constexpr size_t WS_TOTAL = WS_ES + (size_t)256 * 131072;
static_assert(WS_TOTAL <= 512 * MiB, "ws");
static_assert(WS_BIN + 2 * PIN * 4 <= WS_W3T && WS_W3T + 2 * 1024 * 64 * 2 <= WS_XC && WS_MOD + 2 * 3 * 9216 * 4 <= WS_BIN, "small");

constexpr int RING_BYTES = 131072;
constexpr int FFT_BYTES = 133120;
constexpr int TW_OFF = FFT_BYTES;
constexpr int RPB_OFF = TW_OFF + 4096;
constexpr int RED_OFF = RPB_OFF + 7680;
constexpr int MISC_OFF = RED_OFF + 256;
constexpr int LDS_BYTES = 147456;
static_assert(MISC_OFF + 64 <= LDS_BYTES, "lds");

typedef __bf16 bf16x2_t __attribute__((ext_vector_type(2)));
__device__ __forceinline__ unsigned cvt_pk_bf16(float lo, float hi) { const f32x2 v = {lo, hi}; const bf16x2_t b = __builtin_convertvector(v, bf16x2_t); return __builtin_bit_cast(unsigned, b); }
typedef int v8i __attribute__((ext_vector_type(8)));
typedef int i32x4 __attribute__((ext_vector_type(4)));
__device__ __forceinline__ float sat8(float x) { return __builtin_amdgcn_fmed3f(x, -448.0f, 448.0f); }
__device__ __forceinline__ unsigned pk_fp8x4(float a, float b, float c, float d) { int p = 0; p = __builtin_amdgcn_cvt_pk_fp8_f32(sat8(a), sat8(b), p, false); p = __builtin_amdgcn_cvt_pk_fp8_f32(sat8(c), sat8(d), p, true); return (unsigned)p; }
constexpr float W1_SCALE = 32.0f, W2_SCALE = 64.0f;
__device__ __forceinline__ float bf2f(unsigned short b) { return __uint_as_float(((unsigned)b) << 16); }
__device__ __forceinline__ float bflo(unsigned w) { return __uint_as_float(w << 16); }
__device__ __forceinline__ float bfhi(unsigned w) { return __uint_as_float(w & 0xffff0000u); }
__device__ __forceinline__ float sigmoidf_(float x) { return __builtin_amdgcn_rcpf(1.0f + __builtin_amdgcn_exp2f(x * -1.44269504089f)); }
__device__ __forceinline__ float siluf_(float x) { return x * __builtin_amdgcn_rcpf(1.0f + __builtin_amdgcn_exp2f(x * -1.44269504089f)); }
__device__ __forceinline__ int lane_now() { int l_; asm volatile("v_mbcnt_lo_u32_b32 %0, -1, 0\n\tv_mbcnt_hi_u32_b32 %0, -1, %0" : "=v"(l_)); return l_; }
__device__ __forceinline__ float xrow_max(float v) {
    const unsigned a = __builtin_bit_cast(unsigned, v); auto r = __builtin_amdgcn_permlane16_swap(a, a, false, false);
    v = fmaxf(__builtin_bit_cast(float, (unsigned)r[0]), __builtin_bit_cast(float, (unsigned)r[1]));
    const unsigned b = __builtin_bit_cast(unsigned, v); auto q = __builtin_amdgcn_permlane32_swap(b, b, false, false);
    return fmaxf(__builtin_bit_cast(float, (unsigned)q[0]), __builtin_bit_cast(float, (unsigned)q[1]));
}
__device__ __forceinline__ float xrow_sum(float v) {
    const unsigned a = __builtin_bit_cast(unsigned, v); auto r = __builtin_amdgcn_permlane16_swap(a, a, false, false);
    v = __builtin_bit_cast(float, (unsigned)r[0]) + __builtin_bit_cast(float, (unsigned)r[1]);
    const unsigned b = __builtin_bit_cast(unsigned, v); auto q = __builtin_amdgcn_permlane32_swap(b, b, false, false);
    return __builtin_bit_cast(float, (unsigned)q[0]) + __builtin_bit_cast(float, (unsigned)q[1]);
}
__device__ __forceinline__ float shx(float v, int o, int lane) { return __builtin_bit_cast(float, __builtin_amdgcn_ds_bpermute((lane ^ o) << 2, __builtin_bit_cast(int, v))); }
#define DPP_F(v_, ctrl_) __builtin_bit_cast(float, __builtin_amdgcn_update_dpp(0, __builtin_bit_cast(int, (v_)), (ctrl_), 0xF, 0xF, true))
__device__ __forceinline__ float wave_sum(float v) {
    v += DPP_F(v, 0xB1);
    v += DPP_F(v, 0x4E);
    v += DPP_F(v, 0x141);
    v += DPP_F(v, 0x140);
    const int iv = __builtin_bit_cast(int, v);
    const float r0 = __builtin_bit_cast(float, __builtin_amdgcn_readlane(iv, 0)), r1 = __builtin_bit_cast(float, __builtin_amdgcn_readlane(iv, 16)),
                r2 = __builtin_bit_cast(float, __builtin_amdgcn_readlane(iv, 32)), r3 = __builtin_bit_cast(float, __builtin_amdgcn_readlane(iv, 48));
    return (r0 + r1) + (r2 + r3);
}
#define LDS_WAIT() asm volatile("s_waitcnt lgkmcnt(0)" ::: "memory")

#define XB_TMO      128
#define XB_XCNT(j)  (256  + 64 * (j))
#define XB_XSUB(j)  (1280 + 64 * (j))
#define XB_XGEN(j)  (2304 + 64 * (j))
#define XB_TOP      3328
#define XB_TOPGEN   3392
#define XCD_BAR_WORDS 3456
#define XB_SPIN_CAP (1u << 20)
__device__ __forceinline__ unsigned xb_ld(unsigned* p)              { return __hip_atomic_load(p, __ATOMIC_RELAXED, __HIP_MEMORY_SCOPE_AGENT); }
__device__ __forceinline__ unsigned xb_add(unsigned* p, unsigned v) { return __hip_atomic_fetch_add(p, v, __ATOMIC_RELAXED, __HIP_MEMORY_SCOPE_AGENT); }
__device__ __forceinline__ unsigned xb_xcc_id() { return (unsigned)__builtin_amdgcn_s_getreg((3 << 11) | 20) & 0xFu; }
#define XB_SPIN(cond, bar) do { unsigned _sp = 0; while (cond) { __builtin_amdgcn_s_sleep(1); \
    if ((++_sp & 255u) == 0u) { if (xb_ld(&(bar)[XB_TMO])) break; if (_sp > XB_SPIN_CAP) { atomicAdd(&(bar)[XB_TMO], 1u); break; } } } } while (0)
struct XcdBarrier { unsigned* bar; unsigned x; volatile LAS unsigned* st; };
__device__ __forceinline__ XcdBarrier xcd_barrier_post(unsigned* bar, volatile LAS unsigned* st) {
    XcdBarrier b; b.bar = bar; b.x = xb_xcc_id(); b.st = st;
    if (threadIdx.x == 0) (void)xb_add(&bar[XB_XCNT(b.x)], 1u);
    return b;
}
__device__ __forceinline__ void xcd_barrier_complete(unsigned* bar, unsigned x, unsigned& nloc, unsigned& nx) {
    const unsigned G = gridDim.x * gridDim.y * gridDim.z;
    unsigned sum, cnt, mine, sp = 0u;
    for (;;) {
        sum = 0u; cnt = 0u; mine = 0u;
#pragma unroll
        for (unsigned j = 0; j < 16; ++j) { const unsigned c = xb_ld(&bar[XB_XCNT(j)]); sum += c; cnt += (c > 0u) ? 1u : 0u; mine = (j == x) ? c : mine; }
        if (sum == G) break;
        __builtin_amdgcn_s_sleep(1);
        if ((++sp & 255u) == 0u) { if (xb_ld(&bar[XB_TMO])) break; if (sp > XB_SPIN_CAP) { atomicAdd(&bar[XB_TMO], 1u); break; } }
    }
    nloc = mine > 0u ? mine : 1u; nx = cnt > 0u ? cnt : 1u;
}
__device__ __forceinline__ void xcd_barrier(const XcdBarrier& b, int tid) {
    asm volatile("s_waitcnt vmcnt(0)" ::: "memory");
    __syncthreads();
    if (tid == 0) {
        unsigned* bar = b.bar;
        __builtin_amdgcn_s_waitcnt(0);
        unsigned nloc = b.st[0], nx = b.st[1];
        if (nloc == 0u) { xcd_barrier_complete(bar, b.x, nloc, nx); b.st[0] = nloc; b.st[1] = nx; }
        const unsigned old = xb_add(&bar[XB_XSUB(b.x)], 1u);
        const unsigned gen = old / nloc;
        if (old + 1u == (gen + 1u) * nloc) {
            __builtin_amdgcn_fence(__ATOMIC_RELEASE, "agent");
            asm volatile("s_waitcnt vmcnt(0)" ::: "memory");
            const unsigned og = xb_add(&bar[XB_TOP], 1u);
            const unsigned tg = og / nx;
            if (og + 1u == (tg + 1u) * nx) xb_add(&bar[XB_TOPGEN], 1u);
            else XB_SPIN(xb_ld(&bar[XB_TOPGEN]) == tg, bar);
            __builtin_amdgcn_fence(__ATOMIC_ACQUIRE, "agent");
            xb_add(&bar[XB_XGEN(b.x)], 1u);
            asm volatile("s_waitcnt vmcnt(0)" ::: "memory");
        } else {
            XB_SPIN(xb_ld(&bar[XB_XGEN(b.x)]) == gen, bar);
            __builtin_amdgcn_fence(__ATOMIC_ACQUIRE, "agent");
            asm volatile("s_waitcnt vmcnt(0)" ::: "memory");
        }
    }
    __syncthreads();
}

namespace pg8 {
constexpr int BM = 256, BK = 64, HALF = 128, HTB = HALF * BK * 2, NXCD = 8, WGM = 8;
__host__ __device__ __forceinline__ int lds_byte(int r, int c) { const int st = (r >> 4) * 2 + (c >> 5), rr = r & 15, cc = c & 31, ob = rr * 64 + cc * 2; return st * 1024 + (ob ^ (((ob >> 9) & 1) << 5)); }
__host__ __device__ __forceinline__ void stage_rc(int b, int& R, int& C) { const int st = b / 1024, sb = b % 1024, swz = sb ^ (((sb >> 9) & 1) << 5); R = (st >> 1) * 16 + swz / 64; C = (st & 1) * 32 + (swz % 64) / 2; }
__host__ __device__ __forceinline__ int perm32(int rho) { const int n = rho >> 4, i = rho & 15; return 8 * (i >> 2) + 4 * n + (i & 3); }

struct GUnit { const char* A; const char* B; unsigned lda, ldb; int nt; int pm, pn, kind; bool f8; };

__device__ __forceinline__ bool static_tile(int i, int G, int c, int nM, int nN, int& pm, int& pn) {
    const int nwg = nM * nN; const long L = (long)i * G + c; if (L >= nwg) return false;
    int wgid = (int)L; { const int q = nwg / NXCD, r = nwg % NXCD, xcd = wgid % NXCD, off = wgid / NXCD; wgid = (xcd < r ? xcd * (q + 1) : r * (q + 1) + (xcd - r) * q) + off; }
    const int nig = WGM * nN, gid = wgid / nig, fm = gid * WGM, gsz = (nM - fm) < WGM ? (nM - fm) : WGM;
    pm = fm + ((wgid % nig) % gsz); pn = (wgid % nig) / gsz; return true;
}

template <class Epi, class Sched, int F8M = 0  >
__device__ __forceinline__ void gemm_phase(LAS unsigned char* lds, const Sched& S, const Epi& E, int tid_in) {
    int tid_ = tid_in; asm volatile("" : "+v"(tid_));
    const int tid = tid_, wid = __builtin_amdgcn_readfirstlane(tid >> 6), lane = tid & 63, wr = wid >> 2, wc = wid & 3, fr = lane & 15, fq = lane >> 4;
    unsigned RA[2], RB[2], CC[2];
#pragma unroll
    for (int i = 0; i < 2; ++i) { int R, C; stage_rc(tid * 16 + i * 8192, R, C); RA[i] = (unsigned)R; RB[i] = (unsigned)((R & ~31) + perm32(R & 31)); CC[i] = (unsigned)C * 2u; }
    const size_t kstep = (size_t)(BK * 2);
    const unsigned ldsw = (unsigned)wid * 1024u;
#define PG8_SA(b, h) (((b) * 2 + (h)) * HTB)
#define PG8_SB(b, h) ((4 + (b) * 2 + (h)) * HTB)
#define PG8_STAGE(bufoff, gbase, RR, ld) do { _Pragma("unroll") for (int _i = 0; _i < 2; ++_i) \
        __builtin_amdgcn_global_load_lds((const unsigned*)((const char*)(gbase) + ((RR)[_i] * (ld) + CC[_i])), (LAS unsigned*)(lds + (bufoff) + ldsw + _i * 8192), 16, 0, 0); } while (0)
#define PG8_LDA(F8C, dst, b, h) do { _Pragma("unroll") for (int m = 0; m < 4; ++m) { dst[m][0] = *(const LAS i32x4*)(lds + PG8_SA(b, h) + ao0 + m * 2048); dst[m][1] = *(const LAS i32x4*)(lds + PG8_SA(b, h) + ao1 + m * 2048); } } while (0)
#define PG8_LDB(F8C, dst, b, h) do { _Pragma("unroll") for (int n = 0; n < 2; ++n) { dst[n][0] = *(const LAS i32x4*)(lds + PG8_SB(b, h) + bo0 + n * 2048); dst[n][1] = *(const LAS i32x4*)(lds + PG8_SB(b, h) + bo1 + n * 2048); } } while (0)
#define PG8_V8(x) __builtin_shufflevector((x)[0], (x)[1], 0, 1, 2, 3, 4, 5, 6, 7)
#define PG8_MMA(F8C, ai, bj, At, Bt) do { __builtin_amdgcn_s_setprio(1); if constexpr (F8C) { _Pragma("unroll") for (int m = 0; m < 4; ++m) _Pragma("unroll") for (int n = 0; n < 2; ++n) \
            { const v8i b8_ = PG8_V8(Bt[n]), a8_ = PG8_V8(At[m]); asm volatile("v_mfma_scale_f32_16x16x128_f8f6f4 %0, %1, %2, %0, %3, %3 op_sel_hi:[0,0,0]" : "+v"(acc[ai][bj][m][n]) : "v"(b8_), "v"(a8_), "v"(one_scale)); } } \
        else { _Pragma("unroll") for (int m = 0; m < 4; ++m) _Pragma("unroll") for (int n = 0; n < 2; ++n) _Pragma("unroll") for (int k = 0; k < 2; ++k) \
            acc[ai][bj][m][n] = __builtin_amdgcn_mfma_f32_16x16x32_bf16(__builtin_bit_cast(bf16x8, Bt[n][k]), __builtin_bit_cast(bf16x8, At[m][k]), acc[ai][bj][m][n], 0, 0, 0); } __builtin_amdgcn_s_setprio(0); } while (0)
#define PG8_TRIP(F8C, WN) { \
            const bool last = (t == nt - 2); \
            const char* a1 = cA + (size_t)(t + 1) * kstep; \
            const char* a2 = last ? nA : cA + (size_t)(t + 2) * kstep; const char* b2 = last ? nB : cB + (size_t)(t + 2) * kstep; \
            const char* a3 = a2 + kstep; const char* b3 = b2 + kstep; \
            const unsigned xldA = last ? nldA : ldA, xldB = last ? nldB : ldB; const size_t xhsA = last ? nhsA : hsA, xhsB = last ? nhsB : hsB; \
            PG8_LDB(F8C, B0, 0, 0); PG8_LDB(F8C, B1, 0, 1); PG8_SCHED; PG8_LDA(F8C, At, 0, 0); PG8_STAGE(PG8_SA(1, 1), a1 + hsA, RA, ldA); \
            PG8_WAIT_V(WN); PG8_WAIT_L(0); PG8_BAR; PG8_MMA(F8C, 0, 0, At, B0); PG8_MMA(F8C, 0, 1, At, B1); PG8_BAR; PG8_SCHED; \
            PG8_LDA(F8C, At, 0, 1); PG8_STAGE(PG8_SB(0, 0), b2, RB, xldB); PG8_STAGE(PG8_SB(0, 1), b2 + xhsB, RB, xldB); PG8_STAGE(PG8_SA(0, 0), a2, RA, xldA); \
            PG8_WAIT_V(WN); PG8_WAIT_L(0); PG8_BAR; PG8_MMA(F8C, 1, 0, At, B0); PG8_MMA(F8C, 1, 1, At, B1); PG8_BAR; PG8_SCHED; \
            PG8_LDB(F8C, B0, 1, 0); PG8_LDB(F8C, B1, 1, 1); PG8_SCHED; PG8_LDA(F8C, At, 1, 0); PG8_STAGE(PG8_SA(0, 1), a2 + xhsA, RA, xldA); \
            PG8_WAIT_V(8); PG8_WAIT_L(0); PG8_BAR; PG8_MMA(F8C, 0, 0, At, B0); PG8_MMA(F8C, 0, 1, At, B1); PG8_BAR; PG8_SCHED; \
            PG8_LDA(F8C, At, 1, 1); PG8_STAGE(PG8_SB(1, 0), b3, RB, xldB); PG8_STAGE(PG8_SB(1, 1), b3 + xhsB, RB, xldB); PG8_STAGE(PG8_SA(1, 0), a3, RA, xldA); \
            PG8_WAIT_V(8); PG8_WAIT_L(0); PG8_BAR; PG8_MMA(F8C, 1, 0, At, B0); PG8_MMA(F8C, 1, 1, At, B1); PG8_BAR; PG8_SCHED; \
        }
#define PG8_KLOOP(F8C) const int ln_ = lane_now();   \
        const int fr_ = ln_ & 15, fq_ = ln_ >> 4; \
        const int ao0 = lds_byte(wr * 64 + fr_, (F8C) ? 16 * fq_ : 8 * fq_), ao1 = (F8C) ? lds_byte(wr * 64 + fr_, 16 * fq_ + 8) : ao0 + 1024; \
        const int bo0 = lds_byte(wc * 32 + fr_, (F8C) ? 16 * fq_ : 8 * fq_), bo1 = (F8C) ? lds_byte(wc * 32 + fr_, 16 * fq_ + 8) : bo0 + 1024; \
        int t = 0; \
        if constexpr (Epi::NST == 8) { if (ui > 0) { PG8_TRIP(F8C, 16) t = 2; } } \
        for (; t < nt; t += 2) PG8_TRIP(F8C, 8)
#define PG8_WAIT_V(n) asm volatile("s_waitcnt vmcnt(" #n ")" ::: "memory")
#define PG8_WAIT_L(n) asm volatile("s_waitcnt lgkmcnt(" #n ")" ::: "memory")
#define PG8_BAR __builtin_amdgcn_s_barrier()
#define PG8_SCHED __builtin_amdgcn_sched_barrier(0)
    GUnit cur, nxt; int ui = 0;
    if (!S.next(0, cur)) return;
    f32x4 acc[2][2][4][2];
#pragma unroll
    for (int a = 0; a < 2; ++a)
#pragma unroll
        for (int b = 0; b < 2; ++b)
#pragma unroll
            for (int m = 0; m < 4; ++m)
#pragma unroll
                for (int n = 0; n < 2; ++n) acc[a][b][m][n] = (f32x4){0.f, 0.f, 0.f, 0.f};
    i32x4 At[4][2], B0[2][2], B1[2][2];
    int one_scale = 0x7F7F7F7F; asm volatile("" : "+v"(one_scale));
    const char* cA = cur.A; const char* cB = cur.B;
    unsigned ldA = cur.lda, ldB = cur.ldb; size_t hsA = (size_t)HALF * ldA, hsB = (size_t)HALF * ldB;
    PG8_STAGE(PG8_SB(0, 0), cB, RB, ldB); PG8_STAGE(PG8_SB(0, 1), cB + hsB, RB, ldB); PG8_STAGE(PG8_SA(0, 0), cA, RA, ldA); PG8_STAGE(PG8_SA(0, 1), cA + hsA, RA, ldA);
    if (wr == 1) PG8_BAR;
    PG8_WAIT_V(2); PG8_BAR;
    PG8_STAGE(PG8_SB(1, 0), cB + kstep, RB, ldB); PG8_STAGE(PG8_SA(1, 0), cA + kstep, RA, ldA); PG8_STAGE(PG8_SB(1, 1), cB + hsB + kstep, RB, ldB);
    PG8_WAIT_V(6); PG8_BAR;
    for (;;) {
        const bool has_next = S.next(ui + 1, nxt);
        const char* nA = has_next ? nxt.A : cA; const char* nB = has_next ? nxt.B : cB;
        const unsigned nldA = has_next ? nxt.lda : ldA, nldB = has_next ? nxt.ldb : ldB;
        const size_t nhsA = (size_t)HALF * nldA, nhsB = (size_t)HALF * nldB;
        const int nt = cur.nt;
        if constexpr (F8M == 2) { if (cur.f8) { PG8_KLOOP(true) } else { PG8_KLOOP(false) } }
        else if constexpr (F8M == 1) { PG8_KLOOP(true) }
        else { PG8_KLOOP(false) }
        if (wr == 0) PG8_BAR;
        if constexpr (F8M != 0) asm volatile("s_nop 15\n\ts_nop 15" ::: "memory");
        { const int le_ = lane_now(); E(acc, cur, (wid << 6) | le_, wr, wc, le_ & 15, le_ >> 4); }
        if (!has_next) break;
#pragma unroll
        for (int a = 0; a < 2; ++a)
#pragma unroll
            for (int b = 0; b < 2; ++b)
#pragma unroll
                for (int m = 0; m < 4; ++m)
#pragma unroll
                    for (int n = 0; n < 2; ++n) acc[a][b][m][n] = (f32x4){0.f, 0.f, 0.f, 0.f};
        cur = nxt; cA = nA; cB = nB; hsA = nhsA; hsB = nhsB; ldA = nldA; ldB = nldB; ++ui;
        if (wr == 1) PG8_BAR;
    }
    PG8_WAIT_V(0);
    PG8_BAR;
#undef PG8_SA
#undef PG8_SB
#undef PG8_STAGE
#undef PG8_LDA
#undef PG8_KLOOP
#undef PG8_TRIP
#undef PG8_V8
#undef PG8_LDB
#undef PG8_MMA
#undef PG8_WAIT_V
#undef PG8_WAIT_L
#undef PG8_BAR
#undef PG8_SCHED
}
}
using pg8::GUnit;
typedef f32x4 Acc[2][2][4][2];

struct Params {
    const float* in[33];
    float* out;
    unsigned char* ws;
    int ph_lo, ph_hi;
};
enum { I_X = 0, I_C, I_CTX, I_CCTX, I_WMOD, I_BMOD, I_PLG, I_PLB, I_FWI, I_FWO, I_WIN, I_BIN, I_CDW, I_CDB, I_CLG, I_CLB, I_CWP, I_RPB, I_NWP, I_SCW, I_SWP,
       I_HSW, I_HSB, I_HW1, I_HB1, I_HW2, I_HB2, I_HFQ, I_HW3, I_HBI, I_HWP, I_WOUT, I_BOUT };

__device__ __forceinline__ int row_grp(int pm) { return pm < 64 ? 0 : (pm < 128 ? 1 : 2); }

struct SchedPlain {
    const char* A; const char* B; unsigned lda, ldb; int nt, nM, nN, G, c;
    __device__ __forceinline__ bool next(int i, GUnit& u) const {
        int pm, pn; if (!pg8::static_tile(i, G, c, nM, nN, pm, pn)) return false;
        u.A = A + (size_t)pm * 256 * lda; u.B = B + (size_t)pn * 256 * ldb; u.lda = lda; u.ldb = ldb; u.nt = nt; u.pm = pm; u.pn = pn; u.kind = 0; u.f8 = true; return true;
    }
};
template <int NKS, int NSRC, int NTLAST = 4> struct SchedResid {
    const char* A; const char* B; unsigned ld; int nt, G, c; bool ctx; const char* Ac;
    __device__ __forceinline__ bool next(int i, GUnit& u) const {
        int pm, pn; u.lda = ld; u.ldb = ld; u.f8 = true;
        if (pg8::static_tile(i, G, c, TL / 256, 4, pm, pn)) { u.A = A + (size_t)pm * 256 * ld; u.B = B + (size_t)pn * 256 * ld; u.nt = nt; u.pm = pm; u.pn = pn; u.kind = 0; return true; }
        constexpr int NK = NKS * NSRC;
        const int j = i * G + c - (TL / 256) * 4; if (!ctx || j < 0 || j >= 8 * NK) return false;
        const int panel = j / (4 * NK), rem = j % (4 * NK), kk = rem % NK, src = kk / NKS, ks = kk % NKS; pn = rem / NK;
        u.A = Ac + ((size_t)src * TC + panel * 256) * ld + ks * 512; u.B = B + (size_t)pn * 256 * ld + ks * 512; u.nt = (ks == NKS - 1) ? NTLAST : 4; u.pm = TL / 256 + panel; u.pn = pn; u.kind = 1 + kk; return true;
    }
};
enum { KI_GLU = 0, KI_PLAIN = 1, KI_PAIR = 2, KI_TRANS = 3 };
struct SchedInproj {
    const char* ws; int l, nM, G, c;
    __device__ __forceinline__ bool next(int i, GUnit& u) const {
        int pm, pn; if (!pg8::static_tile(i, G, c, nM, 11, pm, pn)) return false;
        const bool tr = (pn == 4) || (pn >= 8), f8 = pn < 8;
        const char* a; const char* b;
        if (f8) { a = (pm < TL / 256) ? ws + WS_H8L + (size_t)pm * 256 * 1024 : ws + WS_H8C + (size_t)(pm - TL / 256) * 256 * 1024; b = ws + WS_WIT + ((size_t)l * PIN + NINP) * D * 2 + 6 * MiB + (size_t)pn * 256 * 1024; u.lda = 1024; u.ldb = 1024; u.nt = 8; }
        else { a = ws + WS_H + (size_t)pm * 256 * 2048; b = ws + WS_WIT + (size_t)l * PIN * D * 2 + (size_t)pn * 256 * 2048; u.lda = 2048; u.ldb = 2048; u.nt = 16; }
        u.A = tr ? b : a; u.B = tr ? a : b; u.pm = pm; u.pn = pn; u.f8 = f8;
        u.kind = tr ? KI_TRANS : (pn < 2 ? KI_GLU : (pn == 6 || pn == 7 ? KI_PAIR : KI_PLAIN)); return true;
    }
};
struct SchedGateBr {
    const char* HB  ; const char* H; const char* HC  ; const char* WG  ; const char* BR; const char* WP; int G, c; bool ctx;
    __device__ __forceinline__ bool next(int i, GUnit& u) const {
        int pm, pn, j, br;
        if (pg8::static_tile(i >> 3, G, c, TL / 256, 4, pm, pn)) { j = i & 7; br = j >> 1; }
        else {
            const int ntl = ((TL / 256) * 4 - c + G - 1) / G, e = i - 8 * ntl;
            if (!ctx || c >= 32 || e < 0 || e > 1) return false;
            pm = TL / 256 + (c >> 4); pn = (c >> 2) & 3; br = c & 3; j = 8 + 2 * br + e;
        }
        if ((j & 1) == 0) { u.A = (pm < TL / 256) ? H + (size_t)pm * 256 * 1024 : HC + (size_t)(pm - TL / 256) * 256 * 1024; u.B = WG + (size_t)(br * 1024 + pn * 256) * 1024; u.lda = 1024; u.ldb = 1024; u.nt = 8; u.f8 = true; }
        else { u.A = BR + (size_t)br * SZ256 + (size_t)pm * 256 * 512; u.B = WP + (size_t)(br * 1024 + pn * 256) * 512; u.lda = 512; u.ldb = 512; u.nt = 4; u.f8 = false; }
        u.pm = pm; u.pn = pn; u.kind = j; return true;
    }
};

struct EpiFfnUp {
    static constexpr bool DUP_OK = true; static constexpr int NST = 8;
    unsigned char* U;
    __device__ __forceinline__ void operator()(const Acc& acc, const GUnit& u, int tid, int wr, int wc, int fr, int fq) const {
        const int row0 = u.pm * 256 + wr * 64 + fr, col0 = u.pn * 128 + wc * 32 + 8 * fq;
        constexpr float IS = 1.0f / W1_SCALE;
#pragma unroll
        for (int ai = 0; ai < 2; ++ai)
#pragma unroll
            for (int m = 0; m < 4; ++m) {
                const f32x4 a0 = acc[ai][0][m][0] * IS, a1 = acc[ai][0][m][1] * IS, g0 = acc[ai][1][m][0] * IS, g1 = acc[ai][1][m][1] * IS;
                u32x2 w; w.x = pk_fp8x4(siluf_(g0[0]) * a0[0], siluf_(g0[1]) * a0[1], siluf_(g0[2]) * a0[2], siluf_(g0[3]) * a0[3]);
                w.y = pk_fp8x4(siluf_(g1[0]) * a1[0], siluf_(g1[1]) * a1[1], siluf_(g1[2]) * a1[2], siluf_(g1[3]) * a1[3]);
                *(u32x2*)(U + (size_t)(row0 + ai * 128 + m * 16) * DFF + col0) = w;
            }
    }
};
struct EpiRes {
    static constexpr bool DUP_OK = false; static constexpr int NST = 0;
    bf16* V; const void* xl; bool xbf  ; const float* modl  ; const float* bias; float coef; float* part;
    const float* xstat; const float* xg; const float* xbt;
    __device__ __forceinline__ void operator()(const Acc& acc, const GUnit& u, int tid, int wr, int wc, int fr, int fq) const {
        int row0 = u.pm * 256 + wr * 64 + fr, colt = u.pn * 256 + wc * 32 + 8 * fq; asm volatile("" : "+v"(row0), "+v"(colt));
        if (u.kind != 0) {
            float* pp = part + ((size_t)(u.kind - 1) * TC + (row0 - TL)) * D + colt;
#pragma unroll
            for (int ai = 0; ai < 2; ++ai)
#pragma unroll
                for (int m = 0; m < 4; ++m)
#pragma unroll
                    for (int bj = 0; bj < 2; ++bj) { float* q = pp + (size_t)(ai * 128 + m * 16) * D + bj * 128; *(f32x4*)q = acc[ai][bj][m][0]; *(f32x4*)(q + 4) = acc[ai][bj][m][1]; }
            return;
        }
        if (xstat) body_ln(acc, u, row0, colt); else if (xbf) body<true>(acc, u, row0, colt); else body<false>(acc, u, row0, colt);
    }
    template <bool XB> __device__ __forceinline__ void body(const Acc& acc, const GUnit& u, int row0, int colt) const {
        const float* mv = modl + (size_t)row_grp(u.pm) * 9216;
        f32x4 sc[2][2], bv[2][2];
#pragma unroll
        for (int bj = 0; bj < 2; ++bj)
#pragma unroll
            for (int n = 0; n < 2; ++n) { sc[bj][n] = *(const f32x4*)(mv + colt + bj * 128 + 4 * n) * coef;
                bv[bj][n] = bias ? *(const f32x4*)(bias + colt + bj * 128 + 4 * n) : (f32x4){0.f, 0.f, 0.f, 0.f}; }
#pragma unroll
        for (int ai = 0; ai < 2; ++ai) {
            bf16* vp = V + (size_t)(row0 + ai * 128) * D + colt;
            if constexpr (XB) {
                const bf16* xh = (const bf16*)xl + (size_t)(row0 + ai * 128) * D + colt;
                u32x4 xw[4][2];
#pragma unroll
                for (int m = 0; m < 4; ++m)
#pragma unroll
                    for (int bj = 0; bj < 2; ++bj) xw[m][bj] = *(const u32x4*)(xh + (size_t)(m * 16) * D + bj * 128);
#pragma unroll
                for (int m = 0; m < 4; ++m)
#pragma unroll
                    for (int bj = 0; bj < 2; ++bj) { const u32x4 w_ = xw[m][bj];
                        const f32x4 x0 = (f32x4){bflo(w_.x), bfhi(w_.x), bflo(w_.y), bfhi(w_.y)}, x1 = (f32x4){bflo(w_.z), bfhi(w_.z), bflo(w_.w), bfhi(w_.w)};
                        const f32x4 v0 = x0 * ALPHA + sc[bj][0] * (acc[ai][bj][m][0] + bv[bj][0]), v1 = x1 * ALPHA + sc[bj][1] * (acc[ai][bj][m][1] + bv[bj][1]);
                        u32x4 w; w.x = cvt_pk_bf16(v0[0], v0[1]); w.y = cvt_pk_bf16(v0[2], v0[3]); w.z = cvt_pk_bf16(v1[0], v1[1]); w.w = cvt_pk_bf16(v1[2], v1[3]);
                        *(u32x4*)(vp + (size_t)(m * 16) * D + bj * 128) = w; }
            } else {
                const float* xb = (const float*)xl + (size_t)(row0 + ai * 128) * D + colt;
#pragma unroll
                for (int mh = 0; mh < 2; ++mh) {
                    f32x4 xf[2][2][2];
#pragma unroll
                    for (int mm = 0; mm < 2; ++mm)
#pragma unroll
                        for (int bj = 0; bj < 2; ++bj) { const float* q = xb + (size_t)((mh * 2 + mm) * 16) * D + bj * 128; xf[mm][bj][0] = *(const f32x4*)q; xf[mm][bj][1] = *(const f32x4*)(q + 4); }
#pragma unroll
                    for (int mm = 0; mm < 2; ++mm)
#pragma unroll
                        for (int bj = 0; bj < 2; ++bj) { const int m = mh * 2 + mm;
                            const f32x4 v0 = xf[mm][bj][0] * ALPHA + sc[bj][0] * (acc[ai][bj][m][0] + bv[bj][0]), v1 = xf[mm][bj][1] * ALPHA + sc[bj][1] * (acc[ai][bj][m][1] + bv[bj][1]);
                            u32x4 w; w.x = cvt_pk_bf16(v0[0], v0[1]); w.y = cvt_pk_bf16(v0[2], v0[3]); w.z = cvt_pk_bf16(v1[0], v1[1]); w.w = cvt_pk_bf16(v1[2], v1[3]);
                            *(u32x4*)(vp + (size_t)(m * 16) * D + bj * 128) = w; }
                    asm volatile("" ::: "memory");
                }
            }
            asm volatile("" ::: "memory");
        }
    }
    __device__ __forceinline__ void body_ln(const Acc& acc, const GUnit& u, int row0, int colt) const {
        const float* mv = modl + (size_t)row_grp(u.pm) * 9216;
#pragma unroll
        for (int bj = 0; bj < 2; ++bj) {
            f32x4 sc[2], gg[2], bb[2], bv[2];
#pragma unroll
            for (int n = 0; n < 2; ++n) { sc[n] = *(const f32x4*)(mv + colt + bj * 128 + 4 * n) * coef; gg[n] = *(const f32x4*)(xg + colt + bj * 128 + 4 * n); bb[n] = *(const f32x4*)(xbt + colt + bj * 128 + 4 * n);
                bv[n] = bias ? *(const f32x4*)(bias + colt + bj * 128 + 4 * n) : (f32x4){0.f, 0.f, 0.f, 0.f}; }
#pragma unroll
            for (int ai = 0; ai < 2; ++ai) {
                bf16* vp = V + (size_t)(row0 + ai * 128) * D + colt + bj * 128; const bf16* xp = (const bf16*)xl + (size_t)(row0 + ai * 128) * D + colt + bj * 128;
                u32x4 xw[4]; f32x2 st[4];
#pragma unroll
                for (int m = 0; m < 4; ++m) { st[m] = *(const f32x2*)(xstat + (size_t)(row0 + ai * 128 + m * 16) * 2); xw[m] = *(const u32x4*)(xp + (size_t)(m * 16) * D); }
#pragma unroll
                for (int m = 0; m < 4; ++m) { const u32x4 w_ = xw[m]; const float mu = st[m].x, rs = st[m].y;
                    const f32x4 x0 = ((f32x4){bflo(w_.x), bfhi(w_.x), bflo(w_.y), bfhi(w_.y)} - mu) * (gg[0] * rs) + bb[0], x1 = ((f32x4){bflo(w_.z), bfhi(w_.z), bflo(w_.w), bfhi(w_.w)} - mu) * (gg[1] * rs) + bb[1];
                    const f32x4 v0 = x0 * ALPHA + sc[0] * (acc[ai][bj][m][0] + bv[0]), v1 = x1 * ALPHA + sc[1] * (acc[ai][bj][m][1] + bv[1]);
                    u32x4 w; w.x = cvt_pk_bf16(v0[0], v0[1]); w.y = cvt_pk_bf16(v0[2], v0[3]); w.z = cvt_pk_bf16(v1[0], v1[1]); w.w = cvt_pk_bf16(v1[2], v1[3]);
                    *(u32x4*)(vp + (size_t)(m * 16) * D) = w; }
                asm volatile("" ::: "memory");
            }
        }
    }
};
struct EpiInproj {
    static constexpr bool DUP_OK = false; static constexpr int NST = 0;
    const float* bin;
    unsigned char* ws;
    __device__ __forceinline__ void operator()(const Acc& acc, const GUnit& u, int tid, int wr, int wc, int fr, int fq) const {
        bf16* const UA = (bf16*)(ws + WS_UA); bf16* const Q = (bf16*)(ws + WS_Q); bf16* const K = (bf16*)(ws + WS_K); bf16* const SB = (bf16*)(ws + WS_SB);
        bf16* const W = (bf16*)(ws + WS_W); bf16* const VT = (bf16*)(ws + WS_VT); bf16* const HT = (bf16*)(ws + WS_HT);
        int c8 = wc * 32 + 8 * fq; asm volatile("" : "+v"(c8));
        const float IS = u.f8 ? (1.0f / W1_SCALE) : 1.0f;
        if (u.kind == KI_TRANS) {
            bf16* dst = (u.pn == 4) ? VT : HT + (size_t)(u.pn - 8) * 256 * MT;
            const int r0 = wr * 64 + fr;
#pragma unroll
            for (int ai = 0; ai < 2; ++ai)
#pragma unroll
                for (int m = 0; m < 4; ++m) {
                    const int r = r0 + ai * 128 + m * 16; const float b = bin[u.pn * 256 + r];
#pragma unroll
                    for (int bj = 0; bj < 2; ++bj) {
                        const f32x4 v0 = acc[ai][bj][m][0] * IS + b, v1 = acc[ai][bj][m][1] * IS + b;
                        u32x4 w; w.x = cvt_pk_bf16(v0[0], v0[1]); w.y = cvt_pk_bf16(v0[2], v0[3]); w.z = cvt_pk_bf16(v1[0], v1[1]); w.w = cvt_pk_bf16(v1[2], v1[3]);
                        *(u32x4*)(dst + (size_t)r * MT + u.pm * 256 + bj * 128 + c8) = w;
                    }
                }
            return;
        }
        const int row0 = u.pm * 256 + wr * 64 + fr;
        f32x4 bv[2][2];
#pragma unroll
        for (int bj = 0; bj < 2; ++bj)
#pragma unroll
            for (int n = 0; n < 2; ++n) bv[bj][n] = *(const f32x4*)(bin + u.pn * 256 + bj * 128 + c8 + 4 * n);
        if (u.kind == KI_PLAIN) {
            bf16* dst = (u.pn == 2) ? Q : (u.pn == 3 ? K : SB); const float scl = (u.pn == 2) ? ATT_SCALE * 1.44269504089f : 1.0f;
#pragma unroll
            for (int ai = 0; ai < 2; ++ai)
#pragma unroll
                for (int m = 0; m < 4; ++m)
#pragma unroll
                    for (int bj = 0; bj < 2; ++bj) {
                        const f32x4 v0 = (acc[ai][bj][m][0] * IS + bv[bj][0]) * scl, v1 = (acc[ai][bj][m][1] * IS + bv[bj][1]) * scl;
                        u32x4 w; w.x = cvt_pk_bf16(v0[0], v0[1]); w.y = cvt_pk_bf16(v0[2], v0[3]); w.z = cvt_pk_bf16(v1[0], v1[1]); w.w = cvt_pk_bf16(v1[2], v1[3]);
                        *(u32x4*)(dst + (size_t)(row0 + ai * 128 + m * 16) * 256 + bj * 128 + c8) = w;
                    }
            return;
        }
        const bool glu = (u.kind == KI_GLU);
        bf16* dst = glu ? UA + u.pn * 128 : W + (u.pn - 6) * 128;
#pragma unroll
        for (int ai = 0; ai < 2; ++ai)
#pragma unroll
            for (int m = 0; m < 4; ++m) {
                f32x4 a0 = acc[ai][0][m][0] * IS + bv[0][0], a1 = acc[ai][0][m][1] * IS + bv[0][1], g0 = acc[ai][1][m][0] * IS + bv[1][0], g1 = acc[ai][1][m][1] * IS + bv[1][1];
                if (glu) {
#pragma unroll
                    for (int j = 0; j < 4; ++j) { g0[j] = sigmoidf_(g0[j]); g1[j] = sigmoidf_(g1[j]); }
                }
                const f32x4 v0 = a0 * g0, v1 = a1 * g1;
                u32x4 w; w.x = cvt_pk_bf16(v0[0], v0[1]); w.y = cvt_pk_bf16(v0[2], v0[3]); w.z = cvt_pk_bf16(v1[0], v1[1]); w.w = cvt_pk_bf16(v1[2], v1[3]);
                *(u32x4*)(dst + (size_t)(row0 + ai * 128 + m * 16) * 256 + c8) = w;
            }
    }
};
__device__ __forceinline__ unsigned pk_u8x4(f32x4 v) { const unsigned a = (unsigned)(v[0] * 255.0f + 0.5f), b = (unsigned)(v[1] * 255.0f + 0.5f), c = (unsigned)(v[2] * 255.0f + 0.5f), d = (unsigned)(v[3] * 255.0f + 0.5f); return a | (b << 8) | (c << 16) | (d << 24); }
struct EpiGateBr {
    static constexpr bool DUP_OK = false; static constexpr int NST = 0;
    const float* bing;
    unsigned char* gs;
    bf16* MG; bf16* MI;
    __device__ __forceinline__ void operator()(const Acc& acc, const GUnit& u, int tid, int wr, int wc, int fr, int fq) const {
        const int br = (u.kind >> 1) & 3; const bool cjob = (u.kind & 8) != 0;
        unsigned so = (unsigned)tid * 16u; asm volatile("" : "+v"(so));
        const unsigned mo = so * 2u;
        if ((u.kind & 1) == 0) {
            const float* bb = bing + br * 1024 + u.pn * 256 + wc * 32 + 8 * fq;
            f32x4 bv[2][2];
#pragma unroll
            for (int bj = 0; bj < 2; ++bj)
#pragma unroll
                for (int n = 0; n < 2; ++n) bv[bj][n] = *(const f32x4*)(bb + bj * 128 + 4 * n);
            unsigned char* sp = gs;
#pragma unroll
            for (int ai = 0; ai < 2; ++ai)
#pragma unroll
                for (int m = 0; m < 4; ++m)
#pragma unroll
                    for (int bj = 0; bj < 2; ++bj) {
                        const float gs_ = u.f8 ? (1.0f / W1_SCALE) : 1.0f; f32x4 v0 = acc[ai][bj][m][0] * gs_ + bv[bj][0], v1 = acc[ai][bj][m][1] * gs_ + bv[bj][1];
#pragma unroll
                        for (int j = 0; j < 4; ++j) { v0[j] = sigmoidf_(v0[j]); v1[j] = sigmoidf_(v1[j]); }
                        u32x2 w; w.x = pk_u8x4(v0); w.y = pk_u8x4(v1);
                        *(u32x2*)(sp + (so >> 1)) = w; sp += 4096;
                    }
        } else {
            unsigned lo = (unsigned)(((wr * 64 + fr) * D + u.pn * 256 + wc * 32 + 8 * fq) * 2); asm volatile("" : "+v"(lo));
            unsigned char* op = cjob ? (unsigned char*)(MI + ((size_t)br * TC + (u.pm - TL / 256) * 256) * D) : (unsigned char*)(MG + (size_t)u.pm * 256 * D);
            const bool ldm = (br > 0 && !cjob), stm = (br < 3 && !cjob);
            if (ldm) { if (stm) branch<true, true>(acc, so, mo, lo, op); else branch<true, false>(acc, so, mo, lo, op); }
            else { if (stm) branch<false, true>(acc, so, mo, lo, op); else branch<false, false>(acc, so, mo, lo, op); }
        }
    }
    template <bool LDM, bool STM> __device__ __forceinline__ void branch(const Acc& acc, unsigned so, unsigned mo, unsigned lo, unsigned char* op) const {
        const unsigned char* sp = gs; unsigned char* mp = gs + 131072;
        u32x2 s[3][2]; u32x4 mw[3][2];
#define GB_U(ptr_) ({ auto q_ = (ptr_); asm volatile("" : "+s"(q_)); q_; })
#define GB_LOAD(t_) do { _Pragma("unroll") for (int k = 0; k < 2; ++k) { s[(t_) % 3][k] = *(const u32x2*)(GB_U(sp + ((t_) * 2 + k) * 4096) + (so >> 1)); \
            if (LDM) mw[(t_) % 3][k] = *(const u32x4*)(GB_U(mp + ((t_) * 2 + k) * 8192) + so); else mw[(t_) % 3][k] = (u32x4){0u, 0u, 0u, 0u}; } } while (0)
        GB_LOAD(0); GB_LOAD(1);
#pragma unroll
        for (int t = 0; t < 8; ++t) { const int ai = t >> 2, m = t & 3, p = t % 3;
            if (t < 6) GB_LOAD(t + 2);
#pragma unroll
            for (int k = 0; k < 2; ++k) { const int bj = k;
                const f32x4 y0 = acc[ai][bj][m][0], y1 = acc[ai][bj][m][1]; const u32x2 sk = s[p][k]; const u32x4 mk = mw[p][k]; f32x4 a0 = (f32x4){bflo(mk.x), bfhi(mk.x), bflo(mk.y), bfhi(mk.y)}, a1 = (f32x4){bflo(mk.z), bfhi(mk.z), bflo(mk.w), bfhi(mk.w)};
                a0[0] += (float)((sk.x >> 0) & 0xffu) * y0[0]; a0[1] += (float)((sk.x >> 8) & 0xffu) * y0[1]; a0[2] += (float)((sk.x >> 16) & 0xffu) * y0[2]; a0[3] += (float)((sk.x >> 24) & 0xffu) * y0[3];
                a1[0] += (float)((sk.y >> 0) & 0xffu) * y1[0]; a1[1] += (float)((sk.y >> 8) & 0xffu) * y1[1]; a1[2] += (float)((sk.y >> 16) & 0xffu) * y1[2]; a1[3] += (float)((sk.y >> 24) & 0xffu) * y1[3];
                if (!STM) { a0 = a0 * (1.0f / 255.0f); a1 = a1 * (1.0f / 255.0f); }
                u32x4 w; w.x = cvt_pk_bf16(a0[0], a0[1]); w.y = cvt_pk_bf16(a0[2], a0[3]); w.z = cvt_pk_bf16(a1[0], a1[1]); w.w = cvt_pk_bf16(a1[2], a1[3]);
                if (STM) *(u32x4*)(GB_U(mp + (t * 2 + k) * 8192) + so) = w;
                else *(u32x4*)(op + (size_t)(ai * 128 + m * 16) * D * 2 + lo + bj * 256) = w; }
            asm volatile("" ::: "memory");
        }
#undef GB_LOAD
#undef GB_U
    }
};

struct Frame {
    LAS unsigned char* lds;
    int tid, lane, wave, bid, G;
    unsigned char* ws;
};

__device__ __forceinline__ void transpose_item(const float* W, int K, int N, int src_col0, bf16* WT, int dst_row0, LAS float* scr, int kb, int lane) {
    const int k0 = 64 * kb;
    float tv[32];
#pragma unroll
    for (int i = 0; i < 32; ++i) { const int kk = 2 * i + (lane >> 5); tv[i] = W[(size_t)(k0 + kk) * N + src_col0 + (lane & 31)]; }
#pragma unroll
    for (int i = 0; i < 32; ++i) { const int kk = 2 * i + (lane >> 5); scr[kk * 33 + (lane & 31)] = tv[i]; }
    LDS_WAIT(); asm volatile("" ::: "memory");
    const int c = lane & 7;
#pragma unroll
    for (int j = 0; j < 4; ++j) { const int n = (lane >> 3) + 8 * j; const LAS float* s = scr + (8 * c) * 33 + n;
        u32x4 o; o.x = cvt_pk_bf16(s[0 * 33], s[1 * 33]); o.y = cvt_pk_bf16(s[2 * 33], s[3 * 33]); o.z = cvt_pk_bf16(s[4 * 33], s[5 * 33]); o.w = cvt_pk_bf16(s[6 * 33], s[7 * 33]);
        *(u32x4*)(WT + (size_t)(dst_row0 + n) * K + k0 + 8 * c) = o; }
    LDS_WAIT(); asm volatile("" ::: "memory");
}
__device__ __forceinline__ void transpose_item8(const float* W, int K, int N, int src_col0, unsigned char* WT, int dst_row0, LAS float* scr, int kb, int lane, float wscale) {
    const int k0 = 64 * kb;
    float tv[32];
#pragma unroll
    for (int i = 0; i < 32; ++i) { const int kk = 2 * i + (lane >> 5); tv[i] = W[(size_t)(k0 + kk) * N + src_col0 + (lane & 31)]; }
#pragma unroll
    for (int i = 0; i < 32; ++i) { const int kk = 2 * i + (lane >> 5); scr[kk * 33 + (lane & 31)] = tv[i]; }
    LDS_WAIT(); asm volatile("" ::: "memory");
    const int n = lane >> 1, hf = lane & 1; const LAS float* s = scr + (32 * hf) * 33 + n;
    u32x4 o0, o1;
    o0.x = pk_fp8x4(s[0 * 33] * wscale, s[1 * 33] * wscale, s[2 * 33] * wscale, s[3 * 33] * wscale); o0.y = pk_fp8x4(s[4 * 33] * wscale, s[5 * 33] * wscale, s[6 * 33] * wscale, s[7 * 33] * wscale);
    o0.z = pk_fp8x4(s[8 * 33] * wscale, s[9 * 33] * wscale, s[10 * 33] * wscale, s[11 * 33] * wscale); o0.w = pk_fp8x4(s[12 * 33] * wscale, s[13 * 33] * wscale, s[14 * 33] * wscale, s[15 * 33] * wscale);
    o1.x = pk_fp8x4(s[16 * 33] * wscale, s[17 * 33] * wscale, s[18 * 33] * wscale, s[19 * 33] * wscale); o1.y = pk_fp8x4(s[20 * 33] * wscale, s[21 * 33] * wscale, s[22 * 33] * wscale, s[23 * 33] * wscale);
    o1.z = pk_fp8x4(s[24 * 33] * wscale, s[25 * 33] * wscale, s[26 * 33] * wscale, s[27 * 33] * wscale); o1.w = pk_fp8x4(s[28 * 33] * wscale, s[29 * 33] * wscale, s[30 * 33] * wscale, s[31 * 33] * wscale);
    u32x4* dst = (u32x4*)(WT + (size_t)(dst_row0 + n) * K + k0 + 32 * hf); dst[0] = o0; dst[1] = o1;
    LDS_WAIT(); asm volatile("" ::: "memory");
}
__host__ __device__ __forceinline__ int inmap(int r) {
    if (r >= NINP) return r;
    const int t = r >> 8, cc = r & 255;
    if (t < 2) return cc < 128 ? 128 * t + cc : 256 + 128 * t + cc - 128;
    if (t < 6) return 256 * t + cc;
    if (t < 8) { const int p = t - 6; return cc < 128 ? 1536 + 128 * p + cc : 1792 + 128 * p + cc - 128; }
    return 2048 + 256 * (t - 8) + cc;
}
__device__ __forceinline__ void prologue_a(Frame& F, const Params& P) {
    LAS float* scr = (LAS float*)(F.lds + F.wave * 16384);
    const int gw = F.bid * NWAVES + F.wave, NGW = F.G * NWAVES;
    constexpr int I1 = 16 * 176, I2 = 44 * 32, I3 = 16 * 216, I4 = 4 * 32, I5 = 16 * 32;
    constexpr int I6 = 32;
    constexpr int NIT = 4 * I1 + 4 * I2 + 2 * I3 + 8 * I4 + 2 * I5 + 2 * I6;
    struct TI { const float* W; unsigned char* dst; int N, K, sc, drow, kb; bool f8; float scale; };
    auto decode = [&](int it, TI& t) {
        int r = it;
        if (r < 4 * I1) { const int mi = r / I1; r %= I1; const int kb = r / 176, nb = r % 176, d0 = nb * 32, pn = d0 >> 8, cc = d0 & 255;
            t = TI{P.in[I_FWI] + (size_t)mi * D * NFF, F.ws + WS_W1T + (size_t)mi * NFF * D, NFF, D, cc < 128 ? 128 * pn + cc : DFF + 128 * pn + cc - 128, d0, kb, true, W1_SCALE}; return; }
        r -= 4 * I1;
        if (r < 4 * I2) { const int mi = r / I2; r %= I2; const int kb = r / 32, nb = r % 32;
            t = TI{P.in[I_FWO] + (size_t)mi * DFF * D, F.ws + WS_W2T + (size_t)mi * D * DFF, D, DFF, nb * 32, nb * 32, kb, true, W2_SCALE}; return; }
        r -= 4 * I2;
        if (r < 2 * I3) { const int mi = r / I3; r %= I3; const int kb = r / 216, nb = r % 216; const float* W = P.in[I_WIN] + (size_t)mi * D * PIN;
            if (nb * 32 >= NINP) t = TI{W, F.ws + WS_WIT + ((size_t)mi * PIN + NINP) * D * 2, PIN, D, inmap(nb * 32), nb * 32 - NINP, kb, true, W1_SCALE};
            else if (nb * 32 < 2048) t = TI{W, F.ws + WS_WIT + ((size_t)mi * PIN + NINP) * D * 2 + 6 * MiB, PIN, D, inmap(nb * 32), nb * 32, kb, true, W1_SCALE};
            else t = TI{W, F.ws + WS_WIT + (size_t)mi * PIN * D * 2, PIN, D, inmap(nb * 32), nb * 32, kb, false, 1.f};
            return; }
        r -= 2 * I3;
        if (r < 8 * I4) { const int mi = r / I4; r %= I4; const int l = mi >> 2, br = mi & 3, kb = r / 32, nb = r % 32;
            t = TI{P.in[br == 0 ? I_CWP : (br == 1 ? I_NWP : (br == 2 ? I_SWP : I_HWP))] + (size_t)l * 256 * D, F.ws + WS_WPT + (size_t)mi * D * 256 * 2, D, 256, nb * 32, nb * 32, kb, false, 1.f}; return; }
        r -= 8 * I4;
        if (r < 2 * I5) { const int mi = r / I5; r %= I5; const int kb = r / 32, nb = r % 32;
            t = TI{P.in[I_WOUT] + (size_t)mi * D * D, F.ws + WS_WOT + (size_t)mi * D * D * 2, D, D, nb * 32, nb * 32, kb, false, 1.f}; return; }
        r -= 2 * I5;
        { const int mi = r / I6, nb = r % I6; t = TI{P.in[I_HW3] + (size_t)mi * 64 * 1024, F.ws + WS_W3T + (size_t)mi * 1024 * 64 * 2, 1024, 64, nb * 32, nb * 32, 0, false, 1.f}; }
    };
    {
        const int lane = F.lane;
        TI cur; float tv[32];
        int it = gw;
        if (it < NIT) { decode(it, cur);
#pragma unroll
            for (int i = 0; i < 32; ++i) tv[i] = cur.W[(size_t)(64 * cur.kb + 2 * i + (lane >> 5)) * cur.N + cur.sc + (lane & 31)]; }
        for (; it < NIT; it += NGW) {
#pragma unroll
            for (int i = 0; i < 32; ++i) scr[(2 * i + (lane >> 5)) * 33 + (lane & 31)] = tv[i];
            TI nx; const bool more = it + NGW < NIT;
            if (more) { decode(it + NGW, nx);
#pragma unroll
                for (int i = 0; i < 32; ++i) tv[i] = nx.W[(size_t)(64 * nx.kb + 2 * i + (lane >> 5)) * nx.N + nx.sc + (lane & 31)]; }
            LDS_WAIT(); asm volatile("" ::: "memory");
            const int k0 = 64 * cur.kb;
            if (cur.f8) { const int n = lane >> 1, hf = lane & 1; const LAS float* s = scr + (32 * hf) * 33 + n; const float ws_ = cur.scale;
                u32x4 o0, o1;
                o0.x = pk_fp8x4(s[0 * 33] * ws_, s[1 * 33] * ws_, s[2 * 33] * ws_, s[3 * 33] * ws_); o0.y = pk_fp8x4(s[4 * 33] * ws_, s[5 * 33] * ws_, s[6 * 33] * ws_, s[7 * 33] * ws_);
                o0.z = pk_fp8x4(s[8 * 33] * ws_, s[9 * 33] * ws_, s[10 * 33] * ws_, s[11 * 33] * ws_); o0.w = pk_fp8x4(s[12 * 33] * ws_, s[13 * 33] * ws_, s[14 * 33] * ws_, s[15 * 33] * ws_);
                o1.x = pk_fp8x4(s[16 * 33] * ws_, s[17 * 33] * ws_, s[18 * 33] * ws_, s[19 * 33] * ws_); o1.y = pk_fp8x4(s[20 * 33] * ws_, s[21 * 33] * ws_, s[22 * 33] * ws_, s[23 * 33] * ws_);
                o1.z = pk_fp8x4(s[24 * 33] * ws_, s[25 * 33] * ws_, s[26 * 33] * ws_, s[27 * 33] * ws_); o1.w = pk_fp8x4(s[28 * 33] * ws_, s[29 * 33] * ws_, s[30 * 33] * ws_, s[31 * 33] * ws_);
                u32x4* dst = (u32x4*)(cur.dst + (size_t)(cur.drow + n) * cur.K + k0 + 32 * hf); dst[0] = o0; dst[1] = o1; }
            else { const int c = lane & 7;
#pragma unroll
                for (int j = 0; j < 4; ++j) { const int n = (lane >> 3) + 8 * j; const LAS float* s = scr + (8 * c) * 33 + n;
                    u32x4 o; o.x = cvt_pk_bf16(s[0 * 33], s[1 * 33]); o.y = cvt_pk_bf16(s[2 * 33], s[3 * 33]); o.z = cvt_pk_bf16(s[4 * 33], s[5 * 33]); o.w = cvt_pk_bf16(s[6 * 33], s[7 * 33]);
                    *(u32x4*)(cur.dst + ((size_t)(cur.drow + n) * cur.K + k0 + 8 * c) * 2) = o; } }
            LDS_WAIT(); asm volatile("" ::: "memory");
            cur = nx;
        }
    }
    { float* bin = (float*)(F.ws + WS_BIN); for (int i = F.bid * NTHR + F.tid; i < 2 * PIN; i += F.G * NTHR) { const int l = i / PIN, r = i % PIN; bin[i] = P.in[I_BIN][l * PIN + inmap(r)]; } }
    __syncthreads();
    LAS float* sv = (LAS float*)F.lds;
    LAS float* red = (LAS float*)(F.lds + 16384);
    for (int i = F.tid; i < 3 * D; i += NTHR) { const int g = i / D, k = i % D; const float c = g < 2 ? P.in[I_C][g * D + k] : P.in[I_CCTX][k]; sv[i] = siluf_(c); }
    __syncthreads();
    for (int un = F.bid; un < 2 * 144; un += F.G) {
        const int l = un / 144, n0 = (un % 144) * 64;
        const float* wm = P.in[I_WMOD] + (size_t)l * D * 9216 + n0 + F.lane;
        float a0 = 0.f, a1 = 0.f, a2 = 0.f;
#pragma unroll 1
        for (int k0 = 0; k0 < 128; k0 += 32) { float wv[32];
#pragma unroll
            for (int kk = 0; kk < 32; ++kk) wv[kk] = wm[(size_t)(F.wave * 128 + k0 + kk) * 9216];
#pragma unroll
            for (int kk = 0; kk < 32; ++kk) { const int k = F.wave * 128 + k0 + kk; a0 += sv[k] * wv[kk]; a1 += sv[D + k] * wv[kk]; a2 += sv[2 * D + k] * wv[kk]; } }
        red[(F.wave * 3 + 0) * 64 + F.lane] = a0; red[(F.wave * 3 + 1) * 64 + F.lane] = a1; red[(F.wave * 3 + 2) * 64 + F.lane] = a2;
        __syncthreads();
        if (F.tid < 192) { const int g = F.tid >> 6, ln = F.tid & 63; float s = P.in[I_BMOD][l * 9216 + n0 + ln];
#pragma unroll
            for (int w = 0; w < 8; ++w) s += red[(w * 3 + g) * 64 + ln];
            ((float*)(F.ws + WS_MOD))[(size_t)(l * 3 + g) * 9216 + n0 + ln] = s; }
        __syncthreads();
    }
}

__device__ __forceinline__ void ln_stats(const f32x4 (&v)[4], float& mean, float& rstd) {
    float s = 0.f;
#pragma unroll
    for (int j = 0; j < 4; ++j) s += (v[j][0] + v[j][1]) + (v[j][2] + v[j][3]);
    mean = wave_sum(s) * (1.0f / D);
    float q = 0.f;
#pragma unroll
    for (int j = 0; j < 4; ++j) { const f32x4 d = v[j] - mean; q += (d[0] * d[0] + d[1] * d[1]) + (d[2] * d[2] + d[3] * d[3]); }
    rstd = 1.0f / sqrtf(wave_sum(q) * (1.0f / D) + LN_EPS);
}
__device__ __forceinline__ void modulate_store(const f32x4 (&x)[4], const float* shift, const float* scale, bf16* hrow, int lane) {
    float mean, rstd; ln_stats(x, mean, rstd);
#pragma unroll
    for (int j = 0; j < 4; ++j) { const int c = 4 * lane + 256 * j; const f32x4 sc = *(const f32x4*)(scale + c), sh = *(const f32x4*)(shift + c);
        const f32x4 h = (x[j] - mean) * rstd * (sc + 1.0f) + sh;
        u32x2 w; w.x = cvt_pk_bf16(h[0], h[1]); w.y = cvt_pk_bf16(h[2], h[3]); *(u32x2*)(hrow + c) = w; }
}
__device__ __forceinline__ void modulate_store8(const f32x4 (&x)[4], const float* shift, const float* scale, unsigned char* hrow, int lane) {
    float mean, rstd; ln_stats(x, mean, rstd);
#pragma unroll
    for (int j = 0; j < 4; ++j) { const int c = 4 * lane + 256 * j; const f32x4 sc = *(const f32x4*)(scale + c), sh = *(const f32x4*)(shift + c);
        const f32x4 h = (x[j] - mean) * rstd * (sc + 1.0f) + sh;
        *(unsigned*)(hrow + c) = pk_fp8x4(h[0], h[1], h[2], h[3]); }
}
constexpr int LNR = 4;
__device__ __forceinline__ void ln_stats_r(const f32x4 (&v)[LNR][4], float (&mean)[LNR], float (&rstd)[LNR]) {
    float s[LNR];
#pragma unroll
    for (int r = 0; r < LNR; ++r) { s[r] = 0.f;
#pragma unroll
        for (int j = 0; j < 4; ++j) s[r] += (v[r][j][0] + v[r][j][1]) + (v[r][j][2] + v[r][j][3]); }
#pragma unroll
    for (int r = 0; r < LNR; ++r) s[r] = wave_sum(s[r]);
    float q[LNR];
#pragma unroll
    for (int r = 0; r < LNR; ++r) { mean[r] = s[r] * (1.0f / D); q[r] = 0.f;
#pragma unroll
        for (int j = 0; j < 4; ++j) { const f32x4 d = v[r][j] - mean[r]; q[r] += (d[0] * d[0] + d[1] * d[1]) + (d[2] * d[2] + d[3] * d[3]); } }
#pragma unroll
    for (int r = 0; r < LNR; ++r) q[r] = wave_sum(q[r]);
#pragma unroll
    for (int r = 0; r < LNR; ++r) rstd[r] = 1.0f / sqrtf(q[r] * (1.0f / D) + LN_EPS);
}
__device__ __forceinline__ void phase_mod0(Frame& F, const Params& P) {
    const int skip = (F.G > 8) ? 4 : 0;
    if (F.bid < skip) return;
    const int gw = (F.bid - skip) * NWAVES + F.wave, NGW = (F.G - skip) * NWAVES;
    const float* MOD = (const float*)(F.ws + WS_MOD); bf16* H = (bf16*)(F.ws + WS_H);
    for (int row0 = gw; row0 < MT; row0 += LNR * NGW) {
        f32x4 x[LNR][4]; int rows[LNR];
#pragma unroll
        for (int r = 0; r < LNR; ++r) { rows[r] = min(row0 + r * NGW, MT - 1); const int row = rows[r];
            const float* xr = row < TL ? P.in[I_X] + (size_t)row * D : P.in[I_CTX] + (size_t)(row - TL) * D;
#pragma unroll
            for (int j = 0; j < 4; ++j) x[r][j] = *(const f32x4*)(xr + 4 * F.lane + 256 * j); }
        float mean[LNR], rstd[LNR]; ln_stats_r(x, mean, rstd);
#pragma unroll
        for (int r = 0; r < LNR; ++r) if (row0 + r * NGW < MT) { const int row = rows[r], g = row < SEQ ? 0 : (row < TL ? 1 : 2);
            const float* shift = MOD + (size_t)g * 9216, *scale = shift + D;
#pragma unroll
            for (int j = 0; j < 4; ++j) { const int c = 4 * F.lane + 256 * j; const f32x4 sc = *(const f32x4*)(scale + c), sh = *(const f32x4*)(shift + c);
                const f32x4 h = (x[r][j] - mean[r]) * rstd[r] * (sc + 1.0f) + sh;
                *(unsigned*)((unsigned char*)H + (size_t)row * D + c) = pk_fp8x4(h[0], h[1], h[2], h[3]); } }
    }
}
__device__ __forceinline__ void phase_ln(Frame& F, const Params& P, const float* lg, const float* lb, const float* modl  , int ishift, bool hmod, bool h8  , bool dual  , bool final_out, int cx_nks, float cx_coef, const float* cx_modv  , const float* cx_bias, const float* cx_xsrc, bool skipx  , const bf16* vsrc  ) {
    const int gw = F.bid * NWAVES + F.wave, NGW = F.G * NWAVES;
    const bf16* V = vsrc; bf16* H = (bf16*)(F.ws + WS_H);
    f32x4 g4[4], b4[4];
#pragma unroll
    for (int j = 0; j < 4; ++j) { g4[j] = *(const f32x4*)(lg + 4 * F.lane + 256 * j); b4[j] = *(const f32x4*)(lb + 4 * F.lane + 256 * j); }
    if (cx_nks > 0) {
        const float* part = (const float*)(F.ws + WS_ES);
        for (int r = gw; r < TC; r += NGW) {
            f32x4 v[4];
#pragma unroll
            for (int j = 0; j < 4; ++j) { const int c = 4 * F.lane + 256 * j; f32x4 s = cx_bias ? *(const f32x4*)(cx_bias + c) : (f32x4){0.f, 0.f, 0.f, 0.f};
                for (int ks = 0; ks < cx_nks; ++ks) s += *(const f32x4*)(part + ((size_t)ks * TC + r) * D + c);
                v[j] = *(const f32x4*)(cx_xsrc + (size_t)r * D + c) * ALPHA + *(const f32x4*)(cx_modv + c) * cx_coef * s; }
            float mean, rstd; ln_stats(v, mean, rstd);
            float* xr = (float*)(F.ws + WS_XC) + (size_t)r * D;
#pragma unroll
            for (int j = 0; j < 4; ++j) { v[j] = (v[j] - mean) * rstd * g4[j] + b4[j]; *(f32x4*)(xr + 4 * F.lane + 256 * j) = v[j]; }
            if (hmod && dual) modulate_store8(v, modl + (size_t)2 * 9216 + ishift * D, modl + (size_t)2 * 9216 + (ishift + 1) * D, F.ws + WS_H8C + (size_t)r * D, F.lane);
            if (hmod) { if (h8) modulate_store8(v, modl + (size_t)2 * 9216 + ishift * D, modl + (size_t)2 * 9216 + (ishift + 1) * D, (unsigned char*)H + (size_t)(TL + r) * D, F.lane);
                        else modulate_store(v, modl + (size_t)2 * 9216 + ishift * D, modl + (size_t)2 * 9216 + (ishift + 1) * D, H + (size_t)(TL + r) * D, F.lane); }
        }
    }
    const int M = TL;
    u32x2 raw[LNR][4];
#pragma unroll
    for (int r = 0; r < LNR; ++r) { const int rw = min(gw + r * NGW, M - 1);
#pragma unroll
        for (int j = 0; j < 4; ++j) raw[r][j] = *(const u32x2*)(V + (size_t)rw * D + 4 * F.lane + 256 * j); }
    for (int row0 = gw; row0 < M; row0 += LNR * NGW) {
        f32x4 v[LNR][4]; int rows[LNR];
#pragma unroll
        for (int r = 0; r < LNR; ++r) { rows[r] = min(row0 + r * NGW, M - 1);
#pragma unroll
            for (int j = 0; j < 4; ++j) { const u32x2 w = raw[r][j]; v[r][j] = (f32x4){bflo(w.x), bfhi(w.x), bflo(w.y), bfhi(w.y)}; } }
        if (row0 + LNR * NGW < M) {
#pragma unroll
            for (int r = 0; r < LNR; ++r) { const int rw = min(row0 + (LNR + r) * NGW, M - 1);
#pragma unroll
                for (int j = 0; j < 4; ++j) raw[r][j] = *(const u32x2*)(V + (size_t)rw * D + 4 * F.lane + 256 * j); }
        }
        float mean[LNR], rstd[LNR]; ln_stats_r(v, mean, rstd);
#pragma unroll
        for (int r = 0; r < LNR; ++r) { const int row = rows[r]; const bool ok = row0 + r * NGW < M;
            float* xr = P.out + (size_t)row * D; bf16* xh = (bf16*)P.out + (size_t)row * D;
            if (skipx && ok && F.lane == 0) *(f32x2*)((float*)(F.ws + WS_LNS) + (size_t)row * 2) = (f32x2){mean[r], rstd[r]};
#pragma unroll
            for (int j = 0; j < 4; ++j) { v[r][j] = (v[r][j] - mean[r]) * rstd[r] * g4[j] + b4[j];
                if (ok) { if (final_out) __builtin_nontemporal_store(v[r][j], (f32x4*)(xr + 4 * F.lane + 256 * j));
                          else if (!skipx) { u32x2 w; w.x = cvt_pk_bf16(v[r][j][0], v[r][j][1]); w.y = cvt_pk_bf16(v[r][j][2], v[r][j][3]); __builtin_nontemporal_store(w, (u32x2*)(xh + 4 * F.lane + 256 * j)); } } } }
        if (hmod) {
            ln_stats_r(v, mean, rstd);
#pragma unroll
            for (int r = 0; r < LNR; ++r) if (row0 + r * NGW < M) { const int row = rows[r], g = row < SEQ ? 0 : 1;
                const float* shift = modl + (size_t)g * 9216 + ishift * D, *scale = shift + D; bf16* hrow = H + (size_t)row * D;
#pragma unroll
                for (int j = 0; j < 4; ++j) { const int c = 4 * F.lane + 256 * j; const f32x4 sc = *(const f32x4*)(scale + c), sh = *(const f32x4*)(shift + c);
                    const f32x4 h = (v[r][j] - mean[r]) * rstd[r] * (sc + 1.0f) + sh;
                    if (h8) __builtin_nontemporal_store(pk_fp8x4(h[0], h[1], h[2], h[3]), (unsigned*)((unsigned char*)H + (size_t)row * D + c));
                    else { u32x2 w; w.x = cvt_pk_bf16(h[0], h[1]); w.y = cvt_pk_bf16(h[2], h[3]); __builtin_nontemporal_store(w, (u32x2*)(hrow + c)); }
                    if (dual) __builtin_nontemporal_store(pk_fp8x4(h[0], h[1], h[2], h[3]), (unsigned*)(F.ws + WS_H8L + (size_t)row * D + c)); } }
        }
    }
}

__device__ __forceinline__ void filter_unit(Frame& F, const Params& P, int l, int L, int t0, float* filt  , bool bfout) {
    LAS float* h1 = (LAS float*)F.lds;
    LAS bf16* h2b = (LAS bf16*)(F.lds + 32768);
    LAS float* zf = (LAS float*)(F.lds + 65536);
    LAS float* w2s = (LAS float*)(F.lds + 81920);
    LAS float* w1s = (LAS float*)(F.lds + 98304);
    const float* w1 = P.in[I_HW1] + l * 33 * 64; const float* b1 = P.in[I_HB1] + l * 64; const float* w2 = P.in[I_HW2] + l * 64 * 64; const float* b2 = P.in[I_HB2] + l * 64;
    const float* fq = P.in[I_HFQ] + l * 128; const float* w3 = P.in[I_HW3] + (size_t)l * 64 * 1024;
    {
#pragma unroll
        for (int i = 0; i < 8; ++i) w2s[F.tid + 512 * i] = w2[F.tid + 512 * i];
#pragma unroll
        for (int i = 0; i < 5; ++i) if (F.tid + 512 * i < 33 * 64) w1s[F.tid + 512 * i] = w1[F.tid + 512 * i];
        const int tl = F.tid >> 3, jg = F.tid & 7; const float t = (float)(t0 + tl);
        if (jg == 0) zf[tl * 36] = t / (float)(L - 1);
#pragma unroll
        for (int ii = 0; ii < 2; ++ii) { const int i = jg + 8 * ii; const float band = 1e-4f + (float)i * ((15.0f - 1e-4f) / 15.0f); float s, c; sincospif(2.0f * t * band / (float)L, &s, &c); zf[tl * 36 + 1 + i] = c; zf[tl * 36 + 17 + i] = -s; }
        __syncthreads();
        float a[8];
#pragma unroll
        for (int jj = 0; jj < 8; ++jj) a[jj] = b1[jg * 8 + jj];
#pragma unroll 3
        for (int i = 0; i < 33; ++i) { const float zv = zf[tl * 36 + i]; const LAS f32x4* wp = (const LAS f32x4*)(w1s + i * 64 + jg * 8); const f32x4 wa = wp[0], wb = wp[1];
            a[0] += zv * wa[0]; a[1] += zv * wa[1]; a[2] += zv * wa[2]; a[3] += zv * wa[3]; a[4] += zv * wb[0]; a[5] += zv * wb[1]; a[6] += zv * wb[2]; a[7] += zv * wb[3]; }
#pragma unroll
        for (int jj = 0; jj < 8; ++jj) h1[tl * 65 + jg * 8 + jj] = sinf(fq[jg * 8 + jj] * a[jj]);
        __syncthreads();
#pragma unroll
        for (int jj = 0; jj < 8; ++jj) a[jj] = b2[jg * 8 + jj];
#pragma unroll 4
        for (int i = 0; i < 64; ++i) { const float hv = h1[tl * 65 + i]; const LAS f32x4* wp = (const LAS f32x4*)(w2s + i * 64 + jg * 8); const f32x4 wa = wp[0], wb = wp[1];
            a[0] += hv * wa[0]; a[1] += hv * wa[1]; a[2] += hv * wa[2]; a[3] += hv * wa[3]; a[4] += hv * wb[0]; a[5] += hv * wb[1]; a[6] += hv * wb[2]; a[7] += hv * wb[3]; }
#pragma unroll
        for (int jj = 0; jj < 8; ++jj) h2b[tl * 72 + jg * 8 + jj] = (bf16)(cvt_pk_bf16(sinf(fq[64 + jg * 8 + jj] * a[jj]), 0.f) & 0xffffu);
        __syncthreads();
    }
    {
        const bf16* W3T = (const bf16*)(F.ws + WS_W3T) + (size_t)l * 1024 * 64;
        const int lane = F.lane, lr = lane & 15, lg = lane >> 4;
        const float dl0 = -4.605170186f / 1.5f, dl1 = -4.605170186f / 0.3f;
        bf16x8 af[4][2];
#pragma unroll
        for (int rt = 0; rt < 4; ++rt)
#pragma unroll
            for (int ks = 0; ks < 2; ++ks) af[rt][ks] = *(const LAS bf16x8*)(h2b + (rt * 16 + lr) * 72 + ks * 32 + 8 * lg);
#pragma unroll 2
        for (int ct = 0; ct < 8; ++ct) {
            const int col = F.wave * 128 + ct * 16 + lr, c = col & 255;
            const bf16x8 b0 = *(const bf16x8*)(W3T + (size_t)col * 64 + 8 * lg), b1 = *(const bf16x8*)(W3T + (size_t)col * 64 + 32 + 8 * lg);
            const float ad = fabsf(dl0 + (dl1 - dl0) * (float)c / 255.0f);
#pragma unroll
            for (int rt = 0; rt < 4; ++rt) {
                f32x4 a = (f32x4){0.f, 0.f, 0.f, 0.f};
                a = __builtin_amdgcn_mfma_f32_16x16x32_bf16(af[rt][0], b0, a, 0, 0, 0);
                a = __builtin_amdgcn_mfma_f32_16x16x32_bf16(af[rt][1], b1, a, 0, 0, 0);
                const int tb = t0 + rt * 16 + 4 * lg;
#pragma unroll
                for (int e = 0; e < 4; ++e) { const float tn = (float)(tb + e) / (float)(L - 1); a[e] *= __expf(-tn * ad); }
                if (bfout) { u32x2 w; w.x = cvt_pk_bf16(a[0], a[1]); w.y = cvt_pk_bf16(a[2], a[3]); *(u32x2*)((bf16*)filt + (size_t)col * L + tb) = w; }
                else *(f32x4*)(filt + (size_t)col * L + tb) = a;
            }
        }
    }
    __syncthreads();
}
__device__ __forceinline__ void phase_filters(Frame& F, const Params& P, int l, bool with_ctx) {
    float* filt = (float*)(F.ws + WS_FILT); float* filtc = (float*)(F.ws + WS_FILTC);
    const int nu = SEQ / 64 + (with_ctx ? CTXL / 64 : 0);
    for (int u = F.bid; u < nu; u += F.G) {
        if (u < SEQ / 64) filter_unit(F, P, l, SEQ, u * 64, filt, true);
        else filter_unit(F, P, l, CTXL, (u - SEQ / 64) * 64, filtc, false);
    }
}

__device__ __forceinline__ void seg_of(int row, int& s0, int& s1) {
    if (row < TL) { s0 = row & ~(SEQ - 1); s1 = s0 + SEQ; } else { s0 = TL + ((row - TL) & ~(CTXL - 1)); s1 = s0 + CTXL; }
}
__device__ __forceinline__ void conformer_tiles(Frame& F, const Params& P, int l, int u0, int ntile) {
    const bf16* UA = (const bf16*)(F.ws + WS_UA); bf16* BR0 = (bf16*)(F.ws + WS_BRV);
    LAS bf16* tin = (LAS bf16*)F.lds;
    LAS float* cout = (LAS float*)(F.lds + 49152);
    const int c = F.tid & 255, half = F.tid >> 8;
    float w[31];
#pragma unroll
    for (int j = 0; j < 31; ++j) w[j] = P.in[I_CDW][(l * 31 + j) * 256 + c];
    const float b = P.in[I_CDB][l * 256 + c];
    const f32x4 g = *(const f32x4*)(P.in[I_CLG] + l * 256 + 4 * F.lane), bb = *(const f32x4*)(P.in[I_CLB] + l * 256 + 4 * F.lane);
    u32x4 v[6];
#define CONF_LOAD(u_) do { const int t0_ = (u_) * 64; int s0_, s1_; seg_of(t0_, s0_, s1_); _Pragma("unroll") for (int k = 0; k < 6; ++k) { const int idx = F.tid + NTHR * k, rr = idx >> 5, c8 = idx & 31, gr = t0_ - 15 + rr; \
        const bool ok_ = idx < 94 * 32 && gr >= s0_ && gr < s1_; const u32x4 t_ = *(const u32x4*)(UA + (size_t)min(max(gr, s0_), s1_ - 1) * 256 + c8 * 8); v[k] = ok_ ? t_ : (u32x4){0u, 0u, 0u, 0u}; } } while (0)
    if (u0 < ntile) CONF_LOAD(u0);
    for (int u = u0; u < ntile; u += F.G) {
        const int t0 = u * 64;
#pragma unroll
        for (int k = 0; k < 6; ++k) { const int idx = F.tid + NTHR * k, rr = idx >> 5, c8 = idx & 31; if (idx < 94 * 32) *(LAS u32x4*)(tin + rr * 256 + c8 * 8) = v[k]; }
        __syncthreads();
        if (u + F.G < ntile) CONF_LOAD(u + F.G);
        {
            float in[62];
#pragma unroll
            for (int i = 0; i < 62; ++i) in[i] = bf2f(tin[(half * 32 + i) * 256 + c]);
#pragma unroll
            for (int t = 0; t < 32; ++t) { float a = b;
#pragma unroll
                for (int j = 0; j < 31; ++j) a += w[j] * in[t + j];
                cout[(half * 32 + t) * 260 + c] = a; }
        }
        __syncthreads();
        {
            f32x4 v[8]; float s[8], q[8];
#pragma unroll
            for (int tt = 0; tt < 8; ++tt) { v[tt] = *(const LAS f32x4*)(cout + (F.wave * 8 + tt) * 260 + 4 * F.lane); s[tt] = (v[tt][0] + v[tt][1]) + (v[tt][2] + v[tt][3]); }
#pragma unroll
            for (int tt = 0; tt < 8; ++tt) s[tt] = wave_sum(s[tt]);
#pragma unroll
            for (int tt = 0; tt < 8; ++tt) { v[tt] = v[tt] - s[tt] * (1.0f / 256.0f); q[tt] = (v[tt][0] * v[tt][0] + v[tt][1] * v[tt][1]) + (v[tt][2] * v[tt][2] + v[tt][3] * v[tt][3]); }
#pragma unroll
            for (int tt = 0; tt < 8; ++tt) q[tt] = wave_sum(q[tt]);
#pragma unroll
            for (int tt = 0; tt < 8; ++tt) { const float rstd = 1.0f / sqrtf(q[tt] * (1.0f / 256.0f) + LN_EPS);
                f32x4 y = v[tt] * rstd * g + bb;
#pragma unroll
                for (int j = 0; j < 4; ++j) y[j] = siluf_(y[j]);
                u32x2 wv; wv.x = cvt_pk_bf16(y[0], y[1]); wv.y = cvt_pk_bf16(y[2], y[3]);
                __builtin_nontemporal_store(wv, (u32x2*)(BR0 + (size_t)(t0 + F.wave * 8 + tt) * 256 + 4 * F.lane)); }
        }
        __syncthreads();
    }
}
#undef CONF_LOAD
__device__ __forceinline__ void shortconv_unit(Frame& F, const Params& P, int l, int t0) {
    const bf16* SB = (const bf16*)(F.ws + WS_SB); const bf16* W = (const bf16*)(F.ws + WS_W); bf16* BR2 = (bf16*)(F.ws + WS_BRV) + 2 * (size_t)MT * 256;
    int s0, s1; seg_of(t0, s0, s1);
    const float* cw = P.in[I_SCW] + l * 3 * 256;
#pragma unroll
    for (int k = 0; k < 4; ++k) { const int idx = F.tid + NTHR * k, tok = idx >> 5, c8 = (idx & 31) * 8, gr = t0 + tok;
        const u32x4 z = (u32x4){0u, 0u, 0u, 0u};
        const u32x4 wm_ = *(const u32x4*)(W + (size_t)max(gr - 1, s0) * 256 + c8), w0 = *(const u32x4*)(W + (size_t)gr * 256 + c8),
                    wp_ = *(const u32x4*)(W + (size_t)min(gr + 1, s1 - 1) * 256 + c8), sb = *(const u32x4*)(SB + (size_t)gr * 256 + c8);
        const u32x4 wm = (gr - 1 >= s0) ? wm_ : z, wp = (gr + 1 < s1) ? wp_ : z;
        float o[8];
#pragma unroll
        for (int j = 0; j < 4; ++j) { const int c = c8 + 2 * j;
            o[2 * j] = bflo(sb[j]) * (cw[c] * bflo(wm[j]) + cw[256 + c] * bflo(w0[j]) + cw[512 + c] * bflo(wp[j]));
            o[2 * j + 1] = bfhi(sb[j]) * (cw[c + 1] * bfhi(wm[j]) + cw[256 + c + 1] * bfhi(w0[j]) + cw[512 + c + 1] * bfhi(wp[j])); }
        u32x4 w; w.x = cvt_pk_bf16(o[0], o[1]); w.y = cvt_pk_bf16(o[2], o[3]); w.z = cvt_pk_bf16(o[4], o[5]); w.w = cvt_pk_bf16(o[6], o[7]);
        __builtin_nontemporal_store(w, (u32x4*)(BR2 + (size_t)gr * 256 + c8)); }
}
__device__ __forceinline__ void attn_stage_ctx(Frame& F, int b, int h) {
    const unsigned char* K = F.ws + WS_K; const unsigned char* VT = F.ws + WS_VT;
#pragma unroll
    for (int i = 0; i < 4; ++i) { const int pi = F.tid + NTHR * i;
        { const int key = pi >> 3, pc = pi & 7; const u32x4 v = *(const u32x4*)(K + (size_t)(TL + b * CTXL + key) * 512 + h * 128 + pc * 16);
          *(LAS u32x4*)(F.lds + key * 128 + ((pc ^ ((key & 3) | ((key >> 1) & 4))) << 4)) = v; }
        { const int dim = pi >> 5, pc = pi & 31; const u32x4 v = *(const u32x4*)(VT + ((size_t)(h * 64 + dim) * MT + TL + b * CTXL) * 2 + pc * 16);
          *(LAS u32x4*)(F.lds + 32768 + dim * 512 + ((pc ^ (dim & 7)) << 4)) = v; } }
}
__device__ __forceinline__ void attn_wave_unit(Frame& F, int wu, bool lat, bool cl  ) {
    const bf16* Q = (const bf16*)(F.ws + WS_Q); const bf16* K = (const bf16*)(F.ws + WS_K); const bf16* VT = (const bf16*)(F.ws + WS_VT);
    bf16* BR1 = (bf16*)(F.ws + WS_BRV) + (size_t)MT * 256;
    const LAS float* rpb = (const LAS float*)(F.lds + RPB_OFF);
    const int lane = lane_now(), q = lane & 15, g = lane >> 4;
    int b, h, r = 0, qb, tq0, cb = 0, r0 = 0;
    if (lat) { qb = wu & 3; h = (wu >> 2) & 3; r = (wu >> 4) & 255; b = wu >> 12; tq0 = b * SEQ + r * 64 + 16 * qb; cb = (qb == 0) ? 0 : (qb == 1 ? 8 : (qb == 2 ? 24 : 32)); r0 = min(max(r - 4, 0), 248); }
    else { qb = wu & 15; h = (wu >> 4) & 3; b = wu >> 6; tq0 = TL + b * CTXL + 16 * qb; }
    bf16x8 qf[2];
#pragma unroll
    for (int kk = 0; kk < 2; ++kk) qf[kk] = *(const bf16x8*)(Q + (size_t)(tq0 + q) * 256 + h * 64 + 32 * kk + 8 * g);
    const int koff = (q >> 2) * 8 + (q & 3);
    const unsigned klo = (unsigned)((koff * 256 + h * 64 + 8 * g) * 2);
    const unsigned vlo = (unsigned)((((h * 64 + q) * MT) + 8 * g) * 2);
    const char* Kc = (const char*)K; const char* Vc = (const char*)VT;
    const int kl0 = koff * 128 + ((g ^ ((q & 3) | (((q >> 2) & 1) << 2))) << 4), vl0 = 32768 + q * 512 + ((g ^ (q & 7)) << 4);
    const int cq = 16 * qb + q, c0 = min(max(cq - 8, 0), 48);
    float mx = -1e30f, sum = 0.f;
    f32x4 o[4];
#pragma unroll
    for (int bl = 0; bl < 4; ++bl) o[bl] = (f32x4){0.f, 0.f, 0.f, 0.f};
    bf16x8 kf[2][2][2];
#define ATT_KBASE(i_) (((i_) < 8) ? (b * SEQ + (r0 + (i_)) * 64 + cb) : (TL + b * CTXL + 32 * ((i_) - 8)))
#define ATT_LOADK(c_) do { _Pragma("unroll") for (int s_ = 0; s_ < 2; ++s_) { const int kb_ = ATT_KBASE(2 * (c_) + s_); _Pragma("unroll") for (int tt = 0; tt < 2; ++tt) { \
        if (cl && (c_) >= 4) { const int lo_ = (2 * (c_) + s_ - 8) * 4096 + tt * 512; kf[s_][tt][0] = *(const LAS bf16x8*)(F.lds + lo_ + kl0); kf[s_][tt][1] = *(const LAS bf16x8*)(F.lds + lo_ + (kl0 ^ 64)); } \
        else { const char* kp_ = Kc + (size_t)(kb_ + 4 * tt) * 512; kf[s_][tt][0] = *(const bf16x8*)(kp_ + klo); kf[s_][tt][1] = *(const bf16x8*)(kp_ + klo + 64); } } } } while (0)
#define ATT_LOADV(dst_, c_) do { _Pragma("unroll") for (int s_ = 0; s_ < 2; ++s_) { const int kb_ = ATT_KBASE(2 * (c_) + s_); _Pragma("unroll") for (int bl = 0; bl < 4; ++bl) \
        { if (cl && (c_) >= 4) { const int m_ = 2 * (c_) + s_ - 8; dst_[s_][bl] = *(const LAS bf16x8*)(F.lds + bl * 8192 + (m_ >> 1) * 128 + ((m_ & 1) ? (vl0 ^ 64) : vl0)); } \
          else dst_[s_][bl] = *(const bf16x8*)(Vc + ((size_t)(16 * bl) * MT + kb_) * 2 + vlo); } } } while (0)
    bf16x8 vf[2][4], vn[2][4];
    u32x4 kg[2][2][4], vg[2][4];
    LAS unsigned char* wb = F.lds + 65536 + F.wave * 8192;
    const int kq = lane >> 3;
    const int wk0 = kq * 128 + (((lane & 7) ^ (kq & 3)) << 4), wv0 = 4096 + (lane >> 2) * 64 + (((lane & 3) ^ ((lane >> 3) & 3)) << 4), vl1 = 4096 + q * 64 + ((g ^ ((q >> 1) & 3)) << 4);
    const unsigned gk = (unsigned)(kq * 512 + h * 128 + (lane & 7) * 16), gv = (unsigned)(((h * 64 + (lane >> 2)) * MT) * 2 + (lane & 3) * 16);
#define ATT_GLOADK(c_) do { _Pragma("unroll") for (int s_ = 0; s_ < 2; ++s_) { const int kb_ = ATT_KBASE(2 * (c_) + s_); _Pragma("unroll") for (int n = 0; n < 4; ++n) \
        kg[(c_) & 1][s_][n] = *(const u32x4*)(Kc + (size_t)kb_ * 512 + (size_t)n * 4096 + gk); } } while (0)
#define ATT_GLOADV(c_) do { _Pragma("unroll") for (int s_ = 0; s_ < 2; ++s_) { const int kb_ = ATT_KBASE(2 * (c_) + s_); _Pragma("unroll") for (int n = 0; n < 4; ++n) \
        vg[s_][n] = *(const u32x4*)(Vc + (size_t)kb_ * 2 + (size_t)n * 16 * MT * 2 + gv); } } while (0)
#define ATT_XPOSEK(c_) do { _Pragma("unroll") for (int s_ = 0; s_ < 2; ++s_) { \
        _Pragma("unroll") for (int n = 0; n < 4; ++n) *(LAS u32x4*)(wb + n * 1024 + ((n & 1) ? (wk0 ^ 64) : wk0)) = kg[(c_) & 1][s_][n]; \
        _Pragma("unroll") for (int tt = 0; tt < 2; ++tt) { kf[s_][tt][0] = *(const LAS bf16x8*)(wb + tt * 512 + kl0); kf[s_][tt][1] = *(const LAS bf16x8*)(wb + tt * 512 + (kl0 ^ 64)); } } } while (0)
#define ATT_XPOSEV() do { _Pragma("unroll") for (int s_ = 0; s_ < 2; ++s_) { \
        _Pragma("unroll") for (int n = 0; n < 4; ++n) *(LAS u32x4*)(wb + n * 1024 + wv0) = vg[s_][n]; \
        _Pragma("unroll") for (int bl = 0; bl < 4; ++bl) vf[s_][bl] = *(const LAS bf16x8*)(wb + bl * 1024 + vl1); } } while (0)
    if (cl) { ATT_GLOADK(0); ATT_GLOADV(0); ATT_GLOADK(1); } else if (lat) { ATT_LOADK(0); ATT_LOADV(vf, 0); } else { ATT_LOADK(4); ATT_LOADV(vf, 4); }
#pragma unroll
    for (int c = 0; c < 8; ++c) {
        if (c < 4 && !lat) continue;
        if (cl) { if (c < 4) { ATT_XPOSEK(c); if (c < 2) ATT_GLOADK(c + 2); } else { ATT_LOADK(c); ATT_LOADV(vf, c); } }
        f32x4 s[2][2];
#pragma unroll
        for (int s_ = 0; s_ < 2; ++s_)
#pragma unroll
            for (int tt = 0; tt < 2; ++tt) {
                f32x4 a = (f32x4){0.f, 0.f, 0.f, 0.f};
                a = __builtin_amdgcn_mfma_f32_16x16x32_bf16(kf[s_][tt][0], qf[0], a, 0, 0, 0);
                a = __builtin_amdgcn_mfma_f32_16x16x32_bf16(kf[s_][tt][1], qf[1], a, 0, 0, 0);
                if (c < 4) {
                    const int i = 2 * c + s_;
                    const LAS float* rp = rpb + (h * 15 + (r0 + i - r + 7)) * 31;
#pragma unroll
                    for (int j = 0; j < 4; ++j) { const int kc = cb + 8 * g + 4 * tt + j; const bool ok = (kc >= c0) && (kc < c0 + 16);
                        const int dc = min(max(kc - cq + 15, 0), 30);
                        a[j] = ok ? a[j] + rp[dc] : -1e30f; }
                }
                s[s_][tt] = a;
            }
        if (!cl && c < 7) { ATT_LOADK(c + 1); ATT_LOADV(vn, c + 1); }
        if (cl && c < 4) { ATT_XPOSEV(); if (c < 3) ATT_GLOADV(c + 1); }
        float cm = -1e30f;
#pragma unroll
        for (int s_ = 0; s_ < 2; ++s_)
#pragma unroll
            for (int tt = 0; tt < 2; ++tt)
#pragma unroll
                for (int j = 0; j < 4; ++j) cm = fmaxf(cm, s[s_][tt][j]);
        cm = xrow_max(cm);
        const float mn = fmaxf(mx, cm), alpha = __builtin_amdgcn_exp2f(mx - mn);
        mx = mn; sum *= alpha;
#pragma unroll
        for (int bl = 0; bl < 4; ++bl) o[bl] *= alpha;
#pragma unroll
        for (int s_ = 0; s_ < 2; ++s_) {
            float p[8];
#pragma unroll
            for (int tt = 0; tt < 2; ++tt)
#pragma unroll
                for (int j = 0; j < 4; ++j) { const float e = __builtin_amdgcn_exp2f(s[s_][tt][j] - mn); p[4 * tt + j] = e; sum += e; }
            u32x4 pw; pw.x = cvt_pk_bf16(p[0], p[1]); pw.y = cvt_pk_bf16(p[2], p[3]); pw.z = cvt_pk_bf16(p[4], p[5]); pw.w = cvt_pk_bf16(p[6], p[7]);
            const bf16x8 pf = __builtin_bit_cast(bf16x8, pw);
#pragma unroll
            for (int bl = 0; bl < 4; ++bl) o[bl] = __builtin_amdgcn_mfma_f32_16x16x32_bf16(vf[s_][bl], pf, o[bl], 0, 0, 0);
        }
        if (!cl && c < 7) {
#pragma unroll
            for (int s_ = 0; s_ < 2; ++s_)
#pragma unroll
                for (int bl = 0; bl < 4; ++bl) vf[s_][bl] = vn[s_][bl];
        }
    }
#undef ATT_XPOSEK
#undef ATT_XPOSEV
#undef ATT_GLOADK
#undef ATT_GLOADV
#undef ATT_LOADV
#undef ATT_LOADK
#undef ATT_KBASE
    sum = xrow_sum(sum);
    const float inv = 1.0f / sum;
#pragma unroll
    for (int bl = 0; bl < 4; ++bl) { u32x2 w; w.x = cvt_pk_bf16(o[bl][0] * inv, o[bl][1] * inv); w.y = cvt_pk_bf16(o[bl][2] * inv, o[bl][3] * inv);
        __builtin_nontemporal_store(w, (u32x2*)(BR1 + (size_t)(tq0 + q) * 256 + h * 64 + 16 * bl + 4 * g)); }
}

constexpr int FL = 16384;
__device__ __forceinline__ f32x2 cmul(f32x2 a, f32x2 b) {
    f32x2 t, r;
    asm("v_pk_mul_f32 %1, %2, %3 op_sel:[1,1] op_sel_hi:[1,0]\n\tv_pk_fma_f32 %0, %2, %3, %1 op_sel:[0,0,0] op_sel_hi:[0,1,1] neg_lo:[0,0,1]" : "=v"(r), "=&v"(t) : "v"(a), "v"(b));
    return r;
}
__device__ __forceinline__ f32x2 cmulc(f32x2 a, f32x2 b) {
    f32x2 t, r;
    asm("v_pk_mul_f32 %1, %2, %3 op_sel:[1,1] op_sel_hi:[1,0]\n\tv_pk_fma_f32 %0, %2, %3, %1 op_sel:[0,0,0] op_sel_hi:[0,1,1] neg_hi:[1,0,0]" : "=v"(r), "=&v"(t) : "v"(a), "v"(b));
    return r;
}
__device__ __forceinline__ f32x2 rotm(f32x2 b, f32x2 d) { f32x2 r; asm("v_pk_add_f32 %0, %1, %2 op_sel:[0,1] op_sel_hi:[1,0] neg_hi:[0,1]" : "=v"(r) : "v"(b), "v"(d)); return r; }
__device__ __forceinline__ f32x2 rotp(f32x2 b, f32x2 d) { f32x2 r; asm("v_pk_add_f32 %0, %1, %2 op_sel:[0,1] op_sel_hi:[1,0] neg_lo:[0,1]" : "=v"(r) : "v"(b), "v"(d)); return r; }
__device__ __forceinline__ f32x2 tw_main(const LAS f32x2* T, int m) { return cmul(T[m >> 7], T[128 + (m & 127)]); }
__device__ __forceinline__ f32x2 tw_half(const LAS f32x2* T, int n) { return cmul(T[256 + (n >> 7)], T[384 + (n & 127)]); }
__device__ __forceinline__ void r4f(f32x2& x0, f32x2& x1, f32x2& x2, f32x2& x3, f32x2 w1, f32x2 w2, f32x2 w3) {
    const f32x2 a = x0 + x2, b = x0 - x2, c = x1 + x3, d = x1 - x3;
    x0 = a + c; x1 = cmul(rotm(b, d), w1); x2 = cmul(a - c, w2); x3 = cmul(rotp(b, d), w3);
}
__device__ __forceinline__ void r4f1(f32x2& x0, f32x2& x1, f32x2& x2, f32x2& x3) {
    const f32x2 a = x0 + x2, b = x0 - x2, c = x1 + x3, d = x1 - x3;
    x0 = a + c; x1 = rotm(b, d); x2 = a - c; x3 = rotp(b, d);
}
__device__ __forceinline__ void r4i(f32x2& x0, f32x2& x1, f32x2& x2, f32x2& x3, f32x2 w1, f32x2 w2, f32x2 w3) {
    const f32x2 t1 = cmulc(x1, w1), t2 = cmulc(x2, w2), t3 = cmulc(x3, w3);
    const f32x2 a = x0 + t2, b = x0 - t2, c = t1 + t3, d = t1 - t3;
    x0 = a + c; x1 = rotp(b, d); x2 = a - c; x3 = rotm(b, d);
}
__device__ __forceinline__ void r4i1(f32x2& x0, f32x2& x1, f32x2& x2, f32x2& x3) {
    const f32x2 a = x0 + x2, b = x0 - x2, c = x1 + x3, d = x1 - x3;
    x0 = a + c; x1 = rotp(b, d); x2 = a - c; x3 = rotm(b, d);
}
#define W16_1 ((f32x2){0.92387953251f, -0.38268343237f})
#define W16_2 ((f32x2){0.70710678119f, -0.70710678119f})
#define W16_3 ((f32x2){0.38268343237f, -0.92387953251f})
template <int SP, bool INV> __device__ __forceinline__ void fft_pass16(LAS f32x2* B, const LAS f32x2* T, int tid) {
    constexpr int STEP = (SP == 1024) ? 1040 : (SP == 64 ? 65 : 4);
#pragma unroll
    for (int jj = 0; jj < 2; ++jj) {
        const int q = tid + 512 * jj;
        int k, base;
        if (SP == 1024) { k = q; base = q + (q >> 6); }
        else if (SP == 64) { k = q & 63; const int i0 = (q >> 6) * 1024 + k; base = i0 + (i0 >> 6); }
        else { k = q >> 8; base = (q & 255) * 65 + k; }
        LAS f32x2* p = B + base;
        f32x2 x[16];
#pragma unroll
        for (int m = 0; m < 16; ++m) x[m] = p[m * STEP];
        const f32x2 b = tw_main(T, k * (1024 / SP));
        const f32x2 b2 = cmul(b, b), w = cmul(b2, b2), w2 = cmul(w, w), w3 = cmul(w, w2);
        f32x2 t1[4], t2[4], t3[4];
        t1[0] = b; t1[1] = cmul(b, W16_1); t1[2] = cmul(b, W16_2); t1[3] = cmul(b, W16_3);
#pragma unroll
        for (int m = 0; m < 4; ++m) { t2[m] = cmul(t1[m], t1[m]); t3[m] = cmul(t1[m], t2[m]); }
        if (!INV) {
#pragma unroll
            for (int m = 0; m < 4; ++m) r4f(x[m], x[m + 4], x[m + 8], x[m + 12], t1[m], t2[m], t3[m]);
#pragma unroll
            for (int j = 0; j < 4; ++j) r4f(x[4 * j], x[4 * j + 1], x[4 * j + 2], x[4 * j + 3], w, w2, w3);
        } else {
#pragma unroll
            for (int j = 0; j < 4; ++j) r4i(x[4 * j], x[4 * j + 1], x[4 * j + 2], x[4 * j + 3], w, w2, w3);
#pragma unroll
            for (int m = 0; m < 4; ++m) r4i(x[m], x[m + 4], x[m + 8], x[m + 12], t1[m], t2[m], t3[m]);
        }
#pragma unroll
        for (int m = 0; m < 16; ++m) p[m * STEP] = x[m];
    }
    __syncthreads();
}
template <bool INV> __device__ __forceinline__ void fft_pass4(LAS f32x2* B, int tid) {
#pragma unroll 4
    for (int jj = 0; jj < 8; ++jj) {
        const int q = tid + 512 * jj;
        LAS f32x2* p = B + (q & 255) * 65 + 4 * (q >> 8);
        f32x2 x0 = p[0], x1 = p[1], x2 = p[2], x3 = p[3];
        if (!INV) r4f1(x0, x1, x2, x3); else r4i1(x0, x1, x2, x3);
        p[0] = x0; p[1] = x1; p[2] = x2; p[3] = x3;
    }
    __syncthreads();
}
__device__ __forceinline__ void fft_fwd(LAS f32x2* B, const LAS f32x2* T, int tid) {
    fft_pass16<1024, false>(B, T, tid); fft_pass16<64, false>(B, T, tid); fft_pass16<4, false>(B, T, tid); fft_pass4<false>(B, tid);
}
__device__ __forceinline__ void fft_inv(LAS f32x2* B, const LAS f32x2* T, int tid) {
    fft_pass4<true>(B, tid); fft_pass16<4, true>(B, T, tid); fft_pass16<64, true>(B, T, tid); fft_pass16<1024, true>(B, T, tid);
}
__device__ __forceinline__ void fft_pass4_keep(LAS f32x2* B, int tid, u32x4 (&ks)[8]) {
#pragma unroll
    for (int jj = 0; jj < 8; ++jj) {
        const int q = tid + 512 * jj;
        const LAS f32x2* p = B + (q & 255) * 65 + 4 * (q >> 8);
        f32x2 x0 = p[0], x1 = p[1], x2 = p[2], x3 = p[3];
        r4f1(x0, x1, x2, x3);
        ks[jj].x = cvt_pk_bf16(x0.x, x0.y); ks[jj].y = cvt_pk_bf16(x1.x, x1.y); ks[jj].z = cvt_pk_bf16(x2.x, x2.y); ks[jj].w = cvt_pk_bf16(x3.x, x3.y);
    }
    __syncthreads();
}
__device__ __forceinline__ void fft_mid4(LAS f32x2* B, int tid, const u32x4 (&ks)[8]) {
#pragma unroll
    for (int jj = 0; jj < 8; ++jj) {
        const int q = tid + 512 * jj;
        LAS f32x2* p = B + (q & 255) * 65 + 4 * (q >> 8);
        f32x2 x0 = p[0], x1 = p[1], x2 = p[2], x3 = p[3];
        r4f1(x0, x1, x2, x3);
        x0 = cmul(x0, (f32x2){bflo(ks[jj].x), bfhi(ks[jj].x)}); x1 = cmul(x1, (f32x2){bflo(ks[jj].y), bfhi(ks[jj].y)});
        x2 = cmul(x2, (f32x2){bflo(ks[jj].z), bfhi(ks[jj].z)}); x3 = cmul(x3, (f32x2){bflo(ks[jj].w), bfhi(ks[jj].w)});
        r4i1(x0, x1, x2, x3);
        p[0] = x0; p[1] = x1; p[2] = x2; p[3] = x3;
    }
    __syncthreads();
}
__device__ __forceinline__ void fft_fwd3(LAS f32x2* B, const LAS f32x2* T, int tid) { fft_pass16<1024, false>(B, T, tid); fft_pass16<64, false>(B, T, tid); fft_pass16<4, false>(B, T, tid); }
__device__ __forceinline__ void fft_inv3(LAS f32x2* B, const LAS f32x2* T, int tid) { fft_pass16<4, true>(B, T, tid); fft_pass16<64, true>(B, T, tid); fft_pass16<1024, true>(B, T, tid); }
__device__ __forceinline__ float conv3_at(const bf16* p, int n, int L, float w0, float w1, float w2, float b) {
    const float xm = n > 0 ? bf2f(p[n - 1]) : 0.f, x0 = bf2f(p[n]), xp = n + 1 < L ? bf2f(p[n + 1]) : 0.f;
    return w0 * xm + w1 * x0 + w2 * xp + b;
}
__device__ __forceinline__ float block_sum(Frame& F, float v) {
    LAS float* red = (LAS float*)(F.lds + RED_OFF);
    v = wave_sum(v);
    __syncthreads();
    if (F.lane == 0) red[F.wave] = v;
    __syncthreads();
    float s = 0.f;
#pragma unroll
    for (int w = 0; w < 8; ++w) s += red[w];
    return s;
}
__device__ __forceinline__ f32x4 conv3x4(const bf16* p, int nb, float w0, float w1, float w2, float b) {
    const u32x2 m = *(const u32x2*)(p + nb);
    const float x0 = bflo(m.x), x1 = bfhi(m.x), x2 = bflo(m.y), x3 = bfhi(m.y);
    const float xm = nb > 0 ? bf2f(p[nb - 1]) : 0.f, xp = nb + 4 < SEQ ? bf2f(p[nb + 4]) : 0.f;
    return (f32x4){w0 * xm + w1 * x0 + w2 * x1 + b, w0 * x0 + w1 * x1 + w2 * x2 + b, w0 * x1 + w1 * x2 + w2 * x3 + b, w0 * x2 + w1 * x3 + w2 * xp + b};
}
typedef u32x4 u32x4_a4 __attribute__((aligned(4)));
__device__ __forceinline__ u32x4 ld16u(const bf16* p) { return *(const u32x4_a4*)p; }
__device__ __forceinline__ void conv3p(const u32x4 a, const u32x4 b, bool first, bool last, float w0, float w1, float w2, float bb, f32x2 (&z)[4]) {
    f32x2 X[6];
    X[0] = (f32x2){bfhi(a.x), bfhi(b.x)}; X[1] = (f32x2){bflo(a.y), bflo(b.y)}; X[2] = (f32x2){bfhi(a.y), bfhi(b.y)};
    X[3] = (f32x2){bflo(a.z), bflo(b.z)}; X[4] = (f32x2){bfhi(a.z), bfhi(b.z)}; X[5] = (f32x2){bflo(a.w), bflo(b.w)};
    if (first) X[0] = (f32x2){0.f, 0.f};
    if (last) X[5] = (f32x2){0.f, 0.f};
#pragma unroll
    for (int e = 0; e < 4; ++e) z[e] = X[e] * w0 + (X[e + 1] * w1 + (X[e + 2] * w2 + bb));
}
__device__ __forceinline__ void hyena_unit(Frame& F, const Params& P, int l, int c, bool dummy) {
    LAS f32x2* B = (LAS f32x2*)F.lds; const LAS f32x2* T = (const LAS f32x2*)(F.lds + TW_OFF);
    const bf16* HT = (const bf16*)(F.ws + WS_HT); const bf16* FILT = (const bf16*)(F.ws + WS_FILT);
    f32x4* Z = (f32x4*)(F.ws + WS_KSCR + (size_t)F.bid * 131072);
    u32x4 ksr[8];
    u32x4* ES = (u32x4*)(F.ws + WS_ES + (size_t)F.bid * 131072) + 4096;
    bf16* BR3 = (bf16*)(F.ws + WS_BRV) + 3 * (size_t)MT * 256;
    const float* sw = P.in[I_HSW] + l * 3 * 768; const float* sb = P.in[I_HSB] + l * 768;
    const int tid = F.tid;
#define HY_NB(jp_) (4 * tq + 2048 * (jp_))
#define HY_TQ int tq = tid; asm volatile("" : "+v"(tq))
#define HY_G(T_, base_, boff_) (*(T_*)((char*)(base_) + (unsigned)(boff_)))
#define HY_LDX(row_, nb_) (*(const u32x4_a4*)((const char*)((row_) - 2) + (unsigned)((nb_) * 2)))
#define HY_LDR(hb_, nb_) (*(const u32x4_a4*)((const char*)((hb_) - 2) + (unsigned)((FL - 4 - (nb_)) * 2)))
#define HY_SLOT(nb_) (B + (nb_) + ((nb_) >> 6))
#define HY_TW4(nb_, w_) do { const f32x2 tb_ = T[256 + ((nb_) >> 7)]; const LAS f32x4* tp_ = (const LAS f32x4*)(T + 384 + ((nb_) & 127)); const f32x4 ta_ = tp_[0], tc_ = tp_[1]; \
        w_[0] = cmul(tb_, (f32x2){ta_[0], ta_[1]}); w_[1] = cmul(tb_, (f32x2){ta_[2], ta_[3]}); w_[2] = cmul(tb_, (f32x2){tc_[0], tc_[1]}); w_[3] = cmul(tb_, (f32x2){tc_[2], tc_[3]}); } while (0)
#define HY_ST4(nb_, c0_, c1_, c2_, c3_) do { LAS f32x2* bp_ = HY_SLOT(nb_); bp_[0] = (c0_); bp_[1] = (c1_); bp_[2] = (c2_); bp_[3] = (c3_); } while (0)
#define HY_UNPK(w_) ((f32x2){bflo(w_), bfhi(w_)})
#define HY_FILT4(fw_, gw_, nb_, f4_, r4_) const f32x4 f4_ = (f32x4){bflo(fw_.x), bfhi(fw_.x), bflo(fw_.y), bfhi(fw_.y)};   \
        const f32x4 r4_ = (f32x4){(nb_) ? bflo(gw_.w) : 0.f, bfhi(gw_.z), bflo(gw_.z), bfhi(gw_.y)}
    {
        const bf16* p0 = HT + (size_t)c * MT; const float v0 = sw[c], v1 = sw[768 + c], v2 = sw[1536 + c], vb = sb[c];
        { HY_TQ;
#pragma unroll
        for (int h = 0; h < 2; ++h) {
            u32x4 xa[4], xb[4];
#pragma unroll
            for (int j = 0; j < 4; ++j) { const int nb = HY_NB(4 * h + j); xa[j] = HY_LDX(p0, nb); xb[j] = HY_LDX(p0 + SEQ, nb); }
#pragma unroll
            for (int j = 0; j < 4; ++j) { const int nb = HY_NB(4 * h + j); f32x2 z[4]; conv3p(xa[j], xb[j], nb == 0, nb + 4 == SEQ, v0, v1, v2, vb, z);
                HY_G(f32x4, Z, nb * 8) = (f32x4){z[0].x, z[0].y, z[1].x, z[1].y}; HY_G(f32x4, Z + 1, nb * 8) = (f32x4){z[2].x, z[2].y, z[3].x, z[3].y}; }
        } }
    }
#pragma unroll 1
    for (int o = 0; o < 2; ++o) {
        const bf16* hf = FILT + (size_t)((o * 2 + 0) * 256 + c) * SEQ; const bf16* hb = FILT + (size_t)((o * 2 + 1) * 256 + c) * SEQ;
        float ss = 0.f;
#pragma unroll 1
        for (int par = 0; par < 2; ++par) {
            if (par == 0) {
                { HY_TQ;
#pragma unroll
                for (int h = 0; h < 2; ++h) {
                    u32x2 fw[4]; u32x4 gw[4];
#pragma unroll
                    for (int j = 0; j < 4; ++j) { const int nb = HY_NB(4 * h + j); fw[j] = HY_G(const u32x2, hf, nb * 2); gw[j] = HY_LDR(hb, nb); }
#pragma unroll
                    for (int j = 0; j < 4; ++j) { const int nb = HY_NB(4 * h + j); HY_FILT4(fw[j], gw[j], nb, f4, r4);
                        const f32x4 a = f4 + r4; ss += (f4[0] * f4[0] + f4[1] * f4[1]) + (f4[2] * f4[2] + f4[3] * f4[3]) + (r4[0] * r4[0] + r4[1] * r4[1]) + (r4[2] * r4[2] + r4[3] * r4[3]);
                        HY_ST4(nb, ((f32x2){a[0], 0.f}), ((f32x2){a[1], 0.f}), ((f32x2){a[2], 0.f}), ((f32x2){a[3], 0.f})); }
                } }
                __syncthreads();
            }
            fft_fwd3(B, T, tid); fft_pass4_keep(B, tid, ksr);
            { HY_TQ;
#pragma unroll
            for (int h = 0; h < 2; ++h) {
                f32x4 za[4], zb[4];
#pragma unroll
                for (int j = 0; j < 4; ++j) { const int nb = HY_NB(4 * h + j); za[j] = HY_G(const f32x4, Z, nb * 8); zb[j] = HY_G(const f32x4, Z + 1, nb * 8); }
#pragma unroll
                for (int j = 0; j < 4; ++j) { const int nb = HY_NB(4 * h + j);
                    const f32x2 z0 = (f32x2){za[j].x, za[j].y}, z1 = (f32x2){za[j].z, za[j].w}, z2 = (f32x2){zb[j].x, zb[j].y}, z3 = (f32x2){zb[j].z, zb[j].w};
                    if (par == 0) { HY_ST4(nb, z0, z1, z2, z3); }
                    else { f32x2 tw[4]; HY_TW4(nb, tw); HY_ST4(nb, cmul(z0, tw[0]), cmul(z1, tw[1]), cmul(z2, tw[2]), cmul(z3, tw[3])); } }
            } }
            __syncthreads();
            fft_fwd3(B, T, tid); fft_mid4(B, tid, ksr);
            fft_inv3(B, T, tid);
            if (par == 0) {
                { HY_TQ;
#pragma unroll
                for (int h = 0; h < 2; ++h) {
                    u32x2 fw[4]; u32x4 gw[4];
#pragma unroll
                    for (int j = 0; j < 4; ++j) { const int nb = HY_NB(4 * h + j); fw[j] = HY_G(const u32x2, hf, nb * 2); gw[j] = HY_LDR(hb, nb); }
#pragma unroll
                    for (int j = 0; j < 4; ++j) { const int jp = 4 * h + j, nb = HY_NB(jp); const LAS f32x2* bp = HY_SLOT(nb); const f32x2 a0 = bp[0] * (1.0f / 16384.0f), a1 = bp[1] * (1.0f / 16384.0f), a2 = bp[2] * (1.0f / 16384.0f), a3 = bp[3] * (1.0f / 16384.0f);
                        u32x4 w; w.x = cvt_pk_bf16(a0.x, a0.y); w.y = cvt_pk_bf16(a1.x, a1.y); w.z = cvt_pk_bf16(a2.x, a2.y); w.w = cvt_pk_bf16(a3.x, a3.y); HY_G(u32x4, ES + jp * 512, tq * 16) = w;
                        HY_FILT4(fw[j], gw[j], nb, f4, r4);
                        const f32x4 d = f4 - r4; f32x2 tw[4]; HY_TW4(nb, tw); HY_ST4(nb, tw[0] * d[0], tw[1] * d[1], tw[2] * d[2], tw[3] * d[3]); }
                } }
                __syncthreads();
            }
        }
        const float nrm = (1.0f / sqrtf(block_sum(F, ss) + 1e-6f)) * 0.5f;
        const float hbias = P.in[I_HBI][(l * 2 + o) * 256 + c];
        const int ch = (o + 1) * 256 + c;
        const bf16* px = HT + (size_t)ch * MT; const float w0 = sw[ch], w1 = sw[768 + ch], w2 = sw[1536 + ch], bb = sb[ch];
        { HY_TQ;
#pragma unroll
        for (int h = 0; h < 4; ++h) {
            u32x4 ev[2], xa[2], xb[2]; f32x4 za[2], zb[2];
#pragma unroll
            for (int j = 0; j < 2; ++j) { const int jp = 2 * h + j, nb = HY_NB(jp); ev[j] = HY_G(const u32x4, ES + jp * 512, tq * 16); za[j] = HY_G(const f32x4, Z, nb * 8); zb[j] = HY_G(const f32x4, Z + 1, nb * 8); xa[j] = HY_LDX(px, nb); xb[j] = HY_LDX(px + SEQ, nb); }
#pragma unroll
            for (int j = 0; j < 2; ++j) { const int nb = HY_NB(2 * h + j);
                const LAS f32x2* bp = HY_SLOT(nb); f32x2 w[4]; HY_TW4(nb, w);
                const f32x2 e0 = HY_UNPK(ev[j].x) + cmulc(bp[0], w[0]) * (1.0f / 16384.0f), e1 = HY_UNPK(ev[j].y) + cmulc(bp[1], w[1]) * (1.0f / 16384.0f),
                            e2 = HY_UNPK(ev[j].z) + cmulc(bp[2], w[2]) * (1.0f / 16384.0f), e3 = HY_UNPK(ev[j].w) + cmulc(bp[3], w[3]) * (1.0f / 16384.0f);
                f32x2 x[4]; conv3p(xa[j], xb[j], nb == 0, nb + 4 == SEQ, w0, w1, w2, bb, x);
                const f32x2 y0 = (e0 * nrm + (f32x2){za[j].x, za[j].y} * hbias) * x[0], y1 = (e1 * nrm + (f32x2){za[j].z, za[j].w} * hbias) * x[1],
                            y2 = (e2 * nrm + (f32x2){zb[j].x, zb[j].y} * hbias) * x[2], y3 = (e3 * nrm + (f32x2){zb[j].z, zb[j].w} * hbias) * x[3];
                if (o == 0) { HY_G(f32x4, Z, nb * 8) = (f32x4){y0.x, y0.y, y1.x, y1.y}; HY_G(f32x4, Z + 1, nb * 8) = (f32x4){y2.x, y2.y, y3.x, y3.y}; }
                else if (!dummy) {
                    const unsigned u0 = cvt_pk_bf16(y0.x, y0.y), u1 = cvt_pk_bf16(y1.x, y1.y), u2 = cvt_pk_bf16(y2.x, y2.y), u3 = cvt_pk_bf16(y3.x, y3.y);
                    bf16* q0 = BR3 + c; bf16* q1 = q0 + (size_t)SEQ * 256; const int ob = nb * 512;
                    HY_G(bf16, q0, ob) = (bf16)(u0 & 0xffffu); HY_G(bf16, q0 + 256, ob) = (bf16)(u1 & 0xffffu); HY_G(bf16, q0 + 512, ob) = (bf16)(u2 & 0xffffu); HY_G(bf16, q0 + 768, ob) = (bf16)(u3 & 0xffffu);
                    HY_G(bf16, q1, ob) = (bf16)(u0 >> 16); HY_G(bf16, q1 + 256, ob) = (bf16)(u1 >> 16); HY_G(bf16, q1 + 512, ob) = (bf16)(u2 >> 16); HY_G(bf16, q1 + 768, ob) = (bf16)(u3 >> 16); }
            }
        } }
        __syncthreads();
    }
#undef HY_NB
#undef HY_TQ
#undef HY_G
#undef HY_LDX
#undef HY_LDR
#undef HY_FILT4
#undef HY_TW4
#undef HY_ST4
#undef HY_SLOT
#undef HY_UNPK
}
__device__ __forceinline__ void hyena_ctx_unit(Frame& F, const Params& P, int l, int c) {
    LAS float* zc = (LAS float*)F.lds;
    LAS float* kk = (LAS float*)(F.lds + 4096);
    const bf16* HT = (const bf16*)(F.ws + WS_HT); const float* FC = (const float*)(F.ws + WS_FILTC);
    bf16* BR3 = (bf16*)(F.ws + WS_BRV) + 3 * (size_t)MT * 256;
    const float* sw = P.in[I_HSW] + l * 3 * 768; const float* sb = P.in[I_HSB] + l * 768;
    const int b = F.tid >> 8, t = F.tid & 255;
    float zv = conv3_at(HT + (size_t)c * MT + TL + b * CTXL, t, CTXL, sw[c], sw[768 + c], sw[1536 + c], sb[c]);
    for (int o = 0; o < 2; ++o) {
        const float* hf = FC + (size_t)((o * 2 + 0) * 256 + c) * CTXL; const float* hb = FC + (size_t)((o * 2 + 1) * 256 + c) * CTXL;
        float ss = 0.f;
        if (F.tid < 256) { const float f = hf[F.tid]; kk[255 + F.tid] = f; ss = f * f; }
        else { const int d = F.tid - 256; if (d >= 1) { const float f = hb[d]; kk[255 - d] = f; ss = f * f; } }
        zc[F.tid] = zv;
        const float nrm = 1.0f / sqrtf(block_sum(F, ss) + 1e-6f);
        float y = 0.f;
        for (int s_ = 0; s_ < 256; ++s_) y += kk[t - s_ + 255] * zc[b * 256 + s_];
        y = y * nrm + P.in[I_HBI][(l * 2 + o) * 256 + c] * zv;
        const int ch = (o + 1) * 256 + c;
        zv = conv3_at(HT + (size_t)ch * MT + TL + b * CTXL, t, CTXL, sw[ch], sw[768 + ch], sw[1536 + ch], sb[ch]) * y;
        __syncthreads();
    }
    BR3[(size_t)(TL + b * CTXL + t) * 256 + c] = (bf16)(cvt_pk_bf16(zv, 0.f) & 0xffffu);
}
__device__ __forceinline__ void phase_mixer(Frame& F, const Params& P, int l, bool last) {
    {
        LAS float* rpb = (LAS float*)(F.lds + RPB_OFF); for (int i = F.tid; i < 1860; i += NTHR) rpb[i] = P.in[I_RPB][l * 1860 + i] * 1.44269504089f;
        LAS f32x2* T = (LAS f32x2*)(F.lds + TW_OFF);
        if (F.tid < 512) { const int tb = F.tid >> 7, a = F.tid & 127; const float x = tb == 0 ? (float)a / 128.0f : (tb == 1 ? (float)a / 16384.0f : (tb == 2 ? (float)a / 256.0f : (float)a / 32768.0f));
            float s, cs; sincospif(2.0f * x, &s, &cs); T[F.tid] = (f32x2){cs, -s}; }
        __syncthreads();
    }
#ifndef MIXMASK
#define MIXMASK 63
#endif
    if (MIXMASK & 1) for (int c = F.bid; c < 256; c += F.G) hyena_unit(F, P, l, ((c & 7) << 5) | (c >> 3), false);
    if (MIXDUP & 1) for (int c = F.bid; c < 256; c += F.G) hyena_unit(F, P, l, c, true);
    if (MIXMASK & 2) if (!last) for (int rep_ = 0; rep_ <= ((MIXDUP >> 1) & 1); ++rep_) for (int c = F.bid; c < 256; c += F.G) { hyena_ctx_unit(F, P, l, c); __syncthreads(); }
    const int ntile = (last ? TL : MT) / 64;
    if (MIXMASK & 4) for (int rep_ = 0; rep_ <= ((MIXDUP >> 2) & 1); ++rep_) conformer_tiles(F, P, l, (F.bid + F.G / 2) % F.G, ntile);
    if (MIXMASK & 8) for (int rep_ = 0; rep_ <= ((MIXDUP >> 3) & 1); ++rep_) for (int u = (F.bid + F.G / 4) % F.G; u < ntile; u += F.G) shortconv_unit(F, P, l, u * 64);
    const int gw = F.bid * NWAVES + F.wave, NGW = F.G * NWAVES;
    if (MIXMASK & 16) for (int rep_ = 0; rep_ <= ((MIXDUP >> 4) & 1); ++rep_) for (int task = F.bid; task < 256; task += F.G) {
        const int h = task & 3, b = task >> 7, rb = ((task >> 2) & 31) * 8;
        __syncthreads();
        attn_stage_ctx(F, b, h);
        __syncthreads();
#pragma unroll 1
        for (int it = 0; it < 4; ++it) { int wu = (b << 12) | ((rb + 2 * it + (F.wave >> 2)) << 4) | (h << 2) | (F.wave & 3); asm volatile("" : "+s"(wu));
            attn_wave_unit(F, wu, true, true); }
    }
    if (MIXMASK & 32) if (!last) for (int wu = gw; wu < 128; wu += NGW) attn_wave_unit(F, wu, false, false);
}

__global__ void __launch_bounds__(NTHR, 2) mk_fwd(Params P) {
    extern __shared__ __attribute__((aligned(16))) unsigned char lds_raw[];
    Frame F;
    const int wave0 = __builtin_amdgcn_readfirstlane(threadIdx.x >> 6);
    F.lds = (LAS unsigned char*)lds_raw; F.tid = threadIdx.x; F.lane = F.tid & 63; F.wave = __builtin_amdgcn_readfirstlane(F.tid >> 6); F.bid = blockIdx.x; F.G = gridDim.x; F.ws = P.ws;
    volatile LAS unsigned* MISC = (volatile LAS unsigned*)(F.lds + MISC_OFF);
    if (F.tid < 4) MISC[F.tid] = 0u;
    __syncthreads();
    XcdBarrier bar = xcd_barrier_post((unsigned*)(P.ws + WS_CTL) + 4096, MISC);
    const int lo = P.ph_lo, hi = P.ph_hi;
    int ph = 0;
#define PHASE_BEGIN if (ph >= lo && ph < hi) { { int t_; asm volatile("v_mbcnt_lo_u32_b32 %0, -1, 0\n\tv_mbcnt_hi_u32_b32 %0, -1, %0" : "=v"(t_)); t_ |= wave0 << 6; F.tid = t_; F.lane = t_ & 63; F.wave = __builtin_amdgcn_readfirstlane(t_ >> 6); size_t o_ = 0; asm volatile("" : "+s"(o_)); F.ws = P.ws + o_; }
#define PHASE_END   if (ph + 1 < hi) xcd_barrier(bar, F.tid); } ++ph;
#define MOD ((const float*)(F.ws + WS_MOD))
#define Hc ((const char*)(F.ws + WS_H))

    PHASE_BEGIN if (PHMASK & (1u << 0)) for (int rep_ = 0; rep_ <= (int)((DUPMASK >> 0) & 1u); ++rep_) { prologue_a(F, P); } PHASE_END
    PHASE_BEGIN if (PHMASK & (1u << 1)) for (int rep_ = 0; rep_ <= (int)((DUPMASK >> 1) & 1u); ++rep_) { phase_mod0(F, P); phase_filters(F, P, 0, true); } PHASE_END

    for (int l = 0; l < 2; ++l) {
        const bool last = (l == 1);
#define modl (MOD + (size_t)l * 3 * 9216)
#define xl ((l == 0) ? (const void*)P.in[I_X] : (const void*)P.out)
#define xc ((l == 0) ? P.in[I_CTX] : (const float*)(F.ws + WS_XC))
#define xcw ((const float*)(F.ws + WS_XC))
        PHASE_BEGIN if (PHMASK & (1u << 2)) for (int rep_ = 0; rep_ <= (int)((DUPMASK >> 2) & 1u); ++rep_) { { SchedPlain S{Hc, (const char*)(F.ws + WS_W1T) + (size_t)(l * 2 + 0) * NFF * D, 1024u, 1024u, 8, MT / 256, 22, F.G, F.bid};
            EpiFfnUp E{F.ws + WS_U}; pg8::gemm_phase<EpiFfnUp, SchedPlain, 1>(F.lds, S, E, F.tid); } } PHASE_END
        PHASE_BEGIN if (PHMASK & (1u << 3)) for (int rep_ = 0; rep_ <= (int)((DUPMASK >> 3) & 1u); ++rep_) { { SchedResid<5, 1, 6> S{(const char*)(F.ws + WS_U), (const char*)(F.ws + WS_W2T) + (size_t)(l * 2 + 0) * D * DFF, (unsigned)DFF, 22, F.G, F.bid, true, (const char*)(F.ws + WS_U) + (size_t)TL * DFF};
            EpiRes E{(bf16*)P.out, (l == 0) ? (const void*)P.in[I_X] : (const void*)(F.ws + WS_BRV), l != 0, modl + 2 * D, nullptr, 0.5f / W2_SCALE, (float*)(F.ws + WS_ES),
                (l != 0) ? (const float*)(F.ws + WS_LNS) : nullptr, P.in[I_PLG] + ((l + 1) % 2 * 3 + 2) * D, P.in[I_PLB] + ((l + 1) % 2 * 3 + 2) * D}; pg8::gemm_phase<EpiRes, SchedResid<5, 1, 6>, 1>(F.lds, S, E, F.tid); } } PHASE_END
        PHASE_BEGIN if (PHMASK & (1u << 4)) for (int rep_ = 0; rep_ <= (int)((DUPMASK >> 4) & 1u); ++rep_) { phase_ln(F, P, P.in[I_PLG] + (l * 3 + 0) * D, P.in[I_PLB] + (l * 3 + 0) * D, modl, 3, true, false, true, false, 5, 0.5f / W2_SCALE, modl + (size_t)2 * 9216 + 2 * D, nullptr, xc, true, (const bf16*)P.out); if (l == 1) phase_filters(F, P, 1, false); } PHASE_END
        PHASE_BEGIN if (PHMASK & (1u << 5)) for (int rep_ = 0; rep_ <= (int)((DUPMASK >> 5) & 1u); ++rep_) { { SchedInproj S{(const char*)F.ws, l, MT / 256, F.G, F.bid};
            EpiInproj E{(const float*)(F.ws + WS_BIN) + l * PIN, F.ws};
            pg8::gemm_phase<EpiInproj, SchedInproj, 2>(F.lds, S, E, F.tid); } } PHASE_END
        PHASE_BEGIN if (PHMASK & (1u << 6)) for (int rep_ = 0; rep_ <= (int)((DUPMASK >> 6) & 1u); ++rep_) { phase_mixer(F, P, l, last); } PHASE_END
        const int Mx = last ? TL : MT;
        PHASE_BEGIN if (PHMASK & (1u << 7)) for (int rep_ = 0; rep_ <= (int)((DUPMASK >> 7) & 1u); ++rep_) { { SchedGateBr S{Hc, (const char*)(F.ws + WS_H8L), (const char*)(F.ws + WS_H8C), (const char*)(F.ws + WS_WIT) + ((size_t)l * PIN + NINP) * D * 2, (const char*)(F.ws + WS_BRV), (const char*)(F.ws + WS_WPT) + (size_t)l * 4 * D * 256 * 2, F.G, F.bid, !last};
            EpiGateBr E{(const float*)(F.ws + WS_BIN) + l * PIN + NINP, F.ws + WS_GS + (size_t)F.bid * 393216, (bf16*)(F.ws + WS_MG), (bf16*)(F.ws + WS_MI)}; pg8::gemm_phase<EpiGateBr, SchedGateBr, 2>(F.lds, S, E, F.tid); } } PHASE_END
        PHASE_BEGIN if (PHMASK & (1u << 8)) for (int rep_ = 0; rep_ <= (int)((DUPMASK >> 8) & 1u); ++rep_) { { SchedResid<4, 4> S{(const char*)(F.ws + WS_MG), (const char*)(F.ws + WS_WOT) + (size_t)l * D * D * 2, 2048u, 16, F.G, F.bid, !last, (const char*)(F.ws + WS_MI)};
            EpiRes E{(bf16*)(F.ws + WS_BRV), (const void*)P.out, true, modl + 5 * D, P.in[I_BOUT] + l * D, 1.0f, (float*)(F.ws + WS_ES), (const float*)(F.ws + WS_LNS), P.in[I_PLG] + (l * 3 + 0) * D, P.in[I_PLB] + (l * 3 + 0) * D}; pg8::gemm_phase(F.lds, S, E, F.tid); } } PHASE_END
        PHASE_BEGIN if (PHMASK & (1u << 9)) for (int rep_ = 0; rep_ <= (int)((DUPMASK >> 9) & 1u); ++rep_) { phase_ln(F, P, P.in[I_PLG] + (l * 3 + 1) * D, P.in[I_PLB] + (l * 3 + 1) * D, modl, 6, true, true, false, false, last ? 0 : 16, 1.0f, modl + (size_t)2 * 9216 + 5 * D, P.in[I_BOUT] + l * D, xcw, true, (const bf16*)(F.ws + WS_BRV)); } PHASE_END
        PHASE_BEGIN if (PHMASK & (1u << 10)) for (int rep_ = 0; rep_ <= (int)((DUPMASK >> 10) & 1u); ++rep_) { { SchedPlain S{Hc, (const char*)(F.ws + WS_W1T) + (size_t)(l * 2 + 1) * NFF * D, 1024u, 1024u, 8, Mx / 256, 22, F.G, F.bid};
            EpiFfnUp E{F.ws + WS_U}; pg8::gemm_phase<EpiFfnUp, SchedPlain, 1>(F.lds, S, E, F.tid); } } PHASE_END
        PHASE_BEGIN if (PHMASK & (1u << 11)) for (int rep_ = 0; rep_ <= (int)((DUPMASK >> 11) & 1u); ++rep_) { { SchedResid<5, 1, 6> S{(const char*)(F.ws + WS_U), (const char*)(F.ws + WS_W2T) + (size_t)(l * 2 + 1) * D * DFF, (unsigned)DFF, 22, F.G, F.bid, !last, (const char*)(F.ws + WS_U) + (size_t)TL * DFF};
            EpiRes E{(bf16*)(F.ws + WS_BRV), (const void*)(F.ws + WS_BRV), true, modl + 8 * D, nullptr, 0.5f / W2_SCALE, (float*)(F.ws + WS_ES), (const float*)(F.ws + WS_LNS), P.in[I_PLG] + (l * 3 + 1) * D, P.in[I_PLB] + (l * 3 + 1) * D}; pg8::gemm_phase<EpiRes, SchedResid<5, 1, 6>, 1>(F.lds, S, E, F.tid); } } PHASE_END
        PHASE_BEGIN if (PHMASK & (1u << 12)) for (int rep_ = 0; rep_ <= (int)((DUPMASK >> 12) & 1u); ++rep_) { phase_ln(F, P, P.in[I_PLG] + (l * 3 + 2) * D, P.in[I_PLB] + (l * 3 + 2) * D, MOD + (size_t)3 * 9216  , 0, !last, true, false, last, last ? 0 : 5, 0.5f / W2_SCALE, modl + (size_t)2 * 9216 + 8 * D, nullptr, xcw, !last, (const bf16*)(F.ws + WS_BRV)); } PHASE_END
    }
#undef MOD
#undef Hc
#undef modl
#undef xcw
#undef xc
#undef xl
#undef PHASE_BEGIN
#undef PHASE_END
}

#ifndef MK_N_LAUNCHES
#define MK_N_LAUNCHES 1
#endif
constexpr int N_PHASES = 2 + 2 * 11;
extern "C" void kernel_launch(void* const* d_in, const int* in_sizes, int n_in, void* d_out, int out_size, void* d_ws, size_t ws_size, hipStream_t stream) {
    static int grid = 0;
    if (grid == 0) {
        if (n_in != 33 || out_size != TL * D || ws_size < WS_TOTAL) { fprintf(stderr, "kernel_launch: unexpected shapes (n_in %d out %d ws %zu)\n", n_in, out_size, ws_size); grid = -1; return; }
        int dev = 0, cus = 0;
        if (hipGetDevice(&dev) != hipSuccess || hipDeviceGetAttribute(&cus, hipDeviceAttributeMultiprocessorCount, dev) != hipSuccess) { grid = -1; return; }
        if (hipFuncSetAttribute((const void*)mk_fwd, hipFuncAttributeMaxDynamicSharedMemorySize, LDS_BYTES) != hipSuccess) { fprintf(stderr, "kernel_launch: hipFuncSetAttribute failed\n"); grid = -1; return; }
        int per_cu = 0;
        if (hipOccupancyMaxActiveBlocksPerMultiprocessor(&per_cu, (const void*)mk_fwd, NTHR, LDS_BYTES) != hipSuccess || per_cu < 1) fprintf(stderr, "kernel_launch: occupancy query says %d\n", per_cu);
        (void)hipGetLastError();
        grid = cus;
    }
    if (grid < 0) return;
    (void)hipMemsetAsync((char*)d_ws + WS_CTL, 0, CTL_BYTES, stream);
    Params p{};
    for (int i = 0; i < 33; ++i) p.in[i] = (const float*)d_in[i];
    p.out = (float*)d_out; p.ws = (unsigned char*)d_ws;
#if MK_N_LAUNCHES == 1
    p.ph_lo = 0; p.ph_hi = N_PHASES;
    hipLaunchKernelGGL(mk_fwd, dim3(grid), dim3(NTHR), LDS_BYTES, stream, p);
#else
    for (int i = 0; i < N_PHASES; ++i) { p.ph_lo = i; p.ph_hi = i + 1; hipLaunchKernelGGL(mk_fwd, dim3(grid), dim3(NTHR), LDS_BYTES, stream, p); }
#endif
}
```

```cpp
#include <hip/hip_runtime.h>
#include <cstdio>
#include <cstdint>

#ifndef PHMASK
#define PHMASK 0xFFFFu
#endif
#ifndef DUPMASK
#define DUPMASK 0u
#endif
#ifndef FFTPROBE
#define FFTPROBE 0
#endif
#ifndef EPIDUP
#define EPIDUP 0
#endif
#ifndef MIXDUP
#define MIXDUP 0
#endif
#define LAS __attribute__((address_space(3)))
typedef unsigned short bf16;
typedef short bf16x8 __attribute__((ext_vector_type(8)));
typedef float f32x4 __attribute__((ext_vector_type(4)));
typedef float f32x2 __attribute__((ext_vector_type(2)));
typedef unsigned u32x4 __attribute__((ext_vector_type(4)));
typedef unsigned u32x2 __attribute__((ext_vector_type(2)));

constexpr int D = 1024, SEQ = 16384, TL = 32768, CTXL = 256, TC = 512, MT = TL + TC;
constexpr int DFF = 2816, NFF = 2 * DFF, PIN = 6912, NINP = 2816, NMOD = 9;
constexpr int WA = 256;
constexpr float LN_EPS = 1e-5f, ALPHA = 1.41421356237f, ATT_SCALE = 0.125f;
constexpr int NWAVES = 8, NTHR = 512;

constexpr size_t MiB = 1u << 20;
constexpr size_t WS_CTL = 0, CTL_BYTES = 1 * MiB;
constexpr size_t WS_MOD = 1 * MiB;
constexpr size_t WS_BIN = WS_MOD + 256 * 1024;
constexpr size_t WS_W3T = WS_BIN + 64 * 1024;
constexpr size_t WS_XC = 2 * MiB;
constexpr size_t WS_W1T = 4 * MiB;
constexpr size_t WS_W2T = WS_W1T + (size_t)4 * NFF * D * 2;
constexpr size_t WS_WIT = WS_W2T + (size_t)4 * D * DFF * 2;
constexpr size_t WS_WPT = WS_WIT + (size_t)2 * PIN * D * 2;
constexpr size_t WS_WOT = WS_WPT + (size_t)8 * D * 256 * 2;
constexpr size_t WS_H = WS_WOT + (size_t)2 * D * D * 2;
constexpr size_t WS_BRV = WS_H + (size_t)MT * D * 2;
constexpr size_t WS_FILT = WS_BRV + (size_t)MT * D * 2;
constexpr size_t WS_FILTC = WS_FILT + (size_t)4 * 256 * SEQ * 4;
constexpr size_t WS_H8L = WS_FILT + 32 * MiB;
constexpr size_t WS_LNS = WS_CTL + 64 * 1024;
constexpr size_t WS_H8C = WS_CTL + 512 * 1024;
constexpr size_t WS_U = WS_FILTC + (size_t)4 * 256 * 256 * 4;
constexpr size_t SZ256 = (size_t)MT * 256 * 2;
constexpr size_t WS_UA = WS_U, WS_Q = WS_U + SZ256, WS_K = WS_U + 2 * SZ256, WS_SB = WS_U + 3 * SZ256, WS_W = WS_U + 4 * SZ256;
constexpr size_t WS_VT = WS_U + 5 * SZ256;
constexpr size_t WS_HT = WS_U + 6 * SZ256;
constexpr size_t WS_KSCR = WS_U + 9 * SZ256;
constexpr size_t WS_MG = WS_U;
constexpr size_t WS_GS = WS_U + 4 * SZ256;
constexpr size_t WS_MI = WS_GS + (size_t)256 * 393216;
constexpr size_t WS_END = WS_U + (size_t)MT * DFF * 2;
static_assert(WS_KSCR + (size_t)256 * 131072 <= WS_END, "kscr");
static_assert(WS_MI + (size_t)4 * TC * D * 2 <= WS_END, "gs/mi");
constexpr size_t WS_ES = WS_END;
constexpr size_t WS_TOTAL = WS_ES + (size_t)256 * 131072;
static_assert(WS_TOTAL <= 512 * MiB, "ws");
static_assert(WS_BIN + 2 * PIN * 4 <= WS_W3T && WS_W3T + 2 * 1024 * 64 * 2 <= WS_XC && WS_MOD + 2 * 3 * 9216 * 4 <= WS_BIN, "small");

constexpr int RING_BYTES = 131072;
constexpr int FFT_BYTES = 133120;
constexpr int TW_OFF = FFT_BYTES;
constexpr int RPB_OFF = TW_OFF + 4096;
constexpr int RED_OFF = RPB_OFF + 7680;
constexpr int MISC_OFF = RED_OFF + 256;
constexpr int LDS_BYTES = 147456;
static_assert(MISC_OFF + 64 <= LDS_BYTES, "lds");

typedef __bf16 bf16x2_t __attribute__((ext_vector_type(2)));
__device__ __forceinline__ unsigned cvt_pk_bf16(float lo, float hi) { const f32x2 v = {lo, hi}; const bf16x2_t b = __builtin_convertvector(v, bf16x2_t); return __builtin_bit_cast(unsigned, b); }
typedef int v8i __attribute__((ext_vector_type(8)));
typedef int i32x4 __attribute__((ext_vector_type(4)));
__device__ __forceinline__ float sat8(float x) { return __builtin_amdgcn_fmed3f(x, -448.0f, 448.0f); }
__device__ __forceinline__ unsigned pk_fp8x4(float a, float b, float c, float d) { int p = 0; p = __builtin_amdgcn_cvt_pk_fp8_f32(sat8(a), sat8(b), p, false); p = __builtin_amdgcn_cvt_pk_fp8_f32(sat8(c), sat8(d), p, true); return (unsigned)p; }
constexpr float W1_SCALE = 32.0f, W2_SCALE = 64.0f;
__device__ __forceinline__ float bf2f(unsigned short b) { return __uint_as_float(((unsigned)b) << 16); }
__device__ __forceinline__ float bflo(unsigned w) { return __uint_as_float(w << 16); }
__device__ __forceinline__ float bfhi(unsigned w) { return __uint_as_float(w & 0xffff0000u); }
__device__ __forceinline__ float sigmoidf_(float x) { return __builtin_amdgcn_rcpf(1.0f + __builtin_amdgcn_exp2f(x * -1.44269504089f)); }
__device__ __forceinline__ float siluf_(float x) { return x * __builtin_amdgcn_rcpf(1.0f + __builtin_amdgcn_exp2f(x * -1.44269504089f)); }
__device__ __forceinline__ int lane_now() { int l_; asm volatile("v_mbcnt_lo_u32_b32 %0, -1, 0\n\tv_mbcnt_hi_u32_b32 %0, -1, %0" : "=v"(l_)); return l_; }
__device__ __forceinline__ float xrow_max(float v) {
    const unsigned a = __builtin_bit_cast(unsigned, v); auto r = __builtin_amdgcn_permlane16_swap(a, a, false, false);
    v = fmaxf(__builtin_bit_cast(float, (unsigned)r[0]), __builtin_bit_cast(float, (unsigned)r[1]));
    const unsigned b = __builtin_bit_cast(unsigned, v); auto q = __builtin_amdgcn_permlane32_swap(b, b, false, false);
    return fmaxf(__builtin_bit_cast(float, (unsigned)q[0]), __builtin_bit_cast(float, (unsigned)q[1]));
}
__device__ __forceinline__ float xrow_sum(float v) {
    const unsigned a = __builtin_bit_cast(unsigned, v); auto r = __builtin_amdgcn_permlane16_swap(a, a, false, false);
    v = __builtin_bit_cast(float, (unsigned)r[0]) + __builtin_bit_cast(float, (unsigned)r[1]);
    const unsigned b = __builtin_bit_cast(unsigned, v); auto q = __builtin_amdgcn_permlane32_swap(b, b, false, false);
    return __builtin_bit_cast(float, (unsigned)q[0]) + __builtin_bit_cast(float, (unsigned)q[1]);
}
__device__ __forceinline__ float shx(float v, int o, int lane) { return __builtin_bit_cast(float, __builtin_amdgcn_ds_bpermute((lane ^ o) << 2, __builtin_bit_cast(int, v))); }
#define DPP_F(v_, ctrl_) __builtin_bit_cast(float, __builtin_amdgcn_update_dpp(0, __builtin_bit_cast(int, (v_)), (ctrl_), 0xF, 0xF, true))
__device__ __forceinline__ float wave_sum(float v) {
    v += DPP_F(v, 0xB1);
    v += DPP_F(v, 0x4E);
    v += DPP_F(v, 0x141);
    v += DPP_F(v, 0x140);
    const int iv = __builtin_bit_cast(int, v);
    const float r0 = __builtin_bit_cast(float, __builtin_amdgcn_readlane(iv, 0)), r1 = __builtin_bit_cast(float, __builtin_amdgcn_readlane(iv, 16)),
                r2 = __builtin_bit_cast(float, __builtin_amdgcn_readlane(iv, 32)), r3 = __builtin_bit_cast(float, __builtin_amdgcn_readlane(iv, 48));
    return (r0 + r1) + (r2 + r3);
}
#define LDS_WAIT() asm volatile("s_waitcnt lgkmcnt(0)" ::: "memory")

#define XB_TMO      128
#define XB_XCNT(j)  (256  + 64 * (j))
#define XB_XSUB(j)  (1280 + 64 * (j))
#define XB_XGEN(j)  (2304 + 64 * (j))
#define XB_TOP      3328
#define XB_TOPGEN   3392
#define XCD_BAR_WORDS 3456
#define XB_SPIN_CAP (1u << 20)
__device__ __forceinline__ unsigned xb_ld(unsigned* p)              { return __hip_atomic_load(p, __ATOMIC_RELAXED, __HIP_MEMORY_SCOPE_AGENT); }
__device__ __forceinline__ unsigned xb_add(unsigned* p, unsigned v) { return __hip_atomic_fetch_add(p, v, __ATOMIC_RELAXED, __HIP_MEMORY_SCOPE_AGENT); }
__device__ __forceinline__ unsigned xb_xcc_id() { return (unsigned)__builtin_amdgcn_s_getreg((3 << 11) | 20) & 0xFu; }
#define XB_SPIN(cond, bar) do { unsigned _sp = 0; while (cond) { __builtin_amdgcn_s_sleep(1); \
    if ((++_sp & 255u) == 0u) { if (xb_ld(&(bar)[XB_TMO])) break; if (_sp > XB_SPIN_CAP) { atomicAdd(&(bar)[XB_TMO], 1u); break; } } } } while (0)
struct XcdBarrier { unsigned* bar; unsigned x; volatile LAS unsigned* st; };
__device__ __forceinline__ XcdBarrier xcd_barrier_post(unsigned* bar, volatile LAS unsigned* st) {
    XcdBarrier b; b.bar = bar; b.x = xb_xcc_id(); b.st = st;
    if (threadIdx.x == 0) (void)xb_add(&bar[XB_XCNT(b.x)], 1u);
    return b;
}
__device__ __forceinline__ void xcd_barrier_complete(unsigned* bar, unsigned x, unsigned& nloc, unsigned& nx) {
    const unsigned G = gridDim.x * gridDim.y * gridDim.z;
    unsigned sum, cnt, mine, sp = 0u;
    for (;;) {
        sum = 0u; cnt = 0u; mine = 0u;
#pragma unroll
        for (unsigned j = 0; j < 16; ++j) { const unsigned c = xb_ld(&bar[XB_XCNT(j)]); sum += c; cnt += (c > 0u) ? 1u : 0u; mine = (j == x) ? c : mine; }
        if (sum == G) break;
        __builtin_amdgcn_s_sleep(1);
        if ((++sp & 255u) == 0u) { if (xb_ld(&bar[XB_TMO])) break; if (sp > XB_SPIN_CAP) { atomicAdd(&bar[XB_TMO], 1u); break; } }
    }
    nloc = mine > 0u ? mine : 1u; nx = cnt > 0u ? cnt : 1u;
}
__device__ __forceinline__ void xcd_barrier(const XcdBarrier& b, int tid) {
    asm volatile("s_waitcnt vmcnt(0)" ::: "memory");
    __syncthreads();
    if (tid == 0) {
        unsigned* bar = b.bar;
        __builtin_amdgcn_s_waitcnt(0);
        unsigned nloc = b.st[0], nx = b.st[1];
        if (nloc == 0u) { xcd_barrier_complete(bar, b.x, nloc, nx); b.st[0] = nloc; b.st[1] = nx; }
        const unsigned old = xb_add(&bar[XB_XSUB(b.x)], 1u);
        const unsigned gen = old / nloc;
        if (old + 1u == (gen + 1u) * nloc) {
            __builtin_amdgcn_fence(__ATOMIC_RELEASE, "agent");
            asm volatile("s_waitcnt vmcnt(0)" ::: "memory");
            const unsigned og = xb_add(&bar[XB_TOP], 1u);
            const unsigned tg = og / nx;
            if (og + 1u == (tg + 1u) * nx) xb_add(&bar[XB_TOPGEN], 1u);
            else XB_SPIN(xb_ld(&bar[XB_TOPGEN]) == tg, bar);
            __builtin_amdgcn_fence(__ATOMIC_ACQUIRE, "agent");
            xb_add(&bar[XB_XGEN(b.x)], 1u);
            asm volatile("s_waitcnt vmcnt(0)" ::: "memory");
        } else {
            XB_SPIN(xb_ld(&bar[XB_XGEN(b.x)]) == gen, bar);
            __builtin_amdgcn_fence(__ATOMIC_ACQUIRE, "agent");
            asm volatile("s_waitcnt vmcnt(0)" ::: "memory");
        }
    }
    __syncthreads();
}

namespace pg8 {
constexpr int BM = 256, BK = 64, HALF = 128, HTB = HALF * BK * 2, NXCD = 8, WGM = 8;
__host__ __device__ __forceinline__ int lds_byte(int r, int c) { const int st = (r >> 4) * 2 + (c >> 5), rr = r & 15, cc = c & 31, ob = rr * 64 + cc * 2; return st * 1024 + (ob ^ (((ob >> 9) & 1) << 5)); }
__host__ __device__ __forceinline__ void stage_rc(int b, int& R, int& C) { const int st = b / 1024, sb = b % 1024, swz = sb ^ (((sb >> 9) & 1) << 5); R = (st >> 1) * 16 + swz / 64; C = (st & 1) * 32 + (swz % 64) / 2; }
__host__ __device__ __forceinline__ int perm32(int rho) { const int n = rho >> 4, i = rho & 15; return 8 * (i >> 2) + 4 * n + (i & 3); }

struct GUnit { const char* A; const char* B; unsigned lda, ldb; int nt; int pm, pn, kind; bool f8; };

__device__ __forceinline__ bool static_tile(int i, int G, int c, int nM, int nN, int& pm, int& pn) {
    const int nwg = nM * nN; const long L = (long)i * G + c; if (L >= nwg) return false;
    int wgid = (int)L; { const int q = nwg / NXCD, r = nwg % NXCD, xcd = wgid % NXCD, off = wgid / NXCD; wgid = (xcd < r ? xcd * (q + 1) : r * (q + 1) + (xcd - r) * q) + off; }
    const int nig = WGM * nN, gid = wgid / nig, fm = gid * WGM, gsz = (nM - fm) < WGM ? (nM - fm) : WGM;
    pm = fm + ((wgid % nig) % gsz); pn = (wgid % nig) / gsz; return true;
}

template <class Epi, class Sched, int F8M = 0  >
__device__ __forceinline__ void gemm_phase(LAS unsigned char* lds, const Sched& S, const Epi& E, int tid_in) {
    int tid_ = tid_in; asm volatile("" : "+v"(tid_));
    const int tid = tid_, wid = __builtin_amdgcn_readfirstlane(tid >> 6), lane = tid & 63, wr = wid >> 2, wc = wid & 3, fr = lane & 15, fq = lane >> 4;
    unsigned RA[2], RB[2], CC[2];
#pragma unroll
    for (int i = 0; i < 2; ++i) { int R, C; stage_rc(tid * 16 + i * 8192, R, C); RA[i] = (unsigned)R; RB[i] = (unsigned)((R & ~31) + perm32(R & 31)); CC[i] = (unsigned)C * 2u; }
    const size_t kstep = (size_t)(BK * 2);
    const unsigned ldsw = (unsigned)wid * 1024u;
#define PG8_SA(b, h) (((b) * 2 + (h)) * HTB)
#define PG8_SB(b, h) ((4 + (b) * 2 + (h)) * HTB)
#define PG8_STAGE(bufoff, gbase, RR, ld) do { _Pragma("unroll") for (int _i = 0; _i < 2; ++_i) \
        __builtin_amdgcn_global_load_lds((const unsigned*)((const char*)(gbase) + ((RR)[_i] * (ld) + CC[_i])), (LAS unsigned*)(lds + (bufoff) + ldsw + _i * 8192), 16, 0, 0); } while (0)
#define PG8_LDA(F8C, dst, b, h) do { _Pragma("unroll") for (int m = 0; m < 4; ++m) { dst[m][0] = *(const LAS i32x4*)(lds + PG8_SA(b, h) + ao0 + m * 2048); dst[m][1] = *(const LAS i32x4*)(lds + PG8_SA(b, h) + ao1 + m * 2048); } } while (0)
#define PG8_LDB(F8C, dst, b, h) do { _Pragma("unroll") for (int n = 0; n < 2; ++n) { dst[n][0] = *(const LAS i32x4*)(lds + PG8_SB(b, h) + bo0 + n * 2048); dst[n][1] = *(const LAS i32x4*)(lds + PG8_SB(b, h) + bo1 + n * 2048); } } while (0)
#define PG8_V8(x) __builtin_shufflevector((x)[0], (x)[1], 0, 1, 2, 3, 4, 5, 6, 7)
#define PG8_MMA(F8C, ai, bj, At, Bt) do { __builtin_amdgcn_s_setprio(1); if constexpr (F8C) { _Pragma("unroll") for (int m = 0; m < 4; ++m) _Pragma("unroll") for (int n = 0; n < 2; ++n) \
            { const v8i b8_ = PG8_V8(Bt[n]), a8_ = PG8_V8(At[m]); asm volatile("v_mfma_scale_f32_16x16x128_f8f6f4 %0, %1, %2, %0, %3, %3 op_sel_hi:[0,0,0]" : "+v"(acc[ai][bj][m][n]) : "v"(b8_), "v"(a8_), "v"(one_scale)); } } \
        else { _Pragma("unroll") for (int m = 0; m < 4; ++m) _Pragma("unroll") for (int n = 0; n < 2; ++n) _Pragma("unroll") for (int k = 0; k < 2; ++k) \
            acc[ai][bj][m][n] = __builtin_amdgcn_mfma_f32_16x16x32_bf16(__builtin_bit_cast(bf16x8, Bt[n][k]), __builtin_bit_cast(bf16x8, At[m][k]), acc[ai][bj][m][n], 0, 0, 0); } __builtin_amdgcn_s_setprio(0); } while (0)
#define PG8_TRIP(F8C, WN) { \
            const bool last = (t == nt - 2); \
            const char* a1 = cA + (size_t)(t + 1) * kstep; \
            const char* a2 = last ? nA : cA + (size_t)(t + 2) * kstep; const char* b2 = last ? nB : cB + (size_t)(t + 2) * kstep; \
            const char* a3 = a2 + kstep; const char* b3 = b2 + kstep; \
            const unsigned xldA = last ? nldA : ldA, xldB = last ? nldB : ldB; const size_t xhsA = last ? nhsA : hsA, xhsB = last ? nhsB : hsB; \
            PG8_LDB(F8C, B0, 0, 0); PG8_LDB(F8C, B1, 0, 1); PG8_SCHED; PG8_LDA(F8C, At, 0, 0); PG8_STAGE(PG8_SA(1, 1), a1 + hsA, RA, ldA); \
            PG8_WAIT_V(WN); PG8_WAIT_L(0); PG8_BAR; PG8_MMA(F8C, 0, 0, At, B0); PG8_MMA(F8C, 0, 1, At, B1); PG8_BAR; PG8_SCHED; \
            PG8_LDA(F8C, At, 0, 1); PG8_STAGE(PG8_SB(0, 0), b2, RB, xldB); PG8_STAGE(PG8_SB(0, 1), b2 + xhsB, RB, xldB); PG8_STAGE(PG8_SA(0, 0), a2, RA, xldA); \
            PG8_WAIT_V(WN); PG8_WAIT_L(0); PG8_BAR; PG8_MMA(F8C, 1, 0, At, B0); PG8_MMA(F8C, 1, 1, At, B1); PG8_BAR; PG8_SCHED; \
            PG8_LDB(F8C, B0, 1, 0); PG8_LDB(F8C, B1, 1, 1); PG8_SCHED; PG8_LDA(F8C, At, 1, 0); PG8_STAGE(PG8_SA(0, 1), a2 + xhsA, RA, xldA); \
            PG8_WAIT_V(8); PG8_WAIT_L(0); PG8_BAR; PG8_MMA(F8C, 0, 0, At, B0); PG8_MMA(F8C, 0, 1, At, B1); PG8_BAR; PG8_SCHED; \
            PG8_LDA(F8C, At, 1, 1); PG8_STAGE(PG8_SB(1, 0), b3, RB, xldB); PG8_STAGE(PG8_SB(1, 1), b3 + xhsB, RB, xldB); PG8_STAGE(PG8_SA(1, 0), a3, RA, xldA); \
            PG8_WAIT_V(8); PG8_WAIT_L(0); PG8_BAR; PG8_MMA(F8C, 1, 0, At, B0); PG8_MMA(F8C, 1, 1, At, B1); PG8_BAR; PG8_SCHED; \
        }
#define PG8_KLOOP(F8C) const int ln_ = lane_now();   \
        const int fr_ = ln_ & 15, fq_ = ln_ >> 4; \
        const int ao0 = lds_byte(wr * 64 + fr_, (F8C) ? 16 * fq_ : 8 * fq_), ao1 = (F8C) ? lds_byte(wr * 64 + fr_, 16 * fq_ + 8) : ao0 + 1024; \
        const int bo0 = lds_byte(wc * 32 + fr_, (F8C) ? 16 * fq_ : 8 * fq_), bo1 = (F8C) ? lds_byte(wc * 32 + fr_, 16 * fq_ + 8) : bo0 + 1024; \
        int t = 0; \
        if constexpr (Epi::NST == 8) { if (ui > 0) { PG8_TRIP(F8C, 16) t = 2; } } \
        for (; t < nt; t += 2) PG8_TRIP(F8C, 8)
#define PG8_WAIT_V(n) asm volatile("s_waitcnt vmcnt(" #n ")" ::: "memory")
#define PG8_WAIT_L(n) asm volatile("s_waitcnt lgkmcnt(" #n ")" ::: "memory")
#define PG8_BAR __builtin_amdgcn_s_barrier()
#define PG8_SCHED __builtin_amdgcn_sched_barrier(0)
    GUnit cur, nxt; int ui = 0;
    if (!S.next(0, cur)) return;
    f32x4 acc[2][2][4][2];
#pragma unroll
    for (int a = 0; a < 2; ++a)
#pragma unroll
        for (int b = 0; b < 2; ++b)
#pragma unroll
            for (int m = 0; m < 4; ++m)
#pragma unroll
                for (int n = 0; n < 2; ++n) acc[a][b][m][n] = (f32x4){0.f, 0.f, 0.f, 0.f};
    i32x4 At[4][2], B0[2][2], B1[2][2];
    int one_scale = 0x7F7F7F7F; asm volatile("" : "+v"(one_scale));
    const char* cA = cur.A; const char* cB = cur.B;
    unsigned ldA = cur.lda, ldB = cur.ldb; size_t hsA = (size_t)HALF * ldA, hsB = (size_t)HALF * ldB;
    PG8_STAGE(PG8_SB(0, 0), cB, RB, ldB); PG8_STAGE(PG8_SB(0, 1), cB + hsB, RB, ldB); PG8_STAGE(PG8_SA(0, 0), cA, RA, ldA); PG8_STAGE(PG8_SA(0, 1), cA + hsA, RA, ldA);
    if (wr == 1) PG8_BAR;
    PG8_WAIT_V(2); PG8_BAR;
    PG8_STAGE(PG8_SB(1, 0), cB + kstep, RB, ldB); PG8_STAGE(PG8_SA(1, 0), cA + kstep, RA, ldA); PG8_STAGE(PG8_SB(1, 1), cB + hsB + kstep, RB, ldB);
    PG8_WAIT_V(6); PG8_BAR;
    for (;;) {
        const bool has_next = S.next(ui + 1, nxt);
        const char* nA = has_next ? nxt.A : cA; const char* nB = has_next ? nxt.B : cB;
        const unsigned nldA = has_next ? nxt.lda : ldA, nldB = has_next ? nxt.ldb : ldB;
        const size_t nhsA = (size_t)HALF * nldA, nhsB = (size_t)HALF * nldB;
        const int nt = cur.nt;
        if constexpr (F8M == 2) { if (cur.f8) { PG8_KLOOP(true) } else { PG8_KLOOP(false) } }
        else if constexpr (F8M == 1) { PG8_KLOOP(true) }
        else { PG8_KLOOP(false) }
        if (wr == 0) PG8_BAR;
        if constexpr (F8M != 0) asm volatile("s_nop 15\n\ts_nop 15" ::: "memory");
        { const int le_ = lane_now(); E(acc, cur, (wid << 6) | le_, wr, wc, le_ & 15, le_ >> 4); }
        if (!has_next) break;
#pragma unroll
        for (int a = 0; a < 2; ++a)
#pragma unroll
            for (int b = 0; b < 2; ++b)
#pragma unroll
                for (int m = 0; m < 4; ++m)
#pragma unroll
                    for (int n = 0; n < 2; ++n) acc[a][b][m][n] = (f32x4){0.f, 0.f, 0.f, 0.f};
        cur = nxt; cA = nA; cB = nB; hsA = nhsA; hsB = nhsB; ldA = nldA; ldB = nldB; ++ui;
        if (wr == 1) PG8_BAR;
    }
    PG8_WAIT_V(0);
    PG8_BAR;
#undef PG8_SA
#undef PG8_SB
#undef PG8_STAGE
#undef PG8_LDA
#undef PG8_KLOOP
#undef PG8_TRIP
#undef PG8_V8
#undef PG8_LDB
#undef PG8_MMA
#undef PG8_WAIT_V
#undef PG8_WAIT_L
#undef PG8_BAR
#undef PG8_SCHED
}
}
using pg8::GUnit;
typedef f32x4 Acc[2][2][4][2];

struct Params {
    const float* in[33];
    float* out;
    unsigned char* ws;
    int ph_lo, ph_hi;
};
enum { I_X = 0, I_C, I_CTX, I_CCTX, I_WMOD, I_BMOD, I_PLG, I_PLB, I_FWI, I_FWO, I_WIN, I_BIN, I_CDW, I_CDB, I_CLG, I_CLB, I_CWP, I_RPB, I_NWP, I_SCW, I_SWP,
       I_HSW, I_HSB, I_HW1, I_HB1, I_HW2, I_HB2, I_HFQ, I_HW3, I_HBI, I_HWP, I_WOUT, I_BOUT };

__device__ __forceinline__ int row_grp(int pm) { return pm < 64 ? 0 : (pm < 128 ? 1 : 2); }

struct SchedPlain {
    const char* A; const char* B; unsigned lda, ldb; int nt, nM, nN, G, c;
    __device__ __forceinline__ bool next(int i, GUnit& u) const {
        int pm, pn; if (!pg8::static_tile(i, G, c, nM, nN, pm, pn)) return false;
        u.A = A + (size_t)pm * 256 * lda; u.B = B + (size_t)pn * 256 * ldb; u.lda = lda; u.ldb = ldb; u.nt = nt; u.pm = pm; u.pn = pn; u.kind = 0; u.f8 = true; return true;
    }
};
template <int NKS, int NSRC, int NTLAST = 4> struct SchedResid {
    const char* A; const char* B; unsigned ld; int nt, G, c; bool ctx; const char* Ac;
    __device__ __forceinline__ bool next(int i, GUnit& u) const {
        int pm, pn; u.lda = ld; u.ldb = ld; u.f8 = true;
        if (pg8::static_tile(i, G, c, TL / 256, 4, pm, pn)) { u.A = A + (size_t)pm * 256 * ld; u.B = B + (size_t)pn * 256 * ld; u.nt = nt; u.pm = pm; u.pn = pn; u.kind = 0; return true; }
        constexpr int NK = NKS * NSRC;
        const int j = i * G + c - (TL / 256) * 4; if (!ctx || j < 0 || j >= 8 * NK) return false;
        const int panel = j / (4 * NK), rem = j % (4 * NK), kk = rem % NK, src = kk / NKS, ks = kk % NKS; pn = rem / NK;
        u.A = Ac + ((size_t)src * TC + panel * 256) * ld + ks * 512; u.B = B + (size_t)pn * 256 * ld + ks * 512; u.nt = (ks == NKS - 1) ? NTLAST : 4; u.pm = TL / 256 + panel; u.pn = pn; u.kind = 1 + kk; return true;
    }
};
enum { KI_GLU = 0, KI_PLAIN = 1, KI_PAIR = 2, KI_TRANS = 3 };
struct SchedInproj {
    const char* ws; int l, nM, G, c;
    __device__ __forceinline__ bool next(int i, GUnit& u) const {
        int pm, pn; if (!pg8::static_tile(i, G, c, nM, 11, pm, pn)) return false;
        const bool tr = (pn == 4) || (pn >= 8), f8 = pn < 8;
        const char* a; const char* b;
        if (f8) { a = (pm < TL / 256) ? ws + WS_H8L + (size_t)pm * 256 * 1024 : ws + WS_H8C + (size_t)(pm - TL / 256) * 256 * 1024; b = ws + WS_WIT + ((size_t)l * PIN + NINP) * D * 2 + 6 * MiB + (size_t)pn * 256 * 1024; u.lda = 1024; u.ldb = 1024; u.nt = 8; }
        else { a = ws + WS_H + (size_t)pm * 256 * 2048; b = ws + WS_WIT + (size_t)l * PIN * D * 2 + (size_t)pn * 256 * 2048; u.lda = 2048; u.ldb = 2048; u.nt = 16; }
        u.A = tr ? b : a; u.B = tr ? a : b; u.pm = pm; u.pn = pn; u.f8 = f8;
        u.kind = tr ? KI_TRANS : (pn < 2 ? KI_GLU : (pn == 6 || pn == 7 ? KI_PAIR : KI_PLAIN)); return true;
    }
};
struct SchedGateBr {
    const char* HB  ; const char* H; const char* HC  ; const char* WG  ; const char* BR; const char* WP; int G, c; bool ctx;
    __device__ __forceinline__ bool next(int i, GUnit& u) const {
        int pm, pn, j, br;
        if (pg8::static_tile(i >> 3, G, c, TL / 256, 4, pm, pn)) { j = i & 7; br = j >> 1; }
        else {
            const int ntl = ((TL / 256) * 4 - c + G - 1) / G, e = i - 8 * ntl;
            if (!ctx || c >= 32 || e < 0 || e > 1) return false;
            pm = TL / 256 + (c >> 4); pn = (c >> 2) & 3; br = c & 3; j = 8 + 2 * br + e;
        }
        if ((j & 1) == 0) { u.A = (pm < TL / 256) ? H + (size_t)pm * 256 * 1024 : HC + (size_t)(pm - TL / 256) * 256 * 1024; u.B = WG + (size_t)(br * 1024 + pn * 256) * 1024; u.lda = 1024; u.ldb = 1024; u.nt = 8; u.f8 = true; }
        else { u.A = BR + (size_t)br * SZ256 + (size_t)pm * 256 * 512; u.B = WP + (size_t)(br * 1024 + pn * 256) * 512; u.lda = 512; u.ldb = 512; u.nt = 4; u.f8 = false; }
        u.pm = pm; u.pn = pn; u.kind = j; return true;
    }
};

struct EpiFfnUp {
    static constexpr bool DUP_OK = true; static constexpr int NST = 8;
    unsigned char* U;
    __device__ __forceinline__ void operator()(const Acc& acc, const GUnit& u, int tid, int wr, int wc, int fr, int fq) const {
        const int row0 = u.pm * 256 + wr * 64 + fr, col0 = u.pn * 128 + wc * 32 + 8 * fq;
        constexpr float IS = 1.0f / W1_SCALE;
#pragma unroll
        for (int ai = 0; ai < 2; ++ai)
#pragma unroll
            for (int m = 0; m < 4; ++m) {
                const f32x4 a0 = acc[ai][0][m][0] * IS, a1 = acc[ai][0][m][1] * IS, g0 = acc[ai][1][m][0] * IS, g1 = acc[ai][1][m][1] * IS;
                u32x2 w; w.x = pk_fp8x4(siluf_(g0[0]) * a0[0], siluf_(g0[1]) * a0[1], siluf_(g0[2]) * a0[2], siluf_(g0[3]) * a0[3]);
                w.y = pk_fp8x4(siluf_(g1[0]) * a1[0], siluf_(g1[1]) * a1[1], siluf_(g1[2]) * a1[2], siluf_(g1[3]) * a1[3]);
                *(u32x2*)(U + (size_t)(row0 + ai * 128 + m * 16) * DFF + col0) = w;
            }
    }
};
struct EpiRes {
    static constexpr bool DUP_OK = false; static constexpr int NST = 0;
    bf16* V; const void* xl; bool xbf  ; const float* modl  ; const float* bias; float coef; float* part;
    const float* xstat; const float* xg; const float* xbt;
    __device__ __forceinline__ void operator()(const Acc& acc, const GUnit& u, int tid, int wr, int wc, int fr, int fq) const {
        int row0 = u.pm * 256 + wr * 64 + fr, colt = u.pn * 256 + wc * 32 + 8 * fq; asm volatile("" : "+v"(row0), "+v"(colt));
        if (u.kind != 0) {
            float* pp = part + ((size_t)(u.kind - 1) * TC + (row0 - TL)) * D + colt;
#pragma unroll
            for (int ai = 0; ai < 2; ++ai)
#pragma unroll
                for (int m = 0; m < 4; ++m)
#pragma unroll
                    for (int bj = 0; bj < 2; ++bj) { float* q = pp + (size_t)(ai * 128 + m * 16) * D + bj * 128; *(f32x4*)q = acc[ai][bj][m][0]; *(f32x4*)(q + 4) = acc[ai][bj][m][1]; }
            return;
        }
        if (xstat) body_ln(acc, u, row0, colt); else if (xbf) body<true>(acc, u, row0, colt); else body<false>(acc, u, row0, colt);
    }
    template <bool XB> __device__ __forceinline__ void body(const Acc& acc, const GUnit& u, int row0, int colt) const {
        const float* mv = modl + (size_t)row_grp(u.pm) * 9216;
        f32x4 sc[2][2], bv[2][2];
#pragma unroll
        for (int bj = 0; bj < 2; ++bj)
#pragma unroll
            for (int n = 0; n < 2; ++n) { sc[bj][n] = *(const f32x4*)(mv + colt + bj * 128 + 4 * n) * coef;
                bv[bj][n] = bias ? *(const f32x4*)(bias + colt + bj * 128 + 4 * n) : (f32x4){0.f, 0.f, 0.f, 0.f}; }
#pragma unroll
        for (int ai = 0; ai < 2; ++ai) {
            bf16* vp = V + (size_t)(row0 + ai * 128) * D + colt;
            if constexpr (XB) {
                const bf16* xh = (const bf16*)xl + (size_t)(row0 + ai * 128) * D + colt;
                u32x4 xw[4][2];
#pragma unroll
                for (int m = 0; m < 4; ++m)
#pragma unroll
                    for (int bj = 0; bj < 2; ++bj) xw[m][bj] = *(const u32x4*)(xh + (size_t)(m * 16) * D + bj * 128);
#pragma unroll
                for (int m = 0; m < 4; ++m)
#pragma unroll
                    for (int bj = 0; bj < 2; ++bj) { const u32x4 w_ = xw[m][bj];
                        const f32x4 x0 = (f32x4){bflo(w_.x), bfhi(w_.x), bflo(w_.y), bfhi(w_.y)}, x1 = (f32x4){bflo(w_.z), bfhi(w_.z), bflo(w_.w), bfhi(w_.w)};
                        const f32x4 v0 = x0 * ALPHA + sc[bj][0] * (acc[ai][bj][m][0] + bv[bj][0]), v1 = x1 * ALPHA + sc[bj][1] * (acc[ai][bj][m][1] + bv[bj][1]);
                        u32x4 w; w.x = cvt_pk_bf16(v0[0], v0[1]); w.y = cvt_pk_bf16(v0[2], v0[3]); w.z = cvt_pk_bf16(v1[0], v1[1]); w.w = cvt_pk_bf16(v1[2], v1[3]);
                        *(u32x4*)(vp + (size_t)(m * 16) * D + bj * 128) = w; }
            } else {
                const float* xb = (const float*)xl + (size_t)(row0 + ai * 128) * D + colt;
#pragma unroll
                for (int mh = 0; mh < 2; ++mh) {
                    f32x4 xf[2][2][2];
#pragma unroll
                    for (int mm = 0; mm < 2; ++mm)
#pragma unroll
                        for (int bj = 0; bj < 2; ++bj) { const float* q = xb + (size_t)((mh * 2 + mm) * 16) * D + bj * 128; xf[mm][bj][0] = *(const f32x4*)q; xf[mm][bj][1] = *(const f32x4*)(q + 4); }
#pragma unroll
                    for (int mm = 0; mm < 2; ++mm)
#pragma unroll
                        for (int bj = 0; bj < 2; ++bj) { const int m = mh * 2 + mm;
                            const f32x4 v0 = xf[mm][bj][0] * ALPHA + sc[bj][0] * (acc[ai][bj][m][0] + bv[bj][0]), v1 = xf[mm][bj][1] * ALPHA + sc[bj][1] * (acc[ai][bj][m][1] + bv[bj][1]);
                            u32x4 w; w.x = cvt_pk_bf16(v0[0], v0[1]); w.y = cvt_pk_bf16(v0[2], v0[3]); w.z = cvt_pk_bf16(v1[0], v1[1]); w.w = cvt_pk_bf16(v1[2], v1[3]);
                            *(u32x4*)(vp + (size_t)(m * 16) * D + bj * 128) = w; }
                    asm volatile("" ::: "memory");
                }
            }
            asm volatile("" ::: "memory");
        }
    }
    __device__ __forceinline__ void body_ln(const Acc& acc, const GUnit& u, int row0, int colt) const {
        const float* mv = modl + (size_t)row_grp(u.pm) * 9216;
#pragma unroll
        for (int bj = 0; bj < 2; ++bj) {
            f32x4 sc[2], gg[2], bb[2], bv[2];
#pragma unroll
            for (int n = 0; n < 2; ++n) { sc[n] = *(const f32x4*)(mv + colt + bj * 128 + 4 * n) * coef; gg[n] = *(const f32x4*)(xg + colt + bj * 128 + 4 * n); bb[n] = *(const f32x4*)(xbt + colt + bj * 128 + 4 * n);
                bv[n] = bias ? *(const f32x4*)(bias + colt + bj * 128 + 4 * n) : (f32x4){0.f, 0.f, 0.f, 0.f}; }
#pragma unroll
            for (int ai = 0; ai < 2; ++ai) {
                bf16* vp = V + (size_t)(row0 + ai * 128) * D + colt + bj * 128; const bf16* xp = (const bf16*)xl + (size_t)(row0 + ai * 128) * D + colt + bj * 128;
                u32x4 xw[4]; f32x2 st[4];
#pragma unroll
                for (int m = 0; m < 4; ++m) { st[m] = *(const f32x2*)(xstat + (size_t)(row0 + ai * 128 + m * 16) * 2); xw[m] = *(const u32x4*)(xp + (size_t)(m * 16) * D); }
#pragma unroll
                for (int m = 0; m < 4; ++m) { const u32x4 w_ = xw[m]; const float mu = st[m].x, rs = st[m].y;
                    const f32x4 x0 = ((f32x4){bflo(w_.x), bfhi(w_.x), bflo(w_.y), bfhi(w_.y)} - mu) * (gg[0] * rs) + bb[0], x1 = ((f32x4){bflo(w_.z), bfhi(w_.z), bflo(w_.w), bfhi(w_.w)} - mu) * (gg[1] * rs) + bb[1];
                    const f32x4 v0 = x0 * ALPHA + sc[0] * (acc[ai][bj][m][0] + bv[0]), v1 = x1 * ALPHA + sc[1] * (acc[ai][bj][m][1] + bv[1]);
                    u32x4 w; w.x = cvt_pk_bf16(v0[0], v0[1]); w.y = cvt_pk_bf16(v0[2], v0[3]); w.z = cvt_pk_bf16(v1[0], v1[1]); w.w = cvt_pk_bf16(v1[2], v1[3]);
                    *(u32x4*)(vp + (size_t)(m * 16) * D) = w; }
                asm volatile("" ::: "memory");
            }
        }
    }
};
struct EpiInproj {
    static constexpr bool DUP_OK = false; static constexpr int NST = 0;
    const float* bin;
    unsigned char* ws;
    __device__ __forceinline__ void operator()(const Acc& acc, const GUnit& u, int tid, int wr, int wc, int fr, int fq) const {
        bf16* const UA = (bf16*)(ws + WS_UA); bf16* const Q = (bf16*)(ws + WS_Q); bf16* const K = (bf16*)(ws + WS_K); bf16* const SB = (bf16*)(ws + WS_SB);
        bf16* const W = (bf16*)(ws + WS_W); bf16* const VT = (bf16*)(ws + WS_VT); bf16* const HT = (bf16*)(ws + WS_HT);
        int c8 = wc * 32 + 8 * fq; asm volatile("" : "+v"(c8));
        const float IS = u.f8 ? (1.0f / W1_SCALE) : 1.0f;
        if (u.kind == KI_TRANS) {
            bf16* dst = (u.pn == 4) ? VT : HT + (size_t)(u.pn - 8) * 256 * MT;
            const int r0 = wr * 64 + fr;
#pragma unroll
            for (int ai = 0; ai < 2; ++ai)
#pragma unroll
                for (int m = 0; m < 4; ++m) {
                    const int r = r0 + ai * 128 + m * 16; const float b = bin[u.pn * 256 + r];
#pragma unroll
                    for (int bj = 0; bj < 2; ++bj) {
                        const f32x4 v0 = acc[ai][bj][m][0] * IS + b, v1 = acc[ai][bj][m][1] * IS + b;
                        u32x4 w; w.x = cvt_pk_bf16(v0[0], v0[1]); w.y = cvt_pk_bf16(v0[2], v0[3]); w.z = cvt_pk_bf16(v1[0], v1[1]); w.w = cvt_pk_bf16(v1[2], v1[3]);
                        *(u32x4*)(dst + (size_t)r * MT + u.pm * 256 + bj * 128 + c8) = w;
                    }
                }
            return;
        }
        const int row0 = u.pm * 256 + wr * 64 + fr;
        f32x4 bv[2][2];
#pragma unroll
        for (int bj = 0; bj < 2; ++bj)
#pragma unroll
            for (int n = 0; n < 2; ++n) bv[bj][n] = *(const f32x4*)(bin + u.pn * 256 + bj * 128 + c8 + 4 * n);
        if (u.kind == KI_PLAIN) {
            bf16* dst = (u.pn == 2) ? Q : (u.pn == 3 ? K : SB); const float scl = (u.pn == 2) ? ATT_SCALE * 1.44269504089f : 1.0f;
#pragma unroll
            for (int ai = 0; ai < 2; ++ai)
#pragma unroll
                for (int m = 0; m < 4; ++m)
#pragma unroll
                    for (int bj = 0; bj < 2; ++bj) {
                        const f32x4 v0 = (acc[ai][bj][m][0] * IS + bv[bj][0]) * scl, v1 = (acc[ai][bj][m][1] * IS + bv[bj][1]) * scl;
                        u32x4 w; w.x = cvt_pk_bf16(v0[0], v0[1]); w.y = cvt_pk_bf16(v0[2], v0[3]); w.z = cvt_pk_bf16(v1[0], v1[1]); w.w = cvt_pk_bf16(v1[2], v1[3]);
                        *(u32x4*)(dst + (size_t)(row0 + ai * 128 + m * 16) * 256 + bj * 128 + c8) = w;
                    }
            return;
        }
        const bool glu = (u.kind == KI_GLU);
        bf16* dst = glu ? UA + u.pn * 128 : W + (u.pn - 6) * 128;
#pragma unroll
        for (int ai = 0; ai < 2; ++ai)
#pragma unroll
            for (int m = 0; m < 4; ++m) {
                f32x4 a0 = acc[ai][0][m][0] * IS + bv[0][0], a1 = acc[ai][0][m][1] * IS + bv[0][1], g0 = acc[ai][1][m][0] * IS + bv[1][0], g1 = acc[ai][1][m][1] * IS + bv[1][1];
                if (glu) {
#pragma unroll
                    for (int j = 0; j < 4; ++j) { g0[j] = sigmoidf_(g0[j]); g1[j] = sigmoidf_(g1[j]); }
                }
                const f32x4 v0 = a0 * g0, v1 = a1 * g1;
                u32x4 w; w.x = cvt_pk_bf16(v0[0], v0[1]); w.y = cvt_pk_bf16(v0[2], v0[3]); w.z = cvt_pk_bf16(v1[0], v1[1]); w.w = cvt_pk_bf16(v1[2], v1[3]);
                *(u32x4*)(dst + (size_t)(row0 + ai * 128 + m * 16) * 256 + c8) = w;
            }
    }
};
__device__ __forceinline__ unsigned pk_u8x4(f32x4 v) { const unsigned a = (unsigned)(v[0] * 255.0f + 0.5f), b = (unsigned)(v[1] * 255.0f + 0.5f), c = (unsigned)(v[2] * 255.0f + 0.5f), d = (unsigned)(v[3] * 255.0f + 0.5f); return a | (b << 8) | (c << 16) | (d << 24); }
struct EpiGateBr {
    static constexpr bool DUP_OK = false; static constexpr int NST = 0;
    const float* bing;
    unsigned char* gs;
    bf16* MG; bf16* MI;
    __device__ __forceinline__ void operator()(const Acc& acc, const GUnit& u, int tid, int wr, int wc, int fr, int fq) const {
        const int br = (u.kind >> 1) & 3; const bool cjob = (u.kind & 8) != 0;
        unsigned so = (unsigned)tid * 16u; asm volatile("" : "+v"(so));
        const unsigned mo = so * 2u;
        if ((u.kind & 1) == 0) {
            const float* bb = bing + br * 1024 + u.pn * 256 + wc * 32 + 8 * fq;
            f32x4 bv[2][2];
#pragma unroll
            for (int bj = 0; bj < 2; ++bj)
#pragma unroll
                for (int n = 0; n < 2; ++n) bv[bj][n] = *(const f32x4*)(bb + bj * 128 + 4 * n);
            unsigned char* sp = gs;
#pragma unroll
            for (int ai = 0; ai < 2; ++ai)
#pragma unroll
                for (int m = 0; m < 4; ++m)
#pragma unroll
                    for (int bj = 0; bj < 2; ++bj) {
                        const float gs_ = u.f8 ? (1.0f / W1_SCALE) : 1.0f; f32x4 v0 = acc[ai][bj][m][0] * gs_ + bv[bj][0], v1 = acc[ai][bj][m][1] * gs_ + bv[bj][1];
#pragma unroll
                        for (int j = 0; j < 4; ++j) { v0[j] = sigmoidf_(v0[j]); v1[j] = sigmoidf_(v1[j]); }
                        u32x2 w; w.x = pk_u8x4(v0); w.y = pk_u8x4(v1);
                        *(u32x2*)(sp + (so >> 1)) = w; sp += 4096;
                    }
        } else {
            unsigned lo = (unsigned)(((wr * 64 + fr) * D + u.pn * 256 + wc * 32 + 8 * fq) * 2); asm volatile("" : "+v"(lo));
            unsigned char* op = cjob ? (unsigned char*)(MI + ((size_t)br * TC + (u.pm - TL / 256) * 256) * D) : (unsigned char*)(MG + (size_t)u.pm * 256 * D);
            const bool ldm = (br > 0 && !cjob), stm = (br < 3 && !cjob);
            if (ldm) { if (stm) branch<true, true>(acc, so, mo, lo, op); else branch<true, false>(acc, so, mo, lo, op); }
            else { if (stm) branch<false, true>(acc, so, mo, lo, op); else branch<false, false>(acc, so, mo, lo, op); }
        }
    }
    template <bool LDM, bool STM> __device__ __forceinline__ void branch(const Acc& acc, unsigned so, unsigned mo, unsigned lo, unsigned char* op) const {
        const unsigned char* sp = gs; unsigned char* mp = gs + 131072;
        u32x2 s[3][2]; u32x4 mw[3][2];
#define GB_U(ptr_) ({ auto q_ = (ptr_); asm volatile("" : "+s"(q_)); q_; })
#define GB_LOAD(t_) do { _Pragma("unroll") for (int k = 0; k < 2; ++k) { s[(t_) % 3][k] = *(const u32x2*)(GB_U(sp + ((t_) * 2 + k) * 4096) + (so >> 1)); \
            if (LDM) mw[(t_) % 3][k] = *(const u32x4*)(GB_U(mp + ((t_) * 2 + k) * 8192) + so); else mw[(t_) % 3][k] = (u32x4){0u, 0u, 0u, 0u}; } } while (0)
        GB_LOAD(0); GB_LOAD(1);
#pragma unroll
        for (int t = 0; t < 8; ++t) { const int ai = t >> 2, m = t & 3, p = t % 3;
            if (t < 6) GB_LOAD(t + 2);
#pragma unroll
            for (int k = 0; k < 2; ++k) { const int bj = k;
                const f32x4 y0 = acc[ai][bj][m][0], y1 = acc[ai][bj][m][1]; const u32x2 sk = s[p][k]; const u32x4 mk = mw[p][k]; f32x4 a0 = (f32x4){bflo(mk.x), bfhi(mk.x), bflo(mk.y), bfhi(mk.y)}, a1 = (f32x4){bflo(mk.z), bfhi(mk.z), bflo(mk.w), bfhi(mk.w)};
                a0[0] += (float)((sk.x >> 0) & 0xffu) * y0[0]; a0[1] += (float)((sk.x >> 8) & 0xffu) * y0[1]; a0[2] += (float)((sk.x >> 16) & 0xffu) * y0[2]; a0[3] += (float)((sk.x >> 24) & 0xffu) * y0[3];
                a1[0] += (float)((sk.y >> 0) & 0xffu) * y1[0]; a1[1] += (float)((sk.y >> 8) & 0xffu) * y1[1]; a1[2] += (float)((sk.y >> 16) & 0xffu) * y1[2]; a1[3] += (float)((sk.y >> 24) & 0xffu) * y1[3];
                if (!STM) { a0 = a0 * (1.0f / 255.0f); a1 = a1 * (1.0f / 255.0f); }
                u32x4 w; w.x = cvt_pk_bf16(a0[0], a0[1]); w.y = cvt_pk_bf16(a0[2], a0[3]); w.z = cvt_pk_bf16(a1[0], a1[1]); w.w = cvt_pk_bf16(a1[2], a1[3]);
                if (STM) *(u32x4*)(GB_U(mp + (t * 2 + k) * 8192) + so) = w;
                else *(u32x4*)(op + (size_t)(ai * 128 + m * 16) * D * 2 + lo + bj * 256) = w; }
            asm volatile("" ::: "memory");
        }
#undef GB_LOAD
#undef GB_U
    }
};

struct Frame {
    LAS unsigned char* lds;
    int tid, lane, wave, bid, G;
    unsigned char* ws;
};

__device__ __forceinline__ void transpose_item(const float* W, int K, int N, int src_col0, bf16* WT, int dst_row0, LAS float* scr, int kb, int lane) {
    const int k0 = 64 * kb;
    float tv[32];
#pragma unroll
    for (int i = 0; i < 32; ++i) { const int kk = 2 * i + (lane >> 5); tv[i] = W[(size_t)(k0 + kk) * N + src_col0 + (lane & 31)]; }
#pragma unroll
    for (int i = 0; i < 32; ++i) { const int kk = 2 * i + (lane >> 5); scr[kk * 33 + (lane & 31)] = tv[i]; }
    LDS_WAIT(); asm volatile("" ::: "memory");
    const int c = lane & 7;
#pragma unroll
    for (int j = 0; j < 4; ++j) { const int n = (lane >> 3) + 8 * j; const LAS float* s = scr + (8 * c) * 33 + n;
        u32x4 o; o.x = cvt_pk_bf16(s[0 * 33], s[1 * 33]); o.y = cvt_pk_bf16(s[2 * 33], s[3 * 33]); o.z = cvt_pk_bf16(s[4 * 33], s[5 * 33]); o.w = cvt_pk_bf16(s[6 * 33], s[7 * 33]);
        *(u32x4*)(WT + (size_t)(dst_row0 + n) * K + k0 + 8 * c) = o; }
    LDS_WAIT(); asm volatile("" ::: "memory");
}
__device__ __forceinline__ void transpose_item8(const float* W, int K, int N, int src_col0, unsigned char* WT, int dst_row0, LAS float* scr, int kb, int lane, float wscale) {
    const int k0 = 64 * kb;
    float tv[32];
#pragma unroll
    for (int i = 0; i < 32; ++i) { const int kk = 2 * i + (lane >> 5); tv[i] = W[(size_t)(k0 + kk) * N + src_col0 + (lane & 31)]; }
#pragma unroll
    for (int i = 0; i < 32; ++i) { const int kk = 2 * i + (lane >> 5); scr[kk * 33 + (lane & 31)] = tv[i]; }
    LDS_WAIT(); asm volatile("" ::: "memory");
    const int n = lane >> 1, hf = lane & 1; const LAS float* s = scr + (32 * hf) * 33 + n;
    u32x4 o0, o1;
    o0.x = pk_fp8x4(s[0 * 33] * wscale, s[1 * 33] * wscale, s[2 * 33] * wscale, s[3 * 33] * wscale); o0.y = pk_fp8x4(s[4 * 33] * wscale, s[5 * 33] * wscale, s[6 * 33] * wscale, s[7 * 33] * wscale);
    o0.z = pk_fp8x4(s[8 * 33] * wscale, s[9 * 33] * wscale, s[10 * 33] * wscale, s[11 * 33] * wscale); o0.w = pk_fp8x4(s[12 * 33] * wscale, s[13 * 33] * wscale, s[14 * 33] * wscale, s[15 * 33] * wscale);
    o1.x = pk_fp8x4(s[16 * 33] * wscale, s[17 * 33] * wscale, s[18 * 33] * wscale, s[19 * 33] * wscale); o1.y = pk_fp8x4(s[20 * 33] * wscale, s[21 * 33] * wscale, s[22 * 33] * wscale, s[23 * 33] * wscale);
    o1.z = pk_fp8x4(s[24 * 33] * wscale, s[25 * 33] * wscale, s[26 * 33] * wscale, s[27 * 33] * wscale); o1.w = pk_fp8x4(s[28 * 33] * wscale, s[29 * 33] * wscale, s[30 * 33] * wscale, s[31 * 33] * wscale);
    u32x4* dst = (u32x4*)(WT + (size_t)(dst_row0 + n) * K + k0 + 32 * hf); dst[0] = o0; dst[1] = o1;
    LDS_WAIT(); asm volatile("" ::: "memory");
}
__host__ __device__ __forceinline__ int inmap(int r) {
    if (r >= NINP) return r;
    const int t = r >> 8, cc = r & 255;
    if (t < 2) return cc < 128 ? 128 * t + cc : 256 + 128 * t + cc - 128;
    if (t < 6) return 256 * t + cc;
    if (t < 8) { const int p = t - 6; return cc < 128 ? 1536 + 128 * p + cc : 1792 + 128 * p + cc - 128; }
    return 2048 + 256 * (t - 8) + cc;
}
__device__ __forceinline__ void prologue_a(Frame& F, const Params& P) {
    LAS float* scr = (LAS float*)(F.lds + F.wave * 16384);
    const int gw = F.bid * NWAVES + F.wave, NGW = F.G * NWAVES;
    constexpr int I1 = 16 * 176, I2 = 44 * 32, I3 = 16 * 216, I4 = 4 * 32, I5 = 16 * 32;
    constexpr int I6 = 32;
    constexpr int NIT = 4 * I1 + 4 * I2 + 2 * I3 + 8 * I4 + 2 * I5 + 2 * I6;
    struct TI { const float* W; unsigned char* dst; int N, K, sc, drow, kb; bool f8; float scale; };
    auto decode = [&](int it, TI& t) {
        int r = it;
        if (r < 4 * I1) { const int mi = r / I1; r %= I1; const int kb = r / 176, nb = r % 176, d0 = nb * 32, pn = d0 >> 8, cc = d0 & 255;
            t = TI{P.in[I_FWI] + (size_t)mi * D * NFF, F.ws + WS_W1T + (size_t)mi * NFF * D, NFF, D, cc < 128 ? 128 * pn + cc : DFF + 128 * pn + cc - 128, d0, kb, true, W1_SCALE}; return; }
        r -= 4 * I1;
        if (r < 4 * I2) { const int mi = r / I2; r %= I2; const int kb = r / 32, nb = r % 32;
            t = TI{P.in[I_FWO] + (size_t)mi * DFF * D, F.ws + WS_W2T + (size_t)mi * D * DFF, D, DFF, nb * 32, nb * 32, kb, true, W2_SCALE}; return; }
        r -= 4 * I2;
        if (r < 2 * I3) { const int mi = r / I3; r %= I3; const int kb = r / 216, nb = r % 216; const float* W = P.in[I_WIN] + (size_t)mi * D * PIN;
            if (nb * 32 >= NINP) t = TI{W, F.ws + WS_WIT + ((size_t)mi * PIN + NINP) * D * 2, PIN, D, inmap(nb * 32), nb * 32 - NINP, kb, true, W1_SCALE};
            else if (nb * 32 < 2048) t = TI{W, F.ws + WS_WIT + ((size_t)mi * PIN + NINP) * D * 2 + 6 * MiB, PIN, D, inmap(nb * 32), nb * 32, kb, true, W1_SCALE};
            else t = TI{W, F.ws + WS_WIT + (size_t)mi * PIN * D * 2, PIN, D, inmap(nb * 32), nb * 32, kb, false, 1.f};
            return; }
        r -= 2 * I3;
        if (r < 8 * I4) { const int mi = r / I4; r %= I4; const int l = mi >> 2, br = mi & 3, kb = r / 32, nb = r % 32;
            t = TI{P.in[br == 0 ? I_CWP : (br == 1 ? I_NWP : (br == 2 ? I_SWP : I_HWP))] + (size_t)l * 256 * D, F.ws + WS_WPT + (size_t)mi * D * 256 * 2, D, 256, nb * 32, nb * 32, kb, false, 1.f}; return; }
        r -= 8 * I4;
        if (r < 2 * I5) { const int mi = r / I5; r %= I5; const int kb = r / 32, nb = r % 32;
            t = TI{P.in[I_WOUT] + (size_t)mi * D * D, F.ws + WS_WOT + (size_t)mi * D * D * 2, D, D, nb * 32, nb * 32, kb, false, 1.f}; return; }
        r -= 2 * I5;
        { const int mi = r / I6, nb = r % I6; t = TI{P.in[I_HW3] + (size_t)mi * 64 * 1024, F.ws + WS_W3T + (size_t)mi * 1024 * 64 * 2, 1024, 64, nb * 32, nb * 32, 0, false, 1.f}; }
    };
    {
        const int lane = F.lane;
        TI cur; float tv[32];
        int it = gw;
        if (it < NIT) { decode(it, cur);
#pragma unroll
            for (int i = 0; i < 32; ++i) tv[i] = cur.W[(size_t)(64 * cur.kb + 2 * i + (lane >> 5)) * cur.N + cur.sc + (lane & 31)]; }
        for (; it < NIT; it += NGW) {
#pragma unroll
            for (int i = 0; i < 32; ++i) scr[(2 * i + (lane >> 5)) * 33 + (lane & 31)] = tv[i];
            TI nx; const bool more = it + NGW < NIT;
            if (more) { decode(it + NGW, nx);
#pragma unroll
                for (int i = 0; i < 32; ++i) tv[i] = nx.W[(size_t)(64 * nx.kb + 2 * i + (lane >> 5)) * nx.N + nx.sc + (lane & 31)]; }
            LDS_WAIT(); asm volatile("" ::: "memory");
            const int k0 = 64 * cur.kb;
            if (cur.f8) { const int n = lane >> 1, hf = lane & 1; const LAS float* s = scr + (32 * hf) * 33 + n; const float ws_ = cur.scale;
                u32x4 o0, o1;
                o0.x = pk_fp8x4(s[0 * 33] * ws_, s[1 * 33] * ws_, s[2 * 33] * ws_, s[3 * 33] * ws_); o0.y = pk_fp8x4(s[4 * 33] * ws_, s[5 * 33] * ws_, s[6 * 33] * ws_, s[7 * 33] * ws_);
                o0.z = pk_fp8x4(s[8 * 33] * ws_, s[9 * 33] * ws_, s[10 * 33] * ws_, s[11 * 33] * ws_); o0.w = pk_fp8x4(s[12 * 33] * ws_, s[13 * 33] * ws_, s[14 * 33] * ws_, s[15 * 33] * ws_);
                o1.x = pk_fp8x4(s[16 * 33] * ws_, s[17 * 33] * ws_, s[18 * 33] * ws_, s[19 * 33] * ws_); o1.y = pk_fp8x4(s[20 * 33] * ws_, s[21 * 33] * ws_, s[22 * 33] * ws_, s[23 * 33] * ws_);
                o1.z = pk_fp8x4(s[24 * 33] * ws_, s[25 * 33] * ws_, s[26 * 33] * ws_, s[27 * 33] * ws_); o1.w = pk_fp8x4(s[28 * 33] * ws_, s[29 * 33] * ws_, s[30 * 33] * ws_, s[31 * 33] * ws_);
                u32x4* dst = (u32x4*)(cur.dst + (size_t)(cur.drow + n) * cur.K + k0 + 32 * hf); dst[0] = o0; dst[1] = o1; }
            else { const int c = lane & 7;
#pragma unroll
                for (int j = 0; j < 4; ++j) { const int n = (lane >> 3) + 8 * j; const LAS float* s = scr + (8 * c) * 33 + n;
                    u32x4 o; o.x = cvt_pk_bf16(s[0 * 33], s[1 * 33]); o.y = cvt_pk_bf16(s[2 * 33], s[3 * 33]); o.z = cvt_pk_bf16(s[4 * 33], s[5 * 33]); o.w = cvt_pk_bf16(s[6 * 33], s[7 * 33]);
                    *(u32x4*)(cur.dst + ((size_t)(cur.drow + n) * cur.K + k0 + 8 * c) * 2) = o; } }
            LDS_WAIT(); asm volatile("" ::: "memory");
            cur = nx;
        }
    }
    { float* bin = (float*)(F.ws + WS_BIN); for (int i = F.bid * NTHR + F.tid; i < 2 * PIN; i += F.G * NTHR) { const int l = i / PIN, r = i % PIN; bin[i] = P.in[I_BIN][l * PIN + inmap(r)]; } }
    __syncthreads();
    LAS float* sv = (LAS float*)F.lds;
    LAS float* red = (LAS float*)(F.lds + 16384);
    for (int i = F.tid; i < 3 * D; i += NTHR) { const int g = i / D, k = i % D; const float c = g < 2 ? P.in[I_C][g * D + k] : P.in[I_CCTX][k]; sv[i] = siluf_(c); }
    __syncthreads();
    for (int un = F.bid; un < 2 * 144; un += F.G) {
        const int l = un / 144, n0 = (un % 144) * 64;
        const float* wm = P.in[I_WMOD] + (size_t)l * D * 9216 + n0 + F.lane;
        float a0 = 0.f, a1 = 0.f, a2 = 0.f;
#pragma unroll 1
        for (int k0 = 0; k0 < 128; k0 += 32) { float wv[32];
#pragma unroll
            for (int kk = 0; kk < 32; ++kk) wv[kk] = wm[(size_t)(F.wave * 128 + k0 + kk) * 9216];
#pragma unroll
            for (int kk = 0; kk < 32; ++kk) { const int k = F.wave * 128 + k0 + kk; a0 += sv[k] * wv[kk]; a1 += sv[D + k] * wv[kk]; a2 += sv[2 * D + k] * wv[kk]; } }
        red[(F.wave * 3 + 0) * 64 + F.lane] = a0; red[(F.wave * 3 + 1) * 64 + F.lane] = a1; red[(F.wave * 3 + 2) * 64 + F.lane] = a2;
        __syncthreads();
        if (F.tid < 192) { const int g = F.tid >> 6, ln = F.tid & 63; float s = P.in[I_BMOD][l * 9216 + n0 + ln];
#pragma unroll
            for (int w = 0; w < 8; ++w) s += red[(w * 3 + g) * 64 + ln];
            ((float*)(F.ws + WS_MOD))[(size_t)(l * 3 + g) * 9216 + n0 + ln] = s; }
        __syncthreads();
    }
}

__device__ __forceinline__ void ln_stats(const f32x4 (&v)[4], float& mean, float& rstd) {
    float s = 0.f;
#pragma unroll
    for (int j = 0; j < 4; ++j) s += (v[j][0] + v[j][1]) + (v[j][2] + v[j][3]);
    mean = wave_sum(s) * (1.0f / D);
    float q = 0.f;
#pragma unroll
    for (int j = 0; j < 4; ++j) { const f32x4 d = v[j] - mean; q += (d[0] * d[0] + d[1] * d[1]) + (d[2] * d[2] + d[3] * d[3]); }
    rstd = __builtin_amdgcn_rsqf(wave_sum(q) * (1.0f / D) + LN_EPS);
}
__device__ __forceinline__ void modulate_store(const f32x4 (&x)[4], const float* shift, const float* scale, bf16* hrow, int lane) {
    float mean, rstd; ln_stats(x, mean, rstd);
#pragma unroll
    for (int j = 0; j < 4; ++j) { const int c = 4 * lane + 256 * j; const f32x4 sc = *(const f32x4*)(scale + c), sh = *(const f32x4*)(shift + c);
        const f32x4 h = (x[j] - mean) * rstd * (sc + 1.0f) + sh;
        u32x2 w; w.x = cvt_pk_bf16(h[0], h[1]); w.y = cvt_pk_bf16(h[2], h[3]); *(u32x2*)(hrow + c) = w; }
}
__device__ __forceinline__ void modulate_store8(const f32x4 (&x)[4], const float* shift, const float* scale, unsigned char* hrow, int lane) {
    float mean, rstd; ln_stats(x, mean, rstd);
#pragma unroll
    for (int j = 0; j < 4; ++j) { const int c = 4 * lane + 256 * j; const f32x4 sc = *(const f32x4*)(scale + c), sh = *(const f32x4*)(shift + c);
        const f32x4 h = (x[j] - mean) * rstd * (sc + 1.0f) + sh;
        *(unsigned*)(hrow + c) = pk_fp8x4(h[0], h[1], h[2], h[3]); }
}
constexpr int LNR = 4;
__device__ __forceinline__ void ln_stats_r(const f32x4 (&v)[LNR][4], float (&mean)[LNR], float (&rstd)[LNR]) {
    float s[LNR];
#pragma unroll
    for (int r = 0; r < LNR; ++r) { s[r] = 0.f;
#pragma unroll
        for (int j = 0; j < 4; ++j) s[r] += (v[r][j][0] + v[r][j][1]) + (v[r][j][2] + v[r][j][3]); }
#pragma unroll
    for (int r = 0; r < LNR; ++r) s[r] = wave_sum(s[r]);
    float q[LNR];
#pragma unroll
    for (int r = 0; r < LNR; ++r) { mean[r] = s[r] * (1.0f / D); q[r] = 0.f;
#pragma unroll
        for (int j = 0; j < 4; ++j) { const f32x4 d = v[r][j] - mean[r]; q[r] += (d[0] * d[0] + d[1] * d[1]) + (d[2] * d[2] + d[3] * d[3]); } }
#pragma unroll
    for (int r = 0; r < LNR; ++r) q[r] = wave_sum(q[r]);
#pragma unroll
    for (int r = 0; r < LNR; ++r) rstd[r] = __builtin_amdgcn_rsqf(q[r] * (1.0f / D) + LN_EPS);
}
__device__ __forceinline__ void phase_mod0(Frame& F, const Params& P) {
    const int skip = (F.G > 8) ? 4 : 0;
    if (F.bid < skip) return;
    const int gw = (F.bid - skip) * NWAVES + F.wave, NGW = (F.G - skip) * NWAVES;
    const float* MOD = (const float*)(F.ws + WS_MOD); bf16* H = (bf16*)(F.ws + WS_H);
    for (int row0 = gw; row0 < MT; row0 += LNR * NGW) {
        f32x4 x[LNR][4]; int rows[LNR];
#pragma unroll
        for (int r = 0; r < LNR; ++r) { rows[r] = min(row0 + r * NGW, MT - 1); const int row = rows[r];
            const float* xr = row < TL ? P.in[I_X] + (size_t)row * D : P.in[I_CTX] + (size_t)(row - TL) * D;
#pragma unroll
            for (int j = 0; j < 4; ++j) x[r][j] = *(const f32x4*)(xr + 4 * F.lane + 256 * j); }
        float mean[LNR], rstd[LNR]; ln_stats_r(x, mean, rstd);
#pragma unroll
        for (int r = 0; r < LNR; ++r) if (row0 + r * NGW < MT) { const int row = rows[r], g = row < SEQ ? 0 : (row < TL ? 1 : 2);
            const float* shift = MOD + (size_t)g * 9216, *scale = shift + D;
#pragma unroll
            for (int j = 0; j < 4; ++j) { const int c = 4 * F.lane + 256 * j; const f32x4 sc = *(const f32x4*)(scale + c), sh = *(const f32x4*)(shift + c);
                const f32x4 h = (x[r][j] - mean[r]) * rstd[r] * (sc + 1.0f) + sh;
                *(unsigned*)((unsigned char*)H + (size_t)row * D + c) = pk_fp8x4(h[0], h[1], h[2], h[3]); } }
    }
}
__device__ __forceinline__ void phase_ln(Frame& F, const Params& P, const float* lg, const float* lb, const float* modl  , int ishift, bool hmod, bool h8  , bool dual  , bool final_out, int cx_nks, float cx_coef, const float* cx_modv  , const float* cx_bias, const float* cx_xsrc, bool skipx  , const bf16* vsrc  ) {
    const int gw = F.bid * NWAVES + F.wave, NGW = F.G * NWAVES;
    const bf16* V = vsrc; bf16* H = (bf16*)(F.ws + WS_H);
    f32x4 g4[4], b4[4];
#pragma unroll
    for (int j = 0; j < 4; ++j) { g4[j] = *(const f32x4*)(lg + 4 * F.lane + 256 * j); b4[j] = *(const f32x4*)(lb + 4 * F.lane + 256 * j); }
    if (cx_nks > 0) {
        const float* part = (const float*)(F.ws + WS_ES);
        for (int r = gw; r < TC; r += NGW) {
            f32x4 v[4];
#pragma unroll
            for (int j = 0; j < 4; ++j) { const int c = 4 * F.lane + 256 * j; f32x4 s = cx_bias ? *(const f32x4*)(cx_bias + c) : (f32x4){0.f, 0.f, 0.f, 0.f};
                for (int ks = 0; ks < cx_nks; ++ks) s += *(const f32x4*)(part + ((size_t)ks * TC + r) * D + c);
                v[j] = *(const f32x4*)(cx_xsrc + (size_t)r * D + c) * ALPHA + *(const f32x4*)(cx_modv + c) * cx_coef * s; }
            float mean, rstd; ln_stats(v, mean, rstd);
            float* xr = (float*)(F.ws + WS_XC) + (size_t)r * D;
#pragma unroll
            for (int j = 0; j < 4; ++j) { v[j] = (v[j] - mean) * rstd * g4[j] + b4[j]; *(f32x4*)(xr + 4 * F.lane + 256 * j) = v[j]; }
            if (hmod && dual) modulate_store8(v, modl + (size_t)2 * 9216 + ishift * D, modl + (size_t)2 * 9216 + (ishift + 1) * D, F.ws + WS_H8C + (size_t)r * D, F.lane);
            if (hmod) { if (h8) modulate_store8(v, modl + (size_t)2 * 9216 + ishift * D, modl + (size_t)2 * 9216 + (ishift + 1) * D, (unsigned char*)H + (size_t)(TL + r) * D, F.lane);
                        else modulate_store(v, modl + (size_t)2 * 9216 + ishift * D, modl + (size_t)2 * 9216 + (ishift + 1) * D, H + (size_t)(TL + r) * D, F.lane); }
        }
    }
    const int M = TL;
    u32x2 raw[LNR][4];
#pragma unroll
    for (int r = 0; r < LNR; ++r) { const int rw = min(gw + r * NGW, M - 1);
#pragma unroll
        for (int j = 0; j < 4; ++j) raw[r][j] = *(const u32x2*)(V + (size_t)rw * D + 4 * F.lane + 256 * j); }
    for (int row0 = gw; row0 < M; row0 += LNR * NGW) {
        f32x4 v[LNR][4]; int rows[LNR];
#pragma unroll
        for (int r = 0; r < LNR; ++r) { rows[r] = min(row0 + r * NGW, M - 1);
#pragma unroll
            for (int j = 0; j < 4; ++j) { const u32x2 w = raw[r][j]; v[r][j] = (f32x4){bflo(w.x), bfhi(w.x), bflo(w.y), bfhi(w.y)}; } }
        if (row0 + LNR * NGW < M) {
#pragma unroll
            for (int r = 0; r < LNR; ++r) { const int rw = min(row0 + (LNR + r) * NGW, M - 1);
#pragma unroll
                for (int j = 0; j < 4; ++j) raw[r][j] = *(const u32x2*)(V + (size_t)rw * D + 4 * F.lane + 256 * j); }
        }
        float mean[LNR], rstd[LNR]; ln_stats_r(v, mean, rstd);
#pragma unroll
        for (int r = 0; r < LNR; ++r) { const int row = rows[r]; const bool ok = row0 + r * NGW < M;
            float* xr = P.out + (size_t)row * D; bf16* xh = (bf16*)P.out + (size_t)row * D;
            if (skipx && ok && F.lane == 0) *(f32x2*)((float*)(F.ws + WS_LNS) + (size_t)row * 2) = (f32x2){mean[r], rstd[r]};
#pragma unroll
            for (int j = 0; j < 4; ++j) { v[r][j] = (v[r][j] - mean[r]) * rstd[r] * g4[j] + b4[j];
                if (ok) { if (final_out) __builtin_nontemporal_store(v[r][j], (f32x4*)(xr + 4 * F.lane + 256 * j));
                          else if (!skipx) { u32x2 w; w.x = cvt_pk_bf16(v[r][j][0], v[r][j][1]); w.y = cvt_pk_bf16(v[r][j][2], v[r][j][3]); __builtin_nontemporal_store(w, (u32x2*)(xh + 4 * F.lane + 256 * j)); } } } }
        if (hmod) {
            ln_stats_r(v, mean, rstd);
#pragma unroll
            for (int r = 0; r < LNR; ++r) if (row0 + r * NGW < M) { const int row = rows[r], g = row < SEQ ? 0 : 1;
                const float* shift = modl + (size_t)g * 9216 + ishift * D, *scale = shift + D; bf16* hrow = H + (size_t)row * D;
#pragma unroll
                for (int j = 0; j < 4; ++j) { const int c = 4 * F.lane + 256 * j; const f32x4 sc = *(const f32x4*)(scale + c), sh = *(const f32x4*)(shift + c);
                    const f32x4 h = (v[r][j] - mean[r]) * rstd[r] * (sc + 1.0f) + sh;
                    if (h8) __builtin_nontemporal_store(pk_fp8x4(h[0], h[1], h[2], h[3]), (unsigned*)((unsigned char*)H + (size_t)row * D + c));
                    else { u32x2 w; w.x = cvt_pk_bf16(h[0], h[1]); w.y = cvt_pk_bf16(h[2], h[3]); __builtin_nontemporal_store(w, (u32x2*)(hrow + c)); }
                    if (dual) __builtin_nontemporal_store(pk_fp8x4(h[0], h[1], h[2], h[3]), (unsigned*)(F.ws + WS_H8L + (size_t)row * D + c)); } }
        }
    }
}

__device__ __forceinline__ void filter_unit(Frame& F, const Params& P, int l, int L, int t0, float* filt  , bool bfout) {
    LAS float* h1 = (LAS float*)F.lds;
    LAS bf16* h2b = (LAS bf16*)(F.lds + 32768);
    LAS float* zf = (LAS float*)(F.lds + 65536);
    LAS float* w2s = (LAS float*)(F.lds + 81920);
    LAS float* w1s = (LAS float*)(F.lds + 98304);
    const float* w1 = P.in[I_HW1] + l * 33 * 64; const float* b1 = P.in[I_HB1] + l * 64; const float* w2 = P.in[I_HW2] + l * 64 * 64; const float* b2 = P.in[I_HB2] + l * 64;
    const float* fq = P.in[I_HFQ] + l * 128; const float* w3 = P.in[I_HW3] + (size_t)l * 64 * 1024;
    {
#pragma unroll
        for (int i = 0; i < 8; ++i) w2s[F.tid + 512 * i] = w2[F.tid + 512 * i];
#pragma unroll
        for (int i = 0; i < 5; ++i) if (F.tid + 512 * i < 33 * 64) w1s[F.tid + 512 * i] = w1[F.tid + 512 * i];
        const int tl = F.tid >> 3, jg = F.tid & 7; const float t = (float)(t0 + tl);
        if (jg == 0) zf[tl * 36] = t / (float)(L - 1);
#pragma unroll
        for (int ii = 0; ii < 2; ++ii) { const int i = jg + 8 * ii; const float band = 1e-4f + (float)i * ((15.0f - 1e-4f) / 15.0f); float s, c; sincospif(2.0f * t * band / (float)L, &s, &c); zf[tl * 36 + 1 + i] = c; zf[tl * 36 + 17 + i] = -s; }
        __syncthreads();
        float a[8];
#pragma unroll
        for (int jj = 0; jj < 8; ++jj) a[jj] = b1[jg * 8 + jj];
#pragma unroll 3
        for (int i = 0; i < 33; ++i) { const float zv = zf[tl * 36 + i]; const LAS f32x4* wp = (const LAS f32x4*)(w1s + i * 64 + jg * 8); const f32x4 wa = wp[0], wb = wp[1];
            a[0] += zv * wa[0]; a[1] += zv * wa[1]; a[2] += zv * wa[2]; a[3] += zv * wa[3]; a[4] += zv * wb[0]; a[5] += zv * wb[1]; a[6] += zv * wb[2]; a[7] += zv * wb[3]; }
#pragma unroll
        for (int jj = 0; jj < 8; ++jj) h1[tl * 65 + jg * 8 + jj] = sinf(fq[jg * 8 + jj] * a[jj]);
        __syncthreads();
#pragma unroll
        for (int jj = 0; jj < 8; ++jj) a[jj] = b2[jg * 8 + jj];
#pragma unroll 4
        for (int i = 0; i < 64; ++i) { const float hv = h1[tl * 65 + i]; const LAS f32x4* wp = (const LAS f32x4*)(w2s + i * 64 + jg * 8); const f32x4 wa = wp[0], wb = wp[1];
            a[0] += hv * wa[0]; a[1] += hv * wa[1]; a[2] += hv * wa[2]; a[3] += hv * wa[3]; a[4] += hv * wb[0]; a[5] += hv * wb[1]; a[6] += hv * wb[2]; a[7] += hv * wb[3]; }
#pragma unroll
        for (int jj = 0; jj < 8; ++jj) h2b[tl * 72 + jg * 8 + jj] = (bf16)(cvt_pk_bf16(sinf(fq[64 + jg * 8 + jj] * a[jj]), 0.f) & 0xffffu);
        __syncthreads();
    }
    {
        const bf16* W3T = (const bf16*)(F.ws + WS_W3T) + (size_t)l * 1024 * 64;
        const int lane = F.lane, lr = lane & 15, lg = lane >> 4;
        const float dl0 = -4.605170186f / 1.5f, dl1 = -4.605170186f / 0.3f;
        bf16x8 af[4][2];
#pragma unroll
        for (int rt = 0; rt < 4; ++rt)
#pragma unroll
            for (int ks = 0; ks < 2; ++ks) af[rt][ks] = *(const LAS bf16x8*)(h2b + (rt * 16 + lr) * 72 + ks * 32 + 8 * lg);
#pragma unroll 2
        for (int ct = 0; ct < 8; ++ct) {
            const int col = F.wave * 128 + ct * 16 + lr, c = col & 255;
            const bf16x8 b0 = *(const bf16x8*)(W3T + (size_t)col * 64 + 8 * lg), b1 = *(const bf16x8*)(W3T + (size_t)col * 64 + 32 + 8 * lg);
            const float ad = fabsf(dl0 + (dl1 - dl0) * (float)c / 255.0f);
#pragma unroll
            for (int rt = 0; rt < 4; ++rt) {
                f32x4 a = (f32x4){0.f, 0.f, 0.f, 0.f};
                a = __builtin_amdgcn_mfma_f32_16x16x32_bf16(af[rt][0], b0, a, 0, 0, 0);
                a = __builtin_amdgcn_mfma_f32_16x16x32_bf16(af[rt][1], b1, a, 0, 0, 0);
                const int tb = t0 + rt * 16 + 4 * lg;
#pragma unroll
                for (int e = 0; e < 4; ++e) { const float tn = (float)(tb + e) / (float)(L - 1); a[e] *= __expf(-tn * ad); }
                if (bfout) { u32x2 w; w.x = cvt_pk_bf16(a[0], a[1]); w.y = cvt_pk_bf16(a[2], a[3]); *(u32x2*)((bf16*)filt + (size_t)col * L + tb) = w; }
                else *(f32x4*)(filt + (size_t)col * L + tb) = a;
            }
        }
    }
    __syncthreads();
}
__device__ __forceinline__ void phase_filters(Frame& F, const Params& P, int l, bool with_ctx) {
    float* filt = (float*)(F.ws + WS_FILT); float* filtc = (float*)(F.ws + WS_FILTC);
    const int nu = SEQ / 64 + (with_ctx ? CTXL / 64 : 0);
    for (int u = F.bid; u < nu; u += F.G) {
        if (u < SEQ / 64) filter_unit(F, P, l, SEQ, u * 64, filt, true);
        else filter_unit(F, P, l, CTXL, (u - SEQ / 64) * 64, filtc, false);
    }
}

__device__ __forceinline__ void seg_of(int row, int& s0, int& s1) {
    if (row < TL) { s0 = row & ~(SEQ - 1); s1 = s0 + SEQ; } else { s0 = TL + ((row - TL) & ~(CTXL - 1)); s1 = s0 + CTXL; }
}
__device__ __forceinline__ void conformer_tiles(Frame& F, const Params& P, int l, int u0, int ntile) {
    const bf16* UA = (const bf16*)(F.ws + WS_UA); bf16* BR0 = (bf16*)(F.ws + WS_BRV);
    LAS bf16* tin = (LAS bf16*)F.lds;
    LAS float* cout = (LAS float*)(F.lds + 49152);
    const int c = F.tid & 255, half = F.tid >> 8;
    float w[31];
#pragma unroll
    for (int j = 0; j < 31; ++j) w[j] = P.in[I_CDW][(l * 31 + j) * 256 + c];
    const float b = P.in[I_CDB][l * 256 + c];
    const f32x4 g = *(const f32x4*)(P.in[I_CLG] + l * 256 + 4 * F.lane), bb = *(const f32x4*)(P.in[I_CLB] + l * 256 + 4 * F.lane);
    u32x4 v[6];
#define CONF_LOAD(u_) do { const int t0_ = (u_) * 64; int s0_, s1_; seg_of(t0_, s0_, s1_); _Pragma("unroll") for (int k = 0; k < 6; ++k) { const int idx = F.tid + NTHR * k, rr = idx >> 5, c8 = idx & 31, gr = t0_ - 15 + rr; \
        const bool ok_ = idx < 94 * 32 && gr >= s0_ && gr < s1_; const u32x4 t_ = *(const u32x4*)(UA + (size_t)min(max(gr, s0_), s1_ - 1) * 256 + c8 * 8); v[k] = ok_ ? t_ : (u32x4){0u, 0u, 0u, 0u}; } } while (0)
    if (u0 < ntile) CONF_LOAD(u0);
    for (int u = u0; u < ntile; u += F.G) {
        const int t0 = u * 64;
#pragma unroll
        for (int k = 0; k < 6; ++k) { const int idx = F.tid + NTHR * k, rr = idx >> 5, c8 = idx & 31; if (idx < 94 * 32) *(LAS u32x4*)(tin + rr * 256 + c8 * 8) = v[k]; }
        __syncthreads();
        if (u + F.G < ntile) CONF_LOAD(u + F.G);
        {
            float in[62];
#pragma unroll
            for (int i = 0; i < 62; ++i) in[i] = bf2f(tin[(half * 32 + i) * 256 + c]);
#pragma unroll
            for (int t = 0; t < 32; ++t) { float a = b;
#pragma unroll
                for (int j = 0; j < 31; ++j) a += w[j] * in[t + j];
                cout[(half * 32 + t) * 260 + c] = a; }
        }
        __syncthreads();
        {
            f32x4 v[8]; float s[8], q[8];
#pragma unroll
            for (int tt = 0; tt < 8; ++tt) { v[tt] = *(const LAS f32x4*)(cout + (F.wave * 8 + tt) * 260 + 4 * F.lane); s[tt] = (v[tt][0] + v[tt][1]) + (v[tt][2] + v[tt][3]); }
#pragma unroll
            for (int tt = 0; tt < 8; ++tt) s[tt] = wave_sum(s[tt]);
#pragma unroll
            for (int tt = 0; tt < 8; ++tt) { v[tt] = v[tt] - s[tt] * (1.0f / 256.0f); q[tt] = (v[tt][0] * v[tt][0] + v[tt][1] * v[tt][1]) + (v[tt][2] * v[tt][2] + v[tt][3] * v[tt][3]); }
#pragma unroll
            for (int tt = 0; tt < 8; ++tt) q[tt] = wave_sum(q[tt]);
#pragma unroll
            for (int tt = 0; tt < 8; ++tt) { const float rstd = __builtin_amdgcn_rsqf(q[tt] * (1.0f / 256.0f) + LN_EPS);
                f32x4 y = v[tt] * rstd * g + bb;
#pragma unroll
                for (int j = 0; j < 4; ++j) y[j] = siluf_(y[j]);
                u32x2 wv; wv.x = cvt_pk_bf16(y[0], y[1]); wv.y = cvt_pk_bf16(y[2], y[3]);
                __builtin_nontemporal_store(wv, (u32x2*)(BR0 + (size_t)(t0 + F.wave * 8 + tt) * 256 + 4 * F.lane)); }
        }
        __syncthreads();
    }
}
#undef CONF_LOAD
__device__ __forceinline__ void shortconv_unit(Frame& F, const Params& P, int l, int t0) {
    const bf16* SB = (const bf16*)(F.ws + WS_SB); const bf16* W = (const bf16*)(F.ws + WS_W); bf16* BR2 = (bf16*)(F.ws + WS_BRV) + 2 * (size_t)MT * 256;
    int s0, s1; seg_of(t0, s0, s1);
    const float* cw = P.in[I_SCW] + l * 3 * 256;
#pragma unroll
    for (int k = 0; k < 4; ++k) { const int idx = F.tid + NTHR * k, tok = idx >> 5, c8 = (idx & 31) * 8, gr = t0 + tok;
        const u32x4 z = (u32x4){0u, 0u, 0u, 0u};
        const u32x4 wm_ = *(const u32x4*)(W + (size_t)max(gr - 1, s0) * 256 + c8), w0 = *(const u32x4*)(W + (size_t)gr * 256 + c8),
                    wp_ = *(const u32x4*)(W + (size_t)min(gr + 1, s1 - 1) * 256 + c8), sb = *(const u32x4*)(SB + (size_t)gr * 256 + c8);
        const u32x4 wm = (gr - 1 >= s0) ? wm_ : z, wp = (gr + 1 < s1) ? wp_ : z;
        float o[8];
#pragma unroll
        for (int j = 0; j < 4; ++j) { const int c = c8 + 2 * j;
            o[2 * j] = bflo(sb[j]) * (cw[c] * bflo(wm[j]) + cw[256 + c] * bflo(w0[j]) + cw[512 + c] * bflo(wp[j]));
            o[2 * j + 1] = bfhi(sb[j]) * (cw[c + 1] * bfhi(wm[j]) + cw[256 + c + 1] * bfhi(w0[j]) + cw[512 + c + 1] * bfhi(wp[j])); }
        u32x4 w; w.x = cvt_pk_bf16(o[0], o[1]); w.y = cvt_pk_bf16(o[2], o[3]); w.z = cvt_pk_bf16(o[4], o[5]); w.w = cvt_pk_bf16(o[6], o[7]);
        __builtin_nontemporal_store(w, (u32x4*)(BR2 + (size_t)gr * 256 + c8)); }
}
__device__ __forceinline__ void attn_stage_ctx(Frame& F, int b, int h) {
    const unsigned char* K = F.ws + WS_K; const unsigned char* VT = F.ws + WS_VT;
#pragma unroll
    for (int i = 0; i < 4; ++i) { const int pi = F.tid + NTHR * i;
        { const int key = pi >> 3, pc = pi & 7; const u32x4 v = *(const u32x4*)(K + (size_t)(TL + b * CTXL + key) * 512 + h * 128 + pc * 16);
          *(LAS u32x4*)(F.lds + key * 128 + ((pc ^ ((key & 3) | ((key >> 1) & 4))) << 4)) = v; }
        { const int dim = pi >> 5, pc = pi & 31; const u32x4 v = *(const u32x4*)(VT + ((size_t)(h * 64 + dim) * MT + TL + b * CTXL) * 2 + pc * 16);
          *(LAS u32x4*)(F.lds + 32768 + dim * 512 + ((pc ^ (dim & 7)) << 4)) = v; } }
}
__device__ __forceinline__ void attn_wave_unit(Frame& F, int wu, bool lat, bool cl  ) {
    const bf16* Q = (const bf16*)(F.ws + WS_Q); const bf16* K = (const bf16*)(F.ws + WS_K); const bf16* VT = (const bf16*)(F.ws + WS_VT);
    bf16* BR1 = (bf16*)(F.ws + WS_BRV) + (size_t)MT * 256;
    const LAS float* rpb = (const LAS float*)(F.lds + RPB_OFF);
    const int lane = lane_now(), q = lane & 15, g = lane >> 4;
    int b, h, r = 0, qb, tq0, cb = 0, r0 = 0;
    if (lat) { qb = wu & 3; h = (wu >> 2) & 3; r = (wu >> 4) & 255; b = wu >> 12; tq0 = b * SEQ + r * 64 + 16 * qb; cb = (qb == 0) ? 0 : (qb == 1 ? 8 : (qb == 2 ? 24 : 32)); r0 = min(max(r - 4, 0), 248); }
    else { qb = wu & 15; h = (wu >> 4) & 3; b = wu >> 6; tq0 = TL + b * CTXL + 16 * qb; }
    bf16x8 qf[2];
#pragma unroll
    for (int kk = 0; kk < 2; ++kk) qf[kk] = *(const bf16x8*)(Q + (size_t)(tq0 + q) * 256 + h * 64 + 32 * kk + 8 * g);
    const int koff = (q >> 2) * 8 + (q & 3);
    const unsigned klo = (unsigned)((koff * 256 + h * 64 + 8 * g) * 2);
    const unsigned vlo = (unsigned)((((h * 64 + q) * MT) + 8 * g) * 2);
    const char* Kc = (const char*)K; const char* Vc = (const char*)VT;
    const int kl0 = koff * 128 + ((g ^ ((q & 3) | (((q >> 2) & 1) << 2))) << 4), vl0 = 32768 + q * 512 + ((g ^ (q & 7)) << 4);
    const int cq = 16 * qb + q, c0 = min(max(cq - 8, 0), 48);
    float mx = -1e30f, sum = 0.f;
    f32x4 o[4];
#pragma unroll
    for (int bl = 0; bl < 4; ++bl) o[bl] = (f32x4){0.f, 0.f, 0.f, 0.f};
    bf16x8 kf[2][2][2];
#define ATT_KBASE(i_) (((i_) < 8) ? (b * SEQ + (r0 + (i_)) * 64 + cb) : (TL + b * CTXL + 32 * ((i_) - 8)))
#define ATT_LOADK(c_) do { _Pragma("unroll") for (int s_ = 0; s_ < 2; ++s_) { const int kb_ = ATT_KBASE(2 * (c_) + s_); _Pragma("unroll") for (int tt = 0; tt < 2; ++tt) { \
        if (cl && (c_) >= 4) { const int lo_ = (2 * (c_) + s_ - 8) * 4096 + tt * 512; kf[s_][tt][0] = *(const LAS bf16x8*)(F.lds + lo_ + kl0); kf[s_][tt][1] = *(const LAS bf16x8*)(F.lds + lo_ + (kl0 ^ 64)); } \
        else { const char* kp_ = Kc + (size_t)(kb_ + 4 * tt) * 512; kf[s_][tt][0] = *(const bf16x8*)(kp_ + klo); kf[s_][tt][1] = *(const bf16x8*)(kp_ + klo + 64); } } } } while (0)
#define ATT_LOADV(dst_, c_) do { _Pragma("unroll") for (int s_ = 0; s_ < 2; ++s_) { const int kb_ = ATT_KBASE(2 * (c_) + s_); _Pragma("unroll") for (int bl = 0; bl < 4; ++bl) \
        { if (cl && (c_) >= 4) { const int m_ = 2 * (c_) + s_ - 8; dst_[s_][bl] = *(const LAS bf16x8*)(F.lds + bl * 8192 + (m_ >> 1) * 128 + ((m_ & 1) ? (vl0 ^ 64) : vl0)); } \
          else dst_[s_][bl] = *(const bf16x8*)(Vc + ((size_t)(16 * bl) * MT + kb_) * 2 + vlo); } } } while (0)
    bf16x8 vf[2][4], vn[2][4];
    u32x4 kg[2][2][4], vg[2][4];
    LAS unsigned char* wb = F.lds + 65536 + F.wave * 8192;
    const int kq = lane >> 3;
    const int wk0 = kq * 128 + (((lane & 7) ^ (kq & 3)) << 4), wv0 = 4096 + (lane >> 2) * 64 + (((lane & 3) ^ ((lane >> 3) & 3)) << 4), vl1 = 4096 + q * 64 + ((g ^ ((q >> 1) & 3)) << 4);
    const unsigned gk = (unsigned)(kq * 512 + h * 128 + (lane & 7) * 16), gv = (unsigned)(((h * 64 + (lane >> 2)) * MT) * 2 + (lane & 3) * 16);
#define ATT_GLOADK(c_) do { _Pragma("unroll") for (int s_ = 0; s_ < 2; ++s_) { const int kb_ = ATT_KBASE(2 * (c_) + s_); _Pragma("unroll") for (int n = 0; n < 4; ++n) \
        kg[(c_) & 1][s_][n] = *(const u32x4*)(Kc + (size_t)kb_ * 512 + (size_t)n * 4096 + gk); } } while (0)
#define ATT_GLOADV(c_) do { _Pragma("unroll") for (int s_ = 0; s_ < 2; ++s_) { const int kb_ = ATT_KBASE(2 * (c_) + s_); _Pragma("unroll") for (int n = 0; n < 4; ++n) \
        vg[s_][n] = *(const u32x4*)(Vc + (size_t)kb_ * 2 + (size_t)n * 16 * MT * 2 + gv); } } while (0)
#define ATT_XPOSEK(c_) do { _Pragma("unroll") for (int s_ = 0; s_ < 2; ++s_) { \
        _Pragma("unroll") for (int n = 0; n < 4; ++n) *(LAS u32x4*)(wb + n * 1024 + ((n & 1) ? (wk0 ^ 64) : wk0)) = kg[(c_) & 1][s_][n]; \
        _Pragma("unroll") for (int tt = 0; tt < 2; ++tt) { kf[s_][tt][0] = *(const LAS bf16x8*)(wb + tt * 512 + kl0); kf[s_][tt][1] = *(const LAS bf16x8*)(wb + tt * 512 + (kl0 ^ 64)); } } } while (0)
#define ATT_XPOSEV() do { _Pragma("unroll") for (int s_ = 0; s_ < 2; ++s_) { \
        _Pragma("unroll") for (int n = 0; n < 4; ++n) *(LAS u32x4*)(wb + n * 1024 + wv0) = vg[s_][n]; \
        _Pragma("unroll") for (int bl = 0; bl < 4; ++bl) vf[s_][bl] = *(const LAS bf16x8*)(wb + bl * 1024 + vl1); } } while (0)
    if (cl) { ATT_GLOADK(0); ATT_GLOADV(0); ATT_GLOADK(1); } else if (lat) { ATT_LOADK(0); ATT_LOADV(vf, 0); } else { ATT_LOADK(4); ATT_LOADV(vf, 4); }
#pragma unroll
    for (int c = 0; c < 8; ++c) {
        if (c < 4 && !lat) continue;
        if (cl) { if (c < 4) { ATT_XPOSEK(c); if (c < 2) ATT_GLOADK(c + 2); } else { ATT_LOADK(c); ATT_LOADV(vf, c); } }
        f32x4 s[2][2];
#pragma unroll
        for (int s_ = 0; s_ < 2; ++s_)
#pragma unroll
            for (int tt = 0; tt < 2; ++tt) {
                f32x4 a = (f32x4){0.f, 0.f, 0.f, 0.f};
                a = __builtin_amdgcn_mfma_f32_16x16x32_bf16(kf[s_][tt][0], qf[0], a, 0, 0, 0);
                a = __builtin_amdgcn_mfma_f32_16x16x32_bf16(kf[s_][tt][1], qf[1], a, 0, 0, 0);
                if (c < 4) {
                    const int i = 2 * c + s_;
                    const LAS float* rp = rpb + (h * 15 + (r0 + i - r + 7)) * 31;
#pragma unroll
                    for (int j = 0; j < 4; ++j) { const int kc = cb + 8 * g + 4 * tt + j; const bool ok = (kc >= c0) && (kc < c0 + 16);
                        const int dc = min(max(kc - cq + 15, 0), 30);
                        a[j] = ok ? a[j] + rp[dc] : -1e30f; }
                }
                s[s_][tt] = a;
            }
        if (!cl && c < 7) { ATT_LOADK(c + 1); ATT_LOADV(vn, c + 1); }
        if (cl && c < 4) { ATT_XPOSEV(); if (c < 3) ATT_GLOADV(c + 1); }
        float cm = -1e30f;
#pragma unroll
        for (int s_ = 0; s_ < 2; ++s_)
#pragma unroll
            for (int tt = 0; tt < 2; ++tt)
#pragma unroll
                for (int j = 0; j < 4; ++j) cm = fmaxf(cm, s[s_][tt][j]);
        cm = xrow_max(cm);
        const float mn = fmaxf(mx, cm), alpha = __builtin_amdgcn_exp2f(mx - mn);
        mx = mn; sum *= alpha;
#pragma unroll
        for (int bl = 0; bl < 4; ++bl) o[bl] *= alpha;
#pragma unroll
        for (int s_ = 0; s_ < 2; ++s_) {
            float p[8];
#pragma unroll
            for (int tt = 0; tt < 2; ++tt)
#pragma unroll
                for (int j = 0; j < 4; ++j) { const float e = __builtin_amdgcn_exp2f(s[s_][tt][j] - mn); p[4 * tt + j] = e; sum += e; }
            u32x4 pw; pw.x = cvt_pk_bf16(p[0], p[1]); pw.y = cvt_pk_bf16(p[2], p[3]); pw.z = cvt_pk_bf16(p[4], p[5]); pw.w = cvt_pk_bf16(p[6], p[7]);
            const bf16x8 pf = __builtin_bit_cast(bf16x8, pw);
#pragma unroll
            for (int bl = 0; bl < 4; ++bl) o[bl] = __builtin_amdgcn_mfma_f32_16x16x32_bf16(vf[s_][bl], pf, o[bl], 0, 0, 0);
        }
        if (!cl && c < 7) {
#pragma unroll
            for (int s_ = 0; s_ < 2; ++s_)
#pragma unroll
                for (int bl = 0; bl < 4; ++bl) vf[s_][bl] = vn[s_][bl];
        }
    }
#undef ATT_XPOSEK
#undef ATT_XPOSEV
#undef ATT_GLOADK
#undef ATT_GLOADV
#undef ATT_LOADV
#undef ATT_LOADK
#undef ATT_KBASE
    sum = xrow_sum(sum);
    const float inv = 1.0f / sum;
#pragma unroll
    for (int bl = 0; bl < 4; ++bl) { u32x2 w; w.x = cvt_pk_bf16(o[bl][0] * inv, o[bl][1] * inv); w.y = cvt_pk_bf16(o[bl][2] * inv, o[bl][3] * inv);
        __builtin_nontemporal_store(w, (u32x2*)(BR1 + (size_t)(tq0 + q) * 256 + h * 64 + 16 * bl + 4 * g)); }
}

constexpr int FL = 16384;
__device__ __forceinline__ f32x2 cmul(f32x2 a, f32x2 b) {
    f32x2 t, r;
    asm("v_pk_mul_f32 %1, %2, %3 op_sel:[1,1] op_sel_hi:[1,0]\n\tv_pk_fma_f32 %0, %2, %3, %1 op_sel:[0,0,0] op_sel_hi:[0,1,1] neg_lo:[0,0,1]" : "=v"(r), "=&v"(t) : "v"(a), "v"(b));
    return r;
}
__device__ __forceinline__ f32x2 cmulc(f32x2 a, f32x2 b) {
    f32x2 t, r;
    asm("v_pk_mul_f32 %1, %2, %3 op_sel:[1,1] op_sel_hi:[1,0]\n\tv_pk_fma_f32 %0, %2, %3, %1 op_sel:[0,0,0] op_sel_hi:[0,1,1] neg_hi:[1,0,0]" : "=v"(r), "=&v"(t) : "v"(a), "v"(b));
    return r;
}
__device__ __forceinline__ f32x2 rotm(f32x2 b, f32x2 d) { f32x2 r; asm("v_pk_add_f32 %0, %1, %2 op_sel:[0,1] op_sel_hi:[1,0] neg_hi:[0,1]" : "=v"(r) : "v"(b), "v"(d)); return r; }
__device__ __forceinline__ f32x2 rotp(f32x2 b, f32x2 d) { f32x2 r; asm("v_pk_add_f32 %0, %1, %2 op_sel:[0,1] op_sel_hi:[1,0] neg_lo:[0,1]" : "=v"(r) : "v"(b), "v"(d)); return r; }
__device__ __forceinline__ f32x2 tw_main(const LAS f32x2* T, int m) { return cmul(T[m >> 7], T[128 + (m & 127)]); }
__device__ __forceinline__ f32x2 tw_half(const LAS f32x2* T, int n) { return cmul(T[256 + (n >> 7)], T[384 + (n & 127)]); }
__device__ __forceinline__ void r4f(f32x2& x0, f32x2& x1, f32x2& x2, f32x2& x3, f32x2 w1, f32x2 w2, f32x2 w3) {
    const f32x2 a = x0 + x2, b = x0 - x2, c = x1 + x3, d = x1 - x3;
    x0 = a + c; x1 = cmul(rotm(b, d), w1); x2 = cmul(a - c, w2); x3 = cmul(rotp(b, d), w3);
}
__device__ __forceinline__ void r4f1(f32x2& x0, f32x2& x1, f32x2& x2, f32x2& x3) {
    const f32x2 a = x0 + x2, b = x0 - x2, c = x1 + x3, d = x1 - x3;
    x0 = a + c; x1 = rotm(b, d); x2 = a - c; x3 = rotp(b, d);
}
__device__ __forceinline__ void r4i(f32x2& x0, f32x2& x1, f32x2& x2, f32x2& x3, f32x2 w1, f32x2 w2, f32x2 w3) {
    const f32x2 t1 = cmulc(x1, w1), t2 = cmulc(x2, w2), t3 = cmulc(x3, w3);
    const f32x2 a = x0 + t2, b = x0 - t2, c = t1 + t3, d = t1 - t3;
    x0 = a + c; x1 = rotp(b, d); x2 = a - c; x3 = rotm(b, d);
}
__device__ __forceinline__ void r4i1(f32x2& x0, f32x2& x1, f32x2& x2, f32x2& x3) {
    const f32x2 a = x0 + x2, b = x0 - x2, c = x1 + x3, d = x1 - x3;
    x0 = a + c; x1 = rotp(b, d); x2 = a - c; x3 = rotm(b, d);
}
#define W16_1 ((f32x2){0.92387953251f, -0.38268343237f})
#define W16_2 ((f32x2){0.70710678119f, -0.70710678119f})
#define W16_3 ((f32x2){0.38268343237f, -0.92387953251f})
template <int SP, bool INV> __device__ __forceinline__ void fft_pass16(LAS f32x2* B, const LAS f32x2* T, int tid) {
    constexpr int STEP = (SP == 1024) ? 1040 : (SP == 64 ? 65 : 4);
#pragma unroll
    for (int jj = 0; jj < 2; ++jj) {
        const int q = tid + 512 * jj;
        int k, base;
        if (SP == 1024) { k = q; base = q + (q >> 6); }
        else if (SP == 64) { k = q & 63; const int i0 = (q >> 6) * 1024 + k; base = i0 + (i0 >> 6); }
        else { k = q >> 8; base = (q & 255) * 65 + k; }
        LAS f32x2* p = B + base;
        f32x2 x[16];
#pragma unroll
        for (int m = 0; m < 16; ++m) x[m] = p[m * STEP];
        const f32x2 b = tw_main(T, k * (1024 / SP));
        const f32x2 b2 = cmul(b, b), w = cmul(b2, b2), w2 = cmul(w, w), w3 = cmul(w, w2);
        f32x2 t1[4], t2[4], t3[4];
        t1[0] = b; t1[1] = cmul(b, W16_1); t1[2] = cmul(b, W16_2); t1[3] = cmul(b, W16_3);
#pragma unroll
        for (int m = 0; m < 4; ++m) { t2[m] = cmul(t1[m], t1[m]); t3[m] = cmul(t1[m], t2[m]); }
        if (!INV) {
#pragma unroll
            for (int m = 0; m < 4; ++m) r4f(x[m], x[m + 4], x[m + 8], x[m + 12], t1[m], t2[m], t3[m]);
#pragma unroll
            for (int j = 0; j < 4; ++j) r4f(x[4 * j], x[4 * j + 1], x[4 * j + 2], x[4 * j + 3], w, w2, w3);
        } else {
#pragma unroll
            for (int j = 0; j < 4; ++j) r4i(x[4 * j], x[4 * j + 1], x[4 * j + 2], x[4 * j + 3], w, w2, w3);
#pragma unroll
            for (int m = 0; m < 4; ++m) r4i(x[m], x[m + 4], x[m + 8], x[m + 12], t1[m], t2[m], t3[m]);
        }
#pragma unroll
        for (int m = 0; m < 16; ++m) p[m * STEP] = x[m];
    }
    __syncthreads();
}
template <bool INV> __device__ __forceinline__ void fft_pass4(LAS f32x2* B, int tid) {
#pragma unroll 4
    for (int jj = 0; jj < 8; ++jj) {
        const int q = tid + 512 * jj;
        LAS f32x2* p = B + (q & 255) * 65 + 4 * (q >> 8);
        f32x2 x0 = p[0], x1 = p[1], x2 = p[2], x3 = p[3];
        if (!INV) r4f1(x0, x1, x2, x3); else r4i1(x0, x1, x2, x3);
        p[0] = x0; p[1] = x1; p[2] = x2; p[3] = x3;
    }
    __syncthreads();
}
__device__ __forceinline__ void fft_fwd(LAS f32x2* B, const LAS f32x2* T, int tid) {
    fft_pass16<1024, false>(B, T, tid); fft_pass16<64, false>(B, T, tid); fft_pass16<4, false>(B, T, tid); fft_pass4<false>(B, tid);
}
__device__ __forceinline__ void fft_inv(LAS f32x2* B, const LAS f32x2* T, int tid) {
    fft_pass4<true>(B, tid); fft_pass16<4, true>(B, T, tid); fft_pass16<64, true>(B, T, tid); fft_pass16<1024, true>(B, T, tid);
}
__device__ __forceinline__ void fft_pass4_keep(LAS f32x2* B, int tid, u32x4 (&ks)[8]) {
#pragma unroll
    for (int jj = 0; jj < 8; ++jj) {
        const int q = tid + 512 * jj;
        const LAS f32x2* p = B + (q & 255) * 65 + 4 * (q >> 8);
        f32x2 x0 = p[0], x1 = p[1], x2 = p[2], x3 = p[3];
        r4f1(x0, x1, x2, x3);
        ks[jj].x = cvt_pk_bf16(x0.x, x0.y); ks[jj].y = cvt_pk_bf16(x1.x, x1.y); ks[jj].z = cvt_pk_bf16(x2.x, x2.y); ks[jj].w = cvt_pk_bf16(x3.x, x3.y);
    }
    __syncthreads();
}
__device__ __forceinline__ void fft_mid4(LAS f32x2* B, int tid, const u32x4 (&ks)[8]) {
#pragma unroll
    for (int jj = 0; jj < 8; ++jj) {
        const int q = tid + 512 * jj;
        LAS f32x2* p = B + (q & 255) * 65 + 4 * (q >> 8);
        f32x2 x0 = p[0], x1 = p[1], x2 = p[2], x3 = p[3];
        r4f1(x0, x1, x2, x3);
        x0 = cmul(x0, (f32x2){bflo(ks[jj].x), bfhi(ks[jj].x)}); x1 = cmul(x1, (f32x2){bflo(ks[jj].y), bfhi(ks[jj].y)});
        x2 = cmul(x2, (f32x2){bflo(ks[jj].z), bfhi(ks[jj].z)}); x3 = cmul(x3, (f32x2){bflo(ks[jj].w), bfhi(ks[jj].w)});
        r4i1(x0, x1, x2, x3);
        p[0] = x0; p[1] = x1; p[2] = x2; p[3] = x3;
    }
    __syncthreads();
}
__device__ __forceinline__ void fft_fwd3(LAS f32x2* B, const LAS f32x2* T, int tid) { fft_pass16<1024, false>(B, T, tid); fft_pass16<64, false>(B, T, tid); fft_pass16<4, false>(B, T, tid); }
__device__ __forceinline__ void fft_inv3(LAS f32x2* B, const LAS f32x2* T, int tid) { fft_pass16<4, true>(B, T, tid); fft_pass16<64, true>(B, T, tid); fft_pass16<1024, true>(B, T, tid); }
__device__ __forceinline__ float conv3_at(const bf16* p, int n, int L, float w0, float w1, float w2, float b) {
    const float xm = n > 0 ? bf2f(p[n - 1]) : 0.f, x0 = bf2f(p[n]), xp = n + 1 < L ? bf2f(p[n + 1]) : 0.f;
    return w0 * xm + w1 * x0 + w2 * xp + b;
}
__device__ __forceinline__ float block_sum(Frame& F, float v) {
    LAS float* red = (LAS float*)(F.lds + RED_OFF);
    v = wave_sum(v);
    __syncthreads();
    if (F.lane == 0) red[F.wave] = v;
    __syncthreads();
    float s = 0.f;
#pragma unroll
    for (int w = 0; w < 8; ++w) s += red[w];
    return s;
}
__device__ __forceinline__ f32x4 conv3x4(const bf16* p, int nb, float w0, float w1, float w2, float b) {
    const u32x2 m = *(const u32x2*)(p + nb);
    const float x0 = bflo(m.x), x1 = bfhi(m.x), x2 = bflo(m.y), x3 = bfhi(m.y);
    const float xm = nb > 0 ? bf2f(p[nb - 1]) : 0.f, xp = nb + 4 < SEQ ? bf2f(p[nb + 4]) : 0.f;
    return (f32x4){w0 * xm + w1 * x0 + w2 * x1 + b, w0 * x0 + w1 * x1 + w2 * x2 + b, w0 * x1 + w1 * x2 + w2 * x3 + b, w0 * x2 + w1 * x3 + w2 * xp + b};
}
typedef u32x4 u32x4_a4 __attribute__((aligned(4)));
__device__ __forceinline__ u32x4 ld16u(const bf16* p) { return *(const u32x4_a4*)p; }
__device__ __forceinline__ void conv3p(const u32x4 a, const u32x4 b, bool first, bool last, float w0, float w1, float w2, float bb, f32x2 (&z)[4]) {
    f32x2 X[6];
    X[0] = (f32x2){bfhi(a.x), bfhi(b.x)}; X[1] = (f32x2){bflo(a.y), bflo(b.y)}; X[2] = (f32x2){bfhi(a.y), bfhi(b.y)};
    X[3] = (f32x2){bflo(a.z), bflo(b.z)}; X[4] = (f32x2){bfhi(a.z), bfhi(b.z)}; X[5] = (f32x2){bflo(a.w), bflo(b.w)};
    if (first) X[0] = (f32x2){0.f, 0.f};
    if (last) X[5] = (f32x2){0.f, 0.f};
#pragma unroll
    for (int e = 0; e < 4; ++e) z[e] = X[e] * w0 + (X[e + 1] * w1 + (X[e + 2] * w2 + bb));
}
__device__ __forceinline__ void hyena_unit(Frame& F, const Params& P, int l, int c, bool dummy) {
    LAS f32x2* B = (LAS f32x2*)F.lds; const LAS f32x2* T = (const LAS f32x2*)(F.lds + TW_OFF);
    const bf16* HT = (const bf16*)(F.ws + WS_HT); const bf16* FILT = (const bf16*)(F.ws + WS_FILT);
    f32x4* Z = (f32x4*)(F.ws + WS_KSCR + (size_t)F.bid * 131072);
    u32x4 ksr[8];
    u32x4* ES = (u32x4*)(F.ws + WS_ES + (size_t)F.bid * 131072) + 4096;
    bf16* BR3 = (bf16*)(F.ws + WS_BRV) + 3 * (size_t)MT * 256;
    const float* sw = P.in[I_HSW] + l * 3 * 768; const float* sb = P.in[I_HSB] + l * 768;
    const int tid = F.tid;
#define HY_NB(jp_) (4 * tq + 2048 * (jp_))
#define HY_TQ int tq = tid; asm volatile("" : "+v"(tq))
#define HY_G(T_, base_, boff_) (*(T_*)((char*)(base_) + (unsigned)(boff_)))
#define HY_LDX(row_, nb_) (*(const u32x4_a4*)((const char*)((row_) - 2) + (unsigned)((nb_) * 2)))
#define HY_LDR(hb_, nb_) (*(const u32x4_a4*)((const char*)((hb_) - 2) + (unsigned)((FL - 4 - (nb_)) * 2)))
#define HY_SLOT(nb_) (B + (nb_) + ((nb_) >> 6))
#define HY_TW4(nb_, w_) do { const f32x2 tb_ = T[256 + ((nb_) >> 7)]; const LAS f32x4* tp_ = (const LAS f32x4*)(T + 384 + ((nb_) & 127)); const f32x4 ta_ = tp_[0], tc_ = tp_[1]; \
        w_[0] = cmul(tb_, (f32x2){ta_[0], ta_[1]}); w_[1] = cmul(tb_, (f32x2){ta_[2], ta_[3]}); w_[2] = cmul(tb_, (f32x2){tc_[0], tc_[1]}); w_[3] = cmul(tb_, (f32x2){tc_[2], tc_[3]}); } while (0)
#define HY_ST4(nb_, c0_, c1_, c2_, c3_) do { LAS f32x2* bp_ = HY_SLOT(nb_); bp_[0] = (c0_); bp_[1] = (c1_); bp_[2] = (c2_); bp_[3] = (c3_); } while (0)
#define HY_UNPK(w_) ((f32x2){bflo(w_), bfhi(w_)})
#define HY_FILT4(fw_, gw_, nb_, f4_, r4_) const f32x4 f4_ = (f32x4){bflo(fw_.x), bfhi(fw_.x), bflo(fw_.y), bfhi(fw_.y)};   \
        const f32x4 r4_ = (f32x4){(nb_) ? bflo(gw_.w) : 0.f, bfhi(gw_.z), bflo(gw_.z), bfhi(gw_.y)}
    {
        const bf16* p0 = HT + (size_t)c * MT; const float v0 = sw[c], v1 = sw[768 + c], v2 = sw[1536 + c], vb = sb[c];
        { HY_TQ;
#pragma unroll
        for (int h = 0; h < 2; ++h) {
            u32x4 xa[4], xb[4];
#pragma unroll
            for (int j = 0; j < 4; ++j) { const int nb = HY_NB(4 * h + j); xa[j] = HY_LDX(p0, nb); xb[j] = HY_LDX(p0 + SEQ, nb); }
#pragma unroll
            for (int j = 0; j < 4; ++j) { const int nb = HY_NB(4 * h + j); f32x2 z[4]; conv3p(xa[j], xb[j], nb == 0, nb + 4 == SEQ, v0, v1, v2, vb, z);
                HY_G(f32x4, Z, nb * 8) = (f32x4){z[0].x, z[0].y, z[1].x, z[1].y}; HY_G(f32x4, Z + 1, nb * 8) = (f32x4){z[2].x, z[2].y, z[3].x, z[3].y}; }
        } }
    }
#pragma unroll 1
    for (int o = 0; o < 2; ++o) {
        const bf16* hf = FILT + (size_t)((o * 2 + 0) * 256 + c) * SEQ; const bf16* hb = FILT + (size_t)((o * 2 + 1) * 256 + c) * SEQ;
        float ss = 0.f;
#pragma unroll 1
        for (int par = 0; par < 2; ++par) {
            if (par == 0) {
                { HY_TQ;
#pragma unroll
                for (int h = 0; h < 2; ++h) {
                    u32x2 fw[4]; u32x4 gw[4];
#pragma unroll
                    for (int j = 0; j < 4; ++j) { const int nb = HY_NB(4 * h + j); fw[j] = HY_G(const u32x2, hf, nb * 2); gw[j] = HY_LDR(hb, nb); }
#pragma unroll
                    for (int j = 0; j < 4; ++j) { const int nb = HY_NB(4 * h + j); HY_FILT4(fw[j], gw[j], nb, f4, r4);
                        const f32x4 a = f4 + r4; ss += (f4[0] * f4[0] + f4[1] * f4[1]) + (f4[2] * f4[2] + f4[3] * f4[3]) + (r4[0] * r4[0] + r4[1] * r4[1]) + (r4[2] * r4[2] + r4[3] * r4[3]);
                        HY_ST4(nb, ((f32x2){a[0], 0.f}), ((f32x2){a[1], 0.f}), ((f32x2){a[2], 0.f}), ((f32x2){a[3], 0.f})); }
                } }
                __syncthreads();
            }
            fft_fwd3(B, T, tid); fft_pass4_keep(B, tid, ksr);
            { HY_TQ;
#pragma unroll
            for (int h = 0; h < 2; ++h) {
                f32x4 za[4], zb[4];
#pragma unroll
                for (int j = 0; j < 4; ++j) { const int nb = HY_NB(4 * h + j); za[j] = HY_G(const f32x4, Z, nb * 8); zb[j] = HY_G(const f32x4, Z + 1, nb * 8); }
#pragma unroll
                for (int j = 0; j < 4; ++j) { const int nb = HY_NB(4 * h + j);
                    const f32x2 z0 = (f32x2){za[j].x, za[j].y}, z1 = (f32x2){za[j].z, za[j].w}, z2 = (f32x2){zb[j].x, zb[j].y}, z3 = (f32x2){zb[j].z, zb[j].w};
                    if (par == 0) { HY_ST4(nb, z0, z1, z2, z3); }
                    else { f32x2 tw[4]; HY_TW4(nb, tw); HY_ST4(nb, cmul(z0, tw[0]), cmul(z1, tw[1]), cmul(z2, tw[2]), cmul(z3, tw[3])); } }
            } }
            __syncthreads();
            fft_fwd3(B, T, tid); fft_mid4(B, tid, ksr);
            fft_inv3(B, T, tid);
            if (par == 0) {
                { HY_TQ;
#pragma unroll
                for (int h = 0; h < 2; ++h) {
                    u32x2 fw[4]; u32x4 gw[4];
#pragma unroll
                    for (int j = 0; j < 4; ++j) { const int nb = HY_NB(4 * h + j); fw[j] = HY_G(const u32x2, hf, nb * 2); gw[j] = HY_LDR(hb, nb); }
#pragma unroll
                    for (int j = 0; j < 4; ++j) { const int jp = 4 * h + j, nb = HY_NB(jp); const LAS f32x2* bp = HY_SLOT(nb); const f32x2 a0 = bp[0] * (1.0f / 16384.0f), a1 = bp[1] * (1.0f / 16384.0f), a2 = bp[2] * (1.0f / 16384.0f), a3 = bp[3] * (1.0f / 16384.0f);
                        u32x4 w; w.x = cvt_pk_bf16(a0.x, a0.y); w.y = cvt_pk_bf16(a1.x, a1.y); w.z = cvt_pk_bf16(a2.x, a2.y); w.w = cvt_pk_bf16(a3.x, a3.y); HY_G(u32x4, ES + jp * 512, tq * 16) = w;
                        HY_FILT4(fw[j], gw[j], nb, f4, r4);
                        const f32x4 d = f4 - r4; f32x2 tw[4]; HY_TW4(nb, tw); HY_ST4(nb, tw[0] * d[0], tw[1] * d[1], tw[2] * d[2], tw[3] * d[3]); }
                } }
                __syncthreads();
            }
        }
        const float nrm = (1.0f / sqrtf(block_sum(F, ss) + 1e-6f)) * 0.5f;
        const float hbias = P.in[I_HBI][(l * 2 + o) * 256 + c];
        const int ch = (o + 1) * 256 + c;
        const bf16* px = HT + (size_t)ch * MT; const float w0 = sw[ch], w1 = sw[768 + ch], w2 = sw[1536 + ch], bb = sb[ch];
        { HY_TQ;
#pragma unroll
        for (int h = 0; h < 4; ++h) {
            u32x4 ev[2], xa[2], xb[2]; f32x4 za[2], zb[2];
#pragma unroll
            for (int j = 0; j < 2; ++j) { const int jp = 2 * h + j, nb = HY_NB(jp); ev[j] = HY_G(const u32x4, ES + jp * 512, tq * 16); za[j] = HY_G(const f32x4, Z, nb * 8); zb[j] = HY_G(const f32x4, Z + 1, nb * 8); xa[j] = HY_LDX(px, nb); xb[j] = HY_LDX(px + SEQ, nb); }
#pragma unroll
            for (int j = 0; j < 2; ++j) { const int nb = HY_NB(2 * h + j);
                const LAS f32x2* bp = HY_SLOT(nb); f32x2 w[4]; HY_TW4(nb, w);
                const f32x2 e0 = HY_UNPK(ev[j].x) + cmulc(bp[0], w[0]) * (1.0f / 16384.0f), e1 = HY_UNPK(ev[j].y) + cmulc(bp[1], w[1]) * (1.0f / 16384.0f),
                            e2 = HY_UNPK(ev[j].z) + cmulc(bp[2], w[2]) * (1.0f / 16384.0f), e3 = HY_UNPK(ev[j].w) + cmulc(bp[3], w[3]) * (1.0f / 16384.0f);
                f32x2 x[4]; conv3p(xa[j], xb[j], nb == 0, nb + 4 == SEQ, w0, w1, w2, bb, x);
                const f32x2 y0 = (e0 * nrm + (f32x2){za[j].x, za[j].y} * hbias) * x[0], y1 = (e1 * nrm + (f32x2){za[j].z, za[j].w} * hbias) * x[1],
                            y2 = (e2 * nrm + (f32x2){zb[j].x, zb[j].y} * hbias) * x[2], y3 = (e3 * nrm + (f32x2){zb[j].z, zb[j].w} * hbias) * x[3];
                if (o == 0) { HY_G(f32x4, Z, nb * 8) = (f32x4){y0.x, y0.y, y1.x, y1.y}; HY_G(f32x4, Z + 1, nb * 8) = (f32x4){y2.x, y2.y, y3.x, y3.y}; }
                else if (!dummy) {
                    const unsigned u0 = cvt_pk_bf16(y0.x, y0.y), u1 = cvt_pk_bf16(y1.x, y1.y), u2 = cvt_pk_bf16(y2.x, y2.y), u3 = cvt_pk_bf16(y3.x, y3.y);
                    bf16* q0 = BR3 + c; bf16* q1 = q0 + (size_t)SEQ * 256; const int ob = nb * 512;
                    HY_G(bf16, q0, ob) = (bf16)(u0 & 0xffffu); HY_G(bf16, q0 + 256, ob) = (bf16)(u1 & 0xffffu); HY_G(bf16, q0 + 512, ob) = (bf16)(u2 & 0xffffu); HY_G(bf16, q0 + 768, ob) = (bf16)(u3 & 0xffffu);
                    HY_G(bf16, q1, ob) = (bf16)(u0 >> 16); HY_G(bf16, q1 + 256, ob) = (bf16)(u1 >> 16); HY_G(bf16, q1 + 512, ob) = (bf16)(u2 >> 16); HY_G(bf16, q1 + 768, ob) = (bf16)(u3 >> 16); }
            }
        } }
        __syncthreads();
    }
#undef HY_NB
#undef HY_TQ
#undef HY_G
#undef HY_LDX
#undef HY_LDR
#undef HY_FILT4
#undef HY_TW4
#undef HY_ST4
#undef HY_SLOT
#undef HY_UNPK
}
__device__ __forceinline__ void hyena_ctx_unit(Frame& F, const Params& P, int l, int c) {
    LAS float* zc = (LAS float*)F.lds;
    LAS float* kk = (LAS float*)(F.lds + 4096);
    const bf16* HT = (const bf16*)(F.ws + WS_HT); const float* FC = (const float*)(F.ws + WS_FILTC);
    bf16* BR3 = (bf16*)(F.ws + WS_BRV) + 3 * (size_t)MT * 256;
    const float* sw = P.in[I_HSW] + l * 3 * 768; const float* sb = P.in[I_HSB] + l * 768;
    const int b = F.tid >> 8, t = F.tid & 255;
    float zv = conv3_at(HT + (size_t)c * MT + TL + b * CTXL, t, CTXL, sw[c], sw[768 + c], sw[1536 + c], sb[c]);
    for (int o = 0; o < 2; ++o) {
        const float* hf = FC + (size_t)((o * 2 + 0) * 256 + c) * CTXL; const float* hb = FC + (size_t)((o * 2 + 1) * 256 + c) * CTXL;
        float ss = 0.f;
        if (F.tid < 256) { const float f = hf[F.tid]; kk[255 + F.tid] = f; ss = f * f; }
        else { const int d = F.tid - 256; if (d >= 1) { const float f = hb[d]; kk[255 - d] = f; ss = f * f; } }
        zc[F.tid] = zv;
        const float nrm = 1.0f / sqrtf(block_sum(F, ss) + 1e-6f);
        float y = 0.f;
        for (int s_ = 0; s_ < 256; ++s_) y += kk[t - s_ + 255] * zc[b * 256 + s_];
        y = y * nrm + P.in[I_HBI][(l * 2 + o) * 256 + c] * zv;
        const int ch = (o + 1) * 256 + c;
        zv = conv3_at(HT + (size_t)ch * MT + TL + b * CTXL, t, CTXL, sw[ch], sw[768 + ch], sw[1536 + ch], sb[ch]) * y;
        __syncthreads();
    }
    BR3[(size_t)(TL + b * CTXL + t) * 256 + c] = (bf16)(cvt_pk_bf16(zv, 0.f) & 0xffffu);
}
__device__ __forceinline__ void phase_mixer(Frame& F, const Params& P, int l, bool last) {
    {
        LAS float* rpb = (LAS float*)(F.lds + RPB_OFF); for (int i = F.tid; i < 1860; i += NTHR) rpb[i] = P.in[I_RPB][l * 1860 + i] * 1.44269504089f;
        LAS f32x2* T = (LAS f32x2*)(F.lds + TW_OFF);
        if (F.tid < 512) { const int tb = F.tid >> 7, a = F.tid & 127; const float x = tb == 0 ? (float)a / 128.0f : (tb == 1 ? (float)a / 16384.0f : (tb == 2 ? (float)a / 256.0f : (float)a / 32768.0f));
            float s, cs; sincospif(2.0f * x, &s, &cs); T[F.tid] = (f32x2){cs, -s}; }
        __syncthreads();
    }
#ifndef MIXMASK
#define MIXMASK 63
#endif
    if (MIXMASK & 1) for (int c = F.bid; c < 256; c += F.G) hyena_unit(F, P, l, ((c & 7) << 5) | (c >> 3), false);
    if (MIXDUP & 1) for (int c = F.bid; c < 256; c += F.G) hyena_unit(F, P, l, c, true);
    if (MIXMASK & 2) if (!last) for (int rep_ = 0; rep_ <= ((MIXDUP >> 1) & 1); ++rep_) for (int c = F.bid; c < 256; c += F.G) { hyena_ctx_unit(F, P, l, c); __syncthreads(); }
    const int ntile = (last ? TL : MT) / 64;
    if (MIXMASK & 4) for (int rep_ = 0; rep_ <= ((MIXDUP >> 2) & 1); ++rep_) conformer_tiles(F, P, l, (F.bid + F.G / 2) % F.G, ntile);
    if (MIXMASK & 8) for (int rep_ = 0; rep_ <= ((MIXDUP >> 3) & 1); ++rep_) for (int u = (F.bid + F.G / 4) % F.G; u < ntile; u += F.G) shortconv_unit(F, P, l, u * 64);
    const int gw = F.bid * NWAVES + F.wave, NGW = F.G * NWAVES;
    if (MIXMASK & 16) for (int rep_ = 0; rep_ <= ((MIXDUP >> 4) & 1); ++rep_) for (int task = F.bid; task < 256; task += F.G) {
        const int h = task & 3, b = task >> 7, rb = ((task >> 2) & 31) * 8;
        __syncthreads();
        attn_stage_ctx(F, b, h);
        __syncthreads();
#pragma unroll 1
        for (int it = 0; it < 4; ++it) { int wu = (b << 12) | ((rb + 2 * it + (F.wave >> 2)) << 4) | (h << 2) | (F.wave & 3); asm volatile("" : "+s"(wu));
            attn_wave_unit(F, wu, true, true); }
    }
    if (MIXMASK & 32) if (!last) for (int wu = gw; wu < 128; wu += NGW) attn_wave_unit(F, wu, false, false);
}

__global__ void __launch_bounds__(NTHR, 2) mk_fwd(Params P) {
    extern __shared__ __attribute__((aligned(16))) unsigned char lds_raw[];
    Frame F;
    const int wave0 = __builtin_amdgcn_readfirstlane(threadIdx.x >> 6);
    F.lds = (LAS unsigned char*)lds_raw; F.tid = threadIdx.x; F.lane = F.tid & 63; F.wave = __builtin_amdgcn_readfirstlane(F.tid >> 6); F.bid = blockIdx.x; F.G = gridDim.x; F.ws = P.ws;
    volatile LAS unsigned* MISC = (volatile LAS unsigned*)(F.lds + MISC_OFF);
    if (F.tid < 4) MISC[F.tid] = 0u;
    __syncthreads();
    XcdBarrier bar = xcd_barrier_post((unsigned*)(P.ws + WS_CTL) + 4096, MISC);
    const int lo = P.ph_lo, hi = P.ph_hi;
    int ph = 0;
#define PHASE_BEGIN if (ph >= lo && ph < hi) { { int t_; asm volatile("v_mbcnt_lo_u32_b32 %0, -1, 0\n\tv_mbcnt_hi_u32_b32 %0, -1, %0" : "=v"(t_)); t_ |= wave0 << 6; F.tid = t_; F.lane = t_ & 63; F.wave = __builtin_amdgcn_readfirstlane(t_ >> 6); size_t o_ = 0; asm volatile("" : "+s"(o_)); F.ws = P.ws + o_; }
#define PHASE_END   if (ph + 1 < hi) xcd_barrier(bar, F.tid); } ++ph;
#define MOD ((const float*)(F.ws + WS_MOD))
#define Hc ((const char*)(F.ws + WS_H))

    PHASE_BEGIN if (PHMASK & (1u << 0)) for (int rep_ = 0; rep_ <= (int)((DUPMASK >> 0) & 1u); ++rep_) { prologue_a(F, P); } PHASE_END
    PHASE_BEGIN if (PHMASK & (1u << 1)) for (int rep_ = 0; rep_ <= (int)((DUPMASK >> 1) & 1u); ++rep_) { phase_mod0(F, P); phase_filters(F, P, 0, true); } PHASE_END

    for (int l = 0; l < 2; ++l) {
        const bool last = (l == 1);
#define modl (MOD + (size_t)l * 3 * 9216)
#define xl ((l == 0) ? (const void*)P.in[I_X] : (const void*)P.out)
#define xc ((l == 0) ? P.in[I_CTX] : (const float*)(F.ws + WS_XC))
#define xcw ((const float*)(F.ws + WS_XC))
        PHASE_BEGIN if (PHMASK & (1u << 2)) for (int rep_ = 0; rep_ <= (int)((DUPMASK >> 2) & 1u); ++rep_) { { SchedPlain S{Hc, (const char*)(F.ws + WS_W1T) + (size_t)(l * 2 + 0) * NFF * D, 1024u, 1024u, 8, MT / 256, 22, F.G, F.bid};
            EpiFfnUp E{F.ws + WS_U}; pg8::gemm_phase<EpiFfnUp, SchedPlain, 1>(F.lds, S, E, F.tid); } } PHASE_END
        PHASE_BEGIN if (PHMASK & (1u << 3)) for (int rep_ = 0; rep_ <= (int)((DUPMASK >> 3) & 1u); ++rep_) { { SchedResid<5, 1, 6> S{(const char*)(F.ws + WS_U), (const char*)(F.ws + WS_W2T) + (size_t)(l * 2 + 0) * D * DFF, (unsigned)DFF, 22, F.G, F.bid, true, (const char*)(F.ws + WS_U) + (size_t)TL * DFF};
            EpiRes E{(bf16*)P.out, (l == 0) ? (const void*)P.in[I_X] : (const void*)(F.ws + WS_BRV), l != 0, modl + 2 * D, nullptr, 0.5f / W2_SCALE, (float*)(F.ws + WS_ES),
                (l != 0) ? (const float*)(F.ws + WS_LNS) : nullptr, P.in[I_PLG] + ((l + 1) % 2 * 3 + 2) * D, P.in[I_PLB] + ((l + 1) % 2 * 3 + 2) * D}; pg8::gemm_phase<EpiRes, SchedResid<5, 1, 6>, 1>(F.lds, S, E, F.tid); } } PHASE_END
        PHASE_BEGIN if (PHMASK & (1u << 4)) for (int rep_ = 0; rep_ <= (int)((DUPMASK >> 4) & 1u); ++rep_) { phase_ln(F, P, P.in[I_PLG] + (l * 3 + 0) * D, P.in[I_PLB] + (l * 3 + 0) * D, modl, 3, true, false, true, false, 5, 0.5f / W2_SCALE, modl + (size_t)2 * 9216 + 2 * D, nullptr, xc, true, (const bf16*)P.out); if (l == 1) phase_filters(F, P, 1, false); } PHASE_END
        PHASE_BEGIN if (PHMASK & (1u << 5)) for (int rep_ = 0; rep_ <= (int)((DUPMASK >> 5) & 1u); ++rep_) { { SchedInproj S{(const char*)F.ws, l, MT / 256, F.G, F.bid};
            EpiInproj E{(const float*)(F.ws + WS_BIN) + l * PIN, F.ws};
            pg8::gemm_phase<EpiInproj, SchedInproj, 2>(F.lds, S, E, F.tid); } } PHASE_END
        PHASE_BEGIN if (PHMASK & (1u << 6)) for (int rep_ = 0; rep_ <= (int)((DUPMASK >> 6) & 1u); ++rep_) { phase_mixer(F, P, l, last); } PHASE_END
        const int Mx = last ? TL : MT;
        PHASE_BEGIN if (PHMASK & (1u << 7)) for (int rep_ = 0; rep_ <= (int)((DUPMASK >> 7) & 1u); ++rep_) { { SchedGateBr S{Hc, (const char*)(F.ws + WS_H8L), (const char*)(F.ws + WS_H8C), (const char*)(F.ws + WS_WIT) + ((size_t)l * PIN + NINP) * D * 2, (const char*)(F.ws + WS_BRV), (const char*)(F.ws + WS_WPT) + (size_t)l * 4 * D * 256 * 2, F.G, F.bid, !last};
            EpiGateBr E{(const float*)(F.ws + WS_BIN) + l * PIN + NINP, F.ws + WS_GS + (size_t)F.bid * 393216, (bf16*)(F.ws + WS_MG), (bf16*)(F.ws + WS_MI)}; pg8::gemm_phase<EpiGateBr, SchedGateBr, 2>(F.lds, S, E, F.tid); } } PHASE_END
        PHASE_BEGIN if (PHMASK & (1u << 8)) for (int rep_ = 0; rep_ <= (int)((DUPMASK >> 8) & 1u); ++rep_) { { SchedResid<4, 4> S{(const char*)(F.ws + WS_MG), (const char*)(F.ws + WS_WOT) + (size_t)l * D * D * 2, 2048u, 16, F.G, F.bid, !last, (const char*)(F.ws + WS_MI)};
            EpiRes E{(bf16*)(F.ws + WS_BRV), (const void*)P.out, true, modl + 5 * D, P.in[I_BOUT] + l * D, 1.0f, (float*)(F.ws + WS_ES), (const float*)(F.ws + WS_LNS), P.in[I_PLG] + (l * 3 + 0) * D, P.in[I_PLB] + (l * 3 + 0) * D}; pg8::gemm_phase(F.lds, S, E, F.tid); } } PHASE_END
        PHASE_BEGIN if (PHMASK & (1u << 9)) for (int rep_ = 0; rep_ <= (int)((DUPMASK >> 9) & 1u); ++rep_) { phase_ln(F, P, P.in[I_PLG] + (l * 3 + 1) * D, P.in[I_PLB] + (l * 3 + 1) * D, modl, 6, true, true, false, false, last ? 0 : 16, 1.0f, modl + (size_t)2 * 9216 + 5 * D, P.in[I_BOUT] + l * D, xcw, true, (const bf16*)(F.ws + WS_BRV)); } PHASE_END
        PHASE_BEGIN if (PHMASK & (1u << 10)) for (int rep_ = 0; rep_ <= (int)((DUPMASK >> 10) & 1u); ++rep_) { { SchedPlain S{Hc, (const char*)(F.ws + WS_W1T) + (size_t)(l * 2 + 1) * NFF * D, 1024u, 1024u, 8, Mx / 256, 22, F.G, F.bid};
            EpiFfnUp E{F.ws + WS_U}; pg8::gemm_phase<EpiFfnUp, SchedPlain, 1>(F.lds, S, E, F.tid); } } PHASE_END
        PHASE_BEGIN if (PHMASK & (1u << 11)) for (int rep_ = 0; rep_ <= (int)((DUPMASK >> 11) & 1u); ++rep_) { { SchedResid<5, 1, 6> S{(const char*)(F.ws + WS_U), (const char*)(F.ws + WS_W2T) + (size_t)(l * 2 + 1) * D * DFF, (unsigned)DFF, 22, F.G, F.bid, !last, (const char*)(F.ws + WS_U) + (size_t)TL * DFF};
            EpiRes E{(bf16*)(F.ws + WS_BRV), (const void*)(F.ws + WS_BRV), true, modl + 8 * D, nullptr, 0.5f / W2_SCALE, (float*)(F.ws + WS_ES), (const float*)(F.ws + WS_LNS), P.in[I_PLG] + (l * 3 + 1) * D, P.in[I_PLB] + (l * 3 + 1) * D}; pg8::gemm_phase<EpiRes, SchedResid<5, 1, 6>, 1>(F.lds, S, E, F.tid); } } PHASE_END
        PHASE_BEGIN if (PHMASK & (1u << 12)) for (int rep_ = 0; rep_ <= (int)((DUPMASK >> 12) & 1u); ++rep_) { phase_ln(F, P, P.in[I_PLG] + (l * 3 + 2) * D, P.in[I_PLB] + (l * 3 + 2) * D, MOD + (size_t)3 * 9216  , 0, !last, true, false, last, last ? 0 : 5, 0.5f / W2_SCALE, modl + (size_t)2 * 9216 + 8 * D, nullptr, xcw, !last, (const bf16*)(F.ws + WS_BRV)); } PHASE_END
    }
#undef MOD
#undef Hc
#undef modl
#undef xcw
#undef xc
#undef xl
#undef PHASE_BEGIN
#undef PHASE_END
}

#ifndef MK_N_LAUNCHES
#define MK_N_LAUNCHES 1
#endif
constexpr int N_PHASES = 2 + 2 * 11;
extern "C" void kernel_launch(void* const* d_in, const int* in_sizes, int n_in, void* d_out, int out_size, void* d_ws, size_t ws_size, hipStream_t stream) {
    static int grid = 0;
    if (grid == 0) {
        if (n_in != 33 || out_size != TL * D || ws_size < WS_TOTAL) { fprintf(stderr, "kernel_launch: unexpected shapes (n_in %d out %d ws %zu)\n", n_in, out_size, ws_size); grid = -1; return; }
        int dev = 0, cus = 0;
        if (hipGetDevice(&dev) != hipSuccess || hipDeviceGetAttribute(&cus, hipDeviceAttributeMultiprocessorCount, dev) != hipSuccess) { grid = -1; return; }
        if (hipFuncSetAttribute((const void*)mk_fwd, hipFuncAttributeMaxDynamicSharedMemorySize, LDS_BYTES) != hipSuccess) { fprintf(stderr, "kernel_launch: hipFuncSetAttribute failed\n"); grid = -1; return; }
        int per_cu = 0;
        if (hipOccupancyMaxActiveBlocksPerMultiprocessor(&per_cu, (const void*)mk_fwd, NTHR, LDS_BYTES) != hipSuccess || per_cu < 1) fprintf(stderr, "kernel_launch: occupancy query says %d\n", per_cu);
        (void)hipGetLastError();
        grid = cus;
    }
    if (grid < 0) return;
    (void)hipMemsetAsync((char*)d_ws + WS_CTL, 0, CTL_BYTES, stream);
    Params p{};
    for (int i = 0; i < 33; ++i) p.in[i] = (const float*)d_in[i];
    p.out = (float*)d_out; p.ws = (unsigned char*)d_ws;
#if MK_N_LAUNCHES == 1
    p.ph_lo = 0; p.ph_hi = N_PHASES;
    hipLaunchKernelGGL(mk_fwd, dim3(grid), dim3(NTHR), LDS_BYTES, stream, p);
#else
    for (int i = 0; i < N_PHASES; ++i) { p.ph_lo = i; p.ph_hi = i + 1; hipLaunchKernelGGL(mk_fwd, dim3(grid), dim3(NTHR), LDS_BYTES, stream, p); }
#endif
}
```

```cpp
#include <hip/hip_runtime.h>
#include <cstdio>
#include <cstdint>

#ifndef PHMASK
#define PHMASK 0xFFFFu
#endif
#ifndef DUPMASK
#define DUPMASK 0u
#endif
#ifndef FFTPROBE
#define FFTPROBE 0
#endif
#ifndef EPIDUP
#define EPIDUP 0
#endif
#ifndef MIXDUP
#define MIXDUP 0
#endif
#define LAS __attribute__((address_space(3)))
typedef unsigned short bf16;
typedef short bf16x8 __attribute__((ext_vector_type(8)));
typedef float f32x4 __attribute__((ext_vector_type(4)));
typedef float f32x2 __attribute__((ext_vector_type(2)));
typedef unsigned u32x4 __attribute__((ext_vector_type(4)));
typedef unsigned u32x2 __attribute__((ext_vector_type(2)));

constexpr int D = 1024, SEQ = 16384, TL = 32768, CTXL = 256, TC = 512, MT = TL + TC;
constexpr int DFF = 2816, NFF = 2 * DFF, PIN = 6912, NINP = 2816, NMOD = 9;
constexpr int WA = 256;
constexpr float LN_EPS = 1e-5f, ALPHA = 1.41421356237f, ATT_SCALE = 0.125f;
constexpr int NWAVES = 8, NTHR = 512;

constexpr size_t MiB = 1u << 20;
constexpr size_t WS_CTL = 0, CTL_BYTES = 1 * MiB;
constexpr size_t WS_MOD = 1 * MiB;
constexpr size_t WS_BIN = WS_MOD + 256 * 1024;
constexpr size_t WS_W3T = WS_BIN + 64 * 1024;
constexpr size_t WS_XC = 2 * MiB;
constexpr size_t WS_W1T = 4 * MiB;
constexpr size_t WS_W2T = WS_W1T + (size_t)4 * NFF * D * 2;
constexpr size_t WS_WIT = WS_W2T + (size_t)4 * D * DFF * 2;
constexpr size_t WS_WPT = WS_WIT + (size_t)2 * PIN * D * 2;
constexpr size_t WS_WOT = WS_WPT + (size_t)8 * D * 256 * 2;
constexpr size_t WS_H = WS_WOT + (size_t)2 * D * D * 2;
constexpr size_t WS_BRV = WS_H + (size_t)MT * D * 2;
constexpr size_t WS_FILT = WS_BRV + (size_t)MT * D * 2;
constexpr size_t WS_FILTC = WS_FILT + (size_t)4 * 256 * SEQ * 4;
constexpr size_t WS_H8L = WS_FILT + 32 * MiB;
constexpr size_t WS_LNS = WS_CTL + 64 * 1024;
constexpr size_t WS_H8C = WS_CTL + 512 * 1024;
constexpr size_t WS_U = WS_FILTC + (size_t)4 * 256 * 256 * 4;
constexpr size_t SZ256 = (size_t)MT * 256 * 2;
constexpr size_t WS_UA = WS_U, WS_Q = WS_U + SZ256, WS_K = WS_U + 2 * SZ256, WS_SB = WS_U + 3 * SZ256, WS_W = WS_U + 4 * SZ256;
constexpr size_t WS_VT = WS_U + 5 * SZ256;
constexpr size_t WS_HT = WS_U + 6 * SZ256;
constexpr size_t WS_KSCR = WS_U + 9 * SZ256;
constexpr size_t WS_MG = WS_U;
constexpr size_t WS_GS = WS_U + 4 * SZ256;
constexpr size_t WS_MI = WS_GS + (size_t)256 * 393216;
constexpr size_t WS_END = WS_U + (size_t)MT * DFF * 2;
static_assert(WS_KSCR + (size_t)256 * 131072 <= WS_END, "kscr");
static_assert(WS_MI + (size_t)4 * TC * D * 2 <= WS_END, "gs/mi");
constexpr size_t WS_ES = WS_END;
constexpr size_t WS_TOTAL = WS_ES + (size_t)256 * 131072;
static_assert(WS_TOTAL <= 512 * MiB, "ws");
static_assert(WS_BIN + 2 * PIN * 4 <= WS_W3T && WS_W3T + 2 * 1024 * 64 * 2 <= WS_XC && WS_MOD + 2 * 3 * 9216 * 4 <= WS_BIN, "small");

constexpr int RING_BYTES = 131072;
constexpr int FFT_BYTES = 133120;
constexpr int TW_OFF = FFT_BYTES;
constexpr int RPB_OFF = TW_OFF + 4096;
constexpr int RED_OFF = RPB_OFF + 7680;
constexpr int MISC_OFF = RED_OFF + 256;
constexpr int LDS_BYTES = 147456;
static_assert(MISC_OFF + 64 <= LDS_BYTES, "lds");

typedef __bf16 bf16x2_t __attribute__((ext_vector_type(2)));
__device__ __forceinline__ unsigned cvt_pk_bf16(float lo, float hi) { const f32x2 v = {lo, hi}; const bf16x2_t b = __builtin_convertvector(v, bf16x2_t); return __builtin_bit_cast(unsigned, b); }
typedef int v8i __attribute__((ext_vector_type(8)));
typedef int i32x4 __attribute__((ext_vector_type(4)));
__device__ __forceinline__ float sat8(float x) { return __builtin_amdgcn_fmed3f(x, -448.0f, 448.0f); }
__device__ __forceinline__ unsigned pk_fp8x4(float a, float b, float c, float d) { int p = 0; p = __builtin_amdgcn_cvt_pk_fp8_f32(sat8(a), sat8(b), p, false); p = __builtin_amdgcn_cvt_pk_fp8_f32(sat8(c), sat8(d), p, true); return (unsigned)p; }
constexpr float W1_SCALE = 32.0f, W2_SCALE = 64.0f;
__device__ __forceinline__ float bf2f(unsigned short b) { return __uint_as_float(((unsigned)b) << 16); }
__device__ __forceinline__ float bflo(unsigned w) { return __uint_as_float(w << 16); }
__device__ __forceinline__ float bfhi(unsigned w) { return __uint_as_float(w & 0xffff0000u); }
__device__ __forceinline__ float sigmoidf_(float x) { return __builtin_amdgcn_rcpf(1.0f + __builtin_amdgcn_exp2f(x * -1.44269504089f)); }
__device__ __forceinline__ float siluf_(float x) { return x * __builtin_amdgcn_rcpf(1.0f + __builtin_amdgcn_exp2f(x * -1.44269504089f)); }
__device__ __forceinline__ int lane_now() { int l_; asm volatile("v_mbcnt_lo_u32_b32 %0, -1, 0\n\tv_mbcnt_hi_u32_b32 %0, -1, %0" : "=v"(l_)); return l_; }
__device__ __forceinline__ float xrow_max(float v) {
    const unsigned a = __builtin_bit_cast(unsigned, v); auto r = __builtin_amdgcn_permlane16_swap(a, a, false, false);
    v = fmaxf(__builtin_bit_cast(float, (unsigned)r[0]), __builtin_bit_cast(float, (unsigned)r[1]));
    const unsigned b = __builtin_bit_cast(unsigned, v); auto q = __builtin_amdgcn_permlane32_swap(b, b, false, false);
    return fmaxf(__builtin_bit_cast(float, (unsigned)q[0]), __builtin_bit_cast(float, (unsigned)q[1]));
}
__device__ __forceinline__ float xrow_sum(float v) {
    const unsigned a = __builtin_bit_cast(unsigned, v); auto r = __builtin_amdgcn_permlane16_swap(a, a, false, false);
    v = __builtin_bit_cast(float, (unsigned)r[0]) + __builtin_bit_cast(float, (unsigned)r[1]);
    const unsigned b = __builtin_bit_cast(unsigned, v); auto q = __builtin_amdgcn_permlane32_swap(b, b, false, false);
    return __builtin_bit_cast(float, (unsigned)q[0]) + __builtin_bit_cast(float, (unsigned)q[1]);
}
__device__ __forceinline__ float shx(float v, int o, int lane) { return __builtin_bit_cast(float, __builtin_amdgcn_ds_bpermute((lane ^ o) << 2, __builtin_bit_cast(int, v))); }
#define DPP_F(v_, ctrl_) __builtin_bit_cast(float, __builtin_amdgcn_update_dpp(0, __builtin_bit_cast(int, (v_)), (ctrl_), 0xF, 0xF, true))
__device__ __forceinline__ float wave_sum(float v) {
    v += DPP_F(v, 0xB1);
    v += DPP_F(v, 0x4E);
    v += DPP_F(v, 0x141);
    v += DPP_F(v, 0x140);
    const int iv = __builtin_bit_cast(int, v);
    const float r0 = __builtin_bit_cast(float, __builtin_amdgcn_readlane(iv, 0)), r1 = __builtin_bit_cast(float, __builtin_amdgcn_readlane(iv, 16)),
                r2 = __builtin_bit_cast(float, __builtin_amdgcn_readlane(iv, 32)), r3 = __builtin_bit_cast(float, __builtin_amdgcn_readlane(iv, 48));
    return (r0 + r1) + (r2 + r3);
}
#define LDS_WAIT() asm volatile("s_waitcnt lgkmcnt(0)" ::: "memory")

#define XB_TMO      128
#define XB_XCNT(j)  (256  + 64 * (j))
#define XB_XSUB(j)  (1280 + 64 * (j))
#define XB_XGEN(j)  (2304 + 64 * (j))
#define XB_TOP      3328
#define XB_TOPGEN   3392
#define XCD_BAR_WORDS 3456
#define XB_SPIN_CAP (1u << 20)
__device__ __forceinline__ unsigned xb_ld(unsigned* p)              { return __hip_atomic_load(p, __ATOMIC_RELAXED, __HIP_MEMORY_SCOPE_AGENT); }
__device__ __forceinline__ unsigned xb_add(unsigned* p, unsigned v) { return __hip_atomic_fetch_add(p, v, __ATOMIC_RELAXED, __HIP_MEMORY_SCOPE_AGENT); }
__device__ __forceinline__ unsigned xb_xcc_id() { return (unsigned)__builtin_amdgcn_s_getreg((3 << 11) | 20) & 0xFu; }
#define XB_SPIN(cond, bar) do { unsigned _sp = 0; while (cond) { __builtin_amdgcn_s_sleep(1); \
    if ((++_sp & 255u) == 0u) { if (xb_ld(&(bar)[XB_TMO])) break; if (_sp > XB_SPIN_CAP) { atomicAdd(&(bar)[XB_TMO], 1u); break; } } } } while (0)
struct XcdBarrier { unsigned* bar; unsigned x; volatile LAS unsigned* st; };
__device__ __forceinline__ XcdBarrier xcd_barrier_post(unsigned* bar, volatile LAS unsigned* st) {
    XcdBarrier b; b.bar = bar; b.x = xb_xcc_id(); b.st = st;
    if (threadIdx.x == 0) (void)xb_add(&bar[XB_XCNT(b.x)], 1u);
    return b;
}
__device__ __forceinline__ void xcd_barrier_complete(unsigned* bar, unsigned x, unsigned& nloc, unsigned& nx) {
    const unsigned G = gridDim.x * gridDim.y * gridDim.z;
    unsigned sum, cnt, mine, sp = 0u;
    for (;;) {
        sum = 0u; cnt = 0u; mine = 0u;
#pragma unroll
        for (unsigned j = 0; j < 16; ++j) { const unsigned c = xb_ld(&bar[XB_XCNT(j)]); sum += c; cnt += (c > 0u) ? 1u : 0u; mine = (j == x) ? c : mine; }
        if (sum == G) break;
        __builtin_amdgcn_s_sleep(1);
        if ((++sp & 255u) == 0u) { if (xb_ld(&bar[XB_TMO])) break; if (sp > XB_SPIN_CAP) { atomicAdd(&bar[XB_TMO], 1u); break; } }
    }
    nloc = mine > 0u ? mine : 1u; nx = cnt > 0u ? cnt : 1u;
}
__device__ __forceinline__ void xcd_barrier(const XcdBarrier& b, int tid) {
    asm volatile("s_waitcnt vmcnt(0)" ::: "memory");
    __syncthreads();
    if (tid == 0) {
        unsigned* bar = b.bar;
        __builtin_amdgcn_s_waitcnt(0);
        unsigned nloc = b.st[0], nx = b.st[1];
        if (nloc == 0u) { xcd_barrier_complete(bar, b.x, nloc, nx); b.st[0] = nloc; b.st[1] = nx; }
        const unsigned old = xb_add(&bar[XB_XSUB(b.x)], 1u);
        const unsigned gen = old / nloc;
        if (old + 1u == (gen + 1u) * nloc) {
            __builtin_amdgcn_fence(__ATOMIC_RELEASE, "agent");
            asm volatile("s_waitcnt vmcnt(0)" ::: "memory");
            const unsigned og = xb_add(&bar[XB_TOP], 1u);
            const unsigned tg = og / nx;
            if (og + 1u == (tg + 1u) * nx) xb_add(&bar[XB_TOPGEN], 1u);
            else XB_SPIN(xb_ld(&bar[XB_TOPGEN]) == tg, bar);
            __builtin_amdgcn_fence(__ATOMIC_ACQUIRE, "agent");
            xb_add(&bar[XB_XGEN(b.x)], 1u);
            asm volatile("s_waitcnt vmcnt(0)" ::: "memory");
        } else {
            XB_SPIN(xb_ld(&bar[XB_XGEN(b.x)]) == gen, bar);
            __builtin_amdgcn_fence(__ATOMIC_ACQUIRE, "agent");
            asm volatile("s_waitcnt vmcnt(0)" ::: "memory");
        }
    }
    __syncthreads();
}

namespace pg8 {
constexpr int BM = 256, BK = 64, HALF = 128, HTB = HALF * BK * 2, NXCD = 8, WGM = 8;
__host__ __device__ __forceinline__ int lds_byte(int r, int c) { const int st = (r >> 4) * 2 + (c >> 5), rr = r & 15, cc = c & 31, ob = rr * 64 + cc * 2; return st * 1024 + (ob ^ (((ob >> 9) & 1) << 5)); }
__host__ __device__ __forceinline__ void stage_rc(int b, int& R, int& C) { const int st = b / 1024, sb = b % 1024, swz = sb ^ (((sb >> 9) & 1) << 5); R = (st >> 1) * 16 + swz / 64; C = (st & 1) * 32 + (swz % 64) / 2; }
__host__ __device__ __forceinline__ int perm32(int rho) { const int n = rho >> 4, i = rho & 15; return 8 * (i >> 2) + 4 * n + (i & 3); }

struct GUnit { const char* A; const char* B; unsigned lda, ldb; int nt; int pm, pn, kind; bool f8; };

__device__ __forceinline__ bool static_tile(int i, int G, int c, int nM, int nN, int& pm, int& pn) {
    const int nwg = nM * nN; const long L = (long)i * G + c; if (L >= nwg) return false;
    int wgid = (int)L; { const int q = nwg / NXCD, r = nwg % NXCD, xcd = wgid % NXCD, off = wgid / NXCD; wgid = (xcd < r ? xcd * (q + 1) : r * (q + 1) + (xcd - r) * q) + off; }
    const int nig = WGM * nN, gid = wgid / nig, fm = gid * WGM, gsz = (nM - fm) < WGM ? (nM - fm) : WGM;
    pm = fm + ((wgid % nig) % gsz); pn = (wgid % nig) / gsz; return true;
}

template <class Epi, class Sched, int F8M = 0  >
__device__ __forceinline__ void gemm_phase(LAS unsigned char* lds, const Sched& S, const Epi& E, int tid_in) {
    int tid_ = tid_in; asm volatile("" : "+v"(tid_));
    const int tid = tid_, wid = __builtin_amdgcn_readfirstlane(tid >> 6), lane = tid & 63, wr = wid >> 2, wc = wid & 3, fr = lane & 15, fq = lane >> 4;
    unsigned RA[2], RB[2], CC[2];
#pragma unroll
    for (int i = 0; i < 2; ++i) { int R, C; stage_rc(tid * 16 + i * 8192, R, C); RA[i] = (unsigned)R; RB[i] = (unsigned)((R & ~31) + perm32(R & 31)); CC[i] = (unsigned)C * 2u; }
    const size_t kstep = (size_t)(BK * 2);
    const unsigned ldsw = (unsigned)wid * 1024u;
#define PG8_SA(b, h) (((b) * 2 + (h)) * HTB)
#define PG8_SB(b, h) ((4 + (b) * 2 + (h)) * HTB)
#define PG8_STAGE(bufoff, gbase, RR, ld) do { _Pragma("unroll") for (int _i = 0; _i < 2; ++_i) \
        __builtin_amdgcn_global_load_lds((const unsigned*)((const char*)(gbase) + ((RR)[_i] * (ld) + CC[_i])), (LAS unsigned*)(lds + (bufoff) + ldsw + _i * 8192), 16, 0, 0); } while (0)
#define PG8_LDA(F8C, dst, b, h) do { _Pragma("unroll") for (int m = 0; m < 4; ++m) { dst[m][0] = *(const LAS i32x4*)(lds + PG8_SA(b, h) + ao0 + m * 2048); dst[m][1] = *(const LAS i32x4*)(lds + PG8_SA(b, h) + ao1 + m * 2048); } } while (0)
#define PG8_LDB(F8C, dst, b, h) do { _Pragma("unroll") for (int n = 0; n < 2; ++n) { dst[n][0] = *(const LAS i32x4*)(lds + PG8_SB(b, h) + bo0 + n * 2048); dst[n][1] = *(const LAS i32x4*)(lds + PG8_SB(b, h) + bo1 + n * 2048); } } while (0)
#define PG8_V8(x) __builtin_shufflevector((x)[0], (x)[1], 0, 1, 2, 3, 4, 5, 6, 7)
#define PG8_MMA(F8C, ai, bj, At, Bt) do { __builtin_amdgcn_s_setprio(1); if constexpr (F8C) { _Pragma("unroll") for (int m = 0; m < 4; ++m) _Pragma("unroll") for (int n = 0; n < 2; ++n) \
            { const v8i b8_ = PG8_V8(Bt[n]), a8_ = PG8_V8(At[m]); asm volatile("v_mfma_scale_f32_16x16x128_f8f6f4 %0, %1, %2, %0, %3, %3 op_sel_hi:[0,0,0]" : "+v"(acc[ai][bj][m][n]) : "v"(b8_), "v"(a8_), "v"(one_scale)); } } \
        else { _Pragma("unroll") for (int m = 0; m < 4; ++m) _Pragma("unroll") for (int n = 0; n < 2; ++n) _Pragma("unroll") for (int k = 0; k < 2; ++k) \
            acc[ai][bj][m][n] = __builtin_amdgcn_mfma_f32_16x16x32_bf16(__builtin_bit_cast(bf16x8, Bt[n][k]), __builtin_bit_cast(bf16x8, At[m][k]), acc[ai][bj][m][n], 0, 0, 0); } __builtin_amdgcn_s_setprio(0); } while (0)
#define PG8_TRIP(F8C, WN) { \
            const bool last = (t == nt - 2); \
            const char* a1 = cA + (size_t)(t + 1) * kstep; \
            const char* a2 = last ? nA : cA + (size_t)(t + 2) * kstep; const char* b2 = last ? nB : cB + (size_t)(t + 2) * kstep; \
            const char* a3 = a2 + kstep; const char* b3 = b2 + kstep; \
            const unsigned xldA = last ? nldA : ldA, xldB = last ? nldB : ldB; const size_t xhsA = last ? nhsA : hsA, xhsB = last ? nhsB : hsB; \
            PG8_LDB(F8C, B0, 0, 0); PG8_LDB(F8C, B1, 0, 1); PG8_SCHED; PG8_LDA(F8C, At, 0, 0); PG8_STAGE(PG8_SA(1, 1), a1 + hsA, RA, ldA); \
            PG8_WAIT_V(WN); PG8_WAIT_L(0); PG8_BAR; PG8_MMA(F8C, 0, 0, At, B0); PG8_MMA(F8C, 0, 1, At, B1); PG8_BAR; PG8_SCHED; \
            PG8_LDA(F8C, At, 0, 1); PG8_STAGE(PG8_SB(0, 0), b2, RB, xldB); PG8_STAGE(PG8_SB(0, 1), b2 + xhsB, RB, xldB); PG8_STAGE(PG8_SA(0, 0), a2, RA, xldA); \
            PG8_WAIT_V(WN); PG8_WAIT_L(0); PG8_BAR; PG8_MMA(F8C, 1, 0, At, B0); PG8_MMA(F8C, 1, 1, At, B1); PG8_BAR; PG8_SCHED; \
            PG8_LDB(F8C, B0, 1, 0); PG8_LDB(F8C, B1, 1, 1); PG8_SCHED; PG8_LDA(F8C, At, 1, 0); PG8_STAGE(PG8_SA(0, 1), a2 + xhsA, RA, xldA); \
            PG8_WAIT_V(8); PG8_WAIT_L(0); PG8_BAR; PG8_MMA(F8C, 0, 0, At, B0); PG8_MMA(F8C, 0, 1, At, B1); PG8_BAR; PG8_SCHED; \
            PG8_LDA(F8C, At, 1, 1); PG8_STAGE(PG8_SB(1, 0), b3, RB, xldB); PG8_STAGE(PG8_SB(1, 1), b3 + xhsB, RB, xldB); PG8_STAGE(PG8_SA(1, 0), a3, RA, xldA); \
            PG8_WAIT_V(8); PG8_WAIT_L(0); PG8_BAR; PG8_MMA(F8C, 1, 0, At, B0); PG8_MMA(F8C, 1, 1, At, B1); PG8_BAR; PG8_SCHED; \
        }
#define PG8_KLOOP(F8C) const int ln_ = lane_now();   \
        const int fr_ = ln_ & 15, fq_ = ln_ >> 4; \
        const int ao0 = lds_byte(wr * 64 + fr_, (F8C) ? 16 * fq_ : 8 * fq_), ao1 = (F8C) ? lds_byte(wr * 64 + fr_, 16 * fq_ + 8) : ao0 + 1024; \
        const int bo0 = lds_byte(wc * 32 + fr_, (F8C) ? 16 * fq_ : 8 * fq_), bo1 = (F8C) ? lds_byte(wc * 32 + fr_, 16 * fq_ + 8) : bo0 + 1024; \
        int t = 0; \
        if constexpr (Epi::NST == 8) { if (ui > 0) { PG8_TRIP(F8C, 16) t = 2; } } \
        for (; t < nt; t += 2) PG8_TRIP(F8C, 8)
#define PG8_WAIT_V(n) asm volatile("s_waitcnt vmcnt(" #n ")" ::: "memory")
#define PG8_WAIT_L(n) asm volatile("s_waitcnt lgkmcnt(" #n ")" ::: "memory")
#define PG8_BAR __builtin_amdgcn_s_barrier()
#define PG8_SCHED __builtin_amdgcn_sched_barrier(0)
    GUnit cur, nxt; int ui = 0;
    if (!S.next(0, cur)) return;
    f32x4 acc[2][2][4][2];
#pragma unroll
    for (int a = 0; a < 2; ++a)
#pragma unroll
        for (int b = 0; b < 2; ++b)
#pragma unroll
            for (int m = 0; m < 4; ++m)
#pragma unroll
                for (int n = 0; n < 2; ++n) acc[a][b][m][n] = (f32x4){0.f, 0.f, 0.f, 0.f};
    i32x4 At[4][2], B0[2][2], B1[2][2];
    int one_scale = 0x7F7F7F7F; asm volatile("" : "+v"(one_scale));
    const char* cA = cur.A; const char* cB = cur.B;
    unsigned ldA = cur.lda, ldB = cur.ldb; size_t hsA = (size_t)HALF * ldA, hsB = (size_t)HALF * ldB;
    PG8_STAGE(PG8_SB(0, 0), cB, RB, ldB); PG8_STAGE(PG8_SB(0, 1), cB + hsB, RB, ldB); PG8_STAGE(PG8_SA(0, 0), cA, RA, ldA); PG8_STAGE(PG8_SA(0, 1), cA + hsA, RA, ldA);
    if (wr == 1) PG8_BAR;
    PG8_WAIT_V(2); PG8_BAR;
    PG8_STAGE(PG8_SB(1, 0), cB + kstep, RB, ldB); PG8_STAGE(PG8_SA(1, 0), cA + kstep, RA, ldA); PG8_STAGE(PG8_SB(1, 1), cB + hsB + kstep, RB, ldB);
    PG8_WAIT_V(6); PG8_BAR;
    for (;;) {
        const bool has_next = S.next(ui + 1, nxt);
        const char* nA = has_next ? nxt.A : cA; const char* nB = has_next ? nxt.B : cB;
        const unsigned nldA = has_next ? nxt.lda : ldA, nldB = has_next ? nxt.ldb : ldB;
        const size_t nhsA = (size_t)HALF * nldA, nhsB = (size_t)HALF * nldB;
        const int nt = cur.nt;
        if constexpr (F8M == 2) { if (cur.f8) { PG8_KLOOP(true) } else { PG8_KLOOP(false) } }
        else if constexpr (F8M == 1) { PG8_KLOOP(true) }
        else { PG8_KLOOP(false) }
        if (wr == 0) PG8_BAR;
        if constexpr (F8M != 0) asm volatile("s_nop 15\n\ts_nop 15" ::: "memory");
        { const int le_ = lane_now(); E(acc, cur, (wid << 6) | le_, wr, wc, le_ & 15, le_ >> 4); }
        if (!has_next) break;
#pragma unroll
        for (int a = 0; a < 2; ++a)
#pragma unroll
            for (int b = 0; b < 2; ++b)
#pragma unroll
                for (int m = 0; m < 4; ++m)
#pragma unroll
                    for (int n = 0; n < 2; ++n) acc[a][b][m][n] = (f32x4){0.f, 0.f, 0.f, 0.f};
        cur = nxt; cA = nA; cB = nB; hsA = nhsA; hsB = nhsB; ldA = nldA; ldB = nldB; ++ui;
        if (wr == 1) PG8_BAR;
    }
    PG8_WAIT_V(0);
    PG8_BAR;
#undef PG8_SA
#undef PG8_SB
#undef PG8_STAGE
#undef PG8_LDA
#undef PG8_KLOOP
#undef PG8_TRIP
#undef PG8_V8
#undef PG8_LDB
#undef PG8_MMA
#undef PG8_WAIT_V
#undef PG8_WAIT_L
#undef PG8_BAR
#undef PG8_SCHED
}
}
using pg8::GUnit;
typedef f32x4 Acc[2][2][4][2];

struct Params {
    const float* in[33];
    float* out;
    unsigned char* ws;
    int ph_lo, ph_hi;
};
enum { I_X = 0, I_C, I_CTX, I_CCTX, I_WMOD, I_BMOD, I_PLG, I_PLB, I_FWI, I_FWO, I_WIN, I_BIN, I_CDW, I_CDB, I_CLG, I_CLB, I_CWP, I_RPB, I_NWP, I_SCW, I_SWP,
       I_HSW, I_HSB, I_HW1, I_HB1, I_HW2, I_HB2, I_HFQ, I_HW3, I_HBI, I_HWP, I_WOUT, I_BOUT };

__device__ __forceinline__ int row_grp(int pm) { return pm < 64 ? 0 : (pm < 128 ? 1 : 2); }

struct SchedPlain {
    const char* A; const char* B; unsigned lda, ldb; int nt, nM, nN, G, c;
    __device__ __forceinline__ bool next(int i, GUnit& u) const {
        int pm, pn; if (!pg8::static_tile(i, G, c, nM, nN, pm, pn)) return false;
        u.A = A + (size_t)pm * 256 * lda; u.B = B + (size_t)pn * 256 * ldb; u.lda = lda; u.ldb = ldb; u.nt = nt; u.pm = pm; u.pn = pn; u.kind = 0; u.f8 = true; return true;
    }
};
template <int NKS, int NSRC, int NTLAST = 4> struct SchedResid {
    const char* A; const char* B; unsigned ld; int nt, G, c; bool ctx; const char* Ac;
    __device__ __forceinline__ bool next(int i, GUnit& u) const {
        int pm, pn; u.lda = ld; u.ldb = ld; u.f8 = true;
        if (pg8::static_tile(i, G, c, TL / 256, 4, pm, pn)) { u.A = A + (size_t)pm * 256 * ld; u.B = B + (size_t)pn * 256 * ld; u.nt = nt; u.pm = pm; u.pn = pn; u.kind = 0; return true; }
        constexpr int NK = NKS * NSRC;
        const int j = i * G + c - (TL / 256) * 4; if (!ctx || j < 0 || j >= 8 * NK) return false;
        const int panel = j / (4 * NK), rem = j % (4 * NK), kk = rem % NK, src = kk / NKS, ks = kk % NKS; pn = rem / NK;
        u.A = Ac + ((size_t)src * TC + panel * 256) * ld + ks * 512; u.B = B + (size_t)pn * 256 * ld + ks * 512; u.nt = (ks == NKS - 1) ? NTLAST : 4; u.pm = TL / 256 + panel; u.pn = pn; u.kind = 1 + kk; return true;
    }
};
enum { KI_GLU = 0, KI_PLAIN = 1, KI_PAIR = 2, KI_TRANS = 3 };
struct SchedInproj {
    const char* ws; int l, nM, G, c;
    __device__ __forceinline__ bool next(int i, GUnit& u) const {
        int pm, pn; if (!pg8::static_tile(i, G, c, nM, 11, pm, pn)) return false;
        const bool tr = (pn == 4) || (pn >= 8), f8 = pn < 8;
        const char* a; const char* b;
        if (f8) { a = (pm < TL / 256) ? ws + WS_H8L + (size_t)pm * 256 * 1024 : ws + WS_H8C + (size_t)(pm - TL / 256) * 256 * 1024; b = ws + WS_WIT + ((size_t)l * PIN + NINP) * D * 2 + 6 * MiB + (size_t)pn * 256 * 1024; u.lda = 1024; u.ldb = 1024; u.nt = 8; }
        else { a = ws + WS_H + (size_t)pm * 256 * 2048; b = ws + WS_WIT + (size_t)l * PIN * D * 2 + (size_t)pn * 256 * 2048; u.lda = 2048; u.ldb = 2048; u.nt = 16; }
        u.A = tr ? b : a; u.B = tr ? a : b; u.pm = pm; u.pn = pn; u.f8 = f8;
        u.kind = tr ? KI_TRANS : (pn < 2 ? KI_GLU : (pn == 6 || pn == 7 ? KI_PAIR : KI_PLAIN)); return true;
    }
};
struct SchedGateBr {
    const char* HB  ; const char* H; const char* HC  ; const char* WG  ; const char* BR; const char* WP; int G, c; bool ctx;
    __device__ __forceinline__ bool next(int i, GUnit& u) const {
        int pm, pn, j, br;
        if (pg8::static_tile(i >> 3, G, c, TL / 256, 4, pm, pn)) { j = i & 7; br = j >> 1; }
        else {
            const int ntl = ((TL / 256) * 4 - c + G - 1) / G, e = i - 8 * ntl;
            if (!ctx || c >= 32 || e < 0 || e > 1) return false;
            pm = TL / 256 + (c >> 4); pn = (c >> 2) & 3; br = c & 3; j = 8 + 2 * br + e;
        }
        if ((j & 1) == 0) { u.A = (pm < TL / 256) ? H + (size_t)pm * 256 * 1024 : HC + (size_t)(pm - TL / 256) * 256 * 1024; u.B = WG + (size_t)(br * 1024 + pn * 256) * 1024; u.lda = 1024; u.ldb = 1024; u.nt = 8; u.f8 = true; }
        else { u.A = BR + (size_t)br * SZ256 + (size_t)pm * 256 * 512; u.B = WP + (size_t)(br * 1024 + pn * 256) * 512; u.lda = 512; u.ldb = 512; u.nt = 4; u.f8 = false; }
        u.pm = pm; u.pn = pn; u.kind = j; return true;
    }
};

struct EpiFfnUp {
    static constexpr bool DUP_OK = true; static constexpr int NST = 8;
    unsigned char* U;
    __device__ __forceinline__ void operator()(const Acc& acc, const GUnit& u, int tid, int wr, int wc, int fr, int fq) const {
        const int row0 = u.pm * 256 + wr * 64 + fr, col0 = u.pn * 128 + wc * 32 + 8 * fq;
        constexpr float IS = 1.0f / W1_SCALE;
#pragma unroll
        for (int ai = 0; ai < 2; ++ai)
#pragma unroll
            for (int m = 0; m < 4; ++m) {
                const f32x4 a0 = acc[ai][0][m][0] * IS, a1 = acc[ai][0][m][1] * IS, g0 = acc[ai][1][m][0] * IS, g1 = acc[ai][1][m][1] * IS;
                u32x2 w; w.x = pk_fp8x4(siluf_(g0[0]) * a0[0], siluf_(g0[1]) * a0[1], siluf_(g0[2]) * a0[2], siluf_(g0[3]) * a0[3]);
                w.y = pk_fp8x4(siluf_(g1[0]) * a1[0], siluf_(g1[1]) * a1[1], siluf_(g1[2]) * a1[2], siluf_(g1[3]) * a1[3]);
                *(u32x2*)(U + (size_t)(row0 + ai * 128 + m * 16) * DFF + col0) = w;
            }
    }
};
struct EpiRes {
    static constexpr bool DUP_OK = false; static constexpr int NST = 0;
    bf16* V; const void* xl; bool xbf  ; const float* modl  ; const float* bias; float coef; float* part;
    const float* xstat; const float* xg; const float* xbt;
    __device__ __forceinline__ void operator()(const Acc& acc, const GUnit& u, int tid, int wr, int wc, int fr, int fq) const {
        int row0 = u.pm * 256 + wr * 64 + fr, colt = u.pn * 256 + wc * 32 + 8 * fq; asm volatile("" : "+v"(row0), "+v"(colt));
        if (u.kind != 0) {
            float* pp = part + ((size_t)(u.kind - 1) * TC + (row0 - TL)) * D + colt;
#pragma unroll
            for (int ai = 0; ai < 2; ++ai)
#pragma unroll
                for (int m = 0; m < 4; ++m)
#pragma unroll
                    for (int bj = 0; bj < 2; ++bj) { float* q = pp + (size_t)(ai * 128 + m * 16) * D + bj * 128; *(f32x4*)q = acc[ai][bj][m][0]; *(f32x4*)(q + 4) = acc[ai][bj][m][1]; }
            return;
        }
        if (xstat) body_ln(acc, u, row0, colt); else if (xbf) body<true>(acc, u, row0, colt); else body<false>(acc, u, row0, colt);
    }
    template <bool XB> __device__ __forceinline__ void body(const Acc& acc, const GUnit& u, int row0, int colt) const {
        const float* mv = modl + (size_t)row_grp(u.pm) * 9216;
        f32x4 sc[2][2], bv[2][2];
#pragma unroll
        for (int bj = 0; bj < 2; ++bj)
#pragma unroll
            for (int n = 0; n < 2; ++n) { sc[bj][n] = *(const f32x4*)(mv + colt + bj * 128 + 4 * n) * coef;
                bv[bj][n] = bias ? *(const f32x4*)(bias + colt + bj * 128 + 4 * n) : (f32x4){0.f, 0.f, 0.f, 0.f}; }
#pragma unroll
        for (int ai = 0; ai < 2; ++ai) {
            bf16* vp = V + (size_t)(row0 + ai * 128) * D + colt;
            if constexpr (XB) {
                const bf16* xh = (const bf16*)xl + (size_t)(row0 + ai * 128) * D + colt;
                u32x4 xw[4][2];
#pragma unroll
                for (int m = 0; m < 4; ++m)
#pragma unroll
                    for (int bj = 0; bj < 2; ++bj) xw[m][bj] = *(const u32x4*)(xh + (size_t)(m * 16) * D + bj * 128);
#pragma unroll
                for (int m = 0; m < 4; ++m)
#pragma unroll
                    for (int bj = 0; bj < 2; ++bj) { const u32x4 w_ = xw[m][bj];
                        const f32x4 x0 = (f32x4){bflo(w_.x), bfhi(w_.x), bflo(w_.y), bfhi(w_.y)}, x1 = (f32x4){bflo(w_.z), bfhi(w_.z), bflo(w_.w), bfhi(w_.w)};
                        const f32x4 v0 = x0 * ALPHA + sc[bj][0] * (acc[ai][bj][m][0] + bv[bj][0]), v1 = x1 * ALPHA + sc[bj][1] * (acc[ai][bj][m][1] + bv[bj][1]);
                        u32x4 w; w.x = cvt_pk_bf16(v0[0], v0[1]); w.y = cvt_pk_bf16(v0[2], v0[3]); w.z = cvt_pk_bf16(v1[0], v1[1]); w.w = cvt_pk_bf16(v1[2], v1[3]);
                        *(u32x4*)(vp + (size_t)(m * 16) * D + bj * 128) = w; }
            } else {
                const float* xb = (const float*)xl + (size_t)(row0 + ai * 128) * D + colt;
#pragma unroll
                for (int mh = 0; mh < 2; ++mh) {
                    f32x4 xf[2][2][2];
#pragma unroll
                    for (int mm = 0; mm < 2; ++mm)
#pragma unroll
                        for (int bj = 0; bj < 2; ++bj) { const float* q = xb + (size_t)((mh * 2 + mm) * 16) * D + bj * 128; xf[mm][bj][0] = *(const f32x4*)q; xf[mm][bj][1] = *(const f32x4*)(q + 4); }
#pragma unroll
                    for (int mm = 0; mm < 2; ++mm)
#pragma unroll
                        for (int bj = 0; bj < 2; ++bj) { const int m = mh * 2 + mm;
                            const f32x4 v0 = xf[mm][bj][0] * ALPHA + sc[bj][0] * (acc[ai][bj][m][0] + bv[bj][0]), v1 = xf[mm][bj][1] * ALPHA + sc[bj][1] * (acc[ai][bj][m][1] + bv[bj][1]);
                            u32x4 w; w.x = cvt_pk_bf16(v0[0], v0[1]); w.y = cvt_pk_bf16(v0[2], v0[3]); w.z = cvt_pk_bf16(v1[0], v1[1]); w.w = cvt_pk_bf16(v1[2], v1[3]);
                            *(u32x4*)(vp + (size_t)(m * 16) * D + bj * 128) = w; }
                    asm volatile("" ::: "memory");
                }
            }
            asm volatile("" ::: "memory");
        }
    }
    __device__ __forceinline__ void body_ln(const Acc& acc, const GUnit& u, int row0, int colt) const {
        const float* mv = modl + (size_t)row_grp(u.pm) * 9216;
#pragma unroll
        for (int bj = 0; bj < 2; ++bj) {
            f32x4 sc[2], gg[2], bb[2], bv[2];
#pragma unroll
            for (int n = 0; n < 2; ++n) { sc[n] = *(const f32x4*)(mv + colt + bj * 128 + 4 * n) * coef; gg[n] = *(const f32x4*)(xg + colt + bj * 128 + 4 * n); bb[n] = *(const f32x4*)(xbt + colt + bj * 128 + 4 * n);
                bv[n] = bias ? *(const f32x4*)(bias + colt + bj * 128 + 4 * n) : (f32x4){0.f, 0.f, 0.f, 0.f}; }
#pragma unroll
            for (int ai = 0; ai < 2; ++ai) {
                bf16* vp = V + (size_t)(row0 + ai * 128) * D + colt + bj * 128; const bf16* xp = (const bf16*)xl + (size_t)(row0 + ai * 128) * D + colt + bj * 128;
                u32x4 xw[4]; f32x2 st[4];
#pragma unroll
                for (int m = 0; m < 4; ++m) { st[m] = *(const f32x2*)(xstat + (size_t)(row0 + ai * 128 + m * 16) * 2); xw[m] = *(const u32x4*)(xp + (size_t)(m * 16) * D); }
#pragma unroll
                for (int m = 0; m < 4; ++m) { const u32x4 w_ = xw[m]; const float mu = st[m].x, rs = st[m].y;
                    const f32x4 x0 = ((f32x4){bflo(w_.x), bfhi(w_.x), bflo(w_.y), bfhi(w_.y)} - mu) * (gg[0] * rs) + bb[0], x1 = ((f32x4){bflo(w_.z), bfhi(w_.z), bflo(w_.w), bfhi(w_.w)} - mu) * (gg[1] * rs) + bb[1];
                    const f32x4 v0 = x0 * ALPHA + sc[0] * (acc[ai][bj][m][0] + bv[0]), v1 = x1 * ALPHA + sc[1] * (acc[ai][bj][m][1] + bv[1]);
                    u32x4 w; w.x = cvt_pk_bf16(v0[0], v0[1]); w.y = cvt_pk_bf16(v0[2], v0[3]); w.z = cvt_pk_bf16(v1[0], v1[1]); w.w = cvt_pk_bf16(v1[2], v1[3]);
                    *(u32x4*)(vp + (size_t)(m * 16) * D) = w; }
                asm volatile("" ::: "memory");
            }
        }
    }
};
struct EpiInproj {
    static constexpr bool DUP_OK = false; static constexpr int NST = 0;
    const float* bin;
    unsigned char* ws;
    __device__ __forceinline__ void operator()(const Acc& acc, const GUnit& u, int tid, int wr, int wc, int fr, int fq) const {
        bf16* const UA = (bf16*)(ws + WS_UA); bf16* const Q = (bf16*)(ws + WS_Q); bf16* const K = (bf16*)(ws + WS_K); bf16* const SB = (bf16*)(ws + WS_SB);
        bf16* const W = (bf16*)(ws + WS_W); bf16* const VT = (bf16*)(ws + WS_VT); bf16* const HT = (bf16*)(ws + WS_HT);
        int c8 = wc * 32 + 8 * fq; asm volatile("" : "+v"(c8));
        const float IS = u.f8 ? (1.0f / W1_SCALE) : 1.0f;
        if (u.kind == KI_TRANS) {
            bf16* dst = (u.pn == 4) ? VT : HT + (size_t)(u.pn - 8) * 256 * MT;
            const int r0 = wr * 64 + fr;
#pragma unroll
            for (int ai = 0; ai < 2; ++ai)
#pragma unroll
                for (int m = 0; m < 4; ++m) {
                    const int r = r0 + ai * 128 + m * 16; const float b = bin[u.pn * 256 + r];
#pragma unroll
                    for (int bj = 0; bj < 2; ++bj) {
                        const f32x4 v0 = acc[ai][bj][m][0] * IS + b, v1 = acc[ai][bj][m][1] * IS + b;
                        u32x4 w; w.x = cvt_pk_bf16(v0[0], v0[1]); w.y = cvt_pk_bf16(v0[2], v0[3]); w.z = cvt_pk_bf16(v1[0], v1[1]); w.w = cvt_pk_bf16(v1[2], v1[3]);
                        *(u32x4*)(dst + (size_t)r * MT + u.pm * 256 + bj * 128 + c8) = w;
                    }
                }
            return;
        }
        const int row0 = u.pm * 256 + wr * 64 + fr;
        f32x4 bv[2][2];
#pragma unroll
        for (int bj = 0; bj < 2; ++bj)
#pragma unroll
            for (int n = 0; n < 2; ++n) bv[bj][n] = *(const f32x4*)(bin + u.pn * 256 + bj * 128 + c8 + 4 * n);
        if (u.kind == KI_PLAIN) {
            bf16* dst = (u.pn == 2) ? Q : (u.pn == 3 ? K : SB); const float scl = (u.pn == 2) ? ATT_SCALE * 1.44269504089f : 1.0f;
#pragma unroll
            for (int ai = 0; ai < 2; ++ai)
#pragma unroll
                for (int m = 0; m < 4; ++m)
#pragma unroll
                    for (int bj = 0; bj < 2; ++bj) {
                        const f32x4 v0 = (acc[ai][bj][m][0] * IS + bv[bj][0]) * scl, v1 = (acc[ai][bj][m][1] * IS + bv[bj][1]) * scl;
                        u32x4 w; w.x = cvt_pk_bf16(v0[0], v0[1]); w.y = cvt_pk_bf16(v0[2], v0[3]); w.z = cvt_pk_bf16(v1[0], v1[1]); w.w = cvt_pk_bf16(v1[2], v1[3]);
                        *(u32x4*)(dst + (size_t)(row0 + ai * 128 + m * 16) * 256 + bj * 128 + c8) = w;
                    }
            return;
        }
        const bool glu = (u.kind == KI_GLU);
        bf16* dst = glu ? UA + u.pn * 128 : W + (u.pn - 6) * 128;
#pragma unroll
        for (int ai = 0; ai < 2; ++ai)
#pragma unroll
            for (int m = 0; m < 4; ++m) {
                f32x4 a0 = acc[ai][0][m][0] * IS + bv[0][0], a1 = acc[ai][0][m][1] * IS + bv[0][1], g0 = acc[ai][1][m][0] * IS + bv[1][0], g1 = acc[ai][1][m][1] * IS + bv[1][1];
                if (glu) {
#pragma unroll
                    for (int j = 0; j < 4; ++j) { g0[j] = sigmoidf_(g0[j]); g1[j] = sigmoidf_(g1[j]); }
                }
                const f32x4 v0 = a0 * g0, v1 = a1 * g1;
                u32x4 w; w.x = cvt_pk_bf16(v0[0], v0[1]); w.y = cvt_pk_bf16(v0[2], v0[3]); w.z = cvt_pk_bf16(v1[0], v1[1]); w.w = cvt_pk_bf16(v1[2], v1[3]);
                *(u32x4*)(dst + (size_t)(row0 + ai * 128 + m * 16) * 256 + c8) = w;
            }
    }
};
__device__ __forceinline__ unsigned pk_u8x4(f32x4 v) { const unsigned a = (unsigned)(v[0] * 255.0f + 0.5f), b = (unsigned)(v[1] * 255.0f + 0.5f), c = (unsigned)(v[2] * 255.0f + 0.5f), d = (unsigned)(v[3] * 255.0f + 0.5f); return a | (b << 8) | (c << 16) | (d << 24); }
struct EpiGateBr {
    static constexpr bool DUP_OK = false; static constexpr int NST = 0;
    const float* bing;
    unsigned char* gs;
    bf16* MG; bf16* MI;
    __device__ __forceinline__ void operator()(const Acc& acc, const GUnit& u, int tid, int wr, int wc, int fr, int fq) const {
        const int br = (u.kind >> 1) & 3; const bool cjob = (u.kind & 8) != 0;
        unsigned so = (unsigned)tid * 16u; asm volatile("" : "+v"(so));
        const unsigned mo = so * 2u;
        if ((u.kind & 1) == 0) {
            const float* bb = bing + br * 1024 + u.pn * 256 + wc * 32 + 8 * fq;
            f32x4 bv[2][2];
#pragma unroll
            for (int bj = 0; bj < 2; ++bj)
#pragma unroll
                for (int n = 0; n < 2; ++n) bv[bj][n] = *(const f32x4*)(bb + bj * 128 + 4 * n);
            unsigned char* sp = gs;
#pragma unroll
            for (int ai = 0; ai < 2; ++ai)
#pragma unroll
                for (int m = 0; m < 4; ++m)
#pragma unroll
                    for (int bj = 0; bj < 2; ++bj) {
                        const float gs_ = u.f8 ? (1.0f / W1_SCALE) : 1.0f; f32x4 v0 = acc[ai][bj][m][0] * gs_ + bv[bj][0], v1 = acc[ai][bj][m][1] * gs_ + bv[bj][1];
#pragma unroll
                        for (int j = 0; j < 4; ++j) { v0[j] = sigmoidf_(v0[j]); v1[j] = sigmoidf_(v1[j]); }
                        u32x2 w; w.x = pk_u8x4(v0); w.y = pk_u8x4(v1);
                        *(u32x2*)(sp + (so >> 1)) = w; sp += 4096;
                    }
        } else {
            unsigned lo = (unsigned)(((wr * 64 + fr) * D + u.pn * 256 + wc * 32 + 8 * fq) * 2); asm volatile("" : "+v"(lo));
            unsigned char* op = cjob ? (unsigned char*)(MI + ((size_t)br * TC + (u.pm - TL / 256) * 256) * D) : (unsigned char*)(MG + (size_t)u.pm * 256 * D);
            const bool ldm = (br > 0 && !cjob), stm = (br < 3 && !cjob);
            if (ldm) { if (stm) branch<true, true>(acc, so, mo, lo, op); else branch<true, false>(acc, so, mo, lo, op); }
            else { if (stm) branch<false, true>(acc, so, mo, lo, op); else branch<false, false>(acc, so, mo, lo, op); }
        }
    }
    template <bool LDM, bool STM> __device__ __forceinline__ void branch(const Acc& acc, unsigned so, unsigned mo, unsigned lo, unsigned char* op) const {
        const unsigned char* sp = gs; unsigned char* mp = gs + 131072;
        u32x2 s[3][2]; u32x4 mw[3][2];
#define GB_U(ptr_) ({ auto q_ = (ptr_); asm volatile("" : "+s"(q_)); q_; })
#define GB_LOAD(t_) do { _Pragma("unroll") for (int k = 0; k < 2; ++k) { s[(t_) % 3][k] = *(const u32x2*)(GB_U(sp + ((t_) * 2 + k) * 4096) + (so >> 1)); \
            if (LDM) mw[(t_) % 3][k] = *(const u32x4*)(GB_U(mp + ((t_) * 2 + k) * 8192) + so); else mw[(t_) % 3][k] = (u32x4){0u, 0u, 0u, 0u}; } } while (0)
        GB_LOAD(0); GB_LOAD(1);
#pragma unroll
        for (int t = 0; t < 8; ++t) { const int ai = t >> 2, m = t & 3, p = t % 3;
            if (t < 6) GB_LOAD(t + 2);
#pragma unroll
            for (int k = 0; k < 2; ++k) { const int bj = k;
                const f32x4 y0 = acc[ai][bj][m][0], y1 = acc[ai][bj][m][1]; const u32x2 sk = s[p][k]; const u32x4 mk = mw[p][k]; f32x4 a0 = (f32x4){bflo(mk.x), bfhi(mk.x), bflo(mk.y), bfhi(mk.y)}, a1 = (f32x4){bflo(mk.z), bfhi(mk.z), bflo(mk.w), bfhi(mk.w)};
                a0[0] += (float)((sk.x >> 0) & 0xffu) * y0[0]; a0[1] += (float)((sk.x >> 8) & 0xffu) * y0[1]; a0[2] += (float)((sk.x >> 16) & 0xffu) * y0[2]; a0[3] += (float)((sk.x >> 24) & 0xffu) * y0[3];
                a1[0] += (float)((sk.y >> 0) & 0xffu) * y1[0]; a1[1] += (float)((sk.y >> 8) & 0xffu) * y1[1]; a1[2] += (float)((sk.y >> 16) & 0xffu) * y1[2]; a1[3] += (float)((sk.y >> 24) & 0xffu) * y1[3];
                if (!STM) { a0 = a0 * (1.0f / 255.0f); a1 = a1 * (1.0f / 255.0f); }
                u32x4 w; w.x = cvt_pk_bf16(a0[0], a0[1]); w.y = cvt_pk_bf16(a0[2], a0[3]); w.z = cvt_pk_bf16(a1[0], a1[1]); w.w = cvt_pk_bf16(a1[2], a1[3]);
                if (STM) *(u32x4*)(GB_U(mp + (t * 2 + k) * 8192) + so) = w;
                else *(u32x4*)(op + (size_t)(ai * 128 + m * 16) * D * 2 + lo + bj * 256) = w; }
            asm volatile("" ::: "memory");
        }
#undef GB_LOAD
#undef GB_U
    }
};

struct Frame {
    LAS unsigned char* lds;
    int tid, lane, wave, bid, G;
    unsigned char* ws;
};

__device__ __forceinline__ void transpose_item(const float* W, int K, int N, int src_col0, bf16* WT, int dst_row0, LAS float* scr, int kb, int lane) {
    const int k0 = 64 * kb;
    float tv[32];
#pragma unroll
    for (int i = 0; i < 32; ++i) { const int kk = 2 * i + (lane >> 5); tv[i] = W[(size_t)(k0 + kk) * N + src_col0 + (lane & 31)]; }
#pragma unroll
    for (int i = 0; i < 32; ++i) { const int kk = 2 * i + (lane >> 5); scr[kk * 33 + (lane & 31)] = tv[i]; }
    LDS_WAIT(); asm volatile("" ::: "memory");
    const int c = lane & 7;
#pragma unroll
    for (int j = 0; j < 4; ++j) { const int n = (lane >> 3) + 8 * j; const LAS float* s = scr + (8 * c) * 33 + n;
        u32x4 o; o.x = cvt_pk_bf16(s[0 * 33], s[1 * 33]); o.y = cvt_pk_bf16(s[2 * 33], s[3 * 33]); o.z = cvt_pk_bf16(s[4 * 33], s[5 * 33]); o.w = cvt_pk_bf16(s[6 * 33], s[7 * 33]);
        *(u32x4*)(WT + (size_t)(dst_row0 + n) * K + k0 + 8 * c) = o; }
    LDS_WAIT(); asm volatile("" ::: "memory");
}
__device__ __forceinline__ void transpose_item8(const float* W, int K, int N, int src_col0, unsigned char* WT, int dst_row0, LAS float* scr, int kb, int lane, float wscale) {
    const int k0 = 64 * kb;
    float tv[32];
#pragma unroll
    for (int i = 0; i < 32; ++i) { const int kk = 2 * i + (lane >> 5); tv[i] = W[(size_t)(k0 + kk) * N + src_col0 + (lane & 31)]; }
#pragma unroll
    for (int i = 0; i < 32; ++i) { const int kk = 2 * i + (lane >> 5); scr[kk * 33 + (lane & 31)] = tv[i]; }
    LDS_WAIT(); asm volatile("" ::: "memory");
    const int n = lane >> 1, hf = lane & 1; const LAS float* s = scr + (32 * hf) * 33 + n;
    u32x4 o0, o1;
    o0.x = pk_fp8x4(s[0 * 33] * wscale, s[1 * 33] * wscale, s[2 * 33] * wscale, s[3 * 33] * wscale); o0.y = pk_fp8x4(s[4 * 33] * wscale, s[5 * 33] * wscale, s[6 * 33] * wscale, s[7 * 33] * wscale);
    o0.z = pk_fp8x4(s[8 * 33] * wscale, s[9 * 33] * wscale, s[10 * 33] * wscale, s[11 * 33] * wscale); o0.w = pk_fp8x4(s[12 * 33] * wscale, s[13 * 33] * wscale, s[14 * 33] * wscale, s[15 * 33] * wscale);
    o1.x = pk_fp8x4(s[16 * 33] * wscale, s[17 * 33] * wscale, s[18 * 33] * wscale, s[19 * 33] * wscale); o1.y = pk_fp8x4(s[20 * 33] * wscale, s[21 * 33] * wscale, s[22 * 33] * wscale, s[23 * 33] * wscale);
    o1.z = pk_fp8x4(s[24 * 33] * wscale, s[25 * 33] * wscale, s[26 * 33] * wscale, s[27 * 33] * wscale); o1.w = pk_fp8x4(s[28 * 33] * wscale, s[29 * 33] * wscale, s[30 * 33] * wscale, s[31 * 33] * wscale);
    u32x4* dst = (u32x4*)(WT + (size_t)(dst_row0 + n) * K + k0 + 32 * hf); dst[0] = o0; dst[1] = o1;
    LDS_WAIT(); asm volatile("" ::: "memory");
}
__host__ __device__ __forceinline__ int inmap(int r) {
    if (r >= NINP) return r;
    const int t = r >> 8, cc = r & 255;
    if (t < 2) return cc < 128 ? 128 * t + cc : 256 + 128 * t + cc - 128;
    if (t < 6) return 256 * t + cc;
    if (t < 8) { const int p = t - 6; return cc < 128 ? 1536 + 128 * p + cc : 1792 + 128 * p + cc - 128; }
    return 2048 + 256 * (t - 8) + cc;
}
__device__ __forceinline__ void prologue_a(Frame& F, const Params& P) {
    LAS float* scr = (LAS float*)(F.lds + F.wave * 16384);
    const int gw = F.bid * NWAVES + F.wave, NGW = F.G * NWAVES;
    constexpr int I1 = 16 * 176, I2 = 44 * 32, I3 = 16 * 216, I4 = 4 * 32, I5 = 16 * 32;
    constexpr int I6 = 32;
    constexpr int NIT = 4 * I1 + 4 * I2 + 2 * I3 + 8 * I4 + 2 * I5 + 2 * I6;
    struct TI { const float* W; unsigned char* dst; int N, K, sc, drow, kb; bool f8; float scale; };
    auto decode = [&](int it, TI& t) {
        int r = it;
        if (r < 4 * I1) { const int mi = r / I1; r %= I1; const int kb = r / 176, nb = r % 176, d0 = nb * 32, pn = d0 >> 8, cc = d0 & 255;
            t = TI{P.in[I_FWI] + (size_t)mi * D * NFF, F.ws + WS_W1T + (size_t)mi * NFF * D, NFF, D, cc < 128 ? 128 * pn + cc : DFF + 128 * pn + cc - 128, d0, kb, true, W1_SCALE}; return; }
        r -= 4 * I1;
        if (r < 4 * I2) { const int mi = r / I2; r %= I2; const int kb = r / 32, nb = r % 32;
            t = TI{P.in[I_FWO] + (size_t)mi * DFF * D, F.ws + WS_W2T + (size_t)mi * D * DFF, D, DFF, nb * 32, nb * 32, kb, true, W2_SCALE}; return; }
        r -= 4 * I2;
        if (r < 2 * I3) { const int mi = r / I3; r %= I3; const int kb = r / 216, nb = r % 216; const float* W = P.in[I_WIN] + (size_t)mi * D * PIN;
            if (nb * 32 >= NINP) t = TI{W, F.ws + WS_WIT + ((size_t)mi * PIN + NINP) * D * 2, PIN, D, inmap(nb * 32), nb * 32 - NINP, kb, true, W1_SCALE};
            else if (nb * 32 < 2048) t = TI{W, F.ws + WS_WIT + ((size_t)mi * PIN + NINP) * D * 2 + 6 * MiB, PIN, D, inmap(nb * 32), nb * 32, kb, true, W1_SCALE};
            else t = TI{W, F.ws + WS_WIT + (size_t)mi * PIN * D * 2, PIN, D, inmap(nb * 32), nb * 32, kb, false, 1.f};
            return; }
        r -= 2 * I3;
        if (r < 8 * I4) { const int mi = r / I4; r %= I4; const int l = mi >> 2, br = mi & 3, kb = r / 32, nb = r % 32;
            t = TI{P.in[br == 0 ? I_CWP : (br == 1 ? I_NWP : (br == 2 ? I_SWP : I_HWP))] + (size_t)l * 256 * D, F.ws + WS_WPT + (size_t)mi * D * 256 * 2, D, 256, nb * 32, nb * 32, kb, false, 1.f}; return; }
        r -= 8 * I4;
        if (r < 2 * I5) { const int mi = r / I5; r %= I5; const int kb = r / 32, nb = r % 32;
            t = TI{P.in[I_WOUT] + (size_t)mi * D * D, F.ws + WS_WOT + (size_t)mi * D * D * 2, D, D, nb * 32, nb * 32, kb, false, 1.f}; return; }
        r -= 2 * I5;
        { const int mi = r / I6, nb = r % I6; t = TI{P.in[I_HW3] + (size_t)mi * 64 * 1024, F.ws + WS_W3T + (size_t)mi * 1024 * 64 * 2, 1024, 64, nb * 32, nb * 32, 0, false, 1.f}; }
    };
    {
        const int lane = F.lane;
        TI dA, dB; float tvA[32], tvB[32];
#define PRO_LOAD(d_, tv_) do { _Pragma("unroll") for (int i = 0; i < 32; ++i) tv_[i] = d_.W[(size_t)(64 * d_.kb + 2 * i + (lane >> 5)) * d_.N + d_.sc + (lane & 31)]; } while (0)
#define PRO_SCR(tv_) do { _Pragma("unroll") for (int i = 0; i < 32; ++i) scr[(2 * i + (lane >> 5)) * 33 + (lane & 31)] = tv_[i]; } while (0)
        auto emit = [&](const TI& cur) {
            const int k0 = 64 * cur.kb;
            if (cur.f8) { const int n = lane >> 1, hf = lane & 1; const LAS float* s = scr + (32 * hf) * 33 + n; const float ws_ = cur.scale;
                u32x4 o0, o1;
                o0.x = pk_fp8x4(s[0 * 33] * ws_, s[1 * 33] * ws_, s[2 * 33] * ws_, s[3 * 33] * ws_); o0.y = pk_fp8x4(s[4 * 33] * ws_, s[5 * 33] * ws_, s[6 * 33] * ws_, s[7 * 33] * ws_);
                o0.z = pk_fp8x4(s[8 * 33] * ws_, s[9 * 33] * ws_, s[10 * 33] * ws_, s[11 * 33] * ws_); o0.w = pk_fp8x4(s[12 * 33] * ws_, s[13 * 33] * ws_, s[14 * 33] * ws_, s[15 * 33] * ws_);
                o1.x = pk_fp8x4(s[16 * 33] * ws_, s[17 * 33] * ws_, s[18 * 33] * ws_, s[19 * 33] * ws_); o1.y = pk_fp8x4(s[20 * 33] * ws_, s[21 * 33] * ws_, s[22 * 33] * ws_, s[23 * 33] * ws_);
                o1.z = pk_fp8x4(s[24 * 33] * ws_, s[25 * 33] * ws_, s[26 * 33] * ws_, s[27 * 33] * ws_); o1.w = pk_fp8x4(s[28 * 33] * ws_, s[29 * 33] * ws_, s[30 * 33] * ws_, s[31 * 33] * ws_);
                u32x4* dst = (u32x4*)(cur.dst + (size_t)(cur.drow + n) * cur.K + k0 + 32 * hf); dst[0] = o0; dst[1] = o1; }
            else { const int c = lane & 7;
#pragma unroll
                for (int j = 0; j < 4; ++j) { const int n = (lane >> 3) + 8 * j; const LAS float* s = scr + (8 * c) * 33 + n;
                    u32x4 o; o.x = cvt_pk_bf16(s[0 * 33], s[1 * 33]); o.y = cvt_pk_bf16(s[2 * 33], s[3 * 33]); o.z = cvt_pk_bf16(s[4 * 33], s[5 * 33]); o.w = cvt_pk_bf16(s[6 * 33], s[7 * 33]);
                    *(u32x4*)(cur.dst + ((size_t)(cur.drow + n) * cur.K + k0 + 8 * c) * 2) = o; } }
        };
        int it = gw;
        bool hA = it < NIT, hB = it + NGW < NIT;
        if (hA) { decode(it, dA); PRO_LOAD(dA, tvA); }
        if (hB) { decode(it + NGW, dB); PRO_LOAD(dB, tvB); }
        for (; hA; it += 2 * NGW) {
            PRO_SCR(tvA);
            TI cA = dA; const bool hn = it + 2 * NGW < NIT;
            if (hn) { decode(it + 2 * NGW, dA); PRO_LOAD(dA, tvA); }
            LDS_WAIT(); asm volatile("" ::: "memory");
            emit(cA);
            LDS_WAIT(); asm volatile("" ::: "memory");
            hA = hn;
            if (!hB) break;
            PRO_SCR(tvB);
            TI cB = dB; const bool hm = it + 3 * NGW < NIT;
            if (hm) { decode(it + 3 * NGW, dB); PRO_LOAD(dB, tvB); }
            LDS_WAIT(); asm volatile("" ::: "memory");
            emit(cB);
            LDS_WAIT(); asm volatile("" ::: "memory");
            hB = hm;
        }
#undef PRO_LOAD
#undef PRO_SCR
    }
    { float* bin = (float*)(F.ws + WS_BIN); for (int i = F.bid * NTHR + F.tid; i < 2 * PIN; i += F.G * NTHR) { const int l = i / PIN, r = i % PIN; bin[i] = P.in[I_BIN][l * PIN + inmap(r)]; } }
    __syncthreads();
    LAS float* sv = (LAS float*)F.lds;
    LAS float* red = (LAS float*)(F.lds + 16384);
    for (int i = F.tid; i < 3 * D; i += NTHR) { const int g = i / D, k = i % D; const float c = g < 2 ? P.in[I_C][g * D + k] : P.in[I_CCTX][k]; sv[i] = siluf_(c); }
    __syncthreads();
    for (int un = F.bid; un < 2 * 144; un += F.G) {
        const int l = un / 144, n0 = (un % 144) * 64;
        const float* wm = P.in[I_WMOD] + (size_t)l * D * 9216 + n0 + F.lane;
        float a0 = 0.f, a1 = 0.f, a2 = 0.f;
        float wv[2][32];
#pragma unroll
        for (int kk = 0; kk < 32; ++kk) wv[0][kk] = wm[(size_t)(F.wave * 128 + kk) * 9216];
#pragma unroll
        for (int kb = 0; kb < 4; ++kb) { const int k0 = kb * 32;
            if (kb < 3) {
#pragma unroll
                for (int kk = 0; kk < 32; ++kk) wv[(kb + 1) & 1][kk] = wm[(size_t)(F.wave * 128 + k0 + 32 + kk) * 9216]; }
#pragma unroll
            for (int kk = 0; kk < 32; ++kk) { const int k = F.wave * 128 + k0 + kk; const float w_ = wv[kb & 1][kk]; a0 += sv[k] * w_; a1 += sv[D + k] * w_; a2 += sv[2 * D + k] * w_; } }
        red[(F.wave * 3 + 0) * 64 + F.lane] = a0; red[(F.wave * 3 + 1) * 64 + F.lane] = a1; red[(F.wave * 3 + 2) * 64 + F.lane] = a2;
        __syncthreads();
        if (F.tid < 192) { const int g = F.tid >> 6, ln = F.tid & 63; float s = P.in[I_BMOD][l * 9216 + n0 + ln];
#pragma unroll
            for (int w = 0; w < 8; ++w) s += red[(w * 3 + g) * 64 + ln];
            ((float*)(F.ws + WS_MOD))[(size_t)(l * 3 + g) * 9216 + n0 + ln] = s; }
        __syncthreads();
    }
}

__device__ __forceinline__ void ln_stats(const f32x4 (&v)[4], float& mean, float& rstd) {
    float s = 0.f;
#pragma unroll
    for (int j = 0; j < 4; ++j) s += (v[j][0] + v[j][1]) + (v[j][2] + v[j][3]);
    mean = wave_sum(s) * (1.0f / D);
    float q = 0.f;
#pragma unroll
    for (int j = 0; j < 4; ++j) { const f32x4 d = v[j] - mean; q += (d[0] * d[0] + d[1] * d[1]) + (d[2] * d[2] + d[3] * d[3]); }
    rstd = __builtin_amdgcn_rsqf(wave_sum(q) * (1.0f / D) + LN_EPS);
}
__device__ __forceinline__ void modulate_store(const f32x4 (&x)[4], const float* shift, const float* scale, bf16* hrow, int lane) {
    float mean, rstd; ln_stats(x, mean, rstd);
#pragma unroll
    for (int j = 0; j < 4; ++j) { const int c = 4 * lane + 256 * j; const f32x4 sc = *(const f32x4*)(scale + c), sh = *(const f32x4*)(shift + c);
        const f32x4 h = (x[j] - mean) * rstd * (sc + 1.0f) + sh;
        u32x2 w; w.x = cvt_pk_bf16(h[0], h[1]); w.y = cvt_pk_bf16(h[2], h[3]); *(u32x2*)(hrow + c) = w; }
}
__device__ __forceinline__ void modulate_store8(const f32x4 (&x)[4], const float* shift, const float* scale, unsigned char* hrow, int lane) {
    float mean, rstd; ln_stats(x, mean, rstd);
#pragma unroll
    for (int j = 0; j < 4; ++j) { const int c = 4 * lane + 256 * j; const f32x4 sc = *(const f32x4*)(scale + c), sh = *(const f32x4*)(shift + c);
        const f32x4 h = (x[j] - mean) * rstd * (sc + 1.0f) + sh;
        *(unsigned*)(hrow + c) = pk_fp8x4(h[0], h[1], h[2], h[3]); }
}
constexpr int LNR = 4;
__device__ __forceinline__ void ln_stats_r(const f32x4 (&v)[LNR][4], float (&mean)[LNR], float (&rstd)[LNR]) {
    float s[LNR];
#pragma unroll
    for (int r = 0; r < LNR; ++r) { s[r] = 0.f;
#pragma unroll
        for (int j = 0; j < 4; ++j) s[r] += (v[r][j][0] + v[r][j][1]) + (v[r][j][2] + v[r][j][3]); }
#pragma unroll
    for (int r = 0; r < LNR; ++r) s[r] = wave_sum(s[r]);
    float q[LNR];
#pragma unroll
    for (int r = 0; r < LNR; ++r) { mean[r] = s[r] * (1.0f / D); q[r] = 0.f;
#pragma unroll
        for (int j = 0; j < 4; ++j) { const f32x4 d = v[r][j] - mean[r]; q[r] += (d[0] * d[0] + d[1] * d[1]) + (d[2] * d[2] + d[3] * d[3]); } }
#pragma unroll
    for (int r = 0; r < LNR; ++r) q[r] = wave_sum(q[r]);
#pragma unroll
    for (int r = 0; r < LNR; ++r) rstd[r] = __builtin_amdgcn_rsqf(q[r] * (1.0f / D) + LN_EPS);
}
__device__ __forceinline__ void phase_mod0(Frame& F, const Params& P) {
    const int skip = (F.G > 8) ? 4 : 0;
    if (F.bid < skip) return;
    const int gw = (F.bid - skip) * NWAVES + F.wave, NGW = (F.G - skip) * NWAVES;
    const float* MOD = (const float*)(F.ws + WS_MOD); bf16* H = (bf16*)(F.ws + WS_H);
    for (int row0 = gw; row0 < MT; row0 += LNR * NGW) {
        f32x4 x[LNR][4]; int rows[LNR];
#pragma unroll
        for (int r = 0; r < LNR; ++r) { rows[r] = min(row0 + r * NGW, MT - 1); const int row = rows[r];
            const float* xr = row < TL ? P.in[I_X] + (size_t)row * D : P.in[I_CTX] + (size_t)(row - TL) * D;
#pragma unroll
            for (int j = 0; j < 4; ++j) x[r][j] = *(const f32x4*)(xr + 4 * F.lane + 256 * j); }
        float mean[LNR], rstd[LNR]; ln_stats_r(x, mean, rstd);
#pragma unroll
        for (int r = 0; r < LNR; ++r) if (row0 + r * NGW < MT) { const int row = rows[r], g = row < SEQ ? 0 : (row < TL ? 1 : 2);
            const float* shift = MOD + (size_t)g * 9216, *scale = shift + D;
#pragma unroll
            for (int j = 0; j < 4; ++j) { const int c = 4 * F.lane + 256 * j; const f32x4 sc = *(const f32x4*)(scale + c), sh = *(const f32x4*)(shift + c);
                const f32x4 h = (x[r][j] - mean[r]) * rstd[r] * (sc + 1.0f) + sh;
                *(unsigned*)((unsigned char*)H + (size_t)row * D + c) = pk_fp8x4(h[0], h[1], h[2], h[3]); } }
    }
}
__device__ __forceinline__ void phase_ln(Frame& F, const Params& P, const float* lg, const float* lb, const float* modl  , int ishift, bool hmod, bool h8  , bool dual  , bool final_out, int cx_nks, float cx_coef, const float* cx_modv  , const float* cx_bias, const float* cx_xsrc, bool skipx  , const bf16* vsrc  ) {
    const int gw = F.bid * NWAVES + F.wave, NGW = F.G * NWAVES;
    const bf16* V = vsrc; bf16* H = (bf16*)(F.ws + WS_H);
    f32x4 g4[4], b4[4];
#pragma unroll
    for (int j = 0; j < 4; ++j) { g4[j] = *(const f32x4*)(lg + 4 * F.lane + 256 * j); b4[j] = *(const f32x4*)(lb + 4 * F.lane + 256 * j); }
    if (cx_nks > 0) {
        const float* part = (const float*)(F.ws + WS_ES);
        for (int r = gw; r < TC; r += NGW) {
            f32x4 v[4];
#pragma unroll
            for (int j = 0; j < 4; ++j) { const int c = 4 * F.lane + 256 * j; f32x4 s = cx_bias ? *(const f32x4*)(cx_bias + c) : (f32x4){0.f, 0.f, 0.f, 0.f};
                for (int ks = 0; ks < cx_nks; ++ks) s += *(const f32x4*)(part + ((size_t)ks * TC + r) * D + c);
                v[j] = *(const f32x4*)(cx_xsrc + (size_t)r * D + c) * ALPHA + *(const f32x4*)(cx_modv + c) * cx_coef * s; }
            float mean, rstd; ln_stats(v, mean, rstd);
            float* xr = (float*)(F.ws + WS_XC) + (size_t)r * D;
#pragma unroll
            for (int j = 0; j < 4; ++j) { v[j] = (v[j] - mean) * rstd * g4[j] + b4[j]; *(f32x4*)(xr + 4 * F.lane + 256 * j) = v[j]; }
            if (hmod && dual) modulate_store8(v, modl + (size_t)2 * 9216 + ishift * D, modl + (size_t)2 * 9216 + (ishift + 1) * D, F.ws + WS_H8C + (size_t)r * D, F.lane);
            if (hmod) { if (h8) modulate_store8(v, modl + (size_t)2 * 9216 + ishift * D, modl + (size_t)2 * 9216 + (ishift + 1) * D, (unsigned char*)H + (size_t)(TL + r) * D, F.lane);
                        else modulate_store(v, modl + (size_t)2 * 9216 + ishift * D, modl + (size_t)2 * 9216 + (ishift + 1) * D, H + (size_t)(TL + r) * D, F.lane); }
        }
    }
    const int M = TL;
    u32x2 raw[LNR][4];
#pragma unroll
    for (int r = 0; r < LNR; ++r) { const int rw = min(gw + r * NGW, M - 1);
#pragma unroll
        for (int j = 0; j < 4; ++j) raw[r][j] = *(const u32x2*)(V + (size_t)rw * D + 4 * F.lane + 256 * j); }
    for (int row0 = gw; row0 < M; row0 += LNR * NGW) {
        f32x4 v[LNR][4]; int rows[LNR];
#pragma unroll
        for (int r = 0; r < LNR; ++r) { rows[r] = min(row0 + r * NGW, M - 1);
#pragma unroll
            for (int j = 0; j < 4; ++j) { const u32x2 w = raw[r][j]; v[r][j] = (f32x4){bflo(w.x), bfhi(w.x), bflo(w.y), bfhi(w.y)}; } }
        if (row0 + LNR * NGW < M) {
#pragma unroll
            for (int r = 0; r < LNR; ++r) { const int rw = min(row0 + (LNR + r) * NGW, M - 1);
#pragma unroll
                for (int j = 0; j < 4; ++j) raw[r][j] = *(const u32x2*)(V + (size_t)rw * D + 4 * F.lane + 256 * j); }
        }
        float mean[LNR], rstd[LNR]; ln_stats_r(v, mean, rstd);
#pragma unroll
        for (int r = 0; r < LNR; ++r) { const int row = rows[r]; const bool ok = row0 + r * NGW < M;
            float* xr = P.out + (size_t)row * D; bf16* xh = (bf16*)P.out + (size_t)row * D;
            if (skipx && ok && F.lane == 0) *(f32x2*)((float*)(F.ws + WS_LNS) + (size_t)row * 2) = (f32x2){mean[r], rstd[r]};
#pragma unroll
            for (int j = 0; j < 4; ++j) { v[r][j] = (v[r][j] - mean[r]) * rstd[r] * g4[j] + b4[j];
                if (ok) { if (final_out) __builtin_nontemporal_store(v[r][j], (f32x4*)(xr + 4 * F.lane + 256 * j));
                          else if (!skipx) { u32x2 w; w.x = cvt_pk_bf16(v[r][j][0], v[r][j][1]); w.y = cvt_pk_bf16(v[r][j][2], v[r][j][3]); __builtin_nontemporal_store(w, (u32x2*)(xh + 4 * F.lane + 256 * j)); } } } }
        if (hmod) {
            ln_stats_r(v, mean, rstd);
#pragma unroll
            for (int r = 0; r < LNR; ++r) if (row0 + r * NGW < M) { const int row = rows[r], g = row < SEQ ? 0 : 1;
                const float* shift = modl + (size_t)g * 9216 + ishift * D, *scale = shift + D; bf16* hrow = H + (size_t)row * D;
#pragma unroll
                for (int j = 0; j < 4; ++j) { const int c = 4 * F.lane + 256 * j; const f32x4 sc = *(const f32x4*)(scale + c), sh = *(const f32x4*)(shift + c);
                    const f32x4 h = (v[r][j] - mean[r]) * rstd[r] * (sc + 1.0f) + sh;
                    if (h8) __builtin_nontemporal_store(pk_fp8x4(h[0], h[1], h[2], h[3]), (unsigned*)((unsigned char*)H + (size_t)row * D + c));
                    else { u32x2 w; w.x = cvt_pk_bf16(h[0], h[1]); w.y = cvt_pk_bf16(h[2], h[3]); __builtin_nontemporal_store(w, (u32x2*)(hrow + c)); }
                    if (dual) __builtin_nontemporal_store(pk_fp8x4(h[0], h[1], h[2], h[3]), (unsigned*)(F.ws + WS_H8L + (size_t)row * D + c)); } }
        }
    }
}

__device__ __forceinline__ void filter_unit(Frame& F, const Params& P, int l, int L, int t0, float* filt  , bool bfout) {
    LAS float* h1 = (LAS float*)F.lds;
    LAS bf16* h2b = (LAS bf16*)(F.lds + 32768);
    LAS float* zf = (LAS float*)(F.lds + 65536);
    LAS float* w2s = (LAS float*)(F.lds + 81920);
    LAS float* w1s = (LAS float*)(F.lds + 98304);
    const float* w1 = P.in[I_HW1] + l * 33 * 64; const float* b1 = P.in[I_HB1] + l * 64; const float* w2 = P.in[I_HW2] + l * 64 * 64; const float* b2 = P.in[I_HB2] + l * 64;
    const float* fq = P.in[I_HFQ] + l * 128; const float* w3 = P.in[I_HW3] + (size_t)l * 64 * 1024;
    {
#pragma unroll
        for (int i = 0; i < 8; ++i) w2s[F.tid + 512 * i] = w2[F.tid + 512 * i];
#pragma unroll
        for (int i = 0; i < 5; ++i) if (F.tid + 512 * i < 33 * 64) w1s[F.tid + 512 * i] = w1[F.tid + 512 * i];
        const int tl = F.tid >> 3, jg = F.tid & 7; const float t = (float)(t0 + tl);
        const float rL = 1.0f / (float)L;
        if (jg == 0) zf[tl * 36] = t * (1.0f / (float)(L - 1));
#pragma unroll
        for (int ii = 0; ii < 2; ++ii) { const int i = jg + 8 * ii; const float band = 1e-4f + (float)i * ((15.0f - 1e-4f) / 15.0f); const float tr_ = t * band * rL;
            zf[tl * 36 + 1 + i] = __builtin_amdgcn_cosf(tr_); zf[tl * 36 + 17 + i] = -__builtin_amdgcn_sinf(tr_); }
        __syncthreads();
        float a[8];
#pragma unroll
        for (int jj = 0; jj < 8; ++jj) a[jj] = b1[jg * 8 + jj];
#pragma unroll 3
        for (int i = 0; i < 33; ++i) { const float zv = zf[tl * 36 + i]; const LAS f32x4* wp = (const LAS f32x4*)(w1s + i * 64 + jg * 8); const f32x4 wa = wp[0], wb = wp[1];
            a[0] += zv * wa[0]; a[1] += zv * wa[1]; a[2] += zv * wa[2]; a[3] += zv * wa[3]; a[4] += zv * wb[0]; a[5] += zv * wb[1]; a[6] += zv * wb[2]; a[7] += zv * wb[3]; }
#pragma unroll
        for (int jj = 0; jj < 8; ++jj) h1[tl * 65 + jg * 8 + jj] = __builtin_amdgcn_sinf(fq[jg * 8 + jj] * a[jj] * 0.15915494309f);
        __syncthreads();
#pragma unroll
        for (int jj = 0; jj < 8; ++jj) a[jj] = b2[jg * 8 + jj];
#pragma unroll 4
        for (int i = 0; i < 64; ++i) { const float hv = h1[tl * 65 + i]; const LAS f32x4* wp = (const LAS f32x4*)(w2s + i * 64 + jg * 8); const f32x4 wa = wp[0], wb = wp[1];
            a[0] += hv * wa[0]; a[1] += hv * wa[1]; a[2] += hv * wa[2]; a[3] += hv * wa[3]; a[4] += hv * wb[0]; a[5] += hv * wb[1]; a[6] += hv * wb[2]; a[7] += hv * wb[3]; }
#pragma unroll
        for (int jj = 0; jj < 8; ++jj) h2b[tl * 72 + jg * 8 + jj] = (bf16)(cvt_pk_bf16(__builtin_amdgcn_sinf(fq[64 + jg * 8 + jj] * a[jj] * 0.15915494309f), 0.f) & 0xffffu);
        __syncthreads();
    }
    {
        const bf16* W3T = (const bf16*)(F.ws + WS_W3T) + (size_t)l * 1024 * 64;
        const int lane = F.lane, lr = lane & 15, lg = lane >> 4;
        const float dl0 = -4.605170186f / 1.5f, dl1 = -4.605170186f / 0.3f, rL1 = 1.0f / (float)(L - 1);
        bf16x8 af[4][2];
#pragma unroll
        for (int rt = 0; rt < 4; ++rt)
#pragma unroll
            for (int ks = 0; ks < 2; ++ks) af[rt][ks] = *(const LAS bf16x8*)(h2b + (rt * 16 + lr) * 72 + ks * 32 + 8 * lg);
#pragma unroll 2
        for (int ct = 0; ct < 8; ++ct) {
            const int col = F.wave * 128 + ct * 16 + lr, c = col & 255;
            const bf16x8 b0 = *(const bf16x8*)(W3T + (size_t)col * 64 + 8 * lg), b1 = *(const bf16x8*)(W3T + (size_t)col * 64 + 32 + 8 * lg);
            const float ad = fabsf(dl0 + (dl1 - dl0) * (float)c * (1.0f / 255.0f)), adl = ad * -1.44269504089f;
#pragma unroll
            for (int rt = 0; rt < 4; ++rt) {
                f32x4 a = (f32x4){0.f, 0.f, 0.f, 0.f};
                a = __builtin_amdgcn_mfma_f32_16x16x32_bf16(af[rt][0], b0, a, 0, 0, 0);
                a = __builtin_amdgcn_mfma_f32_16x16x32_bf16(af[rt][1], b1, a, 0, 0, 0);
                const int tb = t0 + rt * 16 + 4 * lg;
#pragma unroll
                for (int e = 0; e < 4; ++e) { const float tn = (float)(tb + e) * rL1; a[e] *= __builtin_amdgcn_exp2f(tn * adl); }
                if (bfout) { u32x2 w; w.x = cvt_pk_bf16(a[0], a[1]); w.y = cvt_pk_bf16(a[2], a[3]); *(u32x2*)((bf16*)filt + (size_t)col * L + tb) = w; }
                else *(f32x4*)(filt + (size_t)col * L + tb) = a;
            }
        }
    }
    __syncthreads();
}
__device__ __forceinline__ void phase_filters(Frame& F, const Params& P, int l, bool with_ctx) {
    float* filt = (float*)(F.ws + WS_FILT); float* filtc = (float*)(F.ws + WS_FILTC);
    const int nu = SEQ / 64 + (with_ctx ? CTXL / 64 : 0);
    for (int u = F.bid; u < nu; u += F.G) {
        if (u < SEQ / 64) filter_unit(F, P, l, SEQ, u * 64, filt, true);
        else filter_unit(F, P, l, CTXL, (u - SEQ / 64) * 64, filtc, false);
    }
}

__device__ __forceinline__ void seg_of(int row, int& s0, int& s1) {
    if (row < TL) { s0 = row & ~(SEQ - 1); s1 = s0 + SEQ; } else { s0 = TL + ((row - TL) & ~(CTXL - 1)); s1 = s0 + CTXL; }
}
__device__ __forceinline__ void conformer_tiles(Frame& F, const Params& P, int l, int u0, int ntile) {
    const bf16* UA = (const bf16*)(F.ws + WS_UA); bf16* BR0 = (bf16*)(F.ws + WS_BRV);
    LAS bf16* tin = (LAS bf16*)F.lds;
    LAS float* cout = (LAS float*)(F.lds + 49152);
    const int c = F.tid & 255, half = F.tid >> 8;
    float w[31];
#pragma unroll
    for (int j = 0; j < 31; ++j) w[j] = P.in[I_CDW][(l * 31 + j) * 256 + c];
    const float b = P.in[I_CDB][l * 256 + c];
    const f32x4 g = *(const f32x4*)(P.in[I_CLG] + l * 256 + 4 * F.lane), bb = *(const f32x4*)(P.in[I_CLB] + l * 256 + 4 * F.lane);
    u32x4 v[6];
#define CONF_LOAD(u_) do { const int t0_ = (u_) * 64; int s0_, s1_; seg_of(t0_, s0_, s1_); _Pragma("unroll") for (int k = 0; k < 6; ++k) { const int idx = F.tid + NTHR * k, rr = idx >> 5, c8 = idx & 31, gr = t0_ - 15 + rr; \
        const bool ok_ = idx < 94 * 32 && gr >= s0_ && gr < s1_; const u32x4 t_ = *(const u32x4*)(UA + (size_t)min(max(gr, s0_), s1_ - 1) * 256 + c8 * 8); v[k] = ok_ ? t_ : (u32x4){0u, 0u, 0u, 0u}; } } while (0)
    if (u0 < ntile) CONF_LOAD(u0);
    for (int u = u0; u < ntile; u += F.G) {
        const int t0 = u * 64;
#pragma unroll
        for (int k = 0; k < 6; ++k) { const int idx = F.tid + NTHR * k, rr = idx >> 5, c8 = idx & 31; if (idx < 94 * 32) *(LAS u32x4*)(tin + rr * 256 + c8 * 8) = v[k]; }
        __syncthreads();
        if (u + F.G < ntile) CONF_LOAD(u + F.G);
        {
            float in[62];
#pragma unroll
            for (int i = 0; i < 62; ++i) in[i] = bf2f(tin[(half * 32 + i) * 256 + c]);
#pragma unroll
            for (int t = 0; t < 32; ++t) { float a = b;
#pragma unroll
                for (int j = 0; j < 31; ++j) a += w[j] * in[t + j];
                cout[(half * 32 + t) * 260 + c] = a; }
        }
        __syncthreads();
        {
            f32x4 v[8]; float s[8], q[8];
#pragma unroll
            for (int tt = 0; tt < 8; ++tt) { v[tt] = *(const LAS f32x4*)(cout + (F.wave * 8 + tt) * 260 + 4 * F.lane); s[tt] = (v[tt][0] + v[tt][1]) + (v[tt][2] + v[tt][3]); }
#pragma unroll
            for (int tt = 0; tt < 8; ++tt) s[tt] = wave_sum(s[tt]);
#pragma unroll
            for (int tt = 0; tt < 8; ++tt) { v[tt] = v[tt] - s[tt] * (1.0f / 256.0f); q[tt] = (v[tt][0] * v[tt][0] + v[tt][1] * v[tt][1]) + (v[tt][2] * v[tt][2] + v[tt][3] * v[tt][3]); }
#pragma unroll
            for (int tt = 0; tt < 8; ++tt) q[tt] = wave_sum(q[tt]);
#pragma unroll
            for (int tt = 0; tt < 8; ++tt) { const float rstd = __builtin_amdgcn_rsqf(q[tt] * (1.0f / 256.0f) + LN_EPS);
                f32x4 y = v[tt] * rstd * g + bb;
#pragma unroll
                for (int j = 0; j < 4; ++j) y[j] = siluf_(y[j]);
                u32x2 wv; wv.x = cvt_pk_bf16(y[0], y[1]); wv.y = cvt_pk_bf16(y[2], y[3]);
                __builtin_nontemporal_store(wv, (u32x2*)(BR0 + (size_t)(t0 + F.wave * 8 + tt) * 256 + 4 * F.lane)); }
        }
        __syncthreads();
    }
}
#undef CONF_LOAD
__device__ __forceinline__ void shortconv_unit(Frame& F, const Params& P, int l, int t0) {
    const bf16* SB = (const bf16*)(F.ws + WS_SB); const bf16* W = (const bf16*)(F.ws + WS_W); bf16* BR2 = (bf16*)(F.ws + WS_BRV) + 2 * (size_t)MT * 256;
    int s0, s1; seg_of(t0, s0, s1);
    const float* cw = P.in[I_SCW] + l * 3 * 256;
#pragma unroll
    for (int k = 0; k < 4; ++k) { const int idx = F.tid + NTHR * k, tok = idx >> 5, c8 = (idx & 31) * 8, gr = t0 + tok;
        const u32x4 z = (u32x4){0u, 0u, 0u, 0u};
        const u32x4 wm_ = *(const u32x4*)(W + (size_t)max(gr - 1, s0) * 256 + c8), w0 = *(const u32x4*)(W + (size_t)gr * 256 + c8),
                    wp_ = *(const u32x4*)(W + (size_t)min(gr + 1, s1 - 1) * 256 + c8), sb = *(const u32x4*)(SB + (size_t)gr * 256 + c8);
        const u32x4 wm = (gr - 1 >= s0) ? wm_ : z, wp = (gr + 1 < s1) ? wp_ : z;
        float o[8];
#pragma unroll
        for (int j = 0; j < 4; ++j) { const int c = c8 + 2 * j;
            o[2 * j] = bflo(sb[j]) * (cw[c] * bflo(wm[j]) + cw[256 + c] * bflo(w0[j]) + cw[512 + c] * bflo(wp[j]));
            o[2 * j + 1] = bfhi(sb[j]) * (cw[c + 1] * bfhi(wm[j]) + cw[256 + c + 1] * bfhi(w0[j]) + cw[512 + c + 1] * bfhi(wp[j])); }
        u32x4 w; w.x = cvt_pk_bf16(o[0], o[1]); w.y = cvt_pk_bf16(o[2], o[3]); w.z = cvt_pk_bf16(o[4], o[5]); w.w = cvt_pk_bf16(o[6], o[7]);
        __builtin_nontemporal_store(w, (u32x4*)(BR2 + (size_t)gr * 256 + c8)); }
}
__device__ __forceinline__ void attn_stage_ctx(Frame& F, int b, int h) {
    const unsigned char* K = F.ws + WS_K; const unsigned char* VT = F.ws + WS_VT;
#pragma unroll
    for (int i = 0; i < 4; ++i) { const int pi = F.tid + NTHR * i;
        { const int key = pi >> 3, pc = pi & 7; const u32x4 v = *(const u32x4*)(K + (size_t)(TL + b * CTXL + key) * 512 + h * 128 + pc * 16);
          *(LAS u32x4*)(F.lds + key * 128 + ((pc ^ ((key & 3) | ((key >> 1) & 4))) << 4)) = v; }
        { const int dim = pi >> 5, pc = pi & 31; const u32x4 v = *(const u32x4*)(VT + ((size_t)(h * 64 + dim) * MT + TL + b * CTXL) * 2 + pc * 16);
          *(LAS u32x4*)(F.lds + 32768 + dim * 512 + ((pc ^ (dim & 7)) << 4)) = v; } }
}
__device__ __forceinline__ void attn_wave_unit(Frame& F, int wu, bool lat, bool cl  ) {
    const bf16* Q = (const bf16*)(F.ws + WS_Q); const bf16* K = (const bf16*)(F.ws + WS_K); const bf16* VT = (const bf16*)(F.ws + WS_VT);
    bf16* BR1 = (bf16*)(F.ws + WS_BRV) + (size_t)MT * 256;
    const LAS float* rpb = (const LAS float*)(F.lds + RPB_OFF);
    const int lane = lane_now(), q = lane & 15, g = lane >> 4;
    int b, h, r = 0, qb, tq0, cb = 0, r0 = 0;
    if (lat) { qb = wu & 3; h = (wu >> 2) & 3; r = (wu >> 4) & 255; b = wu >> 12; tq0 = b * SEQ + r * 64 + 16 * qb; cb = (qb == 0) ? 0 : (qb == 1 ? 8 : (qb == 2 ? 24 : 32)); r0 = min(max(r - 4, 0), 248); }
    else { qb = wu & 15; h = (wu >> 4) & 3; b = wu >> 6; tq0 = TL + b * CTXL + 16 * qb; }
    bf16x8 qf[2];
#pragma unroll
    for (int kk = 0; kk < 2; ++kk) qf[kk] = *(const bf16x8*)(Q + (size_t)(tq0 + q) * 256 + h * 64 + 32 * kk + 8 * g);
    const int koff = (q >> 2) * 8 + (q & 3);
    const unsigned klo = (unsigned)((koff * 256 + h * 64 + 8 * g) * 2);
    const unsigned vlo = (unsigned)((((h * 64 + q) * MT) + 8 * g) * 2);
    const char* Kc = (const char*)K; const char* Vc = (const char*)VT;
    const int kl0 = koff * 128 + ((g ^ ((q & 3) | (((q >> 2) & 1) << 2))) << 4), vl0 = 32768 + q * 512 + ((g ^ (q & 7)) << 4);
    const int cq = 16 * qb + q, c0 = min(max(cq - 8, 0), 48);
    float mx = -1e30f, sum = 0.f;
    f32x4 o[4];
#pragma unroll
    for (int bl = 0; bl < 4; ++bl) o[bl] = (f32x4){0.f, 0.f, 0.f, 0.f};
    bf16x8 kf[2][2][2];
#define ATT_KBASE(i_) (((i_) < 8) ? (b * SEQ + (r0 + (i_)) * 64 + cb) : (TL + b * CTXL + 32 * ((i_) - 8)))
#define ATT_LOADK(c_) do { _Pragma("unroll") for (int s_ = 0; s_ < 2; ++s_) { const int kb_ = ATT_KBASE(2 * (c_) + s_); _Pragma("unroll") for (int tt = 0; tt < 2; ++tt) { \
        if (cl && (c_) >= 4) { const int lo_ = (2 * (c_) + s_ - 8) * 4096 + tt * 512; kf[s_][tt][0] = *(const LAS bf16x8*)(F.lds + lo_ + kl0); kf[s_][tt][1] = *(const LAS bf16x8*)(F.lds + lo_ + (kl0 ^ 64)); } \
        else { const char* kp_ = Kc + (size_t)(kb_ + 4 * tt) * 512; kf[s_][tt][0] = *(const bf16x8*)(kp_ + klo); kf[s_][tt][1] = *(const bf16x8*)(kp_ + klo + 64); } } } } while (0)
#define ATT_LOADV(dst_, c_) do { _Pragma("unroll") for (int s_ = 0; s_ < 2; ++s_) { const int kb_ = ATT_KBASE(2 * (c_) + s_); _Pragma("unroll") for (int bl = 0; bl < 4; ++bl) \
        { if (cl && (c_) >= 4) { const int m_ = 2 * (c_) + s_ - 8; dst_[s_][bl] = *(const LAS bf16x8*)(F.lds + bl * 8192 + (m_ >> 1) * 128 + ((m_ & 1) ? (vl0 ^ 64) : vl0)); } \
          else dst_[s_][bl] = *(const bf16x8*)(Vc + ((size_t)(16 * bl) * MT + kb_) * 2 + vlo); } } } while (0)
    bf16x8 vf[2][4], vn[2][4];
    u32x4 kg[2][2][4], vg[2][4];
    LAS unsigned char* wb = F.lds + 65536 + F.wave * 8192;
    const int kq = lane >> 3;
    const int wk0 = kq * 128 + (((lane & 7) ^ (kq & 3)) << 4), wv0 = 4096 + (lane >> 2) * 64 + (((lane & 3) ^ ((lane >> 3) & 3)) << 4), vl1 = 4096 + q * 64 + ((g ^ ((q >> 1) & 3)) << 4);
    const unsigned gk = (unsigned)(kq * 512 + h * 128 + (lane & 7) * 16), gv = (unsigned)(((h * 64 + (lane >> 2)) * MT) * 2 + (lane & 3) * 16);
#define ATT_GLOADK(c_) do { _Pragma("unroll") for (int s_ = 0; s_ < 2; ++s_) { const int kb_ = ATT_KBASE(2 * (c_) + s_); _Pragma("unroll") for (int n = 0; n < 4; ++n) \
        kg[(c_) & 1][s_][n] = *(const u32x4*)(Kc + (size_t)kb_ * 512 + (size_t)n * 4096 + gk); } } while (0)
#define ATT_GLOADV(c_) do { _Pragma("unroll") for (int s_ = 0; s_ < 2; ++s_) { const int kb_ = ATT_KBASE(2 * (c_) + s_); _Pragma("unroll") for (int n = 0; n < 4; ++n) \
        vg[s_][n] = *(const u32x4*)(Vc + (size_t)kb_ * 2 + (size_t)n * 16 * MT * 2 + gv); } } while (0)
#define ATT_XPOSEK(c_) do { _Pragma("unroll") for (int s_ = 0; s_ < 2; ++s_) { \
        _Pragma("unroll") for (int n = 0; n < 4; ++n) *(LAS u32x4*)(wb + n * 1024 + ((n & 1) ? (wk0 ^ 64) : wk0)) = kg[(c_) & 1][s_][n]; \
        _Pragma("unroll") for (int tt = 0; tt < 2; ++tt) { kf[s_][tt][0] = *(const LAS bf16x8*)(wb + tt * 512 + kl0); kf[s_][tt][1] = *(const LAS bf16x8*)(wb + tt * 512 + (kl0 ^ 64)); } } } while (0)
#define ATT_XPOSEV() do { _Pragma("unroll") for (int s_ = 0; s_ < 2; ++s_) { \
        _Pragma("unroll") for (int n = 0; n < 4; ++n) *(LAS u32x4*)(wb + n * 1024 + wv0) = vg[s_][n]; \
        _Pragma("unroll") for (int bl = 0; bl < 4; ++bl) vf[s_][bl] = *(const LAS bf16x8*)(wb + bl * 1024 + vl1); } } while (0)
    if (cl) { ATT_GLOADK(0); ATT_GLOADV(0); ATT_GLOADK(1); } else if (lat) { ATT_LOADK(0); ATT_LOADV(vf, 0); } else { ATT_LOADK(4); ATT_LOADV(vf, 4); }
#pragma unroll
    for (int c = 0; c < 8; ++c) {
        if (c < 4 && !lat) continue;
        if (cl) { if (c < 4) { ATT_XPOSEK(c); if (c < 2) ATT_GLOADK(c + 2); } else { ATT_LOADK(c); ATT_LOADV(vf, c); } }
        f32x4 s[2][2];
#pragma unroll
        for (int s_ = 0; s_ < 2; ++s_)
#pragma unroll
            for (int tt = 0; tt < 2; ++tt) {
                f32x4 a = (f32x4){0.f, 0.f, 0.f, 0.f};
                a = __builtin_amdgcn_mfma_f32_16x16x32_bf16(kf[s_][tt][0], qf[0], a, 0, 0, 0);
                a = __builtin_amdgcn_mfma_f32_16x16x32_bf16(kf[s_][tt][1], qf[1], a, 0, 0, 0);
                if (c < 4) {
                    const int i = 2 * c + s_;
                    const LAS float* rp = rpb + (h * 15 + (r0 + i - r + 7)) * 31;
#pragma unroll
                    for (int j = 0; j < 4; ++j) { const int kc = cb + 8 * g + 4 * tt + j; const bool ok = (kc >= c0) && (kc < c0 + 16);
                        const int dc = min(max(kc - cq + 15, 0), 30);
                        a[j] = ok ? a[j] + rp[dc] : -1e30f; }
                }
                s[s_][tt] = a;
            }
        if (!cl && c < 7) { ATT_LOADK(c + 1); ATT_LOADV(vn, c + 1); }
        if (cl && c < 4) { ATT_XPOSEV(); if (c < 3) ATT_GLOADV(c + 1); }
        float cm = -1e30f;
#pragma unroll
        for (int s_ = 0; s_ < 2; ++s_)
#pragma unroll
            for (int tt = 0; tt < 2; ++tt)
#pragma unroll
                for (int j = 0; j < 4; ++j) cm = fmaxf(cm, s[s_][tt][j]);
        cm = xrow_max(cm);
        const float mn = fmaxf(mx, cm), alpha = __builtin_amdgcn_exp2f(mx - mn);
        mx = mn; sum *= alpha;
#pragma unroll
        for (int bl = 0; bl < 4; ++bl) o[bl] *= alpha;
#pragma unroll
        for (int s_ = 0; s_ < 2; ++s_) {
            float p[8];
#pragma unroll
            for (int tt = 0; tt < 2; ++tt)
#pragma unroll
                for (int j = 0; j < 4; ++j) { const float e = __builtin_amdgcn_exp2f(s[s_][tt][j] - mn); p[4 * tt + j] = e; sum += e; }
            u32x4 pw; pw.x = cvt_pk_bf16(p[0], p[1]); pw.y = cvt_pk_bf16(p[2], p[3]); pw.z = cvt_pk_bf16(p[4], p[5]); pw.w = cvt_pk_bf16(p[6], p[7]);
            const bf16x8 pf = __builtin_bit_cast(bf16x8, pw);
#pragma unroll
            for (int bl = 0; bl < 4; ++bl) o[bl] = __builtin_amdgcn_mfma_f32_16x16x32_bf16(vf[s_][bl], pf, o[bl], 0, 0, 0);
        }
        if (!cl && c < 7) {
#pragma unroll
            for (int s_ = 0; s_ < 2; ++s_)
#pragma unroll
                for (int bl = 0; bl < 4; ++bl) vf[s_][bl] = vn[s_][bl];
        }
    }
#undef ATT_XPOSEK
#undef ATT_XPOSEV
#undef ATT_GLOADK
#undef ATT_GLOADV
#undef ATT_LOADV
#undef ATT_LOADK
#undef ATT_KBASE
    sum = xrow_sum(sum);
    const float inv = __builtin_amdgcn_rcpf(sum);
#pragma unroll
    for (int bl = 0; bl < 4; ++bl) { u32x2 w; w.x = cvt_pk_bf16(o[bl][0] * inv, o[bl][1] * inv); w.y = cvt_pk_bf16(o[bl][2] * inv, o[bl][3] * inv);
        __builtin_nontemporal_store(w, (u32x2*)(BR1 + (size_t)(tq0 + q) * 256 + h * 64 + 16 * bl + 4 * g)); }
}

constexpr int FL = 16384;
__device__ __forceinline__ f32x2 cmul(f32x2 a, f32x2 b) {
    f32x2 t, r;
    asm("v_pk_mul_f32 %1, %2, %3 op_sel:[1,1] op_sel_hi:[1,0]\n\tv_pk_fma_f32 %0, %2, %3, %1 op_sel:[0,0,0] op_sel_hi:[0,1,1] neg_lo:[0,0,1]" : "=v"(r), "=&v"(t) : "v"(a), "v"(b));
    return r;
}
__device__ __forceinline__ f32x2 cmulc(f32x2 a, f32x2 b) {
    f32x2 t, r;
    asm("v_pk_mul_f32 %1, %2, %3 op_sel:[1,1] op_sel_hi:[1,0]\n\tv_pk_fma_f32 %0, %2, %3, %1 op_sel:[0,0,0] op_sel_hi:[0,1,1] neg_hi:[1,0,0]" : "=v"(r), "=&v"(t) : "v"(a), "v"(b));
    return r;
}
__device__ __forceinline__ f32x2 rotm(f32x2 b, f32x2 d) { f32x2 r; asm("v_pk_add_f32 %0, %1, %2 op_sel:[0,1] op_sel_hi:[1,0] neg_hi:[0,1]" : "=v"(r) : "v"(b), "v"(d)); return r; }
__device__ __forceinline__ f32x2 rotp(f32x2 b, f32x2 d) { f32x2 r; asm("v_pk_add_f32 %0, %1, %2 op_sel:[0,1] op_sel_hi:[1,0] neg_lo:[0,1]" : "=v"(r) : "v"(b), "v"(d)); return r; }
__device__ __forceinline__ f32x2 tw_main(const LAS f32x2* T, int m) { return cmul(T[m >> 7], T[128 + (m & 127)]); }
__device__ __forceinline__ f32x2 tw_half(const LAS f32x2* T, int n) { return cmul(T[256 + (n >> 7)], T[384 + (n & 127)]); }
__device__ __forceinline__ void r4f(f32x2& x0, f32x2& x1, f32x2& x2, f32x2& x3, f32x2 w1, f32x2 w2, f32x2 w3) {
    const f32x2 a = x0 + x2, b = x0 - x2, c = x1 + x3, d = x1 - x3;
    x0 = a + c; x1 = cmul(rotm(b, d), w1); x2 = cmul(a - c, w2); x3 = cmul(rotp(b, d), w3);
}
__device__ __forceinline__ void r4f1(f32x2& x0, f32x2& x1, f32x2& x2, f32x2& x3) {
    const f32x2 a = x0 + x2, b = x0 - x2, c = x1 + x3, d = x1 - x3;
    x0 = a + c; x1 = rotm(b, d); x2 = a - c; x3 = rotp(b, d);
}
__device__ __forceinline__ void r4i(f32x2& x0, f32x2& x1, f32x2& x2, f32x2& x3, f32x2 w1, f32x2 w2, f32x2 w3) {
    const f32x2 t1 = cmulc(x1, w1), t2 = cmulc(x2, w2), t3 = cmulc(x3, w3);
    const f32x2 a = x0 + t2, b = x0 - t2, c = t1 + t3, d = t1 - t3;
    x0 = a + c; x1 = rotp(b, d); x2 = a - c; x3 = rotm(b, d);
}
__device__ __forceinline__ void r4i1(f32x2& x0, f32x2& x1, f32x2& x2, f32x2& x3) {
    const f32x2 a = x0 + x2, b = x0 - x2, c = x1 + x3, d = x1 - x3;
    x0 = a + c; x1 = rotp(b, d); x2 = a - c; x3 = rotm(b, d);
}
#define W16_1 ((f32x2){0.92387953251f, -0.38268343237f})
#define W16_2 ((f32x2){0.70710678119f, -0.70710678119f})
#define W16_3 ((f32x2){0.38268343237f, -0.92387953251f})
template <int SP, bool INV> __device__ __forceinline__ void fft_pass16(LAS f32x2* B, const LAS f32x2* T, int tid) {
    constexpr int STEP = (SP == 1024) ? 1040 : (SP == 64 ? 65 : 4);
#pragma unroll
    for (int jj = 0; jj < 2; ++jj) {
        const int q = tid + 512 * jj;
        int k, base;
        if (SP == 1024) { k = q; base = q + (q >> 6); }
        else if (SP == 64) { k = q & 63; const int i0 = (q >> 6) * 1024 + k; base = i0 + (i0 >> 6); }
        else { k = q >> 8; base = (q & 255) * 65 + k; }
        LAS f32x2* p = B + base;
        f32x2 x[16];
#pragma unroll
        for (int m = 0; m < 16; ++m) x[m] = p[m * STEP];
        const f32x2 b = tw_main(T, k * (1024 / SP));
        const f32x2 b2 = cmul(b, b), w = cmul(b2, b2), w2 = cmul(w, w), w3 = cmul(w, w2);
        f32x2 t1[4], t2[4], t3[4];
        t1[0] = b; t1[1] = cmul(b, W16_1); t1[2] = cmul(b, W16_2); t1[3] = cmul(b, W16_3);
#pragma unroll
        for (int m = 0; m < 4; ++m) { t2[m] = cmul(t1[m], t1[m]); t3[m] = cmul(t1[m], t2[m]); }
        if (!INV) {
#pragma unroll
            for (int m = 0; m < 4; ++m) r4f(x[m], x[m + 4], x[m + 8], x[m + 12], t1[m], t2[m], t3[m]);
#pragma unroll
            for (int j = 0; j < 4; ++j) r4f(x[4 * j], x[4 * j + 1], x[4 * j + 2], x[4 * j + 3], w, w2, w3);
        } else {
#pragma unroll
            for (int j = 0; j < 4; ++j) r4i(x[4 * j], x[4 * j + 1], x[4 * j + 2], x[4 * j + 3], w, w2, w3);
#pragma unroll
            for (int m = 0; m < 4; ++m) r4i(x[m], x[m + 4], x[m + 8], x[m + 12], t1[m], t2[m], t3[m]);
        }
#pragma unroll
        for (int m = 0; m < 16; ++m) p[m * STEP] = x[m];
    }
    __syncthreads();
}
template <bool INV> __device__ __forceinline__ void fft_pass4(LAS f32x2* B, int tid) {
#pragma unroll 4
    for (int jj = 0; jj < 8; ++jj) {
        const int q = tid + 512 * jj;
        LAS f32x2* p = B + (q & 255) * 65 + 4 * (q >> 8);
        f32x2 x0 = p[0], x1 = p[1], x2 = p[2], x3 = p[3];
        if (!INV) r4f1(x0, x1, x2, x3); else r4i1(x0, x1, x2, x3);
        p[0] = x0; p[1] = x1; p[2] = x2; p[3] = x3;
    }
    __syncthreads();
}
__device__ __forceinline__ void fft_fwd(LAS f32x2* B, const LAS f32x2* T, int tid) {
    fft_pass16<1024, false>(B, T, tid); fft_pass16<64, false>(B, T, tid); fft_pass16<4, false>(B, T, tid); fft_pass4<false>(B, tid);
}
__device__ __forceinline__ void fft_inv(LAS f32x2* B, const LAS f32x2* T, int tid) {
    fft_pass4<true>(B, tid); fft_pass16<4, true>(B, T, tid); fft_pass16<64, true>(B, T, tid); fft_pass16<1024, true>(B, T, tid);
}
__device__ __forceinline__ void fft_pass4_keep(LAS f32x2* B, int tid, u32x4 (&ks)[8]) {
#pragma unroll
    for (int jj = 0; jj < 8; ++jj) {
        const int q = tid + 512 * jj;
        const LAS f32x2* p = B + (q & 255) * 65 + 4 * (q >> 8);
        f32x2 x0 = p[0], x1 = p[1], x2 = p[2], x3 = p[3];
        r4f1(x0, x1, x2, x3);
        ks[jj].x = cvt_pk_bf16(x0.x, x0.y); ks[jj].y = cvt_pk_bf16(x1.x, x1.y); ks[jj].z = cvt_pk_bf16(x2.x, x2.y); ks[jj].w = cvt_pk_bf16(x3.x, x3.y);
    }
    __syncthreads();
}
__device__ __forceinline__ void fft_mid4(LAS f32x2* B, int tid, const u32x4 (&ks)[8]) {
#pragma unroll
    for (int jj = 0; jj < 8; ++jj) {
        const int q = tid + 512 * jj;
        LAS f32x2* p = B + (q & 255) * 65 + 4 * (q >> 8);
        f32x2 x0 = p[0], x1 = p[1], x2 = p[2], x3 = p[3];
        r4f1(x0, x1, x2, x3);
        x0 = cmul(x0, (f32x2){bflo(ks[jj].x), bfhi(ks[jj].x)}); x1 = cmul(x1, (f32x2){bflo(ks[jj].y), bfhi(ks[jj].y)});
        x2 = cmul(x2, (f32x2){bflo(ks[jj].z), bfhi(ks[jj].z)}); x3 = cmul(x3, (f32x2){bflo(ks[jj].w), bfhi(ks[jj].w)});
        r4i1(x0, x1, x2, x3);
        p[0] = x0; p[1] = x1; p[2] = x2; p[3] = x3;
    }
    __syncthreads();
}
__device__ __forceinline__ void fft_fwd3(LAS f32x2* B, const LAS f32x2* T, int tid) { fft_pass16<1024, false>(B, T, tid); fft_pass16<64, false>(B, T, tid); fft_pass16<4, false>(B, T, tid); }
__device__ __forceinline__ void fft_inv3(LAS f32x2* B, const LAS f32x2* T, int tid) { fft_pass16<4, true>(B, T, tid); fft_pass16<64, true>(B, T, tid); fft_pass16<1024, true>(B, T, tid); }
__device__ __forceinline__ float conv3_at(const bf16* p, int n, int L, float w0, float w1, float w2, float b) {
    const float xm = n > 0 ? bf2f(p[n - 1]) : 0.f, x0 = bf2f(p[n]), xp = n + 1 < L ? bf2f(p[n + 1]) : 0.f;
    return w0 * xm + w1 * x0 + w2 * xp + b;
}
__device__ __forceinline__ float block_sum(Frame& F, float v) {
    LAS float* red = (LAS float*)(F.lds + RED_OFF);
    v = wave_sum(v);
    __syncthreads();
    if (F.lane == 0) red[F.wave] = v;
    __syncthreads();
    float s = 0.f;
#pragma unroll
    for (int w = 0; w < 8; ++w) s += red[w];
    return s;
}
__device__ __forceinline__ f32x4 conv3x4(const bf16* p, int nb, float w0, float w1, float w2, float b) {
    const u32x2 m = *(const u32x2*)(p + nb);
    const float x0 = bflo(m.x), x1 = bfhi(m.x), x2 = bflo(m.y), x3 = bfhi(m.y);
    const float xm = nb > 0 ? bf2f(p[nb - 1]) : 0.f, xp = nb + 4 < SEQ ? bf2f(p[nb + 4]) : 0.f;
    return (f32x4){w0 * xm + w1 * x0 + w2 * x1 + b, w0 * x0 + w1 * x1 + w2 * x2 + b, w0 * x1 + w1 * x2 + w2 * x3 + b, w0 * x2 + w1 * x3 + w2 * xp + b};
}
typedef u32x4 u32x4_a4 __attribute__((aligned(4)));
__device__ __forceinline__ u32x4 ld16u(const bf16* p) { return *(const u32x4_a4*)p; }
__device__ __forceinline__ void conv3p(const u32x4 a, const u32x4 b, bool first, bool last, float w0, float w1, float w2, float bb, f32x2 (&z)[4]) {
    f32x2 X[6];
    X[0] = (f32x2){bfhi(a.x), bfhi(b.x)}; X[1] = (f32x2){bflo(a.y), bflo(b.y)}; X[2] = (f32x2){bfhi(a.y), bfhi(b.y)};
    X[3] = (f32x2){bflo(a.z), bflo(b.z)}; X[4] = (f32x2){bfhi(a.z), bfhi(b.z)}; X[5] = (f32x2){bflo(a.w), bflo(b.w)};
    if (first) X[0] = (f32x2){0.f, 0.f};
    if (last) X[5] = (f32x2){0.f, 0.f};
#pragma unroll
    for (int e = 0; e < 4; ++e) z[e] = X[e] * w0 + (X[e + 1] * w1 + (X[e + 2] * w2 + bb));
}
__device__ __forceinline__ void hyena_unit(Frame& F, const Params& P, int l, int c, bool dummy) {
    LAS f32x2* B = (LAS f32x2*)F.lds; const LAS f32x2* T = (const LAS f32x2*)(F.lds + TW_OFF);
    const bf16* HT = (const bf16*)(F.ws + WS_HT); const bf16* FILT = (const bf16*)(F.ws + WS_FILT);
    f32x4* Z = (f32x4*)(F.ws + WS_KSCR + (size_t)F.bid * 131072);
    u32x4 ksr[8];
    u32x4* ES = (u32x4*)(F.ws + WS_ES + (size_t)F.bid * 131072) + 4096;
    bf16* BR3 = (bf16*)(F.ws + WS_BRV) + 3 * (size_t)MT * 256;
    const float* sw = P.in[I_HSW] + l * 3 * 768; const float* sb = P.in[I_HSB] + l * 768;
    const int tid = F.tid;
#define HY_NB(jp_) (4 * tq + 2048 * (jp_))
#define HY_TQ int tq = tid; asm volatile("" : "+v"(tq))
#define HY_G(T_, base_, boff_) (*(T_*)((char*)(base_) + (unsigned)(boff_)))
#define HY_LDX(row_, nb_) (*(const u32x4_a4*)((const char*)((row_) - 2) + (unsigned)((nb_) * 2)))
#define HY_LDR(hb_, nb_) (*(const u32x4_a4*)((const char*)((hb_) - 2) + (unsigned)((FL - 4 - (nb_)) * 2)))
#define HY_SLOT(nb_) (B + (nb_) + ((nb_) >> 6))
#define HY_TW4(nb_, w_) do { const f32x2 tb_ = T[256 + ((nb_) >> 7)]; const LAS f32x4* tp_ = (const LAS f32x4*)(T + 384 + ((nb_) & 127)); const f32x4 ta_ = tp_[0], tc_ = tp_[1]; \
        w_[0] = cmul(tb_, (f32x2){ta_[0], ta_[1]}); w_[1] = cmul(tb_, (f32x2){ta_[2], ta_[3]}); w_[2] = cmul(tb_, (f32x2){tc_[0], tc_[1]}); w_[3] = cmul(tb_, (f32x2){tc_[2], tc_[3]}); } while (0)
#define HY_ST4(nb_, c0_, c1_, c2_, c3_) do { LAS f32x2* bp_ = HY_SLOT(nb_); bp_[0] = (c0_); bp_[1] = (c1_); bp_[2] = (c2_); bp_[3] = (c3_); } while (0)
#define HY_UNPK(w_) ((f32x2){bflo(w_), bfhi(w_)})
#define HY_FILT4(fw_, gw_, nb_, f4_, r4_) const f32x4 f4_ = (f32x4){bflo(fw_.x), bfhi(fw_.x), bflo(fw_.y), bfhi(fw_.y)};   \
        const f32x4 r4_ = (f32x4){(nb_) ? bflo(gw_.w) : 0.f, bfhi(gw_.z), bflo(gw_.z), bfhi(gw_.y)}
    {
        const bf16* p0 = HT + (size_t)c * MT; const float v0 = sw[c], v1 = sw[768 + c], v2 = sw[1536 + c], vb = sb[c];
        { HY_TQ;
#pragma unroll
        for (int h = 0; h < 2; ++h) {
            u32x4 xa[4], xb[4];
#pragma unroll
            for (int j = 0; j < 4; ++j) { const int nb = HY_NB(4 * h + j); xa[j] = HY_LDX(p0, nb); xb[j] = HY_LDX(p0 + SEQ, nb); }
#pragma unroll
            for (int j = 0; j < 4; ++j) { const int nb = HY_NB(4 * h + j); f32x2 z[4]; conv3p(xa[j], xb[j], nb == 0, nb + 4 == SEQ, v0, v1, v2, vb, z);
                HY_G(f32x4, Z, nb * 8) = (f32x4){z[0].x, z[0].y, z[1].x, z[1].y}; HY_G(f32x4, Z + 1, nb * 8) = (f32x4){z[2].x, z[2].y, z[3].x, z[3].y}; }
        } }
    }
#pragma unroll 1
    for (int o = 0; o < 2; ++o) {
        const bf16* hf = FILT + (size_t)((o * 2 + 0) * 256 + c) * SEQ; const bf16* hb = FILT + (size_t)((o * 2 + 1) * 256 + c) * SEQ;
        float ss = 0.f;
#pragma unroll 1
        for (int par = 0; par < 2; ++par) {
            if (par == 0) {
                { HY_TQ;
#pragma unroll
                for (int h = 0; h < 2; ++h) {
                    u32x2 fw[4]; u32x4 gw[4];
#pragma unroll
                    for (int j = 0; j < 4; ++j) { const int nb = HY_NB(4 * h + j); fw[j] = HY_G(const u32x2, hf, nb * 2); gw[j] = HY_LDR(hb, nb); }
#pragma unroll
                    for (int j = 0; j < 4; ++j) { const int nb = HY_NB(4 * h + j); HY_FILT4(fw[j], gw[j], nb, f4, r4);
                        const f32x4 a = f4 + r4; ss += (f4[0] * f4[0] + f4[1] * f4[1]) + (f4[2] * f4[2] + f4[3] * f4[3]) + (r4[0] * r4[0] + r4[1] * r4[1]) + (r4[2] * r4[2] + r4[3] * r4[3]);
                        HY_ST4(nb, ((f32x2){a[0], 0.f}), ((f32x2){a[1], 0.f}), ((f32x2){a[2], 0.f}), ((f32x2){a[3], 0.f})); }
                } }
                __syncthreads();
            }
            fft_fwd3(B, T, tid); fft_pass4_keep(B, tid, ksr);
            { HY_TQ;
#pragma unroll
            for (int h = 0; h < 2; ++h) {
                f32x4 za[4], zb[4];
#pragma unroll
                for (int j = 0; j < 4; ++j) { const int nb = HY_NB(4 * h + j); za[j] = HY_G(const f32x4, Z, nb * 8); zb[j] = HY_G(const f32x4, Z + 1, nb * 8); }
#pragma unroll
                for (int j = 0; j < 4; ++j) { const int nb = HY_NB(4 * h + j);
                    const f32x2 z0 = (f32x2){za[j].x, za[j].y}, z1 = (f32x2){za[j].z, za[j].w}, z2 = (f32x2){zb[j].x, zb[j].y}, z3 = (f32x2){zb[j].z, zb[j].w};
                    if (par == 0) { HY_ST4(nb, z0, z1, z2, z3); }
                    else { f32x2 tw[4]; HY_TW4(nb, tw); HY_ST4(nb, cmul(z0, tw[0]), cmul(z1, tw[1]), cmul(z2, tw[2]), cmul(z3, tw[3])); } }
            } }
            __syncthreads();
            fft_fwd3(B, T, tid); fft_mid4(B, tid, ksr);
            fft_inv3(B, T, tid);
            if (par == 0) {
                { HY_TQ;
#pragma unroll
                for (int h = 0; h < 2; ++h) {
                    u32x2 fw[4]; u32x4 gw[4];
#pragma unroll
                    for (int j = 0; j < 4; ++j) { const int nb = HY_NB(4 * h + j); fw[j] = HY_G(const u32x2, hf, nb * 2); gw[j] = HY_LDR(hb, nb); }
#pragma unroll
                    for (int j = 0; j < 4; ++j) { const int jp = 4 * h + j, nb = HY_NB(jp); const LAS f32x2* bp = HY_SLOT(nb); const f32x2 a0 = bp[0] * (1.0f / 16384.0f), a1 = bp[1] * (1.0f / 16384.0f), a2 = bp[2] * (1.0f / 16384.0f), a3 = bp[3] * (1.0f / 16384.0f);
                        u32x4 w; w.x = cvt_pk_bf16(a0.x, a0.y); w.y = cvt_pk_bf16(a1.x, a1.y); w.z = cvt_pk_bf16(a2.x, a2.y); w.w = cvt_pk_bf16(a3.x, a3.y); HY_G(u32x4, ES + jp * 512, tq * 16) = w;
                        HY_FILT4(fw[j], gw[j], nb, f4, r4);
                        const f32x4 d = f4 - r4; f32x2 tw[4]; HY_TW4(nb, tw); HY_ST4(nb, tw[0] * d[0], tw[1] * d[1], tw[2] * d[2], tw[3] * d[3]); }
                } }
                __syncthreads();
            }
        }
        const float nrm = __builtin_amdgcn_rsqf(block_sum(F, ss) + 1e-6f) * 0.5f;
        const float hbias = P.in[I_HBI][(l * 2 + o) * 256 + c];
        const int ch = (o + 1) * 256 + c;
        const bf16* px = HT + (size_t)ch * MT; const float w0 = sw[ch], w1 = sw[768 + ch], w2 = sw[1536 + ch], bb = sb[ch];
        { HY_TQ;
#pragma unroll
        for (int h = 0; h < 4; ++h) {
            u32x4 ev[2], xa[2], xb[2]; f32x4 za[2], zb[2];
#pragma unroll
            for (int j = 0; j < 2; ++j) { const int jp = 2 * h + j, nb = HY_NB(jp); ev[j] = HY_G(const u32x4, ES + jp * 512, tq * 16); za[j] = HY_G(const f32x4, Z, nb * 8); zb[j] = HY_G(const f32x4, Z + 1, nb * 8); xa[j] = HY_LDX(px, nb); xb[j] = HY_LDX(px + SEQ, nb); }
#pragma unroll
            for (int j = 0; j < 2; ++j) { const int nb = HY_NB(2 * h + j);
                const LAS f32x2* bp = HY_SLOT(nb); f32x2 w[4]; HY_TW4(nb, w);
                const f32x2 e0 = HY_UNPK(ev[j].x) + cmulc(bp[0], w[0]) * (1.0f / 16384.0f), e1 = HY_UNPK(ev[j].y) + cmulc(bp[1], w[1]) * (1.0f / 16384.0f),
                            e2 = HY_UNPK(ev[j].z) + cmulc(bp[2], w[2]) * (1.0f / 16384.0f), e3 = HY_UNPK(ev[j].w) + cmulc(bp[3], w[3]) * (1.0f / 16384.0f);
                f32x2 x[4]; conv3p(xa[j], xb[j], nb == 0, nb + 4 == SEQ, w0, w1, w2, bb, x);
                const f32x2 y0 = (e0 * nrm + (f32x2){za[j].x, za[j].y} * hbias) * x[0], y1 = (e1 * nrm + (f32x2){za[j].z, za[j].w} * hbias) * x[1],
                            y2 = (e2 * nrm + (f32x2){zb[j].x, zb[j].y} * hbias) * x[2], y3 = (e3 * nrm + (f32x2){zb[j].z, zb[j].w} * hbias) * x[3];
                if (o == 0) { HY_G(f32x4, Z, nb * 8) = (f32x4){y0.x, y0.y, y1.x, y1.y}; HY_G(f32x4, Z + 1, nb * 8) = (f32x4){y2.x, y2.y, y3.x, y3.y}; }
                else if (!dummy) {
                    const unsigned u0 = cvt_pk_bf16(y0.x, y0.y), u1 = cvt_pk_bf16(y1.x, y1.y), u2 = cvt_pk_bf16(y2.x, y2.y), u3 = cvt_pk_bf16(y3.x, y3.y);
                    bf16* q0 = BR3 + c; bf16* q1 = q0 + (size_t)SEQ * 256; const int ob = nb * 512;
                    HY_G(bf16, q0, ob) = (bf16)(u0 & 0xffffu); HY_G(bf16, q0 + 256, ob) = (bf16)(u1 & 0xffffu); HY_G(bf16, q0 + 512, ob) = (bf16)(u2 & 0xffffu); HY_G(bf16, q0 + 768, ob) = (bf16)(u3 & 0xffffu);
                    HY_G(bf16, q1, ob) = (bf16)(u0 >> 16); HY_G(bf16, q1 + 256, ob) = (bf16)(u1 >> 16); HY_G(bf16, q1 + 512, ob) = (bf16)(u2 >> 16); HY_G(bf16, q1 + 768, ob) = (bf16)(u3 >> 16); }
            }
        } }
        __syncthreads();
    }
#undef HY_NB
#undef HY_TQ
#undef HY_G
#undef HY_LDX
#undef HY_LDR
#undef HY_FILT4
#undef HY_TW4
#undef HY_ST4
#undef HY_SLOT
#undef HY_UNPK
}
__device__ __forceinline__ void hyena_ctx_unit(Frame& F, const Params& P, int l, int c) {
    LAS float* zc = (LAS float*)F.lds;
    LAS float* kk = (LAS float*)(F.lds + 4096);
    const bf16* HT = (const bf16*)(F.ws + WS_HT); const float* FC = (const float*)(F.ws + WS_FILTC);
    bf16* BR3 = (bf16*)(F.ws + WS_BRV) + 3 * (size_t)MT * 256;
    const float* sw = P.in[I_HSW] + l * 3 * 768; const float* sb = P.in[I_HSB] + l * 768;
    const int b = F.tid >> 8, t = F.tid & 255;
    float zv = conv3_at(HT + (size_t)c * MT + TL + b * CTXL, t, CTXL, sw[c], sw[768 + c], sw[1536 + c], sb[c]);
    for (int o = 0; o < 2; ++o) {
        const float* hf = FC + (size_t)((o * 2 + 0) * 256 + c) * CTXL; const float* hb = FC + (size_t)((o * 2 + 1) * 256 + c) * CTXL;
        float ss = 0.f;
        if (F.tid < 256) { const float f = hf[F.tid]; kk[255 + F.tid] = f; ss = f * f; }
        else { const int d = F.tid - 256; if (d >= 1) { const float f = hb[d]; kk[255 - d] = f; ss = f * f; } }
        zc[F.tid] = zv;
        const float nrm = __builtin_amdgcn_rsqf(block_sum(F, ss) + 1e-6f);
        float y = 0.f;
        for (int s_ = 0; s_ < 256; ++s_) y += kk[t - s_ + 255] * zc[b * 256 + s_];
        y = y * nrm + P.in[I_HBI][(l * 2 + o) * 256 + c] * zv;
        const int ch = (o + 1) * 256 + c;
        zv = conv3_at(HT + (size_t)ch * MT + TL + b * CTXL, t, CTXL, sw[ch], sw[768 + ch], sw[1536 + ch], sb[ch]) * y;
        __syncthreads();
    }
    BR3[(size_t)(TL + b * CTXL + t) * 256 + c] = (bf16)(cvt_pk_bf16(zv, 0.f) & 0xffffu);
}
__device__ __forceinline__ void phase_mixer(Frame& F, const Params& P, int l, bool last) {
    {
        LAS float* rpb = (LAS float*)(F.lds + RPB_OFF); for (int i = F.tid; i < 1860; i += NTHR) rpb[i] = P.in[I_RPB][l * 1860 + i] * 1.44269504089f;
        LAS f32x2* T = (LAS f32x2*)(F.lds + TW_OFF);
        if (F.tid < 512) { const int tb = F.tid >> 7, a = F.tid & 127; const float x = tb == 0 ? (float)a / 128.0f : (tb == 1 ? (float)a / 16384.0f : (tb == 2 ? (float)a / 256.0f : (float)a / 32768.0f));
            float s, cs; sincospif(2.0f * x, &s, &cs); T[F.tid] = (f32x2){cs, -s}; }
        __syncthreads();
    }
#ifndef MIXMASK
#define MIXMASK 63
#endif
    if (MIXMASK & 1) for (int c = F.bid; c < 256; c += F.G) hyena_unit(F, P, l, ((c & 7) << 5) | (c >> 3), false);
    if (MIXDUP & 1) for (int c = F.bid; c < 256; c += F.G) hyena_unit(F, P, l, c, true);
    if (MIXMASK & 2) if (!last) for (int rep_ = 0; rep_ <= ((MIXDUP >> 1) & 1); ++rep_) for (int c = F.bid; c < 256; c += F.G) { hyena_ctx_unit(F, P, l, c); __syncthreads(); }
    const int ntile = (last ? TL : MT) / 64;
    if (MIXMASK & 4) for (int rep_ = 0; rep_ <= ((MIXDUP >> 2) & 1); ++rep_) conformer_tiles(F, P, l, (F.bid + F.G / 2) % F.G, ntile);
    if (MIXMASK & 8) for (int rep_ = 0; rep_ <= ((MIXDUP >> 3) & 1); ++rep_) for (int u = (F.bid + F.G / 4) % F.G; u < ntile; u += F.G) shortconv_unit(F, P, l, u * 64);
    const int gw = F.bid * NWAVES + F.wave, NGW = F.G * NWAVES;
    if (MIXMASK & 16) for (int rep_ = 0; rep_ <= ((MIXDUP >> 4) & 1); ++rep_) for (int task = F.bid; task < 256; task += F.G) {
        const int h = task & 3, b = task >> 7, rb = ((task >> 2) & 31) * 8;
        __syncthreads();
        attn_stage_ctx(F, b, h);
        __syncthreads();
#pragma unroll 1
        for (int it = 0; it < 4; ++it) { int wu = (b << 12) | ((rb + 2 * it + (F.wave >> 2)) << 4) | (h << 2) | (F.wave & 3); asm volatile("" : "+s"(wu));
            attn_wave_unit(F, wu, true, true); }
    }
    if (MIXMASK & 32) if (!last) for (int wu = gw; wu < 128; wu += NGW) attn_wave_unit(F, wu, false, false);
}

__global__ void __launch_bounds__(NTHR, 2) mk_fwd(Params P) {
    extern __shared__ __attribute__((aligned(16))) unsigned char lds_raw[];
    Frame F;
    const int wave0 = __builtin_amdgcn_readfirstlane(threadIdx.x >> 6);
    F.lds = (LAS unsigned char*)lds_raw; F.tid = threadIdx.x; F.lane = F.tid & 63; F.wave = __builtin_amdgcn_readfirstlane(F.tid >> 6); F.bid = blockIdx.x; F.G = gridDim.x; F.ws = P.ws;
    volatile LAS unsigned* MISC = (volatile LAS unsigned*)(F.lds + MISC_OFF);
    if (F.tid < 4) MISC[F.tid] = 0u;
    __syncthreads();
    XcdBarrier bar = xcd_barrier_post((unsigned*)(P.ws + WS_CTL) + 4096, MISC);
    const int lo = P.ph_lo, hi = P.ph_hi;
    int ph = 0;
#define PHASE_BEGIN if (ph >= lo && ph < hi) { { int t_; asm volatile("v_mbcnt_lo_u32_b32 %0, -1, 0\n\tv_mbcnt_hi_u32_b32 %0, -1, %0" : "=v"(t_)); t_ |= wave0 << 6; F.tid = t_; F.lane = t_ & 63; F.wave = __builtin_amdgcn_readfirstlane(t_ >> 6); size_t o_ = 0; asm volatile("" : "+s"(o_)); F.ws = P.ws + o_; }
#define PHASE_END   if (ph + 1 < hi) xcd_barrier(bar, F.tid); } ++ph;
#define MOD ((const float*)(F.ws + WS_MOD))
#define Hc ((const char*)(F.ws + WS_H))

    PHASE_BEGIN if (PHMASK & (1u << 0)) for (int rep_ = 0; rep_ <= (int)((DUPMASK >> 0) & 1u); ++rep_) { prologue_a(F, P); } PHASE_END
    PHASE_BEGIN if (PHMASK & (1u << 1)) for (int rep_ = 0; rep_ <= (int)((DUPMASK >> 1) & 1u); ++rep_) { phase_mod0(F, P); phase_filters(F, P, 0, true); } PHASE_END

    for (int l = 0; l < 2; ++l) {
        const bool last = (l == 1);
#define modl (MOD + (size_t)l * 3 * 9216)
#define xl ((l == 0) ? (const void*)P.in[I_X] : (const void*)P.out)
#define xc ((l == 0) ? P.in[I_CTX] : (const float*)(F.ws + WS_XC))
#define xcw ((const float*)(F.ws + WS_XC))
        PHASE_BEGIN if (PHMASK & (1u << 2)) for (int rep_ = 0; rep_ <= (int)((DUPMASK >> 2) & 1u); ++rep_) { { SchedPlain S{Hc, (const char*)(F.ws + WS_W1T) + (size_t)(l * 2 + 0) * NFF * D, 1024u, 1024u, 8, MT / 256, 22, F.G, F.bid};
            EpiFfnUp E{F.ws + WS_U}; pg8::gemm_phase<EpiFfnUp, SchedPlain, 1>(F.lds, S, E, F.tid); } } PHASE_END
        PHASE_BEGIN if (PHMASK & (1u << 3)) for (int rep_ = 0; rep_ <= (int)((DUPMASK >> 3) & 1u); ++rep_) { { SchedResid<5, 1, 6> S{(const char*)(F.ws + WS_U), (const char*)(F.ws + WS_W2T) + (size_t)(l * 2 + 0) * D * DFF, (unsigned)DFF, 22, F.G, F.bid, true, (const char*)(F.ws + WS_U) + (size_t)TL * DFF};
            EpiRes E{(bf16*)P.out, (l == 0) ? (const void*)P.in[I_X] : (const void*)(F.ws + WS_BRV), l != 0, modl + 2 * D, nullptr, 0.5f / W2_SCALE, (float*)(F.ws + WS_ES),
                (l != 0) ? (const float*)(F.ws + WS_LNS) : nullptr, P.in[I_PLG] + ((l + 1) % 2 * 3 + 2) * D, P.in[I_PLB] + ((l + 1) % 2 * 3 + 2) * D}; pg8::gemm_phase<EpiRes, SchedResid<5, 1, 6>, 1>(F.lds, S, E, F.tid); } } PHASE_END
        PHASE_BEGIN if (PHMASK & (1u << 4)) for (int rep_ = 0; rep_ <= (int)((DUPMASK >> 4) & 1u); ++rep_) { phase_ln(F, P, P.in[I_PLG] + (l * 3 + 0) * D, P.in[I_PLB] + (l * 3 + 0) * D, modl, 3, true, false, true, false, 5, 0.5f / W2_SCALE, modl + (size_t)2 * 9216 + 2 * D, nullptr, xc, true, (const bf16*)P.out); if (l == 1) phase_filters(F, P, 1, false); } PHASE_END
        PHASE_BEGIN if (PHMASK & (1u << 5)) for (int rep_ = 0; rep_ <= (int)((DUPMASK >> 5) & 1u); ++rep_) { { SchedInproj S{(const char*)F.ws, l, MT / 256, F.G, F.bid};
            EpiInproj E{(const float*)(F.ws + WS_BIN) + l * PIN, F.ws};
            pg8::gemm_phase<EpiInproj, SchedInproj, 2>(F.lds, S, E, F.tid); } } PHASE_END
        PHASE_BEGIN if (PHMASK & (1u << 6)) for (int rep_ = 0; rep_ <= (int)((DUPMASK >> 6) & 1u); ++rep_) { phase_mixer(F, P, l, last); } PHASE_END
        const int Mx = last ? TL : MT;
        PHASE_BEGIN if (PHMASK & (1u << 7)) for (int rep_ = 0; rep_ <= (int)((DUPMASK >> 7) & 1u); ++rep_) { { SchedGateBr S{Hc, (const char*)(F.ws + WS_H8L), (const char*)(F.ws + WS_H8C), (const char*)(F.ws + WS_WIT) + ((size_t)l * PIN + NINP) * D * 2, (const char*)(F.ws + WS_BRV), (const char*)(F.ws + WS_WPT) + (size_t)l * 4 * D * 256 * 2, F.G, F.bid, !last};
            EpiGateBr E{(const float*)(F.ws + WS_BIN) + l * PIN + NINP, F.ws + WS_GS + (size_t)F.bid * 393216, (bf16*)(F.ws + WS_MG), (bf16*)(F.ws + WS_MI)}; pg8::gemm_phase<EpiGateBr, SchedGateBr, 2>(F.lds, S, E, F.tid); } } PHASE_END
        PHASE_BEGIN if (PHMASK & (1u << 8)) for (int rep_ = 0; rep_ <= (int)((DUPMASK >> 8) & 1u); ++rep_) { { SchedResid<4, 4> S{(const char*)(F.ws + WS_MG), (const char*)(F.ws + WS_WOT) + (size_t)l * D * D * 2, 2048u, 16, F.G, F.bid, !last, (const char*)(F.ws + WS_MI)};
            EpiRes E{(bf16*)(F.ws + WS_BRV), (const void*)P.out, true, modl + 5 * D, P.in[I_BOUT] + l * D, 1.0f, (float*)(F.ws + WS_ES), (const float*)(F.ws + WS_LNS), P.in[I_PLG] + (l * 3 + 0) * D, P.in[I_PLB] + (l * 3 + 0) * D}; pg8::gemm_phase(F.lds, S, E, F.tid); } } PHASE_END
        PHASE_BEGIN if (PHMASK & (1u << 9)) for (int rep_ = 0; rep_ <= (int)((DUPMASK >> 9) & 1u); ++rep_) { phase_ln(F, P, P.in[I_PLG] + (l * 3 + 1) * D, P.in[I_PLB] + (l * 3 + 1) * D, modl, 6, true, true, false, false, last ? 0 : 16, 1.0f, modl + (size_t)2 * 9216 + 5 * D, P.in[I_BOUT] + l * D, xcw, true, (const bf16*)(F.ws + WS_BRV)); } PHASE_END
        PHASE_BEGIN if (PHMASK & (1u << 10)) for (int rep_ = 0; rep_ <= (int)((DUPMASK >> 10) & 1u); ++rep_) { { SchedPlain S{Hc, (const char*)(F.ws + WS_W1T) + (size_t)(l * 2 + 1) * NFF * D, 1024u, 1024u, 8, Mx / 256, 22, F.G, F.bid};
            EpiFfnUp E{F.ws + WS_U}; pg8::gemm_phase<EpiFfnUp, SchedPlain, 1>(F.lds, S, E, F.tid); } } PHASE_END
        PHASE_BEGIN if (PHMASK & (1u << 11)) for (int rep_ = 0; rep_ <= (int)((DUPMASK >> 11) & 1u); ++rep_) { { SchedResid<5, 1, 6> S{(const char*)(F.ws + WS_U), (const char*)(F.ws + WS_W2T) + (size_t)(l * 2 + 1) * D * DFF, (unsigned)DFF, 22, F.G, F.bid, !last, (const char*)(F.ws + WS_U) + (size_t)TL * DFF};
            EpiRes E{(bf16*)(F.ws + WS_BRV), (const void*)(F.ws + WS_BRV), true, modl + 8 * D, nullptr, 0.5f / W2_SCALE, (float*)(F.ws + WS_ES), (const float*)(F.ws + WS_LNS), P.in[I_PLG] + (l * 3 + 1) * D, P.in[I_PLB] + (l * 3 + 1) * D}; pg8::gemm_phase<EpiRes, SchedResid<5, 1, 6>, 1>(F.lds, S, E, F.tid); } } PHASE_END
        PHASE_BEGIN if (PHMASK & (1u << 12)) for (int rep_ = 0; rep_ <= (int)((DUPMASK >> 12) & 1u); ++rep_) { phase_ln(F, P, P.in[I_PLG] + (l * 3 + 2) * D, P.in[I_PLB] + (l * 3 + 2) * D, MOD + (size_t)3 * 9216  , 0, !last, true, false, last, last ? 0 : 5, 0.5f / W2_SCALE, modl + (size_t)2 * 9216 + 8 * D, nullptr, xcw, !last, (const bf16*)(F.ws + WS_BRV)); } PHASE_END
    }
#undef MOD
#undef Hc
#undef modl
#undef xcw
#undef xc
#undef xl
#undef PHASE_BEGIN
#undef PHASE_END
}

#ifndef MK_N_LAUNCHES
#define MK_N_LAUNCHES 1
#endif
constexpr int N_PHASES = 2 + 2 * 11;
extern "C" void kernel_launch(void* const* d_in, const int* in_sizes, int n_in, void* d_out, int out_size, void* d_ws, size_t ws_size, hipStream_t stream) {
    static int grid = 0;
    if (grid == 0) {
        if (n_in != 33 || out_size != TL * D || ws_size < WS_TOTAL) { fprintf(stderr, "kernel_launch: unexpected shapes (n_in %d out %d ws %zu)\n", n_in, out_size, ws_size); grid = -1; return; }
        int dev = 0, cus = 0;
        if (hipGetDevice(&dev) != hipSuccess || hipDeviceGetAttribute(&cus, hipDeviceAttributeMultiprocessorCount, dev) != hipSuccess) { grid = -1; return; }
        if (hipFuncSetAttribute((const void*)mk_fwd, hipFuncAttributeMaxDynamicSharedMemorySize, LDS_BYTES) != hipSuccess) { fprintf(stderr, "kernel_launch: hipFuncSetAttribute failed\n"); grid = -1; return; }
        int per_cu = 0;
        if (hipOccupancyMaxActiveBlocksPerMultiprocessor(&per_cu, (const void*)mk_fwd, NTHR, LDS_BYTES) != hipSuccess || per_cu < 1) fprintf(stderr, "kernel_launch: occupancy query says %d\n", per_cu);
        (void)hipGetLastError();
        grid = cus;
    }
    if (grid < 0) return;
    (void)hipMemsetAsync((char*)d_ws + WS_CTL, 0, CTL_BYTES, stream);
    Params p{};
    for (int i = 0; i < 33; ++i) p.in[i] = (const float*)d_in[i];
    p.out = (float*)d_out; p.ws = (unsigned char*)d_ws;
#if MK_N_LAUNCHES == 1
    p.ph_lo = 0; p.ph_hi = N_PHASES;
    hipLaunchKernelGGL(mk_fwd, dim3(grid), dim3(NTHR), LDS_BYTES, stream, p);
#else
    for (int i = 0; i < N_PHASES; ++i) { p.ph_lo = i; p.ph_hi = i + 1; hipLaunchKernelGGL(mk_fwd, dim3(grid), dim3(NTHR), LDS_BYTES, stream, p); }
#endif
}
```
